# Optimizing an MI355X kernel written in HIP

```python
import jax
import jax.numpy as jnp
from jax import lax
import numpy as np

D_MODEL = 1024
BATCH = 8
SEQ = 4096
DEPTH = 2

EPS = 1e-6
D_PLE = 256

GLA_HEADS = 4
GLA_DK = 32
GLA_DV = 64
GLA_GATE_RANK = 16
GLA_TAU = 16.0
GLA_CHUNK = 64
GLA_W = GLA_HEADS * GLA_DV

MLA_HEADS = 8
MLA_Q_RANK = 256
MLA_KV_RANK = 128
MLA_NOPE = 64
MLA_ROPE = 32
MLA_QK = MLA_NOPE + MLA_ROPE
MLA_V = 64
MLA_W = MLA_HEADS * MLA_V
ROPE_BASE = 10000.0
Q_BLOCK = 128

POOL_WINDOWS = (2, 4, 8, 16)
N_POOL = 4
POOL_GROUP = 64
POOL_W = N_POOL * POOL_GROUP

D_MIX = GLA_W + MLA_W + POOL_W

IN_SPLITS = (GLA_HEADS * GLA_DK, GLA_HEADS * GLA_DK, GLA_W, GLA_GATE_RANK, GLA_W,
             MLA_Q_RANK, MLA_KV_RANK, MLA_ROPE, POOL_W)
D_IN = 1456

N_EXPERTS = 32
TOP_K = 4
D_FF = 1024
SWIGLU_LIMIT = 7.0
SWIGLU_ALPHA = 1.702
MOE_BLOCK = 256

kernel_name = 'hybrid_gla_mla_pool_moe_ple'


def rms_norm(x, g):
    xf = x.astype(jnp.float32)
    y = xf * lax.rsqrt(jnp.mean(xf * xf, axis=-1, keepdims=True) + EPS)
    return (y * g.astype(jnp.float32)).astype(x.dtype)


def split_cols(z, sizes):
    return jnp.split(z, list(np.cumsum(sizes)[:-1]), axis=-1)


def rope_tables(positions):
    inv = ROPE_BASE ** (-jnp.arange(0, MLA_ROPE, 2, dtype=jnp.float32) / MLA_ROPE)
    ang = positions.astype(jnp.float32)[..., None] * inv
    return jnp.cos(ang), jnp.sin(ang)


def apply_rope(x, cos, sin):
    x1, x2 = jnp.split(x, 2, axis=-1)
    return jnp.concatenate([x1 * cos - x2 * sin, x2 * cos + x1 * sin], axis=-1)


def gla_mixer(q, k, v, g_low, r, w_gate, b_gate, out_norm):
    B, S, _ = q.shape
    H, C, DK, DV = GLA_HEADS, GLA_CHUNK, GLA_DK, GLA_DV
    N = S // C
    logit = (g_low @ w_gate + b_gate).astype(jnp.float32)
    log_a = jax.nn.log_sigmoid(logit) / GLA_TAU

    def chunked(t, d):
        return t.astype(jnp.float32).reshape(B, N, C, H, d).transpose(0, 3, 1, 2, 4)

    qc = chunked(q, DK) * (DK ** -0.5)
    kc = chunked(k, DK)
    vc = chunked(v, DV)
    bc = jnp.cumsum(chunked(log_a, DK), axis=3)
    b_last = bc[:, :, :, -1:, :]
    q_dec = qc * jnp.exp(bc)
    k_dec = kc * jnp.exp(-bc)
    k_end = kc * jnp.exp(b_last - bc)
    causal = jnp.tril(jnp.ones((C, C), dtype=bool))
    att = jnp.where(causal, jnp.einsum('bhnik,bhnjk->bhnij', q_dec, k_dec), 0.0)
    o_intra = jnp.einsum('bhnij,bhnjv->bhniv', att, vc)
    upd = jnp.einsum('bhnjk,bhnjv->bhnkv', k_end, vc)
    decay = jnp.exp(b_last[:, :, :, 0, :])

    def step(state, inp):
        d, u = inp
        return d[..., None] * state + u, state

    s0 = jnp.zeros((B, H, DK, DV), jnp.float32)
    _, s_prev = lax.scan(step, s0, (jnp.moveaxis(decay, 2, 0), jnp.moveaxis(upd, 2, 0)))
    s_prev = jnp.moveaxis(s_prev, 0, 2)
    o_inter = jnp.einsum('bhnik,bhnkv->bhniv', q_dec, s_prev)
    o = (o_intra + o_inter).transpose(0, 2, 3, 1, 4).reshape(B, S, H, DV)
    o = rms_norm(o, out_norm) * jax.nn.silu(r.astype(jnp.float32).reshape(B, S, H, DV))
    return o.reshape(B, S, GLA_W).astype(q.dtype)


def mla_mixer(c_q, c_kv, k_rope_raw, cos, sin, q_norm, w_uq, kv_norm, w_ukv, qk_q_norm, qk_k_norm):
    B, S, _ = c_q.shape
    H = MLA_HEADS
    q = (rms_norm(c_q, q_norm) @ w_uq).reshape(B, S, H, MLA_QK)
    kv = (rms_norm(c_kv, kv_norm) @ w_ukv).reshape(B, S, H, MLA_NOPE + MLA_V)
    k_nope, v = kv[..., :MLA_NOPE], kv[..., MLA_NOPE:]
    k_r = jnp.broadcast_to(k_rope_raw[:, :, None, :], (B, S, H, MLA_ROPE))
    k = jnp.concatenate([k_nope, k_r], axis=-1)
    q = rms_norm(q, qk_q_norm)
    k = rms_norm(k, qk_k_norm)
    cos_h, sin_h = cos[:, :, None, :], sin[:, :, None, :]
    q = jnp.concatenate([q[..., :MLA_NOPE], apply_rope(q[..., MLA_NOPE:], cos_h, sin_h)], axis=-1)
    k = jnp.concatenate([k[..., :MLA_NOPE], apply_rope(k[..., MLA_NOPE:], cos_h, sin_h)], axis=-1)
    q = q.transpose(0, 2, 1, 3)
    k = k.transpose(0, 2, 1, 3)
    v = v.transpose(0, 2, 1, 3)
    scale = MLA_QK ** -0.5
    key_pos = jnp.arange(S)

    def block(i):
        start = i * Q_BLOCK
        qb = lax.dynamic_slice_in_dim(q, start, Q_BLOCK, axis=2)
        s = jnp.einsum('bhqd,bhkd->bhqk', qb, k).astype(jnp.float32) * scale
        q_pos = start + jnp.arange(Q_BLOCK)
        s = jnp.where(key_pos[None, :] <= q_pos[:, None], s, -jnp.inf)
        pr = jax.nn.softmax(s, axis=-1)
        return jnp.einsum('bhqk,bhkd->bhqd', pr.astype(v.dtype), v)

    o = lax.map(block, jnp.arange(S // Q_BLOCK))
    return o.transpose(1, 0, 3, 2, 4).reshape(B, S, MLA_W)


def pool_mixer(u, w_pool, scale):
    B, S, _ = u.shape
    uf = u.astype(jnp.float32).reshape(B, S, N_POOL, POOL_GROUP)
    csum = jnp.cumsum(uf, axis=1)
    t = jnp.arange(S)
    pooled = []
    for gi, w in enumerate(POOL_WINDOWS):
        cg = csum[:, :, gi]
        lagged = jnp.pad(cg, ((0, 0), (w, 0), (0, 0)))[:, :S]
        cnt = jnp.minimum(t + 1, w).astype(jnp.float32)[None, :, None]
        pooled.append((cg - lagged) / cnt)
    pooled = jnp.stack(pooled, axis=2)
    y = jnp.einsum('bsgc,gcd->bsgd', pooled - uf, w_pool.astype(jnp.float32))
    return (y.reshape(B, S, POOL_W) * scale).astype(u.dtype)


def moe_ffn(xn, router_w, router_b, w_gate, b_gate, w_up, b_up, w_down, b_down):
    B, S, D = xn.shape
    T = B * S
    A = T * TOP_K
    x2 = xn.reshape(T, D)
    logits = (x2 @ router_w + router_b).astype(jnp.float32)
    top_val, top_idx = lax.top_k(logits, TOP_K)
    gates = jax.nn.softmax(top_val, axis=-1)
    flat_e = top_idx.reshape(A)
    flat_tok = jnp.arange(A, dtype=jnp.int32) // TOP_K
    flat_gate = gates.reshape(A)
    order = jnp.argsort(flat_e)
    sorted_e = flat_e[order]
    counts = jnp.bincount(flat_e, length=N_EXPERTS)
    padded = (counts + MOE_BLOCK - 1) // MOE_BLOCK * MOE_BLOCK
    pad_end = jnp.cumsum(padded)
    pad_start = pad_end - padded
    start = jnp.cumsum(counts) - counts
    dest = pad_start[sorted_e] + jnp.arange(A) - start[sorted_e]
    n_blocks = (A + N_EXPERTS * (MOE_BLOCK - 1) + MOE_BLOCK - 1) // MOE_BLOCK
    n_rows = n_blocks * MOE_BLOCK
    row_tok = jnp.full((n_rows,), T, jnp.int32).at[dest].set(flat_tok[order])
    row_gate = jnp.zeros((n_rows,), jnp.float32).at[dest].set(flat_gate[order])
    block_e = jnp.minimum(jnp.searchsorted(pad_end, jnp.arange(n_blocks) * MOE_BLOCK, side='right'),
                          N_EXPERTS - 1)
    x_pad = jnp.concatenate([x2, jnp.zeros((1, D), x2.dtype)], axis=0)
    xs = x_pad[row_tok].reshape(n_blocks, MOE_BLOCK, D)

    def run_block(args):
        xb, e = args
        g = jnp.minimum(xb @ w_gate[e] + b_gate[e], SWIGLU_LIMIT)
        up = jnp.clip(xb @ w_up[e] + b_up[e], -SWIGLU_LIMIT, SWIGLU_LIMIT)
        hb = (up + 1.0) * (g * jax.nn.sigmoid(SWIGLU_ALPHA * g))
        return hb @ w_down[e] + b_down[e]

    ys = lax.map(run_block, (xs, block_e)).reshape(n_rows, D)
    ys = ys * row_gate[:, None].astype(ys.dtype)
    out = jnp.zeros((T + 1, D), ys.dtype).at[row_tok].add(ys)[:T]
    return out.reshape(B, S, D)


def _normal(key, shape, scale):
    return jax.random.normal(key, shape, jnp.float32) * scale


def setup_inputs(seed: int = 0) -> dict:
    key = jax.random.key(seed)
    ks = list(jax.random.split(key, 32))
    L, D, E, F = DEPTH, D_MODEL, N_EXPERTS, D_FF

    def gain(k, n, s=0.02):
        return 1.0 + _normal(k, (L, n), s)

    offs = jax.random.randint(ks[2], (BATCH, 1), 0, 1024, dtype=jnp.int32)
    return {
        'x': _normal(ks[0], (BATCH, SEQ, D), 1.0),
        'p': _normal(ks[1], (DEPTH, BATCH, SEQ, D_PLE), 1.0),
        'positions': offs + jnp.arange(SEQ, dtype=jnp.int32)[None, :],
        'mix_norm': gain(ks[3], D),
        'w_in': _normal(ks[4], (L, D, D_IN), D ** -0.5),
        'gla_w_gate': _normal(ks[5], (L, GLA_GATE_RANK, GLA_HEADS * GLA_DK), GLA_GATE_RANK ** -0.5),
        'gla_b_gate': _normal(ks[6], (L, GLA_HEADS * GLA_DK), 0.02),
        'gla_out_norm': gain(ks[7], GLA_DV),
        'mla_q_norm': gain(ks[8], MLA_Q_RANK),
        'mla_w_uq': _normal(ks[9], (L, MLA_Q_RANK, MLA_HEADS * MLA_QK), MLA_Q_RANK ** -0.5),
        'mla_kv_norm': gain(ks[10], MLA_KV_RANK),
        'mla_w_ukv': _normal(ks[11], (L, MLA_KV_RANK, MLA_HEADS * (MLA_NOPE + MLA_V)), MLA_KV_RANK ** -0.5),
        'mla_qk_q_norm': gain(ks[12], MLA_QK),
        'mla_qk_k_norm': gain(ks[13], MLA_QK),
        'pool_w': _normal(ks[14], (L, N_POOL, POOL_GROUP, POOL_GROUP), POOL_GROUP ** -0.5),
        'pool_scale': gain(ks[15], POOL_W, 0.1),
        'w_out': _normal(ks[16], (L, D_MIX, D), D_MIX ** -0.5),
        'ffn_norm': gain(ks[17], D),
        'router_w': _normal(ks[18], (L, D, E), D ** -0.5),
        'router_b': _normal(ks[19], (L, E), 0.01),
        'moe_w_gate': _normal(ks[20], (L, E, D, F), D ** -0.5),
        'moe_b_gate': _normal(ks[21], (L, E, F), 0.02),
        'moe_w_up': _normal(ks[22], (L, E, D, F), D ** -0.5),
        'moe_b_up': _normal(ks[23], (L, E, F), 0.02),
        'moe_w_down': _normal(ks[24], (L, E, F, D), F ** -0.5),
        'moe_b_down': _normal(ks[25], (L, E, D), 0.02),
        'ple_w_proj': _normal(ks[26], (L, D_PLE, D), D_PLE ** -0.5),
        'ple_gate_norm': gain(ks[27], D),
        'ple_w_gate': _normal(ks[28], (L, D, D), D ** -0.5),
        'ple_post_norm': gain(ks[29], D),
    }


def reference(x, p, positions, mix_norm, w_in, gla_w_gate, gla_b_gate, gla_out_norm,
              mla_q_norm, mla_w_uq, mla_kv_norm, mla_w_ukv, mla_qk_q_norm, mla_qk_k_norm,
              pool_w, pool_scale, w_out, ffn_norm, router_w, router_b,
              moe_w_gate, moe_b_gate, moe_w_up, moe_b_up, moe_w_down, moe_b_down,
              ple_w_proj, ple_gate_norm, ple_w_gate, ple_post_norm):
    cos, sin = rope_tables(positions)
    h = x
    for i in range(DEPTH):
        hn = rms_norm(h, mix_norm[i])
        z = hn @ w_in[i]
        gq, gk, gv, g_low, g_r, c_q, c_kv, k_rope_raw, u_pool = split_cols(z, IN_SPLITS)
        y_gla = gla_mixer(gq, gk, gv, g_low, g_r, gla_w_gate[i], gla_b_gate[i], gla_out_norm[i])
        y_mla = mla_mixer(c_q, c_kv, k_rope_raw, cos, sin, mla_q_norm[i], mla_w_uq[i],
                          mla_kv_norm[i], mla_w_ukv[i], mla_qk_q_norm[i], mla_qk_k_norm[i])
        y_pool = pool_mixer(u_pool, pool_w[i], pool_scale[i])
        y_mix = jnp.concatenate([y_gla.astype(y_mla.dtype), y_mla, y_pool.astype(y_mla.dtype)], axis=-1)
        h = h + y_mix @ w_out[i]
        hn = rms_norm(h, ffn_norm[i])
        h = h + moe_ffn(hn, router_w[i], router_b[i], moe_w_gate[i], moe_b_gate[i],
                        moe_w_up[i], moe_b_up[i], moe_w_down[i], moe_b_down[i])
        e = p[i] @ ple_w_proj[i]
        gate = jax.nn.sigmoid(rms_norm(h, ple_gate_norm[i]) @ ple_w_gate[i])
        h = h + rms_norm(e * gate, ple_post_norm[i])
    return h
```

```cpp
#include <hip/hip_runtime.h>
#include <cstdio>
#include <cstdint>

typedef unsigned short bf16_t;
typedef short bf16x8 __attribute__((ext_vector_type(8)));
typedef float f32x4 __attribute__((ext_vector_type(4)));

constexpr int T = 32768, DM = 1024, SEQ = 4096, NBATCH = 8, DEPTH = 2;
constexpr int ZW = 1536;
constexpr int ZC_CQ = 0, ZC_GV = 256, ZC_GR = 512, ZC_UP = 768, ZC_GQ = 1024, ZC_GK = 1152, ZC_CKV = 1280, ZC_KR = 1408, ZC_GLOW = 1440;
constexpr int NE = 32, TOPK = 4, DFF = 1024;
constexpr int HROWS = 139264;
constexpr float EPS = 1e-6f;

__host__ __device__ inline int zsrc(int n) {
    if (n < 256) return 784 + n;
    if (n < 512) return 256 + (n - 256);
    if (n < 768) return 528 + (n - 512);
    if (n < 1024) return 1200 + (n - 768);
    if (n < 1152) return n - 1024;
    if (n < 1280) return 128 + (n - 1152);
    if (n < 1408) return 1040 + (n - 1280);
    if (n < 1440) return 1168 + (n - 1408);
    if (n < 1456) return 512 + (n - 1440);
    return -1;
}

constexpr size_t MiB = 1024 * 1024;
constexpr size_t WS_CTL = 0;
constexpr size_t WS_HB = 1 * MiB;
constexpr size_t WS_RSTD = WS_HB + 64 * MiB;
constexpr size_t WS_WSM = WS_RSTD + 1 * MiB;
constexpr size_t WSM_WIN = 0, WSM_WUQ = 3 * MiB, WSM_WUKV = WSM_WUQ + 384 * 1024, WSM_WOUT = WSM_WUKV + 256 * 1024, WSM_WPG = WSM_WOUT + 2 * MiB,
                 WSM_WPLE = WSM_WPG + 2 * MiB, WSM_WR = WSM_WPLE + 512 * 1024, WSM_STRIDE = WSM_WR + 128 * 1024 + 128 * 1024;
constexpr size_t WS_PB = WS_WSM + 2 * WSM_STRIDE;
constexpr size_t WS_W1 = WS_PB + 32 * MiB;
constexpr size_t WS_W2 = WS_W1 + 128 * MiB;
constexpr size_t WS_E = WS_W2 + 64 * MiB;
constexpr size_t WS_YMIX = WS_E + 64 * MiB;
constexpr size_t WS_Y = WS_YMIX + 64 * MiB;
constexpr size_t WS_UPD = WS_Y + 256 * MiB;
constexpr size_t WS_TOPG = WS_UPD + 17 * MiB;
constexpr size_t WS_LIST = WS_TOPG + 1 * MiB;
constexpr size_t WS_BIG = WS_LIST + 4 * MiB;
constexpr size_t BIG_Z = 0, BIG_Q = 96 * MiB, BIG_KV = BIG_Q + 48 * MiB, BIG_K = BIG_KV + 64 * MiB, BIG_LA = BIG_K + 48 * MiB;
constexpr size_t WS_END = WS_BIG + 272 * MiB;
constexpr int CTL_CNT = 4096;

__device__ __forceinline__ float bf2f(bf16_t v) { return __uint_as_float(((unsigned)v) << 16); }
__device__ __forceinline__ bf16_t f2bf(float f) { unsigned u = __float_as_uint(f); u += 0x7FFFu + ((u >> 16) & 1u); return (bf16_t)(u >> 16); }
__device__ __forceinline__ unsigned pack2(float lo, float hi) { return (unsigned)f2bf(lo) | ((unsigned)f2bf(hi) << 16); }
__device__ __forceinline__ float wave_sum(float v) {
#pragma unroll
    for (int o = 32; o >= 1; o >>= 1) v += __shfl_xor(v, o);
    return v;
}
__device__ __forceinline__ float wave_max(float v) {
#pragma unroll
    for (int o = 32; o >= 1; o >>= 1) v = fmaxf(v, __shfl_xor(v, o));
    return v;
}
__device__ __forceinline__ float sigmoidf_(float x) { return 1.0f / (1.0f + __expf(-x)); }

struct Params {
    const float *x, *p; const int* pos;
    const float *mix_norm, *w_in, *gla_wg, *gla_bg, *gla_on, *q_norm, *w_uq, *kv_norm, *w_ukv, *qkq, *qkk, *pool_w, *pool_s, *w_out, *ffn_norm, *router_w, *router_b,
        *moe_wg, *moe_bg, *moe_wu, *moe_bu, *moe_wd, *moe_bd, *ple_wp, *ple_gn, *ple_wg, *ple_pn;
    float* out; char* ws;
};

struct TcArgs { const float* src; const float* src2; const float* gain; bf16_t* dst; int K, ld_src, mode, pad; long src_estride, dst_estride; };
__global__ void __launch_bounds__(256) k_tconv(TcArgs a) {
    __shared__ float tile[64][65];
    const int e = blockIdx.z;
    const float* s1 = a.src + (long)e * a.src_estride;
    const float* s2 = a.src2 ? a.src2 + (long)e * a.src_estride : nullptr;
    bf16_t* d = a.dst + (long)e * a.dst_estride;
    const int n0 = blockIdx.x * 64, k0 = blockIdx.y * 64, tid = threadIdx.x, tx = tid & 63, ty = tid >> 6;
    const int n = n0 + tx;
    const float* sp = s1; int col;
    if (a.mode == 0) col = n;
    else if (a.mode == 1) col = zsrc(n);
    else { const int tl = n >> 8, w = n & 255; if (w < 128) col = tl * 128 + w; else { col = tl * 128 + (w - 128); sp = s2; } }
#pragma unroll
    for (int i = 0; i < 16; ++i) {
        const int k = k0 + ty + 4 * i; float v = 0.f;
        if (col >= 0) v = sp[(long)k * a.ld_src + col];
        if (a.gain) v *= a.gain[k];
        tile[ty + 4 * i][tx] = v;
    }
    __syncthreads();
    const int nl = tid >> 2, ks = (tid & 3) * 16;
    unsigned w0 = pack2(tile[ks + 0][nl], tile[ks + 1][nl]), w1 = pack2(tile[ks + 2][nl], tile[ks + 3][nl]), w2 = pack2(tile[ks + 4][nl], tile[ks + 5][nl]), w3 = pack2(tile[ks + 6][nl], tile[ks + 7][nl]);
    unsigned w4 = pack2(tile[ks + 8][nl], tile[ks + 9][nl]), w5 = pack2(tile[ks + 10][nl], tile[ks + 11][nl]), w6 = pack2(tile[ks + 12][nl], tile[ks + 13][nl]), w7 = pack2(tile[ks + 14][nl], tile[ks + 15][nl]);
    uint4* o = (uint4*)(d + (long)(n0 + nl) * a.K + k0 + ks);
    o[0] = make_uint4(w0, w1, w2, w3); o[1] = make_uint4(w4, w5, w6, w7);
}
__global__ void __launch_bounds__(256) k_conv_bf16(const float* src, bf16_t* dst, long n8) {
    for (long i = (long)blockIdx.x * 256 + threadIdx.x; i < n8; i += (long)gridDim.x * 256) {
        const float4 a = ((const float4*)src)[2 * i], b = ((const float4*)src)[2 * i + 1];
        ((uint4*)dst)[i] = make_uint4(pack2(a.x, a.y), pack2(a.z, a.w), pack2(b.x, b.y), pack2(b.z, b.w));
    }
}
__global__ void __launch_bounds__(256) k_prep_router(Params P) {
    const int i = blockIdx.x * 256 + threadIdx.x;
    if (i >= 2 * 32 * 1024) return;
    const int l = i >> 15, e = (i >> 10) & 31, k = i & 1023;
    float* Wr = (float*)(P.ws + WS_WSM + (size_t)l * WSM_STRIDE + WSM_WR);
    Wr[e * 1024 + k] = P.router_w[((size_t)l * 1024 + k) * 32 + e] * P.ffn_norm[l * 1024 + k];
}

__global__ void __launch_bounds__(256) k_init_h(Params P) {
    const int wid = threadIdx.x >> 6, lane = threadIdx.x & 63;
    bf16_t* HB = (bf16_t*)(P.ws + WS_HB); float* RS = (float*)(P.ws + WS_RSTD);
    for (int t = blockIdx.x * 4 + wid; t < T; t += gridDim.x * 4) {
        const float* hr = P.x + (size_t)t * 1024;
        float ss = 0.f; float4 v[4];
#pragma unroll
        for (int i = 0; i < 4; ++i) { v[i] = *(const float4*)(hr + i * 256 + lane * 4); ss += v[i].x * v[i].x + v[i].y * v[i].y + v[i].z * v[i].z + v[i].w * v[i].w; }
        ss = wave_sum(ss);
        if (lane == 0) RS[t] = rsqrtf(ss * (1.0f / 1024.0f) + EPS);
#pragma unroll
        for (int i = 0; i < 4; ++i) *(uint2*)(HB + (size_t)t * 1024 + i * 256 + lane * 4) = make_uint2(pack2(v[i].x, v[i].y), pack2(v[i].z, v[i].w));
    }
}

__global__ void __launch_bounds__(256) k_prepB(Params P, int layer) {
    __shared__ float pw[4 * 64 * 64];
    __shared__ float wg[16 * 128];
    const int tid = threadIdx.x, wid = tid >> 6, lane = tid & 63;
    for (int i = tid; i < 4 * 64 * 64; i += 256) pw[i] = P.pool_w[(size_t)layer * 16384 + i];
    for (int i = tid; i < 16 * 128; i += 256) wg[i] = P.gla_wg[(size_t)layer * 2048 + i];
    __syncthreads();
    bf16_t* Z = (bf16_t*)(P.ws + WS_BIG + BIG_Z); float* LA = (float*)(P.ws + WS_BIG + BIG_LA); bf16_t* YM = (bf16_t*)(P.ws + WS_YMIX);
    const float* bg = P.gla_bg + layer * 128; const float* psc = P.pool_s + layer * 256;
    for (int t = blockIdx.x * 4 + wid; t < T; t += gridDim.x * 4) {
        bf16_t* zr = Z + (size_t)t * ZW;
        {
            const uint2 raw = *(const uint2*)(zr + ZC_CQ + lane * 4);
            const float a = bf2f(raw.x & 0xffff), b = bf2f(raw.x >> 16), c = bf2f(raw.y & 0xffff), d = bf2f(raw.y >> 16);
            const float ss = wave_sum(a * a + b * b + c * c + d * d);
            const float r = rsqrtf(ss * (1.0f / 256.0f) + EPS);
            *(uint2*)(zr + ZC_CQ + lane * 4) = make_uint2(pack2(a * r, b * r), pack2(c * r, d * r));
        }
        {
            const unsigned raw = *(const unsigned*)(zr + ZC_CKV + lane * 2);
            const float a = bf2f(raw & 0xffff), b = bf2f(raw >> 16);
            const float ss = wave_sum(a * a + b * b);
            const float r = rsqrtf(ss * (1.0f / 128.0f) + EPS);
            *(unsigned*)(zr + ZC_CKV + lane * 2) = pack2(a * r, b * r);
        }
        {
            float gl = (lane < 16) ? bf2f(zr[ZC_GLOW + lane]) : 0.f;
            float l0 = bg[lane], l1 = bg[lane + 64];
#pragma unroll
            for (int r = 0; r < 16; ++r) { const float g = __shfl(gl, r); l0 += g * wg[r * 128 + lane]; l1 += g * wg[r * 128 + lane + 64]; }
            const float a0 = fminf(l0, 0.f) - log1pf(__expf(-fabsf(l0))), a1 = fminf(l1, 0.f) - log1pf(__expf(-fabsf(l1)));
            LA[(size_t)t * 128 + lane] = a0 * (1.0f / 16.0f); LA[(size_t)t * 128 + lane + 64] = a1 * (1.0f / 16.0f);
        }
        {
            const int s = t & (SEQ - 1);
#pragma unroll
            for (int gi = 0; gi < 4; ++gi) {
                const int w = 2 << gi; const int cnt = (s + 1 < w) ? s + 1 : w;
                const float u0 = bf2f(zr[ZC_UP + gi * 64 + lane]);
                float acc = u0;
                for (int j = 1; j < cnt; ++j) acc += bf2f(zr[(long)ZC_UP + gi * 64 + lane - (long)j * ZW]);
                const float dv = acc / (float)cnt - u0;
                float y = 0.f;
#pragma unroll 8
                for (int c = 0; c < 64; ++c) y += __shfl(dv, c) * pw[(gi * 64 + c) * 64 + lane];
                YM[(size_t)t * 1024 + 768 + gi * 64 + lane] = f2bf(y * psc[gi * 64 + lane]);
            }
        }
    }
}

__global__ void __launch_bounds__(256) k_prepD(Params P, int layer) {
    const int tid = threadIdx.x, wid = tid >> 6, lane = tid & 63;
    bf16_t* Z = (bf16_t*)(P.ws + WS_BIG + BIG_Z); bf16_t* Q = (bf16_t*)(P.ws + WS_BIG + BIG_Q); const bf16_t* KV = (const bf16_t*)(P.ws + WS_BIG + BIG_KV); bf16_t* Kd = (bf16_t*)(P.ws + WS_BIG + BIG_K);
    const float* gq = P.qkq + layer * 96; const float* gk = P.qkk + layer * 96;
    const int i16 = lane & 15;
    const float inv = exp2f(-(float)(2 * i16) * (1.0f / 32.0f) * 13.287712379549449f);
    const float qscale = 0.10206207261596577f;
    for (int th = blockIdx.x * 4 + wid; th < T * 8; th += gridDim.x * 4) {
        const int t = th >> 3, h = th & 7;
        const float ang = (float)P.pos[t] * inv; const float cs = cosf(ang), sn = sinf(ang);
        {
            bf16_t* qp = Q + (size_t)t * 768 + h * 96;
            const float a = bf2f(qp[lane]); const float b = (lane < 32) ? bf2f(qp[64 + lane]) : 0.f;
            const float ss = wave_sum(a * a + b * b);
            const float r = rsqrtf(ss * (1.0f / 96.0f) + EPS);
            const float an = a * r * gq[lane]; const float bn = (lane < 32) ? b * r * gq[64 + lane] : 0.f;
            const float partner = __shfl_xor(bn, 16);
            const float rot = (lane < 16) ? (bn * cs - partner * sn) : (bn * cs + partner * sn);
            qp[lane] = f2bf(an * qscale);
            if (lane < 32) qp[64 + lane] = f2bf(rot * qscale);
        }
        {
            const float a = bf2f(KV[(size_t)t * 1024 + h * 128 + lane]); const float b = (lane < 32) ? bf2f(Z[(size_t)t * ZW + ZC_KR + lane]) : 0.f;
            const float ss = wave_sum(a * a + b * b);
            const float r = rsqrtf(ss * (1.0f / 96.0f) + EPS);
            const float an = a * r * gk[lane]; const float bn = (lane < 32) ? b * r * gk[64 + lane] : 0.f;
            const float partner = __shfl_xor(bn, 16);
            const float rot = (lane < 16) ? (bn * cs - partner * sn) : (bn * cs + partner * sn);
            bf16_t* kp = Kd + ((size_t)t * 8 + h) * 96;
            kp[lane] = f2bf(an);
            if (lane < 32) kp[64 + lane] = f2bf(rot);
        }
    }
}

__global__ void __launch_bounds__(256) k_router(Params P, int layer) {
    const int tid = threadIdx.x, wid = tid >> 6, lane = tid & 63;
    bf16_t* HB = (bf16_t*)(P.ws + WS_HB); float* RS1 = (float*)(P.ws + WS_RSTD) + T;
    const float* Wr = (const float*)(P.ws + WS_WSM + (size_t)layer * WSM_STRIDE + WSM_WR);
    const float* rb = P.router_b + layer * 32;
    unsigned* cnt = (unsigned*)(P.ws + WS_CTL) + CTL_CNT + layer * 32;
    int* LIST = (int*)(P.ws + WS_LIST); float* TOPG = (float*)(P.ws + WS_TOPG);
    for (int t = blockIdx.x * 4 + wid; t < T; t += gridDim.x * 4) {
        const float* hr = P.out + (size_t)t * 1024;
        float4 v[4]; float ss = 0.f;
#pragma unroll
        for (int i = 0; i < 4; ++i) { v[i] = *(const float4*)(hr + i * 256 + lane * 4); ss += v[i].x * v[i].x + v[i].y * v[i].y + v[i].z * v[i].z + v[i].w * v[i].w; }
        ss = wave_sum(ss);
        const float rstd = rsqrtf(ss * (1.0f / 1024.0f) + EPS);
        if (lane == 0) RS1[t] = rstd;
#pragma unroll
        for (int i = 0; i < 4; ++i) *(uint2*)(HB + (size_t)t * 1024 + i * 256 + lane * 4) = make_uint2(pack2(v[i].x, v[i].y), pack2(v[i].z, v[i].w));
        float lg[32];
#pragma unroll
        for (int e = 0; e < 32; ++e) {
            float s = 0.f;
#pragma unroll
            for (int i = 0; i < 4; ++i) { const float4 w = *(const float4*)(Wr + e * 1024 + i * 256 + lane * 4); s += v[i].x * w.x + v[i].y * w.y + v[i].z * w.z + v[i].w * w.w; }
            lg[e] = wave_sum(s) * rstd + rb[e];
        }
        unsigned taken = 0u; float tv[4]; int ti[4];
#pragma unroll
        for (int k = 0; k < 4; ++k) {
            float best = -INFINITY; int bi = 0;
#pragma unroll
            for (int e = 0; e < 32; ++e) { const bool ok = !((taken >> e) & 1u) && (lg[e] > best); best = ok ? lg[e] : best; bi = ok ? e : bi; }
            taken |= 1u << bi; tv[k] = best; ti[k] = bi;
        }
        const float e1 = __expf(tv[1] - tv[0]), e2 = __expf(tv[2] - tv[0]), e3 = __expf(tv[3] - tv[0]);
        const float invs = 1.0f / (1.0f + e1 + e2 + e3);
        const float gt[4] = {invs, e1 * invs, e2 * invs, e3 * invs};
        if (lane < 4) {
            const int e = (lane == 0) ? ti[0] : (lane == 1) ? ti[1] : (lane == 2) ? ti[2] : ti[3];
            const float g = (lane == 0) ? gt[0] : (lane == 1) ? gt[1] : (lane == 2) ? gt[2] : gt[3];
            const unsigned pos = atomicAdd(&cnt[e], 1u);
            LIST[(size_t)e * T + pos] = t * 4 + lane;
            TOPG[t * 4 + lane] = g;
        }
    }
}

__global__ void __launch_bounds__(256) k_combine(Params P) {
    const int tid = threadIdx.x, wid = tid >> 6, lane = tid & 63;
    bf16_t* HB = (bf16_t*)(P.ws + WS_HB); float* RS2 = (float*)(P.ws + WS_RSTD) + 2 * T; const bf16_t* Y = (const bf16_t*)(P.ws + WS_Y);
    for (int t = blockIdx.x * 4 + wid; t < T; t += gridDim.x * 4) {
        float* hr = P.out + (size_t)t * 1024; float ss = 0.f;
#pragma unroll
        for (int i = 0; i < 4; ++i) {
            float4 v = *(const float4*)(hr + i * 256 + lane * 4);
#pragma unroll
            for (int k = 0; k < 4; ++k) {
                const uint2 y = *(const uint2*)(Y + ((size_t)t * 4 + k) * 1024 + i * 256 + lane * 4);
                v.x += bf2f(y.x & 0xffff); v.y += bf2f(y.x >> 16); v.z += bf2f(y.y & 0xffff); v.w += bf2f(y.y >> 16);
            }
            *(float4*)(hr + i * 256 + lane * 4) = v;
            ss += v.x * v.x + v.y * v.y + v.z * v.z + v.w * v.w;
            *(uint2*)(HB + (size_t)t * 1024 + i * 256 + lane * 4) = make_uint2(pack2(v.x, v.y), pack2(v.z, v.w));
        }
        ss = wave_sum(ss);
        if (lane == 0) RS2[t] = rsqrtf(ss * (1.0f / 1024.0f) + EPS);
    }
}

__global__ void __launch_bounds__(256) k_final(Params P, int layer) {
    const int tid = threadIdx.x, wid = tid >> 6, lane = tid & 63;
    bf16_t* HB = (bf16_t*)(P.ws + WS_HB); float* RS = (float*)(P.ws + WS_RSTD); const bf16_t* V = (const bf16_t*)(P.ws + WS_YMIX);
    const float* gp = P.ple_pn + layer * 1024;
    for (int t = blockIdx.x * 4 + wid; t < T; t += gridDim.x * 4) {
        float* hr = P.out + (size_t)t * 1024; float vv[16]; float ss = 0.f;
#pragma unroll
        for (int i = 0; i < 4; ++i) {
            const uint2 y = *(const uint2*)(V + (size_t)t * 1024 + i * 256 + lane * 4);
            vv[4 * i] = bf2f(y.x & 0xffff); vv[4 * i + 1] = bf2f(y.x >> 16); vv[4 * i + 2] = bf2f(y.y & 0xffff); vv[4 * i + 3] = bf2f(y.y >> 16);
            ss += vv[4 * i] * vv[4 * i] + vv[4 * i + 1] * vv[4 * i + 1] + vv[4 * i + 2] * vv[4 * i + 2] + vv[4 * i + 3] * vv[4 * i + 3];
        }
        ss = wave_sum(ss);
        const float r = rsqrtf(ss * (1.0f / 1024.0f) + EPS);
        float s2 = 0.f;
#pragma unroll
        for (int i = 0; i < 4; ++i) {
            float4 v = *(const float4*)(hr + i * 256 + lane * 4); const float4 g = *(const float4*)(gp + i * 256 + lane * 4);
            v.x += vv[4 * i] * r * g.x; v.y += vv[4 * i + 1] * r * g.y; v.z += vv[4 * i + 2] * r * g.z; v.w += vv[4 * i + 3] * r * g.w;
            *(float4*)(hr + i * 256 + lane * 4) = v;
            s2 += v.x * v.x + v.y * v.y + v.z * v.z + v.w * v.w;
            *(uint2*)(HB + (size_t)t * 1024 + i * 256 + lane * 4) = make_uint2(pack2(v.x, v.y), pack2(v.z, v.w));
        }
        s2 = wave_sum(s2);
        if (lane == 0) RS[t] = rsqrtf(s2 * (1.0f / 1024.0f) + EPS);
    }
}

struct EpiZ { bf16_t* Z; const float* rstd;
    __device__ __forceinline__ void operator()(int r, int c, f32x4 v) const { const float s = rstd[r]; *(uint2*)(Z + (size_t)r * ZW + c) = make_uint2(pack2(v[0] * s, v[1] * s), pack2(v[2] * s, v[3] * s)); } };
struct EpiBf16 { bf16_t* O; int ldo;
    __device__ __forceinline__ void operator()(int r, int c, f32x4 v) const { *(uint2*)(O + (size_t)r * ldo + c) = make_uint2(pack2(v[0], v[1]), pack2(v[2], v[3])); } };
struct EpiResid { const float* hin; float* out;
    __device__ __forceinline__ void operator()(int r, int c, f32x4 v) const { const f32x4 b = *(const f32x4*)(hin + (size_t)r * 1024 + c); *(f32x4*)(out + (size_t)r * 1024 + c) = b + v; } };
struct EpiMoe1 { const int* list; const float* rstd1; const float* bg; const float* bu; bf16_t* H;
    __device__ __forceinline__ void operator()(int r, int hc, f32x4 g, f32x4 u) const {
        const float s = rstd1[list[r] >> 2]; const f32x4 b0 = *(const f32x4*)(bg + hc), b1 = *(const f32x4*)(bu + hc); float o[4];
#pragma unroll
        for (int j = 0; j < 4; ++j) { const float gg = fminf(g[j] * s + b0[j], 7.0f); const float uu = fminf(fmaxf(u[j] * s + b1[j], -7.0f), 7.0f); o[j] = (uu + 1.0f) * gg * sigmoidf_(1.702f * gg); }
        *(uint2*)(H + (size_t)r * 1024 + hc) = make_uint2(pack2(o[0], o[1]), pack2(o[2], o[3])); } };
struct EpiMoe2 { const int* list; const float* topg; const float* bd; bf16_t* Y;
    __device__ __forceinline__ void operator()(int r, int c, f32x4 v) const { const int ts = list[r]; const float g = topg[ts]; const f32x4 b = *(const f32x4*)(bd + c);
        *(uint2*)(Y + (size_t)ts * 1024 + c) = make_uint2(pack2((v[0] + b[0]) * g, (v[1] + b[1]) * g), pack2((v[2] + b[2]) * g, (v[3] + b[3]) * g)); } };
struct EpiPle { const bf16_t* E; const float* rstd2; bf16_t* V;
    __device__ __forceinline__ void operator()(int r, int c, f32x4 v) const { const float s = rstd2[r]; const uint2 e = *(const uint2*)(E + (size_t)r * 1024 + c);
        const float o0 = bf2f(e.x & 0xffff) * sigmoidf_(v[0] * s), o1 = bf2f(e.x >> 16) * sigmoidf_(v[1] * s), o2 = bf2f(e.y & 0xffff) * sigmoidf_(v[2] * s), o3 = bf2f(e.y >> 16) * sigmoidf_(v[3] * s);
        *(uint2*)(V + (size_t)r * 1024 + c) = make_uint2(pack2(o0, o1), pack2(o2, o3)); } };

template <class Epi, bool PAIR>
__device__ __forceinline__ void gemm_simple_block(const bf16_t* A, int lda, const int* rowidx, const bf16_t* Bt, int ldb, int M, int K, int mblk, int nblk, const Epi& epi) {
    const int tid = threadIdx.x, wid = tid >> 6, lane = tid & 63, wr = wid >> 1, wc = wid & 1, fr = lane & 15, fq = lane >> 4;
    const int m0 = mblk * 128 + wr * 64;
    if (mblk * 128 >= M) return;
    const bf16_t* ap[4]; const bf16_t* bp[4];
#pragma unroll
    for (int mi = 0; mi < 4; ++mi) { int r = m0 + mi * 16 + fr; if (r >= M) r = M - 1; const long ar = rowidx ? (long)(rowidx[r] >> 2) : (long)r; ap[mi] = A + ar * lda + fq * 8; }
#pragma unroll
    for (int ni = 0; ni < 4; ++ni) {
        int br;
        if (PAIR) { const int hc = nblk * 64 + wc * 32 + (ni & 1) * 16 + fr; br = (hc >> 7) * 256 + (hc & 127) + ((ni >> 1) ? 128 : 0); }
        else br = nblk * 128 + wc * 64 + ni * 16 + fr;
        bp[ni] = Bt + (long)br * ldb + fq * 8;
    }
    f32x4 acc[4][4];
#pragma unroll
    for (int mi = 0; mi < 4; ++mi)
#pragma unroll
        for (int ni = 0; ni < 4; ++ni) acc[mi][ni] = (f32x4){0.f, 0.f, 0.f, 0.f};
    for (int k0 = 0; k0 < K; k0 += 32) {
        bf16x8 a[4], b[4];
#pragma unroll
        for (int i = 0; i < 4; ++i) { a[i] = *(const bf16x8*)(ap[i] + k0); b[i] = *(const bf16x8*)(bp[i] + k0); }
#pragma unroll
        for (int mi = 0; mi < 4; ++mi)
#pragma unroll
            for (int ni = 0; ni < 4; ++ni) acc[mi][ni] = __builtin_amdgcn_mfma_f32_16x16x32_bf16(b[ni], a[mi], acc[mi][ni], 0, 0, 0);
    }
#pragma unroll
    for (int mi = 0; mi < 4; ++mi) {
        const int r = m0 + mi * 16 + fr;
        if (r < M) {
            if constexpr (PAIR) {
#pragma unroll
                for (int ni = 0; ni < 2; ++ni) epi(r, nblk * 64 + wc * 32 + ni * 16 + fq * 4, acc[mi][ni], acc[mi][ni + 2]);
            } else {
#pragma unroll
                for (int ni = 0; ni < 4; ++ni) epi(r, nblk * 128 + wc * 64 + ni * 16 + fq * 4, acc[mi][ni]);
            }
        }
    }
}

enum { G_Z = 0, G_Q, G_KV, G_OUT, G_E, G_PLE };
template <int WHICH> __global__ void __launch_bounds__(256) k_gemm_dense(Params P, int layer) {
    const int nblk = blockIdx.x, mblk = blockIdx.y;
    char* ws = P.ws; const char* wsm = ws + WS_WSM + (size_t)layer * WSM_STRIDE;
    const bf16_t* HB = (const bf16_t*)(ws + WS_HB); const float* RS = (const float*)(ws + WS_RSTD);
    bf16_t* Z = (bf16_t*)(ws + WS_BIG + BIG_Z);
    if constexpr (WHICH == G_Z) { EpiZ e{Z, RS}; gemm_simple_block<EpiZ, false>(HB, 1024, nullptr, (const bf16_t*)(wsm + WSM_WIN), 1024, T, 1024, mblk, nblk, e); }
    if constexpr (WHICH == G_Q) { EpiBf16 e{(bf16_t*)(ws + WS_BIG + BIG_Q), 768}; gemm_simple_block<EpiBf16, false>(Z + ZC_CQ, ZW, nullptr, (const bf16_t*)(wsm + WSM_WUQ), 256, T, 256, mblk, nblk, e); }
    if constexpr (WHICH == G_KV) { EpiBf16 e{(bf16_t*)(ws + WS_BIG + BIG_KV), 1024}; gemm_simple_block<EpiBf16, false>(Z + ZC_CKV, ZW, nullptr, (const bf16_t*)(wsm + WSM_WUKV), 128, T, 128, mblk, nblk, e); }
    if constexpr (WHICH == G_OUT) { EpiResid e{layer == 0 ? P.x : P.out, P.out}; gemm_simple_block<EpiResid, false>((const bf16_t*)(ws + WS_YMIX), 1024, nullptr, (const bf16_t*)(wsm + WSM_WOUT), 1024, T, 1024, mblk, nblk, e); }
    if constexpr (WHICH == G_E) { EpiBf16 e{(bf16_t*)(ws + WS_E), 1024}; gemm_simple_block<EpiBf16, false>((const bf16_t*)(ws + WS_PB) + (size_t)layer * T * 256, 256, nullptr, (const bf16_t*)(wsm + WSM_WPLE), 256, T, 256, mblk, nblk, e); }
    if constexpr (WHICH == G_PLE) { EpiPle e{(const bf16_t*)(ws + WS_E), RS + 2 * T, (bf16_t*)(ws + WS_YMIX)}; gemm_simple_block<EpiPle, false>(HB, 1024, nullptr, (const bf16_t*)(wsm + WSM_WPG), 1024, T, 1024, mblk, nblk, e); }
}
__device__ __forceinline__ int expert_rowoff(const unsigned* cnt, int e) { int off = 0; for (int i = 0; i < e; ++i) off += (int)((cnt[i] + 255u) & ~255u); return off; }
__global__ void __launch_bounds__(256) k_moe1(Params P, int layer) {
    const int e = blockIdx.z; char* ws = P.ws;
    const unsigned* cnt = (const unsigned*)(ws + WS_CTL) + CTL_CNT + layer * 32;
    const int M = (int)cnt[e]; if ((int)blockIdx.y * 128 >= M) return;
    const int off = expert_rowoff(cnt, e);
    const int* list = (const int*)(ws + WS_LIST) + (size_t)e * T;
    EpiMoe1 ep{list, (const float*)(ws + WS_RSTD) + T, P.moe_bg + ((size_t)layer * 32 + e) * 1024, P.moe_bu + ((size_t)layer * 32 + e) * 1024, (bf16_t*)(ws + WS_BIG) + (size_t)off * 1024};
    gemm_simple_block<EpiMoe1, true>((const bf16_t*)(ws + WS_HB), 1024, list, (const bf16_t*)(ws + WS_W1) + (size_t)e * 2048 * 1024, 1024, M, 1024, blockIdx.y, blockIdx.x, ep);
}
__global__ void __launch_bounds__(256) k_moe2(Params P, int layer) {
    const int e = blockIdx.z; char* ws = P.ws;
    const unsigned* cnt = (const unsigned*)(ws + WS_CTL) + CTL_CNT + layer * 32;
    const int M = (int)cnt[e]; if ((int)blockIdx.y * 128 >= M) return;
    const int off = expert_rowoff(cnt, e);
    const int* list = (const int*)(ws + WS_LIST) + (size_t)e * T;
    EpiMoe2 ep{list, (const float*)(ws + WS_TOPG), P.moe_bd + ((size_t)layer * 32 + e) * 1024, (bf16_t*)(ws + WS_Y)};
    gemm_simple_block<EpiMoe2, false>((const bf16_t*)(ws + WS_BIG) + (size_t)off * 1024, 1024, nullptr, (const bf16_t*)(ws + WS_W2) + (size_t)e * 1024 * 1024, 1024, M, 1024, blockIdx.y, blockIdx.x, ep);
}

__global__ void __launch_bounds__(256) k_attn_simple(Params P) {
    __shared__ float qs[4][96]; __shared__ float ps[4][64];
    const int tid = threadIdx.x, wid = tid >> 6, lane = tid & 63;
    const bf16_t* Q = (const bf16_t*)(P.ws + WS_BIG + BIG_Q); const bf16_t* Kd = (const bf16_t*)(P.ws + WS_BIG + BIG_K); const bf16_t* KV = (const bf16_t*)(P.ws + WS_BIG + BIG_KV);
    bf16_t* YM = (bf16_t*)(P.ws + WS_YMIX);
    const long gw = (long)blockIdx.x * 4 + wid;
    const int s = (int)(gw & 4095), bh = (int)(gw >> 12), b = bh >> 3, h = bh & 7;
    const long t = (long)b * SEQ + s;
    qs[wid][lane] = bf2f(Q[t * 768 + h * 96 + lane]);
    if (lane < 32) qs[wid][64 + lane] = bf2f(Q[t * 768 + h * 96 + 64 + lane]);
    __syncthreads();
    float m = -INFINITY, l = 0.f, o = 0.f;
    for (int j0 = 0; j0 <= s; j0 += 64) {
        const int j = j0 + lane; const bool valid = j <= s;
        const long kt = (long)b * SEQ + (valid ? j : s);
        const uint4* kr = (const uint4*)(Kd + (kt * 8 + h) * 96);
        float sc = 0.f;
#pragma unroll
        for (int c = 0; c < 12; ++c) {
            const uint4 kk = kr[c];
            sc += qs[wid][c * 8 + 0] * bf2f(kk.x & 0xffff) + qs[wid][c * 8 + 1] * bf2f(kk.x >> 16) + qs[wid][c * 8 + 2] * bf2f(kk.y & 0xffff) + qs[wid][c * 8 + 3] * bf2f(kk.y >> 16)
                + qs[wid][c * 8 + 4] * bf2f(kk.z & 0xffff) + qs[wid][c * 8 + 5] * bf2f(kk.z >> 16) + qs[wid][c * 8 + 6] * bf2f(kk.w & 0xffff) + qs[wid][c * 8 + 7] * bf2f(kk.w >> 16);
        }
        sc = valid ? sc : -INFINITY;
        const float mn = fmaxf(m, wave_max(sc));
        const float pj = valid ? __expf(sc - mn) : 0.f;
        const float f = __expf(m - mn);
        l = l * f + wave_sum(pj); o *= f; m = mn;
        __syncthreads();
        ps[wid][lane] = pj;
        __syncthreads();
        const bf16_t* vb = KV + ((long)b * SEQ + j0) * 1024 + h * 128 + 64 + lane;
#pragma unroll 8
        for (int jj = 0; jj < 64; ++jj) o += ps[wid][jj] * bf2f(vb[(long)jj * 1024]);
    }
    YM[t * 1024 + 256 + h * 64 + lane] = f2bf(o / l);
}

__global__ void __launch_bounds__(64) k_gla_simple(Params P, int layer) {
    __shared__ float sq[16][32], sk[16][32], sa[16][32];
    const int bh = blockIdx.x, b = bh >> 2, h = bh & 3, lane = threadIdx.x;
    const bf16_t* Z = (const bf16_t*)(P.ws + WS_BIG + BIG_Z); const float* LA = (const float*)(P.ws + WS_BIG + BIG_LA); bf16_t* YM = (bf16_t*)(P.ws + WS_YMIX);
    const float g = P.gla_on[layer * 64 + lane];
    float st[32];
#pragma unroll
    for (int k = 0; k < 32; ++k) st[k] = 0.f;
    for (int c0 = 0; c0 < SEQ; c0 += 16) {
#pragma unroll
        for (int i = 0; i < 8; ++i) {
            const int idx = lane + 64 * i, sp = idx >> 5, k = idx & 31; const size_t t = (size_t)b * SEQ + c0 + sp;
            sq[sp][k] = bf2f(Z[t * ZW + ZC_GQ + h * 32 + k]) * 0.17677669529663687f;
            sk[sp][k] = bf2f(Z[t * ZW + ZC_GK + h * 32 + k]);
            sa[sp][k] = __expf(LA[t * 128 + h * 32 + k]);
        }
        float v[16], r[16];
#pragma unroll
        for (int sp = 0; sp < 16; ++sp) { const size_t t = (size_t)b * SEQ + c0 + sp; v[sp] = bf2f(Z[t * ZW + ZC_GV + h * 64 + lane]); r[sp] = bf2f(Z[t * ZW + ZC_GR + h * 64 + lane]); }
        __syncthreads();
#pragma unroll
        for (int sp = 0; sp < 16; ++sp) {
            float o = 0.f;
#pragma unroll
            for (int k = 0; k < 32; ++k) { st[k] = sa[sp][k] * st[k] + sk[sp][k] * v[sp]; o += sq[sp][k] * st[k]; }
            const float ss = wave_sum(o * o);
            const float on = o * rsqrtf(ss * (1.0f / 64.0f) + EPS) * g;
            const float rr = r[sp];
            YM[((size_t)b * SEQ + c0 + sp) * 1024 + h * 64 + lane] = f2bf(on * rr * sigmoidf_(rr));
        }
        __syncthreads();
    }
}

static void launch_tconv(hipStream_t st, const float* src, const float* src2, const float* gain, bf16_t* dst, int N, int K, int ld_src, int mode, int nexp, long se, long de) {
    TcArgs a{}; a.src = src; a.src2 = src2; a.gain = gain; a.dst = dst; a.K = K; a.ld_src = ld_src; a.mode = mode; a.pad = 0; a.src_estride = se; a.dst_estride = de;
    hipLaunchKernelGGL(k_tconv, dim3(N / 64, K / 64, nexp), dim3(256), 0, st, a);
}

extern "C" void kernel_launch(void* const* d_in, const int* in_sizes, int n_in, void* d_out, int out_size, void* d_ws, size_t ws_size, hipStream_t stream) {
    if (n_in != 30 || ws_size < WS_END) { fprintf(stderr, "kernel_launch: need 30 inputs and %zu bytes of workspace (got %d, %zu)\n", (size_t)WS_END, n_in, ws_size); return; }
    Params P{};
    P.x = (const float*)d_in[0]; P.p = (const float*)d_in[1]; P.pos = (const int*)d_in[2];
    P.mix_norm = (const float*)d_in[3]; P.w_in = (const float*)d_in[4]; P.gla_wg = (const float*)d_in[5]; P.gla_bg = (const float*)d_in[6]; P.gla_on = (const float*)d_in[7];
    P.q_norm = (const float*)d_in[8]; P.w_uq = (const float*)d_in[9]; P.kv_norm = (const float*)d_in[10]; P.w_ukv = (const float*)d_in[11]; P.qkq = (const float*)d_in[12]; P.qkk = (const float*)d_in[13];
    P.pool_w = (const float*)d_in[14]; P.pool_s = (const float*)d_in[15]; P.w_out = (const float*)d_in[16]; P.ffn_norm = (const float*)d_in[17]; P.router_w = (const float*)d_in[18]; P.router_b = (const float*)d_in[19];
    P.moe_wg = (const float*)d_in[20]; P.moe_bg = (const float*)d_in[21]; P.moe_wu = (const float*)d_in[22]; P.moe_bu = (const float*)d_in[23]; P.moe_wd = (const float*)d_in[24]; P.moe_bd = (const float*)d_in[25];
    P.ple_wp = (const float*)d_in[26]; P.ple_gn = (const float*)d_in[27]; P.ple_wg = (const float*)d_in[28]; P.ple_pn = (const float*)d_in[29];
    P.out = (float*)d_out; P.ws = (char*)d_ws;
    char* ws = (char*)d_ws;
    (void)hipMemsetAsync(ws + WS_CTL, 0, 65536, stream);
    for (int l = 0; l < DEPTH; ++l) {
        char* wsm = ws + WS_WSM + (size_t)l * WSM_STRIDE;
        launch_tconv(stream, P.w_in + (size_t)l * 1024 * 1456, nullptr, P.mix_norm + l * 1024, (bf16_t*)(wsm + WSM_WIN), ZW, 1024, 1456, 1, 1, 0, 0);
        launch_tconv(stream, P.w_uq + (size_t)l * 256 * 768, nullptr, P.q_norm + l * 256, (bf16_t*)(wsm + WSM_WUQ), 768, 256, 768, 0, 1, 0, 0);
        launch_tconv(stream, P.w_ukv + (size_t)l * 128 * 1024, nullptr, P.kv_norm + l * 128, (bf16_t*)(wsm + WSM_WUKV), 1024, 128, 1024, 0, 1, 0, 0);
        launch_tconv(stream, P.w_out + (size_t)l * 1024 * 1024, nullptr, nullptr, (bf16_t*)(wsm + WSM_WOUT), 1024, 1024, 1024, 0, 1, 0, 0);
        launch_tconv(stream, P.ple_wg + (size_t)l * 1024 * 1024, nullptr, P.ple_gn + l * 1024, (bf16_t*)(wsm + WSM_WPG), 1024, 1024, 1024, 0, 1, 0, 0);
        launch_tconv(stream, P.ple_wp + (size_t)l * 256 * 1024, nullptr, nullptr, (bf16_t*)(wsm + WSM_WPLE), 1024, 256, 1024, 0, 1, 0, 0);
    }
    hipLaunchKernelGGL(k_conv_bf16, dim3(2048), dim3(256), 0, stream, P.p, (bf16_t*)(ws + WS_PB), (long)2 * T * 256 / 8);
    hipLaunchKernelGGL(k_prep_router, dim3(256), dim3(256), 0, stream, P);
    hipLaunchKernelGGL(k_init_h, dim3(2048), dim3(256), 0, stream, P);
    for (int l = 0; l < DEPTH; ++l) {
        launch_tconv(stream, P.moe_wg + (size_t)l * 32 * 1024 * 1024, P.moe_wu + (size_t)l * 32 * 1024 * 1024, P.ffn_norm + l * 1024, (bf16_t*)(ws + WS_W1), 2048, 1024, 1024, 2, 32, 1024L * 1024, 2048L * 1024);
        launch_tconv(stream, P.moe_wd + (size_t)l * 32 * 1024 * 1024, nullptr, nullptr, (bf16_t*)(ws + WS_W2), 1024, 1024, 1024, 0, 32, 1024L * 1024, 1024L * 1024);
        hipLaunchKernelGGL(k_gemm_dense<G_E>, dim3(8, T / 128), dim3(256), 0, stream, P, l);
        hipLaunchKernelGGL(k_gemm_dense<G_Z>, dim3(ZW / 128, T / 128), dim3(256), 0, stream, P, l);
        hipLaunchKernelGGL(k_prepB, dim3(2048), dim3(256), 0, stream, P, l);
        hipLaunchKernelGGL(k_gemm_dense<G_Q>, dim3(6, T / 128), dim3(256), 0, stream, P, l);
        hipLaunchKernelGGL(k_gemm_dense<G_KV>, dim3(8, T / 128), dim3(256), 0, stream, P, l);
        hipLaunchKernelGGL(k_prepD, dim3(4096), dim3(256), 0, stream, P, l);
        hipLaunchKernelGGL(k_gla_simple, dim3(32), dim3(64), 0, stream, P, l);
        hipLaunchKernelGGL(k_attn_simple, dim3(T * 8 / 4), dim3(256), 0, stream, P);
        hipLaunchKernelGGL(k_gemm_dense<G_OUT>, dim3(8, T / 128), dim3(256), 0, stream, P, l);
        hipLaunchKernelGGL(k_router, dim3(2048), dim3(256), 0, stream, P, l);
        hipLaunchKernelGGL(k_moe1, dim3(16, T / 128, 32), dim3(256), 0, stream, P, l);
        hipLaunchKernelGGL(k_moe2, dim3(8, T / 128, 32), dim3(256), 0, stream, P, l);
        hipLaunchKernelGGL(k_combine, dim3(2048), dim3(256), 0, stream, P);
        hipLaunchKernelGGL(k_gemm_dense<G_PLE>, dim3(8, T / 128), dim3(256), 0, stream, P, l);
        hipLaunchKernelGGL(k_final, dim3(2048), dim3(256), 0, stream, P, l);
    }
}
```

```cpp
#include <hip/hip_runtime.h>
#include <cstdio>
#include <cstdint>

typedef unsigned short bf16_t;
typedef short bf16x8 __attribute__((ext_vector_type(8)));
typedef float f32x4 __attribute__((ext_vector_type(4)));

constexpr int T = 32768, DM = 1024, SEQ = 4096, NBATCH = 8, DEPTH = 2;
constexpr int ZW = 1536;
constexpr int ZC_CQ = 0, ZC_GV = 256, ZC_GR = 512, ZC_UP = 768, ZC_GQ = 1024, ZC_GK = 1152, ZC_CKV = 1280, ZC_KR = 1408, ZC_GLOW = 1440;
constexpr int NE = 32, TOPK = 4, DFF = 1024;
constexpr int HROWS = 139264;
constexpr float EPS = 1e-6f;

__host__ __device__ inline int zsrc(int n) {
    if (n < 256) return 784 + n;
    if (n < 512) return 256 + (n - 256);
    if (n < 768) return 528 + (n - 512);
    if (n < 1024) return 1200 + (n - 768);
    if (n < 1152) return n - 1024;
    if (n < 1280) return 128 + (n - 1152);
    if (n < 1408) return 1040 + (n - 1280);
    if (n < 1440) return 1168 + (n - 1408);
    if (n < 1456) return 512 + (n - 1440);
    return -1;
}

constexpr size_t MiB = 1024 * 1024;
constexpr size_t WS_CTL = 0;
constexpr size_t WS_HB = 1 * MiB;
constexpr size_t WS_RSTD = WS_HB + 64 * MiB;
constexpr size_t WS_WSM = WS_RSTD + 1 * MiB;
constexpr size_t WSM_WIN = 0, WSM_WUQ = 3 * MiB, WSM_WUKV = WSM_WUQ + 384 * 1024, WSM_WOUT = WSM_WUKV + 256 * 1024, WSM_WPG = WSM_WOUT + 2 * MiB,
                 WSM_WPLE = WSM_WPG + 2 * MiB, WSM_WR = WSM_WPLE + 512 * 1024, WSM_STRIDE = WSM_WR + 128 * 1024 + 128 * 1024;
constexpr size_t WS_PB = WS_WSM + 2 * WSM_STRIDE;
constexpr size_t WS_W1 = WS_PB + 32 * MiB;
constexpr size_t WS_W2 = WS_W1 + 128 * MiB;
constexpr size_t WS_E = WS_W2 + 64 * MiB;
constexpr size_t WS_YMIX = WS_E + 64 * MiB;
constexpr size_t WS_Y = WS_YMIX + 64 * MiB;
constexpr size_t WS_UPD = WS_Y + 256 * MiB;
constexpr size_t WS_TOPG = WS_UPD + 17 * MiB;
constexpr size_t WS_LIST = WS_TOPG + 1 * MiB;
constexpr size_t WS_BIG = WS_LIST + 4 * MiB;
constexpr size_t BIG_Z = 0, BIG_Q = 96 * MiB, BIG_KV = BIG_Q + 48 * MiB, BIG_K = BIG_KV + 64 * MiB, BIG_LA = BIG_K + 48 * MiB;
constexpr size_t WS_END = WS_BIG + 272 * MiB;
constexpr int CTL_CNT = 4096;

__device__ __forceinline__ float bf2f(bf16_t v) { return __uint_as_float(((unsigned)v) << 16); }
__device__ __forceinline__ bf16_t f2bf(float f) { unsigned u = __float_as_uint(f); u += 0x7FFFu + ((u >> 16) & 1u); return (bf16_t)(u >> 16); }
__device__ __forceinline__ unsigned pack2(float lo, float hi) { return (unsigned)f2bf(lo) | ((unsigned)f2bf(hi) << 16); }
__device__ __forceinline__ float wave_sum(float v) {
#pragma unroll
    for (int o = 32; o >= 1; o >>= 1) v += __shfl_xor(v, o);
    return v;
}
__device__ __forceinline__ float wave_max(float v) {
#pragma unroll
    for (int o = 32; o >= 1; o >>= 1) v = fmaxf(v, __shfl_xor(v, o));
    return v;
}
__device__ __forceinline__ float sigmoidf_(float x) { return 1.0f / (1.0f + __expf(-x)); }


#define XB_TMO      128
#define XB_XCNT(j)  (256  + 64 * (j))
#define XB_XSUB(j)  (1280 + 64 * (j))
#define XB_XGEN(j)  (2304 + 64 * (j))
#define XB_TOP      3328
#define XB_TOPGEN   3392
#define XCD_BAR_WORDS 3456
#define XB_SPIN_CAP (1u << 18)
#define LAS __attribute__((address_space(3)))

__device__ __forceinline__ unsigned xb_ld(unsigned* p)              { return __hip_atomic_load(p, __ATOMIC_RELAXED, __HIP_MEMORY_SCOPE_AGENT); }
__device__ __forceinline__ unsigned xb_add(unsigned* p, unsigned v) { return __hip_atomic_fetch_add(p, v, __ATOMIC_RELAXED, __HIP_MEMORY_SCOPE_AGENT); }
__device__ __forceinline__ unsigned xb_xcc_id() { return (unsigned)__builtin_amdgcn_s_getreg((3 << 11) | 20) & 0xFu; }
#define XB_SPIN(cond, bar) do { unsigned _sp = 0; while (cond) { __builtin_amdgcn_s_sleep(1); \
    if ((++_sp & 255u) == 0u) { if (xb_ld(&(bar)[XB_TMO])) break; if (_sp > XB_SPIN_CAP) { atomicAdd(&(bar)[XB_TMO], 1u); break; } } } } while (0)

struct XcdBarrier {
    unsigned* bar; unsigned x;
    volatile LAS unsigned* st;
};

__device__ __forceinline__ XcdBarrier xcd_barrier_post(unsigned* bar, volatile LAS unsigned* st) {
    XcdBarrier b; b.bar = bar; b.x = xb_xcc_id(); b.st = st;
    if (threadIdx.x == 0) (void)xb_add(&bar[XB_XCNT(b.x)], 1u);
    return b;
}
__device__ __forceinline__ void xcd_barrier_complete(unsigned* bar, unsigned x, unsigned& nloc, unsigned& nx) {
    const unsigned G = gridDim.x * gridDim.y * gridDim.z;
    unsigned sum, cnt, mine, sp = 0u;
    for (;;) {
        sum = 0u; cnt = 0u; mine = 0u;
#pragma unroll
        for (unsigned j = 0; j < 16; ++j) { const unsigned c = xb_ld(&bar[XB_XCNT(j)]); sum += c; cnt += (c > 0u) ? 1u : 0u; mine = (j == x) ? c : mine; }
        if (sum == G) break;
        __builtin_amdgcn_s_sleep(1);
        if ((++sp & 255u) == 0u) { if (xb_ld(&bar[XB_TMO])) break; if (sp > XB_SPIN_CAP) { atomicAdd(&bar[XB_TMO], 1u); break; } }
    }
    nloc = mine > 0u ? mine : 1u; nx = cnt > 0u ? cnt : 1u;
}

__device__ __forceinline__ void xcd_barrier(const XcdBarrier& b) {
    asm volatile("s_waitcnt vmcnt(0)" ::: "memory");
    __syncthreads();
    if (threadIdx.x == 0) {
        unsigned* bar = b.bar;
        __builtin_amdgcn_s_waitcnt(0);
        unsigned nloc = b.st[0], nx = b.st[1];
        if (nloc == 0u) { xcd_barrier_complete(bar, b.x, nloc, nx); b.st[0] = nloc; b.st[1] = nx; }
        const unsigned old = xb_add(&bar[XB_XSUB(b.x)], 1u);
        const unsigned gen = old / nloc;
        if (old + 1u == (gen + 1u) * nloc) {
            __builtin_amdgcn_fence(__ATOMIC_RELEASE, "agent");
            asm volatile("s_waitcnt vmcnt(0)" ::: "memory");
            const unsigned og = xb_add(&bar[XB_TOP], 1u);
            const unsigned tg = og / nx;
            if (og + 1u == (tg + 1u) * nx) xb_add(&bar[XB_TOPGEN], 1u);
            else XB_SPIN(xb_ld(&bar[XB_TOPGEN]) == tg, bar);
            __builtin_amdgcn_fence(__ATOMIC_ACQUIRE, "agent");
            xb_add(&bar[XB_XGEN(b.x)], 1u);
            asm volatile("s_waitcnt vmcnt(0)" ::: "memory");
        } else {
            XB_SPIN(xb_ld(&bar[XB_XGEN(b.x)]) == gen, bar);
            __builtin_amdgcn_fence(__ATOMIC_ACQUIRE, "agent");
            asm volatile("s_waitcnt vmcnt(0)" ::: "memory");
        }
    }
    __syncthreads();
}

struct Params {
    const float *x, *p; const int* pos;
    const float *mix_norm, *w_in, *gla_wg, *gla_bg, *gla_on, *q_norm, *w_uq, *kv_norm, *w_ukv, *qkq, *qkk, *pool_w, *pool_s, *w_out, *ffn_norm, *router_w, *router_b,
        *moe_wg, *moe_bg, *moe_wu, *moe_bu, *moe_wd, *moe_bd, *ple_wp, *ple_gn, *ple_wg, *ple_pn;
    float* out; char* ws;
};


constexpr int NTHR = 512, NWV = 8;
__device__ __forceinline__ int opaque_tid() { int t = threadIdx.x; asm volatile("" : "+v"(t)); return t; }
constexpr int LDS_BYTES = 147456;
constexpr int LDS_BAR_OFF = LDS_BYTES - 16;

__device__ __forceinline__ void ph_tconv(const float* src, const float* src2, const float* gain, bf16_t* dst, int N, int K, int ld_src, int mode, int nexp, long se, long de, unsigned char* lds) {
    const int tz = opaque_tid(); const int tid = tz & 255, half = tz >> 8, tx = tid & 63, ty = tid >> 6;
    float (*tile)[65] = (float (*)[65])(lds + half * 16640);
    const int nx = N / 64, ny = K / 64, nunits = nx * ny * nexp;
    for (int u0 = blockIdx.x * 2; u0 < nunits; u0 += gridDim.x * 2) {
        const int u = u0 + half; const int bx = u % nx, by = (u / nx) % ny, e = u / (nx * ny);
        const float* s1 = src + (long)e * se; const float* s2 = src2 ? src2 + (long)e * se : nullptr; bf16_t* d = dst + (long)e * de;
        const int n0 = bx * 64, k0 = by * 64, n = n0 + tx;
        const float* sp = s1; int col;
        if (mode == 0) col = n;
        else if (mode == 1) col = zsrc(n);
        else { const int tl = n >> 8, w = n & 255; if (w < 128) col = tl * 128 + w; else { col = tl * 128 + (w - 128); sp = s2; } }
#pragma unroll
        for (int i = 0; i < 16; ++i) {
            const int k = k0 + ty + 4 * i; float v = 0.f;
            if (col >= 0) v = sp[(long)k * ld_src + col];
            if (gain) v *= gain[k];
            tile[ty + 4 * i][tx] = v;
        }
        __syncthreads();
        const int nl = tid >> 2, ks = (tid & 3) * 16;
        unsigned w0 = pack2(tile[ks + 0][nl], tile[ks + 1][nl]), w1 = pack2(tile[ks + 2][nl], tile[ks + 3][nl]), w2 = pack2(tile[ks + 4][nl], tile[ks + 5][nl]), w3 = pack2(tile[ks + 6][nl], tile[ks + 7][nl]);
        unsigned w4 = pack2(tile[ks + 8][nl], tile[ks + 9][nl]), w5 = pack2(tile[ks + 10][nl], tile[ks + 11][nl]), w6 = pack2(tile[ks + 12][nl], tile[ks + 13][nl]), w7 = pack2(tile[ks + 14][nl], tile[ks + 15][nl]);
        uint4* o = (uint4*)(d + (long)(n0 + nl) * K + k0 + ks);
        o[0] = make_uint4(w0, w1, w2, w3); o[1] = make_uint4(w4, w5, w6, w7);
        __syncthreads();
    }
}
__device__ __forceinline__ void ph_conv_bf16(const float* src, bf16_t* dst, long n8) {
    const int tz = opaque_tid();
    for (long i = (long)blockIdx.x * NTHR + tz; i < n8; i += (long)gridDim.x * NTHR) {
        const float4 a = ((const float4*)src)[2 * i], b = ((const float4*)src)[2 * i + 1];
        ((uint4*)dst)[i] = make_uint4(pack2(a.x, a.y), pack2(a.z, a.w), pack2(b.x, b.y), pack2(b.z, b.w));
    }
}
__device__ __forceinline__ void ph_prep_router(const Params& P) {
    const int tz = opaque_tid();
    for (int i = blockIdx.x * NTHR + tz; i < 2 * 32 * 1024; i += gridDim.x * NTHR) {
        const int l = i >> 15, e = (i >> 10) & 31, k = i & 1023;
        float* Wr = (float*)(P.ws + WS_WSM + (size_t)l * WSM_STRIDE + WSM_WR);
        Wr[e * 1024 + k] = P.router_w[((size_t)l * 1024 + k) * 32 + e] * P.ffn_norm[l * 1024 + k];
    }
}

__device__ __forceinline__ void ph_init_h(const Params& P) {
    const int tz = opaque_tid(); const int wid = tz >> 6, lane = tz & 63;
    bf16_t* HB = (bf16_t*)(P.ws + WS_HB); float* RS = (float*)(P.ws + WS_RSTD);
    for (int t = blockIdx.x * NWV + wid; t < T; t += gridDim.x * NWV) {
        const float* hr = P.x + (size_t)t * 1024;
        float ss = 0.f; float4 v[4];
#pragma unroll
        for (int i = 0; i < 4; ++i) { v[i] = *(const float4*)(hr + i * 256 + lane * 4); ss += v[i].x * v[i].x + v[i].y * v[i].y + v[i].z * v[i].z + v[i].w * v[i].w; }
        ss = wave_sum(ss);
        if (lane == 0) RS[t] = rsqrtf(ss * (1.0f / 1024.0f) + EPS);
#pragma unroll
        for (int i = 0; i < 4; ++i) *(uint2*)(HB + (size_t)t * 1024 + i * 256 + lane * 4) = make_uint2(pack2(v[i].x, v[i].y), pack2(v[i].z, v[i].w));
    }
}

__device__ __forceinline__ void ph_prepB(const Params& P, int layer, unsigned char* lds) {
    float* pw = (float*)lds;
    float* wg = (float*)(lds + 65536);
    const int tid = opaque_tid(), wid = tid >> 6, lane = tid & 63;
    for (int i = tid; i < 4 * 64 * 64; i += NTHR) pw[i] = P.pool_w[(size_t)layer * 16384 + i];
    for (int i = tid; i < 16 * 128; i += NTHR) wg[i] = P.gla_wg[(size_t)layer * 2048 + i];
    __syncthreads();
    bf16_t* Z = (bf16_t*)(P.ws + WS_BIG + BIG_Z); float* LA = (float*)(P.ws + WS_BIG + BIG_LA); bf16_t* YM = (bf16_t*)(P.ws + WS_YMIX);
    const float* bg = P.gla_bg + layer * 128; const float* psc = P.pool_s + layer * 256;
    for (int t = blockIdx.x * NWV + wid; t < T; t += gridDim.x * NWV) {
        bf16_t* zr = Z + (size_t)t * ZW;
        {
            const uint2 raw = *(const uint2*)(zr + ZC_CQ + lane * 4);
            const float a = bf2f(raw.x & 0xffff), b = bf2f(raw.x >> 16), c = bf2f(raw.y & 0xffff), d = bf2f(raw.y >> 16);
            const float ss = wave_sum(a * a + b * b + c * c + d * d);
            const float r = rsqrtf(ss * (1.0f / 256.0f) + EPS);
            *(uint2*)(zr + ZC_CQ + lane * 4) = make_uint2(pack2(a * r, b * r), pack2(c * r, d * r));
        }
        {
            const unsigned raw = *(const unsigned*)(zr + ZC_CKV + lane * 2);
            const float a = bf2f(raw & 0xffff), b = bf2f(raw >> 16);
            const float ss = wave_sum(a * a + b * b);
            const float r = rsqrtf(ss * (1.0f / 128.0f) + EPS);
            *(unsigned*)(zr + ZC_CKV + lane * 2) = pack2(a * r, b * r);
        }
        {
            float gl = (lane < 16) ? bf2f(zr[ZC_GLOW + lane]) : 0.f;
            float l0 = bg[lane], l1 = bg[lane + 64];
#pragma unroll
            for (int r = 0; r < 16; ++r) { const float g = __shfl(gl, r); l0 += g * wg[r * 128 + lane]; l1 += g * wg[r * 128 + lane + 64]; }
            const float a0 = fminf(l0, 0.f) - log1pf(__expf(-fabsf(l0))), a1 = fminf(l1, 0.f) - log1pf(__expf(-fabsf(l1)));
            LA[(size_t)t * 128 + lane] = a0 * (1.0f / 16.0f); LA[(size_t)t * 128 + lane + 64] = a1 * (1.0f / 16.0f);
        }
        {
            const int s = t & (SEQ - 1);
#pragma unroll
            for (int gi = 0; gi < 4; ++gi) {
                const int w = 2 << gi; const int cnt = (s + 1 < w) ? s + 1 : w;
                const float u0 = bf2f(zr[ZC_UP + gi * 64 + lane]);
                float acc = u0;
                for (int j = 1; j < cnt; ++j) acc += bf2f(zr[(long)ZC_UP + gi * 64 + lane - (long)j * ZW]);
                const float dv = acc / (float)cnt - u0;
                float y = 0.f;
#pragma unroll 8
                for (int c = 0; c < 64; ++c) y += __shfl(dv, c) * pw[(gi * 64 + c) * 64 + lane];
                YM[(size_t)t * 1024 + 768 + gi * 64 + lane] = f2bf(y * psc[gi * 64 + lane]);
            }
        }
    }
}

__device__ __forceinline__ void ph_prepD(const Params& P, int layer) {
    const int tid = opaque_tid(), wid = tid >> 6, lane = tid & 63;
    bf16_t* Z = (bf16_t*)(P.ws + WS_BIG + BIG_Z); bf16_t* Q = (bf16_t*)(P.ws + WS_BIG + BIG_Q); const bf16_t* KV = (const bf16_t*)(P.ws + WS_BIG + BIG_KV); bf16_t* Kd = (bf16_t*)(P.ws + WS_BIG + BIG_K);
    const float* gq = P.qkq + layer * 96; const float* gk = P.qkk + layer * 96;
    const int i16 = lane & 15;
    const float inv = exp2f(-(float)(2 * i16) * (1.0f / 32.0f) * 13.287712379549449f);
    const float qscale = 0.10206207261596577f;
    for (int th = blockIdx.x * NWV + wid; th < T * 8; th += gridDim.x * NWV) {
        const int t = th >> 3, h = th & 7;
        const float ang = (float)P.pos[t] * inv; const float cs = cosf(ang), sn = sinf(ang);
        {
            bf16_t* qp = Q + (size_t)t * 768 + h * 96;
            const float a = bf2f(qp[lane]); const float b = (lane < 32) ? bf2f(qp[64 + lane]) : 0.f;
            const float ss = wave_sum(a * a + b * b);
            const float r = rsqrtf(ss * (1.0f / 96.0f) + EPS);
            const float an = a * r * gq[lane]; const float bn = (lane < 32) ? b * r * gq[64 + lane] : 0.f;
            const float partner = __shfl_xor(bn, 16);
            const float rot = (lane < 16) ? (bn * cs - partner * sn) : (bn * cs + partner * sn);
            qp[lane] = f2bf(an * qscale);
            if (lane < 32) qp[64 + lane] = f2bf(rot * qscale);
        }
        {
            const float a = bf2f(KV[(size_t)t * 1024 + h * 128 + lane]); const float b = (lane < 32) ? bf2f(Z[(size_t)t * ZW + ZC_KR + lane]) : 0.f;
            const float ss = wave_sum(a * a + b * b);
            const float r = rsqrtf(ss * (1.0f / 96.0f) + EPS);
            const float an = a * r * gk[lane]; const float bn = (lane < 32) ? b * r * gk[64 + lane] : 0.f;
            const float partner = __shfl_xor(bn, 16);
            const float rot = (lane < 16) ? (bn * cs - partner * sn) : (bn * cs + partner * sn);
            bf16_t* kp = Kd + ((size_t)t * 8 + h) * 96;
            kp[lane] = f2bf(an);
            if (lane < 32) kp[64 + lane] = f2bf(rot);
        }
    }
}

__device__ __forceinline__ void ph_router(const Params& P, int layer) {
    const int tid = opaque_tid(), wid = tid >> 6, lane = tid & 63;
    bf16_t* HB = (bf16_t*)(P.ws + WS_HB); float* RS1 = (float*)(P.ws + WS_RSTD) + T;
    const float* Wr = (const float*)(P.ws + WS_WSM + (size_t)layer * WSM_STRIDE + WSM_WR);
    const float* rb = P.router_b + layer * 32;
    unsigned* cnt = (unsigned*)(P.ws + WS_CTL) + CTL_CNT + layer * 32;
    int* LIST = (int*)(P.ws + WS_LIST); float* TOPG = (float*)(P.ws + WS_TOPG);
    for (int t = blockIdx.x * NWV + wid; t < T; t += gridDim.x * NWV) {
        const float* hr = P.out + (size_t)t * 1024;
        float4 v[4]; float ss = 0.f;
#pragma unroll
        for (int i = 0; i < 4; ++i) { v[i] = *(const float4*)(hr + i * 256 + lane * 4); ss += v[i].x * v[i].x + v[i].y * v[i].y + v[i].z * v[i].z + v[i].w * v[i].w; }
        ss = wave_sum(ss);
        const float rstd = rsqrtf(ss * (1.0f / 1024.0f) + EPS);
        if (lane == 0) RS1[t] = rstd;
#pragma unroll
        for (int i = 0; i < 4; ++i) *(uint2*)(HB + (size_t)t * 1024 + i * 256 + lane * 4) = make_uint2(pack2(v[i].x, v[i].y), pack2(v[i].z, v[i].w));
        float mylg = -INFINITY;
#pragma unroll 4
        for (int e = 0; e < 32; ++e) {
            float s = 0.f;
#pragma unroll
            for (int i = 0; i < 4; ++i) { const float4 w = *(const float4*)(Wr + e * 1024 + i * 256 + lane * 4); s += v[i].x * w.x + v[i].y * w.y + v[i].z * w.z + v[i].w * w.w; }
            const float tot = wave_sum(s) * rstd + rb[e];
            mylg = (lane == e) ? tot : mylg;
        }
        float tv[4]; int ti[4];
#pragma unroll
        for (int k = 0; k < 4; ++k) {
            const float best = wave_max(mylg);
            const unsigned long long mask = __ballot(mylg == best);
            const int bi = __ffsll((long long)mask) - 1;
            tv[k] = best; ti[k] = bi;
            mylg = (lane == bi) ? -INFINITY : mylg;
        }
        const float e1 = __expf(tv[1] - tv[0]), e2 = __expf(tv[2] - tv[0]), e3 = __expf(tv[3] - tv[0]);
        const float invs = 1.0f / (1.0f + e1 + e2 + e3);
        if (lane < 4) {
            const int e = (lane == 0) ? ti[0] : (lane == 1) ? ti[1] : (lane == 2) ? ti[2] : ti[3];
            const float g = (lane == 0) ? invs : (lane == 1) ? e1 * invs : (lane == 2) ? e2 * invs : e3 * invs;
            const unsigned pos = atomicAdd(&cnt[e], 1u);
            LIST[(size_t)e * T + pos] = t * 4 + lane;
            TOPG[t * 4 + lane] = g;
        }
    }
}

__device__ __forceinline__ void ph_combine(const Params& P) {
    const int tid = opaque_tid(), wid = tid >> 6, lane = tid & 63;
    bf16_t* HB = (bf16_t*)(P.ws + WS_HB); float* RS2 = (float*)(P.ws + WS_RSTD) + 2 * T; const bf16_t* Y = (const bf16_t*)(P.ws + WS_Y);
    for (int t = blockIdx.x * NWV + wid; t < T; t += gridDim.x * NWV) {
        float* hr = P.out + (size_t)t * 1024; float ss = 0.f;
#pragma unroll
        for (int i = 0; i < 4; ++i) {
            float4 v = *(const float4*)(hr + i * 256 + lane * 4);
#pragma unroll
            for (int k = 0; k < 4; ++k) {
                const uint2 y = *(const uint2*)(Y + ((size_t)t * 4 + k) * 1024 + i * 256 + lane * 4);
                v.x += bf2f(y.x & 0xffff); v.y += bf2f(y.x >> 16); v.z += bf2f(y.y & 0xffff); v.w += bf2f(y.y >> 16);
            }
            *(float4*)(hr + i * 256 + lane * 4) = v;
            ss += v.x * v.x + v.y * v.y + v.z * v.z + v.w * v.w;
            *(uint2*)(HB + (size_t)t * 1024 + i * 256 + lane * 4) = make_uint2(pack2(v.x, v.y), pack2(v.z, v.w));
        }
        ss = wave_sum(ss);
        if (lane == 0) RS2[t] = rsqrtf(ss * (1.0f / 1024.0f) + EPS);
    }
}

__device__ __forceinline__ void ph_final(const Params& P, int layer) {
    const int tid = opaque_tid(), wid = tid >> 6, lane = tid & 63;
    bf16_t* HB = (bf16_t*)(P.ws + WS_HB); float* RS = (float*)(P.ws + WS_RSTD); const bf16_t* V = (const bf16_t*)(P.ws + WS_YMIX);
    const float* gp = P.ple_pn + layer * 1024;
    for (int t = blockIdx.x * NWV + wid; t < T; t += gridDim.x * NWV) {
        float* hr = P.out + (size_t)t * 1024; float vv[16]; float ss = 0.f;
#pragma unroll
        for (int i = 0; i < 4; ++i) {
            const uint2 y = *(const uint2*)(V + (size_t)t * 1024 + i * 256 + lane * 4);
            vv[4 * i] = bf2f(y.x & 0xffff); vv[4 * i + 1] = bf2f(y.x >> 16); vv[4 * i + 2] = bf2f(y.y & 0xffff); vv[4 * i + 3] = bf2f(y.y >> 16);
            ss += vv[4 * i] * vv[4 * i] + vv[4 * i + 1] * vv[4 * i + 1] + vv[4 * i + 2] * vv[4 * i + 2] + vv[4 * i + 3] * vv[4 * i + 3];
        }
        ss = wave_sum(ss);
        const float r = rsqrtf(ss * (1.0f / 1024.0f) + EPS);
        float s2 = 0.f;
#pragma unroll
        for (int i = 0; i < 4; ++i) {
            float4 v = *(const float4*)(hr + i * 256 + lane * 4); const float4 g = *(const float4*)(gp + i * 256 + lane * 4);
            v.x += vv[4 * i] * r * g.x; v.y += vv[4 * i + 1] * r * g.y; v.z += vv[4 * i + 2] * r * g.z; v.w += vv[4 * i + 3] * r * g.w;
            *(float4*)(hr + i * 256 + lane * 4) = v;
            s2 += v.x * v.x + v.y * v.y + v.z * v.z + v.w * v.w;
            *(uint2*)(HB + (size_t)t * 1024 + i * 256 + lane * 4) = make_uint2(pack2(v.x, v.y), pack2(v.z, v.w));
        }
        s2 = wave_sum(s2);
        if (lane == 0) RS[t] = rsqrtf(s2 * (1.0f / 1024.0f) + EPS);
    }
}

struct EpiZ { bf16_t* Z; const float* rstd;
    __device__ __forceinline__ void operator()(int r, int c, f32x4 v) const { const float s = rstd[r]; *(uint2*)(Z + (size_t)r * ZW + c) = make_uint2(pack2(v[0] * s, v[1] * s), pack2(v[2] * s, v[3] * s)); } };
struct EpiBf16 { bf16_t* O; int ldo;
    __device__ __forceinline__ void operator()(int r, int c, f32x4 v) const { *(uint2*)(O + (size_t)r * ldo + c) = make_uint2(pack2(v[0], v[1]), pack2(v[2], v[3])); } };
struct EpiResid { const float* hin; float* out;
    __device__ __forceinline__ void operator()(int r, int c, f32x4 v) const { const f32x4 b = *(const f32x4*)(hin + (size_t)r * 1024 + c); *(f32x4*)(out + (size_t)r * 1024 + c) = b + v; } };
struct EpiMoe1 { const int* list; const float* rstd1; const float* bg; const float* bu; bf16_t* H;
    __device__ __forceinline__ void operator()(int r, int hc, f32x4 g, f32x4 u) const {
        const float s = rstd1[list[r] >> 2]; const f32x4 b0 = *(const f32x4*)(bg + hc), b1 = *(const f32x4*)(bu + hc); float o[4];
#pragma unroll
        for (int j = 0; j < 4; ++j) { const float gg = fminf(g[j] * s + b0[j], 7.0f); const float uu = fminf(fmaxf(u[j] * s + b1[j], -7.0f), 7.0f); o[j] = (uu + 1.0f) * gg * sigmoidf_(1.702f * gg); }
        *(uint2*)(H + (size_t)r * 1024 + hc) = make_uint2(pack2(o[0], o[1]), pack2(o[2], o[3])); } };
struct EpiMoe2 { const int* list; const float* topg; const float* bd; bf16_t* Y;
    __device__ __forceinline__ void operator()(int r, int c, f32x4 v) const { const int ts = list[r]; const float g = topg[ts]; const f32x4 b = *(const f32x4*)(bd + c);
        *(uint2*)(Y + (size_t)ts * 1024 + c) = make_uint2(pack2((v[0] + b[0]) * g, (v[1] + b[1]) * g), pack2((v[2] + b[2]) * g, (v[3] + b[3]) * g)); } };
struct EpiPle { const bf16_t* E; const float* rstd2; bf16_t* V;
    __device__ __forceinline__ void operator()(int r, int c, f32x4 v) const { const float s = rstd2[r]; const uint2 e = *(const uint2*)(E + (size_t)r * 1024 + c);
        const float o0 = bf2f(e.x & 0xffff) * sigmoidf_(v[0] * s), o1 = bf2f(e.x >> 16) * sigmoidf_(v[1] * s), o2 = bf2f(e.y & 0xffff) * sigmoidf_(v[2] * s), o3 = bf2f(e.y >> 16) * sigmoidf_(v[3] * s);
        *(uint2*)(V + (size_t)r * 1024 + c) = make_uint2(pack2(o0, o1), pack2(o2, o3)); } };

template <class Epi, bool PAIR>
__device__ __forceinline__ void gemm_simple_unit(const bf16_t* A, int lda, const int* rowidx, const bf16_t* Bt, int ldb, int M, int K, int mblk, int nblk, const Epi& epi) {
    const int tid = opaque_tid(), wid = tid >> 6, lane = tid & 63, wr = wid >> 1, wc = wid & 1, fr = lane & 15, fq = lane >> 4;
    const int m0 = mblk * 256 + wr * 64;
    if (m0 >= M) return;
    const bf16_t* ap[4]; const bf16_t* bp[4];
#pragma unroll
    for (int mi = 0; mi < 4; ++mi) { int r = m0 + mi * 16 + fr; if (r >= M) r = M - 1; const long ar = rowidx ? (long)(rowidx[r] >> 2) : (long)r; ap[mi] = A + ar * lda + fq * 8; }
#pragma unroll
    for (int ni = 0; ni < 4; ++ni) {
        int br;
        if (PAIR) { const int hc = nblk * 64 + wc * 32 + (ni & 1) * 16 + fr; br = (hc >> 7) * 256 + (hc & 127) + ((ni >> 1) ? 128 : 0); }
        else br = nblk * 128 + wc * 64 + ni * 16 + fr;
        bp[ni] = Bt + (long)br * ldb + fq * 8;
    }
    f32x4 acc[4][4];
#pragma unroll
    for (int mi = 0; mi < 4; ++mi)
#pragma unroll
        for (int ni = 0; ni < 4; ++ni) acc[mi][ni] = (f32x4){0.f, 0.f, 0.f, 0.f};
    for (int k0 = 0; k0 < K; k0 += 32) {
        bf16x8 a[4], b[4];
#pragma unroll
        for (int i = 0; i < 4; ++i) { a[i] = *(const bf16x8*)(ap[i] + k0); b[i] = *(const bf16x8*)(bp[i] + k0); }
#pragma unroll
        for (int mi = 0; mi < 4; ++mi)
#pragma unroll
            for (int ni = 0; ni < 4; ++ni) acc[mi][ni] = __builtin_amdgcn_mfma_f32_16x16x32_bf16(b[ni], a[mi], acc[mi][ni], 0, 0, 0);
    }
#pragma unroll
    for (int mi = 0; mi < 4; ++mi) {
        const int r = m0 + mi * 16 + fr;
        if (r < M) {
            if constexpr (PAIR) {
#pragma unroll
                for (int ni = 0; ni < 2; ++ni) epi(r, nblk * 64 + wc * 32 + ni * 16 + fq * 4, acc[mi][ni], acc[mi][ni + 2]);
            } else {
#pragma unroll
                for (int ni = 0; ni < 4; ++ni) epi(r, nblk * 128 + wc * 64 + ni * 16 + fq * 4, acc[mi][ni]);
            }
        }
    }
}
template <class Epi>
__device__ __forceinline__ void ph_gemm_dense(const bf16_t* A, int lda, const bf16_t* Bt, int N, int K, const Epi& epi) {
    const int ncol = N / 128, nunits = (T / 256) * ncol;
    for (int u = blockIdx.x; u < nunits; u += gridDim.x) gemm_simple_unit<Epi, false>(A, lda, nullptr, Bt, K, T, K, u / ncol, u % ncol, epi);
}
__device__ __forceinline__ bool moe_decode(const unsigned* cnt, int ncol, int u, int& e, int& mblk, int& nblk, int& rowoff) {
    int acc = 0, off = 0;
    for (int i = 0; i < 32; ++i) {
        const int tl = ((int)cnt[i] + 255) >> 8;
        if (u < (acc + tl) * ncol) { e = i; const int local = u - acc * ncol; mblk = local / ncol; nblk = local % ncol; rowoff = off; return true; }
        acc += tl; off += tl * 256;
    }
    return false;
}
__device__ __forceinline__ void ph_moe1(const Params& P, int layer) {
    char* ws = P.ws; const unsigned* cnt = (const unsigned*)(ws + WS_CTL) + CTL_CNT + layer * 32;
    for (int u = blockIdx.x;; u += gridDim.x) {
        int e, mblk, nblk, off; if (!moe_decode(cnt, 16, u, e, mblk, nblk, off)) break;
        const int* list = (const int*)(ws + WS_LIST) + (size_t)e * T;
        EpiMoe1 ep{list, (const float*)(ws + WS_RSTD) + T, P.moe_bg + ((size_t)layer * 32 + e) * 1024, P.moe_bu + ((size_t)layer * 32 + e) * 1024, (bf16_t*)(ws + WS_BIG) + (size_t)off * 1024};
        gemm_simple_unit<EpiMoe1, true>((const bf16_t*)(ws + WS_HB), 1024, list, (const bf16_t*)(ws + WS_W1) + (size_t)e * 2048 * 1024, 1024, (int)cnt[e], 1024, mblk, nblk, ep);
    }
}
__device__ __forceinline__ void ph_moe2(const Params& P, int layer) {
    char* ws = P.ws; const unsigned* cnt = (const unsigned*)(ws + WS_CTL) + CTL_CNT + layer * 32;
    for (int u = blockIdx.x;; u += gridDim.x) {
        int e, mblk, nblk, off; if (!moe_decode(cnt, 8, u, e, mblk, nblk, off)) break;
        const int* list = (const int*)(ws + WS_LIST) + (size_t)e * T;
        EpiMoe2 ep{list, (const float*)(ws + WS_TOPG), P.moe_bd + ((size_t)layer * 32 + e) * 1024, (bf16_t*)(ws + WS_Y)};
        gemm_simple_unit<EpiMoe2, false>((const bf16_t*)(ws + WS_BIG) + (size_t)off * 1024, 1024, nullptr, (const bf16_t*)(ws + WS_W2) + (size_t)e * 1024 * 1024, 1024, (int)cnt[e], 1024, mblk, nblk, ep);
    }
}

__device__ __forceinline__ void ph_attn_simple(const Params& P, unsigned char* lds) {
    float (*qs)[96] = (float (*)[96])lds; float (*ps)[64] = (float (*)[64])(lds + 8 * 96 * 4);
    const int tid = opaque_tid(), wid = tid >> 6, lane = tid & 63;
    const bf16_t* Q = (const bf16_t*)(P.ws + WS_BIG + BIG_Q); const bf16_t* Kd = (const bf16_t*)(P.ws + WS_BIG + BIG_K); const bf16_t* KV = (const bf16_t*)(P.ws + WS_BIG + BIG_KV);
    bf16_t* YM = (bf16_t*)(P.ws + WS_YMIX);
    for (int u = blockIdx.x; u < T; u += gridDim.x) {
        const long gw = (long)u * 8 + wid;
        const int s = (int)(gw & 4095), bh = (int)(gw >> 12), b = bh >> 3, h = bh & 7;
        const long t = (long)b * SEQ + s;
        __syncthreads();
        qs[wid][lane] = bf2f(Q[t * 768 + h * 96 + lane]);
        if (lane < 32) qs[wid][64 + lane] = bf2f(Q[t * 768 + h * 96 + 64 + lane]);
        __syncthreads();
        float m = -INFINITY, l = 0.f, o = 0.f;
        for (int j0 = 0; j0 <= s; j0 += 64) {
            const int j = j0 + lane; const bool valid = j <= s;
            const long kt = (long)b * SEQ + (valid ? j : s);
            const uint4* kr = (const uint4*)(Kd + (kt * 8 + h) * 96);
            float sc = 0.f;
#pragma unroll
            for (int c = 0; c < 12; ++c) {
                const uint4 kk = kr[c];
                sc += qs[wid][c * 8 + 0] * bf2f(kk.x & 0xffff) + qs[wid][c * 8 + 1] * bf2f(kk.x >> 16) + qs[wid][c * 8 + 2] * bf2f(kk.y & 0xffff) + qs[wid][c * 8 + 3] * bf2f(kk.y >> 16)
                    + qs[wid][c * 8 + 4] * bf2f(kk.z & 0xffff) + qs[wid][c * 8 + 5] * bf2f(kk.z >> 16) + qs[wid][c * 8 + 6] * bf2f(kk.w & 0xffff) + qs[wid][c * 8 + 7] * bf2f(kk.w >> 16);
            }
            sc = valid ? sc : -INFINITY;
            const float mn = fmaxf(m, wave_max(sc));
            const float pj = valid ? __expf(sc - mn) : 0.f;
            const float f = __expf(m - mn);
            l = l * f + wave_sum(pj); o *= f; m = mn;
            __syncthreads();
            ps[wid][lane] = pj;
            __syncthreads();
            const bf16_t* vb = KV + ((long)b * SEQ + j0) * 1024 + h * 128 + 64 + lane;
#pragma unroll 8
            for (int jj = 0; jj < 64; ++jj) o += ps[wid][jj] * bf2f(vb[(long)jj * 1024]);
        }
        YM[t * 1024 + 256 + h * 64 + lane] = f2bf(o / l);
    }
}

__device__ __forceinline__ void ph_gla_simple(const Params& P, int layer, unsigned char* lds) {
    if (blockIdx.x >= 4) return;
    const int tz = opaque_tid(); const int wid = tz >> 6, lane = tz & 63;
    float (*sq)[32] = (float (*)[32])(lds + wid * 3072), (*sk)[32] = (float (*)[32])(lds + wid * 3072 + 1024), (*sa)[32] = (float (*)[32])(lds + wid * 3072 + 2048);
    const int bh = blockIdx.x * 8 + wid, b = bh >> 2, h = bh & 3;
    const bf16_t* Z = (const bf16_t*)(P.ws + WS_BIG + BIG_Z); const float* LA = (const float*)(P.ws + WS_BIG + BIG_LA); bf16_t* YM = (bf16_t*)(P.ws + WS_YMIX);
    const float g = P.gla_on[layer * 64 + lane];
    float st[32];
#pragma unroll
    for (int k = 0; k < 32; ++k) st[k] = 0.f;
    for (int c0 = 0; c0 < SEQ; c0 += 8) {
#pragma unroll
        for (int i = 0; i < 4; ++i) {
            const int idx = lane + 64 * i, sp = idx >> 5, k = idx & 31; const size_t t = (size_t)b * SEQ + c0 + sp;
            sq[sp][k] = bf2f(Z[t * ZW + ZC_GQ + h * 32 + k]) * 0.17677669529663687f;
            sk[sp][k] = bf2f(Z[t * ZW + ZC_GK + h * 32 + k]);
            sa[sp][k] = __expf(LA[t * 128 + h * 32 + k]);
        }
        float v[8], r[8];
#pragma unroll
        for (int sp = 0; sp < 8; ++sp) { const size_t t = (size_t)b * SEQ + c0 + sp; v[sp] = bf2f(Z[t * ZW + ZC_GV + h * 64 + lane]); r[sp] = bf2f(Z[t * ZW + ZC_GR + h * 64 + lane]); }
        __syncthreads();
#pragma unroll
        for (int sp = 0; sp < 8; ++sp) {
            float o = 0.f;
#pragma unroll
            for (int k = 0; k < 32; ++k) { st[k] = sa[sp][k] * st[k] + sk[sp][k] * v[sp]; o += sq[sp][k] * st[k]; }
            const float ss = wave_sum(o * o);
            const float on = o * rsqrtf(ss * (1.0f / 64.0f) + EPS) * g;
            const float rr = r[sp];
            YM[((size_t)b * SEQ + c0 + sp) * 1024 + h * 64 + lane] = f2bf(on * rr * sigmoidf_(rr));
        }
        __syncthreads();
    }
}

template <int L> __device__ __forceinline__ void layer_body(const Params& P, const XcdBarrier& bar, unsigned char* lds) {
    constexpr int l = L; char* ws = P.ws;
    const bf16_t* HB = (const bf16_t*)(ws + WS_HB); const float* RS = (const float*)(ws + WS_RSTD);
    bf16_t* Z = (bf16_t*)(ws + WS_BIG + BIG_Z);
    {
        const char* wsm = ws + WS_WSM + (size_t)l * WSM_STRIDE;
        ph_tconv(P.moe_wg + (size_t)l * 32 * 1024 * 1024, P.moe_wu + (size_t)l * 32 * 1024 * 1024, P.ffn_norm + l * 1024, (bf16_t*)(ws + WS_W1), 2048, 1024, 1024, 2, 32, 1024L * 1024, 2048L * 1024, lds);
        ph_tconv(P.moe_wd + (size_t)l * 32 * 1024 * 1024, nullptr, nullptr, (bf16_t*)(ws + WS_W2), 1024, 1024, 1024, 0, 32, 1024L * 1024, 1024L * 1024, lds);
        { EpiBf16 e{(bf16_t*)(ws + WS_E), 1024}; ph_gemm_dense((const bf16_t*)(ws + WS_PB) + (size_t)l * T * 256, 256, (const bf16_t*)(wsm + WSM_WPLE), 1024, 256, e); }
        { EpiZ e{Z, RS}; ph_gemm_dense(HB, 1024, (const bf16_t*)(wsm + WSM_WIN), ZW, 1024, e); }
        xcd_barrier(bar);
        ph_prepB(P, l, lds);
        xcd_barrier(bar);
        { EpiBf16 e{(bf16_t*)(ws + WS_BIG + BIG_Q), 768}; ph_gemm_dense(Z + ZC_CQ, ZW, (const bf16_t*)(wsm + WSM_WUQ), 768, 256, e); }
        { EpiBf16 e{(bf16_t*)(ws + WS_BIG + BIG_KV), 1024}; ph_gemm_dense(Z + ZC_CKV, ZW, (const bf16_t*)(wsm + WSM_WUKV), 1024, 128, e); }
        xcd_barrier(bar);
        ph_prepD(P, l);
        xcd_barrier(bar);
        ph_gla_simple(P, l, lds);
        ph_attn_simple(P, lds);
        xcd_barrier(bar);
        { EpiResid e{l == 0 ? P.x : P.out, P.out}; ph_gemm_dense((const bf16_t*)(ws + WS_YMIX), 1024, (const bf16_t*)(wsm + WSM_WOUT), 1024, 1024, e); }
        xcd_barrier(bar);
        ph_router(P, l);
        xcd_barrier(bar);
        ph_moe1(P, l);
        xcd_barrier(bar);
        ph_moe2(P, l);
        xcd_barrier(bar);
        ph_combine(P);
        xcd_barrier(bar);
        { EpiPle e{(const bf16_t*)(ws + WS_E), RS + 2 * T, (bf16_t*)(ws + WS_YMIX)}; ph_gemm_dense(HB, 1024, (const bf16_t*)(wsm + WSM_WPG), 1024, 1024, e); }
        xcd_barrier(bar);
        ph_final(P, l);
        xcd_barrier(bar);
    }
}

__global__ void __launch_bounds__(NTHR, 2) mega_fwd(Params P) {
    extern __shared__ __attribute__((aligned(16))) unsigned char lds[];
    char* ws = P.ws;
    if (threadIdx.x == 0) *(uint4*)(lds + LDS_BAR_OFF) = make_uint4(0u, 0u, 0u, 0u);
    __syncthreads();
    const XcdBarrier bar = xcd_barrier_post((unsigned*)(ws + WS_CTL), (volatile LAS unsigned*)(lds + LDS_BAR_OFF));
    const bf16_t* HB = (const bf16_t*)(ws + WS_HB); const float* RS = (const float*)(ws + WS_RSTD);
    bf16_t* Z = (bf16_t*)(ws + WS_BIG + BIG_Z);
    for (int l = 0; l < DEPTH; ++l) {
        char* wsm = ws + WS_WSM + (size_t)l * WSM_STRIDE;
        ph_tconv(P.w_in + (size_t)l * 1024 * 1456, nullptr, P.mix_norm + l * 1024, (bf16_t*)(wsm + WSM_WIN), ZW, 1024, 1456, 1, 1, 0, 0, lds);
        ph_tconv(P.w_uq + (size_t)l * 256 * 768, nullptr, P.q_norm + l * 256, (bf16_t*)(wsm + WSM_WUQ), 768, 256, 768, 0, 1, 0, 0, lds);
        ph_tconv(P.w_ukv + (size_t)l * 128 * 1024, nullptr, P.kv_norm + l * 128, (bf16_t*)(wsm + WSM_WUKV), 1024, 128, 1024, 0, 1, 0, 0, lds);
        ph_tconv(P.w_out + (size_t)l * 1024 * 1024, nullptr, nullptr, (bf16_t*)(wsm + WSM_WOUT), 1024, 1024, 1024, 0, 1, 0, 0, lds);
        ph_tconv(P.ple_wg + (size_t)l * 1024 * 1024, nullptr, P.ple_gn + l * 1024, (bf16_t*)(wsm + WSM_WPG), 1024, 1024, 1024, 0, 1, 0, 0, lds);
        ph_tconv(P.ple_wp + (size_t)l * 256 * 1024, nullptr, nullptr, (bf16_t*)(wsm + WSM_WPLE), 1024, 256, 1024, 0, 1, 0, 0, lds);
    }
    ph_conv_bf16(P.p, (bf16_t*)(ws + WS_PB), (long)2 * T * 256 / 8);
    ph_prep_router(P);
    ph_init_h(P);
    xcd_barrier(bar);
    layer_body<0>(P, bar, lds);
    layer_body<1>(P, bar, lds);
}

extern "C" void kernel_launch(void* const* d_in, const int* in_sizes, int n_in, void* d_out, int out_size, void* d_ws, size_t ws_size, hipStream_t stream) {
    if (n_in != 30 || ws_size < WS_END) { fprintf(stderr, "kernel_launch: need 30 inputs and %zu bytes of workspace (got %d, %zu)\n", (size_t)WS_END, n_in, ws_size); return; }
    static int grid = 0;
    if (!grid) {
        int dev = 0, cus = 0, per_cu = 0;
        if (hipGetDevice(&dev) != hipSuccess || hipDeviceGetAttribute(&cus, hipDeviceAttributeMultiprocessorCount, dev) != hipSuccess) { fprintf(stderr, "kernel_launch: device query failed\n"); return; }
        if (hipFuncSetAttribute((const void*)mega_fwd, hipFuncAttributeMaxDynamicSharedMemorySize, LDS_BYTES) != hipSuccess) { fprintf(stderr, "kernel_launch: hipFuncSetAttribute failed\n"); return; }
        if (hipOccupancyMaxActiveBlocksPerMultiprocessor(&per_cu, (const void*)mega_fwd, NTHR, LDS_BYTES) != hipSuccess || per_cu < 1) { fprintf(stderr, "kernel_launch: occupancy query says %d\n", per_cu); return; }
        grid = cus;
    }
    Params P{};
    P.x = (const float*)d_in[0]; P.p = (const float*)d_in[1]; P.pos = (const int*)d_in[2];
    P.mix_norm = (const float*)d_in[3]; P.w_in = (const float*)d_in[4]; P.gla_wg = (const float*)d_in[5]; P.gla_bg = (const float*)d_in[6]; P.gla_on = (const float*)d_in[7];
    P.q_norm = (const float*)d_in[8]; P.w_uq = (const float*)d_in[9]; P.kv_norm = (const float*)d_in[10]; P.w_ukv = (const float*)d_in[11]; P.qkq = (const float*)d_in[12]; P.qkk = (const float*)d_in[13];
    P.pool_w = (const float*)d_in[14]; P.pool_s = (const float*)d_in[15]; P.w_out = (const float*)d_in[16]; P.ffn_norm = (const float*)d_in[17]; P.router_w = (const float*)d_in[18]; P.router_b = (const float*)d_in[19];
    P.moe_wg = (const float*)d_in[20]; P.moe_bg = (const float*)d_in[21]; P.moe_wu = (const float*)d_in[22]; P.moe_bu = (const float*)d_in[23]; P.moe_wd = (const float*)d_in[24]; P.moe_bd = (const float*)d_in[25];
    P.ple_wp = (const float*)d_in[26]; P.ple_gn = (const float*)d_in[27]; P.ple_wg = (const float*)d_in[28]; P.ple_pn = (const float*)d_in[29];
    P.out = (float*)d_out; P.ws = (char*)d_ws;
    (void)hipMemsetAsync((char*)d_ws + WS_CTL, 0, 65536, stream);
    hipLaunchKernelGGL(mega_fwd, dim3(grid), dim3(NTHR), LDS_BYTES, stream, P);
}
```

```cpp
#include <hip/hip_runtime.h>
#include <cstdio>
#include <cstdint>

typedef unsigned short bf16_t;
typedef short bf16x8 __attribute__((ext_vector_type(8)));
typedef float f32x4 __attribute__((ext_vector_type(4)));

constexpr int T = 32768, DM = 1024, SEQ = 4096, NBATCH = 8, DEPTH = 2;
constexpr int ZW = 1536;
constexpr int ZC_CQ = 0, ZC_GV = 256, ZC_GR = 512, ZC_UP = 768, ZC_GQ = 1024, ZC_GK = 1152, ZC_CKV = 1280, ZC_KR = 1408, ZC_GLOW = 1440;
constexpr int NE = 32, TOPK = 4, DFF = 1024;
constexpr int HROWS = 139264;
constexpr float EPS = 1e-6f;

__host__ __device__ inline int zsrc(int n) {
    if (n < 256) return 784 + n;
    if (n < 512) return 256 + (n - 256);
    if (n < 768) return 528 + (n - 512);
    if (n < 1024) return 1200 + (n - 768);
    if (n < 1152) return n - 1024;
    if (n < 1280) return 128 + (n - 1152);
    if (n < 1408) return 1040 + (n - 1280);
    if (n < 1440) return 1168 + (n - 1408);
    if (n < 1456) return 512 + (n - 1440);
    return -1;
}

constexpr size_t MiB = 1024 * 1024;
constexpr size_t WS_CTL = 0;
constexpr size_t WS_HB = 1 * MiB;
constexpr size_t WS_RSTD = WS_HB + 64 * MiB;
constexpr size_t WS_WSM = WS_RSTD + 1 * MiB;
constexpr size_t WSM_WIN = 0, WSM_WUQ = 3 * MiB, WSM_WUKV = WSM_WUQ + 384 * 1024, WSM_WOUT = WSM_WUKV + 256 * 1024, WSM_WPG = WSM_WOUT + 2 * MiB,
                 WSM_WPLE = WSM_WPG + 2 * MiB, WSM_WR = WSM_WPLE + 512 * 1024, WSM_STRIDE = WSM_WR + 128 * 1024 + 128 * 1024;
constexpr size_t WS_PB = WS_WSM + 2 * WSM_STRIDE;
constexpr size_t WS_W1 = WS_PB + 32 * MiB;
constexpr size_t WS_W2 = WS_W1 + 128 * MiB;
constexpr size_t WS_E = WS_W2 + 64 * MiB;
constexpr size_t WS_YMIX = WS_E + 64 * MiB;
constexpr size_t WS_Y = WS_YMIX + 64 * MiB;
constexpr size_t WS_UPD = WS_Y + 256 * MiB;
constexpr size_t WS_DEC = WS_UPD + 16 * MiB;
constexpr size_t WS_SPREV = WS_DEC + 1 * MiB;
constexpr size_t WS_TOPG = WS_SPREV + 8 * MiB;
constexpr size_t WS_LIST = WS_TOPG + 1 * MiB;
constexpr size_t WS_BIG = WS_LIST + 4 * MiB;
constexpr size_t BIG_Z = 0, BIG_Q = 96 * MiB, BIG_KV = BIG_Q + 48 * MiB, BIG_K = BIG_KV + 64 * MiB, BIG_LA = BIG_K + 48 * MiB;
constexpr size_t WS_END = WS_BIG + 272 * MiB;
constexpr int CTL_CNT = 4096;

__device__ __forceinline__ float bf2f(bf16_t v) { return __uint_as_float(((unsigned)v) << 16); }
__device__ __forceinline__ bf16_t f2bf(float f) { unsigned u = __float_as_uint(f); u += 0x7FFFu + ((u >> 16) & 1u); return (bf16_t)(u >> 16); }
__device__ __forceinline__ unsigned pack2(float lo, float hi) { return (unsigned)f2bf(lo) | ((unsigned)f2bf(hi) << 16); }
__device__ __forceinline__ float wave_sum(float v) {
#pragma unroll
    for (int o = 32; o >= 1; o >>= 1) v += __shfl_xor(v, o);
    return v;
}
__device__ __forceinline__ float wave_max(float v) {
#pragma unroll
    for (int o = 32; o >= 1; o >>= 1) v = fmaxf(v, __shfl_xor(v, o));
    return v;
}
__device__ __forceinline__ float sigmoidf_(float x) { return 1.0f / (1.0f + __expf(-x)); }


#define XB_TMO      128
#define XB_XCNT(j)  (256  + 64 * (j))
#define XB_XSUB(j)  (1280 + 64 * (j))
#define XB_XGEN(j)  (2304 + 64 * (j))
#define XB_TOP      3328
#define XB_TOPGEN   3392
#define XCD_BAR_WORDS 3456
#define XB_SPIN_CAP (1u << 18)
#define LAS __attribute__((address_space(3)))

__device__ __forceinline__ unsigned xb_ld(unsigned* p)              { return __hip_atomic_load(p, __ATOMIC_RELAXED, __HIP_MEMORY_SCOPE_AGENT); }
__device__ __forceinline__ unsigned xb_add(unsigned* p, unsigned v) { return __hip_atomic_fetch_add(p, v, __ATOMIC_RELAXED, __HIP_MEMORY_SCOPE_AGENT); }
__device__ __forceinline__ unsigned xb_xcc_id() { return (unsigned)__builtin_amdgcn_s_getreg((3 << 11) | 20) & 0xFu; }
#define XB_SPIN(cond, bar) do { unsigned _sp = 0; while (cond) { __builtin_amdgcn_s_sleep(1); \
    if ((++_sp & 255u) == 0u) { if (xb_ld(&(bar)[XB_TMO])) break; if (_sp > XB_SPIN_CAP) { atomicAdd(&(bar)[XB_TMO], 1u); break; } } } } while (0)

struct XcdBarrier {
    unsigned* bar; unsigned x;
    volatile LAS unsigned* st;
};

__device__ __forceinline__ XcdBarrier xcd_barrier_post(unsigned* bar, volatile LAS unsigned* st) {
    XcdBarrier b; b.bar = bar; b.x = xb_xcc_id(); b.st = st;
    if (threadIdx.x == 0) (void)xb_add(&bar[XB_XCNT(b.x)], 1u);
    return b;
}
__device__ __forceinline__ void xcd_barrier_complete(unsigned* bar, unsigned x, unsigned& nloc, unsigned& nx) {
    const unsigned G = gridDim.x * gridDim.y * gridDim.z;
    unsigned sum, cnt, mine, sp = 0u;
    for (;;) {
        sum = 0u; cnt = 0u; mine = 0u;
#pragma unroll
        for (unsigned j = 0; j < 16; ++j) { const unsigned c = xb_ld(&bar[XB_XCNT(j)]); sum += c; cnt += (c > 0u) ? 1u : 0u; mine = (j == x) ? c : mine; }
        if (sum == G) break;
        __builtin_amdgcn_s_sleep(1);
        if ((++sp & 255u) == 0u) { if (xb_ld(&bar[XB_TMO])) break; if (sp > XB_SPIN_CAP) { atomicAdd(&bar[XB_TMO], 1u); break; } }
    }
    nloc = mine > 0u ? mine : 1u; nx = cnt > 0u ? cnt : 1u;
}

__device__ __forceinline__ void xcd_barrier(const XcdBarrier& b) {
    asm volatile("s_waitcnt vmcnt(0)" ::: "memory");
    __syncthreads();
    if (threadIdx.x == 0) {
        unsigned* bar = b.bar;
        __builtin_amdgcn_s_waitcnt(0);
        unsigned nloc = b.st[0], nx = b.st[1];
        if (nloc == 0u) { xcd_barrier_complete(bar, b.x, nloc, nx); b.st[0] = nloc; b.st[1] = nx; }
        const unsigned old = xb_add(&bar[XB_XSUB(b.x)], 1u);
        const unsigned gen = old / nloc;
        if (old + 1u == (gen + 1u) * nloc) {
            __builtin_amdgcn_fence(__ATOMIC_RELEASE, "agent");
            asm volatile("s_waitcnt vmcnt(0)" ::: "memory");
            const unsigned og = xb_add(&bar[XB_TOP], 1u);
            const unsigned tg = og / nx;
            if (og + 1u == (tg + 1u) * nx) xb_add(&bar[XB_TOPGEN], 1u);
            else XB_SPIN(xb_ld(&bar[XB_TOPGEN]) == tg, bar);
            __builtin_amdgcn_fence(__ATOMIC_ACQUIRE, "agent");
            xb_add(&bar[XB_XGEN(b.x)], 1u);
            asm volatile("s_waitcnt vmcnt(0)" ::: "memory");
        } else {
            XB_SPIN(xb_ld(&bar[XB_XGEN(b.x)]) == gen, bar);
            __builtin_amdgcn_fence(__ATOMIC_ACQUIRE, "agent");
            asm volatile("s_waitcnt vmcnt(0)" ::: "memory");
        }
    }
    __syncthreads();
}

struct Params {
    const float *x, *p; const int* pos;
    const float *mix_norm, *w_in, *gla_wg, *gla_bg, *gla_on, *q_norm, *w_uq, *kv_norm, *w_ukv, *qkq, *qkk, *pool_w, *pool_s, *w_out, *ffn_norm, *router_w, *router_b,
        *moe_wg, *moe_bg, *moe_wu, *moe_bu, *moe_wd, *moe_bd, *ple_wp, *ple_gn, *ple_wg, *ple_pn;
    float* out; char* ws;
};


constexpr int NTHR = 512, NWV = 8;
__device__ __forceinline__ int opaque_tid() { int t = threadIdx.x; asm volatile("" : "+v"(t)); return t; }
constexpr int LDS_BYTES = 147456;
constexpr int LDS_BAR_OFF = LDS_BYTES - 16;

__device__ __forceinline__ void ph_tconv(const float* src, const float* src2, const float* gain, bf16_t* dst, int N, int K, int ld_src, int mode, int nexp, long se, long de, unsigned char* lds) {
    const int tz = opaque_tid(); const int tid = tz & 255, half = tz >> 8, tx = tid & 63, ty = tid >> 6;
    float (*tile)[65] = (float (*)[65])(lds + half * 16640);
    const int nx = N / 64, ny = K / 64, nunits = nx * ny * nexp;
    for (int u0 = blockIdx.x * 2; u0 < nunits; u0 += gridDim.x * 2) {
        const int u = u0 + half; const int bx = u % nx, by = (u / nx) % ny, e = u / (nx * ny);
        const float* s1 = src + (long)e * se; const float* s2 = src2 ? src2 + (long)e * se : nullptr; bf16_t* d = dst + (long)e * de;
        const int n0 = bx * 64, k0 = by * 64, n = n0 + tx;
        const float* sp = s1; int col;
        if (mode == 0) col = n;
        else if (mode == 1) col = zsrc(n);
        else { const int tl = n >> 8, w = n & 255; if (w < 128) col = tl * 128 + w; else { col = tl * 128 + (w - 128); sp = s2; } }
#pragma unroll
        for (int i = 0; i < 16; ++i) {
            const int k = k0 + ty + 4 * i; float v = 0.f;
            if (col >= 0) v = sp[(long)k * ld_src + col];
            if (gain) v *= gain[k];
            tile[ty + 4 * i][tx] = v;
        }
        __syncthreads();
        const int nl = tid >> 2, ks = (tid & 3) * 16;
        unsigned w0 = pack2(tile[ks + 0][nl], tile[ks + 1][nl]), w1 = pack2(tile[ks + 2][nl], tile[ks + 3][nl]), w2 = pack2(tile[ks + 4][nl], tile[ks + 5][nl]), w3 = pack2(tile[ks + 6][nl], tile[ks + 7][nl]);
        unsigned w4 = pack2(tile[ks + 8][nl], tile[ks + 9][nl]), w5 = pack2(tile[ks + 10][nl], tile[ks + 11][nl]), w6 = pack2(tile[ks + 12][nl], tile[ks + 13][nl]), w7 = pack2(tile[ks + 14][nl], tile[ks + 15][nl]);
        uint4* o = (uint4*)(d + (long)(n0 + nl) * K + k0 + ks);
        o[0] = make_uint4(w0, w1, w2, w3); o[1] = make_uint4(w4, w5, w6, w7);
        __syncthreads();
    }
}
__device__ __forceinline__ void ph_conv_bf16(const float* src, bf16_t* dst, long n8) {
    const int tz = opaque_tid();
    for (long i = (long)blockIdx.x * NTHR + tz; i < n8; i += (long)gridDim.x * NTHR) {
        const float4 a = ((const float4*)src)[2 * i], b = ((const float4*)src)[2 * i + 1];
        ((uint4*)dst)[i] = make_uint4(pack2(a.x, a.y), pack2(a.z, a.w), pack2(b.x, b.y), pack2(b.z, b.w));
    }
}
__device__ __forceinline__ void ph_prep_router(const Params& P) {
    const int tz = opaque_tid();
    for (int i = blockIdx.x * NTHR + tz; i < 2 * 32 * 1024; i += gridDim.x * NTHR) {
        const int l = i >> 15, e = (i >> 10) & 31, k = i & 1023;
        float* Wr = (float*)(P.ws + WS_WSM + (size_t)l * WSM_STRIDE + WSM_WR);
        Wr[e * 1024 + k] = P.router_w[((size_t)l * 1024 + k) * 32 + e] * P.ffn_norm[l * 1024 + k];
    }
}

__device__ __forceinline__ void ph_init_h(const Params& P) {
    const int tz = opaque_tid(); const int wid = tz >> 6, lane = tz & 63;
    bf16_t* HB = (bf16_t*)(P.ws + WS_HB); float* RS = (float*)(P.ws + WS_RSTD);
    for (int t = blockIdx.x * NWV + wid; t < T; t += gridDim.x * NWV) {
        const float* hr = P.x + (size_t)t * 1024;
        float ss = 0.f; float4 v[4];
#pragma unroll
        for (int i = 0; i < 4; ++i) { v[i] = *(const float4*)(hr + i * 256 + lane * 4); ss += v[i].x * v[i].x + v[i].y * v[i].y + v[i].z * v[i].z + v[i].w * v[i].w; }
        ss = wave_sum(ss);
        if (lane == 0) RS[t] = rsqrtf(ss * (1.0f / 1024.0f) + EPS);
#pragma unroll
        for (int i = 0; i < 4; ++i) *(uint2*)(HB + (size_t)t * 1024 + i * 256 + lane * 4) = make_uint2(pack2(v[i].x, v[i].y), pack2(v[i].z, v[i].w));
    }
}

__device__ __forceinline__ void ph_prepB(const Params& P, int layer, unsigned char* lds) {
    float* pw = (float*)lds;
    float* wg = (float*)(lds + 65536);
    const int tid = opaque_tid(), wid = tid >> 6, lane = tid & 63;
    for (int i = tid; i < 4 * 64 * 64; i += NTHR) pw[i] = P.pool_w[(size_t)layer * 16384 + i];
    for (int i = tid; i < 16 * 128; i += NTHR) wg[i] = P.gla_wg[(size_t)layer * 2048 + i];
    __syncthreads();
    bf16_t* Z = (bf16_t*)(P.ws + WS_BIG + BIG_Z); float* LA = (float*)(P.ws + WS_BIG + BIG_LA); bf16_t* YM = (bf16_t*)(P.ws + WS_YMIX);
    const float* bg = P.gla_bg + layer * 128; const float* psc = P.pool_s + layer * 256;
    for (int t = blockIdx.x * NWV + wid; t < T; t += gridDim.x * NWV) {
        bf16_t* zr = Z + (size_t)t * ZW;
        {
            const uint2 raw = *(const uint2*)(zr + ZC_CQ + lane * 4);
            const float a = bf2f(raw.x & 0xffff), b = bf2f(raw.x >> 16), c = bf2f(raw.y & 0xffff), d = bf2f(raw.y >> 16);
            const float ss = wave_sum(a * a + b * b + c * c + d * d);
            const float r = rsqrtf(ss * (1.0f / 256.0f) + EPS);
            *(uint2*)(zr + ZC_CQ + lane * 4) = make_uint2(pack2(a * r, b * r), pack2(c * r, d * r));
        }
        {
            const unsigned raw = *(const unsigned*)(zr + ZC_CKV + lane * 2);
            const float a = bf2f(raw & 0xffff), b = bf2f(raw >> 16);
            const float ss = wave_sum(a * a + b * b);
            const float r = rsqrtf(ss * (1.0f / 128.0f) + EPS);
            *(unsigned*)(zr + ZC_CKV + lane * 2) = pack2(a * r, b * r);
        }
        {
            float gl = (lane < 16) ? bf2f(zr[ZC_GLOW + lane]) : 0.f;
            float l0 = bg[lane], l1 = bg[lane + 64];
#pragma unroll
            for (int r = 0; r < 16; ++r) { const float g = __shfl(gl, r); l0 += g * wg[r * 128 + lane]; l1 += g * wg[r * 128 + lane + 64]; }
            const float a0 = fminf(l0, 0.f) - log1pf(__expf(-fabsf(l0))), a1 = fminf(l1, 0.f) - log1pf(__expf(-fabsf(l1)));
            LA[(size_t)t * 128 + lane] = a0 * (1.0f / 16.0f); LA[(size_t)t * 128 + lane + 64] = a1 * (1.0f / 16.0f);
        }
        {
            const int s = t & (SEQ - 1);
#pragma unroll
            for (int gi = 0; gi < 4; ++gi) {
                const int w = 2 << gi; const int cnt = (s + 1 < w) ? s + 1 : w;
                const float u0 = bf2f(zr[ZC_UP + gi * 64 + lane]);
                float acc = u0;
                for (int j = 1; j < cnt; ++j) acc += bf2f(zr[(long)ZC_UP + gi * 64 + lane - (long)j * ZW]);
                const float dv = acc / (float)cnt - u0;
                float y = 0.f;
#pragma unroll 8
                for (int c = 0; c < 64; ++c) y += __shfl(dv, c) * pw[(gi * 64 + c) * 64 + lane];
                YM[(size_t)t * 1024 + 768 + gi * 64 + lane] = f2bf(y * psc[gi * 64 + lane]);
            }
        }
    }
}

__device__ __forceinline__ void ph_prepD(const Params& P, int layer) {
    const int tid = opaque_tid(), wid = tid >> 6, lane = tid & 63;
    bf16_t* Z = (bf16_t*)(P.ws + WS_BIG + BIG_Z); bf16_t* Q = (bf16_t*)(P.ws + WS_BIG + BIG_Q); const bf16_t* KV = (const bf16_t*)(P.ws + WS_BIG + BIG_KV); bf16_t* Kd = (bf16_t*)(P.ws + WS_BIG + BIG_K);
    const float* gq = P.qkq + layer * 96; const float* gk = P.qkk + layer * 96;
    const int i16 = lane & 15;
    const float inv = exp2f(-(float)(2 * i16) * (1.0f / 32.0f) * 13.287712379549449f);
    const float qscale = 0.10206207261596577f * 1.4426950408889634f;
    for (int th = blockIdx.x * NWV + wid; th < T * 8; th += gridDim.x * NWV) {
        const int t = th >> 3, h = th & 7;
        const float ang = (float)P.pos[t] * inv; const float cs = cosf(ang), sn = sinf(ang);
        {
            bf16_t* qp = Q + (size_t)t * 768 + h * 96;
            const float a = bf2f(qp[lane]); const float b = (lane < 32) ? bf2f(qp[64 + lane]) : 0.f;
            const float ss = wave_sum(a * a + b * b);
            const float r = rsqrtf(ss * (1.0f / 96.0f) + EPS);
            const float an = a * r * gq[lane]; const float bn = (lane < 32) ? b * r * gq[64 + lane] : 0.f;
            const float partner = __shfl_xor(bn, 16);
            const float rot = (lane < 16) ? (bn * cs - partner * sn) : (bn * cs + partner * sn);
            qp[lane] = f2bf(an * qscale);
            if (lane < 32) qp[64 + lane] = f2bf(rot * qscale);
        }
        {
            const float a = bf2f(KV[(size_t)t * 1024 + h * 128 + lane]); const float b = (lane < 32) ? bf2f(Z[(size_t)t * ZW + ZC_KR + lane]) : 0.f;
            const float ss = wave_sum(a * a + b * b);
            const float r = rsqrtf(ss * (1.0f / 96.0f) + EPS);
            const float an = a * r * gk[lane]; const float bn = (lane < 32) ? b * r * gk[64 + lane] : 0.f;
            const float partner = __shfl_xor(bn, 16);
            const float rot = (lane < 16) ? (bn * cs - partner * sn) : (bn * cs + partner * sn);
            bf16_t* kp = Kd + ((size_t)t * 8 + h) * 96;
            kp[lane] = f2bf(an);
            if (lane < 32) kp[64 + lane] = f2bf(rot);
        }
    }
}

__device__ __forceinline__ void ph_router(const Params& P, int layer) {
    const int tid = opaque_tid(), wid = tid >> 6, lane = tid & 63;
    bf16_t* HB = (bf16_t*)(P.ws + WS_HB); float* RS1 = (float*)(P.ws + WS_RSTD) + T;
    const float* Wr = (const float*)(P.ws + WS_WSM + (size_t)layer * WSM_STRIDE + WSM_WR);
    const float* rb = P.router_b + layer * 32;
    unsigned* cnt = (unsigned*)(P.ws + WS_CTL) + CTL_CNT + layer * 32;
    int* LIST = (int*)(P.ws + WS_LIST); float* TOPG = (float*)(P.ws + WS_TOPG);
    for (int t = blockIdx.x * NWV + wid; t < T; t += gridDim.x * NWV) {
        const float* hr = P.out + (size_t)t * 1024;
        float4 v[4]; float ss = 0.f;
#pragma unroll
        for (int i = 0; i < 4; ++i) { v[i] = *(const float4*)(hr + i * 256 + lane * 4); ss += v[i].x * v[i].x + v[i].y * v[i].y + v[i].z * v[i].z + v[i].w * v[i].w; }
        ss = wave_sum(ss);
        const float rstd = rsqrtf(ss * (1.0f / 1024.0f) + EPS);
        if (lane == 0) RS1[t] = rstd;
#pragma unroll
        for (int i = 0; i < 4; ++i) *(uint2*)(HB + (size_t)t * 1024 + i * 256 + lane * 4) = make_uint2(pack2(v[i].x, v[i].y), pack2(v[i].z, v[i].w));
        float mylg = -INFINITY;
#pragma unroll 4
        for (int e = 0; e < 32; ++e) {
            float s = 0.f;
#pragma unroll
            for (int i = 0; i < 4; ++i) { const float4 w = *(const float4*)(Wr + e * 1024 + i * 256 + lane * 4); s += v[i].x * w.x + v[i].y * w.y + v[i].z * w.z + v[i].w * w.w; }
            const float tot = wave_sum(s) * rstd + rb[e];
            mylg = (lane == e) ? tot : mylg;
        }
        float tv[4]; int ti[4];
#pragma unroll
        for (int k = 0; k < 4; ++k) {
            const float best = wave_max(mylg);
            const unsigned long long mask = __ballot(mylg == best);
            const int bi = __ffsll((long long)mask) - 1;
            tv[k] = best; ti[k] = bi;
            mylg = (lane == bi) ? -INFINITY : mylg;
        }
        const float e1 = __expf(tv[1] - tv[0]), e2 = __expf(tv[2] - tv[0]), e3 = __expf(tv[3] - tv[0]);
        const float invs = 1.0f / (1.0f + e1 + e2 + e3);
        if (lane < 4) {
            const int e = (lane == 0) ? ti[0] : (lane == 1) ? ti[1] : (lane == 2) ? ti[2] : ti[3];
            const float g = (lane == 0) ? invs : (lane == 1) ? e1 * invs : (lane == 2) ? e2 * invs : e3 * invs;
            const unsigned pos = atomicAdd(&cnt[e], 1u);
            LIST[(size_t)e * T + pos] = t * 4 + lane;
            TOPG[t * 4 + lane] = g;
        }
    }
}

__device__ __forceinline__ void ph_combine(const Params& P) {
    const int tid = opaque_tid(), wid = tid >> 6, lane = tid & 63;
    bf16_t* HB = (bf16_t*)(P.ws + WS_HB); float* RS2 = (float*)(P.ws + WS_RSTD) + 2 * T; const bf16_t* Y = (const bf16_t*)(P.ws + WS_Y);
    for (int t = blockIdx.x * NWV + wid; t < T; t += gridDim.x * NWV) {
        float* hr = P.out + (size_t)t * 1024; float ss = 0.f;
#pragma unroll
        for (int i = 0; i < 4; ++i) {
            float4 v = *(const float4*)(hr + i * 256 + lane * 4);
#pragma unroll
            for (int k = 0; k < 4; ++k) {
                const uint2 y = *(const uint2*)(Y + ((size_t)t * 4 + k) * 1024 + i * 256 + lane * 4);
                v.x += bf2f(y.x & 0xffff); v.y += bf2f(y.x >> 16); v.z += bf2f(y.y & 0xffff); v.w += bf2f(y.y >> 16);
            }
            *(float4*)(hr + i * 256 + lane * 4) = v;
            ss += v.x * v.x + v.y * v.y + v.z * v.z + v.w * v.w;
            *(uint2*)(HB + (size_t)t * 1024 + i * 256 + lane * 4) = make_uint2(pack2(v.x, v.y), pack2(v.z, v.w));
        }
        ss = wave_sum(ss);
        if (lane == 0) RS2[t] = rsqrtf(ss * (1.0f / 1024.0f) + EPS);
    }
}

__device__ __forceinline__ void ph_final(const Params& P, int layer) {
    const int tid = opaque_tid(), wid = tid >> 6, lane = tid & 63;
    bf16_t* HB = (bf16_t*)(P.ws + WS_HB); float* RS = (float*)(P.ws + WS_RSTD); const bf16_t* V = (const bf16_t*)(P.ws + WS_YMIX);
    const float* gp = P.ple_pn + layer * 1024;
    for (int t = blockIdx.x * NWV + wid; t < T; t += gridDim.x * NWV) {
        float* hr = P.out + (size_t)t * 1024; float vv[16]; float ss = 0.f;
#pragma unroll
        for (int i = 0; i < 4; ++i) {
            const uint2 y = *(const uint2*)(V + (size_t)t * 1024 + i * 256 + lane * 4);
            vv[4 * i] = bf2f(y.x & 0xffff); vv[4 * i + 1] = bf2f(y.x >> 16); vv[4 * i + 2] = bf2f(y.y & 0xffff); vv[4 * i + 3] = bf2f(y.y >> 16);
            ss += vv[4 * i] * vv[4 * i] + vv[4 * i + 1] * vv[4 * i + 1] + vv[4 * i + 2] * vv[4 * i + 2] + vv[4 * i + 3] * vv[4 * i + 3];
        }
        ss = wave_sum(ss);
        const float r = rsqrtf(ss * (1.0f / 1024.0f) + EPS);
        float s2 = 0.f;
#pragma unroll
        for (int i = 0; i < 4; ++i) {
            float4 v = *(const float4*)(hr + i * 256 + lane * 4); const float4 g = *(const float4*)(gp + i * 256 + lane * 4);
            v.x += vv[4 * i] * r * g.x; v.y += vv[4 * i + 1] * r * g.y; v.z += vv[4 * i + 2] * r * g.z; v.w += vv[4 * i + 3] * r * g.w;
            *(float4*)(hr + i * 256 + lane * 4) = v;
            s2 += v.x * v.x + v.y * v.y + v.z * v.z + v.w * v.w;
            *(uint2*)(HB + (size_t)t * 1024 + i * 256 + lane * 4) = make_uint2(pack2(v.x, v.y), pack2(v.z, v.w));
        }
        s2 = wave_sum(s2);
        if (lane == 0) RS[t] = rsqrtf(s2 * (1.0f / 1024.0f) + EPS);
    }
}

struct EpiZ { bf16_t* Z; const float* rstd;
    __device__ __forceinline__ void operator()(int r, int c, f32x4 v) const { const float s = rstd[r]; *(uint2*)(Z + (size_t)r * ZW + c) = make_uint2(pack2(v[0] * s, v[1] * s), pack2(v[2] * s, v[3] * s)); } };
struct EpiBf16 { bf16_t* O; int ldo;
    __device__ __forceinline__ void operator()(int r, int c, f32x4 v) const { *(uint2*)(O + (size_t)r * ldo + c) = make_uint2(pack2(v[0], v[1]), pack2(v[2], v[3])); } };
struct EpiResid { const float* hin; float* out;
    __device__ __forceinline__ void operator()(int r, int c, f32x4 v) const { const f32x4 b = *(const f32x4*)(hin + (size_t)r * 1024 + c); *(f32x4*)(out + (size_t)r * 1024 + c) = b + v; } };
struct EpiMoe1 { const int* list; const float* rstd1; const float* bg; const float* bu; bf16_t* H;
    __device__ __forceinline__ void operator()(int r, int hc, f32x4 g, f32x4 u) const {
        const float s = rstd1[list[r] >> 2]; const f32x4 b0 = *(const f32x4*)(bg + hc), b1 = *(const f32x4*)(bu + hc); float o[4];
#pragma unroll
        for (int j = 0; j < 4; ++j) { const float gg = fminf(g[j] * s + b0[j], 7.0f); const float uu = fminf(fmaxf(u[j] * s + b1[j], -7.0f), 7.0f); o[j] = (uu + 1.0f) * gg * sigmoidf_(1.702f * gg); }
        *(uint2*)(H + (size_t)r * 1024 + hc) = make_uint2(pack2(o[0], o[1]), pack2(o[2], o[3])); } };
struct EpiMoe2 { const int* list; const float* topg; const float* bd; bf16_t* Y;
    __device__ __forceinline__ void operator()(int r, int c, f32x4 v) const { const int ts = list[r]; const float g = topg[ts]; const f32x4 b = *(const f32x4*)(bd + c);
        *(uint2*)(Y + (size_t)ts * 1024 + c) = make_uint2(pack2((v[0] + b[0]) * g, (v[1] + b[1]) * g), pack2((v[2] + b[2]) * g, (v[3] + b[3]) * g)); } };
struct EpiPle { const bf16_t* E; const float* rstd2; bf16_t* V;
    __device__ __forceinline__ void operator()(int r, int c, f32x4 v) const { const float s = rstd2[r]; const uint2 e = *(const uint2*)(E + (size_t)r * 1024 + c);
        const float o0 = bf2f(e.x & 0xffff) * sigmoidf_(v[0] * s), o1 = bf2f(e.x >> 16) * sigmoidf_(v[1] * s), o2 = bf2f(e.y & 0xffff) * sigmoidf_(v[2] * s), o3 = bf2f(e.y >> 16) * sigmoidf_(v[3] * s);
        *(uint2*)(V + (size_t)r * 1024 + c) = make_uint2(pack2(o0, o1), pack2(o2, o3)); } };

template <class Epi, bool PAIR>
__device__ __forceinline__ void gemm_simple_unit(const bf16_t* A, int lda, const int* rowidx, const bf16_t* Bt, int ldb, int M, int K, int mblk, int nblk, const Epi& epi) {
    const int tid = opaque_tid(), wid = tid >> 6, lane = tid & 63, wr = wid >> 1, wc = wid & 1, fr = lane & 15, fq = lane >> 4;
    const int m0 = mblk * 256 + wr * 64;
    if (m0 >= M) return;
    const bf16_t* ap[4]; const bf16_t* bp[4];
#pragma unroll
    for (int mi = 0; mi < 4; ++mi) { int r = m0 + mi * 16 + fr; if (r >= M) r = M - 1; const long ar = rowidx ? (long)(rowidx[r] >> 2) : (long)r; ap[mi] = A + ar * lda + fq * 8; }
#pragma unroll
    for (int ni = 0; ni < 4; ++ni) {
        int br;
        if (PAIR) { const int hc = nblk * 64 + wc * 32 + (ni & 1) * 16 + fr; br = (hc >> 7) * 256 + (hc & 127) + ((ni >> 1) ? 128 : 0); }
        else br = nblk * 128 + wc * 64 + ni * 16 + fr;
        bp[ni] = Bt + (long)br * ldb + fq * 8;
    }
    f32x4 acc[4][4];
#pragma unroll
    for (int mi = 0; mi < 4; ++mi)
#pragma unroll
        for (int ni = 0; ni < 4; ++ni) acc[mi][ni] = (f32x4){0.f, 0.f, 0.f, 0.f};
    for (int k0 = 0; k0 < K; k0 += 32) {
        bf16x8 a[4], b[4];
#pragma unroll
        for (int i = 0; i < 4; ++i) { a[i] = *(const bf16x8*)(ap[i] + k0); b[i] = *(const bf16x8*)(bp[i] + k0); }
#pragma unroll
        for (int mi = 0; mi < 4; ++mi)
#pragma unroll
            for (int ni = 0; ni < 4; ++ni) acc[mi][ni] = __builtin_amdgcn_mfma_f32_16x16x32_bf16(b[ni], a[mi], acc[mi][ni], 0, 0, 0);
    }
#pragma unroll
    for (int mi = 0; mi < 4; ++mi) {
        const int r = m0 + mi * 16 + fr;
        if (r < M) {
            if constexpr (PAIR) {
#pragma unroll
                for (int ni = 0; ni < 2; ++ni) epi(r, nblk * 64 + wc * 32 + ni * 16 + fq * 4, acc[mi][ni], acc[mi][ni + 2]);
            } else {
#pragma unroll
                for (int ni = 0; ni < 4; ++ni) epi(r, nblk * 128 + wc * 64 + ni * 16 + fq * 4, acc[mi][ni]);
            }
        }
    }
}

namespace fg {
constexpr int BM = 256, BK = 64, HALF = 128, HTB = HALF * BK * 2  , STAGE_BYTES = 8 * HTB, NXCD = 8, WGM = 8;
__host__ __device__ __forceinline__ int lds_byte(int r, int c) { const int st = (r >> 4) * 2 + (c >> 5), rr = r & 15, cc = c & 31, ob = rr * 64 + cc * 2; return st * 1024 + (ob ^ (((ob >> 9) & 1) << 5)); }
__host__ __device__ __forceinline__ void stage_rc(int b, int& R, int& C) { const int st = b / 1024, sb = b % 1024, swz = sb ^ (((sb >> 9) & 1) << 5); R = (st >> 1) * 16 + swz / 64; C = (st & 1) * 32 + (swz % 64) / 2; }

template <class PB>
__device__ __forceinline__ void gemm_phase(LAS unsigned char* lds, const PB& S) {
    constexpr int K = PB::K, nt = K / BK;
    typedef typename PB::Unit Unit;
    const int tid = opaque_tid(); const int wid = __builtin_amdgcn_readfirstlane(tid >> 6), lane = tid & 63, wr = wid >> 2, wc = wid & 3, fr = lane & 15, fq = lane >> 4;
    unsigned voffB[2];
#pragma unroll
    for (int i = 0; i < 2; ++i) { int R_, C_; stage_rc(tid * 16 + i * 8192, R_, C_); voffB[i] = (unsigned)(R_ * K + C_) * 2u; }
#define FG_AOFFS(dst, unit) do { int tz_ = tid; asm volatile("" : "+v"(tz_)); _Pragma("unroll") for (int i_ = 0; i_ < 2; ++i_) { int R_, C_; stage_rc(tz_ * 16 + i_ * 8192, R_, C_); \
        _Pragma("unroll") for (int h_ = 0; h_ < 2; ++h_) dst[h_][i_] = S.a_off(unit, h_ * HALF + R_) + (unsigned)C_ * 2u; } } while (0)
    constexpr size_t kstep = (size_t)(BK * 2);
    constexpr size_t hstep = (size_t)HALF * K * 2;
    const unsigned ldsw = (unsigned)wid * 1024u;
    const int aoff = lds_byte(wr * 64 + fr, fq * 8), boff = lds_byte(wc * 32 + fr, fq * 8);
#define FG_SA(b, h) (((b) * 2 + (h)) * HTB)
#define FG_SB(b, h) ((4 + (b) * 2 + (h)) * HTB)
#define FG_STAGE_B(bufoff, gbase) do { _Pragma("unroll") for (int _i = 0; _i < 2; ++_i) \
        __builtin_amdgcn_global_load_lds((const unsigned*)((const char*)(gbase) + voffB[_i]), (LAS unsigned*)(lds + (bufoff) + ldsw + _i * 8192), 16, 0, 0); } while (0)
#define FG_STAGE_A(bufoff, o0, o1) do { \
        __builtin_amdgcn_global_load_lds((const unsigned*)(Abase + (o0)), (LAS unsigned*)(lds + (bufoff) + ldsw), 16, 0, 0); \
        __builtin_amdgcn_global_load_lds((const unsigned*)(Abase + (o1)), (LAS unsigned*)(lds + (bufoff) + ldsw + 8192), 16, 0, 0); } while (0)
#define FG_LDA(dst, b, h) do { _Pragma("unroll") for (int m = 0; m < 4; ++m) _Pragma("unroll") for (int k = 0; k < 2; ++k) dst[m][k] = *(const LAS bf16x8*)(lds + FG_SA(b, h) + aoff + m * 2048 + k * 1024); } while (0)
#define FG_LDB(dst, b, h) do { _Pragma("unroll") for (int n = 0; n < 2; ++n) _Pragma("unroll") for (int k = 0; k < 2; ++k) dst[n][k] = *(const LAS bf16x8*)(lds + FG_SB(b, h) + boff + n * 2048 + k * 1024); } while (0)
#define FG_MMA(ai, bj, At, Bt) do { __builtin_amdgcn_s_setprio(1); _Pragma("unroll") for (int m = 0; m < 4; ++m) _Pragma("unroll") for (int n = 0; n < 2; ++n) _Pragma("unroll") for (int k = 0; k < 2; ++k) \
        acc[ai][bj][m][n] = __builtin_amdgcn_mfma_f32_16x16x32_bf16(Bt[n][k], At[m][k], acc[ai][bj][m][n], 0, 0, 0); __builtin_amdgcn_s_setprio(0); } while (0)
#define FG_WAIT_V(n) asm volatile("s_waitcnt vmcnt(" #n ")" ::: "memory")
#define FG_WAIT_L(n) asm volatile("s_waitcnt lgkmcnt(" #n ")" ::: "memory")
#define FG_BAR __builtin_amdgcn_s_barrier()
#define FG_SCHED __builtin_amdgcn_sched_barrier(0)
    Unit cur, nxt; int ui = 0;
    if (!S.next(0, cur)) return;
    f32x4 acc[2][2][4][2];
#pragma unroll
    for (int a = 0; a < 2; ++a)
#pragma unroll
        for (int b = 0; b < 2; ++b)
#pragma unroll
            for (int m = 0; m < 4; ++m)
#pragma unroll
                for (int n = 0; n < 2; ++n) acc[a][b][m][n] = (f32x4){0.f, 0.f, 0.f, 0.f};
    bf16x8 At[4][2], B0[2][2], B1[2][2];
    const char* Abase = S.a_base();
    unsigned vAc[2][2], vAn[2][2];
    FG_AOFFS(vAc, cur);
    const char* cB = S.b_base(cur);
    FG_STAGE_B(FG_SB(0, 0), cB); FG_STAGE_A(FG_SA(0, 0), vAc[0][0], vAc[0][1]); FG_STAGE_B(FG_SB(0, 1), cB + hstep); FG_STAGE_A(FG_SA(0, 1), vAc[1][0], vAc[1][1]);
    if (wr == 1) FG_BAR;
    FG_WAIT_V(4); FG_BAR;
    FG_STAGE_B(FG_SB(1, 0), cB + kstep); FG_STAGE_A(FG_SA(1, 0), vAc[0][0] + (unsigned)kstep, vAc[0][1] + (unsigned)kstep); FG_STAGE_B(FG_SB(1, 1), cB + hstep + kstep);
    FG_WAIT_V(6); FG_BAR;
    for (;;) {
        const bool has_next = S.next(ui + 1, nxt);
        const char* nB = has_next ? S.b_base(nxt) : cB;
        if (has_next) { FG_AOFFS(vAn, nxt); }
        else {
#pragma unroll
            for (int h = 0; h < 2; ++h)
#pragma unroll
                for (int i = 0; i < 2; ++i) vAn[h][i] = vAc[h][i];
        }
        for (int t = 0; t < nt; t += 2) {
            const bool last = (t == nt - 2);
            const unsigned k1 = (unsigned)((t + 1) * (int)kstep), k2 = last ? 0u : (unsigned)((t + 2) * (int)kstep);
            const unsigned a1_0 = vAc[1][0] + k1, a1_1 = vAc[1][1] + k1;
            const unsigned a2h0_0 = (last ? vAn[0][0] : vAc[0][0]) + k2, a2h0_1 = (last ? vAn[0][1] : vAc[0][1]) + k2;
            const unsigned a2h1_0 = (last ? vAn[1][0] : vAc[1][0]) + k2, a2h1_1 = (last ? vAn[1][1] : vAc[1][1]) + k2;
            const char* b2 = last ? nB : cB + (size_t)(t + 2) * kstep; const char* b3 = b2 + kstep;
            FG_LDB(B0, 0, 0); FG_SCHED; FG_LDA(At, 0, 0); FG_STAGE_A(FG_SA(1, 1), a1_0, a1_1);
            FG_WAIT_L(8); FG_BAR; FG_WAIT_L(0); FG_MMA(0, 0, At, B0); FG_BAR; FG_SCHED;
            FG_LDB(B1, 0, 1); FG_STAGE_B(FG_SB(0, 0), b2);
            FG_BAR; FG_WAIT_L(0); FG_MMA(0, 1, At, B1); FG_BAR;
            FG_LDA(At, 0, 1); FG_STAGE_A(FG_SA(0, 0), a2h0_0, a2h0_1);
            FG_BAR; FG_WAIT_L(0); FG_MMA(1, 0, At, B0); FG_BAR; FG_SCHED;
            FG_STAGE_B(FG_SB(0, 1), b2 + hstep);
            FG_WAIT_V(6); FG_BAR; FG_MMA(1, 1, At, B1); FG_BAR;
            FG_LDB(B0, 1, 0); FG_SCHED; FG_LDA(At, 1, 0); FG_STAGE_A(FG_SA(0, 1), a2h1_0, a2h1_1);
            FG_WAIT_L(8); FG_BAR; FG_WAIT_L(0); FG_MMA(0, 0, At, B0); FG_BAR; FG_SCHED;
            FG_LDB(B1, 1, 1); FG_STAGE_B(FG_SB(1, 0), b3);
            FG_BAR; FG_WAIT_L(0); FG_MMA(0, 1, At, B1); FG_BAR;
            FG_LDA(At, 1, 1); FG_STAGE_A(FG_SA(1, 0), a2h0_0 + (unsigned)kstep, a2h0_1 + (unsigned)kstep);
            FG_BAR; FG_WAIT_L(0); FG_MMA(1, 0, At, B0); FG_BAR; FG_SCHED;
            FG_STAGE_B(FG_SB(1, 1), b3 + hstep);
            FG_WAIT_V(6); FG_BAR; FG_MMA(1, 1, At, B1); FG_BAR;
        }
        S.epilogue(acc, cur, wr, wc, fr, fq);
        if (!has_next) break;
#pragma unroll
        for (int a = 0; a < 2; ++a)
#pragma unroll
            for (int b = 0; b < 2; ++b)
#pragma unroll
                for (int m = 0; m < 4; ++m)
#pragma unroll
                    for (int n = 0; n < 2; ++n) acc[a][b][m][n] = (f32x4){0.f, 0.f, 0.f, 0.f};
        cur = nxt; cB = nB; ++ui;
#pragma unroll
        for (int h = 0; h < 2; ++h)
#pragma unroll
            for (int i = 0; i < 2; ++i) vAc[h][i] = vAn[h][i];
    }
    FG_WAIT_V(0);
    if (wr == 0) FG_BAR;
    FG_BAR;
#undef FG_AOFFS
#undef FG_SA
#undef FG_SB
#undef FG_STAGE_A
#undef FG_STAGE_B
#undef FG_LDA
#undef FG_LDB
#undef FG_MMA
#undef FG_WAIT_V
#undef FG_WAIT_L
#undef FG_BAR
#undef FG_SCHED
}

template <int K_, int LDA, class Epi>
struct DenseProb {
    static constexpr int K = K_;
    struct Unit { int pm, pn; };
    const bf16_t* A; const bf16_t* Bt; int nM, nN, nwg, G, c; Epi epi;
    __device__ __forceinline__ DenseProb(const bf16_t* A_, const bf16_t* Bt_, int N, const Epi& e) : A(A_), Bt(Bt_), nM(T / BM), nN(N / BM), nwg((T / BM) * (N / BM)), G(gridDim.x), c(blockIdx.x), epi(e) {}
    __device__ __forceinline__ bool next(int i, Unit& u) const {
        const long L = (long)i * G + c; if (L >= nwg) return false;
        int wgid = (int)L; { const int q = nwg / NXCD, r = nwg % NXCD, xcd = wgid % NXCD, off = wgid / NXCD; wgid = (xcd < r ? xcd * (q + 1) : r * (q + 1) + (xcd - r) * q) + off; }
        const int nig = WGM * nN, gid = wgid / nig, fm = gid * WGM, gsz = (nM - fm) < WGM ? (nM - fm) : WGM;
        u.pm = fm + ((wgid % nig) % gsz); u.pn = (wgid % nig) / gsz; return true;
    }
    __device__ __forceinline__ const char* a_base() const { return (const char*)A; }
    __device__ __forceinline__ unsigned a_off(const Unit& u, int r) const { return (unsigned)((u.pm * BM + r) * LDA) * 2u; }
    __device__ __forceinline__ const char* b_base(const Unit& u) const { return (const char*)Bt + (size_t)u.pn * BM * K * 2; }
    __device__ __forceinline__ void epilogue(const f32x4 (&acc)[2][2][4][2], const Unit& u, int wr, int wc, int fr, int fq) const {
        const int row0 = u.pm * BM + wr * 64 + fr, col0 = u.pn * BM + wc * 32 + 4 * fq;
#pragma unroll
        for (int ai = 0; ai < 2; ++ai)
#pragma unroll
            for (int m = 0; m < 4; ++m)
#pragma unroll
                for (int bj = 0; bj < 2; ++bj)
#pragma unroll
                    for (int n = 0; n < 2; ++n) epi(row0 + ai * HALF + m * 16, col0 + bj * HALF + n * 16, acc[ai][bj][m][n]);
    }
};
}
template <int K, int LDA, class Epi>
__device__ __forceinline__ void ph_gemm_fast(LAS unsigned char* lds, const bf16_t* A, const bf16_t* Bt, int N, const Epi& epi) {
    const fg::DenseProb<K, LDA, Epi> pb(A, Bt, N, epi);
    fg::gemm_phase(lds, pb);
}


namespace fg {
struct MoeUnit { int e, mblk, pn, rowoff, M; };
template <bool FIRST>
struct MoeProb {
    static constexpr int K = 1024, NCOL = FIRST ? 8 : 4;
    typedef MoeUnit Unit;
    const Params& P; int layer; const LAS int* tab;
    int G, c; mutable int e_, acc_, off_;
    __device__ __forceinline__ MoeProb(const Params& P_, int layer_, const LAS int* tab_) : P(P_), layer(layer_), tab(tab_), G(gridDim.x), c(blockIdx.x), e_(0), acc_(0), off_(0) {}
    __device__ __forceinline__ bool next(int i, Unit& u) const {
        const int L = i * G + c, tile = L / NCOL;
        while (e_ < 32) { const int tl = (tab[e_] + 255) >> 8; if (tile < acc_ + tl) break; acc_ += tl; off_ += tl * 256; ++e_; }
        if (e_ >= 32) return false;
        u.e = e_; u.mblk = tile - acc_; u.pn = L % NCOL; u.rowoff = off_; u.M = tab[e_]; return true;
    }
    __device__ __forceinline__ const char* a_base() const { return FIRST ? (const char*)(P.ws + WS_HB) : (const char*)(P.ws + WS_BIG); }
    __device__ __forceinline__ unsigned a_off(const Unit& u, int r) const {
        if (FIRST) { int rr = u.mblk * 256 + r; rr = rr < u.M ? rr : u.M - 1; const int ts = ((const int*)(P.ws + WS_LIST))[(size_t)u.e * T + rr]; return (unsigned)(ts >> 2) * 2048u; }
        return (unsigned)(u.rowoff + u.mblk * 256 + r) * 2048u;
    }
    __device__ __forceinline__ const char* b_base(const Unit& u) const {
        return FIRST ? (const char*)(P.ws + WS_W1) + ((size_t)u.e * 2048 + (size_t)u.pn * 256) * 2048 : (const char*)(P.ws + WS_W2) + ((size_t)u.e * 1024 + (size_t)u.pn * 256) * 2048;
    }
    __device__ __forceinline__ void epilogue(const f32x4 (&acc)[2][2][4][2], const Unit& u, int wr, int wc, int fr, int fq) const {
        char* ws = P.ws; const int* list = (const int*)(ws + WS_LIST) + (size_t)u.e * T; const int rl0 = u.mblk * 256 + wr * 64 + fr;
        if (FIRST) {
            const EpiMoe1 ep{list, (const float*)(ws + WS_RSTD) + T, P.moe_bg + ((size_t)layer * 32 + u.e) * 1024, P.moe_bu + ((size_t)layer * 32 + u.e) * 1024, (bf16_t*)(ws + WS_BIG) + (size_t)u.rowoff * 1024};
            const int hc0 = u.pn * 128 + wc * 32 + 4 * fq;
#pragma unroll
            for (int ai = 0; ai < 2; ++ai)
#pragma unroll
                for (int m = 0; m < 4; ++m) { const int r = rl0 + ai * HALF + m * 16;
                    if (r < u.M) {
#pragma unroll
                        for (int n = 0; n < 2; ++n) ep(r, hc0 + n * 16, acc[ai][0][m][n], acc[ai][1][m][n]); } }
        } else {
            const EpiMoe2 ep{list, (const float*)(ws + WS_TOPG), P.moe_bd + ((size_t)layer * 32 + u.e) * 1024, (bf16_t*)(ws + WS_Y)};
            const int col0 = u.pn * 256 + wc * 32 + 4 * fq;
#pragma unroll
            for (int ai = 0; ai < 2; ++ai)
#pragma unroll
                for (int m = 0; m < 4; ++m) { const int r = rl0 + ai * HALF + m * 16;
                    if (r < u.M) {
#pragma unroll
                        for (int bj = 0; bj < 2; ++bj)
#pragma unroll
                            for (int n = 0; n < 2; ++n) ep(r, col0 + bj * HALF + n * 16, acc[ai][bj][m][n]); } }
        }
    }
};
}
template <bool FIRST>
__device__ __forceinline__ void ph_moe_fast(const Params& P, int layer, LAS unsigned char* lds) {
    LAS int* tab = (LAS int*)(lds + fg::STAGE_BYTES);
    const int tz = opaque_tid();
    if (tz < 32) tab[tz] = (int)((const unsigned*)(P.ws + WS_CTL))[CTL_CNT + layer * 32 + tz];
    __syncthreads();
    const fg::MoeProb<FIRST> pb(P, layer, tab);
    fg::gemm_phase(lds, pb);
}

template <class Epi>
__device__ __forceinline__ void ph_gemm_dense(const bf16_t* A, int lda, const bf16_t* Bt, int N, int K, const Epi& epi) {
    const int ncol = N / 128, nunits = (T / 256) * ncol;
    for (int u = blockIdx.x; u < nunits; u += gridDim.x) gemm_simple_unit<Epi, false>(A, lda, nullptr, Bt, K, T, K, u / ncol, u % ncol, epi);
}
__device__ __forceinline__ bool moe_decode(const unsigned* cnt, int ncol, int u, int& e, int& mblk, int& nblk, int& rowoff) {
    int acc = 0, off = 0;
    for (int i = 0; i < 32; ++i) {
        const int tl = ((int)cnt[i] + 255) >> 8;
        if (u < (acc + tl) * ncol) { e = i; const int local = u - acc * ncol; mblk = local / ncol; nblk = local % ncol; rowoff = off; return true; }
        acc += tl; off += tl * 256;
    }
    return false;
}
__device__ __forceinline__ void ph_moe1(const Params& P, int layer) {
    char* ws = P.ws; const unsigned* cnt = (const unsigned*)(ws + WS_CTL) + CTL_CNT + layer * 32;
    for (int u = blockIdx.x;; u += gridDim.x) {
        int e, mblk, nblk, off; if (!moe_decode(cnt, 16, u, e, mblk, nblk, off)) break;
        const int* list = (const int*)(ws + WS_LIST) + (size_t)e * T;
        EpiMoe1 ep{list, (const float*)(ws + WS_RSTD) + T, P.moe_bg + ((size_t)layer * 32 + e) * 1024, P.moe_bu + ((size_t)layer * 32 + e) * 1024, (bf16_t*)(ws + WS_BIG) + (size_t)off * 1024};
        gemm_simple_unit<EpiMoe1, true>((const bf16_t*)(ws + WS_HB), 1024, list, (const bf16_t*)(ws + WS_W1) + (size_t)e * 2048 * 1024, 1024, (int)cnt[e], 1024, mblk, nblk, ep);
    }
}
__device__ __forceinline__ void ph_moe2(const Params& P, int layer) {
    char* ws = P.ws; const unsigned* cnt = (const unsigned*)(ws + WS_CTL) + CTL_CNT + layer * 32;
    for (int u = blockIdx.x;; u += gridDim.x) {
        int e, mblk, nblk, off; if (!moe_decode(cnt, 8, u, e, mblk, nblk, off)) break;
        const int* list = (const int*)(ws + WS_LIST) + (size_t)e * T;
        EpiMoe2 ep{list, (const float*)(ws + WS_TOPG), P.moe_bd + ((size_t)layer * 32 + e) * 1024, (bf16_t*)(ws + WS_Y)};
        gemm_simple_unit<EpiMoe2, false>((const bf16_t*)(ws + WS_BIG) + (size_t)off * 1024, 1024, nullptr, (const bf16_t*)(ws + WS_W2) + (size_t)e * 1024 * 1024, 1024, (int)cnt[e], 1024, mblk, nblk, ep);
    }
}

__device__ __forceinline__ void ph_attn_simple(const Params& P, unsigned char* lds) {
    float (*qs)[96] = (float (*)[96])lds; float (*ps)[64] = (float (*)[64])(lds + 8 * 96 * 4);
    const int tid = opaque_tid(), wid = tid >> 6, lane = tid & 63;
    const bf16_t* Q = (const bf16_t*)(P.ws + WS_BIG + BIG_Q); const bf16_t* Kd = (const bf16_t*)(P.ws + WS_BIG + BIG_K); const bf16_t* KV = (const bf16_t*)(P.ws + WS_BIG + BIG_KV);
    bf16_t* YM = (bf16_t*)(P.ws + WS_YMIX);
    for (int u = blockIdx.x; u < T; u += gridDim.x) {
        const long gw = (long)u * 8 + wid;
        const int s = (int)(gw & 4095), bh = (int)(gw >> 12), b = bh >> 3, h = bh & 7;
        const long t = (long)b * SEQ + s;
        __syncthreads();
        qs[wid][lane] = bf2f(Q[t * 768 + h * 96 + lane]);
        if (lane < 32) qs[wid][64 + lane] = bf2f(Q[t * 768 + h * 96 + 64 + lane]);
        __syncthreads();
        float m = -INFINITY, l = 0.f, o = 0.f;
        for (int j0 = 0; j0 <= s; j0 += 64) {
            const int j = j0 + lane; const bool valid = j <= s;
            const long kt = (long)b * SEQ + (valid ? j : s);
            const uint4* kr = (const uint4*)(Kd + (kt * 8 + h) * 96);
            float sc = 0.f;
#pragma unroll
            for (int c = 0; c < 12; ++c) {
                const uint4 kk = kr[c];
                sc += qs[wid][c * 8 + 0] * bf2f(kk.x & 0xffff) + qs[wid][c * 8 + 1] * bf2f(kk.x >> 16) + qs[wid][c * 8 + 2] * bf2f(kk.y & 0xffff) + qs[wid][c * 8 + 3] * bf2f(kk.y >> 16)
                    + qs[wid][c * 8 + 4] * bf2f(kk.z & 0xffff) + qs[wid][c * 8 + 5] * bf2f(kk.z >> 16) + qs[wid][c * 8 + 6] * bf2f(kk.w & 0xffff) + qs[wid][c * 8 + 7] * bf2f(kk.w >> 16);
            }
            sc = valid ? sc : -INFINITY;
            const float mn = fmaxf(m, wave_max(sc));
            const float pj = valid ? __expf(sc - mn) : 0.f;
            const float f = __expf(m - mn);
            l = l * f + wave_sum(pj); o *= f; m = mn;
            __syncthreads();
            ps[wid][lane] = pj;
            __syncthreads();
            const bf16_t* vb = KV + ((long)b * SEQ + j0) * 1024 + h * 128 + 64 + lane;
#pragma unroll 8
            for (int jj = 0; jj < 64; ++jj) o += ps[wid][jj] * bf2f(vb[(long)jj * 1024]);
        }
        YM[t * 1024 + 256 + h * 64 + lane] = f2bf(o / l);
    }
}


namespace at {
typedef float f32x16 __attribute__((ext_vector_type(16)));
typedef short s16x4 __attribute__((ext_vector_type(4)));
constexpr int KSLOT = 12288, VSLOT = 8192, NSLOT = 3, LDS_K = 0, LDS_V = NSLOT * KSLOT, LDS_END = LDS_V + NSLOT * VSLOT;
typedef float f32x2_t __attribute__((ext_vector_type(2))); typedef __bf16 bf16x2_t __attribute__((ext_vector_type(2)));
__device__ __forceinline__ unsigned cvtpk(float lo, float hi) { const f32x2_t v = {lo, hi}; const bf16x2_t b = __builtin_convertvector(v, bf16x2_t); return __builtin_bit_cast(unsigned, b); }
__device__ __forceinline__ void glds16(const void* gsrc, unsigned lds_dst) { unsigned keep;
    asm volatile("s_mov_b32 %0, m0\n\ts_mov_b32 m0, %2\n\ts_nop 0\n\tglobal_load_lds_dwordx4 %1, off\n\ts_mov_b32 m0, %0" : "=&s"(keep) : "v"(gsrc), "s"(lds_dst) : "memory"); }
__device__ __forceinline__ s16x4 vtr(const LAS unsigned char* p) { return __builtin_bit_cast(s16x4, __builtin_amdgcn_ds_read_tr16_b64_v4i16((LAS s16x4*)p)); }
__device__ __forceinline__ float xhalf_max(float v) { auto rr = __builtin_amdgcn_permlane32_swap(__float_as_uint(v), __float_as_uint(v), false, false); return fmaxf(__uint_as_float(rr[0]), __uint_as_float(rr[1])); }
__device__ __forceinline__ float xhalf_sum(float v) { auto rr = __builtin_amdgcn_permlane32_swap(__float_as_uint(v), __float_as_uint(v), false, false); return __uint_as_float(rr[0]) + __uint_as_float(rr[1]); }

__device__ __forceinline__ void attn_unit(int b, int h, int qb, const bf16_t* Q, const bf16_t* Kd, const bf16_t* KV, bf16_t* YM, LAS unsigned char* lds) {
    const int tid = opaque_tid(); const int lane = tid & 63, r32 = lane & 31, hi = lane >> 5; const int wid = __builtin_amdgcn_readfirstlane(tid >> 6);
    const int q0 = qb * 256; const size_t row = (size_t)b * SEQ + q0 + wid * 32 + r32;
    const int NT = 4 * qb + 4;
    const char* ksrcA = (const char*)(Kd + (((size_t)b * SEQ + lane) * 8 + h) * 96) + wid * 16;
    const char* ksrcB = (const char*)(Kd + (((size_t)b * SEQ + lane) * 8 + h) * 96) + (8 + (wid & 3)) * 16;
    const char* vsrc = (const char*)(KV + ((size_t)b * SEQ + 16 * (wid & 3) + (lane >> 2)) * 1024 + h * 128 + 64 + (wid >> 2) * 32 + (lane & 3) * 8);
    const unsigned lds0 = (unsigned)(size_t)lds;
#define AT_DMA(j, slot) do { \
        glds16(ksrcA + (size_t)(j) * (64 * 1536), (unsigned)__builtin_amdgcn_readfirstlane((int)(lds0 + LDS_K + (slot) * KSLOT + wid * 1024))); \
        glds16(ksrcB + (size_t)(j) * (64 * 1536), (unsigned)__builtin_amdgcn_readfirstlane((int)(lds0 + LDS_K + (slot) * KSLOT + (8 + (wid & 3)) * 1024))); \
        glds16(vsrc + (size_t)(j) * (64 * 2048), (unsigned)__builtin_amdgcn_readfirstlane((int)(lds0 + LDS_V + (slot) * VSLOT + wid * 1024))); } while (0)
    AT_DMA(0, 0); AT_DMA(1, 1);
    bf16x8 qf[6];
#pragma unroll
    for (int ks = 0; ks < 6; ++ks) qf[ks] = *(const bf16x8*)(Q + row * 768 + h * 96 + ks * 16 + hi * 8);
    asm volatile("" : "+v"(qf[0]), "+v"(qf[1]), "+v"(qf[2]), "+v"(qf[3]), "+v"(qf[4]), "+v"(qf[5]));
    float m = -INFINITY, l = 0.f;
    f32x16 o0, o1;
#pragma unroll
    for (int r = 0; r < 16; ++r) { o0[r] = 0.f; o1[r] = 0.f; }
    const int kfo = hi * 1024 + r32 * 16;
    const int vfo = ((lane >> 4) & 1) * 32 + (lane & 3) * 8 + (4 * hi + ((lane & 15) >> 2)) * 64;
    const int qrel = wid * 32 + r32;
    int slot = 0;
    for (int j = 0; j < NT; ++j) {
        if (j + 1 < NT) asm volatile("s_waitcnt vmcnt(3)\n\ts_barrier" ::: "memory"); else asm volatile("s_waitcnt vmcnt(0)\n\ts_barrier" ::: "memory");
        if (j + 2 < NT) { const int s2 = (slot == 0) ? 2 : slot - 1; AT_DMA(j + 2, s2); }
        const LAS unsigned char* kp = lds + LDS_K + slot * KSLOT + kfo;
        const LAS unsigned char* vp = lds + LDS_V + slot * VSLOT + vfo;
        f32x16 s0, s1;
#pragma unroll
        for (int r = 0; r < 16; ++r) { s0[r] = 0.f; s1[r] = 0.f; }
#pragma unroll
        for (int ks = 0; ks < 6; ++ks) {
            const bf16x8 k0 = *(const LAS bf16x8*)(kp + ks * 2048), k1 = *(const LAS bf16x8*)(kp + ks * 2048 + 512);
            s0 = __builtin_amdgcn_mfma_f32_32x32x16_bf16(k0, qf[ks], s0, 0, 0, 0);
            s1 = __builtin_amdgcn_mfma_f32_32x32x16_bf16(k1, qf[ks], s1, 0, 0, 0);
        }
        if (j >= NT - 4) {
            const int kb = 64 * (j - (NT - 4)) + 4 * hi;
#pragma unroll
            for (int r = 0; r < 16; ++r) { const int kv = kb + (r & 3) + 8 * (r >> 2); if (kv > qrel) s0[r] = -INFINITY; if (kv + 32 > qrel) s1[r] = -INFINITY; }
        }
        float mt = fmaxf(s0[0], s1[0]);
#pragma unroll
        for (int r = 1; r < 16; ++r) mt = fmaxf(mt, fmaxf(s0[r], s1[r]));
        mt = xhalf_max(mt);
        const float mn = fmaxf(m, mt);
        const float f = __builtin_amdgcn_exp2f(m - mn);
        float ps = 0.f;
#pragma unroll
        for (int r = 0; r < 16; ++r) { s0[r] = __builtin_amdgcn_exp2f(s0[r] - mn); s1[r] = __builtin_amdgcn_exp2f(s1[r] - mn); ps += s0[r] + s1[r]; }
        l = l * f + ps; m = mn;
#pragma unroll
        for (int r = 0; r < 16; ++r) { o0[r] *= f; o1[r] *= f; }
        bf16x8 pf[4];
        {
            unsigned w[16];
#pragma unroll
            for (int i = 0; i < 8; ++i) { w[i] = cvtpk(s0[2 * i], s0[2 * i + 1]); w[8 + i] = cvtpk(s1[2 * i], s1[2 * i + 1]); }
#pragma unroll
            for (int k = 0; k < 4; ++k) { typedef unsigned u32x4 __attribute__((ext_vector_type(4))); const u32x4 t = {w[4 * k], w[4 * k + 1], w[4 * k + 2], w[4 * k + 3]}; pf[k] = __builtin_bit_cast(bf16x8, t); }
        }
#pragma unroll
        for (int k = 0; k < 4; ++k) {
            const s16x4 a0 = vtr(vp + k * 1024), a1 = vtr(vp + k * 1024 + 512), c0 = vtr(vp + 4096 + k * 1024), c1 = vtr(vp + 4096 + k * 1024 + 512);
            const bf16x8 v0 = {a0[0], a0[1], a0[2], a0[3], a1[0], a1[1], a1[2], a1[3]}, v1 = {c0[0], c0[1], c0[2], c0[3], c1[0], c1[1], c1[2], c1[3]};
            o0 = __builtin_amdgcn_mfma_f32_32x32x16_bf16(v0, pf[k], o0, 0, 0, 0);
            o1 = __builtin_amdgcn_mfma_f32_32x32x16_bf16(v1, pf[k], o1, 0, 0, 0);
        }
        slot = (slot == 2) ? 0 : slot + 1;
    }
    l = xhalf_sum(l);
    const float rl = 1.0f / l;
    bf16_t* op = YM + row * 1024 + 256 + h * 64 + 4 * hi;
#pragma unroll
    for (int g = 0; g < 4; ++g) {
        *(uint2*)(op + 8 * g) = make_uint2(cvtpk(o0[4 * g] * rl, o0[4 * g + 1] * rl), cvtpk(o0[4 * g + 2] * rl, o0[4 * g + 3] * rl));
        *(uint2*)(op + 32 + 8 * g) = make_uint2(cvtpk(o1[4 * g] * rl, o1[4 * g + 1] * rl), cvtpk(o1[4 * g + 2] * rl, o1[4 * g + 3] * rl));
    }
    asm volatile("s_waitcnt lgkmcnt(0)\n\ts_barrier" ::: "memory");
#undef AT_DMA
}
}
__device__ __forceinline__ void ph_attn_fast(const Params& P, LAS unsigned char* lds) {
    const bf16_t* Q = (const bf16_t*)(P.ws + WS_BIG + BIG_Q); const bf16_t* Kd = (const bf16_t*)(P.ws + WS_BIG + BIG_K); const bf16_t* KV = (const bf16_t*)(P.ws + WS_BIG + BIG_KV);
    bf16_t* YM = (bf16_t*)(P.ws + WS_YMIX);
    const int G = gridDim.x;
    for (int v0 = (blockIdx.x % 8) * (G / 8) + blockIdx.x / 8; v0 < 256; v0 += G) {
        const int bh = v0 >> 2, s = v0 & 3;
#pragma unroll 1
        for (int i = 0; i < 4; ++i) { const int qb = (i == 0) ? s : (i == 1) ? 7 - s : (i == 2) ? 8 + s : 15 - s; at::attn_unit(bh >> 3, bh & 7, qb, Q, Kd, KV, YM, lds); }
    }
}


__device__ __forceinline__ void ph_gla_x(const Params& P, LAS unsigned char* lds) {
    const int tid = opaque_tid(); const int wid = __builtin_amdgcn_readfirstlane(tid >> 6), lane = tid & 63;
    LAS float* kend = (LAS float*)(lds + wid * 8192);
    const bf16_t* Z = (const bf16_t*)(P.ws + WS_BIG + BIG_Z); float* LA = (float*)(P.ws + WS_BIG + BIG_LA);
    float* UPD = (float*)(P.ws + WS_UPD); float* DEC = (float*)(P.ws + WS_DEC);
    for (int u = blockIdx.x * NWV + wid; u < 2048; u += gridDim.x * NWV) {
        const int bh = u >> 6, n = u & 63, b = bh >> 2, h = bh & 3;
        const size_t t0 = (size_t)b * SEQ + n * 64;
        const int k = lane & 31, half = lane >> 5;
        float c[32]; float run = 0.f;
#pragma unroll
        for (int i = 0; i < 32; ++i) { run += LA[(t0 + 32 * half + i) * 128 + h * 32 + k]; c[i] = run; }
        const float tot0 = __shfl(run, k);
        const float add = half ? tot0 : 0.f;
        const float blast = __shfl(run, 32 + k) + tot0;
#pragma unroll
        for (int i = 0; i < 32; ++i) {
            const float bc = c[i] + add; const size_t t = t0 + 32 * half + i;
            LA[t * 128 + h * 32 + k] = bc;
            kend[(32 * half + i) * 32 + k] = bf2f(Z[t * ZW + ZC_GK + h * 32 + k]) * __expf(blast - bc);
        }
        if (half == 0) DEC[(size_t)u * 32 + k] = __expf(blast);
        asm volatile("s_waitcnt lgkmcnt(0)" ::: "memory");
        float acc[32];
#pragma unroll
        for (int i = 0; i < 32; ++i) acc[i] = 0.f;
#pragma unroll 4
        for (int j = 0; j < 64; ++j) {
            const float vj = bf2f(Z[(t0 + j) * ZW + ZC_GV + h * 64 + lane]);
#pragma unroll
            for (int kq = 0; kq < 8; ++kq) { const f32x4 ke = *(const LAS f32x4*)(kend + j * 32 + kq * 4); acc[4 * kq] += ke[0] * vj; acc[4 * kq + 1] += ke[1] * vj; acc[4 * kq + 2] += ke[2] * vj; acc[4 * kq + 3] += ke[3] * vj; }
        }
#pragma unroll
        for (int kk = 0; kk < 32; ++kk) UPD[((size_t)u * 32 + kk) * 64 + lane] = acc[kk];
        asm volatile("s_waitcnt lgkmcnt(0)" ::: "memory");
    }
}
__device__ __forceinline__ void ph_gla_scan(const Params& P) {
    const int tz = opaque_tid();
    const float* UPD = (const float*)(P.ws + WS_UPD); const float* DEC = (const float*)(P.ws + WS_DEC); bf16_t* SP = (bf16_t*)(P.ws + WS_SPREV);
    for (int e = blockIdx.x * NTHR + tz; e < 32 * 2048; e += gridDim.x * NTHR) {
        const int bh = e >> 11, kv = e & 2047, k = kv >> 6;
        float st = 0.f;
#pragma unroll 8
        for (int n = 0; n < 64; ++n) {
            const size_t u = (size_t)bh * 64 + n;
            SP[u * 2048 + kv] = f2bf(st);
            st = DEC[u * 32 + k] * st + UPD[u * 2048 + kv];
        }
    }
}
__device__ __forceinline__ void ph_gla_y(const Params& P, int layer, LAS unsigned char* lds) {
    using at::f32x16; using at::s16x4; using at::vtr; using at::cvtpk;
    typedef unsigned u32x4 __attribute__((ext_vector_type(4)));
    const int tid = opaque_tid(); const int wid = __builtin_amdgcn_readfirstlane(tid >> 6), lane = tid & 63, r32 = lane & 31, hi = lane >> 5;
    LAS unsigned char* vl = lds + wid * 12288; LAS unsigned char* sl = vl + 8192;
    const bf16_t* Z = (const bf16_t*)(P.ws + WS_BIG + BIG_Z); const float* LA = (const float*)(P.ws + WS_BIG + BIG_LA); const bf16_t* SP = (const bf16_t*)(P.ws + WS_SPREV);
    bf16_t* YM = (bf16_t*)(P.ws + WS_YMIX); const float* gon = P.gla_on + layer * 64;
    const int vfo = ((lane >> 4) & 1) * 32 + (lane & 3) * 8 + (4 * hi + ((lane & 15) >> 2)) * 64;
    const int sfo = ((lane >> 4) & 1) * 32 + (lane & 3) * 8 + ((lane & 15) >> 2) * 64;
    for (int u = blockIdx.x * NWV + wid; u < 2048; u += gridDim.x * NWV) {
        const int bh = u >> 6, n = u & 63, b = bh >> 2, h = bh & 3;
        const size_t t0 = (size_t)b * SEQ + n * 64;
#pragma unroll
        for (int p = 0; p < 8; ++p) {
            const int row = 8 * p + (lane >> 3), dv = 8 * (lane & 7);
            const u32x4 x = *(const u32x4*)(Z + (t0 + row) * ZW + ZC_GV + h * 64 + dv);
            *(LAS u32x4*)(vl + (dv >> 5) * 4096 + (row >> 3) * 512 + (row & 7) * 64 + (dv & 31) * 2) = x;
        }
#pragma unroll
        for (int p = 0; p < 4; ++p) {
            const int row = 8 * p + (lane >> 3), dv = 8 * (lane & 7);
            const u32x4 x = *(const u32x4*)(SP + ((size_t)u * 32 + row) * 64 + dv);
            *(LAS u32x4*)(sl + (dv >> 5) * 2048 + (row >> 3) * 512 + (row & 7) * 64 + (dv & 31) * 2) = x;
        }
        bf16x8 qfr[2][2], kfr[2][2];
#pragma unroll
        for (int blk = 0; blk < 2; ++blk)
#pragma unroll
            for (int ks = 0; ks < 2; ++ks) {
                const size_t t = t0 + 32 * blk + r32; const int k0 = 16 * ks + 8 * hi;
                const uint4 qraw = *(const uint4*)(Z + t * ZW + ZC_GQ + h * 32 + k0), kraw = *(const uint4*)(Z + t * ZW + ZC_GK + h * 32 + k0);
                const f32x4 b0 = *(const f32x4*)(LA + t * 128 + h * 32 + k0), b1 = *(const f32x4*)(LA + t * 128 + h * 32 + k0 + 4);
                const unsigned qw[4] = {qraw.x, qraw.y, qraw.z, qraw.w}, kw[4] = {kraw.x, kraw.y, kraw.z, kraw.w};
                const float bcv[8] = {b0[0], b0[1], b0[2], b0[3], b1[0], b1[1], b1[2], b1[3]};
                u32x4 qo, ko;
#pragma unroll
                for (int w = 0; w < 4; ++w) {
                    const float e0 = __expf(bcv[2 * w]), e1 = __expf(bcv[2 * w + 1]);
                    const float q0 = bf2f(qw[w] & 0xffff) * 0.17677669529663687f * e0, q1 = bf2f(qw[w] >> 16) * 0.17677669529663687f * e1;
                    const float k0f = bf2f(kw[w] & 0xffff) * __expf(-bcv[2 * w]), k1f = bf2f(kw[w] >> 16) * __expf(-bcv[2 * w + 1]);
                    qo[w] = cvtpk(q0, q1); ko[w] = cvtpk(k0f, k1f);
                }
                qfr[blk][ks] = __builtin_bit_cast(bf16x8, qo); kfr[blk][ks] = __builtin_bit_cast(bf16x8, ko);
            }
        f32x16 z16;
#pragma unroll
        for (int r = 0; r < 16; ++r) z16[r] = 0.f;
        f32x16 s00 = __builtin_amdgcn_mfma_f32_32x32x16_bf16(kfr[0][0], qfr[0][0], z16, 0, 0, 0); s00 = __builtin_amdgcn_mfma_f32_32x32x16_bf16(kfr[0][1], qfr[0][1], s00, 0, 0, 0);
        f32x16 s01 = __builtin_amdgcn_mfma_f32_32x32x16_bf16(kfr[0][0], qfr[1][0], z16, 0, 0, 0); s01 = __builtin_amdgcn_mfma_f32_32x32x16_bf16(kfr[0][1], qfr[1][1], s01, 0, 0, 0);
        f32x16 s11 = __builtin_amdgcn_mfma_f32_32x32x16_bf16(kfr[1][0], qfr[1][0], z16, 0, 0, 0); s11 = __builtin_amdgcn_mfma_f32_32x32x16_bf16(kfr[1][1], qfr[1][1], s11, 0, 0, 0);
#pragma unroll
        for (int r = 0; r < 16; ++r) { const int jl = (r & 3) + 8 * (r >> 2) + 4 * hi; if (jl > r32) { s00[r] = 0.f; s11[r] = 0.f; } }
        bf16x8 p00[2], p01[2], p11[2];
#pragma unroll
        for (int sp = 0; sp < 2; ++sp) {
            u32x4 a, c, d;
#pragma unroll
            for (int w = 0; w < 4; ++w) { a[w] = cvtpk(s00[8 * sp + 2 * w], s00[8 * sp + 2 * w + 1]); c[w] = cvtpk(s01[8 * sp + 2 * w], s01[8 * sp + 2 * w + 1]); d[w] = cvtpk(s11[8 * sp + 2 * w], s11[8 * sp + 2 * w + 1]); }
            p00[sp] = __builtin_bit_cast(bf16x8, a); p01[sp] = __builtin_bit_cast(bf16x8, c); p11[sp] = __builtin_bit_cast(bf16x8, d);
        }
        asm volatile("s_waitcnt lgkmcnt(0)" ::: "memory");
        f32x16 o[2][2];
#pragma unroll
        for (int vb = 0; vb < 2; ++vb) {
            o[vb][0] = z16; o[vb][1] = z16;
#pragma unroll
            for (int k2 = 0; k2 < 4; ++k2) {
                const s16x4 a0 = vtr(vl + vfo + vb * 4096 + k2 * 1024), a1 = vtr(vl + vfo + vb * 4096 + k2 * 1024 + 512);
                const bf16x8 vt = {a0[0], a0[1], a0[2], a0[3], a1[0], a1[1], a1[2], a1[3]};
                if (k2 < 2) { o[vb][0] = __builtin_amdgcn_mfma_f32_32x32x16_bf16(vt, p00[k2], o[vb][0], 0, 0, 0); o[vb][1] = __builtin_amdgcn_mfma_f32_32x32x16_bf16(vt, p01[k2], o[vb][1], 0, 0, 0); }
                else o[vb][1] = __builtin_amdgcn_mfma_f32_32x32x16_bf16(vt, p11[k2 - 2], o[vb][1], 0, 0, 0);
            }
#pragma unroll
            for (int ks = 0; ks < 2; ++ks) {
                const s16x4 a0 = vtr(sl + sfo + vb * 2048 + (2 * ks + hi) * 512), a1 = vtr(sl + sfo + vb * 2048 + (2 * ks + hi) * 512 + 256);
                const bf16x8 st = {a0[0], a0[1], a0[2], a0[3], a1[0], a1[1], a1[2], a1[3]};
                o[vb][0] = __builtin_amdgcn_mfma_f32_32x32x16_bf16(st, qfr[0][ks], o[vb][0], 0, 0, 0);
                o[vb][1] = __builtin_amdgcn_mfma_f32_32x32x16_bf16(st, qfr[1][ks], o[vb][1], 0, 0, 0);
            }
        }
#pragma unroll
        for (int ib = 0; ib < 2; ++ib) {
            const size_t t = t0 + 32 * ib + r32;
            float ss = 0.f;
#pragma unroll
            for (int r = 0; r < 16; ++r) ss += o[0][ib][r] * o[0][ib][r] + o[1][ib][r] * o[1][ib][r];
            ss = at::xhalf_sum(ss);
            const float rstd = rsqrtf(ss * (1.0f / 64.0f) + EPS);
#pragma unroll
            for (int vb = 0; vb < 2; ++vb)
#pragma unroll
                for (int g = 0; g < 4; ++g) {
                    const int v0 = 32 * vb + 8 * g + 4 * hi;
                    const uint2 rr = *(const uint2*)(Z + t * ZW + ZC_GR + h * 64 + v0); const f32x4 gn = *(const f32x4*)(gon + v0);
                    const float r0 = bf2f(rr.x & 0xffff), r1 = bf2f(rr.x >> 16), r2 = bf2f(rr.y & 0xffff), r3 = bf2f(rr.y >> 16);
                    const float y0 = o[vb][ib][4 * g] * rstd * gn[0] * r0 * sigmoidf_(r0), y1 = o[vb][ib][4 * g + 1] * rstd * gn[1] * r1 * sigmoidf_(r1);
                    const float y2 = o[vb][ib][4 * g + 2] * rstd * gn[2] * r2 * sigmoidf_(r2), y3 = o[vb][ib][4 * g + 3] * rstd * gn[3] * r3 * sigmoidf_(r3);
                    *(uint2*)(YM + t * 1024 + h * 64 + v0) = make_uint2(cvtpk(y0, y1), cvtpk(y2, y3));
                }
        }
        asm volatile("s_waitcnt lgkmcnt(0)" ::: "memory");
    }
}

__device__ __forceinline__ void ph_gla_simple(const Params& P, int layer, unsigned char* lds) {
    if (blockIdx.x >= 4) return;
    const int tz = opaque_tid(); const int wid = tz >> 6, lane = tz & 63;
    float (*sq)[32] = (float (*)[32])(lds + wid * 3072), (*sk)[32] = (float (*)[32])(lds + wid * 3072 + 1024), (*sa)[32] = (float (*)[32])(lds + wid * 3072 + 2048);
    const int bh = blockIdx.x * 8 + wid, b = bh >> 2, h = bh & 3;
    const bf16_t* Z = (const bf16_t*)(P.ws + WS_BIG + BIG_Z); const float* LA = (const float*)(P.ws + WS_BIG + BIG_LA); bf16_t* YM = (bf16_t*)(P.ws + WS_YMIX);
    const float g = P.gla_on[layer * 64 + lane];
    float st[32];
#pragma unroll
    for (int k = 0; k < 32; ++k) st[k] = 0.f;
    for (int c0 = 0; c0 < SEQ; c0 += 8) {
#pragma unroll
        for (int i = 0; i < 4; ++i) {
            const int idx = lane + 64 * i, sp = idx >> 5, k = idx & 31; const size_t t = (size_t)b * SEQ + c0 + sp;
            sq[sp][k] = bf2f(Z[t * ZW + ZC_GQ + h * 32 + k]) * 0.17677669529663687f;
            sk[sp][k] = bf2f(Z[t * ZW + ZC_GK + h * 32 + k]);
            sa[sp][k] = __expf(LA[t * 128 + h * 32 + k]);
        }
        float v[8], r[8];
#pragma unroll
        for (int sp = 0; sp < 8; ++sp) { const size_t t = (size_t)b * SEQ + c0 + sp; v[sp] = bf2f(Z[t * ZW + ZC_GV + h * 64 + lane]); r[sp] = bf2f(Z[t * ZW + ZC_GR + h * 64 + lane]); }
        __syncthreads();
#pragma unroll
        for (int sp = 0; sp < 8; ++sp) {
            float o = 0.f;
#pragma unroll
            for (int k = 0; k < 32; ++k) { st[k] = sa[sp][k] * st[k] + sk[sp][k] * v[sp]; o += sq[sp][k] * st[k]; }
            const float ss = wave_sum(o * o);
            const float on = o * rsqrtf(ss * (1.0f / 64.0f) + EPS) * g;
            const float rr = r[sp];
            YM[((size_t)b * SEQ + c0 + sp) * 1024 + h * 64 + lane] = f2bf(on * rr * sigmoidf_(rr));
        }
        __syncthreads();
    }
}

template <int L> __device__ __forceinline__ void layer_body(const Params& P, const XcdBarrier& bar, unsigned char* lds) {
    constexpr int l = L; char* ws = P.ws; LAS unsigned char* ldsl = (LAS unsigned char*)lds;
    const bf16_t* HB = (const bf16_t*)(ws + WS_HB); const float* RS = (const float*)(ws + WS_RSTD);
    bf16_t* Z = (bf16_t*)(ws + WS_BIG + BIG_Z);
    {
        const char* wsm = ws + WS_WSM + (size_t)l * WSM_STRIDE;
        ph_tconv(P.moe_wg + (size_t)l * 32 * 1024 * 1024, P.moe_wu + (size_t)l * 32 * 1024 * 1024, P.ffn_norm + l * 1024, (bf16_t*)(ws + WS_W1), 2048, 1024, 1024, 2, 32, 1024L * 1024, 2048L * 1024, lds);
        ph_tconv(P.moe_wd + (size_t)l * 32 * 1024 * 1024, nullptr, nullptr, (bf16_t*)(ws + WS_W2), 1024, 1024, 1024, 0, 32, 1024L * 1024, 1024L * 1024, lds);
        { EpiBf16 e{(bf16_t*)(ws + WS_E), 1024}; ph_gemm_fast<256, 256>(ldsl, (const bf16_t*)(ws + WS_PB) + (size_t)l * T * 256, (const bf16_t*)(wsm + WSM_WPLE), 1024, e); }
        { EpiZ e{Z, RS}; ph_gemm_fast<1024, 1024>(ldsl, HB, (const bf16_t*)(wsm + WSM_WIN), ZW, e); }
        xcd_barrier(bar);
        ph_prepB(P, l, lds);
        xcd_barrier(bar);
        { EpiBf16 e{(bf16_t*)(ws + WS_BIG + BIG_Q), 768}; ph_gemm_fast<256, ZW>(ldsl, Z + ZC_CQ, (const bf16_t*)(wsm + WSM_WUQ), 768, e); }
        { EpiBf16 e{(bf16_t*)(ws + WS_BIG + BIG_KV), 1024}; ph_gemm_fast<128, ZW>(ldsl, Z + ZC_CKV, (const bf16_t*)(wsm + WSM_WUKV), 1024, e); }
        __syncthreads();
        ph_gla_x(P, ldsl);
        xcd_barrier(bar);
        ph_prepD(P, l);
        ph_gla_scan(P);
        xcd_barrier(bar);
        ph_attn_fast(P, ldsl);
        ph_gla_y(P, l, ldsl);
        xcd_barrier(bar);
        { EpiResid e{l == 0 ? P.x : P.out, P.out}; ph_gemm_fast<1024, 1024>(ldsl, (const bf16_t*)(ws + WS_YMIX), (const bf16_t*)(wsm + WSM_WOUT), 1024, e); }
        xcd_barrier(bar);
        ph_router(P, l);
        xcd_barrier(bar);
        ph_moe_fast<true>(P, l, ldsl);
        xcd_barrier(bar);
        ph_moe_fast<false>(P, l, ldsl);
        xcd_barrier(bar);
        ph_combine(P);
        xcd_barrier(bar);
        { EpiPle e{(const bf16_t*)(ws + WS_E), RS + 2 * T, (bf16_t*)(ws + WS_YMIX)}; ph_gemm_fast<1024, 1024>(ldsl, HB, (const bf16_t*)(wsm + WSM_WPG), 1024, e); }
        xcd_barrier(bar);
        ph_final(P, l);
        xcd_barrier(bar);
    }
}

__global__ void __launch_bounds__(NTHR, 2) mega_fwd(Params P) {
    extern __shared__ __attribute__((aligned(16))) unsigned char lds[];
    char* ws = P.ws;
    if (threadIdx.x == 0) *(uint4*)(lds + LDS_BAR_OFF) = make_uint4(0u, 0u, 0u, 0u);
    __syncthreads();
    const XcdBarrier bar = xcd_barrier_post((unsigned*)(ws + WS_CTL), (volatile LAS unsigned*)(lds + LDS_BAR_OFF));
    const bf16_t* HB = (const bf16_t*)(ws + WS_HB); const float* RS = (const float*)(ws + WS_RSTD);
    bf16_t* Z = (bf16_t*)(ws + WS_BIG + BIG_Z);
    for (int l = 0; l < DEPTH; ++l) {
        char* wsm = ws + WS_WSM + (size_t)l * WSM_STRIDE;
        ph_tconv(P.w_in + (size_t)l * 1024 * 1456, nullptr, P.mix_norm + l * 1024, (bf16_t*)(wsm + WSM_WIN), ZW, 1024, 1456, 1, 1, 0, 0, lds);
        ph_tconv(P.w_uq + (size_t)l * 256 * 768, nullptr, P.q_norm + l * 256, (bf16_t*)(wsm + WSM_WUQ), 768, 256, 768, 0, 1, 0, 0, lds);
        ph_tconv(P.w_ukv + (size_t)l * 128 * 1024, nullptr, P.kv_norm + l * 128, (bf16_t*)(wsm + WSM_WUKV), 1024, 128, 1024, 0, 1, 0, 0, lds);
        ph_tconv(P.w_out + (size_t)l * 1024 * 1024, nullptr, nullptr, (bf16_t*)(wsm + WSM_WOUT), 1024, 1024, 1024, 0, 1, 0, 0, lds);
        ph_tconv(P.ple_wg + (size_t)l * 1024 * 1024, nullptr, P.ple_gn + l * 1024, (bf16_t*)(wsm + WSM_WPG), 1024, 1024, 1024, 0, 1, 0, 0, lds);
        ph_tconv(P.ple_wp + (size_t)l * 256 * 1024, nullptr, nullptr, (bf16_t*)(wsm + WSM_WPLE), 1024, 256, 1024, 0, 1, 0, 0, lds);
    }
    ph_conv_bf16(P.p, (bf16_t*)(ws + WS_PB), (long)2 * T * 256 / 8);
    ph_prep_router(P);
    ph_init_h(P);
    xcd_barrier(bar);
    layer_body<0>(P, bar, lds);
    layer_body<1>(P, bar, lds);
}

extern "C" void kernel_launch(void* const* d_in, const int* in_sizes, int n_in, void* d_out, int out_size, void* d_ws, size_t ws_size, hipStream_t stream) {
    if (n_in != 30 || ws_size < WS_END) { fprintf(stderr, "kernel_launch: need 30 inputs and %zu bytes of workspace (got %d, %zu)\n", (size_t)WS_END, n_in, ws_size); return; }
    static int grid = 0;
    if (!grid) {
        int dev = 0, cus = 0, per_cu = 0;
        if (hipGetDevice(&dev) != hipSuccess || hipDeviceGetAttribute(&cus, hipDeviceAttributeMultiprocessorCount, dev) != hipSuccess) { fprintf(stderr, "kernel_launch: device query failed\n"); return; }
        if (hipFuncSetAttribute((const void*)mega_fwd, hipFuncAttributeMaxDynamicSharedMemorySize, LDS_BYTES) != hipSuccess) { fprintf(stderr, "kernel_launch: hipFuncSetAttribute failed\n"); return; }
        if (hipOccupancyMaxActiveBlocksPerMultiprocessor(&per_cu, (const void*)mega_fwd, NTHR, LDS_BYTES) != hipSuccess || per_cu < 1) { fprintf(stderr, "kernel_launch: occupancy query says %d\n", per_cu); return; }
        grid = cus;
    }
    Params P{};
    P.x = (const float*)d_in[0]; P.p = (const float*)d_in[1]; P.pos = (const int*)d_in[2];
    P.mix_norm = (const float*)d_in[3]; P.w_in = (const float*)d_in[4]; P.gla_wg = (const float*)d_in[5]; P.gla_bg = (const float*)d_in[6]; P.gla_on = (const float*)d_in[7];
    P.q_norm = (const float*)d_in[8]; P.w_uq = (const float*)d_in[9]; P.kv_norm = (const float*)d_in[10]; P.w_ukv = (const float*)d_in[11]; P.qkq = (const float*)d_in[12]; P.qkk = (const float*)d_in[13];
    P.pool_w = (const float*)d_in[14]; P.pool_s = (const float*)d_in[15]; P.w_out = (const float*)d_in[16]; P.ffn_norm = (const float*)d_in[17]; P.router_w = (const float*)d_in[18]; P.router_b = (const float*)d_in[19];
    P.moe_wg = (const float*)d_in[20]; P.moe_bg = (const float*)d_in[21]; P.moe_wu = (const float*)d_in[22]; P.moe_bu = (const float*)d_in[23]; P.moe_wd = (const float*)d_in[24]; P.moe_bd = (const float*)d_in[25];
    P.ple_wp = (const float*)d_in[26]; P.ple_gn = (const float*)d_in[27]; P.ple_wg = (const float*)d_in[28]; P.ple_pn = (const float*)d_in[29];
    P.out = (float*)d_out; P.ws = (char*)d_ws;
    (void)hipMemsetAsync((char*)d_ws + WS_CTL, 0, 65536, stream);
    hipLaunchKernelGGL(mega_fwd, dim3(grid), dim3(NTHR), LDS_BYTES, stream, P);
}
```

```cpp
#include <hip/hip_runtime.h>
#include <cstdio>
#include <cstdint>

typedef unsigned short bf16_t;
typedef short bf16x8 __attribute__((ext_vector_type(8)));
typedef float f32x4 __attribute__((ext_vector_type(4)));

constexpr int T = 32768, DM = 1024, SEQ = 4096, NBATCH = 8, DEPTH = 2;
constexpr int ZW = 1536;
constexpr int ZC_CQ = 0, ZC_GV = 256, ZC_GR = 512, ZC_UP = 768, ZC_GQ = 1024, ZC_GK = 1152, ZC_CKV = 1280, ZC_KR = 1408, ZC_GLOW = 1440;
constexpr int NE = 32, TOPK = 4, DFF = 1024;
constexpr int HROWS = 139264;
constexpr float EPS = 1e-6f;

__host__ __device__ inline int zsrc(int n) {
    if (n < 256) return 784 + n;
    if (n < 512) return 256 + (n - 256);
    if (n < 768) return 528 + (n - 512);
    if (n < 1024) return 1200 + (n - 768);
    if (n < 1152) return n - 1024;
    if (n < 1280) return 128 + (n - 1152);
    if (n < 1408) return 1040 + (n - 1280);
    if (n < 1440) return 1168 + (n - 1408);
    if (n < 1456) return 512 + (n - 1440);
    return -1;
}

constexpr size_t MiB = 1024 * 1024;
constexpr size_t WS_CTL = 0;
constexpr size_t WS_HB = 1 * MiB;
constexpr size_t WS_RSTD = WS_HB + 64 * MiB;
constexpr size_t WS_WSM = WS_RSTD + 1 * MiB;
constexpr size_t WSM_WIN = 0, WSM_WUQ = 3 * MiB, WSM_WUKV = WSM_WUQ + 384 * 1024, WSM_WOUT = WSM_WUKV + 256 * 1024, WSM_WPG = WSM_WOUT + 2 * MiB,
                 WSM_WPLE = WSM_WPG + 2 * MiB, WSM_WR = WSM_WPLE + 512 * 1024, WSM_WPT = WSM_WR + 128 * 1024, WSM_STRIDE = WSM_WR + 128 * 1024 + 128 * 1024;
constexpr size_t WS_PB = WS_WSM + 2 * WSM_STRIDE;
constexpr size_t WS_W1 = WS_PB + 32 * MiB;
constexpr size_t WS_W2 = WS_W1 + 128 * MiB;
constexpr size_t WS_E = WS_W2 + 64 * MiB;
constexpr size_t WS_YMIX = WS_E + 64 * MiB;
constexpr size_t WS_Y = WS_YMIX + 64 * MiB;
constexpr size_t WS_UPD = WS_Y + 256 * MiB;
constexpr size_t WS_DEC = WS_UPD + 16 * MiB;
constexpr size_t WS_SPREV = WS_DEC + 1 * MiB;
constexpr size_t WS_TOPG = WS_SPREV + 8 * MiB;
constexpr size_t WS_LIST = WS_TOPG + 1 * MiB;
constexpr size_t WS_BIG = WS_LIST + 4 * MiB;
constexpr size_t BIG_Z = 0, BIG_Q = 96 * MiB, BIG_KV = BIG_Q + 48 * MiB, BIG_K = BIG_KV + 64 * MiB, BIG_LA = BIG_K + 48 * MiB;
constexpr size_t WS_ROPE = WS_BIG + 272 * MiB;
constexpr size_t WS_END = WS_ROPE + 4 * MiB;
constexpr int CTL_CNT = 4096;

__device__ __forceinline__ float bf2f(bf16_t v) { return __uint_as_float(((unsigned)v) << 16); }
__device__ __forceinline__ bf16_t f2bf(float f) { unsigned u = __float_as_uint(f); u += 0x7FFFu + ((u >> 16) & 1u); return (bf16_t)(u >> 16); }
__device__ __forceinline__ unsigned pack2(float lo, float hi) { return (unsigned)f2bf(lo) | ((unsigned)f2bf(hi) << 16); }
template <int CTRL> __device__ __forceinline__ float dppx(float v) { return __int_as_float(__builtin_amdgcn_update_dpp(0, __float_as_int(v), CTRL, 0xf, 0xf, true)); }
__device__ __forceinline__ float wave_sum(float v) {
    v += dppx<0xB1>(v); v += dppx<0x4E>(v); v += dppx<0x141>(v); v += dppx<0x140>(v);
    { auto rr = __builtin_amdgcn_permlane16_swap(__float_as_uint(v), __float_as_uint(v), false, false); v = __uint_as_float(rr[0]) + __uint_as_float(rr[1]); }
    { auto rr = __builtin_amdgcn_permlane32_swap(__float_as_uint(v), __float_as_uint(v), false, false); v = __uint_as_float(rr[0]) + __uint_as_float(rr[1]); }
    return v;
}
__device__ __forceinline__ float wave_max(float v) {
    v = fmaxf(v, dppx<0xB1>(v)); v = fmaxf(v, dppx<0x4E>(v)); v = fmaxf(v, dppx<0x141>(v)); v = fmaxf(v, dppx<0x140>(v));
    { auto rr = __builtin_amdgcn_permlane16_swap(__float_as_uint(v), __float_as_uint(v), false, false); v = fmaxf(__uint_as_float(rr[0]), __uint_as_float(rr[1])); }
    { auto rr = __builtin_amdgcn_permlane32_swap(__float_as_uint(v), __float_as_uint(v), false, false); v = fmaxf(__uint_as_float(rr[0]), __uint_as_float(rr[1])); }
    return v;
}
__device__ __forceinline__ float sigmoidf_(float x) { return 1.0f / (1.0f + __expf(-x)); }


#define XB_TMO      128
#define XB_XCNT(j)  (256  + 64 * (j))
#define XB_XSUB(j)  (1280 + 64 * (j))
#define XB_XGEN(j)  (2304 + 64 * (j))
#define XB_TOP      3328
#define XB_TOPGEN   3392
#define XCD_BAR_WORDS 3456
#define XB_SPIN_CAP (1u << 18)
#define LAS __attribute__((address_space(3)))

__device__ __forceinline__ unsigned xb_ld(unsigned* p)              { return __hip_atomic_load(p, __ATOMIC_RELAXED, __HIP_MEMORY_SCOPE_AGENT); }
__device__ __forceinline__ unsigned xb_add(unsigned* p, unsigned v) { return __hip_atomic_fetch_add(p, v, __ATOMIC_RELAXED, __HIP_MEMORY_SCOPE_AGENT); }
__device__ __forceinline__ unsigned xb_xcc_id() { return (unsigned)__builtin_amdgcn_s_getreg((3 << 11) | 20) & 0xFu; }
#define XB_SPIN(cond, bar) do { unsigned _sp = 0; while (cond) { __builtin_amdgcn_s_sleep(1); \
    if ((++_sp & 255u) == 0u) { if (xb_ld(&(bar)[XB_TMO])) break; if (_sp > XB_SPIN_CAP) { atomicAdd(&(bar)[XB_TMO], 1u); break; } } } } while (0)

struct XcdBarrier {
    unsigned* bar; unsigned x;
    volatile LAS unsigned* st;
};

__device__ __forceinline__ XcdBarrier xcd_barrier_post(unsigned* bar, volatile LAS unsigned* st) {
    XcdBarrier b; b.bar = bar; b.x = xb_xcc_id(); b.st = st;
    if (threadIdx.x == 0) (void)xb_add(&bar[XB_XCNT(b.x)], 1u);
    return b;
}
__device__ __forceinline__ void xcd_barrier_complete(unsigned* bar, unsigned x, unsigned& nloc, unsigned& nx) {
    const unsigned G = gridDim.x * gridDim.y * gridDim.z;
    unsigned sum, cnt, mine, sp = 0u;
    for (;;) {
        sum = 0u; cnt = 0u; mine = 0u;
#pragma unroll
        for (unsigned j = 0; j < 16; ++j) { const unsigned c = xb_ld(&bar[XB_XCNT(j)]); sum += c; cnt += (c > 0u) ? 1u : 0u; mine = (j == x) ? c : mine; }
        if (sum == G) break;
        __builtin_amdgcn_s_sleep(1);
        if ((++sp & 255u) == 0u) { if (xb_ld(&bar[XB_TMO])) break; if (sp > XB_SPIN_CAP) { atomicAdd(&bar[XB_TMO], 1u); break; } }
    }
    nloc = mine > 0u ? mine : 1u; nx = cnt > 0u ? cnt : 1u;
}

__device__ __forceinline__ void xcd_barrier1(const XcdBarrier& b) {
    asm volatile("s_waitcnt vmcnt(0)" ::: "memory");
    __syncthreads();
    if (threadIdx.x == 0) {
        unsigned* bar = b.bar;
        __builtin_amdgcn_s_waitcnt(0);
        unsigned nloc = b.st[0], nx = b.st[1];
        if (nloc == 0u) { xcd_barrier_complete(bar, b.x, nloc, nx); b.st[0] = nloc; b.st[1] = nx; }
        const unsigned old = xb_add(&bar[XB_XSUB(b.x)], 1u);
        const unsigned gen = old / nloc;
        if (old + 1u == (gen + 1u) * nloc) {
            __builtin_amdgcn_fence(__ATOMIC_RELEASE, "agent");
            asm volatile("s_waitcnt vmcnt(0)" ::: "memory");
            const unsigned og = xb_add(&bar[XB_TOP], 1u);
            const unsigned tg = og / nx;
            if (og + 1u == (tg + 1u) * nx) xb_add(&bar[XB_TOPGEN], 1u);
            else XB_SPIN(xb_ld(&bar[XB_TOPGEN]) == tg, bar);
            __builtin_amdgcn_fence(__ATOMIC_ACQUIRE, "agent");
            xb_add(&bar[XB_XGEN(b.x)], 1u);
            asm volatile("s_waitcnt vmcnt(0)" ::: "memory");
        } else {
            XB_SPIN(xb_ld(&bar[XB_XGEN(b.x)]) == gen, bar);
            __builtin_amdgcn_fence(__ATOMIC_ACQUIRE, "agent");
            asm volatile("s_waitcnt vmcnt(0)" ::: "memory");
        }
    }
    __syncthreads();
}

struct Params {
    const float *x, *p; const int* pos;
    const float *mix_norm, *w_in, *gla_wg, *gla_bg, *gla_on, *q_norm, *w_uq, *kv_norm, *w_ukv, *qkq, *qkk, *pool_w, *pool_s, *w_out, *ffn_norm, *router_w, *router_b,
        *moe_wg, *moe_bg, *moe_wu, *moe_bu, *moe_wd, *moe_bd, *ple_wp, *ple_gn, *ple_wg, *ple_pn;
    float* out; char* ws;
};


#ifdef DBL_BAR
__device__ __forceinline__ void xcd_barrier(const XcdBarrier& b) { xcd_barrier1(b); xcd_barrier1(b); }
#else
__device__ __forceinline__ void xcd_barrier(const XcdBarrier& b) { xcd_barrier1(b); }
#endif
constexpr int NTHR = 512, NWV = 8;
__device__ __forceinline__ int opaque_tid() { int t = threadIdx.x; asm volatile("" : "+v"(t)); return t; }
constexpr int LDS_BYTES = 147456;
constexpr int LDS_BAR_OFF = LDS_BYTES - 16;

__device__ __forceinline__ void ph_tconv(const float* src, const float* src2, const float* gain, bf16_t* dst, int N, int K, int ld_src, int mode, int nexp, long se, long de, unsigned char* lds) {
    const int tz = opaque_tid(); const int tid = tz & 255, half = tz >> 8, tx = tid & 63, ty = tid >> 6;
    float (*tile)[65] = (float (*)[65])(lds + half * 16640);
    const int nx = N / 64, ny = K / 64, nunits = nx * ny * nexp;
    for (int u0 = blockIdx.x * 2; u0 < nunits; u0 += gridDim.x * 2) {
        const int u = u0 + half; const int bx = u % nx, by = (u / nx) % ny, e = u / (nx * ny);
        const float* s1 = src + (long)e * se; const float* s2 = src2 ? src2 + (long)e * se : nullptr; bf16_t* d = dst + (long)e * de;
        const int n0 = bx * 64, k0 = by * 64, n = n0 + tx;
        const float* sp = s1; int col;
        if (mode == 0) col = n;
        else if (mode == 1) col = zsrc(n);
        else { const int tl = n >> 8, w = n & 255; if (w < 128) col = tl * 128 + w; else { col = tl * 128 + (w - 128); sp = s2; } }
#pragma unroll
        for (int i = 0; i < 16; ++i) {
            const int k = k0 + ty + 4 * i; float v = 0.f;
            if (col >= 0) v = sp[(long)k * ld_src + col];
            if (gain) v *= gain[k];
            tile[ty + 4 * i][tx] = v;
        }
        __syncthreads();
        const int nl = tid >> 2, ks = (tid & 3) * 16;
        unsigned w0 = pack2(tile[ks + 0][nl], tile[ks + 1][nl]), w1 = pack2(tile[ks + 2][nl], tile[ks + 3][nl]), w2 = pack2(tile[ks + 4][nl], tile[ks + 5][nl]), w3 = pack2(tile[ks + 6][nl], tile[ks + 7][nl]);
        unsigned w4 = pack2(tile[ks + 8][nl], tile[ks + 9][nl]), w5 = pack2(tile[ks + 10][nl], tile[ks + 11][nl]), w6 = pack2(tile[ks + 12][nl], tile[ks + 13][nl]), w7 = pack2(tile[ks + 14][nl], tile[ks + 15][nl]);
        uint4* o = (uint4*)(d + (long)(n0 + nl) * K + k0 + ks);
        o[0] = make_uint4(w0, w1, w2, w3); o[1] = make_uint4(w4, w5, w6, w7);
        __syncthreads();
    }
}
__device__ __forceinline__ void ph_conv_bf16(const float* src, bf16_t* dst, long n8) {
    const int tz = opaque_tid();
    for (long i = (long)blockIdx.x * NTHR + tz; i < n8; i += (long)gridDim.x * NTHR) {
        const float4 a = ((const float4*)src)[2 * i], b = ((const float4*)src)[2 * i + 1];
        ((uint4*)dst)[i] = make_uint4(pack2(a.x, a.y), pack2(a.z, a.w), pack2(b.x, b.y), pack2(b.z, b.w));
    }
}
__device__ __forceinline__ void ph_prep_router(const Params& P) {
    const int tz = opaque_tid();
    for (int i = blockIdx.x * NTHR + tz; i < 2 * 4 * 64 * 64; i += gridDim.x * NTHR) {
        const int l = i >> 14, g = (i >> 12) & 3, d = (i >> 6) & 63, c = i & 63;
        ((bf16_t*)(P.ws + WS_WSM + (size_t)l * WSM_STRIDE + WSM_WPT))[(g * 64 + d) * 64 + c] = f2bf(P.pool_w[(size_t)l * 16384 + (g * 64 + c) * 64 + d]);
    }
    for (int i = blockIdx.x * NTHR + tz; i < 2 * 32 * 1024; i += gridDim.x * NTHR) {
        const int l = i >> 15, e = (i >> 10) & 31, k = i & 1023;
        float* Wr = (float*)(P.ws + WS_WSM + (size_t)l * WSM_STRIDE + WSM_WR);
        Wr[e * 1024 + k] = P.router_w[((size_t)l * 1024 + k) * 32 + e] * P.ffn_norm[l * 1024 + k];
    }
}


__device__ __forceinline__ void ph_rope_table(const Params& P) {
    const int tz = opaque_tid();
    float* RT = (float*)(P.ws + WS_ROPE);
    for (int e = blockIdx.x * NTHR + tz; e < T * 16; e += gridDim.x * NTHR) {
        const int t = e >> 4, i = e & 15;
        const float inv = exp2f(-(float)(2 * i) * (1.0f / 32.0f) * 13.287712379549449f);
        const float ang = (float)P.pos[t] * inv;
        RT[(size_t)t * 32 + i] = cosf(ang); RT[(size_t)t * 32 + 16 + i] = sinf(ang);
    }
}

__device__ __forceinline__ void ph_init_h(const Params& P) {
    const int tz = opaque_tid(); const int wid = tz >> 6, lane = tz & 63;
    bf16_t* HB = (bf16_t*)(P.ws + WS_HB); float* RS = (float*)(P.ws + WS_RSTD);
    for (int t = blockIdx.x * NWV + wid; t < T; t += gridDim.x * NWV) {
        const float* hr = P.x + (size_t)t * 1024;
        float ss = 0.f; float4 v[4];
#pragma unroll
        for (int i = 0; i < 4; ++i) { v[i] = *(const float4*)(hr + i * 256 + lane * 4); ss += v[i].x * v[i].x + v[i].y * v[i].y + v[i].z * v[i].z + v[i].w * v[i].w; }
        ss = wave_sum(ss);
        if (lane == 0) RS[t] = rsqrtf(ss * (1.0f / 1024.0f) + EPS);
#pragma unroll
        for (int i = 0; i < 4; ++i) *(uint2*)(HB + (size_t)t * 1024 + i * 256 + lane * 4) = make_uint2(pack2(v[i].x, v[i].y), pack2(v[i].z, v[i].w));
    }
}

__device__ __forceinline__ void ph_prepB(const Params& P, int layer, unsigned char* lds) {
    float* wg = (float*)lds;
    const int tid = opaque_tid(), wid = tid >> 6, lane = tid & 63;
    for (int i = tid; i < 16 * 128; i += NTHR) wg[i] = P.gla_wg[(size_t)layer * 2048 + i];
    __syncthreads();
    bf16_t* Z = (bf16_t*)(P.ws + WS_BIG + BIG_Z); float* LA = (float*)(P.ws + WS_BIG + BIG_LA); bf16_t* YM = (bf16_t*)(P.ws + WS_YMIX);
    const float* bg = P.gla_bg + layer * 128; const float* psc = P.pool_s + layer * 256;
    const float bg0 = bg[lane], bg1 = bg[lane + 64];
    for (int t0 = (blockIdx.x * NWV + wid) * 2; t0 < T; t0 += gridDim.x * NWV * 2) {
        uint2 cq[2]; unsigned ckv[2]; float gl[2];
#pragma unroll
        for (int tt = 0; tt < 2; ++tt) { const bf16_t* zr = Z + (size_t)(t0 + tt) * ZW; cq[tt] = *(const uint2*)(zr + ZC_CQ + lane * 4); ckv[tt] = *(const unsigned*)(zr + ZC_CKV + lane * 2); gl[tt] = (lane < 16) ? bf2f(zr[ZC_GLOW + lane]) : 0.f; }
#pragma unroll
        for (int tt = 0; tt < 2; ++tt) {
            bf16_t* zr = Z + (size_t)(t0 + tt) * ZW;
            {
                const float a = bf2f(cq[tt].x & 0xffff), b = bf2f(cq[tt].x >> 16), c = bf2f(cq[tt].y & 0xffff), d = bf2f(cq[tt].y >> 16);
                const float r = rsqrtf(wave_sum(a * a + b * b + c * c + d * d) * (1.0f / 256.0f) + EPS);
                *(uint2*)(zr + ZC_CQ + lane * 4) = make_uint2(pack2(a * r, b * r), pack2(c * r, d * r));
            }
            {
                const float a = bf2f(ckv[tt] & 0xffff), b = bf2f(ckv[tt] >> 16);
                const float r = rsqrtf(wave_sum(a * a + b * b) * (1.0f / 128.0f) + EPS);
                *(unsigned*)(zr + ZC_CKV + lane * 2) = pack2(a * r, b * r);
            }
            {
                float l0 = bg0, l1 = bg1;
#pragma unroll
                for (int r = 0; r < 16; ++r) { const float g = __uint_as_float(__builtin_amdgcn_readlane(__float_as_uint(gl[tt]), r)); l0 += g * wg[r * 128 + lane]; l1 += g * wg[r * 128 + lane + 64]; }
                const float a0 = fminf(l0, 0.f) - log1pf(__expf(-fabsf(l0))), a1 = fminf(l1, 0.f) - log1pf(__expf(-fabsf(l1)));
                LA[(size_t)(t0 + tt) * 128 + lane] = a0 * (1.0f / 16.0f); LA[(size_t)(t0 + tt) * 128 + lane + 64] = a1 * (1.0f / 16.0f);
            }
        }
    }
    const bf16_t* WpT = (const bf16_t*)(P.ws + WS_WSM + (size_t)layer * WSM_STRIDE + WSM_WPT);
    const int fr = lane & 15, fq = lane >> 4;
    for (int u = blockIdx.x * NWV + wid; u < T / 16; u += gridDim.x * NWV) {
        const int t = u * 16 + fr, sq = t & (SEQ - 1);
#pragma unroll
        for (int gi = 0; gi < 4; ++gi) {
            const int w = 2 << gi; const int cnt = (sq + 1 < w) ? sq + 1 : w; const float rc = 1.0f / (float)cnt;
            bf16x8 af[2];
#pragma unroll
            for (int ks = 0; ks < 2; ++ks) {
                const bf16_t* up = Z + (size_t)t * ZW + ZC_UP + gi * 64 + ks * 32 + fq * 8;
                float acc[8], u0[8];
#pragma unroll
                for (int j = 0; j < 16; ++j) if (j < w) {
                    const int jj = (j < cnt) ? j : 0; const float msk = (j < cnt) ? 1.0f : 0.f;
                    const uint4 x = *(const uint4*)(up - (long)jj * ZW);
                    const float xv[8] = {bf2f(x.x & 0xffff), bf2f(x.x >> 16), bf2f(x.y & 0xffff), bf2f(x.y >> 16), bf2f(x.z & 0xffff), bf2f(x.z >> 16), bf2f(x.w & 0xffff), bf2f(x.w >> 16)};
#pragma unroll
                    for (int e = 0; e < 8; ++e) { if (j == 0) { u0[e] = xv[e]; acc[e] = xv[e]; } else acc[e] += msk * xv[e]; }
                }
                typedef unsigned u32x4 __attribute__((ext_vector_type(4)));
                const u32x4 pk = {pack2(acc[0] * rc - u0[0], acc[1] * rc - u0[1]), pack2(acc[2] * rc - u0[2], acc[3] * rc - u0[3]), pack2(acc[4] * rc - u0[4], acc[5] * rc - u0[5]), pack2(acc[6] * rc - u0[6], acc[7] * rc - u0[7])};
                af[ks] = __builtin_bit_cast(bf16x8, pk);
            }
#pragma unroll
            for (int nb = 0; nb < 4; ++nb) {
                f32x4 acc = {0.f, 0.f, 0.f, 0.f};
#pragma unroll
                for (int ks = 0; ks < 2; ++ks) { const bf16x8 bfr = *(const bf16x8*)(WpT + ((size_t)gi * 64 + nb * 16 + fr) * 64 + ks * 32 + fq * 8); acc = __builtin_amdgcn_mfma_f32_16x16x32_bf16(bfr, af[ks], acc, 0, 0, 0); }
                const int d0 = nb * 16 + fq * 4; const f32x4 sc = *(const f32x4*)(psc + gi * 64 + d0);
                *(uint2*)(YM + (size_t)t * 1024 + 768 + gi * 64 + d0) = make_uint2(pack2(acc[0] * sc[0], acc[1] * sc[1]), pack2(acc[2] * sc[2], acc[3] * sc[3]));
            }
        }
    }
}

__device__ __forceinline__ void ph_prepD(const Params& P, int layer) {
    const int tid = opaque_tid(), wid = tid >> 6, lane = tid & 63;
    bf16_t* Z = (bf16_t*)(P.ws + WS_BIG + BIG_Z); bf16_t* Q = (bf16_t*)(P.ws + WS_BIG + BIG_Q); const bf16_t* KV = (const bf16_t*)(P.ws + WS_BIG + BIG_KV); bf16_t* Kd = (bf16_t*)(P.ws + WS_BIG + BIG_K);
    const float* RT = (const float*)(P.ws + WS_ROPE);
    const float gq0 = P.qkq[layer * 96 + lane], gq1 = (lane < 32) ? P.qkq[layer * 96 + 64 + lane] : 0.f;
    const float gk0 = P.qkk[layer * 96 + lane], gk1 = (lane < 32) ? P.qkk[layer * 96 + 64 + lane] : 0.f;
    const float qscale = 0.10206207261596577f * 1.4426950408889634f;
    for (int t = blockIdx.x * NWV + wid; t < T; t += gridDim.x * NWV) {
        const float cs = RT[(size_t)t * 32 + (lane & 15)], sn = RT[(size_t)t * 32 + 16 + (lane & 15)];
        const float kr = (lane < 32) ? bf2f(Z[(size_t)t * ZW + ZC_KR + lane]) : 0.f;
        float qa[8], qb[8], ka[8];
#pragma unroll
        for (int h = 0; h < 8; ++h) {
            qa[h] = bf2f(Q[(size_t)t * 768 + h * 96 + lane]); qb[h] = (lane < 32) ? bf2f(Q[(size_t)t * 768 + h * 96 + 64 + lane]) : 0.f;
            ka[h] = bf2f(KV[(size_t)t * 1024 + h * 128 + lane]);
        }
#pragma unroll
        for (int h = 0; h < 8; ++h) {
            {
                const float r = rsqrtf(wave_sum(qa[h] * qa[h] + qb[h] * qb[h]) * (1.0f / 96.0f) + EPS);
                const float an = qa[h] * r * gq0, bn = qb[h] * r * gq1;
                const float partner = __shfl_xor(bn, 16);
                const float rot = (lane < 16) ? (bn * cs - partner * sn) : (bn * cs + partner * sn);
                Q[(size_t)t * 768 + h * 96 + lane] = f2bf(an * qscale);
                if (lane < 32) Q[(size_t)t * 768 + h * 96 + 64 + lane] = f2bf(rot * qscale);
            }
            {
                const float r = rsqrtf(wave_sum(ka[h] * ka[h] + kr * kr) * (1.0f / 96.0f) + EPS);
                const float an = ka[h] * r * gk0, bn = kr * r * gk1;
                const float partner = __shfl_xor(bn, 16);
                const float rot = (lane < 16) ? (bn * cs - partner * sn) : (bn * cs + partner * sn);
                bf16_t* kp = Kd + ((size_t)t * 8 + h) * 96;
                kp[lane] = f2bf(an);
                if (lane < 32) kp[64 + lane] = f2bf(rot);
            }
        }
    }
}

__device__ __forceinline__ void ph_router(const Params& P, int layer, LAS unsigned char* lds) {
    const int tid = opaque_tid(), wid = tid >> 6, lane = tid & 63;
    bf16_t* HB = (bf16_t*)(P.ws + WS_HB); float* RS1 = (float*)(P.ws + WS_RSTD) + T;
    const float* Wr = (const float*)(P.ws + WS_WSM + (size_t)layer * WSM_STRIDE + WSM_WR);
    const float* rb = P.router_b + layer * 32;
    unsigned* cnt = (unsigned*)(P.ws + WS_CTL) + CTL_CNT + layer * 32;
    int* LIST = (int*)(P.ws + WS_LIST); float* TOPG = (float*)(P.ws + WS_TOPG);
    LAS f32x4* wl = (LAS f32x4*)lds;
    for (int i = tid; i < 32 * 256; i += NTHR) wl[i] = *(const f32x4*)(Wr + (size_t)i * 4);
    __syncthreads();
    const float myb = rb[lane >> 1];
    for (int t0 = (blockIdx.x * NWV + wid) * 2; t0 < T; t0 += gridDim.x * NWV * 2) {
        f32x4 v[2][4]; float rstd[2];
#pragma unroll
        for (int tt = 0; tt < 2; ++tt) {
            const float* hr = P.out + (size_t)(t0 + tt) * 1024; float ss = 0.f;
#pragma unroll
            for (int i = 0; i < 4; ++i) { v[tt][i] = *(const f32x4*)(hr + i * 256 + lane * 4); ss += v[tt][i][0] * v[tt][i][0] + v[tt][i][1] * v[tt][i][1] + v[tt][i][2] * v[tt][i][2] + v[tt][i][3] * v[tt][i][3]; }
            ss = wave_sum(ss);
            rstd[tt] = rsqrtf(ss * (1.0f / 1024.0f) + EPS);
            if (lane == 0) RS1[t0 + tt] = rstd[tt];
#pragma unroll
            for (int i = 0; i < 4; ++i) *(uint2*)(HB + (size_t)(t0 + tt) * 1024 + i * 256 + lane * 4) = make_uint2(pack2(v[tt][i][0], v[tt][i][1]), pack2(v[tt][i][2], v[tt][i][3]));
        }
        float q0[16], q1[16];
        {
            const bool lo5 = !(lane & 32);
#pragma unroll
            for (int e = 0; e < 16; ++e) {
                float a0 = 0.f, a1 = 0.f, b0 = 0.f, b1 = 0.f;
#pragma unroll
                for (int i = 0; i < 4; ++i) {
                    const f32x4 w = wl[e * 256 + i * 64 + lane], x = wl[(e + 16) * 256 + i * 64 + lane];
                    a0 += v[0][i][0] * w[0] + v[0][i][1] * w[1] + v[0][i][2] * w[2] + v[0][i][3] * w[3];
                    a1 += v[1][i][0] * w[0] + v[1][i][1] * w[1] + v[1][i][2] * w[2] + v[1][i][3] * w[3];
                    b0 += v[0][i][0] * x[0] + v[0][i][1] * x[1] + v[0][i][2] * x[2] + v[0][i][3] * x[3];
                    b1 += v[1][i][0] * x[0] + v[1][i][1] * x[1] + v[1][i][2] * x[2] + v[1][i][3] * x[3];
                }
                q0[e] = (lo5 ? a0 : b0) + __shfl_xor(lo5 ? b0 : a0, 32);
                q1[e] = (lo5 ? a1 : b1) + __shfl_xor(lo5 ? b1 : a1, 32);
                asm volatile("" ::: "memory");
            }
        }
#define RT_STEP(src, dst, n, bit) do { const bool lo_ = !(lane & (bit)); _Pragma("unroll") for (int e_ = 0; e_ < (n); ++e_) { \
            const float mine_ = lo_ ? src[e_] : src[e_ + (n)], give_ = lo_ ? src[e_ + (n)] : src[e_]; dst[e_] = mine_ + __shfl_xor(give_, (bit)); } } while (0)
        float lg[2];
        {
            float r[8], s4[4], s2[2];
            RT_STEP(q0, r, 8, 16); RT_STEP(r, s4, 4, 8); RT_STEP(s4, s2, 2, 4);
            { const bool lo_ = !(lane & 2); const float mine_ = lo_ ? s2[0] : s2[1], give_ = lo_ ? s2[1] : s2[0]; float x = mine_ + __shfl_xor(give_, 2); x += __shfl_xor(x, 1); lg[0] = x * rstd[0] + myb; }
            RT_STEP(q1, r, 8, 16); RT_STEP(r, s4, 4, 8); RT_STEP(s4, s2, 2, 4);
            { const bool lo_ = !(lane & 2); const float mine_ = lo_ ? s2[0] : s2[1], give_ = lo_ ? s2[1] : s2[0]; float x = mine_ + __shfl_xor(give_, 2); x += __shfl_xor(x, 1); lg[1] = x * rstd[1] + myb; }
        }
#undef RT_STEP
#pragma unroll
        for (int tt = 0; tt < 2; ++tt) {
            float mylg = lg[tt]; float tv[4]; int ti[4];
#pragma unroll
            for (int k = 0; k < 4; ++k) {
                const float best = wave_max(mylg);
                const unsigned long long mask = __ballot(mylg == best);
                const int bi = (__ffsll((long long)mask) - 1) >> 1;
                tv[k] = best; ti[k] = bi;
                mylg = ((lane >> 1) == bi) ? -INFINITY : mylg;
            }
            const float e1 = __expf(tv[1] - tv[0]), e2 = __expf(tv[2] - tv[0]), e3 = __expf(tv[3] - tv[0]);
            const float invs = 1.0f / (1.0f + e1 + e2 + e3);
            if (lane < 4) {
                const int e = (lane == 0) ? ti[0] : (lane == 1) ? ti[1] : (lane == 2) ? ti[2] : ti[3];
                const float g = (lane == 0) ? invs : (lane == 1) ? e1 * invs : (lane == 2) ? e2 * invs : e3 * invs;
                const unsigned pos = atomicAdd(&cnt[e], 1u);
                LIST[(size_t)e * T + pos] = (t0 + tt) * 4 + lane;
                TOPG[(t0 + tt) * 4 + lane] = g;
            }
        }
    }
}

__device__ __forceinline__ void ph_combine(const Params& P) {
    const int tid = opaque_tid(), wid = tid >> 6, lane = tid & 63;
    bf16_t* HB = (bf16_t*)(P.ws + WS_HB); float* RS2 = (float*)(P.ws + WS_RSTD) + 2 * T; const bf16_t* Y = (const bf16_t*)(P.ws + WS_Y);
    for (int t0 = (blockIdx.x * NWV + wid) * 2; t0 < T; t0 += gridDim.x * NWV * 2) {
        f32x4 hv[2][4]; uint2 yv[2][4][4];
#pragma unroll
        for (int tt = 0; tt < 2; ++tt)
#pragma unroll
            for (int i = 0; i < 4; ++i) {
                hv[tt][i] = *(const f32x4*)(P.out + (size_t)(t0 + tt) * 1024 + i * 256 + lane * 4);
#pragma unroll
                for (int k = 0; k < 4; ++k) yv[tt][i][k] = *(const uint2*)(Y + ((size_t)(t0 + tt) * 4 + k) * 1024 + i * 256 + lane * 4);
            }
#pragma unroll
        for (int tt = 0; tt < 2; ++tt) {
            float ss = 0.f;
#pragma unroll
            for (int i = 0; i < 4; ++i) {
                f32x4 v = hv[tt][i];
#pragma unroll
                for (int k = 0; k < 4; ++k) { const uint2 y = yv[tt][i][k]; v[0] += bf2f(y.x & 0xffff); v[1] += bf2f(y.x >> 16); v[2] += bf2f(y.y & 0xffff); v[3] += bf2f(y.y >> 16); }
                *(f32x4*)(P.out + (size_t)(t0 + tt) * 1024 + i * 256 + lane * 4) = v;
                ss += v[0] * v[0] + v[1] * v[1] + v[2] * v[2] + v[3] * v[3];
                *(uint2*)(HB + (size_t)(t0 + tt) * 1024 + i * 256 + lane * 4) = make_uint2(pack2(v[0], v[1]), pack2(v[2], v[3]));
            }
            ss = wave_sum(ss);
            if (lane == 0) RS2[t0 + tt] = rsqrtf(ss * (1.0f / 1024.0f) + EPS);
        }
    }
}

__device__ __forceinline__ void ph_final(const Params& P, int layer) {
    const int tid = opaque_tid(), wid = tid >> 6, lane = tid & 63;
    bf16_t* HB = (bf16_t*)(P.ws + WS_HB); float* RS = (float*)(P.ws + WS_RSTD); const bf16_t* V = (const bf16_t*)(P.ws + WS_YMIX);
    const float* gp = P.ple_pn + layer * 1024;
    f32x4 g[4];
#pragma unroll
    for (int i = 0; i < 4; ++i) g[i] = *(const f32x4*)(gp + i * 256 + lane * 4);
    for (int t0 = (blockIdx.x * NWV + wid) * 2; t0 < T; t0 += gridDim.x * NWV * 2) {
        f32x4 hv[2][4]; uint2 yv[2][4];
#pragma unroll
        for (int tt = 0; tt < 2; ++tt)
#pragma unroll
            for (int i = 0; i < 4; ++i) { hv[tt][i] = *(const f32x4*)(P.out + (size_t)(t0 + tt) * 1024 + i * 256 + lane * 4); yv[tt][i] = *(const uint2*)(V + (size_t)(t0 + tt) * 1024 + i * 256 + lane * 4); }
#pragma unroll
        for (int tt = 0; tt < 2; ++tt) {
            f32x4 vv[4]; float ss = 0.f;
#pragma unroll
            for (int i = 0; i < 4; ++i) { const uint2 y = yv[tt][i]; vv[i] = (f32x4){bf2f(y.x & 0xffff), bf2f(y.x >> 16), bf2f(y.y & 0xffff), bf2f(y.y >> 16)}; ss += vv[i][0] * vv[i][0] + vv[i][1] * vv[i][1] + vv[i][2] * vv[i][2] + vv[i][3] * vv[i][3]; }
            ss = wave_sum(ss);
            const float r = rsqrtf(ss * (1.0f / 1024.0f) + EPS);
            float s2 = 0.f;
#pragma unroll
            for (int i = 0; i < 4; ++i) {
                const f32x4 v = hv[tt][i] + vv[i] * r * g[i];
                *(f32x4*)(P.out + (size_t)(t0 + tt) * 1024 + i * 256 + lane * 4) = v;
                s2 += v[0] * v[0] + v[1] * v[1] + v[2] * v[2] + v[3] * v[3];
                *(uint2*)(HB + (size_t)(t0 + tt) * 1024 + i * 256 + lane * 4) = make_uint2(pack2(v[0], v[1]), pack2(v[2], v[3]));
            }
            s2 = wave_sum(s2);
            if (lane == 0) RS[t0 + tt] = rsqrtf(s2 * (1.0f / 1024.0f) + EPS);
        }
    }
}

struct EpiZ { bf16_t* Z; const float* rstd;
    __device__ __forceinline__ void operator()(int r, int c, f32x4 v) const { const float s = rstd[r]; *(uint2*)(Z + (size_t)r * ZW + c) = make_uint2(pack2(v[0] * s, v[1] * s), pack2(v[2] * s, v[3] * s)); } };
struct EpiBf16 { bf16_t* O; int ldo;
    __device__ __forceinline__ void operator()(int r, int c, f32x4 v) const { *(uint2*)(O + (size_t)r * ldo + c) = make_uint2(pack2(v[0], v[1]), pack2(v[2], v[3])); } };
struct EpiResid { const float* hin; float* out;
    __device__ __forceinline__ void operator()(int r, int c, f32x4 v) const { const f32x4 b = *(const f32x4*)(hin + (size_t)r * 1024 + c); *(f32x4*)(out + (size_t)r * 1024 + c) = b + v; } };
struct EpiMoe1 { const int* list; const float* rstd1; const float* bg; const float* bu; bf16_t* H;
    __device__ __forceinline__ void operator()(int r, int hc, f32x4 g, f32x4 u) const {
        const float s = rstd1[list[r] >> 2]; const f32x4 b0 = *(const f32x4*)(bg + hc), b1 = *(const f32x4*)(bu + hc); float o[4];
#pragma unroll
        for (int j = 0; j < 4; ++j) { const float gg = fminf(g[j] * s + b0[j], 7.0f); const float uu = fminf(fmaxf(u[j] * s + b1[j], -7.0f), 7.0f); o[j] = (uu + 1.0f) * gg * sigmoidf_(1.702f * gg); }
        *(uint2*)(H + (size_t)r * 1024 + hc) = make_uint2(pack2(o[0], o[1]), pack2(o[2], o[3])); } };
struct EpiMoe2 { const int* list; const float* topg; const float* bd; bf16_t* Y;
    __device__ __forceinline__ void operator()(int r, int c, f32x4 v) const { const int ts = list[r]; const float g = topg[ts]; const f32x4 b = *(const f32x4*)(bd + c);
        *(uint2*)(Y + (size_t)ts * 1024 + c) = make_uint2(pack2((v[0] + b[0]) * g, (v[1] + b[1]) * g), pack2((v[2] + b[2]) * g, (v[3] + b[3]) * g)); } };
struct EpiPle { const bf16_t* E; const float* rstd2; bf16_t* V;
    __device__ __forceinline__ void operator()(int r, int c, f32x4 v) const { const float s = rstd2[r]; const uint2 e = *(const uint2*)(E + (size_t)r * 1024 + c);
        const float o0 = bf2f(e.x & 0xffff) * sigmoidf_(v[0] * s), o1 = bf2f(e.x >> 16) * sigmoidf_(v[1] * s), o2 = bf2f(e.y & 0xffff) * sigmoidf_(v[2] * s), o3 = bf2f(e.y >> 16) * sigmoidf_(v[3] * s);
        *(uint2*)(V + (size_t)r * 1024 + c) = make_uint2(pack2(o0, o1), pack2(o2, o3)); } };

template <class Epi, bool PAIR>
__device__ __forceinline__ void gemm_simple_unit(const bf16_t* A, int lda, const int* rowidx, const bf16_t* Bt, int ldb, int M, int K, int mblk, int nblk, const Epi& epi) {
    const int tid = opaque_tid(), wid = tid >> 6, lane = tid & 63, wr = wid >> 1, wc = wid & 1, fr = lane & 15, fq = lane >> 4;
    const int m0 = mblk * 256 + wr * 64;
    if (m0 >= M) return;
    const bf16_t* ap[4]; const bf16_t* bp[4];
#pragma unroll
    for (int mi = 0; mi < 4; ++mi) { int r = m0 + mi * 16 + fr; if (r >= M) r = M - 1; const long ar = rowidx ? (long)(rowidx[r] >> 2) : (long)r; ap[mi] = A + ar * lda + fq * 8; }
#pragma unroll
    for (int ni = 0; ni < 4; ++ni) {
        int br;
        if (PAIR) { const int hc = nblk * 64 + wc * 32 + (ni & 1) * 16 + fr; br = (hc >> 7) * 256 + (hc & 127) + ((ni >> 1) ? 128 : 0); }
        else br = nblk * 128 + wc * 64 + ni * 16 + fr;
        bp[ni] = Bt + (long)br * ldb + fq * 8;
    }
    f32x4 acc[4][4];
#pragma unroll
    for (int mi = 0; mi < 4; ++mi)
#pragma unroll
        for (int ni = 0; ni < 4; ++ni) acc[mi][ni] = (f32x4){0.f, 0.f, 0.f, 0.f};
    for (int k0 = 0; k0 < K; k0 += 32) {
        bf16x8 a[4], b[4];
#pragma unroll
        for (int i = 0; i < 4; ++i) { a[i] = *(const bf16x8*)(ap[i] + k0); b[i] = *(const bf16x8*)(bp[i] + k0); }
#pragma unroll
        for (int mi = 0; mi < 4; ++mi)
#pragma unroll
            for (int ni = 0; ni < 4; ++ni) acc[mi][ni] = __builtin_amdgcn_mfma_f32_16x16x32_bf16(b[ni], a[mi], acc[mi][ni], 0, 0, 0);
    }
#pragma unroll
    for (int mi = 0; mi < 4; ++mi) {
        const int r = m0 + mi * 16 + fr;
        if (r < M) {
            if constexpr (PAIR) {
#pragma unroll
                for (int ni = 0; ni < 2; ++ni) epi(r, nblk * 64 + wc * 32 + ni * 16 + fq * 4, acc[mi][ni], acc[mi][ni + 2]);
            } else {
#pragma unroll
                for (int ni = 0; ni < 4; ++ni) epi(r, nblk * 128 + wc * 64 + ni * 16 + fq * 4, acc[mi][ni]);
            }
        }
    }
}

namespace fg {
constexpr int BM = 256, BK = 64, HALF = 128, HTB = HALF * BK * 2  , STAGE_BYTES = 8 * HTB, NXCD = 8, WGM = 8;
__host__ __device__ __forceinline__ int lds_byte(int r, int c) { const int st = (r >> 4) * 2 + (c >> 5), rr = r & 15, cc = c & 31, ob = rr * 64 + cc * 2; return st * 1024 + (ob ^ (((ob >> 9) & 1) << 5)); }
__host__ __device__ __forceinline__ void stage_rc(int b, int& R, int& C) { const int st = b / 1024, sb = b % 1024, swz = sb ^ (((sb >> 9) & 1) << 5); R = (st >> 1) * 16 + swz / 64; C = (st & 1) * 32 + (swz % 64) / 2; }

template <class PB>
__device__ __forceinline__ void gemm_phase(LAS unsigned char* lds, const PB& S) {
    constexpr int K = PB::K, nt = K / BK;
    typedef typename PB::Unit Unit;
    const int tid = opaque_tid(); const int wid = __builtin_amdgcn_readfirstlane(tid >> 6), lane = tid & 63, wr = wid >> 2, wc = wid & 3, fr = lane & 15, fq = lane >> 4;
    unsigned voffB[2];
#pragma unroll
    for (int i = 0; i < 2; ++i) { int R_, C_; stage_rc(tid * 16 + i * 8192, R_, C_); voffB[i] = (unsigned)(R_ * K + C_) * 2u; }
#define FG_AOFFS(dst, unit) do { int tz_ = tid; asm volatile("" : "+v"(tz_)); _Pragma("unroll") for (int i_ = 0; i_ < 2; ++i_) { int R_, C_; stage_rc(tz_ * 16 + i_ * 8192, R_, C_); \
        _Pragma("unroll") for (int h_ = 0; h_ < 2; ++h_) dst[h_][i_] = S.a_off(unit, h_ * HALF + R_) + (unsigned)C_ * 2u; } } while (0)
    constexpr size_t kstep = (size_t)(BK * 2);
    constexpr size_t hstep = (size_t)HALF * K * 2;
    const unsigned ldsw = (unsigned)wid * 1024u;
    const int aoff = lds_byte(wr * 64 + fr, fq * 8), boff = lds_byte(wc * 32 + fr, fq * 8);
#define FG_SA(b, h) (((b) * 2 + (h)) * HTB)
#define FG_SB(b, h) ((4 + (b) * 2 + (h)) * HTB)
#define FG_STAGE_B(bufoff, gbase) do { _Pragma("unroll") for (int _i = 0; _i < 2; ++_i) \
        __builtin_amdgcn_global_load_lds((const unsigned*)((const char*)(gbase) + voffB[_i]), (LAS unsigned*)(lds + (bufoff) + ldsw + _i * 8192), 16, 0, 0); } while (0)
#define FG_STAGE_A(bufoff, o0, o1) do { \
        __builtin_amdgcn_global_load_lds((const unsigned*)(Abase + (o0)), (LAS unsigned*)(lds + (bufoff) + ldsw), 16, 0, 0); \
        __builtin_amdgcn_global_load_lds((const unsigned*)(Abase + (o1)), (LAS unsigned*)(lds + (bufoff) + ldsw + 8192), 16, 0, 0); } while (0)
#define FG_LDA(dst, b, h) do { _Pragma("unroll") for (int m = 0; m < 4; ++m) _Pragma("unroll") for (int k = 0; k < 2; ++k) dst[m][k] = *(const LAS bf16x8*)(lds + FG_SA(b, h) + aoff + m * 2048 + k * 1024); } while (0)
#define FG_LDB(dst, b, h) do { _Pragma("unroll") for (int n = 0; n < 2; ++n) _Pragma("unroll") for (int k = 0; k < 2; ++k) dst[n][k] = *(const LAS bf16x8*)(lds + FG_SB(b, h) + boff + n * 2048 + k * 1024); } while (0)
#define FG_MMA(ai, bj, At, Bt) do { __builtin_amdgcn_s_setprio(1); _Pragma("unroll") for (int m = 0; m < 4; ++m) _Pragma("unroll") for (int n = 0; n < 2; ++n) _Pragma("unroll") for (int k = 0; k < 2; ++k) \
        acc[ai][bj][m][n] = __builtin_amdgcn_mfma_f32_16x16x32_bf16(Bt[n][k], At[m][k], acc[ai][bj][m][n], 0, 0, 0); __builtin_amdgcn_s_setprio(0); } while (0)
#define FG_WAIT_V(n) asm volatile("s_waitcnt vmcnt(" #n ")" ::: "memory")
#define FG_WAIT_L(n) asm volatile("s_waitcnt lgkmcnt(" #n ")" ::: "memory")
#define FG_BAR __builtin_amdgcn_s_barrier()
#define FG_SCHED __builtin_amdgcn_sched_barrier(0)
    Unit cur, nxt; int ui = 0;
    if (!S.next(0, cur)) return;
    f32x4 acc[2][2][4][2];
#pragma unroll
    for (int a = 0; a < 2; ++a)
#pragma unroll
        for (int b = 0; b < 2; ++b)
#pragma unroll
            for (int m = 0; m < 4; ++m)
#pragma unroll
                for (int n = 0; n < 2; ++n) acc[a][b][m][n] = (f32x4){0.f, 0.f, 0.f, 0.f};
    bf16x8 At[4][2], B0[2][2], B1[2][2];
    const char* Abase = S.a_base();
    unsigned vAc[2][2], vAn[2][2];
    FG_AOFFS(vAc, cur);
    const char* cB = S.b_base(cur);
    FG_STAGE_B(FG_SB(0, 0), cB); FG_STAGE_A(FG_SA(0, 0), vAc[0][0], vAc[0][1]); FG_STAGE_B(FG_SB(0, 1), cB + hstep); FG_STAGE_A(FG_SA(0, 1), vAc[1][0], vAc[1][1]);
    if (wr == 1) FG_BAR;
    FG_WAIT_V(4); FG_BAR;
    FG_STAGE_B(FG_SB(1, 0), cB + kstep); FG_STAGE_A(FG_SA(1, 0), vAc[0][0] + (unsigned)kstep, vAc[0][1] + (unsigned)kstep); FG_STAGE_B(FG_SB(1, 1), cB + hstep + kstep);
    FG_WAIT_V(6); FG_BAR;
    for (;;) {
        const bool has_next = S.next(ui + 1, nxt);
        const char* nB = has_next ? S.b_base(nxt) : cB;
        if (has_next) { FG_AOFFS(vAn, nxt); }
        else {
#pragma unroll
            for (int h = 0; h < 2; ++h)
#pragma unroll
                for (int i = 0; i < 2; ++i) vAn[h][i] = vAc[h][i];
        }
#pragma unroll 1
        for (int t = 0; t < nt; t += 2) {
            const bool last = (t == nt - 2);
            const unsigned k1 = (unsigned)((t + 1) * (int)kstep), k2 = last ? 0u : (unsigned)((t + 2) * (int)kstep);
            const char* b2 = last ? nB : cB + (size_t)(t + 2) * kstep; const char* b3 = b2 + kstep;
#define FG_A2(h, i) ((last ? vAn[h][i] : vAc[h][i]) + k2)
            FG_LDB(B0, 0, 0); FG_SCHED; FG_LDA(At, 0, 0); FG_STAGE_A(FG_SA(1, 1), vAc[1][0] + k1, vAc[1][1] + k1);
            FG_WAIT_L(8); FG_BAR; FG_WAIT_L(0); FG_MMA(0, 0, At, B0); FG_BAR; FG_SCHED;
            FG_LDB(B1, 0, 1); FG_STAGE_B(FG_SB(0, 0), b2);
            FG_BAR; FG_WAIT_L(0); FG_MMA(0, 1, At, B1); FG_BAR;
            FG_LDA(At, 0, 1); FG_STAGE_A(FG_SA(0, 0), FG_A2(0, 0), FG_A2(0, 1));
            FG_BAR; FG_WAIT_L(0); FG_MMA(1, 0, At, B0); FG_BAR; FG_SCHED;
            FG_STAGE_B(FG_SB(0, 1), b2 + hstep);
            FG_WAIT_V(6); FG_BAR; FG_MMA(1, 1, At, B1); FG_BAR;
            FG_LDB(B0, 1, 0); FG_SCHED; FG_LDA(At, 1, 0); FG_STAGE_A(FG_SA(0, 1), FG_A2(1, 0), FG_A2(1, 1));
            FG_WAIT_L(8); FG_BAR; FG_WAIT_L(0); FG_MMA(0, 0, At, B0); FG_BAR; FG_SCHED;
            FG_LDB(B1, 1, 1); FG_STAGE_B(FG_SB(1, 0), b3);
            FG_BAR; FG_WAIT_L(0); FG_MMA(0, 1, At, B1); FG_BAR;
            FG_LDA(At, 1, 1); FG_STAGE_A(FG_SA(1, 0), FG_A2(0, 0) + (unsigned)kstep, FG_A2(0, 1) + (unsigned)kstep);
            FG_BAR; FG_WAIT_L(0); FG_MMA(1, 0, At, B0); FG_BAR; FG_SCHED;
            FG_STAGE_B(FG_SB(1, 1), b3 + hstep);
            FG_WAIT_V(6); FG_BAR; FG_MMA(1, 1, At, B1); FG_BAR;
        }
        S.epilogue(acc, cur, wr, wc, fr, fq);
        if (!has_next) break;
#pragma unroll
        for (int a = 0; a < 2; ++a)
#pragma unroll
            for (int b = 0; b < 2; ++b)
#pragma unroll
                for (int m = 0; m < 4; ++m)
#pragma unroll
                    for (int n = 0; n < 2; ++n) acc[a][b][m][n] = (f32x4){0.f, 0.f, 0.f, 0.f};
        cur = nxt; cB = nB; ++ui;
#pragma unroll
        for (int h = 0; h < 2; ++h)
#pragma unroll
            for (int i = 0; i < 2; ++i) vAc[h][i] = vAn[h][i];
    }
    FG_WAIT_V(0);
    if (wr == 0) FG_BAR;
    FG_BAR;
#undef FG_AOFFS
#undef FG_A2
#undef FG_SA
#undef FG_SB
#undef FG_STAGE_A
#undef FG_STAGE_B
#undef FG_LDA
#undef FG_LDB
#undef FG_MMA
#undef FG_WAIT_V
#undef FG_WAIT_L
#undef FG_BAR
#undef FG_SCHED
}

template <int K_, int LDA, class Epi>
struct DenseProb {
    static constexpr int K = K_;
    struct Unit { int pm, pn; };
    const bf16_t* A; const bf16_t* Bt; int nM, nN, nwg, G, c; Epi epi;
    __device__ __forceinline__ DenseProb(const bf16_t* A_, const bf16_t* Bt_, int N, const Epi& e) : A(A_), Bt(Bt_), nM(T / BM), nN(N / BM), nwg((T / BM) * (N / BM)), G(gridDim.x), c(blockIdx.x), epi(e) {}
    __device__ __forceinline__ bool next(int i, Unit& u) const {
        const long L = (long)i * G + c; if (L >= nwg) return false;
        int wgid = (int)L; { const int q = nwg / NXCD, r = nwg % NXCD, xcd = wgid % NXCD, off = wgid / NXCD; wgid = (xcd < r ? xcd * (q + 1) : r * (q + 1) + (xcd - r) * q) + off; }
        const int nig = WGM * nN, gid = wgid / nig, fm = gid * WGM, gsz = (nM - fm) < WGM ? (nM - fm) : WGM;
        u.pm = fm + ((wgid % nig) % gsz); u.pn = (wgid % nig) / gsz; return true;
    }
    __device__ __forceinline__ const char* a_base() const { return (const char*)A; }
    __device__ __forceinline__ unsigned a_off(const Unit& u, int r) const { return (unsigned)((u.pm * BM + r) * LDA) * 2u; }
    __device__ __forceinline__ const char* b_base(const Unit& u) const { return (const char*)Bt + (size_t)u.pn * BM * K * 2; }
    __device__ __forceinline__ void epilogue(const f32x4 (&acc)[2][2][4][2], const Unit& u, int wr, int wc, int fr, int fq) const {
        const int row0 = u.pm * BM + wr * 64 + fr, col0 = u.pn * BM + wc * 32 + 4 * fq;
#pragma unroll
        for (int ai = 0; ai < 2; ++ai)
#pragma unroll
            for (int m = 0; m < 4; ++m)
#pragma unroll
                for (int bj = 0; bj < 2; ++bj)
#pragma unroll
                    for (int n = 0; n < 2; ++n) epi(row0 + ai * HALF + m * 16, col0 + bj * HALF + n * 16, acc[ai][bj][m][n]);
    }
};
}
template <int K, int LDA, class Epi>
__device__ __forceinline__ void ph_gemm_fast(LAS unsigned char* lds, const bf16_t* A, const bf16_t* Bt, int N, const Epi& epi) {
    const fg::DenseProb<K, LDA, Epi> pb(A, Bt, N, epi);
    fg::gemm_phase(lds, pb);
}


namespace fg {
struct MoeUnit { int e, mblk, pn, rowoff, M; };
template <bool FIRST>
struct MoeProb {
    static constexpr int K = 1024, NCOL = FIRST ? 8 : 4;
    typedef MoeUnit Unit;
    const Params& P; int layer; const LAS int* tab;
    int G, c; mutable int e_, acc_, off_;
    __device__ __forceinline__ MoeProb(const Params& P_, int layer_, const LAS int* tab_) : P(P_), layer(layer_), tab(tab_), G(gridDim.x), c(blockIdx.x), e_(0), acc_(0), off_(0) {}
    __device__ __forceinline__ bool next(int i, Unit& u) const {
        const int L = i * G + c, tile = L / NCOL;
        while (e_ < 32) { const int tl = (tab[e_] + 255) >> 8; if (tile < acc_ + tl) break; acc_ += tl; off_ += tl * 256; ++e_; }
        if (e_ >= 32) return false;
        u.e = e_; u.mblk = tile - acc_; u.pn = L % NCOL; u.rowoff = off_; u.M = tab[e_]; return true;
    }
    __device__ __forceinline__ const char* a_base() const { return FIRST ? (const char*)(P.ws + WS_HB) : (const char*)(P.ws + WS_BIG); }
    __device__ __forceinline__ unsigned a_off(const Unit& u, int r) const {
        if (FIRST) { int rr = u.mblk * 256 + r; rr = rr < u.M ? rr : u.M - 1; const int ts = ((const int*)(P.ws + WS_LIST))[(size_t)u.e * T + rr]; return (unsigned)(ts >> 2) * 2048u; }
        return (unsigned)(u.rowoff + u.mblk * 256 + r) * 2048u;
    }
    __device__ __forceinline__ const char* b_base(const Unit& u) const {
        return FIRST ? (const char*)(P.ws + WS_W1) + ((size_t)u.e * 2048 + (size_t)u.pn * 256) * 2048 : (const char*)(P.ws + WS_W2) + ((size_t)u.e * 1024 + (size_t)u.pn * 256) * 2048;
    }
    __device__ __forceinline__ void epilogue(const f32x4 (&acc)[2][2][4][2], const Unit& u, int wr, int wc, int fr, int fq) const {
        char* ws = P.ws; const int* list = (const int*)(ws + WS_LIST) + (size_t)u.e * T; const int rl0 = u.mblk * 256 + wr * 64 + fr;
        if (FIRST) {
            const EpiMoe1 ep{list, (const float*)(ws + WS_RSTD) + T, P.moe_bg + ((size_t)layer * 32 + u.e) * 1024, P.moe_bu + ((size_t)layer * 32 + u.e) * 1024, (bf16_t*)(ws + WS_BIG) + (size_t)u.rowoff * 1024};
            const int hc0 = u.pn * 128 + wc * 32 + 4 * fq;
#pragma unroll
            for (int ai = 0; ai < 2; ++ai)
#pragma unroll
                for (int m = 0; m < 4; ++m) { const int r = rl0 + ai * HALF + m * 16;
                    if (r < u.M) {
#pragma unroll
                        for (int n = 0; n < 2; ++n) ep(r, hc0 + n * 16, acc[ai][0][m][n], acc[ai][1][m][n]); } }
        } else {
            const EpiMoe2 ep{list, (const float*)(ws + WS_TOPG), P.moe_bd + ((size_t)layer * 32 + u.e) * 1024, (bf16_t*)(ws + WS_Y)};
            const int col0 = u.pn * 256 + wc * 32 + 4 * fq;
#pragma unroll
            for (int ai = 0; ai < 2; ++ai)
#pragma unroll
                for (int m = 0; m < 4; ++m) { const int r = rl0 + ai * HALF + m * 16;
                    if (r < u.M) {
#pragma unroll
                        for (int bj = 0; bj < 2; ++bj)
#pragma unroll
                            for (int n = 0; n < 2; ++n) ep(r, col0 + bj * HALF + n * 16, acc[ai][bj][m][n]); } }
        }
    }
};
}
template <bool FIRST>
__device__ __forceinline__ void ph_moe_fast(const Params& P, int layer, LAS unsigned char* lds) {
    LAS int* tab = (LAS int*)(lds + fg::STAGE_BYTES);
    const int tz = opaque_tid();
    if (tz < 32) tab[tz] = (int)((const unsigned*)(P.ws + WS_CTL))[CTL_CNT + layer * 32 + tz];
    __syncthreads();
    const fg::MoeProb<FIRST> pb(P, layer, tab);
    fg::gemm_phase(lds, pb);
}

template <class Epi>
__device__ __forceinline__ void ph_gemm_dense(const bf16_t* A, int lda, const bf16_t* Bt, int N, int K, const Epi& epi) {
    const int ncol = N / 128, nunits = (T / 256) * ncol;
    for (int u = blockIdx.x; u < nunits; u += gridDim.x) gemm_simple_unit<Epi, false>(A, lda, nullptr, Bt, K, T, K, u / ncol, u % ncol, epi);
}
__device__ __forceinline__ bool moe_decode(const unsigned* cnt, int ncol, int u, int& e, int& mblk, int& nblk, int& rowoff) {
    int acc = 0, off = 0;
    for (int i = 0; i < 32; ++i) {
        const int tl = ((int)cnt[i] + 255) >> 8;
        if (u < (acc + tl) * ncol) { e = i; const int local = u - acc * ncol; mblk = local / ncol; nblk = local % ncol; rowoff = off; return true; }
        acc += tl; off += tl * 256;
    }
    return false;
}
__device__ __forceinline__ void ph_moe1(const Params& P, int layer) {
    char* ws = P.ws; const unsigned* cnt = (const unsigned*)(ws + WS_CTL) + CTL_CNT + layer * 32;
    for (int u = blockIdx.x;; u += gridDim.x) {
        int e, mblk, nblk, off; if (!moe_decode(cnt, 16, u, e, mblk, nblk, off)) break;
        const int* list = (const int*)(ws + WS_LIST) + (size_t)e * T;
        EpiMoe1 ep{list, (const float*)(ws + WS_RSTD) + T, P.moe_bg + ((size_t)layer * 32 + e) * 1024, P.moe_bu + ((size_t)layer * 32 + e) * 1024, (bf16_t*)(ws + WS_BIG) + (size_t)off * 1024};
        gemm_simple_unit<EpiMoe1, true>((const bf16_t*)(ws + WS_HB), 1024, list, (const bf16_t*)(ws + WS_W1) + (size_t)e * 2048 * 1024, 1024, (int)cnt[e], 1024, mblk, nblk, ep);
    }
}
__device__ __forceinline__ void ph_moe2(const Params& P, int layer) {
    char* ws = P.ws; const unsigned* cnt = (const unsigned*)(ws + WS_CTL) + CTL_CNT + layer * 32;
    for (int u = blockIdx.x;; u += gridDim.x) {
        int e, mblk, nblk, off; if (!moe_decode(cnt, 8, u, e, mblk, nblk, off)) break;
        const int* list = (const int*)(ws + WS_LIST) + (size_t)e * T;
        EpiMoe2 ep{list, (const float*)(ws + WS_TOPG), P.moe_bd + ((size_t)layer * 32 + e) * 1024, (bf16_t*)(ws + WS_Y)};
        gemm_simple_unit<EpiMoe2, false>((const bf16_t*)(ws + WS_BIG) + (size_t)off * 1024, 1024, nullptr, (const bf16_t*)(ws + WS_W2) + (size_t)e * 1024 * 1024, 1024, (int)cnt[e], 1024, mblk, nblk, ep);
    }
}

__device__ __forceinline__ void ph_attn_simple(const Params& P, unsigned char* lds) {
    float (*qs)[96] = (float (*)[96])lds; float (*ps)[64] = (float (*)[64])(lds + 8 * 96 * 4);
    const int tid = opaque_tid(), wid = tid >> 6, lane = tid & 63;
    const bf16_t* Q = (const bf16_t*)(P.ws + WS_BIG + BIG_Q); const bf16_t* Kd = (const bf16_t*)(P.ws + WS_BIG + BIG_K); const bf16_t* KV = (const bf16_t*)(P.ws + WS_BIG + BIG_KV);
    bf16_t* YM = (bf16_t*)(P.ws + WS_YMIX);
    for (int u = blockIdx.x; u < T; u += gridDim.x) {
        const long gw = (long)u * 8 + wid;
        const int s = (int)(gw & 4095), bh = (int)(gw >> 12), b = bh >> 3, h = bh & 7;
        const long t = (long)b * SEQ + s;
        __syncthreads();
        qs[wid][lane] = bf2f(Q[t * 768 + h * 96 + lane]);
        if (lane < 32) qs[wid][64 + lane] = bf2f(Q[t * 768 + h * 96 + 64 + lane]);
        __syncthreads();
        float m = -INFINITY, l = 0.f, o = 0.f;
        for (int j0 = 0; j0 <= s; j0 += 64) {
            const int j = j0 + lane; const bool valid = j <= s;
            const long kt = (long)b * SEQ + (valid ? j : s);
            const uint4* kr = (const uint4*)(Kd + (kt * 8 + h) * 96);
            float sc = 0.f;
#pragma unroll
            for (int c = 0; c < 12; ++c) {
                const uint4 kk = kr[c];
                sc += qs[wid][c * 8 + 0] * bf2f(kk.x & 0xffff) + qs[wid][c * 8 + 1] * bf2f(kk.x >> 16) + qs[wid][c * 8 + 2] * bf2f(kk.y & 0xffff) + qs[wid][c * 8 + 3] * bf2f(kk.y >> 16)
                    + qs[wid][c * 8 + 4] * bf2f(kk.z & 0xffff) + qs[wid][c * 8 + 5] * bf2f(kk.z >> 16) + qs[wid][c * 8 + 6] * bf2f(kk.w & 0xffff) + qs[wid][c * 8 + 7] * bf2f(kk.w >> 16);
            }
            sc = valid ? sc : -INFINITY;
            const float mn = fmaxf(m, wave_max(sc));
            const float pj = valid ? __expf(sc - mn) : 0.f;
            const float f = __expf(m - mn);
            l = l * f + wave_sum(pj); o *= f; m = mn;
            __syncthreads();
            ps[wid][lane] = pj;
            __syncthreads();
            const bf16_t* vb = KV + ((long)b * SEQ + j0) * 1024 + h * 128 + 64 + lane;
#pragma unroll 8
            for (int jj = 0; jj < 64; ++jj) o += ps[wid][jj] * bf2f(vb[(long)jj * 1024]);
        }
        YM[t * 1024 + 256 + h * 64 + lane] = f2bf(o / l);
    }
}


namespace at {
typedef float f32x16 __attribute__((ext_vector_type(16)));
typedef short s16x4 __attribute__((ext_vector_type(4)));
constexpr int KSLOT = 12288, VSLOT = 8192, NSLOT = 3, LDS_K = 0, LDS_V = NSLOT * KSLOT, LDS_END = LDS_V + NSLOT * VSLOT;
typedef float f32x2_t __attribute__((ext_vector_type(2))); typedef __bf16 bf16x2_t __attribute__((ext_vector_type(2)));
__device__ __forceinline__ unsigned cvtpk(float lo, float hi) { const f32x2_t v = {lo, hi}; const bf16x2_t b = __builtin_convertvector(v, bf16x2_t); return __builtin_bit_cast(unsigned, b); }
__device__ __forceinline__ void glds16(const void* gsrc, unsigned lds_dst) { unsigned keep;
    asm volatile("s_mov_b32 %0, m0\n\ts_mov_b32 m0, %2\n\ts_nop 0\n\tglobal_load_lds_dwordx4 %1, off\n\ts_mov_b32 m0, %0" : "=&s"(keep) : "v"(gsrc), "s"(lds_dst) : "memory"); }
__device__ __forceinline__ s16x4 vtr(const LAS unsigned char* p) { return __builtin_bit_cast(s16x4, __builtin_amdgcn_ds_read_tr16_b64_v4i16((LAS s16x4*)p)); }
__device__ __forceinline__ float xhalf_max(float v) { auto rr = __builtin_amdgcn_permlane32_swap(__float_as_uint(v), __float_as_uint(v), false, false); return fmaxf(__uint_as_float(rr[0]), __uint_as_float(rr[1])); }
__device__ __forceinline__ float xhalf_sum(float v) { auto rr = __builtin_amdgcn_permlane32_swap(__float_as_uint(v), __float_as_uint(v), false, false); return __uint_as_float(rr[0]) + __uint_as_float(rr[1]); }

__device__ __forceinline__ void attn_unit(int b, int h, int qb, const bf16_t* Q, const bf16_t* Kd, const bf16_t* KV, bf16_t* YM, LAS unsigned char* lds) {
    const int tid = opaque_tid(); const int lane = tid & 63, r32 = lane & 31, hi = lane >> 5; const int wid = __builtin_amdgcn_readfirstlane(tid >> 6);
    const int q0 = qb * 256; const size_t row = (size_t)b * SEQ + q0 + wid * 32 + r32;
    const int NT = 4 * qb + 4;
    const char* ksrcA = (const char*)(Kd + (((size_t)b * SEQ + lane) * 8 + h) * 96) + wid * 16;
    const char* ksrcB = (const char*)(Kd + (((size_t)b * SEQ + lane) * 8 + h) * 96) + (8 + (wid & 3)) * 16;
    const char* vsrc = (const char*)(KV + ((size_t)b * SEQ + 16 * (wid & 3) + (lane >> 2)) * 1024 + h * 128 + 64 + (wid >> 2) * 32 + (lane & 3) * 8);
    const unsigned lds0 = (unsigned)(size_t)lds;
#define AT_DMA(j, slot) do { \
        glds16(ksrcA + (size_t)(j) * (64 * 1536), (unsigned)__builtin_amdgcn_readfirstlane((int)(lds0 + LDS_K + (slot) * KSLOT + wid * 1024))); \
        glds16(ksrcB + (size_t)(j) * (64 * 1536), (unsigned)__builtin_amdgcn_readfirstlane((int)(lds0 + LDS_K + (slot) * KSLOT + (8 + (wid & 3)) * 1024))); \
        glds16(vsrc + (size_t)(j) * (64 * 2048), (unsigned)__builtin_amdgcn_readfirstlane((int)(lds0 + LDS_V + (slot) * VSLOT + wid * 1024))); } while (0)
    AT_DMA(0, 0); AT_DMA(1, 1);
    bf16x8 qf[6];
#pragma unroll
    for (int ks = 0; ks < 6; ++ks) qf[ks] = *(const bf16x8*)(Q + row * 768 + h * 96 + ks * 16 + hi * 8);
    asm volatile("" : "+v"(qf[0]), "+v"(qf[1]), "+v"(qf[2]), "+v"(qf[3]), "+v"(qf[4]), "+v"(qf[5]));
    float m = -INFINITY, l = 0.f;
    f32x16 o0, o1;
#pragma unroll
    for (int r = 0; r < 16; ++r) { o0[r] = 0.f; o1[r] = 0.f; }
    const int kfo = hi * 1024 + r32 * 16;
    const int vfo = ((lane >> 4) & 1) * 32 + (lane & 3) * 8 + (4 * hi + ((lane & 15) >> 2)) * 64;
    const int qrel = wid * 32 + r32;
    int slot = 0;
    for (int j = 0; j < NT; ++j) {
        if (j + 1 < NT) asm volatile("s_waitcnt vmcnt(3)\n\ts_barrier" ::: "memory"); else asm volatile("s_waitcnt vmcnt(0)\n\ts_barrier" ::: "memory");
        if (j + 2 < NT) { const int s2 = (slot == 0) ? 2 : slot - 1; AT_DMA(j + 2, s2); }
        const LAS unsigned char* kp = lds + LDS_K + slot * KSLOT + kfo;
        const LAS unsigned char* vp = lds + LDS_V + slot * VSLOT + vfo;
        f32x16 s0, s1;
#pragma unroll
        for (int r = 0; r < 16; ++r) { s0[r] = 0.f; s1[r] = 0.f; }
#pragma unroll
        for (int ks = 0; ks < 6; ++ks) {
            const bf16x8 k0 = *(const LAS bf16x8*)(kp + ks * 2048), k1 = *(const LAS bf16x8*)(kp + ks * 2048 + 512);
            s0 = __builtin_amdgcn_mfma_f32_32x32x16_bf16(k0, qf[ks], s0, 0, 0, 0);
            s1 = __builtin_amdgcn_mfma_f32_32x32x16_bf16(k1, qf[ks], s1, 0, 0, 0);
        }
        if (j >= NT - 4) {
            const int kb = 64 * (j - (NT - 4)) + 4 * hi;
#pragma unroll
            for (int r = 0; r < 16; ++r) { const int kv = kb + (r & 3) + 8 * (r >> 2); if (kv > qrel) s0[r] = -INFINITY; if (kv + 32 > qrel) s1[r] = -INFINITY; }
        }
        float mt = fmaxf(s0[0], s1[0]);
#pragma unroll
        for (int r = 1; r < 16; ++r) mt = fmaxf(mt, fmaxf(s0[r], s1[r]));
        mt = xhalf_max(mt);
        const float mn = fmaxf(m, mt);
        const float f = __builtin_amdgcn_exp2f(m - mn);
        float ps = 0.f;
#pragma unroll
        for (int r = 0; r < 16; ++r) { s0[r] = __builtin_amdgcn_exp2f(s0[r] - mn); s1[r] = __builtin_amdgcn_exp2f(s1[r] - mn); ps += s0[r] + s1[r]; }
        l = l * f + ps; m = mn;
#pragma unroll
        for (int r = 0; r < 16; ++r) { o0[r] *= f; o1[r] *= f; }
        bf16x8 pf[4];
        {
            unsigned w[16];
#pragma unroll
            for (int i = 0; i < 8; ++i) { w[i] = cvtpk(s0[2 * i], s0[2 * i + 1]); w[8 + i] = cvtpk(s1[2 * i], s1[2 * i + 1]); }
#pragma unroll
            for (int k = 0; k < 4; ++k) { typedef unsigned u32x4 __attribute__((ext_vector_type(4))); const u32x4 t = {w[4 * k], w[4 * k + 1], w[4 * k + 2], w[4 * k + 3]}; pf[k] = __builtin_bit_cast(bf16x8, t); }
        }
#pragma unroll
        for (int k = 0; k < 4; ++k) {
            const s16x4 a0 = vtr(vp + k * 1024), a1 = vtr(vp + k * 1024 + 512), c0 = vtr(vp + 4096 + k * 1024), c1 = vtr(vp + 4096 + k * 1024 + 512);
            const bf16x8 v0 = {a0[0], a0[1], a0[2], a0[3], a1[0], a1[1], a1[2], a1[3]}, v1 = {c0[0], c0[1], c0[2], c0[3], c1[0], c1[1], c1[2], c1[3]};
            o0 = __builtin_amdgcn_mfma_f32_32x32x16_bf16(v0, pf[k], o0, 0, 0, 0);
            o1 = __builtin_amdgcn_mfma_f32_32x32x16_bf16(v1, pf[k], o1, 0, 0, 0);
        }
        slot = (slot == 2) ? 0 : slot + 1;
    }
    l = xhalf_sum(l);
    const float rl = 1.0f / l;
    bf16_t* op = YM + row * 1024 + 256 + h * 64 + 4 * hi;
#pragma unroll
    for (int g = 0; g < 4; ++g) {
        *(uint2*)(op + 8 * g) = make_uint2(cvtpk(o0[4 * g] * rl, o0[4 * g + 1] * rl), cvtpk(o0[4 * g + 2] * rl, o0[4 * g + 3] * rl));
        *(uint2*)(op + 32 + 8 * g) = make_uint2(cvtpk(o1[4 * g] * rl, o1[4 * g + 1] * rl), cvtpk(o1[4 * g + 2] * rl, o1[4 * g + 3] * rl));
    }
    asm volatile("s_waitcnt lgkmcnt(0)\n\ts_barrier" ::: "memory");
#undef AT_DMA
}
}
__device__ __forceinline__ void ph_attn_fast(const Params& P, LAS unsigned char* lds) {
    const bf16_t* Q = (const bf16_t*)(P.ws + WS_BIG + BIG_Q); const bf16_t* Kd = (const bf16_t*)(P.ws + WS_BIG + BIG_K); const bf16_t* KV = (const bf16_t*)(P.ws + WS_BIG + BIG_KV);
    bf16_t* YM = (bf16_t*)(P.ws + WS_YMIX);
    const int G = gridDim.x;
    for (int v0 = (blockIdx.x % 8) * (G / 8) + blockIdx.x / 8; v0 < 256; v0 += G) {
        const int bh = v0 >> 2, s = v0 & 3;
#pragma unroll 1
        for (int i = 0; i < 4; ++i) { const int qb = (i == 0) ? s : (i == 1) ? 7 - s : (i == 2) ? 8 + s : 15 - s; at::attn_unit(bh >> 3, bh & 7, qb, Q, Kd, KV, YM, lds); }
    }
}


__device__ __forceinline__ void ph_gla_x(const Params& P, LAS unsigned char* lds) {
    const int tid = opaque_tid(); const int wid = __builtin_amdgcn_readfirstlane(tid >> 6), lane = tid & 63;
    LAS float* kend = (LAS float*)(lds + wid * 8192);
    const bf16_t* Z = (const bf16_t*)(P.ws + WS_BIG + BIG_Z); float* LA = (float*)(P.ws + WS_BIG + BIG_LA);
    float* UPD = (float*)(P.ws + WS_UPD); float* DEC = (float*)(P.ws + WS_DEC);
    for (int u = blockIdx.x * NWV + wid; u < 2048; u += gridDim.x * NWV) {
        const int bh = u >> 6, n = u & 63, b = bh >> 2, h = bh & 3;
        const size_t t0 = (size_t)b * SEQ + n * 64;
        const int k = lane & 31, half = lane >> 5;
        float c[32]; float run = 0.f;
#pragma unroll
        for (int i = 0; i < 32; ++i) { run += LA[(t0 + 32 * half + i) * 128 + h * 32 + k]; c[i] = run; }
        const float tot0 = __shfl(run, k);
        const float add = half ? tot0 : 0.f;
        const float blast = __shfl(run, 32 + k) + tot0;
#pragma unroll
        for (int i = 0; i < 32; ++i) {
            const float bc = c[i] + add; const size_t t = t0 + 32 * half + i;
            LA[t * 128 + h * 32 + k] = bc;
            kend[(32 * half + i) * 32 + k] = bf2f(Z[t * ZW + ZC_GK + h * 32 + k]) * __expf(blast - bc);
        }
        if (half == 0) DEC[(size_t)u * 32 + k] = __expf(blast);
        asm volatile("s_waitcnt lgkmcnt(0)" ::: "memory");
        float acc[32];
#pragma unroll
        for (int i = 0; i < 32; ++i) acc[i] = 0.f;
#pragma unroll 4
        for (int j = 0; j < 64; ++j) {
            const float vj = bf2f(Z[(t0 + j) * ZW + ZC_GV + h * 64 + lane]);
#pragma unroll
            for (int kq = 0; kq < 8; ++kq) { const f32x4 ke = *(const LAS f32x4*)(kend + j * 32 + kq * 4); acc[4 * kq] += ke[0] * vj; acc[4 * kq + 1] += ke[1] * vj; acc[4 * kq + 2] += ke[2] * vj; acc[4 * kq + 3] += ke[3] * vj; }
        }
#pragma unroll
        for (int kk = 0; kk < 32; ++kk) UPD[((size_t)u * 32 + kk) * 64 + lane] = acc[kk];
        asm volatile("s_waitcnt lgkmcnt(0)" ::: "memory");
    }
}
__device__ __forceinline__ void ph_gla_scan(const Params& P) {
    const int tz = opaque_tid();
    const float* UPD = (const float*)(P.ws + WS_UPD); const float* DEC = (const float*)(P.ws + WS_DEC); bf16_t* SP = (bf16_t*)(P.ws + WS_SPREV);
    for (int e = blockIdx.x * NTHR + tz; e < 32 * 2048; e += gridDim.x * NTHR) {
        const int bh = e >> 11, kv = e & 2047, k = kv >> 6;
        float st = 0.f;
#pragma unroll 8
        for (int n = 0; n < 64; ++n) {
            const size_t u = (size_t)bh * 64 + n;
            SP[u * 2048 + kv] = f2bf(st);
            st = DEC[u * 32 + k] * st + UPD[u * 2048 + kv];
        }
    }
}
__device__ __forceinline__ void ph_gla_y(const Params& P, int layer, LAS unsigned char* lds) {
    using at::f32x16; using at::s16x4; using at::vtr; using at::cvtpk;
    typedef unsigned u32x4 __attribute__((ext_vector_type(4)));
    const int tid = opaque_tid(); const int wid = __builtin_amdgcn_readfirstlane(tid >> 6), lane = tid & 63, r32 = lane & 31, hi = lane >> 5;
    LAS unsigned char* vl = lds + wid * 12288; LAS unsigned char* sl = vl + 8192;
    const bf16_t* Z = (const bf16_t*)(P.ws + WS_BIG + BIG_Z); const float* LA = (const float*)(P.ws + WS_BIG + BIG_LA); const bf16_t* SP = (const bf16_t*)(P.ws + WS_SPREV);
    bf16_t* YM = (bf16_t*)(P.ws + WS_YMIX); const float* gon = P.gla_on + layer * 64;
    const int vfo = ((lane >> 4) & 1) * 32 + (lane & 3) * 8 + (4 * hi + ((lane & 15) >> 2)) * 64;
    const int sfo = ((lane >> 4) & 1) * 32 + (lane & 3) * 8 + ((lane & 15) >> 2) * 64;
    for (int u = blockIdx.x * NWV + wid; u < 2048; u += gridDim.x * NWV) {
        const int bh = u >> 6, n = u & 63, b = bh >> 2, h = bh & 3;
        const size_t t0 = (size_t)b * SEQ + n * 64;
#pragma unroll
        for (int p = 0; p < 8; ++p) {
            const int row = 8 * p + (lane >> 3), dv = 8 * (lane & 7);
            const u32x4 x = *(const u32x4*)(Z + (t0 + row) * ZW + ZC_GV + h * 64 + dv);
            *(LAS u32x4*)(vl + (dv >> 5) * 4096 + (row >> 3) * 512 + (row & 7) * 64 + (dv & 31) * 2) = x;
        }
#pragma unroll
        for (int p = 0; p < 4; ++p) {
            const int row = 8 * p + (lane >> 3), dv = 8 * (lane & 7);
            const u32x4 x = *(const u32x4*)(SP + ((size_t)u * 32 + row) * 64 + dv);
            *(LAS u32x4*)(sl + (dv >> 5) * 2048 + (row >> 3) * 512 + (row & 7) * 64 + (dv & 31) * 2) = x;
        }
        bf16x8 qfr[2][2], kfr[2][2];
#pragma unroll
        for (int blk = 0; blk < 2; ++blk)
#pragma unroll
            for (int ks = 0; ks < 2; ++ks) {
                const size_t t = t0 + 32 * blk + r32; const int k0 = 16 * ks + 8 * hi;
                const uint4 qraw = *(const uint4*)(Z + t * ZW + ZC_GQ + h * 32 + k0), kraw = *(const uint4*)(Z + t * ZW + ZC_GK + h * 32 + k0);
                const f32x4 b0 = *(const f32x4*)(LA + t * 128 + h * 32 + k0), b1 = *(const f32x4*)(LA + t * 128 + h * 32 + k0 + 4);
                const unsigned qw[4] = {qraw.x, qraw.y, qraw.z, qraw.w}, kw[4] = {kraw.x, kraw.y, kraw.z, kraw.w};
                const float bcv[8] = {b0[0], b0[1], b0[2], b0[3], b1[0], b1[1], b1[2], b1[3]};
                u32x4 qo, ko;
#pragma unroll
                for (int w = 0; w < 4; ++w) {
                    const float e0 = __expf(bcv[2 * w]), e1 = __expf(bcv[2 * w + 1]);
                    const float q0 = bf2f(qw[w] & 0xffff) * 0.17677669529663687f * e0, q1 = bf2f(qw[w] >> 16) * 0.17677669529663687f * e1;
                    const float k0f = bf2f(kw[w] & 0xffff) * __expf(-bcv[2 * w]), k1f = bf2f(kw[w] >> 16) * __expf(-bcv[2 * w + 1]);
                    qo[w] = cvtpk(q0, q1); ko[w] = cvtpk(k0f, k1f);
                }
                qfr[blk][ks] = __builtin_bit_cast(bf16x8, qo); kfr[blk][ks] = __builtin_bit_cast(bf16x8, ko);
            }
        f32x16 z16;
#pragma unroll
        for (int r = 0; r < 16; ++r) z16[r] = 0.f;
        f32x16 s00 = __builtin_amdgcn_mfma_f32_32x32x16_bf16(kfr[0][0], qfr[0][0], z16, 0, 0, 0); s00 = __builtin_amdgcn_mfma_f32_32x32x16_bf16(kfr[0][1], qfr[0][1], s00, 0, 0, 0);
        f32x16 s01 = __builtin_amdgcn_mfma_f32_32x32x16_bf16(kfr[0][0], qfr[1][0], z16, 0, 0, 0); s01 = __builtin_amdgcn_mfma_f32_32x32x16_bf16(kfr[0][1], qfr[1][1], s01, 0, 0, 0);
        f32x16 s11 = __builtin_amdgcn_mfma_f32_32x32x16_bf16(kfr[1][0], qfr[1][0], z16, 0, 0, 0); s11 = __builtin_amdgcn_mfma_f32_32x32x16_bf16(kfr[1][1], qfr[1][1], s11, 0, 0, 0);
#pragma unroll
        for (int r = 0; r < 16; ++r) { const int jl = (r & 3) + 8 * (r >> 2) + 4 * hi; if (jl > r32) { s00[r] = 0.f; s11[r] = 0.f; } }
        bf16x8 p00[2], p01[2], p11[2];
#pragma unroll
        for (int sp = 0; sp < 2; ++sp) {
            u32x4 a, c, d;
#pragma unroll
            for (int w = 0; w < 4; ++w) { a[w] = cvtpk(s00[8 * sp + 2 * w], s00[8 * sp + 2 * w + 1]); c[w] = cvtpk(s01[8 * sp + 2 * w], s01[8 * sp + 2 * w + 1]); d[w] = cvtpk(s11[8 * sp + 2 * w], s11[8 * sp + 2 * w + 1]); }
            p00[sp] = __builtin_bit_cast(bf16x8, a); p01[sp] = __builtin_bit_cast(bf16x8, c); p11[sp] = __builtin_bit_cast(bf16x8, d);
        }
        asm volatile("s_waitcnt lgkmcnt(0)" ::: "memory");
        f32x16 o[2][2];
#pragma unroll
        for (int vb = 0; vb < 2; ++vb) {
            o[vb][0] = z16; o[vb][1] = z16;
#pragma unroll
            for (int k2 = 0; k2 < 4; ++k2) {
                const s16x4 a0 = vtr(vl + vfo + vb * 4096 + k2 * 1024), a1 = vtr(vl + vfo + vb * 4096 + k2 * 1024 + 512);
                const bf16x8 vt = {a0[0], a0[1], a0[2], a0[3], a1[0], a1[1], a1[2], a1[3]};
                if (k2 < 2) { o[vb][0] = __builtin_amdgcn_mfma_f32_32x32x16_bf16(vt, p00[k2], o[vb][0], 0, 0, 0); o[vb][1] = __builtin_amdgcn_mfma_f32_32x32x16_bf16(vt, p01[k2], o[vb][1], 0, 0, 0); }
                else o[vb][1] = __builtin_amdgcn_mfma_f32_32x32x16_bf16(vt, p11[k2 - 2], o[vb][1], 0, 0, 0);
            }
#pragma unroll
            for (int ks = 0; ks < 2; ++ks) {
                const s16x4 a0 = vtr(sl + sfo + vb * 2048 + (2 * ks + hi) * 512), a1 = vtr(sl + sfo + vb * 2048 + (2 * ks + hi) * 512 + 256);
                const bf16x8 st = {a0[0], a0[1], a0[2], a0[3], a1[0], a1[1], a1[2], a1[3]};
                o[vb][0] = __builtin_amdgcn_mfma_f32_32x32x16_bf16(st, qfr[0][ks], o[vb][0], 0, 0, 0);
                o[vb][1] = __builtin_amdgcn_mfma_f32_32x32x16_bf16(st, qfr[1][ks], o[vb][1], 0, 0, 0);
            }
        }
#pragma unroll
        for (int ib = 0; ib < 2; ++ib) {
            const size_t t = t0 + 32 * ib + r32;
            float ss = 0.f;
#pragma unroll
            for (int r = 0; r < 16; ++r) ss += o[0][ib][r] * o[0][ib][r] + o[1][ib][r] * o[1][ib][r];
            ss = at::xhalf_sum(ss);
            const float rstd = rsqrtf(ss * (1.0f / 64.0f) + EPS);
#pragma unroll
            for (int vb = 0; vb < 2; ++vb)
#pragma unroll
                for (int g = 0; g < 4; ++g) {
                    const int v0 = 32 * vb + 8 * g + 4 * hi;
                    const uint2 rr = *(const uint2*)(Z + t * ZW + ZC_GR + h * 64 + v0); const f32x4 gn = *(const f32x4*)(gon + v0);
                    const float r0 = bf2f(rr.x & 0xffff), r1 = bf2f(rr.x >> 16), r2 = bf2f(rr.y & 0xffff), r3 = bf2f(rr.y >> 16);
                    const float y0 = o[vb][ib][4 * g] * rstd * gn[0] * r0 * sigmoidf_(r0), y1 = o[vb][ib][4 * g + 1] * rstd * gn[1] * r1 * sigmoidf_(r1);
                    const float y2 = o[vb][ib][4 * g + 2] * rstd * gn[2] * r2 * sigmoidf_(r2), y3 = o[vb][ib][4 * g + 3] * rstd * gn[3] * r3 * sigmoidf_(r3);
                    *(uint2*)(YM + t * 1024 + h * 64 + v0) = make_uint2(cvtpk(y0, y1), cvtpk(y2, y3));
                }
        }
        asm volatile("s_waitcnt lgkmcnt(0)" ::: "memory");
    }
}

__device__ __forceinline__ void ph_gla_simple(const Params& P, int layer, unsigned char* lds) {
    if (blockIdx.x >= 4) return;
    const int tz = opaque_tid(); const int wid = tz >> 6, lane = tz & 63;
    float (*sq)[32] = (float (*)[32])(lds + wid * 3072), (*sk)[32] = (float (*)[32])(lds + wid * 3072 + 1024), (*sa)[32] = (float (*)[32])(lds + wid * 3072 + 2048);
    const int bh = blockIdx.x * 8 + wid, b = bh >> 2, h = bh & 3;
    const bf16_t* Z = (const bf16_t*)(P.ws + WS_BIG + BIG_Z); const float* LA = (const float*)(P.ws + WS_BIG + BIG_LA); bf16_t* YM = (bf16_t*)(P.ws + WS_YMIX);
    const float g = P.gla_on[layer * 64 + lane];
    float st[32];
#pragma unroll
    for (int k = 0; k < 32; ++k) st[k] = 0.f;
    for (int c0 = 0; c0 < SEQ; c0 += 8) {
#pragma unroll
        for (int i = 0; i < 4; ++i) {
            const int idx = lane + 64 * i, sp = idx >> 5, k = idx & 31; const size_t t = (size_t)b * SEQ + c0 + sp;
            sq[sp][k] = bf2f(Z[t * ZW + ZC_GQ + h * 32 + k]) * 0.17677669529663687f;
            sk[sp][k] = bf2f(Z[t * ZW + ZC_GK + h * 32 + k]);
            sa[sp][k] = __expf(LA[t * 128 + h * 32 + k]);
        }
        float v[8], r[8];
#pragma unroll
        for (int sp = 0; sp < 8; ++sp) { const size_t t = (size_t)b * SEQ + c0 + sp; v[sp] = bf2f(Z[t * ZW + ZC_GV + h * 64 + lane]); r[sp] = bf2f(Z[t * ZW + ZC_GR + h * 64 + lane]); }
        __syncthreads();
#pragma unroll
        for (int sp = 0; sp < 8; ++sp) {
            float o = 0.f;
#pragma unroll
            for (int k = 0; k < 32; ++k) { st[k] = sa[sp][k] * st[k] + sk[sp][k] * v[sp]; o += sq[sp][k] * st[k]; }
            const float ss = wave_sum(o * o);
            const float on = o * rsqrtf(ss * (1.0f / 64.0f) + EPS) * g;
            const float rr = r[sp];
            YM[((size_t)b * SEQ + c0 + sp) * 1024 + h * 64 + lane] = f2bf(on * rr * sigmoidf_(rr));
        }
        __syncthreads();
    }
}

template <int L> __device__ __forceinline__ void layer_body(const Params& P, const XcdBarrier& bar, unsigned char* lds) {
    constexpr int l = L; char* ws = P.ws; LAS unsigned char* ldsl = (LAS unsigned char*)lds;
    const bf16_t* HB = (const bf16_t*)(ws + WS_HB); const float* RS = (const float*)(ws + WS_RSTD);
    bf16_t* Z = (bf16_t*)(ws + WS_BIG + BIG_Z);
    {
        const char* wsm = ws + WS_WSM + (size_t)l * WSM_STRIDE;
        ph_tconv(P.moe_wg + (size_t)l * 32 * 1024 * 1024, P.moe_wu + (size_t)l * 32 * 1024 * 1024, P.ffn_norm + l * 1024, (bf16_t*)(ws + WS_W1), 2048, 1024, 1024, 2, 32, 1024L * 1024, 2048L * 1024, lds);
        ph_tconv(P.moe_wd + (size_t)l * 32 * 1024 * 1024, nullptr, nullptr, (bf16_t*)(ws + WS_W2), 1024, 1024, 1024, 0, 32, 1024L * 1024, 1024L * 1024, lds);
#ifdef DBL_TCONV
        ph_tconv(P.moe_wg + (size_t)l * 32 * 1024 * 1024, P.moe_wu + (size_t)l * 32 * 1024 * 1024, P.ffn_norm + l * 1024, (bf16_t*)(ws + WS_W1), 2048, 1024, 1024, 2, 32, 1024L * 1024, 2048L * 1024, lds);
        ph_tconv(P.moe_wd + (size_t)l * 32 * 1024 * 1024, nullptr, nullptr, (bf16_t*)(ws + WS_W2), 1024, 1024, 1024, 0, 32, 1024L * 1024, 1024L * 1024, lds);
#endif
        { EpiBf16 e{(bf16_t*)(ws + WS_E), 1024}; ph_gemm_fast<256, 256>(ldsl, (const bf16_t*)(ws + WS_PB) + (size_t)l * T * 256, (const bf16_t*)(wsm + WSM_WPLE), 1024, e); }
#ifdef DBL_SHORTK
        { EpiBf16 e{(bf16_t*)(ws + WS_E), 1024}; ph_gemm_fast<256, 256>(ldsl, (const bf16_t*)(ws + WS_PB) + (size_t)l * T * 256, (const bf16_t*)(wsm + WSM_WPLE), 1024, e); }
#endif
        { EpiZ e{Z, RS}; ph_gemm_fast<1024, 1024>(ldsl, HB, (const bf16_t*)(wsm + WSM_WIN), ZW, e); }
#ifdef DBL_Z
        { EpiZ e{Z, RS}; ph_gemm_fast<1024, 1024>(ldsl, HB, (const bf16_t*)(wsm + WSM_WIN), ZW, e); }
#endif
        xcd_barrier(bar);
        ph_prepB(P, l, lds);
#ifdef DBL_PREPB
        __syncthreads(); ph_prepB(P, l, lds);
#endif
        xcd_barrier(bar);
        { EpiBf16 e{(bf16_t*)(ws + WS_BIG + BIG_Q), 768}; ph_gemm_fast<256, ZW>(ldsl, Z + ZC_CQ, (const bf16_t*)(wsm + WSM_WUQ), 768, e); }
        { EpiBf16 e{(bf16_t*)(ws + WS_BIG + BIG_KV), 1024}; ph_gemm_fast<128, ZW>(ldsl, Z + ZC_CKV, (const bf16_t*)(wsm + WSM_WUKV), 1024, e); }
#ifdef DBL_SHORTK
        { EpiBf16 e{(bf16_t*)(ws + WS_BIG + BIG_Q), 768}; ph_gemm_fast<256, ZW>(ldsl, Z + ZC_CQ, (const bf16_t*)(wsm + WSM_WUQ), 768, e); }
        { EpiBf16 e{(bf16_t*)(ws + WS_BIG + BIG_KV), 1024}; ph_gemm_fast<128, ZW>(ldsl, Z + ZC_CKV, (const bf16_t*)(wsm + WSM_WUKV), 1024, e); }
#endif
        __syncthreads();
        ph_gla_x(P, ldsl);
        xcd_barrier(bar);
        ph_prepD(P, l);
        ph_gla_scan(P);
        xcd_barrier(bar);
        ph_attn_fast(P, ldsl);
#ifdef DBL_ATTN
        ph_attn_fast(P, ldsl);
#endif
        ph_gla_y(P, l, ldsl);
#ifdef DBL_GLAY
        ph_gla_y(P, l, ldsl);
#endif
        xcd_barrier(bar);
        { EpiResid e{l == 0 ? P.x : P.out, P.out}; ph_gemm_fast<1024, 1024>(ldsl, (const bf16_t*)(ws + WS_YMIX), (const bf16_t*)(wsm + WSM_WOUT), 1024, e); }
#ifdef DBL_WOUT0
        if (l == 0) { EpiResid e{P.x, P.out}; ph_gemm_fast<1024, 1024>(ldsl, (const bf16_t*)(ws + WS_YMIX), (const bf16_t*)(wsm + WSM_WOUT), 1024, e); }
#endif
        xcd_barrier(bar);
        ph_router(P, l, ldsl);
        xcd_barrier(bar);
        ph_moe_fast<true>(P, l, ldsl);
#ifdef DBL_MOE1
        __syncthreads(); ph_moe_fast<true>(P, l, ldsl);
#endif
        xcd_barrier(bar);
        ph_moe_fast<false>(P, l, ldsl);
#ifdef DBL_MOE2
        __syncthreads(); ph_moe_fast<false>(P, l, ldsl);
#endif
        xcd_barrier(bar);
        ph_combine(P);
        xcd_barrier(bar);
        { EpiPle e{(const bf16_t*)(ws + WS_E), RS + 2 * T, (bf16_t*)(ws + WS_YMIX)}; ph_gemm_fast<1024, 1024>(ldsl, HB, (const bf16_t*)(wsm + WSM_WPG), 1024, e); }
#ifdef DBL_PLE
        { EpiPle e{(const bf16_t*)(ws + WS_E), RS + 2 * T, (bf16_t*)(ws + WS_YMIX)}; ph_gemm_fast<1024, 1024>(ldsl, HB, (const bf16_t*)(wsm + WSM_WPG), 1024, e); }
#endif
        xcd_barrier(bar);
        ph_final(P, l);
        xcd_barrier(bar);
    }
}

__global__ void __launch_bounds__(NTHR, 2) mega_fwd(Params P) {
    extern __shared__ __attribute__((aligned(16))) unsigned char lds[];
    char* ws = P.ws;
    if (threadIdx.x == 0) *(uint4*)(lds + LDS_BAR_OFF) = make_uint4(0u, 0u, 0u, 0u);
    __syncthreads();
    const XcdBarrier bar = xcd_barrier_post((unsigned*)(ws + WS_CTL), (volatile LAS unsigned*)(lds + LDS_BAR_OFF));
    const bf16_t* HB = (const bf16_t*)(ws + WS_HB); const float* RS = (const float*)(ws + WS_RSTD);
    bf16_t* Z = (bf16_t*)(ws + WS_BIG + BIG_Z);
    for (int l = 0; l < DEPTH; ++l) {
        char* wsm = ws + WS_WSM + (size_t)l * WSM_STRIDE;
        ph_tconv(P.w_in + (size_t)l * 1024 * 1456, nullptr, P.mix_norm + l * 1024, (bf16_t*)(wsm + WSM_WIN), ZW, 1024, 1456, 1, 1, 0, 0, lds);
        ph_tconv(P.w_uq + (size_t)l * 256 * 768, nullptr, P.q_norm + l * 256, (bf16_t*)(wsm + WSM_WUQ), 768, 256, 768, 0, 1, 0, 0, lds);
        ph_tconv(P.w_ukv + (size_t)l * 128 * 1024, nullptr, P.kv_norm + l * 128, (bf16_t*)(wsm + WSM_WUKV), 1024, 128, 1024, 0, 1, 0, 0, lds);
        ph_tconv(P.w_out + (size_t)l * 1024 * 1024, nullptr, nullptr, (bf16_t*)(wsm + WSM_WOUT), 1024, 1024, 1024, 0, 1, 0, 0, lds);
        ph_tconv(P.ple_wg + (size_t)l * 1024 * 1024, nullptr, P.ple_gn + l * 1024, (bf16_t*)(wsm + WSM_WPG), 1024, 1024, 1024, 0, 1, 0, 0, lds);
        ph_tconv(P.ple_wp + (size_t)l * 256 * 1024, nullptr, nullptr, (bf16_t*)(wsm + WSM_WPLE), 1024, 256, 1024, 0, 1, 0, 0, lds);
    }
    ph_conv_bf16(P.p, (bf16_t*)(ws + WS_PB), (long)2 * T * 256 / 8);
    ph_prep_router(P);
    ph_init_h(P);
    ph_rope_table(P);
#ifdef DBL_P0
    __syncthreads();
    for (int l = 0; l < DEPTH; ++l) {
        char* wsm = ws + WS_WSM + (size_t)l * WSM_STRIDE;
        ph_tconv(P.w_in + (size_t)l * 1024 * 1456, nullptr, P.mix_norm + l * 1024, (bf16_t*)(wsm + WSM_WIN), ZW, 1024, 1456, 1, 1, 0, 0, lds);
        ph_tconv(P.w_uq + (size_t)l * 256 * 768, nullptr, P.q_norm + l * 256, (bf16_t*)(wsm + WSM_WUQ), 768, 256, 768, 0, 1, 0, 0, lds);
        ph_tconv(P.w_ukv + (size_t)l * 128 * 1024, nullptr, P.kv_norm + l * 128, (bf16_t*)(wsm + WSM_WUKV), 1024, 128, 1024, 0, 1, 0, 0, lds);
        ph_tconv(P.w_out + (size_t)l * 1024 * 1024, nullptr, nullptr, (bf16_t*)(wsm + WSM_WOUT), 1024, 1024, 1024, 0, 1, 0, 0, lds);
        ph_tconv(P.ple_wg + (size_t)l * 1024 * 1024, nullptr, P.ple_gn + l * 1024, (bf16_t*)(wsm + WSM_WPG), 1024, 1024, 1024, 0, 1, 0, 0, lds);
        ph_tconv(P.ple_wp + (size_t)l * 256 * 1024, nullptr, nullptr, (bf16_t*)(wsm + WSM_WPLE), 1024, 256, 1024, 0, 1, 0, 0, lds);
    }
    ph_conv_bf16(P.p, (bf16_t*)(ws + WS_PB), (long)2 * T * 256 / 8);
    ph_prep_router(P);
    ph_init_h(P);
    ph_rope_table(P);
#endif
    xcd_barrier(bar);
    layer_body<0>(P, bar, lds);
    layer_body<1>(P, bar, lds);
}

extern "C" void kernel_launch(void* const* d_in, const int* in_sizes, int n_in, void* d_out, int out_size, void* d_ws, size_t ws_size, hipStream_t stream) {
    if (n_in != 30 || ws_size < WS_END) { fprintf(stderr, "kernel_launch: need 30 inputs and %zu bytes of workspace (got %d, %zu)\n", (size_t)WS_END, n_in, ws_size); return; }
    static int grid = 0;
    if (!grid) {
        int dev = 0, cus = 0, per_cu = 0;
        if (hipGetDevice(&dev) != hipSuccess || hipDeviceGetAttribute(&cus, hipDeviceAttributeMultiprocessorCount, dev) != hipSuccess) { fprintf(stderr, "kernel_launch: device query failed\n"); return; }
        if (hipFuncSetAttribute((const void*)mega_fwd, hipFuncAttributeMaxDynamicSharedMemorySize, LDS_BYTES) != hipSuccess) { fprintf(stderr, "kernel_launch: hipFuncSetAttribute failed\n"); return; }
        if (hipOccupancyMaxActiveBlocksPerMultiprocessor(&per_cu, (const void*)mega_fwd, NTHR, LDS_BYTES) != hipSuccess || per_cu < 1) { fprintf(stderr, "kernel_launch: occupancy query says %d\n", per_cu); return; }
        grid = cus;
    }
    Params P{};
    P.x = (const float*)d_in[0]; P.p = (const float*)d_in[1]; P.pos = (const int*)d_in[2];
    P.mix_norm = (const float*)d_in[3]; P.w_in = (const float*)d_in[4]; P.gla_wg = (const float*)d_in[5]; P.gla_bg = (const float*)d_in[6]; P.gla_on = (const float*)d_in[7];
    P.q_norm = (const float*)d_in[8]; P.w_uq = (const float*)d_in[9]; P.kv_norm = (const float*)d_in[10]; P.w_ukv = (const float*)d_in[11]; P.qkq = (const float*)d_in[12]; P.qkk = (const float*)d_in[13];
    P.pool_w = (const float*)d_in[14]; P.pool_s = (const float*)d_in[15]; P.w_out = (const float*)d_in[16]; P.ffn_norm = (const float*)d_in[17]; P.router_w = (const float*)d_in[18]; P.router_b = (const float*)d_in[19];
    P.moe_wg = (const float*)d_in[20]; P.moe_bg = (const float*)d_in[21]; P.moe_wu = (const float*)d_in[22]; P.moe_bu = (const float*)d_in[23]; P.moe_wd = (const float*)d_in[24]; P.moe_bd = (const float*)d_in[25];
    P.ple_wp = (const float*)d_in[26]; P.ple_gn = (const float*)d_in[27]; P.ple_wg = (const float*)d_in[28]; P.ple_pn = (const float*)d_in[29];
    P.out = (float*)d_out; P.ws = (char*)d_ws;
    (void)hipMemsetAsync((char*)d_ws + WS_CTL, 0, 65536, stream);
    hipLaunchKernelGGL(mega_fwd, dim3(grid), dim3(NTHR), LDS_BYTES, stream, P);
}
```

```cpp
#include <hip/hip_runtime.h>
#include <cstdio>
#include <cstdint>

typedef unsigned short bf16_t;
typedef short bf16x8 __attribute__((ext_vector_type(8)));
typedef float f32x4 __attribute__((ext_vector_type(4)));

constexpr int T = 32768, DM = 1024, SEQ = 4096, NBATCH = 8, DEPTH = 2;
constexpr int ZW = 1536;
constexpr int ZC_CQ = 0, ZC_GV = 256, ZC_GR = 512, ZC_UP = 768, ZC_GQ = 1024, ZC_GK = 1152, ZC_CKV = 1280, ZC_KR = 1408, ZC_GLOW = 1440;
constexpr int NE = 32, TOPK = 4, DFF = 1024;
constexpr int HROWS = 139264;
constexpr float EPS = 1e-6f;

__host__ __device__ inline int zsrc(int n) {
    if (n < 256) return 784 + n;
    if (n < 512) return 256 + (n - 256);
    if (n < 768) return 528 + (n - 512);
    if (n < 1024) return 1200 + (n - 768);
    if (n < 1152) return n - 1024;
    if (n < 1280) return 128 + (n - 1152);
    if (n < 1408) return 1040 + (n - 1280);
    if (n < 1440) return 1168 + (n - 1408);
    if (n < 1456) return 512 + (n - 1440);
    return -1;
}

constexpr size_t MiB = 1024 * 1024;
constexpr size_t WS_CTL = 0;
constexpr size_t WS_HB = 1 * MiB;
constexpr size_t WS_RSTD = WS_HB + 64 * MiB;
constexpr size_t WS_WSM = WS_RSTD + 1 * MiB;
constexpr size_t WSM_WIN = 0, WSM_WUQ = 3 * MiB, WSM_WUKV = WSM_WUQ + 384 * 1024, WSM_WOUT = WSM_WUKV + 256 * 1024, WSM_WPG = WSM_WOUT + 2 * MiB,
                 WSM_WPLE = WSM_WPG + 2 * MiB, WSM_WR = WSM_WPLE + 512 * 1024, WSM_WPT = WSM_WR + 128 * 1024, WSM_STRIDE = WSM_WR + 128 * 1024 + 128 * 1024;
constexpr size_t WS_PB = WS_WSM + 2 * WSM_STRIDE;
constexpr size_t WS_W1 = WS_PB + 32 * MiB;
constexpr size_t WS_W2 = WS_W1 + 128 * MiB;
constexpr size_t WS_E = WS_W2 + 64 * MiB;
constexpr size_t WS_YMIX = WS_E + 64 * MiB;
constexpr size_t WS_Y = WS_YMIX + 64 * MiB;
constexpr size_t WS_UPD = WS_Y + 256 * MiB;
constexpr size_t WS_DEC = WS_UPD + 16 * MiB;
constexpr size_t WS_SPREV = WS_DEC + 1 * MiB;
constexpr size_t WS_TOPG = WS_SPREV + 8 * MiB;
constexpr size_t WS_LIST = WS_TOPG + 1 * MiB;
constexpr size_t WS_BIG = WS_LIST + 4 * MiB;
constexpr size_t BIG_Z = 0, BIG_Q = 96 * MiB, BIG_KV = BIG_Q + 48 * MiB, BIG_K = BIG_KV + 64 * MiB, BIG_LA = BIG_K + 48 * MiB;
constexpr size_t WS_ROPE = WS_BIG + 272 * MiB;
constexpr size_t WS_LRS = WS_ROPE + 4 * MiB;
constexpr size_t WS_LGT = WS_LRS + 4 * MiB;
constexpr size_t WS_END = WS_LGT + 4 * MiB;
constexpr int CTL_CNT = 4096;

constexpr bool MOE_FP8_L0 = true, MOE_FP8_L1 = true;
__device__ __forceinline__ float bf2f(bf16_t v) { return __uint_as_float(((unsigned)v) << 16); }
__device__ __forceinline__ bf16_t f2bf(float f) { unsigned u = __float_as_uint(f); u += 0x7FFFu + ((u >> 16) & 1u); return (bf16_t)(u >> 16); }
__device__ __forceinline__ unsigned pack2(float lo, float hi) { return (unsigned)f2bf(lo) | ((unsigned)f2bf(hi) << 16); }
template <int CTRL> __device__ __forceinline__ float dppx(float v) { return __int_as_float(__builtin_amdgcn_update_dpp(0, __float_as_int(v), CTRL, 0xf, 0xf, true)); }
__device__ __forceinline__ unsigned pack4_fp8(float x0, float x1, float x2, float x3) { int w = 0; w = __builtin_amdgcn_cvt_pk_fp8_f32(x0, x1, w, false); w = __builtin_amdgcn_cvt_pk_fp8_f32(x2, x3, w, true); return (unsigned)w; }
__device__ __forceinline__ float wave_sum(float v) {
    v += dppx<0xB1>(v); v += dppx<0x4E>(v); v += dppx<0x141>(v); v += dppx<0x140>(v);
    { auto rr = __builtin_amdgcn_permlane16_swap(__float_as_uint(v), __float_as_uint(v), false, false); v = __uint_as_float(rr[0]) + __uint_as_float(rr[1]); }
    { auto rr = __builtin_amdgcn_permlane32_swap(__float_as_uint(v), __float_as_uint(v), false, false); v = __uint_as_float(rr[0]) + __uint_as_float(rr[1]); }
    return v;
}
__device__ __forceinline__ float wave_max(float v) {
    v = fmaxf(v, dppx<0xB1>(v)); v = fmaxf(v, dppx<0x4E>(v)); v = fmaxf(v, dppx<0x141>(v)); v = fmaxf(v, dppx<0x140>(v));
    { auto rr = __builtin_amdgcn_permlane16_swap(__float_as_uint(v), __float_as_uint(v), false, false); v = fmaxf(__uint_as_float(rr[0]), __uint_as_float(rr[1])); }
    { auto rr = __builtin_amdgcn_permlane32_swap(__float_as_uint(v), __float_as_uint(v), false, false); v = fmaxf(__uint_as_float(rr[0]), __uint_as_float(rr[1])); }
    return v;
}
__device__ __forceinline__ float sigmoidf_(float x) { return 1.0f / (1.0f + __expf(-x)); }


#define XB_TMO      128
#define XB_XCNT(j)  (256  + 64 * (j))
#define XB_XSUB(j)  (1280 + 64 * (j))
#define XB_XGEN(j)  (2304 + 64 * (j))
#define XB_TOP      3328
#define XB_TOPGEN   3392
#define XCD_BAR_WORDS 3456
#define XB_SPIN_CAP (1u << 18)
#define LAS __attribute__((address_space(3)))

constexpr int LDS_WID_OFF = 147456 - 16 - 256, LDS_GRID_OFF = 147456 - 16 + 8;
__device__ __forceinline__ int grid_size() { extern __shared__ __attribute__((aligned(16))) unsigned char lds_dyn_[]; return __builtin_amdgcn_readfirstlane(*(const volatile LAS int*)((LAS unsigned char*)lds_dyn_ + LDS_GRID_OFF)); }
__device__ __forceinline__ unsigned hw_wave_key() { return (unsigned)__builtin_amdgcn_s_getreg((5 << 11) | 4) & 63u; }
__device__ __forceinline__ int opaque_tid() {
    extern __shared__ __attribute__((aligned(16))) unsigned char lds_dyn_[];
    const int wv = __builtin_amdgcn_readfirstlane(*(const volatile LAS int*)((LAS unsigned char*)lds_dyn_ + LDS_WID_OFF + hw_wave_key() * 4));
    int ln; asm volatile("v_mbcnt_lo_u32_b32 %0, -1, 0\n\tv_mbcnt_hi_u32_b32 %0, -1, %0" : "=v"(ln));
    int t = wv * 64 + ln;
    asm volatile("" : "+v"(t)); return t;
}

__device__ __forceinline__ unsigned xb_ld(unsigned* p)              { return __hip_atomic_load(p, __ATOMIC_RELAXED, __HIP_MEMORY_SCOPE_AGENT); }
__device__ __forceinline__ unsigned xb_add(unsigned* p, unsigned v) { return __hip_atomic_fetch_add(p, v, __ATOMIC_RELAXED, __HIP_MEMORY_SCOPE_AGENT); }
__device__ __forceinline__ unsigned xb_xcc_id() { return (unsigned)__builtin_amdgcn_s_getreg((3 << 11) | 20) & 0xFu; }
#define XB_SPIN(cond, bar) do { unsigned _sp = 0; while (cond) { __builtin_amdgcn_s_sleep(1); \
    if ((++_sp & 255u) == 0u) { if (xb_ld(&(bar)[XB_TMO])) break; if (_sp > XB_SPIN_CAP) { atomicAdd(&(bar)[XB_TMO], 1u); break; } } } } while (0)

struct XcdBarrier {
    unsigned* bar; unsigned x;
    volatile LAS unsigned* st;
};

__device__ __forceinline__ XcdBarrier xcd_barrier_post(unsigned* bar, volatile LAS unsigned* st) {
    XcdBarrier b; b.bar = bar; b.x = xb_xcc_id(); b.st = st;
    if (threadIdx.x == 0) (void)xb_add(&bar[XB_XCNT(b.x)], 1u);
    return b;
}
__device__ __forceinline__ void xcd_barrier_complete(unsigned* bar, unsigned x, unsigned& nloc, unsigned& nx) {
    const unsigned G = (unsigned)grid_size();
    unsigned sum, cnt, mine, sp = 0u;
    for (;;) {
        sum = 0u; cnt = 0u; mine = 0u;
#pragma unroll
        for (unsigned j = 0; j < 16; ++j) { const unsigned c = xb_ld(&bar[XB_XCNT(j)]); sum += c; cnt += (c > 0u) ? 1u : 0u; mine = (j == x) ? c : mine; }
        if (sum == G) break;
        __builtin_amdgcn_s_sleep(1);
        if ((++sp & 255u) == 0u) { if (xb_ld(&bar[XB_TMO])) break; if (sp > XB_SPIN_CAP) { atomicAdd(&bar[XB_TMO], 1u); break; } }
    }
    nloc = mine > 0u ? mine : 1u; nx = cnt > 0u ? cnt : 1u;
}

__device__ __forceinline__ void xcd_barrier1(const XcdBarrier& b) {
    asm volatile("s_waitcnt vmcnt(0)" ::: "memory");
    __syncthreads();
    if (opaque_tid() == 0) {
        unsigned* bar = b.bar;
        __builtin_amdgcn_s_waitcnt(0);
        unsigned nloc = b.st[0], nx = b.st[1];
        if (nloc == 0u) { xcd_barrier_complete(bar, b.x, nloc, nx); b.st[0] = nloc; b.st[1] = nx; }
        const unsigned old = xb_add(&bar[XB_XSUB(b.x)], 1u);
        const unsigned gen = old / nloc;
        if (old + 1u == (gen + 1u) * nloc) {
            __builtin_amdgcn_fence(__ATOMIC_RELEASE, "agent");
            asm volatile("s_waitcnt vmcnt(0)" ::: "memory");
            const unsigned og = xb_add(&bar[XB_TOP], 1u);
            const unsigned tg = og / nx;
            if (og + 1u == (tg + 1u) * nx) xb_add(&bar[XB_TOPGEN], 1u);
            else XB_SPIN(xb_ld(&bar[XB_TOPGEN]) == tg, bar);
            __builtin_amdgcn_fence(__ATOMIC_ACQUIRE, "agent");
            xb_add(&bar[XB_XGEN(b.x)], 1u);
            asm volatile("s_waitcnt vmcnt(0)" ::: "memory");
        } else {
            XB_SPIN(xb_ld(&bar[XB_XGEN(b.x)]) == gen, bar);
            __builtin_amdgcn_fence(__ATOMIC_ACQUIRE, "agent");
            asm volatile("s_waitcnt vmcnt(0)" ::: "memory");
        }
    }
    __syncthreads();
}

struct Params {
    const float *x, *p; const int* pos;
    const float *mix_norm, *w_in, *gla_wg, *gla_bg, *gla_on, *q_norm, *w_uq, *kv_norm, *w_ukv, *qkq, *qkk, *pool_w, *pool_s, *w_out, *ffn_norm, *router_w, *router_b,
        *moe_wg, *moe_bg, *moe_wu, *moe_bu, *moe_wd, *moe_bd, *ple_wp, *ple_gn, *ple_wg, *ple_pn;
    float* out; char* ws; int grid; int pad_;
};


#ifdef DBL_BAR
__device__ __forceinline__ void xcd_barrier(const XcdBarrier& b) { xcd_barrier1(b); xcd_barrier1(b); }
#else
__device__ __forceinline__ void xcd_barrier(const XcdBarrier& b) { xcd_barrier1(b); }
#endif
constexpr int NTHR = 512, NWV = 8;

constexpr int LDS_BYTES = 147456;
constexpr int LDS_BAR_OFF = LDS_BYTES - 16;

__device__ __forceinline__ void ph_tconv(const float* src, const float* src2, const float* gain, bf16_t* dst, int N, int K, int ld_src, int mode, int nexp, long se, long de, unsigned char* lds) {
    const int tz = opaque_tid(); const int tid = tz & 255, half = tz >> 8, tx = tid & 63, ty = tid >> 6;
    float (*tile)[65] = (float (*)[65])(lds + half * 16640);
    const int nx = N / 64, ny = K / 64, nunits = nx * ny * nexp;
    for (int u0 = blockIdx.x * 2; u0 < nunits; u0 += grid_size() * 2) {
        const int u = u0 + half; const int bx = u % nx, by = (u / nx) % ny, e = u / (nx * ny);
        const float* s1 = src + (long)e * se; const float* s2 = src2 ? src2 + (long)e * se : nullptr; bf16_t* d = dst + (long)e * de;
        const int n0 = bx * 64, k0 = by * 64, n = n0 + tx;
        const float* sp = s1; int col;
        if (mode == 0) col = n;
        else if (mode == 1) col = zsrc(n);
        else { const int tl = n >> 8, w = n & 255; if (w < 128) col = tl * 128 + w; else { col = tl * 128 + (w - 128); sp = s2; } }
#pragma unroll
        for (int i = 0; i < 16; ++i) {
            const int k = k0 + ty + 4 * i; float v = 0.f;
            if (col >= 0) v = sp[(long)k * ld_src + col];
            if (gain) v *= gain[k];
            tile[ty + 4 * i][tx] = v;
        }
        __syncthreads();
        const int nl = tid >> 2, ks = (tid & 3) * 16;
        unsigned w0 = pack2(tile[ks + 0][nl], tile[ks + 1][nl]), w1 = pack2(tile[ks + 2][nl], tile[ks + 3][nl]), w2 = pack2(tile[ks + 4][nl], tile[ks + 5][nl]), w3 = pack2(tile[ks + 6][nl], tile[ks + 7][nl]);
        unsigned w4 = pack2(tile[ks + 8][nl], tile[ks + 9][nl]), w5 = pack2(tile[ks + 10][nl], tile[ks + 11][nl]), w6 = pack2(tile[ks + 12][nl], tile[ks + 13][nl]), w7 = pack2(tile[ks + 14][nl], tile[ks + 15][nl]);
        uint4* o = (uint4*)(d + (long)(n0 + nl) * K + k0 + ks);
        o[0] = make_uint4(w0, w1, w2, w3); o[1] = make_uint4(w4, w5, w6, w7);
        __syncthreads();
    }
}

template <bool FP8> __device__ __forceinline__ void ph_tconv_exp(const Params& P, int layer, LAS unsigned char* lds) {
    const int tid = opaque_tid();
    const int lr = tid >> 6, c4 = tid & 63;
    const int sn = tid >> 3, sk = tid & 7;
    constexpr int PITCH = FP8 ? 80 : 144;
    LAS unsigned char* tile = lds;
    const float* gain = P.ffn_norm + layer * 1024;
    const int nunits = 3 * 32 * 16 * 4;
    for (int u = blockIdx.x; u < nunits; u += grid_size()) {
        const int nt = u & 3, kt = (u >> 2) & 15, e = (u >> 6) & 31, mat = u >> 11;
        const float* src = (mat == 0 ? P.moe_wg : mat == 1 ? P.moe_wu : P.moe_wd) + ((size_t)layer * 32 + e) * 1024 * 1024 + (size_t)(kt * 64) * 1024 + nt * 256 + c4 * 4;
        f32x4 v[8];
#pragma unroll
        for (int i = 0; i < 8; ++i) v[i] = *(const f32x4*)(src + (size_t)(lr + 8 * i) * 1024);
        if (mat < 2) {
#pragma unroll
            for (int i = 0; i < 8; ++i) v[i] *= gain[kt * 64 + lr + 8 * i];
        }
        __syncthreads();
        if constexpr (FP8) {
#pragma unroll
            for (int i = 0; i < 8; ++i) { const unsigned w = pack4_fp8(v[i][0] * 64.0f, v[i][1] * 64.0f, v[i][2] * 64.0f, v[i][3] * 64.0f);
#pragma unroll
                for (int j = 0; j < 4; ++j) tile[(c4 * 4 + j) * PITCH + lr + 8 * i] = (unsigned char)(w >> (8 * j)); }
        } else {
#pragma unroll
            for (int i = 0; i < 8; ++i)
#pragma unroll
                for (int j = 0; j < 4; ++j) *(LAS bf16_t*)(tile + (c4 * 4 + j) * PITCH + (lr + 8 * i) * 2) = f2bf(v[i][j]);
        }
        __syncthreads();
        typedef unsigned u32x4 __attribute__((ext_vector_type(4)));
        if constexpr (FP8) {
            unsigned char* dst = (mat < 2) ? (unsigned char*)(P.ws + WS_W1) + (size_t)e * 2048 * 1024 : (unsigned char*)(P.ws + WS_W2) + (size_t)e * 1024 * 1024;
#pragma unroll
            for (int j = 0; j < 2; ++j) {
                const int id = tid + 512 * j, nl = id >> 2, ck = id & 3, n = nt * 256 + nl;
                const int drow = (mat == 2) ? n : ((n >> 7) * 256 + (n & 127) + (mat == 1 ? 128 : 0));
                *(u32x4*)(dst + (size_t)drow * 1024 + kt * 64 + ck * 16) = *(const LAS u32x4*)(tile + nl * PITCH + ck * 16);
            }
        } else {
            bf16_t* dst = (mat < 2) ? (bf16_t*)(P.ws + WS_W1) + (size_t)e * 2048 * 1024 : (bf16_t*)(P.ws + WS_W2) + (size_t)e * 1024 * 1024;
#pragma unroll
            for (int j = 0; j < 4; ++j) {
                const int nl = sn + 64 * j, n = nt * 256 + nl;
                const int drow = (mat == 2) ? n : ((n >> 7) * 256 + (n & 127) + (mat == 1 ? 128 : 0));
                *(u32x4*)(dst + (size_t)drow * 1024 + kt * 64 + sk * 8) = *(const LAS u32x4*)(tile + nl * PITCH + sk * 16);
            }
        }
    }
    __syncthreads();
}
__device__ __forceinline__ void ph_conv_bf16(const float* src, bf16_t* dst, long n8) {
    const int tz = opaque_tid();
    for (int i = blockIdx.x * NTHR + tz; i < (int)n8; i += grid_size() * NTHR) {
        const float4 a = ((const float4*)src)[2 * i], b = ((const float4*)src)[2 * i + 1];
        ((uint4*)dst)[i] = make_uint4(pack2(a.x, a.y), pack2(a.z, a.w), pack2(b.x, b.y), pack2(b.z, b.w));
    }
}
__device__ __forceinline__ void ph_prep_router(const Params& P) {
    const int tz = opaque_tid();
    for (int i = blockIdx.x * NTHR + tz; i < 2 * 4 * 64 * 64; i += grid_size() * NTHR) {
        const int l = i >> 14, g = (i >> 12) & 3, d = (i >> 6) & 63, c = i & 63;
        ((bf16_t*)(P.ws + WS_WSM + (size_t)l * WSM_STRIDE + WSM_WPT))[(g * 64 + d) * 64 + c] = f2bf(P.pool_w[(size_t)l * 16384 + (g * 64 + c) * 64 + d]);
    }
    for (int i = blockIdx.x * NTHR + tz; i < 2 * 32 * 1024; i += grid_size() * NTHR) {
        const int l = i >> 15, e = (i >> 10) & 31, k = i & 1023;
        float* Wr = (float*)(P.ws + WS_WSM + (size_t)l * WSM_STRIDE + WSM_WR);
        Wr[e * 1024 + k] = P.router_w[((size_t)l * 1024 + k) * 32 + e] * P.ffn_norm[l * 1024 + k];
    }
}


__device__ __forceinline__ void ph_rope_table(const Params& P) {
    const int tz = opaque_tid();
    float* RT = (float*)(P.ws + WS_ROPE);
    for (int e = blockIdx.x * NTHR + tz; e < T * 16; e += grid_size() * NTHR) {
        const int t = e >> 4, i = e & 15;
        const float inv = exp2f(-(float)(2 * i) * (1.0f / 32.0f) * 13.287712379549449f);
        const float ang = (float)P.pos[t] * inv;
        RT[(size_t)t * 32 + i] = cosf(ang); RT[(size_t)t * 32 + 16 + i] = sinf(ang);
    }
}

__device__ __forceinline__ void ph_init_h(const Params& P) {
    const int tz = opaque_tid(); const int wid = tz >> 6, lane = tz & 63;
    bf16_t* HB = (bf16_t*)(P.ws + WS_HB); float* RS = (float*)(P.ws + WS_RSTD);
    for (int t = blockIdx.x * NWV + wid; t < T; t += grid_size() * NWV) {
        const float* hr = P.x + (size_t)t * 1024;
        float ss = 0.f; float4 v[4];
#pragma unroll
        for (int i = 0; i < 4; ++i) { v[i] = *(const float4*)(hr + i * 256 + lane * 4); ss += v[i].x * v[i].x + v[i].y * v[i].y + v[i].z * v[i].z + v[i].w * v[i].w; }
        ss = wave_sum(ss);
        if (lane == 0) RS[t] = rsqrtf(ss * (1.0f / 1024.0f) + EPS);
#pragma unroll
        for (int i = 0; i < 4; ++i) *(uint2*)(HB + (size_t)t * 1024 + i * 256 + lane * 4) = make_uint2(pack2(v[i].x, v[i].y), pack2(v[i].z, v[i].w));
    }
}

__device__ __forceinline__ void ph_prepB(const Params& P, int layer, unsigned char* lds) {
    float* wg = (float*)lds;
    const int tid = opaque_tid(), wid = tid >> 6, lane = tid & 63;
    for (int i = tid; i < 16 * 128; i += NTHR) wg[i] = P.gla_wg[(size_t)layer * 2048 + i];
    __syncthreads();
    bf16_t* Z = (bf16_t*)(P.ws + WS_BIG + BIG_Z); float* LA = (float*)(P.ws + WS_BIG + BIG_LA); bf16_t* YM = (bf16_t*)(P.ws + WS_YMIX);
    const float* bg = P.gla_bg + layer * 128; const float* psc = P.pool_s + layer * 256;
    const float bg0 = bg[lane], bg1 = bg[lane + 64];
    for (int t0 = (blockIdx.x * NWV + wid) * 2; t0 < T; t0 += grid_size() * NWV * 2) {
        uint2 cq[2]; unsigned ckv[2]; float gl[2];
#pragma unroll
        for (int tt = 0; tt < 2; ++tt) { const bf16_t* zr = Z + (size_t)(t0 + tt) * ZW; cq[tt] = *(const uint2*)(zr + ZC_CQ + lane * 4); ckv[tt] = *(const unsigned*)(zr + ZC_CKV + lane * 2); gl[tt] = (lane < 16) ? bf2f(zr[ZC_GLOW + lane]) : 0.f; }
#pragma unroll
        for (int tt = 0; tt < 2; ++tt) {
            bf16_t* zr = Z + (size_t)(t0 + tt) * ZW;
            {
                const float a = bf2f(cq[tt].x & 0xffff), b = bf2f(cq[tt].x >> 16), c = bf2f(cq[tt].y & 0xffff), d = bf2f(cq[tt].y >> 16);
                const float r = rsqrtf(wave_sum(a * a + b * b + c * c + d * d) * (1.0f / 256.0f) + EPS);
                *(uint2*)(zr + ZC_CQ + lane * 4) = make_uint2(pack2(a * r, b * r), pack2(c * r, d * r));
            }
            {
                const float a = bf2f(ckv[tt] & 0xffff), b = bf2f(ckv[tt] >> 16);
                const float r = rsqrtf(wave_sum(a * a + b * b) * (1.0f / 128.0f) + EPS);
                *(unsigned*)(zr + ZC_CKV + lane * 2) = pack2(a * r, b * r);
            }
            {
                float l0 = bg0, l1 = bg1;
#pragma unroll
                for (int r = 0; r < 16; ++r) { const float g = __uint_as_float(__builtin_amdgcn_readlane(__float_as_uint(gl[tt]), r)); l0 += g * wg[r * 128 + lane]; l1 += g * wg[r * 128 + lane + 64]; }
                const float a0 = fminf(l0, 0.f) - log1pf(__expf(-fabsf(l0))), a1 = fminf(l1, 0.f) - log1pf(__expf(-fabsf(l1)));
                LA[(size_t)(t0 + tt) * 128 + lane] = a0 * (1.0f / 16.0f); LA[(size_t)(t0 + tt) * 128 + lane + 64] = a1 * (1.0f / 16.0f);
            }
        }
    }
    const bf16_t* WpT = (const bf16_t*)(P.ws + WS_WSM + (size_t)layer * WSM_STRIDE + WSM_WPT);
    const int fr = lane & 15, fq = lane >> 4;
    for (int u = blockIdx.x * NWV + wid; u < T / 16; u += grid_size() * NWV) {
        const int t = u * 16 + fr, sq = t & (SEQ - 1);
#pragma unroll
        for (int gi = 0; gi < 4; ++gi) {
            const int w = 2 << gi; const int cnt = (sq + 1 < w) ? sq + 1 : w; const float rc = 1.0f / (float)cnt;
            bf16x8 af[2];
#pragma unroll
            for (int ks = 0; ks < 2; ++ks) {
                const bf16_t* up = Z + (size_t)t * ZW + ZC_UP + gi * 64 + ks * 32 + fq * 8;
                float acc[8], u0[8];
#pragma unroll
                for (int j = 0; j < 16; ++j) if (j < w) {
                    const int jj = (j < cnt) ? j : 0; const float msk = (j < cnt) ? 1.0f : 0.f;
                    const uint4 x = *(const uint4*)(up - (long)jj * ZW);
                    const float xv[8] = {bf2f(x.x & 0xffff), bf2f(x.x >> 16), bf2f(x.y & 0xffff), bf2f(x.y >> 16), bf2f(x.z & 0xffff), bf2f(x.z >> 16), bf2f(x.w & 0xffff), bf2f(x.w >> 16)};
#pragma unroll
                    for (int e = 0; e < 8; ++e) { if (j == 0) { u0[e] = xv[e]; acc[e] = xv[e]; } else acc[e] += msk * xv[e]; }
                }
                typedef unsigned u32x4 __attribute__((ext_vector_type(4)));
                const u32x4 pk = {pack2(acc[0] * rc - u0[0], acc[1] * rc - u0[1]), pack2(acc[2] * rc - u0[2], acc[3] * rc - u0[3]), pack2(acc[4] * rc - u0[4], acc[5] * rc - u0[5]), pack2(acc[6] * rc - u0[6], acc[7] * rc - u0[7])};
                af[ks] = __builtin_bit_cast(bf16x8, pk);
            }
#pragma unroll
            for (int nb = 0; nb < 4; ++nb) {
                f32x4 acc = {0.f, 0.f, 0.f, 0.f};
#pragma unroll
                for (int ks = 0; ks < 2; ++ks) { const bf16x8 bfr = *(const bf16x8*)(WpT + ((size_t)gi * 64 + nb * 16 + fr) * 64 + ks * 32 + fq * 8); acc = __builtin_amdgcn_mfma_f32_16x16x32_bf16(bfr, af[ks], acc, 0, 0, 0); }
                const int d0 = nb * 16 + fq * 4; const f32x4 sc = *(const f32x4*)(psc + gi * 64 + d0);
                *(uint2*)(YM + (size_t)t * 1024 + 768 + gi * 64 + d0) = make_uint2(pack2(acc[0] * sc[0], acc[1] * sc[1]), pack2(acc[2] * sc[2], acc[3] * sc[3]));
            }
        }
    }
}

template <bool DRY = false> __device__ __forceinline__ void ph_prepD(const Params& P, int layer) {
    const int tid = opaque_tid(), wid = tid >> 6, lane = tid & 63;
    bf16_t* Z = (bf16_t*)(P.ws + WS_BIG + BIG_Z); bf16_t* Q = (bf16_t*)(P.ws + WS_BIG + BIG_Q); const bf16_t* KV = (const bf16_t*)(P.ws + WS_BIG + BIG_KV); bf16_t* Kd = DRY ? (bf16_t*)(P.ws + WS_Y + 64 * MiB) : (bf16_t*)(P.ws + WS_BIG + BIG_K);
    bf16_t* QW = DRY ? (bf16_t*)(P.ws + WS_Y) : Q;
    const float* RT = (const float*)(P.ws + WS_ROPE);
    const float gq0 = P.qkq[layer * 96 + lane], gq1 = (lane < 32) ? P.qkq[layer * 96 + 64 + lane] : 0.f;
    const float gk0 = P.qkk[layer * 96 + lane], gk1 = (lane < 32) ? P.qkk[layer * 96 + 64 + lane] : 0.f;
    const float qscale = 0.10206207261596577f * 1.4426950408889634f;
    for (int t = blockIdx.x * NWV + wid; t < T; t += grid_size() * NWV) {
        const float cs = RT[(size_t)t * 32 + (lane & 15)], sn = RT[(size_t)t * 32 + 16 + (lane & 15)];
        const float kr = (lane < 32) ? bf2f(Z[(size_t)t * ZW + ZC_KR + lane]) : 0.f;
        float qa[8], qb[8], ka[8];
#pragma unroll
        for (int h = 0; h < 8; ++h) {
            qa[h] = bf2f(Q[(size_t)t * 768 + h * 96 + lane]); qb[h] = (lane < 32) ? bf2f(Q[(size_t)t * 768 + h * 96 + 64 + lane]) : 0.f;
            ka[h] = bf2f(KV[(size_t)t * 1024 + h * 128 + lane]);
        }
#pragma unroll
        for (int h = 0; h < 8; ++h) {
            {
                const float r = rsqrtf(wave_sum(qa[h] * qa[h] + qb[h] * qb[h]) * (1.0f / 96.0f) + EPS);
                const float an = qa[h] * r * gq0, bn = qb[h] * r * gq1;
                const float partner = __shfl_xor(bn, 16);
                const float rot = (lane < 16) ? (bn * cs - partner * sn) : (bn * cs + partner * sn);
                QW[(size_t)t * 768 + h * 96 + lane] = f2bf(an * qscale);
                if (lane < 32) QW[(size_t)t * 768 + h * 96 + 64 + lane] = f2bf(rot * qscale);
            }
            {
                const float r = rsqrtf(wave_sum(ka[h] * ka[h] + kr * kr) * (1.0f / 96.0f) + EPS);
                const float an = ka[h] * r * gk0, bn = kr * r * gk1;
                const float partner = __shfl_xor(bn, 16);
                const float rot = (lane < 16) ? (bn * cs - partner * sn) : (bn * cs + partner * sn);
                bf16_t* kp = Kd + ((size_t)t * 8 + h) * 96;
                kp[lane] = f2bf(an);
                if (lane < 32) kp[64 + lane] = f2bf(rot);
            }
        }
    }
}

template <bool FP8> __device__ __forceinline__ void ph_router(const Params& P, int layer, LAS unsigned char* lds) {
    const int tid = opaque_tid(), wid = tid >> 6, lane = tid & 63;
    bf16_t* HB = (bf16_t*)(P.ws + WS_HB); float* RS1 = (float*)(P.ws + WS_RSTD) + T;
    const float* Wr = (const float*)(P.ws + WS_WSM + (size_t)layer * WSM_STRIDE + WSM_WR);
    const float* rb = P.router_b + layer * 32;
    unsigned* cnt = (unsigned*)(P.ws + WS_CTL) + CTL_CNT + layer * 32;
    int* LIST = (int*)(P.ws + WS_LIST); float* TOPG = (float*)(P.ws + WS_TOPG);
    LAS f32x4* wl = (LAS f32x4*)lds;
    for (int i = tid; i < 32 * 256; i += NTHR) wl[i] = *(const f32x4*)(Wr + (size_t)i * 4);
    __syncthreads();
    const float myb = rb[lane >> 1];
    for (int t0 = (blockIdx.x * NWV + wid) * 2; t0 < T; t0 += grid_size() * NWV * 2) {
        f32x4 v[2][4]; float rstd[2];
#pragma unroll
        for (int tt = 0; tt < 2; ++tt) {
            const float* hr = P.out + (size_t)(t0 + tt) * 1024; float ss = 0.f;
#pragma unroll
            for (int i = 0; i < 4; ++i) { v[tt][i] = *(const f32x4*)(hr + i * 256 + lane * 4); ss += v[tt][i][0] * v[tt][i][0] + v[tt][i][1] * v[tt][i][1] + v[tt][i][2] * v[tt][i][2] + v[tt][i][3] * v[tt][i][3]; }
            ss = wave_sum(ss);
            rstd[tt] = rsqrtf(ss * (1.0f / 1024.0f) + EPS);
            if (lane == 0) RS1[t0 + tt] = rstd[tt];
#pragma unroll
            for (int i = 0; i < 4; ++i) {
                if constexpr (FP8) *(unsigned*)((unsigned char*)HB + (size_t)(t0 + tt) * 1024 + i * 256 + lane * 4) = pack4_fp8(v[tt][i][0], v[tt][i][1], v[tt][i][2], v[tt][i][3]);
                else *(uint2*)(HB + (size_t)(t0 + tt) * 1024 + i * 256 + lane * 4) = make_uint2(pack2(v[tt][i][0], v[tt][i][1]), pack2(v[tt][i][2], v[tt][i][3]));
            }
        }
        float q0[16], q1[16];
        {
            const bool lo5 = !(lane & 32);
#pragma unroll
            for (int e = 0; e < 16; ++e) {
                float a0 = 0.f, a1 = 0.f, b0 = 0.f, b1 = 0.f;
#pragma unroll
                for (int i = 0; i < 4; ++i) {
                    const f32x4 w = wl[e * 256 + i * 64 + lane], x = wl[(e + 16) * 256 + i * 64 + lane];
                    a0 += v[0][i][0] * w[0] + v[0][i][1] * w[1] + v[0][i][2] * w[2] + v[0][i][3] * w[3];
                    a1 += v[1][i][0] * w[0] + v[1][i][1] * w[1] + v[1][i][2] * w[2] + v[1][i][3] * w[3];
                    b0 += v[0][i][0] * x[0] + v[0][i][1] * x[1] + v[0][i][2] * x[2] + v[0][i][3] * x[3];
                    b1 += v[1][i][0] * x[0] + v[1][i][1] * x[1] + v[1][i][2] * x[2] + v[1][i][3] * x[3];
                }
                q0[e] = (lo5 ? a0 : b0) + __shfl_xor(lo5 ? b0 : a0, 32);
                q1[e] = (lo5 ? a1 : b1) + __shfl_xor(lo5 ? b1 : a1, 32);
                asm volatile("" ::: "memory");
            }
        }
#define RT_STEP(src, dst, n, bit) do { const bool lo_ = !(lane & (bit)); _Pragma("unroll") for (int e_ = 0; e_ < (n); ++e_) { \
            const float mine_ = lo_ ? src[e_] : src[e_ + (n)], give_ = lo_ ? src[e_ + (n)] : src[e_]; dst[e_] = mine_ + __shfl_xor(give_, (bit)); } } while (0)
        float lg[2];
        {
            float r[8], s4[4], s2[2];
            RT_STEP(q0, r, 8, 16); RT_STEP(r, s4, 4, 8); RT_STEP(s4, s2, 2, 4);
            { const bool lo_ = !(lane & 2); const float mine_ = lo_ ? s2[0] : s2[1], give_ = lo_ ? s2[1] : s2[0]; float x = mine_ + __shfl_xor(give_, 2); x += __shfl_xor(x, 1); lg[0] = x * rstd[0] + myb; }
            RT_STEP(q1, r, 8, 16); RT_STEP(r, s4, 4, 8); RT_STEP(s4, s2, 2, 4);
            { const bool lo_ = !(lane & 2); const float mine_ = lo_ ? s2[0] : s2[1], give_ = lo_ ? s2[1] : s2[0]; float x = mine_ + __shfl_xor(give_, 2); x += __shfl_xor(x, 1); lg[1] = x * rstd[1] + myb; }
        }
#undef RT_STEP
#pragma unroll
        for (int tt = 0; tt < 2; ++tt) {
            float mylg = lg[tt]; float tv[4]; int ti[4];
#pragma unroll
            for (int k = 0; k < 4; ++k) {
                const float best = wave_max(mylg);
                const unsigned long long mask = __ballot(mylg == best);
                const int bi = (__ffsll((long long)mask) - 1) >> 1;
                tv[k] = best; ti[k] = bi;
                mylg = ((lane >> 1) == bi) ? -INFINITY : mylg;
            }
            const float e1 = __expf(tv[1] - tv[0]), e2 = __expf(tv[2] - tv[0]), e3 = __expf(tv[3] - tv[0]);
            const float invs = 1.0f / (1.0f + e1 + e2 + e3);
            if (lane < 4) {
                const int e = (lane == 0) ? ti[0] : (lane == 1) ? ti[1] : (lane == 2) ? ti[2] : ti[3];
                const float g = (lane == 0) ? invs : (lane == 1) ? e1 * invs : (lane == 2) ? e2 * invs : e3 * invs;
                const unsigned pos = atomicAdd(&cnt[e], 1u);
                LIST[(size_t)e * T + pos] = (t0 + tt) * 4 + lane;
                ((float*)(P.ws + WS_LRS))[(size_t)e * T + pos] = rstd[tt];
                ((float*)(P.ws + WS_LGT))[(size_t)e * T + pos] = g;
            }
        }
    }
}

template <bool DRY = false> __device__ __forceinline__ void ph_combine(const Params& P) {
    const int tid = opaque_tid(), wid = tid >> 6, lane = tid & 63;
    bf16_t* HB = DRY ? (bf16_t*)(P.ws + WS_BIG + 128 * MiB) : (bf16_t*)(P.ws + WS_HB); float* RS2 = DRY ? (float*)(P.ws + WS_BIG + 200 * MiB) : (float*)(P.ws + WS_RSTD) + 2 * T; const bf16_t* Y = (const bf16_t*)(P.ws + WS_Y);
    float* OUTW = DRY ? (float*)(P.ws + WS_BIG) : P.out;
    for (int t0 = (blockIdx.x * NWV + wid) * 2; t0 < T; t0 += grid_size() * NWV * 2) {
        f32x4 hv[2][4]; uint2 yv[2][4][4];
#pragma unroll
        for (int tt = 0; tt < 2; ++tt)
#pragma unroll
            for (int i = 0; i < 4; ++i) {
                hv[tt][i] = *(const f32x4*)(P.out + (size_t)(t0 + tt) * 1024 + i * 256 + lane * 4);
#pragma unroll
                for (int k = 0; k < 4; ++k) yv[tt][i][k] = *(const uint2*)(Y + ((size_t)(t0 + tt) * 4 + k) * 1024 + i * 256 + lane * 4);
            }
#pragma unroll
        for (int tt = 0; tt < 2; ++tt) {
            float ss = 0.f;
#pragma unroll
            for (int i = 0; i < 4; ++i) {
                f32x4 v = hv[tt][i];
#pragma unroll
                for (int k = 0; k < 4; ++k) { const uint2 y = yv[tt][i][k]; v[0] += bf2f(y.x & 0xffff); v[1] += bf2f(y.x >> 16); v[2] += bf2f(y.y & 0xffff); v[3] += bf2f(y.y >> 16); }
                *(f32x4*)(OUTW + (size_t)(t0 + tt) * 1024 + i * 256 + lane * 4) = v;
                ss += v[0] * v[0] + v[1] * v[1] + v[2] * v[2] + v[3] * v[3];
                *(uint2*)(HB + (size_t)(t0 + tt) * 1024 + i * 256 + lane * 4) = make_uint2(pack2(v[0], v[1]), pack2(v[2], v[3]));
            }
            ss = wave_sum(ss);
            if (lane == 0) RS2[t0 + tt] = rsqrtf(ss * (1.0f / 1024.0f) + EPS);
        }
    }
}

template <bool DRY = false> __device__ __forceinline__ void ph_final(const Params& P, int layer) {
    const int tid = opaque_tid(), wid = tid >> 6, lane = tid & 63;
    bf16_t* HB = DRY ? (bf16_t*)(P.ws + WS_BIG + 128 * MiB) : (bf16_t*)(P.ws + WS_HB); float* RS = DRY ? (float*)(P.ws + WS_BIG + 200 * MiB) : (float*)(P.ws + WS_RSTD); const bf16_t* V = (const bf16_t*)(P.ws + WS_YMIX);
    float* OUTW = DRY ? (float*)(P.ws + WS_BIG) : P.out;
    const float* gp = P.ple_pn + layer * 1024;
    f32x4 g[4];
#pragma unroll
    for (int i = 0; i < 4; ++i) g[i] = *(const f32x4*)(gp + i * 256 + lane * 4);
    for (int t0 = (blockIdx.x * NWV + wid) * 2; t0 < T; t0 += grid_size() * NWV * 2) {
        f32x4 hv[2][4]; uint2 yv[2][4];
#pragma unroll
        for (int tt = 0; tt < 2; ++tt)
#pragma unroll
            for (int i = 0; i < 4; ++i) { hv[tt][i] = *(const f32x4*)(P.out + (size_t)(t0 + tt) * 1024 + i * 256 + lane * 4); yv[tt][i] = *(const uint2*)(V + (size_t)(t0 + tt) * 1024 + i * 256 + lane * 4); }
#pragma unroll
        for (int tt = 0; tt < 2; ++tt) {
            f32x4 vv[4]; float ss = 0.f;
#pragma unroll
            for (int i = 0; i < 4; ++i) { const uint2 y = yv[tt][i]; vv[i] = (f32x4){bf2f(y.x & 0xffff), bf2f(y.x >> 16), bf2f(y.y & 0xffff), bf2f(y.y >> 16)}; ss += vv[i][0] * vv[i][0] + vv[i][1] * vv[i][1] + vv[i][2] * vv[i][2] + vv[i][3] * vv[i][3]; }
            ss = wave_sum(ss);
            const float r = rsqrtf(ss * (1.0f / 1024.0f) + EPS);
            float s2 = 0.f;
#pragma unroll
            for (int i = 0; i < 4; ++i) {
                const f32x4 v = hv[tt][i] + vv[i] * r * g[i];
                *(f32x4*)(OUTW + (size_t)(t0 + tt) * 1024 + i * 256 + lane * 4) = v;
                s2 += v[0] * v[0] + v[1] * v[1] + v[2] * v[2] + v[3] * v[3];
                *(uint2*)(HB + (size_t)(t0 + tt) * 1024 + i * 256 + lane * 4) = make_uint2(pack2(v[0], v[1]), pack2(v[2], v[3]));
            }
            s2 = wave_sum(s2);
            if (lane == 0) RS[t0 + tt] = rsqrtf(s2 * (1.0f / 1024.0f) + EPS);
        }
    }
}

struct EpiZ { bf16_t* Z; const float* rstd;
    __device__ __forceinline__ void operator()(int r, int c, f32x4 v) const { const float s = rstd[r]; *(uint2*)(Z + (size_t)r * ZW + c) = make_uint2(pack2(v[0] * s, v[1] * s), pack2(v[2] * s, v[3] * s)); } };
struct EpiBf16 { bf16_t* O; int ldo;
    __device__ __forceinline__ void operator()(int r, int c, f32x4 v) const { *(uint2*)(O + (size_t)r * ldo + c) = make_uint2(pack2(v[0], v[1]), pack2(v[2], v[3])); } };
struct EpiResid { const float* hin; float* out;
    __device__ __forceinline__ void operator()(int r, int c, f32x4 v) const { const f32x4 b = *(const f32x4*)(hin + (size_t)r * 1024 + c); *(f32x4*)(out + (size_t)r * 1024 + c) = b + v; } };
struct EpiMoe1 { const int* list; const float* rstd1; const float* bg; const float* bu; bf16_t* H;
    __device__ __forceinline__ void operator()(int r, int hc, f32x4 g, f32x4 u) const {
        const float s = rstd1[list[r] >> 2]; const f32x4 b0 = *(const f32x4*)(bg + hc), b1 = *(const f32x4*)(bu + hc); float o[4];
#pragma unroll
        for (int j = 0; j < 4; ++j) { const float gg = fminf(g[j] * s + b0[j], 7.0f); const float uu = fminf(fmaxf(u[j] * s + b1[j], -7.0f), 7.0f); o[j] = (uu + 1.0f) * gg * sigmoidf_(1.702f * gg); }
        *(uint2*)(H + (size_t)r * 1024 + hc) = make_uint2(pack2(o[0], o[1]), pack2(o[2], o[3])); } };
struct EpiMoe2 { const int* list; const float* topg; const float* bd; bf16_t* Y;
    __device__ __forceinline__ void operator()(int r, int c, f32x4 v) const { const int ts = list[r]; const float g = topg[ts]; const f32x4 b = *(const f32x4*)(bd + c);
        *(uint2*)(Y + (size_t)ts * 1024 + c) = make_uint2(pack2((v[0] + b[0]) * g, (v[1] + b[1]) * g), pack2((v[2] + b[2]) * g, (v[3] + b[3]) * g)); } };
struct EpiPle { const bf16_t* E; const float* rstd2; bf16_t* V;
    __device__ __forceinline__ void operator()(int r, int c, f32x4 v) const { const float s = rstd2[r]; const uint2 e = *(const uint2*)(E + (size_t)r * 1024 + c);
        const float o0 = bf2f(e.x & 0xffff) * sigmoidf_(v[0] * s), o1 = bf2f(e.x >> 16) * sigmoidf_(v[1] * s), o2 = bf2f(e.y & 0xffff) * sigmoidf_(v[2] * s), o3 = bf2f(e.y >> 16) * sigmoidf_(v[3] * s);
        *(uint2*)(V + (size_t)r * 1024 + c) = make_uint2(pack2(o0, o1), pack2(o2, o3)); } };


typedef unsigned u32x4_t __attribute__((ext_vector_type(4)));
struct EpiZ8 { bf16_t* Z; const float* rstd;
    __device__ __forceinline__ void operator()(int r, int c, f32x4 a, f32x4 b) const { const float s = rstd[r]; *(u32x4_t*)(Z + (size_t)r * ZW + c) = (u32x4_t){pack2(a[0] * s, a[1] * s), pack2(a[2] * s, a[3] * s), pack2(b[0] * s, b[1] * s), pack2(b[2] * s, b[3] * s)}; } };
struct EpiBf16_8 { bf16_t* O; int ldo;
    __device__ __forceinline__ void operator()(int r, int c, f32x4 a, f32x4 b) const { *(u32x4_t*)(O + (size_t)r * ldo + c) = (u32x4_t){pack2(a[0], a[1]), pack2(a[2], a[3]), pack2(b[0], b[1]), pack2(b[2], b[3])}; } };
struct EpiPle8 { const bf16_t* E; const float* rstd2; bf16_t* V;
    __device__ __forceinline__ void operator()(int r, int c, f32x4 a, f32x4 b) const { const float s = rstd2[r]; const u32x4_t e = *(const u32x4_t*)(E + (size_t)r * 1024 + c);
        *(u32x4_t*)(V + (size_t)r * 1024 + c) = (u32x4_t){pack2(bf2f(e[0] & 0xffff) * sigmoidf_(a[0] * s), bf2f(e[0] >> 16) * sigmoidf_(a[1] * s)), pack2(bf2f(e[1] & 0xffff) * sigmoidf_(a[2] * s), bf2f(e[1] >> 16) * sigmoidf_(a[3] * s)),
                                                            pack2(bf2f(e[2] & 0xffff) * sigmoidf_(b[0] * s), bf2f(e[2] >> 16) * sigmoidf_(b[1] * s)), pack2(bf2f(e[3] & 0xffff) * sigmoidf_(b[2] * s), bf2f(e[3] >> 16) * sigmoidf_(b[3] * s))}; } };
__device__ __forceinline__ float swiglu_(float g, float u, float s, float bgv, float buv) { const float gg = fminf(g * s + bgv, 7.0f); const float uu = fminf(fmaxf(u * s + buv, -7.0f), 7.0f); return (uu + 1.0f) * gg * sigmoidf_(1.702f * gg); }

template <class Epi, bool PAIR>
__device__ __forceinline__ void gemm_simple_unit(const bf16_t* A, int lda, const int* rowidx, const bf16_t* Bt, int ldb, int M, int K, int mblk, int nblk, const Epi& epi) {
    const int tid = opaque_tid(), wid = tid >> 6, lane = tid & 63, wr = wid >> 1, wc = wid & 1, fr = lane & 15, fq = lane >> 4;
    const int m0 = mblk * 256 + wr * 64;
    if (m0 >= M) return;
    const bf16_t* ap[4]; const bf16_t* bp[4];
#pragma unroll
    for (int mi = 0; mi < 4; ++mi) { int r = m0 + mi * 16 + fr; if (r >= M) r = M - 1; const long ar = rowidx ? (long)(rowidx[r] >> 2) : (long)r; ap[mi] = A + ar * lda + fq * 8; }
#pragma unroll
    for (int ni = 0; ni < 4; ++ni) {
        int br;
        if (PAIR) { const int hc = nblk * 64 + wc * 32 + (ni & 1) * 16 + fr; br = (hc >> 7) * 256 + (hc & 127) + ((ni >> 1) ? 128 : 0); }
        else br = nblk * 128 + wc * 64 + ni * 16 + fr;
        bp[ni] = Bt + (long)br * ldb + fq * 8;
    }
    f32x4 acc[4][4];
#pragma unroll
    for (int mi = 0; mi < 4; ++mi)
#pragma unroll
        for (int ni = 0; ni < 4; ++ni) acc[mi][ni] = (f32x4){0.f, 0.f, 0.f, 0.f};
    for (int k0 = 0; k0 < K; k0 += 32) {
        bf16x8 a[4], b[4];
#pragma unroll
        for (int i = 0; i < 4; ++i) { a[i] = *(const bf16x8*)(ap[i] + k0); b[i] = *(const bf16x8*)(bp[i] + k0); }
#pragma unroll
        for (int mi = 0; mi < 4; ++mi)
#pragma unroll
            for (int ni = 0; ni < 4; ++ni) acc[mi][ni] = __builtin_amdgcn_mfma_f32_16x16x32_bf16(b[ni], a[mi], acc[mi][ni], 0, 0, 0);
    }
#pragma unroll
    for (int mi = 0; mi < 4; ++mi) {
        const int r = m0 + mi * 16 + fr;
        if (r < M) {
            if constexpr (PAIR) {
#pragma unroll
                for (int ni = 0; ni < 2; ++ni) epi(r, nblk * 64 + wc * 32 + ni * 16 + fq * 4, acc[mi][ni], acc[mi][ni + 2]);
            } else {
#pragma unroll
                for (int ni = 0; ni < 4; ++ni) epi(r, nblk * 128 + wc * 64 + ni * 16 + fq * 4, acc[mi][ni]);
            }
        }
    }
}

namespace fg {
typedef int v4i_t __attribute__((ext_vector_type(4))); typedef int v8i_t __attribute__((ext_vector_type(8)));
constexpr int BM = 256, BK = 64, HALF = 128, HTB = HALF * BK * 2  , STAGE_BYTES = 8 * HTB, NXCD = 8, WGM = 8;
__host__ __device__ __forceinline__ int lds_byte(int r, int c) { const int st = (r >> 4) * 2 + (c >> 5), rr = r & 15, cc = c & 31, ob = rr * 64 + cc * 2; return st * 1024 + (ob ^ (((ob >> 9) & 1) << 5)); }
__host__ __device__ __forceinline__ int perm32(int rho) { const int n = rho >> 4, i = rho & 15; return 8 * (i >> 2) + 4 * n + (i & 3); }
__host__ __device__ __forceinline__ void stage_rc(int b, int& R, int& C) { const int st = b / 1024, sb = b % 1024, swz = sb ^ (((sb >> 9) & 1) << 5); R = (st >> 1) * 16 + swz / 64; C = (st & 1) * 32 + (swz % 64) / 2; }

template <class PB>
__device__ __forceinline__ void gemm_phase(LAS unsigned char* lds, const PB& S) {
    constexpr int K = PB::K, nt = K / BK;
    typedef typename PB::Unit Unit;
    const int tid = opaque_tid(); const int wid = __builtin_amdgcn_readfirstlane(tid >> 6), lane = tid & 63, wr = wid >> 2, wc = wid & 3, fr = lane & 15, fq = lane >> 4;
    unsigned voffB[2];
#pragma unroll
    for (int i = 0; i < 2; ++i) { int R_, C_; stage_rc(tid * 16 + i * 8192, R_, C_); const int Rb_ = PB::PERM ? ((R_ & ~31) + perm32(R_ & 31)) : R_; voffB[i] = (unsigned)(Rb_ * K + C_) * 2u; }
#define FG_AOFFS(dst, unit) do { int tz_ = tid; asm volatile("" : "+v"(tz_)); _Pragma("unroll") for (int i_ = 0; i_ < 2; ++i_) { int R_, C_; stage_rc(tz_ * 16 + i_ * 8192, R_, C_); \
        _Pragma("unroll") for (int h_ = 0; h_ < 2; ++h_) dst[h_][i_] = S.a_off(unit, h_ * HALF + R_) + (unsigned)C_ * 2u; } } while (0)
    constexpr size_t kstep = (size_t)(BK * 2);
    constexpr size_t hstep = (size_t)HALF * K * 2;
    const unsigned ldsw = (unsigned)wid * 1024u;
    const int aoff = lds_byte(wr * 64 + fr, fq * 8), boff = lds_byte(wc * 32 + fr, fq * 8);
#define FG_SA(b, h) (((b) * 2 + (h)) * HTB)
#define FG_SB(b, h) ((4 + (b) * 2 + (h)) * HTB)
#define FG_STAGE_B(bufoff, gbase) do { _Pragma("unroll") for (int _i = 0; _i < 2; ++_i) \
        __builtin_amdgcn_global_load_lds((const unsigned*)((const char*)(gbase) + voffB[_i]), (LAS unsigned*)(lds + (bufoff) + ldsw + _i * 8192), 16, 0, 0); } while (0)
#define FG_STAGE_A(bufoff, o0, o1) do { \
        __builtin_amdgcn_global_load_lds((const unsigned*)(Abase + (o0)), (LAS unsigned*)(lds + (bufoff) + ldsw), 16, 0, 0); \
        __builtin_amdgcn_global_load_lds((const unsigned*)(Abase + (o1)), (LAS unsigned*)(lds + (bufoff) + ldsw + 8192), 16, 0, 0); } while (0)
#define FG_LD8(dst, off) do { const v4i_t lo_ = *(const LAS v4i_t*)(lds + (off)), hi_ = *(const LAS v4i_t*)(lds + (off) + 1024); dst = (v8i_t){lo_[0], lo_[1], lo_[2], lo_[3], hi_[0], hi_[1], hi_[2], hi_[3]}; } while (0)
#define FG_LDA(dst, b, h) do { _Pragma("unroll") for (int m = 0; m < 4; ++m) FG_LD8(dst[m], FG_SA(b, h) + aoff + m * 2048); } while (0)
#define FG_LDB(dst, b, h) do { _Pragma("unroll") for (int n = 0; n < 2; ++n) FG_LD8(dst[n], FG_SB(b, h) + boff + n * 2048); } while (0)
#define FG_HALF(v, k) ((k) == 0 ? __builtin_bit_cast(bf16x8, (v4i_t){(v)[0], (v)[1], (v)[2], (v)[3]}) : __builtin_bit_cast(bf16x8, (v4i_t){(v)[4], (v)[5], (v)[6], (v)[7]}))
#define FG_MMA(ai, bj, At, Bt) do { __builtin_amdgcn_s_setprio(1); \
        if constexpr (PB::FP8) { _Pragma("unroll") for (int m = 0; m < 4; ++m) _Pragma("unroll") for (int n = 0; n < 2; ++n) \
            asm volatile("v_mfma_scale_f32_16x16x128_f8f6f4 %0, %1, %2, %0, %3, %4 op_sel_hi:[0,0,0]" : "+v"(acc[ai][bj][m][n]) : "v"(Bt[n]), "v"(At[m]), "v"(sclW), "v"(sclA)); } \
        else { _Pragma("unroll") for (int m = 0; m < 4; ++m) _Pragma("unroll") for (int n = 0; n < 2; ++n) _Pragma("unroll") for (int k = 0; k < 2; ++k) \
            acc[ai][bj][m][n] = __builtin_amdgcn_mfma_f32_16x16x32_bf16(FG_HALF(Bt[n], k), FG_HALF(At[m], k), acc[ai][bj][m][n], 0, 0, 0); } \
        __builtin_amdgcn_s_setprio(0); } while (0)
#define FG_WAIT_V(n) asm volatile("s_waitcnt vmcnt(" #n ")" ::: "memory")
#define FG_WAIT_L(n) asm volatile("s_waitcnt lgkmcnt(" #n ")" ::: "memory")
#define FG_BAR __builtin_amdgcn_s_barrier()
#define FG_SCHED __builtin_amdgcn_sched_barrier(0)
    Unit cur, nxt; int ui = 0;
    if (!S.next(0, cur)) return;
    f32x4 acc[2][2][4][2];
#pragma unroll
    for (int a = 0; a < 2; ++a)
#pragma unroll
        for (int b = 0; b < 2; ++b)
#pragma unroll
            for (int m = 0; m < 4; ++m)
#pragma unroll
                for (int n = 0; n < 2; ++n) acc[a][b][m][n] = (f32x4){0.f, 0.f, 0.f, 0.f};
    v8i_t At[4], B0[2], B1[2];
    int sclW = 0x79797979, sclA = 0x7f7f7f7f;
    asm volatile("" : "+v"(sclW), "+v"(sclA));
    const char* Abase = S.a_base();
    unsigned vAc[2][2];
    FG_AOFFS(vAc, cur);
    const char* cB = S.b_base(cur);
    FG_STAGE_B(FG_SB(0, 0), cB); FG_STAGE_A(FG_SA(0, 0), vAc[0][0], vAc[0][1]); FG_STAGE_B(FG_SB(0, 1), cB + hstep); FG_STAGE_A(FG_SA(0, 1), vAc[1][0], vAc[1][1]);
    if (wr == 1) FG_BAR;
    FG_WAIT_V(4); FG_BAR;
    FG_STAGE_B(FG_SB(1, 0), cB + kstep); FG_STAGE_A(FG_SA(1, 0), vAc[0][0] + (unsigned)kstep, vAc[0][1] + (unsigned)kstep); FG_STAGE_B(FG_SB(1, 1), cB + hstep + kstep);
    FG_WAIT_V(6); FG_BAR;
    for (;;) {
        const bool has_next = S.next(ui + 1, nxt);
        const char* nB = has_next ? S.b_base(nxt) : cB;
        {
            unsigned vAn[2][2];
            if (has_next) { FG_AOFFS(vAn, nxt); }
            else {
#pragma unroll
                for (int h = 0; h < 2; ++h)
#pragma unroll
                    for (int i = 0; i < 2; ++i) vAn[h][i] = vAc[h][i];
            }
            *(LAS v4i_t*)(lds + STAGE_BYTES + 512 + tid * 16) = (v4i_t){(int)vAn[0][0], (int)vAn[0][1], (int)vAn[1][0], (int)vAn[1][1]};
        }
#pragma unroll 1
        for (int t = 0; t < nt; t += 2) {
            const bool last = (t == nt - 2);
            const unsigned k1 = (unsigned)((t + 1) * (int)kstep), k2 = last ? 0u : (unsigned)((t + 2) * (int)kstep);
            const char* b2 = last ? nB : cB + (size_t)(t + 2) * kstep; const char* b3 = b2 + kstep;
            const unsigned c10_ = vAc[1][0], c11_ = vAc[1][1];
            if (last) { const v4i_t nx_ = *(const LAS v4i_t*)(lds + STAGE_BYTES + 512 + tid * 16); vAc[0][0] = (unsigned)nx_[0]; vAc[0][1] = (unsigned)nx_[1]; vAc[1][0] = (unsigned)nx_[2]; vAc[1][1] = (unsigned)nx_[3]; }
#define FG_A2(h, i) (vAc[h][i] + k2)
            FG_LDB(B0, 0, 0); FG_SCHED; FG_LDA(At, 0, 0); FG_STAGE_A(FG_SA(1, 1), c10_ + k1, c11_ + k1);
            FG_WAIT_L(8); FG_BAR; FG_WAIT_L(0); FG_MMA(0, 0, At, B0); FG_BAR; FG_SCHED;
            FG_LDB(B1, 0, 1); FG_STAGE_B(FG_SB(0, 0), b2);
            FG_BAR; FG_WAIT_L(0); FG_MMA(0, 1, At, B1); FG_BAR;
            FG_LDA(At, 0, 1); FG_STAGE_A(FG_SA(0, 0), FG_A2(0, 0), FG_A2(0, 1));
            FG_BAR; FG_WAIT_L(0); FG_MMA(1, 0, At, B0); FG_BAR; FG_SCHED;
            FG_STAGE_B(FG_SB(0, 1), b2 + hstep);
            FG_WAIT_V(6); FG_BAR; FG_MMA(1, 1, At, B1); FG_BAR;
            FG_LDB(B0, 1, 0); FG_SCHED; FG_LDA(At, 1, 0); FG_STAGE_A(FG_SA(0, 1), FG_A2(1, 0), FG_A2(1, 1));
            FG_WAIT_L(8); FG_BAR; FG_WAIT_L(0); FG_MMA(0, 0, At, B0); FG_BAR; FG_SCHED;
            FG_LDB(B1, 1, 1); FG_STAGE_B(FG_SB(1, 0), b3);
            FG_BAR; FG_WAIT_L(0); FG_MMA(0, 1, At, B1); FG_BAR;
            FG_LDA(At, 1, 1); FG_STAGE_A(FG_SA(1, 0), FG_A2(0, 0) + (unsigned)kstep, FG_A2(0, 1) + (unsigned)kstep);
            FG_BAR; FG_WAIT_L(0); FG_MMA(1, 0, At, B0); FG_BAR; FG_SCHED;
            FG_STAGE_B(FG_SB(1, 1), b3 + hstep);
            FG_WAIT_V(6); FG_BAR; FG_MMA(1, 1, At, B1); FG_BAR;
        }
        if constexpr (PB::FP8) asm volatile("s_nop 15\n\ts_nop 15\n\ts_nop 15" ::: "memory");
        S.epilogue(acc, cur, wr, wc, fr, fq);
        if (!has_next) break;
#pragma unroll
        for (int a = 0; a < 2; ++a)
#pragma unroll
            for (int b = 0; b < 2; ++b)
#pragma unroll
                for (int m = 0; m < 4; ++m)
#pragma unroll
                    for (int n = 0; n < 2; ++n) acc[a][b][m][n] = (f32x4){0.f, 0.f, 0.f, 0.f};
        cur = nxt; cB = nB; ++ui;
    }
    FG_WAIT_V(0);
    if (wr == 0) FG_BAR;
    FG_BAR;
#undef FG_AOFFS
#undef FG_A2
#undef FG_SA
#undef FG_SB
#undef FG_STAGE_A
#undef FG_STAGE_B
#undef FG_LDA
#undef FG_LD8
#undef FG_HALF
#undef FG_LDB
#undef FG_MMA
#undef FG_WAIT_V
#undef FG_WAIT_L
#undef FG_BAR
#undef FG_SCHED
}

template <int K_, int LDA, class Epi, bool PERM_>
struct DenseProb {
    static constexpr int K = K_; static constexpr bool PERM = PERM_, FP8 = false;
    struct Unit { int pm, pn; };
    const bf16_t* A; const bf16_t* Bt; int nM, nN, nwg, G, c; Epi epi;
    __device__ __forceinline__ DenseProb(const bf16_t* A_, const bf16_t* Bt_, int N, const Epi& e) : A(A_), Bt(Bt_), nM(T / BM), nN(N / BM), nwg((T / BM) * (N / BM)), G(grid_size()), c(blockIdx.x), epi(e) {}
    __device__ __forceinline__ bool next(int i, Unit& u) const {
        const long L = (long)i * G + c; if (L >= nwg) return false;
        int wgid = (int)L; { const int q = nwg / NXCD, r = nwg % NXCD, xcd = wgid % NXCD, off = wgid / NXCD; wgid = (xcd < r ? xcd * (q + 1) : r * (q + 1) + (xcd - r) * q) + off; }
        const int nig = WGM * nN, gid = wgid / nig, fm = gid * WGM, gsz = (nM - fm) < WGM ? (nM - fm) : WGM;
        u.pm = fm + ((wgid % nig) % gsz); u.pn = (wgid % nig) / gsz; return true;
    }
    __device__ __forceinline__ const char* a_base() const { return (const char*)A; }
    __device__ __forceinline__ unsigned a_off(const Unit& u, int r) const { return (unsigned)((u.pm * BM + r) * LDA) * 2u; }
    __device__ __forceinline__ const char* b_base(const Unit& u) const { return (const char*)Bt + (size_t)u.pn * BM * K * 2; }
    __device__ __forceinline__ void epilogue(const f32x4 (&acc)[2][2][4][2], const Unit& u, int wr, int wc, int fr, int fq) const {
        const int row0 = u.pm * BM + wr * 64 + fr;
        if constexpr (PERM) {
            const int col0 = u.pn * BM + wc * 32 + 8 * fq;
#pragma unroll
            for (int ai = 0; ai < 2; ++ai)
#pragma unroll
                for (int m = 0; m < 4; ++m)
#pragma unroll
                    for (int bj = 0; bj < 2; ++bj) epi(row0 + ai * HALF + m * 16, col0 + bj * HALF, acc[ai][bj][m][0], acc[ai][bj][m][1]);
        } else {
            const int col0 = u.pn * BM + wc * 32 + 4 * fq;
#pragma unroll
            for (int ai = 0; ai < 2; ++ai)
#pragma unroll
                for (int m = 0; m < 4; ++m)
#pragma unroll
                    for (int bj = 0; bj < 2; ++bj)
#pragma unroll
                        for (int n = 0; n < 2; ++n) epi(row0 + ai * HALF + m * 16, col0 + bj * HALF + n * 16, acc[ai][bj][m][n]);
        }
    }
};
}
template <int K, int LDA, bool PERM, class Epi>
__device__ __forceinline__ void ph_gemm_fast(LAS unsigned char* lds, const bf16_t* A, const bf16_t* Bt, int N, const Epi& epi) {
    const fg::DenseProb<K, LDA, Epi, PERM> pb(A, Bt, N, epi);
    fg::gemm_phase(lds, pb);
}


namespace fg {
struct MoeUnit { int e, mblk, pn, rowoff, M; };
template <bool FIRST, bool FP8_>
struct MoeProb {
    static constexpr int K = FP8_ ? 512 : 1024  , NCOL = FIRST ? 8 : 4; static constexpr bool PERM = true, FP8 = FP8_; static constexpr unsigned RB = FP8_ ? 1024u : 2048u  ;
    typedef MoeUnit Unit;
    const Params& P; int layer; const LAS int* tab;
    int G, c; mutable int e_, acc_, off_;
    __device__ __forceinline__ MoeProb(const Params& P_, int layer_, const LAS int* tab_) : P(P_), layer(layer_), tab(tab_), G(grid_size()), c(blockIdx.x), e_(0), acc_(0), off_(0) {}
    __device__ __forceinline__ bool next(int i, Unit& u) const {
        const int j = i * (G >> 3) + (c >> 3), tile = (j / NCOL) * 8 + (c & 7);
        while (e_ < 32) { const int tl = (tab[e_] + 255) >> 8; if (tile < acc_ + tl) break; acc_ += tl; off_ += tl * 256; ++e_; }
        if (e_ >= 32) return false;
        u.e = e_; u.mblk = tile - acc_; u.pn = j % NCOL; u.rowoff = off_; u.M = tab[e_]; return true;
    }
    __device__ __forceinline__ const char* a_base() const { return FIRST ? (const char*)(P.ws + WS_HB) : (const char*)(P.ws + WS_BIG); }
    __device__ __forceinline__ unsigned a_off(const Unit& u, int r) const {
        if (FIRST) { int rr = u.mblk * 256 + r; rr = rr < u.M ? rr : u.M - 1; const int ts = ((const int*)(P.ws + WS_LIST))[(size_t)u.e * T + rr]; return (unsigned)(ts >> 2) * RB; }
        return (unsigned)(u.rowoff + u.mblk * 256 + r) * RB;
    }
    __device__ __forceinline__ const char* b_base(const Unit& u) const {
        return FIRST ? (const char*)(P.ws + WS_W1) + ((size_t)u.e * 2048 + (size_t)u.pn * 256) * RB : (const char*)(P.ws + WS_W2) + ((size_t)u.e * 1024 + (size_t)u.pn * 256) * RB;
    }
    __device__ __forceinline__ void epilogue(const f32x4 (&acc)[2][2][4][2], const Unit& u, int wr, int wc, int fr, int fq) const {
        char* ws = P.ws; const int rl0 = u.mblk * 256 + wr * 64 + fr;
        if (FIRST) {
            const float* lrs = (const float*)(ws + WS_LRS) + (size_t)u.e * T;
            bf16_t* H = (bf16_t*)(ws + WS_BIG) + (size_t)u.rowoff * 1024;
            const int hc0 = u.pn * 128 + wc * 32 + 8 * fq;
            const float* bgp = P.moe_bg + ((size_t)layer * 32 + u.e) * 1024 + hc0; const float* bup = P.moe_bu + ((size_t)layer * 32 + u.e) * 1024 + hc0;
            const f32x4 bg0 = *(const f32x4*)bgp, bg1 = *(const f32x4*)(bgp + 4), bu0 = *(const f32x4*)bup, bu1 = *(const f32x4*)(bup + 4);
            float sc[2][4];
#pragma unroll
            for (int ai = 0; ai < 2; ++ai)
#pragma unroll
                for (int m = 0; m < 4; ++m) { const int r = rl0 + ai * HALF + m * 16; sc[ai][m] = lrs[r < u.M ? r : u.M - 1]; }
#pragma unroll
            for (int ai = 0; ai < 2; ++ai)
#pragma unroll
                for (int m = 0; m < 4; ++m) { const int r = rl0 + ai * HALF + m * 16;
                    if (r < u.M) {
                        const float s_ = sc[ai][m]; const f32x4 g0 = acc[ai][0][m][0], g1 = acc[ai][0][m][1], u0 = acc[ai][1][m][0], u1 = acc[ai][1][m][1];
                        const float h0 = swiglu_(g0[0], u0[0], s_, bg0[0], bu0[0]), h1 = swiglu_(g0[1], u0[1], s_, bg0[1], bu0[1]), h2 = swiglu_(g0[2], u0[2], s_, bg0[2], bu0[2]), h3 = swiglu_(g0[3], u0[3], s_, bg0[3], bu0[3]);
                        const float h4 = swiglu_(g1[0], u1[0], s_, bg1[0], bu1[0]), h5 = swiglu_(g1[1], u1[1], s_, bg1[1], bu1[1]), h6 = swiglu_(g1[2], u1[2], s_, bg1[2], bu1[2]), h7 = swiglu_(g1[3], u1[3], s_, bg1[3], bu1[3]);
                        if constexpr (FP8_) *(uint2*)((unsigned char*)(ws + WS_BIG) + (size_t)(u.rowoff + r) * 1024 + hc0) = make_uint2(pack4_fp8(h0, h1, h2, h3), pack4_fp8(h4, h5, h6, h7));
                        else *(u32x4_t*)(H + (size_t)r * 1024 + hc0) = (u32x4_t){pack2(h0, h1), pack2(h2, h3), pack2(h4, h5), pack2(h6, h7)};
                    } }
        } else {
            const int* list = (const int*)(ws + WS_LIST) + (size_t)u.e * T; const float* lgt = (const float*)(ws + WS_LGT) + (size_t)u.e * T;
            bf16_t* Y = (bf16_t*)(ws + WS_Y);
            const int col0 = u.pn * 256 + wc * 32 + 8 * fq;
            const float* bdp = P.moe_bd + ((size_t)layer * 32 + u.e) * 1024 + col0;
            f32x4 bd[2][2];
#pragma unroll
            for (int bj = 0; bj < 2; ++bj) { bd[bj][0] = *(const f32x4*)(bdp + bj * HALF); bd[bj][1] = *(const f32x4*)(bdp + bj * HALF + 4); }
            int tsv[2][4]; float gv[2][4];
#pragma unroll
            for (int ai = 0; ai < 2; ++ai)
#pragma unroll
                for (int m = 0; m < 4; ++m) { const int r = rl0 + ai * HALF + m * 16; const int rc = r < u.M ? r : u.M - 1; tsv[ai][m] = list[rc]; gv[ai][m] = lgt[rc]; }
#pragma unroll
            for (int ai = 0; ai < 2; ++ai)
#pragma unroll
                for (int m = 0; m < 4; ++m) { const int r = rl0 + ai * HALF + m * 16;
                    if (r < u.M) {
                        const float g = gv[ai][m]; bf16_t* yr = Y + (size_t)tsv[ai][m] * 1024 + col0;
#pragma unroll
                        for (int bj = 0; bj < 2; ++bj) { const f32x4 a = (acc[ai][bj][m][0] + bd[bj][0]) * g, b = (acc[ai][bj][m][1] + bd[bj][1]) * g;
                            *(u32x4_t*)(yr + bj * HALF) = (u32x4_t){pack2(a[0], a[1]), pack2(a[2], a[3]), pack2(b[0], b[1]), pack2(b[2], b[3])}; }
                    } }
        }
    }
};
}
template <bool FIRST, bool FP8>
__device__ __forceinline__ void ph_moe_fast(const Params& P, int layer, LAS unsigned char* lds) {
    LAS int* tab = (LAS int*)(lds + fg::STAGE_BYTES);
    const int tz = opaque_tid();
    if (tz < 32) tab[tz] = (int)((const unsigned*)(P.ws + WS_CTL))[CTL_CNT + layer * 32 + tz];
    __syncthreads();
    const fg::MoeProb<FIRST, FP8> pb(P, layer, tab);
    fg::gemm_phase(lds, pb);
}

template <class Epi>
__device__ __forceinline__ void ph_gemm_dense(const bf16_t* A, int lda, const bf16_t* Bt, int N, int K, const Epi& epi) {
    const int ncol = N / 128, nunits = (T / 256) * ncol;
    for (int u = blockIdx.x; u < nunits; u += grid_size()) gemm_simple_unit<Epi, false>(A, lda, nullptr, Bt, K, T, K, u / ncol, u % ncol, epi);
}
__device__ __forceinline__ bool moe_decode(const unsigned* cnt, int ncol, int u, int& e, int& mblk, int& nblk, int& rowoff) {
    int acc = 0, off = 0;
    for (int i = 0; i < 32; ++i) {
        const int tl = ((int)cnt[i] + 255) >> 8;
        if (u < (acc + tl) * ncol) { e = i; const int local = u - acc * ncol; mblk = local / ncol; nblk = local % ncol; rowoff = off; return true; }
        acc += tl; off += tl * 256;
    }
    return false;
}
__device__ __forceinline__ void ph_moe1(const Params& P, int layer) {
    char* ws = P.ws; const unsigned* cnt = (const unsigned*)(ws + WS_CTL) + CTL_CNT + layer * 32;
    for (int u = blockIdx.x;; u += grid_size()) {
        int e, mblk, nblk, off; if (!moe_decode(cnt, 16, u, e, mblk, nblk, off)) break;
        const int* list = (const int*)(ws + WS_LIST) + (size_t)e * T;
        EpiMoe1 ep{list, (const float*)(ws + WS_RSTD) + T, P.moe_bg + ((size_t)layer * 32 + e) * 1024, P.moe_bu + ((size_t)layer * 32 + e) * 1024, (bf16_t*)(ws + WS_BIG) + (size_t)off * 1024};
        gemm_simple_unit<EpiMoe1, true>((const bf16_t*)(ws + WS_HB), 1024, list, (const bf16_t*)(ws + WS_W1) + (size_t)e * 2048 * 1024, 1024, (int)cnt[e], 1024, mblk, nblk, ep);
    }
}
__device__ __forceinline__ void ph_moe2(const Params& P, int layer) {
    char* ws = P.ws; const unsigned* cnt = (const unsigned*)(ws + WS_CTL) + CTL_CNT + layer * 32;
    for (int u = blockIdx.x;; u += grid_size()) {
        int e, mblk, nblk, off; if (!moe_decode(cnt, 8, u, e, mblk, nblk, off)) break;
        const int* list = (const int*)(ws + WS_LIST) + (size_t)e * T;
        EpiMoe2 ep{list, (const float*)(ws + WS_TOPG), P.moe_bd + ((size_t)layer * 32 + e) * 1024, (bf16_t*)(ws + WS_Y)};
        gemm_simple_unit<EpiMoe2, false>((const bf16_t*)(ws + WS_BIG) + (size_t)off * 1024, 1024, nullptr, (const bf16_t*)(ws + WS_W2) + (size_t)e * 1024 * 1024, 1024, (int)cnt[e], 1024, mblk, nblk, ep);
    }
}

__device__ __forceinline__ void ph_attn_simple(const Params& P, unsigned char* lds) {
    float (*qs)[96] = (float (*)[96])lds; float (*ps)[64] = (float (*)[64])(lds + 8 * 96 * 4);
    const int tid = opaque_tid(), wid = tid >> 6, lane = tid & 63;
    const bf16_t* Q = (const bf16_t*)(P.ws + WS_BIG + BIG_Q); const bf16_t* Kd = (const bf16_t*)(P.ws + WS_BIG + BIG_K); const bf16_t* KV = (const bf16_t*)(P.ws + WS_BIG + BIG_KV);
    bf16_t* YM = (bf16_t*)(P.ws + WS_YMIX);
    for (int u = blockIdx.x; u < T; u += grid_size()) {
        const long gw = (long)u * 8 + wid;
        const int s = (int)(gw & 4095), bh = (int)(gw >> 12), b = bh >> 3, h = bh & 7;
        const long t = (long)b * SEQ + s;
        __syncthreads();
        qs[wid][lane] = bf2f(Q[t * 768 + h * 96 + lane]);
        if (lane < 32) qs[wid][64 + lane] = bf2f(Q[t * 768 + h * 96 + 64 + lane]);
        __syncthreads();
        float m = -INFINITY, l = 0.f, o = 0.f;
        for (int j0 = 0; j0 <= s; j0 += 64) {
            const int j = j0 + lane; const bool valid = j <= s;
            const long kt = (long)b * SEQ + (valid ? j : s);
            const uint4* kr = (const uint4*)(Kd + (kt * 8 + h) * 96);
            float sc = 0.f;
#pragma unroll
            for (int c = 0; c < 12; ++c) {
                const uint4 kk = kr[c];
                sc += qs[wid][c * 8 + 0] * bf2f(kk.x & 0xffff) + qs[wid][c * 8 + 1] * bf2f(kk.x >> 16) + qs[wid][c * 8 + 2] * bf2f(kk.y & 0xffff) + qs[wid][c * 8 + 3] * bf2f(kk.y >> 16)
                    + qs[wid][c * 8 + 4] * bf2f(kk.z & 0xffff) + qs[wid][c * 8 + 5] * bf2f(kk.z >> 16) + qs[wid][c * 8 + 6] * bf2f(kk.w & 0xffff) + qs[wid][c * 8 + 7] * bf2f(kk.w >> 16);
            }
            sc = valid ? sc : -INFINITY;
            const float mn = fmaxf(m, wave_max(sc));
            const float pj = valid ? __expf(sc - mn) : 0.f;
            const float f = __expf(m - mn);
            l = l * f + wave_sum(pj); o *= f; m = mn;
            __syncthreads();
            ps[wid][lane] = pj;
            __syncthreads();
            const bf16_t* vb = KV + ((long)b * SEQ + j0) * 1024 + h * 128 + 64 + lane;
#pragma unroll 8
            for (int jj = 0; jj < 64; ++jj) o += ps[wid][jj] * bf2f(vb[(long)jj * 1024]);
        }
        YM[t * 1024 + 256 + h * 64 + lane] = f2bf(o / l);
    }
}


namespace at {
typedef float f32x16 __attribute__((ext_vector_type(16)));
typedef short s16x4 __attribute__((ext_vector_type(4)));
constexpr int KSLOT = 12288, VSLOT = 8192, NSLOT = 3, LDS_K = 0, LDS_V = NSLOT * KSLOT, LDS_END = LDS_V + NSLOT * VSLOT;
typedef float f32x2_t __attribute__((ext_vector_type(2))); typedef __bf16 bf16x2_t __attribute__((ext_vector_type(2)));
__device__ __forceinline__ unsigned cvtpk(float lo, float hi) { const f32x2_t v = {lo, hi}; const bf16x2_t b = __builtin_convertvector(v, bf16x2_t); return __builtin_bit_cast(unsigned, b); }
__device__ __forceinline__ void glds16(const void* gsrc, unsigned lds_dst) { unsigned keep;
    asm volatile("s_mov_b32 %0, m0\n\ts_mov_b32 m0, %2\n\ts_nop 0\n\tglobal_load_lds_dwordx4 %1, off\n\ts_mov_b32 m0, %0" : "=&s"(keep) : "v"(gsrc), "s"(lds_dst) : "memory"); }
__device__ __forceinline__ s16x4 vtr(const LAS unsigned char* p) { return __builtin_bit_cast(s16x4, __builtin_amdgcn_ds_read_tr16_b64_v4i16((LAS s16x4*)p)); }
__device__ __forceinline__ float xhalf_max(float v) { auto rr = __builtin_amdgcn_permlane32_swap(__float_as_uint(v), __float_as_uint(v), false, false); return fmaxf(__uint_as_float(rr[0]), __uint_as_float(rr[1])); }
__device__ __forceinline__ float xhalf_sum(float v) { auto rr = __builtin_amdgcn_permlane32_swap(__float_as_uint(v), __float_as_uint(v), false, false); return __uint_as_float(rr[0]) + __uint_as_float(rr[1]); }

__device__ __forceinline__ void attn_unit(int b, int h, int qb, const bf16_t* Q, const bf16_t* Kd, const bf16_t* KV, bf16_t* YM, LAS unsigned char* lds) {
    const int tid = opaque_tid(); const int lane = tid & 63, r32 = lane & 31, hi = lane >> 5; const int wid = __builtin_amdgcn_readfirstlane(tid >> 6);
    const int q0 = qb * 256; const size_t row = (size_t)b * SEQ + q0 + wid * 32 + r32;
    const int NT = 4 * qb + 4;
    const char* ksrcA = (const char*)(Kd + (((size_t)b * SEQ + lane) * 8 + h) * 96) + wid * 16;
    const char* ksrcB = (const char*)(Kd + (((size_t)b * SEQ + lane) * 8 + h) * 96) + (8 + (wid & 3)) * 16;
    const char* vsrc = (const char*)(KV + ((size_t)b * SEQ + 16 * (wid & 3) + (lane >> 2)) * 1024 + h * 128 + 64 + (wid >> 2) * 32 + (lane & 3) * 8);
    const unsigned lds0 = (unsigned)(size_t)lds;
#define AT_DMA(j, slot) do { \
        glds16(ksrcA + (size_t)(j) * (64 * 1536), (unsigned)__builtin_amdgcn_readfirstlane((int)(lds0 + LDS_K + (slot) * KSLOT + wid * 1024))); \
        glds16(ksrcB + (size_t)(j) * (64 * 1536), (unsigned)__builtin_amdgcn_readfirstlane((int)(lds0 + LDS_K + (slot) * KSLOT + (8 + (wid & 3)) * 1024))); \
        glds16(vsrc + (size_t)(j) * (64 * 2048), (unsigned)__builtin_amdgcn_readfirstlane((int)(lds0 + LDS_V + (slot) * VSLOT + wid * 1024))); } while (0)
    AT_DMA(0, 0); AT_DMA(1, 1);
    bf16x8 qf[6];
#pragma unroll
    for (int ks = 0; ks < 6; ++ks) qf[ks] = *(const bf16x8*)(Q + row * 768 + h * 96 + ks * 16 + hi * 8);
    asm volatile("" : "+v"(qf[0]), "+v"(qf[1]), "+v"(qf[2]), "+v"(qf[3]), "+v"(qf[4]), "+v"(qf[5]));
    float m = -INFINITY, l = 0.f;
    f32x16 o0, o1;
#pragma unroll
    for (int r = 0; r < 16; ++r) { o0[r] = 0.f; o1[r] = 0.f; }
    const int kfo = hi * 1024 + r32 * 16;
    const int vfo = ((lane >> 4) & 1) * 32 + (lane & 3) * 8 + (4 * hi + ((lane & 15) >> 2)) * 64;
    const int qrel = wid * 32 + r32;
    int slot = 0;
    for (int j = 0; j < NT; ++j) {
        if (j + 1 < NT) asm volatile("s_waitcnt vmcnt(3)\n\ts_barrier" ::: "memory"); else asm volatile("s_waitcnt vmcnt(0)\n\ts_barrier" ::: "memory");
        if (j + 2 < NT) { const int s2 = (slot == 0) ? 2 : slot - 1; AT_DMA(j + 2, s2); }
        const LAS unsigned char* kp = lds + LDS_K + slot * KSLOT + kfo;
        const LAS unsigned char* vp = lds + LDS_V + slot * VSLOT + vfo;
        f32x16 s0, s1;
#pragma unroll
        for (int r = 0; r < 16; ++r) { s0[r] = 0.f; s1[r] = 0.f; }
#pragma unroll
        for (int ks = 0; ks < 6; ++ks) {
            const bf16x8 k0 = *(const LAS bf16x8*)(kp + ks * 2048), k1 = *(const LAS bf16x8*)(kp + ks * 2048 + 512);
            s0 = __builtin_amdgcn_mfma_f32_32x32x16_bf16(k0, qf[ks], s0, 0, 0, 0);
            s1 = __builtin_amdgcn_mfma_f32_32x32x16_bf16(k1, qf[ks], s1, 0, 0, 0);
        }
        if (j >= NT - 4) {
            const int kb = 64 * (j - (NT - 4)) + 4 * hi;
#pragma unroll
            for (int r = 0; r < 16; ++r) { const int kv = kb + (r & 3) + 8 * (r >> 2); if (kv > qrel) s0[r] = -INFINITY; if (kv + 32 > qrel) s1[r] = -INFINITY; }
        }
        float mt = fmaxf(s0[0], s1[0]);
#pragma unroll
        for (int r = 1; r < 16; ++r) mt = fmaxf(mt, fmaxf(s0[r], s1[r]));
        mt = xhalf_max(mt);
        const float mn = fmaxf(m, mt);
        const float f = __builtin_amdgcn_exp2f(m - mn);
        float ps = 0.f;
#pragma unroll
        for (int r = 0; r < 16; ++r) { s0[r] = __builtin_amdgcn_exp2f(s0[r] - mn); s1[r] = __builtin_amdgcn_exp2f(s1[r] - mn); ps += s0[r] + s1[r]; }
        l = l * f + ps; m = mn;
#pragma unroll
        for (int r = 0; r < 16; ++r) { o0[r] *= f; o1[r] *= f; }
        bf16x8 pf[4];
        {
            unsigned w[16];
#pragma unroll
            for (int i = 0; i < 8; ++i) { w[i] = cvtpk(s0[2 * i], s0[2 * i + 1]); w[8 + i] = cvtpk(s1[2 * i], s1[2 * i + 1]); }
#pragma unroll
            for (int k = 0; k < 4; ++k) { typedef unsigned u32x4 __attribute__((ext_vector_type(4))); const u32x4 t = {w[4 * k], w[4 * k + 1], w[4 * k + 2], w[4 * k + 3]}; pf[k] = __builtin_bit_cast(bf16x8, t); }
        }
#pragma unroll
        for (int k = 0; k < 4; ++k) {
            const s16x4 a0 = vtr(vp + k * 1024), a1 = vtr(vp + k * 1024 + 512), c0 = vtr(vp + 4096 + k * 1024), c1 = vtr(vp + 4096 + k * 1024 + 512);
            const bf16x8 v0 = {a0[0], a0[1], a0[2], a0[3], a1[0], a1[1], a1[2], a1[3]}, v1 = {c0[0], c0[1], c0[2], c0[3], c1[0], c1[1], c1[2], c1[3]};
            o0 = __builtin_amdgcn_mfma_f32_32x32x16_bf16(v0, pf[k], o0, 0, 0, 0);
            o1 = __builtin_amdgcn_mfma_f32_32x32x16_bf16(v1, pf[k], o1, 0, 0, 0);
        }
        slot = (slot == 2) ? 0 : slot + 1;
    }
    l = xhalf_sum(l);
    const float rl = 1.0f / l;
    bf16_t* op = YM + row * 1024 + 256 + h * 64 + 4 * hi;
#pragma unroll
    for (int g = 0; g < 4; ++g) {
        *(uint2*)(op + 8 * g) = make_uint2(cvtpk(o0[4 * g] * rl, o0[4 * g + 1] * rl), cvtpk(o0[4 * g + 2] * rl, o0[4 * g + 3] * rl));
        *(uint2*)(op + 32 + 8 * g) = make_uint2(cvtpk(o1[4 * g] * rl, o1[4 * g + 1] * rl), cvtpk(o1[4 * g + 2] * rl, o1[4 * g + 3] * rl));
    }
    asm volatile("s_waitcnt lgkmcnt(0)\n\ts_barrier" ::: "memory");
#undef AT_DMA
}
}
__device__ __forceinline__ void ph_attn_fast(const Params& P, LAS unsigned char* lds) {
    const bf16_t* Q = (const bf16_t*)(P.ws + WS_BIG + BIG_Q); const bf16_t* Kd = (const bf16_t*)(P.ws + WS_BIG + BIG_K); const bf16_t* KV = (const bf16_t*)(P.ws + WS_BIG + BIG_KV);
    bf16_t* YM = (bf16_t*)(P.ws + WS_YMIX);
    const int G = grid_size();
    for (int v0 = (blockIdx.x % 8) * (G / 8) + blockIdx.x / 8; v0 < 256; v0 += G) {
        const int bh = v0 >> 2, s = v0 & 3;
#pragma unroll 1
        for (int i = 0; i < 4; ++i) { const int qb = (i == 0) ? s : (i == 1) ? 7 - s : (i == 2) ? 8 + s : 15 - s; at::attn_unit(bh >> 3, bh & 7, qb, Q, Kd, KV, YM, lds); }
    }
}


template <bool DRY = false> __device__ __forceinline__ void ph_gla_x(const Params& P, LAS unsigned char* lds) {
    const int tid = opaque_tid(); const int wid = __builtin_amdgcn_readfirstlane(tid >> 6), lane = tid & 63;
    LAS float* kend = (LAS float*)(lds + wid * 8192);
    const bf16_t* Z = (const bf16_t*)(P.ws + WS_BIG + BIG_Z); float* LA = (float*)(P.ws + WS_BIG + BIG_LA);
    float* UPD = DRY ? (float*)(P.ws + WS_Y + 32 * MiB) : (float*)(P.ws + WS_UPD); float* DEC = DRY ? (float*)(P.ws + WS_Y + 64 * MiB) : (float*)(P.ws + WS_DEC); float* LAW = DRY ? (float*)(P.ws + WS_Y) : LA;
    for (int u = blockIdx.x * NWV + wid; u < 2048; u += grid_size() * NWV) {
        const int bh = u >> 6, n = u & 63, b = bh >> 2, h = bh & 3;
        const size_t t0 = (size_t)b * SEQ + n * 64;
        const int k = lane & 31, half = lane >> 5;
        float c[32]; float run = 0.f;
#pragma unroll
        for (int i = 0; i < 32; ++i) { run += LA[(t0 + 32 * half + i) * 128 + h * 32 + k]; c[i] = run; }
        const float tot0 = __shfl(run, k);
        const float add = half ? tot0 : 0.f;
        const float blast = __shfl(run, 32 + k) + tot0;
#pragma unroll
        for (int i = 0; i < 32; ++i) {
            const float bc = c[i] + add; const size_t t = t0 + 32 * half + i;
            LAW[t * 128 + h * 32 + k] = bc;
            kend[(32 * half + i) * 32 + k] = bf2f(Z[t * ZW + ZC_GK + h * 32 + k]) * __expf(blast - bc);
        }
        if (half == 0) DEC[(size_t)u * 32 + k] = __expf(blast);
        asm volatile("s_waitcnt lgkmcnt(0)" ::: "memory");
        float acc[32];
#pragma unroll
        for (int i = 0; i < 32; ++i) acc[i] = 0.f;
#pragma unroll 4
        for (int j = 0; j < 64; ++j) {
            const float vj = bf2f(Z[(t0 + j) * ZW + ZC_GV + h * 64 + lane]);
#pragma unroll
            for (int kq = 0; kq < 8; ++kq) { const f32x4 ke = *(const LAS f32x4*)(kend + j * 32 + kq * 4); acc[4 * kq] += ke[0] * vj; acc[4 * kq + 1] += ke[1] * vj; acc[4 * kq + 2] += ke[2] * vj; acc[4 * kq + 3] += ke[3] * vj; }
        }
#pragma unroll
        for (int kk = 0; kk < 32; ++kk) UPD[((size_t)u * 32 + kk) * 64 + lane] = acc[kk];
        asm volatile("s_waitcnt lgkmcnt(0)" ::: "memory");
    }
}
__device__ __forceinline__ void ph_gla_scan(const Params& P) {
    const int tz = opaque_tid();
    const float* UPD = (const float*)(P.ws + WS_UPD); const float* DEC = (const float*)(P.ws + WS_DEC); bf16_t* SP = (bf16_t*)(P.ws + WS_SPREV);
    for (int e = blockIdx.x * NTHR + tz; e < 32 * 2048; e += grid_size() * NTHR) {
        const int bh = e >> 11, kv = e & 2047, k = kv >> 6;
        float st = 0.f;
#pragma unroll 8
        for (int n = 0; n < 64; ++n) {
            const size_t u = (size_t)bh * 64 + n;
            SP[u * 2048 + kv] = f2bf(st);
            st = DEC[u * 32 + k] * st + UPD[u * 2048 + kv];
        }
    }
}
__device__ __forceinline__ void ph_gla_y(const Params& P, int layer, LAS unsigned char* lds) {
    using at::f32x16; using at::s16x4; using at::vtr; using at::cvtpk;
    typedef unsigned u32x4 __attribute__((ext_vector_type(4)));
    const int tid = opaque_tid(); const int wid = __builtin_amdgcn_readfirstlane(tid >> 6), lane = tid & 63, r32 = lane & 31, hi = lane >> 5;
    LAS unsigned char* vl = lds + wid * 12288; LAS unsigned char* sl = vl + 8192;
    const bf16_t* Z = (const bf16_t*)(P.ws + WS_BIG + BIG_Z); const float* LA = (const float*)(P.ws + WS_BIG + BIG_LA); const bf16_t* SP = (const bf16_t*)(P.ws + WS_SPREV);
    bf16_t* YM = (bf16_t*)(P.ws + WS_YMIX); const float* gon = P.gla_on + layer * 64;
    const int vfo = ((lane >> 4) & 1) * 32 + (lane & 3) * 8 + (4 * hi + ((lane & 15) >> 2)) * 64;
    const int sfo = ((lane >> 4) & 1) * 32 + (lane & 3) * 8 + ((lane & 15) >> 2) * 64;
    for (int u = blockIdx.x * NWV + wid; u < 2048; u += grid_size() * NWV) {
        const int bh = u >> 6, n = u & 63, b = bh >> 2, h = bh & 3;
        const size_t t0 = (size_t)b * SEQ + n * 64;
#pragma unroll
        for (int p = 0; p < 8; ++p) {
            const int row = 8 * p + (lane >> 3), dv = 8 * (lane & 7);
            const u32x4 x = *(const u32x4*)(Z + (t0 + row) * ZW + ZC_GV + h * 64 + dv);
            *(LAS u32x4*)(vl + (dv >> 5) * 4096 + (row >> 3) * 512 + (row & 7) * 64 + (dv & 31) * 2) = x;
        }
#pragma unroll
        for (int p = 0; p < 4; ++p) {
            const int row = 8 * p + (lane >> 3), dv = 8 * (lane & 7);
            const u32x4 x = *(const u32x4*)(SP + ((size_t)u * 32 + row) * 64 + dv);
            *(LAS u32x4*)(sl + (dv >> 5) * 2048 + (row >> 3) * 512 + (row & 7) * 64 + (dv & 31) * 2) = x;
        }
        bf16x8 qfr[2][2], kfr[2][2];
#pragma unroll
        for (int blk = 0; blk < 2; ++blk)
#pragma unroll
            for (int ks = 0; ks < 2; ++ks) {
                const size_t t = t0 + 32 * blk + r32; const int k0 = 16 * ks + 8 * hi;
                const uint4 qraw = *(const uint4*)(Z + t * ZW + ZC_GQ + h * 32 + k0), kraw = *(const uint4*)(Z + t * ZW + ZC_GK + h * 32 + k0);
                const f32x4 b0 = *(const f32x4*)(LA + t * 128 + h * 32 + k0), b1 = *(const f32x4*)(LA + t * 128 + h * 32 + k0 + 4);
                const unsigned qw[4] = {qraw.x, qraw.y, qraw.z, qraw.w}, kw[4] = {kraw.x, kraw.y, kraw.z, kraw.w};
                const float bcv[8] = {b0[0], b0[1], b0[2], b0[3], b1[0], b1[1], b1[2], b1[3]};
                u32x4 qo, ko;
#pragma unroll
                for (int w = 0; w < 4; ++w) {
                    const float e0 = __expf(bcv[2 * w]), e1 = __expf(bcv[2 * w + 1]);
                    const float q0 = bf2f(qw[w] & 0xffff) * 0.17677669529663687f * e0, q1 = bf2f(qw[w] >> 16) * 0.17677669529663687f * e1;
                    const float k0f = bf2f(kw[w] & 0xffff) * __expf(-bcv[2 * w]), k1f = bf2f(kw[w] >> 16) * __expf(-bcv[2 * w + 1]);
                    qo[w] = cvtpk(q0, q1); ko[w] = cvtpk(k0f, k1f);
                }
                qfr[blk][ks] = __builtin_bit_cast(bf16x8, qo); kfr[blk][ks] = __builtin_bit_cast(bf16x8, ko);
            }
        f32x16 z16;
#pragma unroll
        for (int r = 0; r < 16; ++r) z16[r] = 0.f;
        f32x16 s00 = __builtin_amdgcn_mfma_f32_32x32x16_bf16(kfr[0][0], qfr[0][0], z16, 0, 0, 0); s00 = __builtin_amdgcn_mfma_f32_32x32x16_bf16(kfr[0][1], qfr[0][1], s00, 0, 0, 0);
        f32x16 s01 = __builtin_amdgcn_mfma_f32_32x32x16_bf16(kfr[0][0], qfr[1][0], z16, 0, 0, 0); s01 = __builtin_amdgcn_mfma_f32_32x32x16_bf16(kfr[0][1], qfr[1][1], s01, 0, 0, 0);
        f32x16 s11 = __builtin_amdgcn_mfma_f32_32x32x16_bf16(kfr[1][0], qfr[1][0], z16, 0, 0, 0); s11 = __builtin_amdgcn_mfma_f32_32x32x16_bf16(kfr[1][1], qfr[1][1], s11, 0, 0, 0);
#pragma unroll
        for (int r = 0; r < 16; ++r) { const int jl = (r & 3) + 8 * (r >> 2) + 4 * hi; if (jl > r32) { s00[r] = 0.f; s11[r] = 0.f; } }
        bf16x8 p00[2], p01[2], p11[2];
#pragma unroll
        for (int sp = 0; sp < 2; ++sp) {
            u32x4 a, c, d;
#pragma unroll
            for (int w = 0; w < 4; ++w) { a[w] = cvtpk(s00[8 * sp + 2 * w], s00[8 * sp + 2 * w + 1]); c[w] = cvtpk(s01[8 * sp + 2 * w], s01[8 * sp + 2 * w + 1]); d[w] = cvtpk(s11[8 * sp + 2 * w], s11[8 * sp + 2 * w + 1]); }
            p00[sp] = __builtin_bit_cast(bf16x8, a); p01[sp] = __builtin_bit_cast(bf16x8, c); p11[sp] = __builtin_bit_cast(bf16x8, d);
        }
        asm volatile("s_waitcnt lgkmcnt(0)" ::: "memory");
        f32x16 o[2][2];
#pragma unroll
        for (int vb = 0; vb < 2; ++vb) {
            o[vb][0] = z16; o[vb][1] = z16;
#pragma unroll
            for (int k2 = 0; k2 < 4; ++k2) {
                const s16x4 a0 = vtr(vl + vfo + vb * 4096 + k2 * 1024), a1 = vtr(vl + vfo + vb * 4096 + k2 * 1024 + 512);
                const bf16x8 vt = {a0[0], a0[1], a0[2], a0[3], a1[0], a1[1], a1[2], a1[3]};
                if (k2 < 2) { o[vb][0] = __builtin_amdgcn_mfma_f32_32x32x16_bf16(vt, p00[k2], o[vb][0], 0, 0, 0); o[vb][1] = __builtin_amdgcn_mfma_f32_32x32x16_bf16(vt, p01[k2], o[vb][1], 0, 0, 0); }
                else o[vb][1] = __builtin_amdgcn_mfma_f32_32x32x16_bf16(vt, p11[k2 - 2], o[vb][1], 0, 0, 0);
            }
#pragma unroll
            for (int ks = 0; ks < 2; ++ks) {
                const s16x4 a0 = vtr(sl + sfo + vb * 2048 + (2 * ks + hi) * 512), a1 = vtr(sl + sfo + vb * 2048 + (2 * ks + hi) * 512 + 256);
                const bf16x8 st = {a0[0], a0[1], a0[2], a0[3], a1[0], a1[1], a1[2], a1[3]};
                o[vb][0] = __builtin_amdgcn_mfma_f32_32x32x16_bf16(st, qfr[0][ks], o[vb][0], 0, 0, 0);
                o[vb][1] = __builtin_amdgcn_mfma_f32_32x32x16_bf16(st, qfr[1][ks], o[vb][1], 0, 0, 0);
            }
        }
#pragma unroll
        for (int ib = 0; ib < 2; ++ib) {
            const size_t t = t0 + 32 * ib + r32;
            float ss = 0.f;
#pragma unroll
            for (int r = 0; r < 16; ++r) ss += o[0][ib][r] * o[0][ib][r] + o[1][ib][r] * o[1][ib][r];
            ss = at::xhalf_sum(ss);
            const float rstd = rsqrtf(ss * (1.0f / 64.0f) + EPS);
#pragma unroll
            for (int vb = 0; vb < 2; ++vb)
#pragma unroll
                for (int g = 0; g < 4; ++g) {
                    const int v0 = 32 * vb + 8 * g + 4 * hi;
                    const uint2 rr = *(const uint2*)(Z + t * ZW + ZC_GR + h * 64 + v0); const f32x4 gn = *(const f32x4*)(gon + v0);
                    const float r0 = bf2f(rr.x & 0xffff), r1 = bf2f(rr.x >> 16), r2 = bf2f(rr.y & 0xffff), r3 = bf2f(rr.y >> 16);
                    const float y0 = o[vb][ib][4 * g] * rstd * gn[0] * r0 * sigmoidf_(r0), y1 = o[vb][ib][4 * g + 1] * rstd * gn[1] * r1 * sigmoidf_(r1);
                    const float y2 = o[vb][ib][4 * g + 2] * rstd * gn[2] * r2 * sigmoidf_(r2), y3 = o[vb][ib][4 * g + 3] * rstd * gn[3] * r3 * sigmoidf_(r3);
                    *(uint2*)(YM + t * 1024 + h * 64 + v0) = make_uint2(cvtpk(y0, y1), cvtpk(y2, y3));
                }
        }
        asm volatile("s_waitcnt lgkmcnt(0)" ::: "memory");
    }
}

__device__ __forceinline__ void ph_gla_simple(const Params& P, int layer, unsigned char* lds) {
    if (blockIdx.x >= 4) return;
    const int tz = opaque_tid(); const int wid = tz >> 6, lane = tz & 63;
    float (*sq)[32] = (float (*)[32])(lds + wid * 3072), (*sk)[32] = (float (*)[32])(lds + wid * 3072 + 1024), (*sa)[32] = (float (*)[32])(lds + wid * 3072 + 2048);
    const int bh = blockIdx.x * 8 + wid, b = bh >> 2, h = bh & 3;
    const bf16_t* Z = (const bf16_t*)(P.ws + WS_BIG + BIG_Z); const float* LA = (const float*)(P.ws + WS_BIG + BIG_LA); bf16_t* YM = (bf16_t*)(P.ws + WS_YMIX);
    const float g = P.gla_on[layer * 64 + lane];
    float st[32];
#pragma unroll
    for (int k = 0; k < 32; ++k) st[k] = 0.f;
    for (int c0 = 0; c0 < SEQ; c0 += 8) {
#pragma unroll
        for (int i = 0; i < 4; ++i) {
            const int idx = lane + 64 * i, sp = idx >> 5, k = idx & 31; const size_t t = (size_t)b * SEQ + c0 + sp;
            sq[sp][k] = bf2f(Z[t * ZW + ZC_GQ + h * 32 + k]) * 0.17677669529663687f;
            sk[sp][k] = bf2f(Z[t * ZW + ZC_GK + h * 32 + k]);
            sa[sp][k] = __expf(LA[t * 128 + h * 32 + k]);
        }
        float v[8], r[8];
#pragma unroll
        for (int sp = 0; sp < 8; ++sp) { const size_t t = (size_t)b * SEQ + c0 + sp; v[sp] = bf2f(Z[t * ZW + ZC_GV + h * 64 + lane]); r[sp] = bf2f(Z[t * ZW + ZC_GR + h * 64 + lane]); }
        __syncthreads();
#pragma unroll
        for (int sp = 0; sp < 8; ++sp) {
            float o = 0.f;
#pragma unroll
            for (int k = 0; k < 32; ++k) { st[k] = sa[sp][k] * st[k] + sk[sp][k] * v[sp]; o += sq[sp][k] * st[k]; }
            const float ss = wave_sum(o * o);
            const float on = o * rsqrtf(ss * (1.0f / 64.0f) + EPS) * g;
            const float rr = r[sp];
            YM[((size_t)b * SEQ + c0 + sp) * 1024 + h * 64 + lane] = f2bf(on * rr * sigmoidf_(rr));
        }
        __syncthreads();
    }
}

template <int L> __device__ __forceinline__ void layer_body(const Params& P, const XcdBarrier& bar, unsigned char* lds) {
    constexpr int l = L; char* ws = P.ws; LAS unsigned char* ldsl = (LAS unsigned char*)lds;
    const bf16_t* HB = (const bf16_t*)(ws + WS_HB); const float* RS = (const float*)(ws + WS_RSTD);
    bf16_t* Z = (bf16_t*)(ws + WS_BIG + BIG_Z);
    {
        const char* wsm = ws + WS_WSM + (size_t)l * WSM_STRIDE;
        ph_tconv_exp<(L == 0 ? MOE_FP8_L0 : MOE_FP8_L1)>(P, l, ldsl);
        { EpiBf16_8 e{(bf16_t*)(ws + WS_E), 1024}; ph_gemm_fast<256, 256, true>(ldsl, (const bf16_t*)(ws + WS_PB) + (size_t)l * T * 256, (const bf16_t*)(wsm + WSM_WPLE), 1024, e); }
#ifdef DBL_SHORTK
        { EpiBf16_8 e{(bf16_t*)(ws + WS_E), 1024}; ph_gemm_fast<256, 256, true>(ldsl, (const bf16_t*)(ws + WS_PB) + (size_t)l * T * 256, (const bf16_t*)(wsm + WSM_WPLE), 1024, e); }
#endif
        { EpiZ8 e{Z, RS}; ph_gemm_fast<1024, 1024, true>(ldsl, HB, (const bf16_t*)(wsm + WSM_WIN), ZW, e); }
#ifdef DBL_Z
        { EpiZ8 e{Z, RS}; ph_gemm_fast<1024, 1024, true>(ldsl, HB, (const bf16_t*)(wsm + WSM_WIN), ZW, e); }
#endif
        xcd_barrier(bar);
        ph_prepB(P, l, lds);
#ifdef DBL_PREPB
        __syncthreads(); ph_prepB(P, l, lds);
#endif
        xcd_barrier(bar);
        { EpiBf16_8 e{(bf16_t*)(ws + WS_BIG + BIG_Q), 768}; ph_gemm_fast<256, ZW, true>(ldsl, Z + ZC_CQ, (const bf16_t*)(wsm + WSM_WUQ), 768, e); }
        { EpiBf16_8 e{(bf16_t*)(ws + WS_BIG + BIG_KV), 1024}; ph_gemm_fast<128, ZW, true>(ldsl, Z + ZC_CKV, (const bf16_t*)(wsm + WSM_WUKV), 1024, e); }
#ifdef DBL_SHORTK
        { EpiBf16_8 e{(bf16_t*)(ws + WS_BIG + BIG_Q), 768}; ph_gemm_fast<256, ZW, true>(ldsl, Z + ZC_CQ, (const bf16_t*)(wsm + WSM_WUQ), 768, e); }
        { EpiBf16_8 e{(bf16_t*)(ws + WS_BIG + BIG_KV), 1024}; ph_gemm_fast<128, ZW, true>(ldsl, Z + ZC_CKV, (const bf16_t*)(wsm + WSM_WUKV), 1024, e); }
#endif
        __syncthreads();
        ph_gla_x(P, ldsl);
#ifdef DBL_GLAX
        ph_gla_x<true>(P, ldsl);
#endif
        xcd_barrier(bar);
        ph_prepD(P, l);
#ifdef DBL_PREPD
        ph_prepD<true>(P, l);
#endif
        ph_gla_scan(P);
#ifdef DBL_SCAN
        ph_gla_scan(P);
#endif
        xcd_barrier(bar);
        ph_attn_fast(P, ldsl);
#ifdef DBL_ATTN
        ph_attn_fast(P, ldsl);
#endif
        ph_gla_y(P, l, ldsl);
#ifdef DBL_GLAY
        ph_gla_y(P, l, ldsl);
#endif
        xcd_barrier(bar);
        { EpiResid e{l == 0 ? P.x : P.out, P.out}; ph_gemm_fast<1024, 1024, false>(ldsl, (const bf16_t*)(ws + WS_YMIX), (const bf16_t*)(wsm + WSM_WOUT), 1024, e); }
#ifdef DBL_WOUT0
        if (l == 0) { EpiResid e{P.x, P.out}; ph_gemm_fast<1024, 1024, false>(ldsl, (const bf16_t*)(ws + WS_YMIX), (const bf16_t*)(wsm + WSM_WOUT), 1024, e); }
#endif
        xcd_barrier(bar);
        ph_router<(L == 0 ? MOE_FP8_L0 : MOE_FP8_L1)>(P, l, ldsl);
        xcd_barrier(bar);
        ph_moe_fast<true, (L == 0 ? MOE_FP8_L0 : MOE_FP8_L1)>(P, l, ldsl);
#ifdef DBL_MOE1
        __syncthreads(); ph_moe_fast<true, (L == 0 ? MOE_FP8_L0 : MOE_FP8_L1)>(P, l, ldsl);
#endif
        xcd_barrier(bar);
        ph_moe_fast<false, (L == 0 ? MOE_FP8_L0 : MOE_FP8_L1)>(P, l, ldsl);
#ifdef DBL_MOE2
        __syncthreads(); ph_moe_fast<false, (L == 0 ? MOE_FP8_L0 : MOE_FP8_L1)>(P, l, ldsl);
#endif
        xcd_barrier(bar);
        ph_combine(P);
#ifdef DBL_COMBINE
        ph_combine<true>(P);
#endif
        xcd_barrier(bar);
        { EpiPle8 e{(const bf16_t*)(ws + WS_E), RS + 2 * T, (bf16_t*)(ws + WS_YMIX)}; ph_gemm_fast<1024, 1024, true>(ldsl, HB, (const bf16_t*)(wsm + WSM_WPG), 1024, e); }
#ifdef DBL_PLE
        { EpiPle8 e{(const bf16_t*)(ws + WS_E), RS + 2 * T, (bf16_t*)(ws + WS_YMIX)}; ph_gemm_fast<1024, 1024, true>(ldsl, HB, (const bf16_t*)(wsm + WSM_WPG), 1024, e); }
#endif
        xcd_barrier(bar);
        ph_final(P, l);
#ifdef DBL_FINAL
        ph_final<true>(P, l);
#endif
        xcd_barrier(bar);
    }
}

__global__ void __launch_bounds__(NTHR, 2) mega_fwd(Params P) {
    extern __shared__ __attribute__((aligned(16))) unsigned char lds[];
    char* ws = P.ws;
    if (threadIdx.x == 0) *(uint4*)(lds + LDS_BAR_OFF) = make_uint4(0u, 0u, (unsigned)P.grid, 0u);
    if ((threadIdx.x & 63) == 0) *(volatile LAS int*)((LAS unsigned char*)lds + LDS_WID_OFF + hw_wave_key() * 4) = (int)(threadIdx.x >> 6);
    __syncthreads();
    const XcdBarrier bar = xcd_barrier_post((unsigned*)(ws + WS_CTL), (volatile LAS unsigned*)(lds + LDS_BAR_OFF));
    const bf16_t* HB = (const bf16_t*)(ws + WS_HB); const float* RS = (const float*)(ws + WS_RSTD);
    bf16_t* Z = (bf16_t*)(ws + WS_BIG + BIG_Z);
    for (int l = 0; l < DEPTH; ++l) {
        char* wsm = ws + WS_WSM + (size_t)l * WSM_STRIDE;
        ph_tconv(P.w_in + (size_t)l * 1024 * 1456, nullptr, P.mix_norm + l * 1024, (bf16_t*)(wsm + WSM_WIN), ZW, 1024, 1456, 1, 1, 0, 0, lds);
        ph_tconv(P.w_uq + (size_t)l * 256 * 768, nullptr, P.q_norm + l * 256, (bf16_t*)(wsm + WSM_WUQ), 768, 256, 768, 0, 1, 0, 0, lds);
        ph_tconv(P.w_ukv + (size_t)l * 128 * 1024, nullptr, P.kv_norm + l * 128, (bf16_t*)(wsm + WSM_WUKV), 1024, 128, 1024, 0, 1, 0, 0, lds);
        ph_tconv(P.w_out + (size_t)l * 1024 * 1024, nullptr, nullptr, (bf16_t*)(wsm + WSM_WOUT), 1024, 1024, 1024, 0, 1, 0, 0, lds);
        ph_tconv(P.ple_wg + (size_t)l * 1024 * 1024, nullptr, P.ple_gn + l * 1024, (bf16_t*)(wsm + WSM_WPG), 1024, 1024, 1024, 0, 1, 0, 0, lds);
        ph_tconv(P.ple_wp + (size_t)l * 256 * 1024, nullptr, nullptr, (bf16_t*)(wsm + WSM_WPLE), 1024, 256, 1024, 0, 1, 0, 0, lds);
    }
    ph_conv_bf16(P.p, (bf16_t*)(ws + WS_PB), (long)2 * T * 256 / 8);
    ph_prep_router(P);
    ph_init_h(P);
    ph_rope_table(P);
#ifdef DBL_P0
    __syncthreads();
    for (int l = 0; l < DEPTH; ++l) {
        char* wsm = ws + WS_WSM + (size_t)l * WSM_STRIDE;
        ph_tconv(P.w_in + (size_t)l * 1024 * 1456, nullptr, P.mix_norm + l * 1024, (bf16_t*)(wsm + WSM_WIN), ZW, 1024, 1456, 1, 1, 0, 0, lds);
        ph_tconv(P.w_uq + (size_t)l * 256 * 768, nullptr, P.q_norm + l * 256, (bf16_t*)(wsm + WSM_WUQ), 768, 256, 768, 0, 1, 0, 0, lds);
        ph_tconv(P.w_ukv + (size_t)l * 128 * 1024, nullptr, P.kv_norm + l * 128, (bf16_t*)(wsm + WSM_WUKV), 1024, 128, 1024, 0, 1, 0, 0, lds);
        ph_tconv(P.w_out + (size_t)l * 1024 * 1024, nullptr, nullptr, (bf16_t*)(wsm + WSM_WOUT), 1024, 1024, 1024, 0, 1, 0, 0, lds);
        ph_tconv(P.ple_wg + (size_t)l * 1024 * 1024, nullptr, P.ple_gn + l * 1024, (bf16_t*)(wsm + WSM_WPG), 1024, 1024, 1024, 0, 1, 0, 0, lds);
        ph_tconv(P.ple_wp + (size_t)l * 256 * 1024, nullptr, nullptr, (bf16_t*)(wsm + WSM_WPLE), 1024, 256, 1024, 0, 1, 0, 0, lds);
    }
    ph_conv_bf16(P.p, (bf16_t*)(ws + WS_PB), (long)2 * T * 256 / 8);
    ph_prep_router(P);
    ph_init_h(P);
    ph_rope_table(P);
#endif
    xcd_barrier(bar);
    layer_body<0>(P, bar, lds);
    layer_body<1>(P, bar, lds);
}

extern "C" void kernel_launch(void* const* d_in, const int* in_sizes, int n_in, void* d_out, int out_size, void* d_ws, size_t ws_size, hipStream_t stream) {
    if (n_in != 30 || ws_size < WS_END) { fprintf(stderr, "kernel_launch: need 30 inputs and %zu bytes of workspace (got %d, %zu)\n", (size_t)WS_END, n_in, ws_size); return; }
    static int grid = 0;
    if (!grid) {
        int dev = 0, cus = 0, per_cu = 0;
        if (hipGetDevice(&dev) != hipSuccess || hipDeviceGetAttribute(&cus, hipDeviceAttributeMultiprocessorCount, dev) != hipSuccess) { fprintf(stderr, "kernel_launch: device query failed\n"); return; }
        if (hipFuncSetAttribute((const void*)mega_fwd, hipFuncAttributeMaxDynamicSharedMemorySize, LDS_BYTES) != hipSuccess) { fprintf(stderr, "kernel_launch: hipFuncSetAttribute failed\n"); return; }
        if (hipOccupancyMaxActiveBlocksPerMultiprocessor(&per_cu, (const void*)mega_fwd, NTHR, LDS_BYTES) != hipSuccess || per_cu < 1) { fprintf(stderr, "kernel_launch: occupancy query says %d\n", per_cu); return; }
        grid = cus;
    }
    Params P{};
    P.x = (const float*)d_in[0]; P.p = (const float*)d_in[1]; P.pos = (const int*)d_in[2];
    P.mix_norm = (const float*)d_in[3]; P.w_in = (const float*)d_in[4]; P.gla_wg = (const float*)d_in[5]; P.gla_bg = (const float*)d_in[6]; P.gla_on = (const float*)d_in[7];
    P.q_norm = (const float*)d_in[8]; P.w_uq = (const float*)d_in[9]; P.kv_norm = (const float*)d_in[10]; P.w_ukv = (const float*)d_in[11]; P.qkq = (const float*)d_in[12]; P.qkk = (const float*)d_in[13];
    P.pool_w = (const float*)d_in[14]; P.pool_s = (const float*)d_in[15]; P.w_out = (const float*)d_in[16]; P.ffn_norm = (const float*)d_in[17]; P.router_w = (const float*)d_in[18]; P.router_b = (const float*)d_in[19];
    P.moe_wg = (const float*)d_in[20]; P.moe_bg = (const float*)d_in[21]; P.moe_wu = (const float*)d_in[22]; P.moe_bu = (const float*)d_in[23]; P.moe_wd = (const float*)d_in[24]; P.moe_bd = (const float*)d_in[25];
    P.ple_wp = (const float*)d_in[26]; P.ple_gn = (const float*)d_in[27]; P.ple_wg = (const float*)d_in[28]; P.ple_pn = (const float*)d_in[29];
    P.out = (float*)d_out; P.ws = (char*)d_ws; P.grid = grid; P.pad_ = 0;
    (void)hipMemsetAsync((char*)d_ws + WS_CTL, 0, 65536, stream);
    hipLaunchKernelGGL(mega_fwd, dim3(grid), dim3(NTHR), LDS_BYTES, stream, P);
}
```

```cpp
#include <hip/hip_runtime.h>
#include <cstdio>
#include <cstdint>

typedef unsigned short bf16_t;
typedef short bf16x8 __attribute__((ext_vector_type(8)));
typedef float f32x4 __attribute__((ext_vector_type(4)));

constexpr int T = 32768, DM = 1024, SEQ = 4096, NBATCH = 8, DEPTH = 2;
constexpr int ZW = 1536;
constexpr int ZC_CQ = 0, ZC_GV = 256, ZC_GR = 512, ZC_UP = 768, ZC_GQ = 1024, ZC_GK = 1152, ZC_CKV = 1280, ZC_KR = 1408, ZC_GLOW = 1440;
constexpr int NE = 32, TOPK = 4, DFF = 1024;
constexpr int HROWS = 139264;
constexpr float EPS = 1e-6f;

__host__ __device__ inline int zsrc(int n) {
    if (n < 256) return 784 + n;
    if (n < 512) return 256 + (n - 256);
    if (n < 768) return 528 + (n - 512);
    if (n < 1024) return 1200 + (n - 768);
    if (n < 1152) return n - 1024;
    if (n < 1280) return 128 + (n - 1152);
    if (n < 1408) return 1040 + (n - 1280);
    if (n < 1440) return 1168 + (n - 1408);
    if (n < 1456) return 512 + (n - 1440);
    return -1;
}

constexpr size_t MiB = 1024 * 1024;
constexpr size_t WS_CTL = 0;
constexpr size_t WS_HB = 1 * MiB;
constexpr size_t WS_RSTD = WS_HB + 64 * MiB;
constexpr size_t WS_WSM = WS_RSTD + 1 * MiB;
constexpr size_t WSM_WIN = 0, WSM_WUQ = 3 * MiB, WSM_WUKV = WSM_WUQ + 384 * 1024, WSM_WOUT = WSM_WUKV + 256 * 1024, WSM_WPG = WSM_WOUT + 2 * MiB,
                 WSM_WPLE = WSM_WPG + 2 * MiB, WSM_WR = WSM_WPLE + 512 * 1024, WSM_WPT = WSM_WR + 128 * 1024, WSM_STRIDE = WSM_WR + 128 * 1024 + 128 * 1024;
constexpr size_t WS_PB = WS_WSM + 2 * WSM_STRIDE;
constexpr size_t WS_W1 = WS_PB + 32 * MiB;
constexpr size_t WS_W2 = WS_W1 + 128 * MiB;
constexpr size_t WS_E = WS_W2 + 64 * MiB;
constexpr size_t WS_YMIX = WS_E + 64 * MiB;
constexpr size_t WS_Y = WS_YMIX + 64 * MiB;
constexpr size_t WS_UPD = WS_Y + 256 * MiB;
constexpr size_t WS_DEC = WS_UPD + 16 * MiB;
constexpr size_t WS_SPREV = WS_DEC + 1 * MiB;
constexpr size_t WS_TOPG = WS_SPREV + 8 * MiB;
constexpr size_t WS_LIST = WS_TOPG + 1 * MiB;
constexpr size_t WS_BIG = WS_LIST + 4 * MiB;
constexpr size_t BIG_Z = 0, BIG_Q = 96 * MiB, BIG_KV = BIG_Q + 48 * MiB, BIG_K = BIG_KV + 64 * MiB, BIG_LA = BIG_K + 48 * MiB;
constexpr size_t WS_ROPE = WS_BIG + 272 * MiB;
constexpr size_t WS_LRS = WS_ROPE + 4 * MiB;
constexpr size_t WS_LGT = WS_LRS + 4 * MiB;
constexpr size_t WS_END = WS_LGT + 4 * MiB;
constexpr int CTL_CNT = 4096;

constexpr bool MOE_FP8_L0 = true, MOE_FP8_L1 = true;
__device__ __forceinline__ float bf2f(bf16_t v) { return __uint_as_float(((unsigned)v) << 16); }
__device__ __forceinline__ bf16_t f2bf(float f) { unsigned u = __float_as_uint(f); u += 0x7FFFu + ((u >> 16) & 1u); return (bf16_t)(u >> 16); }
__device__ __forceinline__ unsigned pack2(float lo, float hi) { return (unsigned)f2bf(lo) | ((unsigned)f2bf(hi) << 16); }
template <int CTRL> __device__ __forceinline__ float dppx(float v) { return __int_as_float(__builtin_amdgcn_update_dpp(0, __float_as_int(v), CTRL, 0xf, 0xf, true)); }
__device__ __forceinline__ unsigned pack4_fp8(float x0, float x1, float x2, float x3) { int w = 0; w = __builtin_amdgcn_cvt_pk_fp8_f32(x0, x1, w, false); w = __builtin_amdgcn_cvt_pk_fp8_f32(x2, x3, w, true); return (unsigned)w; }
__device__ __forceinline__ float wave_sum(float v) {
    v += dppx<0xB1>(v); v += dppx<0x4E>(v); v += dppx<0x141>(v); v += dppx<0x140>(v);
    { auto rr = __builtin_amdgcn_permlane16_swap(__float_as_uint(v), __float_as_uint(v), false, false); v = __uint_as_float(rr[0]) + __uint_as_float(rr[1]); }
    { auto rr = __builtin_amdgcn_permlane32_swap(__float_as_uint(v), __float_as_uint(v), false, false); v = __uint_as_float(rr[0]) + __uint_as_float(rr[1]); }
    return v;
}
__device__ __forceinline__ float wave_max(float v) {
    v = fmaxf(v, dppx<0xB1>(v)); v = fmaxf(v, dppx<0x4E>(v)); v = fmaxf(v, dppx<0x141>(v)); v = fmaxf(v, dppx<0x140>(v));
    { auto rr = __builtin_amdgcn_permlane16_swap(__float_as_uint(v), __float_as_uint(v), false, false); v = fmaxf(__uint_as_float(rr[0]), __uint_as_float(rr[1])); }
    { auto rr = __builtin_amdgcn_permlane32_swap(__float_as_uint(v), __float_as_uint(v), false, false); v = fmaxf(__uint_as_float(rr[0]), __uint_as_float(rr[1])); }
    return v;
}
__device__ __forceinline__ float sigmoidf_(float x) { return __builtin_amdgcn_rcpf(1.0f + __builtin_amdgcn_exp2f(-1.4426950408889634f * x)); }


#define XB_TMO      128
#define XB_XCNT(j)  (256  + 64 * (j))
#define XB_XSUB(j)  (1280 + 64 * (j))
#define XB_XGEN(j)  (2304 + 64 * (j))
#define XB_TOP      3328
#define XB_TOPGEN   3392
#define XCD_BAR_WORDS 3456
#define XB_SPIN_CAP (1u << 18)
#define LAS __attribute__((address_space(3)))

constexpr int LDS_WID_OFF = 147456 - 16 - 256, LDS_GRID_OFF = 147456 - 16 + 8;
__device__ __forceinline__ int grid_size() { extern __shared__ __attribute__((aligned(16))) unsigned char lds_dyn_[]; return __builtin_amdgcn_readfirstlane(*(const volatile LAS int*)((LAS unsigned char*)lds_dyn_ + LDS_GRID_OFF)); }
__device__ __forceinline__ unsigned hw_wave_key() { return (unsigned)__builtin_amdgcn_s_getreg((5 << 11) | 4) & 63u; }
__device__ __forceinline__ int opaque_tid() {
    extern __shared__ __attribute__((aligned(16))) unsigned char lds_dyn_[];
    const int wv = __builtin_amdgcn_readfirstlane(*(const volatile LAS int*)((LAS unsigned char*)lds_dyn_ + LDS_WID_OFF + hw_wave_key() * 4));
    int ln; asm volatile("v_mbcnt_lo_u32_b32 %0, -1, 0\n\tv_mbcnt_hi_u32_b32 %0, -1, %0" : "=v"(ln));
    int t = wv * 64 + ln;
    asm volatile("" : "+v"(t)); return t;
}

__device__ __forceinline__ unsigned xb_ld(unsigned* p)              { return __hip_atomic_load(p, __ATOMIC_RELAXED, __HIP_MEMORY_SCOPE_AGENT); }
__device__ __forceinline__ unsigned xb_add(unsigned* p, unsigned v) { return __hip_atomic_fetch_add(p, v, __ATOMIC_RELAXED, __HIP_MEMORY_SCOPE_AGENT); }
__device__ __forceinline__ unsigned xb_xcc_id() { return (unsigned)__builtin_amdgcn_s_getreg((3 << 11) | 20) & 0xFu; }
#define XB_SPIN(cond, bar) do { unsigned _sp = 0; while (cond) { __builtin_amdgcn_s_sleep(1); \
    if ((++_sp & 255u) == 0u) { if (xb_ld(&(bar)[XB_TMO])) break; if (_sp > XB_SPIN_CAP) { atomicAdd(&(bar)[XB_TMO], 1u); break; } } } } while (0)

struct XcdBarrier {
    unsigned* bar; unsigned x;
    volatile LAS unsigned* st;
};

__device__ __forceinline__ XcdBarrier xcd_barrier_post(unsigned* bar, volatile LAS unsigned* st) {
    XcdBarrier b; b.bar = bar; b.x = xb_xcc_id(); b.st = st;
    if (threadIdx.x == 0) (void)xb_add(&bar[XB_XCNT(b.x)], 1u);
    return b;
}
__device__ __forceinline__ void xcd_barrier_complete(unsigned* bar, unsigned x, unsigned& nloc, unsigned& nx) {
    const unsigned G = (unsigned)grid_size();
    unsigned sum, cnt, mine, sp = 0u;
    for (;;) {
        sum = 0u; cnt = 0u; mine = 0u;
#pragma unroll
        for (unsigned j = 0; j < 16; ++j) { const unsigned c = xb_ld(&bar[XB_XCNT(j)]); sum += c; cnt += (c > 0u) ? 1u : 0u; mine = (j == x) ? c : mine; }
        if (sum == G) break;
        __builtin_amdgcn_s_sleep(1);
        if ((++sp & 255u) == 0u) { if (xb_ld(&bar[XB_TMO])) break; if (sp > XB_SPIN_CAP) { atomicAdd(&bar[XB_TMO], 1u); break; } }
    }
    nloc = mine > 0u ? mine : 1u; nx = cnt > 0u ? cnt : 1u;
}

__device__ __forceinline__ void xcd_barrier1(const XcdBarrier& b) {
    asm volatile("s_waitcnt vmcnt(0)" ::: "memory");
    __syncthreads();
    if (opaque_tid() == 0) {
        unsigned* bar = b.bar;
        __builtin_amdgcn_s_waitcnt(0);
        unsigned nloc = b.st[0], nx = b.st[1];
        if (nloc == 0u) { xcd_barrier_complete(bar, b.x, nloc, nx); b.st[0] = nloc; b.st[1] = nx; }
        const unsigned old = xb_add(&bar[XB_XSUB(b.x)], 1u);
        const unsigned gen = old / nloc;
        if (old + 1u == (gen + 1u) * nloc) {
            __builtin_amdgcn_fence(__ATOMIC_RELEASE, "agent");
            asm volatile("s_waitcnt vmcnt(0)" ::: "memory");
            const unsigned og = xb_add(&bar[XB_TOP], 1u);
            const unsigned tg = og / nx;
            if (og + 1u == (tg + 1u) * nx) xb_add(&bar[XB_TOPGEN], 1u);
            else XB_SPIN(xb_ld(&bar[XB_TOPGEN]) == tg, bar);
            __builtin_amdgcn_fence(__ATOMIC_ACQUIRE, "agent");
            xb_add(&bar[XB_XGEN(b.x)], 1u);
            asm volatile("s_waitcnt vmcnt(0)" ::: "memory");
        } else {
            XB_SPIN(xb_ld(&bar[XB_XGEN(b.x)]) == gen, bar);
            __builtin_amdgcn_fence(__ATOMIC_ACQUIRE, "agent");
            asm volatile("s_waitcnt vmcnt(0)" ::: "memory");
        }
    }
    __syncthreads();
}

struct Params {
    const float *x, *p; const int* pos;
    const float *mix_norm, *w_in, *gla_wg, *gla_bg, *gla_on, *q_norm, *w_uq, *kv_norm, *w_ukv, *qkq, *qkk, *pool_w, *pool_s, *w_out, *ffn_norm, *router_w, *router_b,
        *moe_wg, *moe_bg, *moe_wu, *moe_bu, *moe_wd, *moe_bd, *ple_wp, *ple_gn, *ple_wg, *ple_pn;
    float* out; char* ws; int grid; int pad_;
};


#ifdef DBL_BAR
__device__ __forceinline__ void xcd_barrier(const XcdBarrier& b) { xcd_barrier1(b); xcd_barrier1(b); }
#else
__device__ __forceinline__ void xcd_barrier(const XcdBarrier& b) { xcd_barrier1(b); }
#endif
constexpr int NTHR = 512, NWV = 8;

constexpr int LDS_BYTES = 147456;
constexpr int LDS_BAR_OFF = LDS_BYTES - 16;

__device__ __forceinline__ void ph_tconv(const float* src, const float* src2, const float* gain, bf16_t* dst, int N, int K, int ld_src, int mode, int nexp, long se, long de, unsigned char* lds) {
    const int tz = opaque_tid(); const int tid = tz & 255, half = tz >> 8, tx = tid & 63, ty = tid >> 6;
    float (*tile)[65] = (float (*)[65])(lds + half * 16640);
    const int nx = N / 64, ny = K / 64, nunits = nx * ny * nexp;
    for (int u0 = blockIdx.x * 2; u0 < nunits; u0 += grid_size() * 2) {
        const int u = u0 + half; const int bx = u % nx, by = (u / nx) % ny, e = u / (nx * ny);
        const float* s1 = src + (long)e * se; const float* s2 = src2 ? src2 + (long)e * se : nullptr; bf16_t* d = dst + (long)e * de;
        const int n0 = bx * 64, k0 = by * 64, n = n0 + tx;
        const float* sp = s1; int col;
        if (mode == 0) col = n;
        else if (mode == 1) col = zsrc(n);
        else { const int tl = n >> 8, w = n & 255; if (w < 128) col = tl * 128 + w; else { col = tl * 128 + (w - 128); sp = s2; } }
#pragma unroll
        for (int i = 0; i < 16; ++i) {
            const int k = k0 + ty + 4 * i; float v = 0.f;
            if (col >= 0) v = sp[(long)k * ld_src + col];
            if (gain) v *= gain[k];
            tile[ty + 4 * i][tx] = v;
        }
        __syncthreads();
        const int nl = tid >> 2, ks = (tid & 3) * 16;
        unsigned w0 = pack2(tile[ks + 0][nl], tile[ks + 1][nl]), w1 = pack2(tile[ks + 2][nl], tile[ks + 3][nl]), w2 = pack2(tile[ks + 4][nl], tile[ks + 5][nl]), w3 = pack2(tile[ks + 6][nl], tile[ks + 7][nl]);
        unsigned w4 = pack2(tile[ks + 8][nl], tile[ks + 9][nl]), w5 = pack2(tile[ks + 10][nl], tile[ks + 11][nl]), w6 = pack2(tile[ks + 12][nl], tile[ks + 13][nl]), w7 = pack2(tile[ks + 14][nl], tile[ks + 15][nl]);
        uint4* o = (uint4*)(d + (long)(n0 + nl) * K + k0 + ks);
        o[0] = make_uint4(w0, w1, w2, w3); o[1] = make_uint4(w4, w5, w6, w7);
        __syncthreads();
    }
}

template <bool FP8> __device__ __forceinline__ void ph_tconv_exp(const Params& P, int layer, LAS unsigned char* lds) {
    const int tid = opaque_tid();
    const int lr = tid >> 6, c4 = tid & 63;
    const int sn = tid >> 3, sk = tid & 7;
    constexpr int PITCH = FP8 ? 80 : 144;
    LAS unsigned char* tile = lds;
    const float* gain = P.ffn_norm + layer * 1024;
    const int nunits = 3 * 32 * 16 * 4;
    for (int u = blockIdx.x; u < nunits; u += grid_size()) {
        const int nt = u & 3, kt = (u >> 2) & 15, e = (u >> 6) & 31, mat = u >> 11;
        const float* src = (mat == 0 ? P.moe_wg : mat == 1 ? P.moe_wu : P.moe_wd) + ((size_t)layer * 32 + e) * 1024 * 1024 + (size_t)(kt * 64) * 1024 + nt * 256 + c4 * 4;
        f32x4 v[8];
#pragma unroll
        for (int i = 0; i < 8; ++i) v[i] = *(const f32x4*)(src + (size_t)(lr + 8 * i) * 1024);
        if (mat < 2) {
#pragma unroll
            for (int i = 0; i < 8; ++i) v[i] *= gain[kt * 64 + lr + 8 * i];
        }
        __syncthreads();
        if constexpr (FP8) {
#pragma unroll
            for (int i = 0; i < 8; ++i) { const unsigned w = pack4_fp8(v[i][0] * 64.0f, v[i][1] * 64.0f, v[i][2] * 64.0f, v[i][3] * 64.0f);
#pragma unroll
                for (int j = 0; j < 4; ++j) tile[(c4 * 4 + j) * PITCH + lr + 8 * i] = (unsigned char)(w >> (8 * j)); }
        } else {
#pragma unroll
            for (int i = 0; i < 8; ++i)
#pragma unroll
                for (int j = 0; j < 4; ++j) *(LAS bf16_t*)(tile + (c4 * 4 + j) * PITCH + (lr + 8 * i) * 2) = f2bf(v[i][j]);
        }
        __syncthreads();
        typedef unsigned u32x4 __attribute__((ext_vector_type(4)));
        if constexpr (FP8) {
            unsigned char* dst = (mat < 2) ? (unsigned char*)(P.ws + WS_W1) + (size_t)e * 2048 * 1024 : (unsigned char*)(P.ws + WS_W2) + (size_t)e * 1024 * 1024;
#pragma unroll
            for (int j = 0; j < 2; ++j) {
                const int id = tid + 512 * j, nl = id >> 2, ck = id & 3, n = nt * 256 + nl;
                const int drow = (mat == 2) ? n : ((n >> 7) * 256 + (n & 127) + (mat == 1 ? 128 : 0));
                *(u32x4*)(dst + (size_t)drow * 1024 + kt * 64 + ck * 16) = *(const LAS u32x4*)(tile + nl * PITCH + ck * 16);
            }
        } else {
            bf16_t* dst = (mat < 2) ? (bf16_t*)(P.ws + WS_W1) + (size_t)e * 2048 * 1024 : (bf16_t*)(P.ws + WS_W2) + (size_t)e * 1024 * 1024;
#pragma unroll
            for (int j = 0; j < 4; ++j) {
                const int nl = sn + 64 * j, n = nt * 256 + nl;
                const int drow = (mat == 2) ? n : ((n >> 7) * 256 + (n & 127) + (mat == 1 ? 128 : 0));
                *(u32x4*)(dst + (size_t)drow * 1024 + kt * 64 + sk * 8) = *(const LAS u32x4*)(tile + nl * PITCH + sk * 16);
            }
        }
    }
    __syncthreads();
}
__device__ __forceinline__ void ph_conv_bf16(const float* src, bf16_t* dst, long n8) {
    const int tz = opaque_tid();
    for (int i = blockIdx.x * NTHR + tz; i < (int)n8; i += grid_size() * NTHR) {
        const float4 a = ((const float4*)src)[2 * i], b = ((const float4*)src)[2 * i + 1];
        ((uint4*)dst)[i] = make_uint4(pack2(a.x, a.y), pack2(a.z, a.w), pack2(b.x, b.y), pack2(b.z, b.w));
    }
}
__device__ __forceinline__ void ph_prep_router(const Params& P) {
    const int tz = opaque_tid();
    for (int i = blockIdx.x * NTHR + tz; i < 2 * 4 * 64 * 64; i += grid_size() * NTHR) {
        const int l = i >> 14, g = (i >> 12) & 3, d = (i >> 6) & 63, c = i & 63;
        ((bf16_t*)(P.ws + WS_WSM + (size_t)l * WSM_STRIDE + WSM_WPT))[(g * 64 + d) * 64 + c] = f2bf(P.pool_w[(size_t)l * 16384 + (g * 64 + c) * 64 + d]);
    }
    for (int i = blockIdx.x * NTHR + tz; i < 2 * 32 * 1024; i += grid_size() * NTHR) {
        const int l = i >> 15, e = (i >> 10) & 31, k = i & 1023;
        float* Wr = (float*)(P.ws + WS_WSM + (size_t)l * WSM_STRIDE + WSM_WR);
        Wr[e * 1024 + k] = P.router_w[((size_t)l * 1024 + k) * 32 + e] * P.ffn_norm[l * 1024 + k];
    }
}


__device__ __forceinline__ void ph_rope_table(const Params& P) {
    const int tz = opaque_tid();
    float* RT = (float*)(P.ws + WS_ROPE);
    for (int e = blockIdx.x * NTHR + tz; e < T * 16; e += grid_size() * NTHR) {
        const int t = e >> 4, i = e & 15;
        const float inv = exp2f(-(float)(2 * i) * (1.0f / 32.0f) * 13.287712379549449f);
        const float ang = (float)P.pos[t] * inv;
        RT[(size_t)t * 32 + i] = cosf(ang); RT[(size_t)t * 32 + 16 + i] = sinf(ang);
    }
}

__device__ __forceinline__ void ph_init_h(const Params& P) {
    const int tz = opaque_tid(); const int wid = tz >> 6, lane = tz & 63;
    bf16_t* HB = (bf16_t*)(P.ws + WS_HB); float* RS = (float*)(P.ws + WS_RSTD);
    for (int t = blockIdx.x * NWV + wid; t < T; t += grid_size() * NWV) {
        const float* hr = P.x + (size_t)t * 1024;
        float ss = 0.f; float4 v[4];
#pragma unroll
        for (int i = 0; i < 4; ++i) { v[i] = *(const float4*)(hr + i * 256 + lane * 4); ss += v[i].x * v[i].x + v[i].y * v[i].y + v[i].z * v[i].z + v[i].w * v[i].w; }
        ss = wave_sum(ss);
        if (lane == 0) RS[t] = rsqrtf(ss * (1.0f / 1024.0f) + EPS);
#pragma unroll
        for (int i = 0; i < 4; ++i) *(uint2*)(HB + (size_t)t * 1024 + i * 256 + lane * 4) = make_uint2(pack2(v[i].x, v[i].y), pack2(v[i].z, v[i].w));
    }
}

__device__ __forceinline__ void ph_prepB(const Params& P, int layer, unsigned char* lds) {
    float* wg = (float*)lds;
    const int tid = opaque_tid(), wid = tid >> 6, lane = tid & 63;
    for (int i = tid; i < 16 * 128; i += NTHR) wg[i] = P.gla_wg[(size_t)layer * 2048 + i];
    __syncthreads();
    bf16_t* Z = (bf16_t*)(P.ws + WS_BIG + BIG_Z); float* LA = (float*)(P.ws + WS_BIG + BIG_LA); bf16_t* YM = (bf16_t*)(P.ws + WS_YMIX);
    const float* bg = P.gla_bg + layer * 128; const float* psc = P.pool_s + layer * 256;
    const float bg0 = bg[lane], bg1 = bg[lane + 64];
    for (int t0 = (blockIdx.x * NWV + wid) * 2; t0 < T; t0 += grid_size() * NWV * 2) {
        uint2 cq[2]; unsigned ckv[2]; float gl[2];
#pragma unroll
        for (int tt = 0; tt < 2; ++tt) { const bf16_t* zr = Z + (size_t)(t0 + tt) * ZW; cq[tt] = *(const uint2*)(zr + ZC_CQ + lane * 4); ckv[tt] = *(const unsigned*)(zr + ZC_CKV + lane * 2); gl[tt] = (lane < 16) ? bf2f(zr[ZC_GLOW + lane]) : 0.f; }
#pragma unroll
        for (int tt = 0; tt < 2; ++tt) {
            bf16_t* zr = Z + (size_t)(t0 + tt) * ZW;
            {
                const float a = bf2f(cq[tt].x & 0xffff), b = bf2f(cq[tt].x >> 16), c = bf2f(cq[tt].y & 0xffff), d = bf2f(cq[tt].y >> 16);
                const float r = rsqrtf(wave_sum(a * a + b * b + c * c + d * d) * (1.0f / 256.0f) + EPS);
                *(uint2*)(zr + ZC_CQ + lane * 4) = make_uint2(pack2(a * r, b * r), pack2(c * r, d * r));
            }
            {
                const float a = bf2f(ckv[tt] & 0xffff), b = bf2f(ckv[tt] >> 16);
                const float r = rsqrtf(wave_sum(a * a + b * b) * (1.0f / 128.0f) + EPS);
                *(unsigned*)(zr + ZC_CKV + lane * 2) = pack2(a * r, b * r);
            }
            {
                float l0 = bg0, l1 = bg1;
#pragma unroll
                for (int r = 0; r < 16; ++r) { const float g = __uint_as_float(__builtin_amdgcn_readlane(__float_as_uint(gl[tt]), r)); l0 += g * wg[r * 128 + lane]; l1 += g * wg[r * 128 + lane + 64]; }
                const float a0 = fminf(l0, 0.f) - log1pf(__expf(-fabsf(l0))), a1 = fminf(l1, 0.f) - log1pf(__expf(-fabsf(l1)));
                LA[(size_t)(t0 + tt) * 128 + lane] = a0 * (1.0f / 16.0f); LA[(size_t)(t0 + tt) * 128 + lane + 64] = a1 * (1.0f / 16.0f);
            }
        }
    }
    const bf16_t* WpT = (const bf16_t*)(P.ws + WS_WSM + (size_t)layer * WSM_STRIDE + WSM_WPT);
    const int fr = lane & 15, fq = lane >> 4;
    for (int u = blockIdx.x * NWV + wid; u < T / 16; u += grid_size() * NWV) {
        const int t = u * 16 + fr, sq = t & (SEQ - 1);
#pragma unroll
        for (int gi = 0; gi < 4; ++gi) {
            const int w = 2 << gi; const int cnt = (sq + 1 < w) ? sq + 1 : w; const float rc = 1.0f / (float)cnt;
            bf16x8 af[2];
#pragma unroll
            for (int ks = 0; ks < 2; ++ks) {
                const bf16_t* up = Z + (size_t)t * ZW + ZC_UP + gi * 64 + ks * 32 + fq * 8;
                float acc[8], u0[8];
#pragma unroll
                for (int j = 0; j < 16; ++j) if (j < w) {
                    const int jj = (j < cnt) ? j : 0; const float msk = (j < cnt) ? 1.0f : 0.f;
                    const uint4 x = *(const uint4*)(up - (long)jj * ZW);
                    const float xv[8] = {bf2f(x.x & 0xffff), bf2f(x.x >> 16), bf2f(x.y & 0xffff), bf2f(x.y >> 16), bf2f(x.z & 0xffff), bf2f(x.z >> 16), bf2f(x.w & 0xffff), bf2f(x.w >> 16)};
#pragma unroll
                    for (int e = 0; e < 8; ++e) { if (j == 0) { u0[e] = xv[e]; acc[e] = xv[e]; } else acc[e] += msk * xv[e]; }
                }
                typedef unsigned u32x4 __attribute__((ext_vector_type(4)));
                const u32x4 pk = {pack2(acc[0] * rc - u0[0], acc[1] * rc - u0[1]), pack2(acc[2] * rc - u0[2], acc[3] * rc - u0[3]), pack2(acc[4] * rc - u0[4], acc[5] * rc - u0[5]), pack2(acc[6] * rc - u0[6], acc[7] * rc - u0[7])};
                af[ks] = __builtin_bit_cast(bf16x8, pk);
            }
#pragma unroll
            for (int nb = 0; nb < 4; ++nb) {
                f32x4 acc = {0.f, 0.f, 0.f, 0.f};
#pragma unroll
                for (int ks = 0; ks < 2; ++ks) { const bf16x8 bfr = *(const bf16x8*)(WpT + ((size_t)gi * 64 + nb * 16 + fr) * 64 + ks * 32 + fq * 8); acc = __builtin_amdgcn_mfma_f32_16x16x32_bf16(bfr, af[ks], acc, 0, 0, 0); }
                const int d0 = nb * 16 + fq * 4; const f32x4 sc = *(const f32x4*)(psc + gi * 64 + d0);
                *(uint2*)(YM + (size_t)t * 1024 + 768 + gi * 64 + d0) = make_uint2(pack2(acc[0] * sc[0], acc[1] * sc[1]), pack2(acc[2] * sc[2], acc[3] * sc[3]));
            }
        }
    }
}

template <bool DRY = false> __device__ __forceinline__ void ph_prepD(const Params& P, int layer) {
    const int tid = opaque_tid(), wid = tid >> 6, lane = tid & 63;
    bf16_t* Z = (bf16_t*)(P.ws + WS_BIG + BIG_Z); bf16_t* Q = (bf16_t*)(P.ws + WS_BIG + BIG_Q); const bf16_t* KV = (const bf16_t*)(P.ws + WS_BIG + BIG_KV); bf16_t* Kd = DRY ? (bf16_t*)(P.ws + WS_Y + 64 * MiB) : (bf16_t*)(P.ws + WS_BIG + BIG_K);
    bf16_t* QW = DRY ? (bf16_t*)(P.ws + WS_Y) : Q;
    const float* RT = (const float*)(P.ws + WS_ROPE);
    const float gq0 = P.qkq[layer * 96 + lane], gq1 = (lane < 32) ? P.qkq[layer * 96 + 64 + lane] : 0.f;
    const float gk0 = P.qkk[layer * 96 + lane], gk1 = (lane < 32) ? P.qkk[layer * 96 + 64 + lane] : 0.f;
    const float qscale = 0.10206207261596577f * 1.4426950408889634f;
    for (int t = blockIdx.x * NWV + wid; t < T; t += grid_size() * NWV) {
        const float cs = RT[(size_t)t * 32 + (lane & 15)], sn = RT[(size_t)t * 32 + 16 + (lane & 15)];
        const float kr = (lane < 32) ? bf2f(Z[(size_t)t * ZW + ZC_KR + lane]) : 0.f;
        float qa[8], qb[8], ka[8];
#pragma unroll
        for (int h = 0; h < 8; ++h) {
            qa[h] = bf2f(Q[(size_t)t * 768 + h * 96 + lane]); qb[h] = (lane < 32) ? bf2f(Q[(size_t)t * 768 + h * 96 + 64 + lane]) : 0.f;
            ka[h] = bf2f(KV[(size_t)t * 1024 + h * 128 + lane]);
        }
#pragma unroll
        for (int h = 0; h < 8; ++h) {
            {
                const float r = rsqrtf(wave_sum(qa[h] * qa[h] + qb[h] * qb[h]) * (1.0f / 96.0f) + EPS);
                const float an = qa[h] * r * gq0, bn = qb[h] * r * gq1;
                const float partner = __shfl_xor(bn, 16);
                const float rot = (lane < 16) ? (bn * cs - partner * sn) : (bn * cs + partner * sn);
                QW[(size_t)t * 768 + h * 96 + lane] = f2bf(an * qscale);
                if (lane < 32) QW[(size_t)t * 768 + h * 96 + 64 + lane] = f2bf(rot * qscale);
            }
            {
                const float r = rsqrtf(wave_sum(ka[h] * ka[h] + kr * kr) * (1.0f / 96.0f) + EPS);
                const float an = ka[h] * r * gk0, bn = kr * r * gk1;
                const float partner = __shfl_xor(bn, 16);
                const float rot = (lane < 16) ? (bn * cs - partner * sn) : (bn * cs + partner * sn);
                bf16_t* kp = Kd + ((size_t)t * 8 + h) * 96;
                kp[lane] = f2bf(an);
                if (lane < 32) kp[64 + lane] = f2bf(rot);
            }
        }
    }
}

template <bool FP8> __device__ __forceinline__ void ph_router(const Params& P, int layer, LAS unsigned char* lds) {
    const int tid = opaque_tid(), wid = tid >> 6, lane = tid & 63;
    bf16_t* HB = (bf16_t*)(P.ws + WS_HB); float* RS1 = (float*)(P.ws + WS_RSTD) + T;
    const float* Wr = (const float*)(P.ws + WS_WSM + (size_t)layer * WSM_STRIDE + WSM_WR);
    const float* rb = P.router_b + layer * 32;
    unsigned* cnt = (unsigned*)(P.ws + WS_CTL) + CTL_CNT + layer * 32;
    int* LIST = (int*)(P.ws + WS_LIST); float* TOPG = (float*)(P.ws + WS_TOPG);
    LAS f32x4* wl = (LAS f32x4*)lds;
    for (int i = tid; i < 32 * 256; i += NTHR) wl[i] = *(const f32x4*)(Wr + (size_t)i * 4);
    constexpr int ENT_PER_WAVE = 128;
    LAS unsigned* lcnt = (LAS unsigned*)(lds + 131072); LAS unsigned* lbase = lcnt + 32;
    LAS unsigned* ent = lbase + 32;
    LAS unsigned* ent_tok = ent + NWV * ENT_PER_WAVE * 2; LAS float* ent_rs = (LAS float*)(ent_tok + NWV * ENT_PER_WAVE / 4);
    if (tid < 32) lcnt[tid] = 0u;
    int nloc = 0;
    __syncthreads();
    const float myb = rb[lane >> 1];
    for (int t0 = (blockIdx.x * NWV + wid) * 2; t0 < T; t0 += grid_size() * NWV * 2) {
        f32x4 v[2][4]; float rstd[2];
#pragma unroll
        for (int tt = 0; tt < 2; ++tt) {
            const bf16_t* hr = HB + (size_t)(t0 + tt) * 1024; float ss = 0.f;
#pragma unroll
            for (int i = 0; i < 4; ++i) { const uint2 raw = *(const uint2*)(hr + i * 256 + lane * 4); v[tt][i] = (f32x4){bf2f(raw.x & 0xffff), bf2f(raw.x >> 16), bf2f(raw.y & 0xffff), bf2f(raw.y >> 16)};
                ss += v[tt][i][0] * v[tt][i][0] + v[tt][i][1] * v[tt][i][1] + v[tt][i][2] * v[tt][i][2] + v[tt][i][3] * v[tt][i][3]; }
            ss = wave_sum(ss);
            rstd[tt] = rsqrtf(ss * (1.0f / 1024.0f) + EPS);
            if (lane == 0) RS1[t0 + tt] = rstd[tt];
#pragma unroll
            for (int i = 0; i < 4; ++i) {
                if constexpr (FP8) *(unsigned*)((unsigned char*)(P.ws + WS_YMIX) + (size_t)(t0 + tt) * 1024 + i * 256 + lane * 4) = pack4_fp8(v[tt][i][0], v[tt][i][1], v[tt][i][2], v[tt][i][3]);
            }
        }
        float q0[16], q1[16];
        {
            const bool lo5 = !(lane & 32);
#pragma unroll
            for (int e = 0; e < 16; ++e) {
                float a0 = 0.f, a1 = 0.f, b0 = 0.f, b1 = 0.f;
#pragma unroll
                for (int i = 0; i < 4; ++i) {
                    const f32x4 w = wl[e * 256 + i * 64 + lane], x = wl[(e + 16) * 256 + i * 64 + lane];
                    a0 += v[0][i][0] * w[0] + v[0][i][1] * w[1] + v[0][i][2] * w[2] + v[0][i][3] * w[3];
                    a1 += v[1][i][0] * w[0] + v[1][i][1] * w[1] + v[1][i][2] * w[2] + v[1][i][3] * w[3];
                    b0 += v[0][i][0] * x[0] + v[0][i][1] * x[1] + v[0][i][2] * x[2] + v[0][i][3] * x[3];
                    b1 += v[1][i][0] * x[0] + v[1][i][1] * x[1] + v[1][i][2] * x[2] + v[1][i][3] * x[3];
                }
                q0[e] = (lo5 ? a0 : b0) + __shfl_xor(lo5 ? b0 : a0, 32);
                q1[e] = (lo5 ? a1 : b1) + __shfl_xor(lo5 ? b1 : a1, 32);
                asm volatile("" ::: "memory");
            }
        }
#define RT_STEP(src, dst, n, bit) do { const bool lo_ = !(lane & (bit)); _Pragma("unroll") for (int e_ = 0; e_ < (n); ++e_) { \
            const float mine_ = lo_ ? src[e_] : src[e_ + (n)], give_ = lo_ ? src[e_ + (n)] : src[e_]; dst[e_] = mine_ + __shfl_xor(give_, (bit)); } } while (0)
        float lg[2];
        {
            float r[8], s4[4], s2[2];
            RT_STEP(q0, r, 8, 16); RT_STEP(r, s4, 4, 8); RT_STEP(s4, s2, 2, 4);
            { const bool lo_ = !(lane & 2); const float mine_ = lo_ ? s2[0] : s2[1], give_ = lo_ ? s2[1] : s2[0]; float x = mine_ + __shfl_xor(give_, 2); x += __shfl_xor(x, 1); lg[0] = x * rstd[0] + myb; }
            RT_STEP(q1, r, 8, 16); RT_STEP(r, s4, 4, 8); RT_STEP(s4, s2, 2, 4);
            { const bool lo_ = !(lane & 2); const float mine_ = lo_ ? s2[0] : s2[1], give_ = lo_ ? s2[1] : s2[0]; float x = mine_ + __shfl_xor(give_, 2); x += __shfl_xor(x, 1); lg[1] = x * rstd[1] + myb; }
        }
#undef RT_STEP
#pragma unroll
        for (int tt = 0; tt < 2; ++tt) {
            float mylg = lg[tt]; float tv[4]; int ti[4];
#pragma unroll
            for (int k = 0; k < 4; ++k) {
                const float best = wave_max(mylg);
                const unsigned long long mask = __ballot(mylg == best);
                const int bi = (__ffsll((long long)mask) - 1) >> 1;
                tv[k] = best; ti[k] = bi;
                mylg = ((lane >> 1) == bi) ? -INFINITY : mylg;
            }
            const float e1 = __expf(tv[1] - tv[0]), e2 = __expf(tv[2] - tv[0]), e3 = __expf(tv[3] - tv[0]);
            const float invs = 1.0f / (1.0f + e1 + e2 + e3);
                if (lane < 4) {
                const int e = (lane == 0) ? ti[0] : (lane == 1) ? ti[1] : (lane == 2) ? ti[2] : ti[3];
                const float g = (lane == 0) ? invs : (lane == 1) ? e1 * invs : (lane == 2) ? e2 * invs : e3 * invs;
                const unsigned rk = __hip_atomic_fetch_add(&lcnt[e], 1u, __ATOMIC_RELAXED, __HIP_MEMORY_SCOPE_WORKGROUP);
                const int slot_ = nloc * 4 + lane;
                ent[(wid * ENT_PER_WAVE + slot_) * 2] = (unsigned)e | (rk << 8);
                ent[(wid * ENT_PER_WAVE + slot_) * 2 + 1] = __float_as_uint(g);
            }
            if (lane == 0) { ent_tok[wid * (ENT_PER_WAVE / 4) + nloc] = (unsigned)(t0 + tt); ent_rs[wid * (ENT_PER_WAVE / 4) + nloc] = rstd[tt]; }
            ++nloc;
        }
    }
    __syncthreads();
    if (tid < 32) lbase[tid] = atomicAdd(&cnt[tid], lcnt[tid]);
    __syncthreads();
    for (int i = lane; i < nloc * 4; i += 64) {
        const unsigned code = ent[(wid * ENT_PER_WAVE + i) * 2]; const int e = (int)(code & 255u); const unsigned pos = lbase[e] + (code >> 8);
        const unsigned tok = ent_tok[wid * (ENT_PER_WAVE / 4) + (i >> 2)];
        LIST[(size_t)e * T + pos] = (int)(tok * 4 + (i & 3));
        ((float*)(P.ws + WS_LRS))[(size_t)e * T + pos] = ent_rs[wid * (ENT_PER_WAVE / 4) + (i >> 2)];
        ((float*)(P.ws + WS_LGT))[(size_t)e * T + pos] = __uint_as_float(ent[(wid * ENT_PER_WAVE + i) * 2 + 1]);
    }
    __syncthreads();
}

template <bool DRY = false> __device__ __forceinline__ void ph_combine(const Params& P) {
    const int tid = opaque_tid(), wid = tid >> 6, lane = tid & 63;
    bf16_t* HB = (bf16_t*)(P.ws + WS_HB); bf16_t* HBW = DRY ? (bf16_t*)(P.ws + WS_BIG + 128 * MiB) : HB; float* RS2 = DRY ? (float*)(P.ws + WS_BIG + 200 * MiB) : (float*)(P.ws + WS_RSTD) + 2 * T; const bf16_t* Y = (const bf16_t*)(P.ws + WS_Y);
    for (int t0 = (blockIdx.x * NWV + wid) * 2; t0 < T; t0 += grid_size() * NWV * 2) {
        uint2 hv[2][4]; uint2 yv[2][4][4];
#pragma unroll
        for (int tt = 0; tt < 2; ++tt)
#pragma unroll
            for (int i = 0; i < 4; ++i) {
                hv[tt][i] = *(const uint2*)(HB + (size_t)(t0 + tt) * 1024 + i * 256 + lane * 4);
#pragma unroll
                for (int k = 0; k < 4; ++k) yv[tt][i][k] = *(const uint2*)(Y + ((size_t)(t0 + tt) * 4 + k) * 1024 + i * 256 + lane * 4);
            }
#pragma unroll
        for (int tt = 0; tt < 2; ++tt) {
            float ss = 0.f;
#pragma unroll
            for (int i = 0; i < 4; ++i) {
                f32x4 v = {bf2f(hv[tt][i].x & 0xffff), bf2f(hv[tt][i].x >> 16), bf2f(hv[tt][i].y & 0xffff), bf2f(hv[tt][i].y >> 16)};
#pragma unroll
                for (int k = 0; k < 4; ++k) { const uint2 y = yv[tt][i][k]; v[0] += bf2f(y.x & 0xffff); v[1] += bf2f(y.x >> 16); v[2] += bf2f(y.y & 0xffff); v[3] += bf2f(y.y >> 16); }
                ss += v[0] * v[0] + v[1] * v[1] + v[2] * v[2] + v[3] * v[3];
                *(uint2*)(HBW + (size_t)(t0 + tt) * 1024 + i * 256 + lane * 4) = make_uint2(pack2(v[0], v[1]), pack2(v[2], v[3]));
            }
            ss = wave_sum(ss);
            if (lane == 0) RS2[t0 + tt] = rsqrtf(ss * (1.0f / 1024.0f) + EPS);
        }
    }
}

template <bool DRY = false> __device__ __forceinline__ void ph_final(const Params& P, int layer) {
    const int tid = opaque_tid(), wid = tid >> 6, lane = tid & 63;
    bf16_t* HB = (bf16_t*)(P.ws + WS_HB); bf16_t* HBW = DRY ? (bf16_t*)(P.ws + WS_BIG + 128 * MiB) : HB; float* RS = DRY ? (float*)(P.ws + WS_BIG + 200 * MiB) : (float*)(P.ws + WS_RSTD); const bf16_t* V = (const bf16_t*)(P.ws + WS_YMIX);
    float* OUTW = DRY ? (float*)(P.ws + WS_BIG) : P.out;
    const float* gp = P.ple_pn + layer * 1024;
    f32x4 g[4];
#pragma unroll
    for (int i = 0; i < 4; ++i) g[i] = *(const f32x4*)(gp + i * 256 + lane * 4);
    for (int t0 = (blockIdx.x * NWV + wid) * 2; t0 < T; t0 += grid_size() * NWV * 2) {
        uint2 hv[2][4]; uint2 yv[2][4];
#pragma unroll
        for (int tt = 0; tt < 2; ++tt)
#pragma unroll
            for (int i = 0; i < 4; ++i) { hv[tt][i] = *(const uint2*)(HB + (size_t)(t0 + tt) * 1024 + i * 256 + lane * 4); yv[tt][i] = *(const uint2*)(V + (size_t)(t0 + tt) * 1024 + i * 256 + lane * 4); }
#pragma unroll
        for (int tt = 0; tt < 2; ++tt) {
            f32x4 vv[4]; float ss = 0.f;
#pragma unroll
            for (int i = 0; i < 4; ++i) { const uint2 y = yv[tt][i]; vv[i] = (f32x4){bf2f(y.x & 0xffff), bf2f(y.x >> 16), bf2f(y.y & 0xffff), bf2f(y.y >> 16)}; ss += vv[i][0] * vv[i][0] + vv[i][1] * vv[i][1] + vv[i][2] * vv[i][2] + vv[i][3] * vv[i][3]; }
            ss = wave_sum(ss);
            const float r = rsqrtf(ss * (1.0f / 1024.0f) + EPS);
            float s2 = 0.f;
#pragma unroll
            for (int i = 0; i < 4; ++i) {
                const f32x4 h = {bf2f(hv[tt][i].x & 0xffff), bf2f(hv[tt][i].x >> 16), bf2f(hv[tt][i].y & 0xffff), bf2f(hv[tt][i].y >> 16)};
                const f32x4 v = h + vv[i] * r * g[i];
                if (layer == DEPTH - 1) *(f32x4*)(OUTW + (size_t)(t0 + tt) * 1024 + i * 256 + lane * 4) = v;
                else { s2 += v[0] * v[0] + v[1] * v[1] + v[2] * v[2] + v[3] * v[3]; *(uint2*)(HBW + (size_t)(t0 + tt) * 1024 + i * 256 + lane * 4) = make_uint2(pack2(v[0], v[1]), pack2(v[2], v[3])); }
            }
            if (layer != DEPTH - 1) { s2 = wave_sum(s2); if (lane == 0) RS[t0 + tt] = rsqrtf(s2 * (1.0f / 1024.0f) + EPS); }
        }
    }
}

struct EpiZ { bf16_t* Z; const float* rstd;
    __device__ __forceinline__ void operator()(int r, int c, f32x4 v) const { const float s = rstd[r]; *(uint2*)(Z + (size_t)r * ZW + c) = make_uint2(pack2(v[0] * s, v[1] * s), pack2(v[2] * s, v[3] * s)); } };
struct EpiBf16 { bf16_t* O; int ldo;
    __device__ __forceinline__ void operator()(int r, int c, f32x4 v) const { *(uint2*)(O + (size_t)r * ldo + c) = make_uint2(pack2(v[0], v[1]), pack2(v[2], v[3])); } };
struct EpiResid { const float* hin; float* out;
    __device__ __forceinline__ void operator()(int r, int c, f32x4 v) const { const f32x4 b = *(const f32x4*)(hin + (size_t)r * 1024 + c); *(f32x4*)(out + (size_t)r * 1024 + c) = b + v; } };
struct EpiMoe1 { const int* list; const float* rstd1; const float* bg; const float* bu; bf16_t* H;
    __device__ __forceinline__ void operator()(int r, int hc, f32x4 g, f32x4 u) const {
        const float s = rstd1[list[r] >> 2]; const f32x4 b0 = *(const f32x4*)(bg + hc), b1 = *(const f32x4*)(bu + hc); float o[4];
#pragma unroll
        for (int j = 0; j < 4; ++j) { const float gg = fminf(g[j] * s + b0[j], 7.0f); const float uu = fminf(fmaxf(u[j] * s + b1[j], -7.0f), 7.0f); o[j] = (uu + 1.0f) * gg * sigmoidf_(1.702f * gg); }
        *(uint2*)(H + (size_t)r * 1024 + hc) = make_uint2(pack2(o[0], o[1]), pack2(o[2], o[3])); } };
struct EpiMoe2 { const int* list; const float* topg; const float* bd; bf16_t* Y;
    __device__ __forceinline__ void operator()(int r, int c, f32x4 v) const { const int ts = list[r]; const float g = topg[ts]; const f32x4 b = *(const f32x4*)(bd + c);
        *(uint2*)(Y + (size_t)ts * 1024 + c) = make_uint2(pack2((v[0] + b[0]) * g, (v[1] + b[1]) * g), pack2((v[2] + b[2]) * g, (v[3] + b[3]) * g)); } };
struct EpiPle { const bf16_t* E; const float* rstd2; bf16_t* V;
    __device__ __forceinline__ void operator()(int r, int c, f32x4 v) const { const float s = rstd2[r]; const uint2 e = *(const uint2*)(E + (size_t)r * 1024 + c);
        const float o0 = bf2f(e.x & 0xffff) * sigmoidf_(v[0] * s), o1 = bf2f(e.x >> 16) * sigmoidf_(v[1] * s), o2 = bf2f(e.y & 0xffff) * sigmoidf_(v[2] * s), o3 = bf2f(e.y >> 16) * sigmoidf_(v[3] * s);
        *(uint2*)(V + (size_t)r * 1024 + c) = make_uint2(pack2(o0, o1), pack2(o2, o3)); } };


typedef unsigned u32x4_t __attribute__((ext_vector_type(4)));
struct EpiZ8 { bf16_t* Z; const float* rstd;
    __device__ __forceinline__ void operator()(int r, int c, f32x4 a, f32x4 b) const { const float s = rstd[r]; *(u32x4_t*)(Z + (size_t)r * ZW + c) = (u32x4_t){pack2(a[0] * s, a[1] * s), pack2(a[2] * s, a[3] * s), pack2(b[0] * s, b[1] * s), pack2(b[2] * s, b[3] * s)}; } };
struct EpiBf16_8 { bf16_t* O; int ldo;
    __device__ __forceinline__ void operator()(int r, int c, f32x4 a, f32x4 b) const { *(u32x4_t*)(O + (size_t)r * ldo + c) = (u32x4_t){pack2(a[0], a[1]), pack2(a[2], a[3]), pack2(b[0], b[1]), pack2(b[2], b[3])}; } };
struct EpiResid8 { const float* xin; bf16_t* HB;
    __device__ __forceinline__ void operator()(int r, int c, f32x4 a, f32x4 b) const {
        f32x4 h0, h1;
        if (xin) { h0 = *(const f32x4*)(xin + (size_t)r * 1024 + c); h1 = *(const f32x4*)(xin + (size_t)r * 1024 + c + 4); }
        else { const u32x4_t e = *(const u32x4_t*)(HB + (size_t)r * 1024 + c); h0 = (f32x4){bf2f(e[0] & 0xffff), bf2f(e[0] >> 16), bf2f(e[1] & 0xffff), bf2f(e[1] >> 16)}; h1 = (f32x4){bf2f(e[2] & 0xffff), bf2f(e[2] >> 16), bf2f(e[3] & 0xffff), bf2f(e[3] >> 16)}; }
        h0 += a; h1 += b;
        *(u32x4_t*)(HB + (size_t)r * 1024 + c) = (u32x4_t){pack2(h0[0], h0[1]), pack2(h0[2], h0[3]), pack2(h1[0], h1[1]), pack2(h1[2], h1[3])}; } };
struct EpiPle8 { const bf16_t* E; const float* rstd2; bf16_t* V;
    __device__ __forceinline__ void operator()(int r, int c, f32x4 a, f32x4 b) const { const float s = rstd2[r]; const u32x4_t e = *(const u32x4_t*)(E + (size_t)r * 1024 + c);
        *(u32x4_t*)(V + (size_t)r * 1024 + c) = (u32x4_t){pack2(bf2f(e[0] & 0xffff) * sigmoidf_(a[0] * s), bf2f(e[0] >> 16) * sigmoidf_(a[1] * s)), pack2(bf2f(e[1] & 0xffff) * sigmoidf_(a[2] * s), bf2f(e[1] >> 16) * sigmoidf_(a[3] * s)),
                                                            pack2(bf2f(e[2] & 0xffff) * sigmoidf_(b[0] * s), bf2f(e[2] >> 16) * sigmoidf_(b[1] * s)), pack2(bf2f(e[3] & 0xffff) * sigmoidf_(b[2] * s), bf2f(e[3] >> 16) * sigmoidf_(b[3] * s))}; } };
__device__ __forceinline__ float swiglu_(float g, float u, float s, float bgv, float buv) { const float gg = fminf(g * s + bgv, 7.0f); const float uu = fminf(fmaxf(u * s + buv, -7.0f), 7.0f); return (uu + 1.0f) * gg * sigmoidf_(1.702f * gg); }

template <class Epi, bool PAIR>
__device__ __forceinline__ void gemm_simple_unit(const bf16_t* A, int lda, const int* rowidx, const bf16_t* Bt, int ldb, int M, int K, int mblk, int nblk, const Epi& epi) {
    const int tid = opaque_tid(), wid = tid >> 6, lane = tid & 63, wr = wid >> 1, wc = wid & 1, fr = lane & 15, fq = lane >> 4;
    const int m0 = mblk * 256 + wr * 64;
    if (m0 >= M) return;
    const bf16_t* ap[4]; const bf16_t* bp[4];
#pragma unroll
    for (int mi = 0; mi < 4; ++mi) { int r = m0 + mi * 16 + fr; if (r >= M) r = M - 1; const long ar = rowidx ? (long)(rowidx[r] >> 2) : (long)r; ap[mi] = A + ar * lda + fq * 8; }
#pragma unroll
    for (int ni = 0; ni < 4; ++ni) {
        int br;
        if (PAIR) { const int hc = nblk * 64 + wc * 32 + (ni & 1) * 16 + fr; br = (hc >> 7) * 256 + (hc & 127) + ((ni >> 1) ? 128 : 0); }
        else br = nblk * 128 + wc * 64 + ni * 16 + fr;
        bp[ni] = Bt + (long)br * ldb + fq * 8;
    }
    f32x4 acc[4][4];
#pragma unroll
    for (int mi = 0; mi < 4; ++mi)
#pragma unroll
        for (int ni = 0; ni < 4; ++ni) acc[mi][ni] = (f32x4){0.f, 0.f, 0.f, 0.f};
    for (int k0 = 0; k0 < K; k0 += 32) {
        bf16x8 a[4], b[4];
#pragma unroll
        for (int i = 0; i < 4; ++i) { a[i] = *(const bf16x8*)(ap[i] + k0); b[i] = *(const bf16x8*)(bp[i] + k0); }
#pragma unroll
        for (int mi = 0; mi < 4; ++mi)
#pragma unroll
            for (int ni = 0; ni < 4; ++ni) acc[mi][ni] = __builtin_amdgcn_mfma_f32_16x16x32_bf16(b[ni], a[mi], acc[mi][ni], 0, 0, 0);
    }
#pragma unroll
    for (int mi = 0; mi < 4; ++mi) {
        const int r = m0 + mi * 16 + fr;
        if (r < M) {
            if constexpr (PAIR) {
#pragma unroll
                for (int ni = 0; ni < 2; ++ni) epi(r, nblk * 64 + wc * 32 + ni * 16 + fq * 4, acc[mi][ni], acc[mi][ni + 2]);
            } else {
#pragma unroll
                for (int ni = 0; ni < 4; ++ni) epi(r, nblk * 128 + wc * 64 + ni * 16 + fq * 4, acc[mi][ni]);
            }
        }
    }
}

namespace fg {
typedef int v4i_t __attribute__((ext_vector_type(4))); typedef int v8i_t __attribute__((ext_vector_type(8)));
constexpr int BM = 256, BK = 64, HALF = 128, HTB = HALF * BK * 2  , STAGE_BYTES = 8 * HTB, NXCD = 8, WGM = 8;
__host__ __device__ __forceinline__ int lds_byte(int r, int c) { const int st = (r >> 4) * 2 + (c >> 5), rr = r & 15, cc = c & 31, ob = rr * 64 + cc * 2; return st * 1024 + (ob ^ (((ob >> 9) & 1) << 5)); }
__host__ __device__ __forceinline__ int perm32(int rho) { const int n = rho >> 4, i = rho & 15; return 8 * (i >> 2) + 4 * n + (i & 3); }
__host__ __device__ __forceinline__ void stage_rc(int b, int& R, int& C) { const int st = b / 1024, sb = b % 1024, swz = sb ^ (((sb >> 9) & 1) << 5); R = (st >> 1) * 16 + swz / 64; C = (st & 1) * 32 + (swz % 64) / 2; }

template <class PB>
__device__ __forceinline__ void gemm_phase(LAS unsigned char* lds, const PB& S) {
    constexpr int K = PB::K, nt = K / BK;
    typedef typename PB::Unit Unit;
    const int tid = opaque_tid(); const int wid = __builtin_amdgcn_readfirstlane(tid >> 6), lane = tid & 63, wr = wid >> 2, wc = wid & 3, fr = lane & 15, fq = lane >> 4;
    unsigned voffB[2];
#pragma unroll
    for (int i = 0; i < 2; ++i) { int R_, C_; stage_rc(tid * 16 + i * 8192, R_, C_); const int Rb_ = PB::PERM ? ((R_ & ~31) + perm32(R_ & 31)) : R_; voffB[i] = (unsigned)(Rb_ * K + C_) * 2u; }
#define FG_AOFFS(dst, unit) do { int tz_ = tid; asm volatile("" : "+v"(tz_)); _Pragma("unroll") for (int i_ = 0; i_ < 2; ++i_) { int R_, C_; stage_rc(tz_ * 16 + i_ * 8192, R_, C_); \
        _Pragma("unroll") for (int h_ = 0; h_ < 2; ++h_) dst[h_][i_] = S.a_off(unit, h_ * HALF + R_) + (unsigned)C_ * 2u; } } while (0)
    constexpr size_t kstep = (size_t)(BK * 2);
    constexpr size_t hstep = (size_t)HALF * K * 2;
    const unsigned ldsw = (unsigned)wid * 1024u;
    const int aoff = lds_byte(wr * 64 + fr, fq * 8), boff = lds_byte(wc * 32 + fr, fq * 8);
#define FG_SA(b, h) (((b) * 2 + (h)) * HTB)
#define FG_SB(b, h) ((4 + (b) * 2 + (h)) * HTB)
#define FG_STAGE_B(bufoff, gbase) do { _Pragma("unroll") for (int _i = 0; _i < 2; ++_i) \
        __builtin_amdgcn_global_load_lds((const unsigned*)((const char*)(gbase) + voffB[_i]), (LAS unsigned*)(lds + (bufoff) + ldsw + _i * 8192), 16, 0, 0); } while (0)
#define FG_STAGE_A(bufoff, o0, o1) do { \
        __builtin_amdgcn_global_load_lds((const unsigned*)(Abase + (o0)), (LAS unsigned*)(lds + (bufoff) + ldsw), 16, 0, 0); \
        __builtin_amdgcn_global_load_lds((const unsigned*)(Abase + (o1)), (LAS unsigned*)(lds + (bufoff) + ldsw + 8192), 16, 0, 0); } while (0)
#define FG_LD8(dst, off) do { const v4i_t lo_ = *(const LAS v4i_t*)(lds + (off)), hi_ = *(const LAS v4i_t*)(lds + (off) + 1024); dst = (v8i_t){lo_[0], lo_[1], lo_[2], lo_[3], hi_[0], hi_[1], hi_[2], hi_[3]}; } while (0)
#define FG_LDA(dst, b, h) do { _Pragma("unroll") for (int m = 0; m < 4; ++m) FG_LD8(dst[m], FG_SA(b, h) + aoff + m * 2048); } while (0)
#define FG_LDB(dst, b, h) do { _Pragma("unroll") for (int n = 0; n < 2; ++n) FG_LD8(dst[n], FG_SB(b, h) + boff + n * 2048); } while (0)
#define FG_HALF(v, k) ((k) == 0 ? __builtin_bit_cast(bf16x8, (v4i_t){(v)[0], (v)[1], (v)[2], (v)[3]}) : __builtin_bit_cast(bf16x8, (v4i_t){(v)[4], (v)[5], (v)[6], (v)[7]}))
#define FG_MMA(ai, bj, At, Bt) do { __builtin_amdgcn_s_setprio(1); \
        if constexpr (PB::FP8) { _Pragma("unroll") for (int m = 0; m < 4; ++m) _Pragma("unroll") for (int n = 0; n < 2; ++n) \
            asm volatile("v_mfma_scale_f32_16x16x128_f8f6f4 %0, %1, %2, %0, %3, %4 op_sel_hi:[0,0,0]" : "+v"(acc[ai][bj][m][n]) : "v"(Bt[n]), "v"(At[m]), "v"(sclW), "v"(sclA)); } \
        else { _Pragma("unroll") for (int m = 0; m < 4; ++m) _Pragma("unroll") for (int n = 0; n < 2; ++n) _Pragma("unroll") for (int k = 0; k < 2; ++k) \
            acc[ai][bj][m][n] = __builtin_amdgcn_mfma_f32_16x16x32_bf16(FG_HALF(Bt[n], k), FG_HALF(At[m], k), acc[ai][bj][m][n], 0, 0, 0); } \
        __builtin_amdgcn_s_setprio(0); } while (0)
#define FG_WAIT_V(n) asm volatile("s_waitcnt vmcnt(" #n ")" ::: "memory")
#define FG_WAIT_L(n) asm volatile("s_waitcnt lgkmcnt(" #n ")" ::: "memory")
#define FG_BAR __builtin_amdgcn_s_barrier()
#define FG_SCHED __builtin_amdgcn_sched_barrier(0)
    Unit cur, nxt; int ui = 0;
    if (!S.next(0, cur)) return;
    f32x4 acc[2][2][4][2];
#pragma unroll
    for (int a = 0; a < 2; ++a)
#pragma unroll
        for (int b = 0; b < 2; ++b)
#pragma unroll
            for (int m = 0; m < 4; ++m)
#pragma unroll
                for (int n = 0; n < 2; ++n) acc[a][b][m][n] = (f32x4){0.f, 0.f, 0.f, 0.f};
    v8i_t At[4], B0[2], B1[2];
    int sclW = 0x79797979, sclA = 0x7f7f7f7f;
    asm volatile("" : "+v"(sclW), "+v"(sclA));
    const char* Abase = S.a_base();
    unsigned vAc[2][2];
    FG_AOFFS(vAc, cur);
    const char* cB = S.b_base(cur);
    FG_STAGE_B(FG_SB(0, 0), cB); FG_STAGE_A(FG_SA(0, 0), vAc[0][0], vAc[0][1]); FG_STAGE_B(FG_SB(0, 1), cB + hstep); FG_STAGE_A(FG_SA(0, 1), vAc[1][0], vAc[1][1]);
    if (wr == 1) FG_BAR;
    FG_WAIT_V(4); FG_BAR;
    FG_STAGE_B(FG_SB(1, 0), cB + kstep); FG_STAGE_A(FG_SA(1, 0), vAc[0][0] + (unsigned)kstep, vAc[0][1] + (unsigned)kstep); FG_STAGE_B(FG_SB(1, 1), cB + hstep + kstep);
    FG_WAIT_V(6); FG_BAR;
    for (;;) {
        const bool has_next = S.next(ui + 1, nxt);
        const char* nB = has_next ? S.b_base(nxt) : cB;
        {
            unsigned vAn[2][2];
            if (has_next) { FG_AOFFS(vAn, nxt); }
            else {
#pragma unroll
                for (int h = 0; h < 2; ++h)
#pragma unroll
                    for (int i = 0; i < 2; ++i) vAn[h][i] = vAc[h][i];
            }
            *(LAS v4i_t*)(lds + STAGE_BYTES + 512 + tid * 16) = (v4i_t){(int)vAn[0][0], (int)vAn[0][1], (int)vAn[1][0], (int)vAn[1][1]};
        }
#pragma unroll 1
        for (int t = 0; t < nt; t += 2) {
            const bool last = (t == nt - 2);
            const unsigned k1 = (unsigned)((t + 1) * (int)kstep), k2 = last ? 0u : (unsigned)((t + 2) * (int)kstep);
            const char* b2 = last ? nB : cB + (size_t)(t + 2) * kstep; const char* b3 = b2 + kstep;
            const unsigned c10_ = vAc[1][0], c11_ = vAc[1][1];
            if (last) { const v4i_t nx_ = *(const LAS v4i_t*)(lds + STAGE_BYTES + 512 + tid * 16); vAc[0][0] = (unsigned)nx_[0]; vAc[0][1] = (unsigned)nx_[1]; vAc[1][0] = (unsigned)nx_[2]; vAc[1][1] = (unsigned)nx_[3]; }
#define FG_A2(h, i) (vAc[h][i] + k2)
            FG_LDB(B0, 0, 0); FG_SCHED; FG_LDA(At, 0, 0); FG_STAGE_A(FG_SA(1, 1), c10_ + k1, c11_ + k1);
            FG_WAIT_L(8); FG_BAR; FG_WAIT_L(0); FG_MMA(0, 0, At, B0); FG_BAR; FG_SCHED;
            FG_LDB(B1, 0, 1); FG_STAGE_B(FG_SB(0, 0), b2);
            FG_BAR; FG_WAIT_L(0); FG_MMA(0, 1, At, B1); FG_BAR;
            FG_LDA(At, 0, 1); FG_STAGE_A(FG_SA(0, 0), FG_A2(0, 0), FG_A2(0, 1));
            FG_BAR; FG_WAIT_L(0); FG_MMA(1, 0, At, B0); FG_BAR; FG_SCHED;
            FG_STAGE_B(FG_SB(0, 1), b2 + hstep);
            FG_WAIT_V(6); FG_BAR; FG_MMA(1, 1, At, B1); FG_BAR;
            FG_LDB(B0, 1, 0); FG_SCHED; FG_LDA(At, 1, 0); FG_STAGE_A(FG_SA(0, 1), FG_A2(1, 0), FG_A2(1, 1));
            FG_WAIT_L(8); FG_BAR; FG_WAIT_L(0); FG_MMA(0, 0, At, B0); FG_BAR; FG_SCHED;
            FG_LDB(B1, 1, 1); FG_STAGE_B(FG_SB(1, 0), b3);
            FG_BAR; FG_WAIT_L(0); FG_MMA(0, 1, At, B1); FG_BAR;
            FG_LDA(At, 1, 1); FG_STAGE_A(FG_SA(1, 0), FG_A2(0, 0) + (unsigned)kstep, FG_A2(0, 1) + (unsigned)kstep);
            FG_BAR; FG_WAIT_L(0); FG_MMA(1, 0, At, B0); FG_BAR; FG_SCHED;
            FG_STAGE_B(FG_SB(1, 1), b3 + hstep);
            FG_WAIT_V(6); FG_BAR; FG_MMA(1, 1, At, B1); FG_BAR;
        }
        if constexpr (PB::FP8) asm volatile("s_nop 15\n\ts_nop 15\n\ts_nop 15" ::: "memory");
        S.epilogue(acc, cur, wr, wc, fr, fq);
        if (!has_next) break;
#pragma unroll
        for (int a = 0; a < 2; ++a)
#pragma unroll
            for (int b = 0; b < 2; ++b)
#pragma unroll
                for (int m = 0; m < 4; ++m)
#pragma unroll
                    for (int n = 0; n < 2; ++n) acc[a][b][m][n] = (f32x4){0.f, 0.f, 0.f, 0.f};
        cur = nxt; cB = nB; ++ui;
    }
    FG_WAIT_V(0);
    if (wr == 0) FG_BAR;
    FG_BAR;
#undef FG_AOFFS
#undef FG_A2
#undef FG_SA
#undef FG_SB
#undef FG_STAGE_A
#undef FG_STAGE_B
#undef FG_LDA
#undef FG_LD8
#undef FG_HALF
#undef FG_LDB
#undef FG_MMA
#undef FG_WAIT_V
#undef FG_WAIT_L
#undef FG_BAR
#undef FG_SCHED
}

template <int K_, int LDA, class Epi, bool PERM_>
struct DenseProb {
    static constexpr int K = K_; static constexpr bool PERM = PERM_, FP8 = false;
    struct Unit { int pm, pn; };
    const bf16_t* A; const bf16_t* Bt; int nM, nN, nwg, G, c; Epi epi;
    __device__ __forceinline__ DenseProb(const bf16_t* A_, const bf16_t* Bt_, int N, const Epi& e) : A(A_), Bt(Bt_), nM(T / BM), nN(N / BM), nwg((T / BM) * (N / BM)), G(grid_size()), c(blockIdx.x), epi(e) {}
    __device__ __forceinline__ bool next(int i, Unit& u) const {
        const long L = (long)i * G + c; if (L >= nwg) return false;
        int wgid = (int)L; { const int q = nwg / NXCD, r = nwg % NXCD, xcd = wgid % NXCD, off = wgid / NXCD; wgid = (xcd < r ? xcd * (q + 1) : r * (q + 1) + (xcd - r) * q) + off; }
        const int nig = WGM * nN, gid = wgid / nig, fm = gid * WGM, gsz = (nM - fm) < WGM ? (nM - fm) : WGM;
        u.pm = fm + ((wgid % nig) % gsz); u.pn = (wgid % nig) / gsz; return true;
    }
    __device__ __forceinline__ const char* a_base() const { return (const char*)A; }
    __device__ __forceinline__ unsigned a_off(const Unit& u, int r) const { return (unsigned)((u.pm * BM + r) * LDA) * 2u; }
    __device__ __forceinline__ const char* b_base(const Unit& u) const { return (const char*)Bt + (size_t)u.pn * BM * K * 2; }
    __device__ __forceinline__ void epilogue(const f32x4 (&acc)[2][2][4][2], const Unit& u, int wr, int wc, int fr, int fq) const {
        const int row0 = u.pm * BM + wr * 64 + fr;
        if constexpr (PERM) {
            const int col0 = u.pn * BM + wc * 32 + 8 * fq;
#pragma unroll
            for (int ai = 0; ai < 2; ++ai)
#pragma unroll
                for (int m = 0; m < 4; ++m)
#pragma unroll
                    for (int bj = 0; bj < 2; ++bj) epi(row0 + ai * HALF + m * 16, col0 + bj * HALF, acc[ai][bj][m][0], acc[ai][bj][m][1]);
        } else {
            const int col0 = u.pn * BM + wc * 32 + 4 * fq;
#pragma unroll
            for (int ai = 0; ai < 2; ++ai)
#pragma unroll
                for (int m = 0; m < 4; ++m)
#pragma unroll
                    for (int bj = 0; bj < 2; ++bj)
#pragma unroll
                        for (int n = 0; n < 2; ++n) epi(row0 + ai * HALF + m * 16, col0 + bj * HALF + n * 16, acc[ai][bj][m][n]);
        }
    }
};
}
template <int K, int LDA, bool PERM, class Epi>
__device__ __forceinline__ void ph_gemm_fast(LAS unsigned char* lds, const bf16_t* A, const bf16_t* Bt, int N, const Epi& epi) {
    const fg::DenseProb<K, LDA, Epi, PERM> pb(A, Bt, N, epi);
    fg::gemm_phase(lds, pb);
}


namespace fg {
struct MoeUnit { int e, mblk, pn, rowoff, M; };
template <bool FIRST, bool FP8_>
struct MoeProb {
    static constexpr int K = FP8_ ? 512 : 1024  , NCOL = FIRST ? 8 : 4; static constexpr bool PERM = true, FP8 = FP8_; static constexpr unsigned RB = FP8_ ? 1024u : 2048u  ;
    typedef MoeUnit Unit;
    const Params& P; int layer; const LAS int* tab;
    int G, c; mutable int e_, acc_, off_;
    __device__ __forceinline__ MoeProb(const Params& P_, int layer_, const LAS int* tab_) : P(P_), layer(layer_), tab(tab_), G(grid_size()), c(blockIdx.x), e_(0), acc_(0), off_(0) {}
    __device__ __forceinline__ bool next(int i, Unit& u) const {
        const int j = i * (G >> 3) + (c >> 3), tile = (j / NCOL) * 8 + (c & 7);
        while (e_ < 32) { const int tl = (tab[e_] + 255) >> 8; if (tile < acc_ + tl) break; acc_ += tl; off_ += tl * 256; ++e_; }
        if (e_ >= 32) return false;
        u.e = e_; u.mblk = tile - acc_; u.pn = j % NCOL; u.rowoff = off_; u.M = tab[e_]; return true;
    }
    __device__ __forceinline__ const char* a_base() const { return FIRST ? (const char*)(P.ws + (FP8_ ? WS_YMIX : WS_HB)) : (const char*)(P.ws + WS_BIG); }
    __device__ __forceinline__ unsigned a_off(const Unit& u, int r) const {
        if (FIRST) { int rr = u.mblk * 256 + r; rr = rr < u.M ? rr : u.M - 1; const int ts = ((const int*)(P.ws + WS_LIST))[(size_t)u.e * T + rr]; return (unsigned)(ts >> 2) * RB; }
        return (unsigned)(u.rowoff + u.mblk * 256 + r) * RB;
    }
    __device__ __forceinline__ const char* b_base(const Unit& u) const {
        return FIRST ? (const char*)(P.ws + WS_W1) + ((size_t)u.e * 2048 + (size_t)u.pn * 256) * RB : (const char*)(P.ws + WS_W2) + ((size_t)u.e * 1024 + (size_t)u.pn * 256) * RB;
    }
    __device__ __forceinline__ void epilogue(const f32x4 (&acc)[2][2][4][2], const Unit& u, int wr, int wc, int fr, int fq) const {
        char* ws = P.ws; const int rl0 = u.mblk * 256 + wr * 64 + fr;
        if (FIRST) {
            const float* lrs = (const float*)(ws + WS_LRS) + (size_t)u.e * T;
            bf16_t* H = (bf16_t*)(ws + WS_BIG) + (size_t)u.rowoff * 1024;
            const int hc0 = u.pn * 128 + wc * 32 + 8 * fq;
            const float* bgp = P.moe_bg + ((size_t)layer * 32 + u.e) * 1024 + hc0; const float* bup = P.moe_bu + ((size_t)layer * 32 + u.e) * 1024 + hc0;
            const f32x4 bg0 = *(const f32x4*)bgp, bg1 = *(const f32x4*)(bgp + 4), bu0 = *(const f32x4*)bup, bu1 = *(const f32x4*)(bup + 4);
            float sc[2][4];
#pragma unroll
            for (int ai = 0; ai < 2; ++ai)
#pragma unroll
                for (int m = 0; m < 4; ++m) { const int r = rl0 + ai * HALF + m * 16; sc[ai][m] = lrs[r < u.M ? r : u.M - 1]; }
#pragma unroll
            for (int ai = 0; ai < 2; ++ai)
#pragma unroll
                for (int m = 0; m < 4; ++m) { const int r = rl0 + ai * HALF + m * 16;
                    if (r < u.M) {
                        const float s_ = sc[ai][m]; const f32x4 g0 = acc[ai][0][m][0], g1 = acc[ai][0][m][1], u0 = acc[ai][1][m][0], u1 = acc[ai][1][m][1];
                        const float h0 = swiglu_(g0[0], u0[0], s_, bg0[0], bu0[0]), h1 = swiglu_(g0[1], u0[1], s_, bg0[1], bu0[1]), h2 = swiglu_(g0[2], u0[2], s_, bg0[2], bu0[2]), h3 = swiglu_(g0[3], u0[3], s_, bg0[3], bu0[3]);
                        const float h4 = swiglu_(g1[0], u1[0], s_, bg1[0], bu1[0]), h5 = swiglu_(g1[1], u1[1], s_, bg1[1], bu1[1]), h6 = swiglu_(g1[2], u1[2], s_, bg1[2], bu1[2]), h7 = swiglu_(g1[3], u1[3], s_, bg1[3], bu1[3]);
                        if constexpr (FP8_) *(uint2*)((unsigned char*)(ws + WS_BIG) + (size_t)(u.rowoff + r) * 1024 + hc0) = make_uint2(pack4_fp8(h0, h1, h2, h3), pack4_fp8(h4, h5, h6, h7));
                        else *(u32x4_t*)(H + (size_t)r * 1024 + hc0) = (u32x4_t){pack2(h0, h1), pack2(h2, h3), pack2(h4, h5), pack2(h6, h7)};
                    } }
        } else {
            const int* list = (const int*)(ws + WS_LIST) + (size_t)u.e * T; const float* lgt = (const float*)(ws + WS_LGT) + (size_t)u.e * T;
            bf16_t* Y = (bf16_t*)(ws + WS_Y);
            const int col0 = u.pn * 256 + wc * 32 + 8 * fq;
            const float* bdp = P.moe_bd + ((size_t)layer * 32 + u.e) * 1024 + col0;
            f32x4 bd[2][2];
#pragma unroll
            for (int bj = 0; bj < 2; ++bj) { bd[bj][0] = *(const f32x4*)(bdp + bj * HALF); bd[bj][1] = *(const f32x4*)(bdp + bj * HALF + 4); }
            int tsv[2][4]; float gv[2][4];
#pragma unroll
            for (int ai = 0; ai < 2; ++ai)
#pragma unroll
                for (int m = 0; m < 4; ++m) { const int r = rl0 + ai * HALF + m * 16; const int rc = r < u.M ? r : u.M - 1; tsv[ai][m] = list[rc]; gv[ai][m] = lgt[rc]; }
#pragma unroll
            for (int ai = 0; ai < 2; ++ai)
#pragma unroll
                for (int m = 0; m < 4; ++m) { const int r = rl0 + ai * HALF + m * 16;
                    if (r < u.M) {
                        const float g = gv[ai][m]; bf16_t* yr = Y + (size_t)tsv[ai][m] * 1024 + col0;
#pragma unroll
                        for (int bj = 0; bj < 2; ++bj) { const f32x4 a = (acc[ai][bj][m][0] + bd[bj][0]) * g, b = (acc[ai][bj][m][1] + bd[bj][1]) * g;
                            *(u32x4_t*)(yr + bj * HALF) = (u32x4_t){pack2(a[0], a[1]), pack2(a[2], a[3]), pack2(b[0], b[1]), pack2(b[2], b[3])}; }
                    } }
        }
    }
};
}
template <bool FIRST, bool FP8>
__device__ __forceinline__ void ph_moe_fast(const Params& P, int layer, LAS unsigned char* lds) {
    LAS int* tab = (LAS int*)(lds + fg::STAGE_BYTES);
    const int tz = opaque_tid();
    if (tz < 32) tab[tz] = (int)((const unsigned*)(P.ws + WS_CTL))[CTL_CNT + layer * 32 + tz];
    __syncthreads();
    const fg::MoeProb<FIRST, FP8> pb(P, layer, tab);
    fg::gemm_phase(lds, pb);
}

template <class Epi>
__device__ __forceinline__ void ph_gemm_dense(const bf16_t* A, int lda, const bf16_t* Bt, int N, int K, const Epi& epi) {
    const int ncol = N / 128, nunits = (T / 256) * ncol;
    for (int u = blockIdx.x; u < nunits; u += grid_size()) gemm_simple_unit<Epi, false>(A, lda, nullptr, Bt, K, T, K, u / ncol, u % ncol, epi);
}
__device__ __forceinline__ bool moe_decode(const unsigned* cnt, int ncol, int u, int& e, int& mblk, int& nblk, int& rowoff) {
    int acc = 0, off = 0;
    for (int i = 0; i < 32; ++i) {
        const int tl = ((int)cnt[i] + 255) >> 8;
        if (u < (acc + tl) * ncol) { e = i; const int local = u - acc * ncol; mblk = local / ncol; nblk = local % ncol; rowoff = off; return true; }
        acc += tl; off += tl * 256;
    }
    return false;
}
__device__ __forceinline__ void ph_moe1(const Params& P, int layer) {
    char* ws = P.ws; const unsigned* cnt = (const unsigned*)(ws + WS_CTL) + CTL_CNT + layer * 32;
    for (int u = blockIdx.x;; u += grid_size()) {
        int e, mblk, nblk, off; if (!moe_decode(cnt, 16, u, e, mblk, nblk, off)) break;
        const int* list = (const int*)(ws + WS_LIST) + (size_t)e * T;
        EpiMoe1 ep{list, (const float*)(ws + WS_RSTD) + T, P.moe_bg + ((size_t)layer * 32 + e) * 1024, P.moe_bu + ((size_t)layer * 32 + e) * 1024, (bf16_t*)(ws + WS_BIG) + (size_t)off * 1024};
        gemm_simple_unit<EpiMoe1, true>((const bf16_t*)(ws + WS_HB), 1024, list, (const bf16_t*)(ws + WS_W1) + (size_t)e * 2048 * 1024, 1024, (int)cnt[e], 1024, mblk, nblk, ep);
    }
}
__device__ __forceinline__ void ph_moe2(const Params& P, int layer) {
    char* ws = P.ws; const unsigned* cnt = (const unsigned*)(ws + WS_CTL) + CTL_CNT + layer * 32;
    for (int u = blockIdx.x;; u += grid_size()) {
        int e, mblk, nblk, off; if (!moe_decode(cnt, 8, u, e, mblk, nblk, off)) break;
        const int* list = (const int*)(ws + WS_LIST) + (size_t)e * T;
        EpiMoe2 ep{list, (const float*)(ws + WS_TOPG), P.moe_bd + ((size_t)layer * 32 + e) * 1024, (bf16_t*)(ws + WS_Y)};
        gemm_simple_unit<EpiMoe2, false>((const bf16_t*)(ws + WS_BIG) + (size_t)off * 1024, 1024, nullptr, (const bf16_t*)(ws + WS_W2) + (size_t)e * 1024 * 1024, 1024, (int)cnt[e], 1024, mblk, nblk, ep);
    }
}

__device__ __forceinline__ void ph_attn_simple(const Params& P, unsigned char* lds) {
    float (*qs)[96] = (float (*)[96])lds; float (*ps)[64] = (float (*)[64])(lds + 8 * 96 * 4);
    const int tid = opaque_tid(), wid = tid >> 6, lane = tid & 63;
    const bf16_t* Q = (const bf16_t*)(P.ws + WS_BIG + BIG_Q); const bf16_t* Kd = (const bf16_t*)(P.ws + WS_BIG + BIG_K); const bf16_t* KV = (const bf16_t*)(P.ws + WS_BIG + BIG_KV);
    bf16_t* YM = (bf16_t*)(P.ws + WS_YMIX);
    for (int u = blockIdx.x; u < T; u += grid_size()) {
        const long gw = (long)u * 8 + wid;
        const int s = (int)(gw & 4095), bh = (int)(gw >> 12), b = bh >> 3, h = bh & 7;
        const long t = (long)b * SEQ + s;
        __syncthreads();
        qs[wid][lane] = bf2f(Q[t * 768 + h * 96 + lane]);
        if (lane < 32) qs[wid][64 + lane] = bf2f(Q[t * 768 + h * 96 + 64 + lane]);
        __syncthreads();
        float m = -INFINITY, l = 0.f, o = 0.f;
        for (int j0 = 0; j0 <= s; j0 += 64) {
            const int j = j0 + lane; const bool valid = j <= s;
            const long kt = (long)b * SEQ + (valid ? j : s);
            const uint4* kr = (const uint4*)(Kd + (kt * 8 + h) * 96);
            float sc = 0.f;
#pragma unroll
            for (int c = 0; c < 12; ++c) {
                const uint4 kk = kr[c];
                sc += qs[wid][c * 8 + 0] * bf2f(kk.x & 0xffff) + qs[wid][c * 8 + 1] * bf2f(kk.x >> 16) + qs[wid][c * 8 + 2] * bf2f(kk.y & 0xffff) + qs[wid][c * 8 + 3] * bf2f(kk.y >> 16)
                    + qs[wid][c * 8 + 4] * bf2f(kk.z & 0xffff) + qs[wid][c * 8 + 5] * bf2f(kk.z >> 16) + qs[wid][c * 8 + 6] * bf2f(kk.w & 0xffff) + qs[wid][c * 8 + 7] * bf2f(kk.w >> 16);
            }
            sc = valid ? sc : -INFINITY;
            const float mn = fmaxf(m, wave_max(sc));
            const float pj = valid ? __expf(sc - mn) : 0.f;
            const float f = __expf(m - mn);
            l = l * f + wave_sum(pj); o *= f; m = mn;
            __syncthreads();
            ps[wid][lane] = pj;
            __syncthreads();
            const bf16_t* vb = KV + ((long)b * SEQ + j0) * 1024 + h * 128 + 64 + lane;
#pragma unroll 8
            for (int jj = 0; jj < 64; ++jj) o += ps[wid][jj] * bf2f(vb[(long)jj * 1024]);
        }
        YM[t * 1024 + 256 + h * 64 + lane] = f2bf(o / l);
    }
}


namespace at {
typedef float f32x16 __attribute__((ext_vector_type(16)));
typedef short s16x4 __attribute__((ext_vector_type(4)));
constexpr int KSLOT = 12288, VSLOT = 8192, NSLOT = 3, LDS_K = 0, LDS_V = NSLOT * KSLOT, LDS_END = LDS_V + NSLOT * VSLOT;
typedef float f32x2_t __attribute__((ext_vector_type(2))); typedef __bf16 bf16x2_t __attribute__((ext_vector_type(2)));
__device__ __forceinline__ unsigned cvtpk(float lo, float hi) { const f32x2_t v = {lo, hi}; const bf16x2_t b = __builtin_convertvector(v, bf16x2_t); return __builtin_bit_cast(unsigned, b); }
__device__ __forceinline__ void glds16(const void* gsrc, unsigned lds_dst) { unsigned keep;
    asm volatile("s_mov_b32 %0, m0\n\ts_mov_b32 m0, %2\n\ts_nop 0\n\tglobal_load_lds_dwordx4 %1, off\n\ts_mov_b32 m0, %0" : "=&s"(keep) : "v"(gsrc), "s"(lds_dst) : "memory"); }
__device__ __forceinline__ s16x4 vtr(const LAS unsigned char* p) { return __builtin_bit_cast(s16x4, __builtin_amdgcn_ds_read_tr16_b64_v4i16((LAS s16x4*)p)); }
__device__ __forceinline__ float xhalf_max(float v) { auto rr = __builtin_amdgcn_permlane32_swap(__float_as_uint(v), __float_as_uint(v), false, false); return fmaxf(__uint_as_float(rr[0]), __uint_as_float(rr[1])); }
__device__ __forceinline__ float xhalf_sum(float v) { auto rr = __builtin_amdgcn_permlane32_swap(__float_as_uint(v), __float_as_uint(v), false, false); return __uint_as_float(rr[0]) + __uint_as_float(rr[1]); }

__device__ __forceinline__ void attn_unit(int b, int h, int qb, const bf16_t* Q, const bf16_t* Kd, const bf16_t* KV, bf16_t* YM, LAS unsigned char* lds) {
    const int tid = opaque_tid(); const int lane = tid & 63, r32 = lane & 31, hi = lane >> 5; const int wid = __builtin_amdgcn_readfirstlane(tid >> 6);
    const int q0 = qb * 256; const size_t row = (size_t)b * SEQ + q0 + wid * 32 + r32;
    const int NT = 4 * qb + 4;
    const char* ksrcA = (const char*)(Kd + (((size_t)b * SEQ + lane) * 8 + h) * 96) + wid * 16;
    const char* ksrcB = (const char*)(Kd + (((size_t)b * SEQ + lane) * 8 + h) * 96) + (8 + (wid & 3)) * 16;
    const char* vsrc = (const char*)(KV + ((size_t)b * SEQ + 16 * (wid & 3) + (lane >> 2)) * 1024 + h * 128 + 64 + (wid >> 2) * 32 + (lane & 3) * 8);
    const unsigned lds0 = (unsigned)(size_t)lds;
#define AT_DMA(j, slot) do { \
        glds16(ksrcA + (size_t)(j) * (64 * 1536), (unsigned)__builtin_amdgcn_readfirstlane((int)(lds0 + LDS_K + (slot) * KSLOT + wid * 1024))); \
        glds16(ksrcB + (size_t)(j) * (64 * 1536), (unsigned)__builtin_amdgcn_readfirstlane((int)(lds0 + LDS_K + (slot) * KSLOT + (8 + (wid & 3)) * 1024))); \
        glds16(vsrc + (size_t)(j) * (64 * 2048), (unsigned)__builtin_amdgcn_readfirstlane((int)(lds0 + LDS_V + (slot) * VSLOT + wid * 1024))); } while (0)
    AT_DMA(0, 0); AT_DMA(1, 1);
    bf16x8 qf[6];
#pragma unroll
    for (int ks = 0; ks < 6; ++ks) qf[ks] = *(const bf16x8*)(Q + row * 768 + h * 96 + ks * 16 + hi * 8);
    asm volatile("" : "+v"(qf[0]), "+v"(qf[1]), "+v"(qf[2]), "+v"(qf[3]), "+v"(qf[4]), "+v"(qf[5]));
    constexpr float THR = 8.0f;
    float mref = 0.f, l = 0.f;
    f32x16 o0, o1, negm;
#pragma unroll
    for (int r = 0; r < 16; ++r) { o0[r] = 0.f; o1[r] = 0.f; negm[r] = 0.f; }
    const int kfo = hi * 1024 + r32 * 16;
    const int vfo = ((lane >> 4) & 1) * 32 + (lane & 3) * 8 + (4 * hi + ((lane & 15) >> 2)) * 64;
    const int qrel = wid * 32 + r32;
    int slot = 0;
    for (int j = 0; j < NT; ++j) {
        if (j + 1 < NT) asm volatile("s_waitcnt vmcnt(3)\n\ts_barrier" ::: "memory"); else asm volatile("s_waitcnt vmcnt(0)\n\ts_barrier" ::: "memory");
        if (j + 2 < NT) { const int s2 = (slot == 0) ? 2 : slot - 1; AT_DMA(j + 2, s2); }
        const LAS unsigned char* kp = lds + LDS_K + slot * KSLOT + kfo;
        const LAS unsigned char* vp = lds + LDS_V + slot * VSLOT + vfo;
        f32x16 s0, s1;
#pragma unroll
        for (int ks = 0; ks < 6; ++ks) {
            const bf16x8 k0 = *(const LAS bf16x8*)(kp + ks * 2048), k1 = *(const LAS bf16x8*)(kp + ks * 2048 + 512);
            s0 = __builtin_amdgcn_mfma_f32_32x32x16_bf16(k0, qf[ks], ks == 0 ? negm : s0, 0, 0, 0);
            s1 = __builtin_amdgcn_mfma_f32_32x32x16_bf16(k1, qf[ks], ks == 0 ? negm : s1, 0, 0, 0);
        }
        if (j >= NT - 4) {
            const int kb = 64 * (j - (NT - 4)) + 4 * hi;
#pragma unroll
            for (int r = 0; r < 16; ++r) { const int kv = kb + (r & 3) + 8 * (r >> 2); if (kv > qrel) s0[r] = -INFINITY; if (kv + 32 > qrel) s1[r] = -INFINITY; }
        }
        float rm = fmaxf(fmaxf(s0[0], s1[0]), fmaxf(s0[1], s1[1]));
#pragma unroll
        for (int r = 2; r < 16; r += 2) rm = fmaxf(rm, fmaxf(fmaxf(s0[r], s1[r]), fmaxf(s0[r + 1], s1[r + 1])));
        rm = xhalf_max(rm);
        if (__any(rm > THR)) {
            const float dl = fmaxf(rm, 0.f);
            mref += dl;
#pragma unroll
            for (int r = 0; r < 16; ++r) { s0[r] -= dl; s1[r] -= dl; negm[r] = -mref; }
            const float f = __builtin_amdgcn_exp2f(-dl);
            l *= f;
#pragma unroll
            for (int r = 0; r < 16; ++r) { o0[r] *= f; o1[r] *= f; }
        }
        float ps0 = 0.f, ps1 = 0.f;
#pragma unroll
        for (int r = 0; r < 16; ++r) { s0[r] = __builtin_amdgcn_exp2f(s0[r]); s1[r] = __builtin_amdgcn_exp2f(s1[r]); ps0 += s0[r]; ps1 += s1[r]; }
        l += ps0 + ps1;
        bf16x8 pf[4];
        {
            unsigned w[16];
#pragma unroll
            for (int i = 0; i < 8; ++i) { w[i] = cvtpk(s0[2 * i], s0[2 * i + 1]); w[8 + i] = cvtpk(s1[2 * i], s1[2 * i + 1]); }
#pragma unroll
            for (int k = 0; k < 4; ++k) { typedef unsigned u32x4 __attribute__((ext_vector_type(4))); const u32x4 t = {w[4 * k], w[4 * k + 1], w[4 * k + 2], w[4 * k + 3]}; pf[k] = __builtin_bit_cast(bf16x8, t); }
        }
#pragma unroll
        for (int k = 0; k < 4; ++k) {
            const s16x4 a0 = vtr(vp + k * 1024), a1 = vtr(vp + k * 1024 + 512), c0 = vtr(vp + 4096 + k * 1024), c1 = vtr(vp + 4096 + k * 1024 + 512);
            const bf16x8 v0 = {a0[0], a0[1], a0[2], a0[3], a1[0], a1[1], a1[2], a1[3]}, v1 = {c0[0], c0[1], c0[2], c0[3], c1[0], c1[1], c1[2], c1[3]};
            o0 = __builtin_amdgcn_mfma_f32_32x32x16_bf16(v0, pf[k], o0, 0, 0, 0);
            o1 = __builtin_amdgcn_mfma_f32_32x32x16_bf16(v1, pf[k], o1, 0, 0, 0);
        }
        slot = (slot == 2) ? 0 : slot + 1;
    }
    l = xhalf_sum(l);
    const float rl = 1.0f / l;
    bf16_t* op = YM + row * 1024 + 256 + h * 64 + 4 * hi;
#pragma unroll
    for (int g = 0; g < 4; ++g) {
        *(uint2*)(op + 8 * g) = make_uint2(cvtpk(o0[4 * g] * rl, o0[4 * g + 1] * rl), cvtpk(o0[4 * g + 2] * rl, o0[4 * g + 3] * rl));
        *(uint2*)(op + 32 + 8 * g) = make_uint2(cvtpk(o1[4 * g] * rl, o1[4 * g + 1] * rl), cvtpk(o1[4 * g + 2] * rl, o1[4 * g + 3] * rl));
    }
    asm volatile("s_waitcnt lgkmcnt(0)\n\ts_barrier" ::: "memory");
#undef AT_DMA
}
}
__device__ __forceinline__ void ph_attn_fast(const Params& P, LAS unsigned char* lds) {
    const bf16_t* Q = (const bf16_t*)(P.ws + WS_BIG + BIG_Q); const bf16_t* Kd = (const bf16_t*)(P.ws + WS_BIG + BIG_K); const bf16_t* KV = (const bf16_t*)(P.ws + WS_BIG + BIG_KV);
    bf16_t* YM = (bf16_t*)(P.ws + WS_YMIX);
    const int G = grid_size();
    for (int v0 = (blockIdx.x % 8) * (G / 8) + blockIdx.x / 8; v0 < 256; v0 += G) {
        const int bh = v0 >> 2, s = v0 & 3;
#pragma unroll 1
        for (int i = 0; i < 4; ++i) { const int qb = (i == 0) ? s : (i == 1) ? 7 - s : (i == 2) ? 8 + s : 15 - s; at::attn_unit(bh >> 3, bh & 7, qb, Q, Kd, KV, YM, lds); }
    }
}


template <bool DRY = false> __device__ __forceinline__ void ph_gla_x(const Params& P, LAS unsigned char* lds) {
    const int tid = opaque_tid(); const int wid = __builtin_amdgcn_readfirstlane(tid >> 6), lane = tid & 63;
    LAS float* kend = (LAS float*)(lds + wid * 8192);
    const bf16_t* Z = (const bf16_t*)(P.ws + WS_BIG + BIG_Z); float* LA = (float*)(P.ws + WS_BIG + BIG_LA);
    float* UPD = DRY ? (float*)(P.ws + WS_Y + 32 * MiB) : (float*)(P.ws + WS_UPD); float* DEC = DRY ? (float*)(P.ws + WS_Y + 64 * MiB) : (float*)(P.ws + WS_DEC); float* LAW = DRY ? (float*)(P.ws + WS_Y) : LA;
    for (int u = blockIdx.x * NWV + wid; u < 2048; u += grid_size() * NWV) {
        const int bh = u >> 6, n = u & 63, b = bh >> 2, h = bh & 3;
        const size_t t0 = (size_t)b * SEQ + n * 64;
        const int k = lane & 31, half = lane >> 5;
        float c[32]; float run = 0.f;
#pragma unroll
        for (int i = 0; i < 32; ++i) { run += LA[(t0 + 32 * half + i) * 128 + h * 32 + k]; c[i] = run; }
        const float tot0 = __shfl(run, k);
        const float add = half ? tot0 : 0.f;
        const float blast = __shfl(run, 32 + k) + tot0;
#pragma unroll
        for (int i = 0; i < 32; ++i) {
            const float bc = c[i] + add; const size_t t = t0 + 32 * half + i;
            LAW[t * 128 + h * 32 + k] = bc;
            kend[(32 * half + i) * 32 + k] = bf2f(Z[t * ZW + ZC_GK + h * 32 + k]) * __expf(blast - bc);
        }
        if (half == 0) DEC[(size_t)u * 32 + k] = __expf(blast);
        asm volatile("s_waitcnt lgkmcnt(0)" ::: "memory");
        float acc[32];
#pragma unroll
        for (int i = 0; i < 32; ++i) acc[i] = 0.f;
#pragma unroll 4
        for (int j = 0; j < 64; ++j) {
            const float vj = bf2f(Z[(t0 + j) * ZW + ZC_GV + h * 64 + lane]);
#pragma unroll
            for (int kq = 0; kq < 8; ++kq) { const f32x4 ke = *(const LAS f32x4*)(kend + j * 32 + kq * 4); acc[4 * kq] += ke[0] * vj; acc[4 * kq + 1] += ke[1] * vj; acc[4 * kq + 2] += ke[2] * vj; acc[4 * kq + 3] += ke[3] * vj; }
        }
#pragma unroll
        for (int kk = 0; kk < 32; ++kk) UPD[((size_t)u * 32 + kk) * 64 + lane] = acc[kk];
        asm volatile("s_waitcnt lgkmcnt(0)" ::: "memory");
    }
}
__device__ __forceinline__ void ph_gla_scan(const Params& P) {
    const int tz = opaque_tid();
    const float* UPD = (const float*)(P.ws + WS_UPD); const float* DEC = (const float*)(P.ws + WS_DEC); bf16_t* SP = (bf16_t*)(P.ws + WS_SPREV);
    for (int e = blockIdx.x * NTHR + tz; e < 32 * 2048; e += grid_size() * NTHR) {
        const int bh = e >> 11, kv = e & 2047, k = kv >> 6;
        float st = 0.f;
#pragma unroll 8
        for (int n = 0; n < 64; ++n) {
            const size_t u = (size_t)bh * 64 + n;
            SP[u * 2048 + kv] = f2bf(st);
            st = DEC[u * 32 + k] * st + UPD[u * 2048 + kv];
        }
    }
}
__device__ __forceinline__ void ph_gla_y(const Params& P, int layer, LAS unsigned char* lds) {
    using at::f32x16; using at::s16x4; using at::vtr; using at::cvtpk;
    typedef unsigned u32x4 __attribute__((ext_vector_type(4)));
    const int tid = opaque_tid(); const int wid = __builtin_amdgcn_readfirstlane(tid >> 6), lane = tid & 63, r32 = lane & 31, hi = lane >> 5;
    LAS unsigned char* vl = lds + wid * 12288; LAS unsigned char* sl = vl + 8192;
    const bf16_t* Z = (const bf16_t*)(P.ws + WS_BIG + BIG_Z); const float* LA = (const float*)(P.ws + WS_BIG + BIG_LA); const bf16_t* SP = (const bf16_t*)(P.ws + WS_SPREV);
    bf16_t* YM = (bf16_t*)(P.ws + WS_YMIX); const float* gon = P.gla_on + layer * 64;
    const int vfo = ((lane >> 4) & 1) * 32 + (lane & 3) * 8 + (4 * hi + ((lane & 15) >> 2)) * 64;
    const int sfo = ((lane >> 4) & 1) * 32 + (lane & 3) * 8 + ((lane & 15) >> 2) * 64;
    for (int u = blockIdx.x * NWV + wid; u < 2048; u += grid_size() * NWV) {
        const int bh = u >> 6, n = u & 63, b = bh >> 2, h = bh & 3;
        const size_t t0 = (size_t)b * SEQ + n * 64;
#pragma unroll
        for (int p = 0; p < 8; ++p) {
            const int row = 8 * p + (lane >> 3), dv = 8 * (lane & 7);
            const u32x4 x = *(const u32x4*)(Z + (t0 + row) * ZW + ZC_GV + h * 64 + dv);
            *(LAS u32x4*)(vl + (dv >> 5) * 4096 + (row >> 3) * 512 + (row & 7) * 64 + (dv & 31) * 2) = x;
        }
#pragma unroll
        for (int p = 0; p < 4; ++p) {
            const int row = 8 * p + (lane >> 3), dv = 8 * (lane & 7);
            const u32x4 x = *(const u32x4*)(SP + ((size_t)u * 32 + row) * 64 + dv);
            *(LAS u32x4*)(sl + (dv >> 5) * 2048 + (row >> 3) * 512 + (row & 7) * 64 + (dv & 31) * 2) = x;
        }
        bf16x8 qfr[2][2], kfr[2][2];
#pragma unroll
        for (int blk = 0; blk < 2; ++blk)
#pragma unroll
            for (int ks = 0; ks < 2; ++ks) {
                const size_t t = t0 + 32 * blk + r32; const int k0 = 16 * ks + 8 * hi;
                const uint4 qraw = *(const uint4*)(Z + t * ZW + ZC_GQ + h * 32 + k0), kraw = *(const uint4*)(Z + t * ZW + ZC_GK + h * 32 + k0);
                const f32x4 b0 = *(const f32x4*)(LA + t * 128 + h * 32 + k0), b1 = *(const f32x4*)(LA + t * 128 + h * 32 + k0 + 4);
                const unsigned qw[4] = {qraw.x, qraw.y, qraw.z, qraw.w}, kw[4] = {kraw.x, kraw.y, kraw.z, kraw.w};
                const float bcv[8] = {b0[0], b0[1], b0[2], b0[3], b1[0], b1[1], b1[2], b1[3]};
                u32x4 qo, ko;
#pragma unroll
                for (int w = 0; w < 4; ++w) {
                    const float e0 = __expf(bcv[2 * w]), e1 = __expf(bcv[2 * w + 1]);
                    const float q0 = bf2f(qw[w] & 0xffff) * 0.17677669529663687f * e0, q1 = bf2f(qw[w] >> 16) * 0.17677669529663687f * e1;
                    const float k0f = bf2f(kw[w] & 0xffff) * __expf(-bcv[2 * w]), k1f = bf2f(kw[w] >> 16) * __expf(-bcv[2 * w + 1]);
                    qo[w] = cvtpk(q0, q1); ko[w] = cvtpk(k0f, k1f);
                }
                qfr[blk][ks] = __builtin_bit_cast(bf16x8, qo); kfr[blk][ks] = __builtin_bit_cast(bf16x8, ko);
            }
        f32x16 z16;
#pragma unroll
        for (int r = 0; r < 16; ++r) z16[r] = 0.f;
        f32x16 s00 = __builtin_amdgcn_mfma_f32_32x32x16_bf16(kfr[0][0], qfr[0][0], z16, 0, 0, 0); s00 = __builtin_amdgcn_mfma_f32_32x32x16_bf16(kfr[0][1], qfr[0][1], s00, 0, 0, 0);
        f32x16 s01 = __builtin_amdgcn_mfma_f32_32x32x16_bf16(kfr[0][0], qfr[1][0], z16, 0, 0, 0); s01 = __builtin_amdgcn_mfma_f32_32x32x16_bf16(kfr[0][1], qfr[1][1], s01, 0, 0, 0);
        f32x16 s11 = __builtin_amdgcn_mfma_f32_32x32x16_bf16(kfr[1][0], qfr[1][0], z16, 0, 0, 0); s11 = __builtin_amdgcn_mfma_f32_32x32x16_bf16(kfr[1][1], qfr[1][1], s11, 0, 0, 0);
#pragma unroll
        for (int r = 0; r < 16; ++r) { const int jl = (r & 3) + 8 * (r >> 2) + 4 * hi; if (jl > r32) { s00[r] = 0.f; s11[r] = 0.f; } }
        bf16x8 p00[2], p01[2], p11[2];
#pragma unroll
        for (int sp = 0; sp < 2; ++sp) {
            u32x4 a, c, d;
#pragma unroll
            for (int w = 0; w < 4; ++w) { a[w] = cvtpk(s00[8 * sp + 2 * w], s00[8 * sp + 2 * w + 1]); c[w] = cvtpk(s01[8 * sp + 2 * w], s01[8 * sp + 2 * w + 1]); d[w] = cvtpk(s11[8 * sp + 2 * w], s11[8 * sp + 2 * w + 1]); }
            p00[sp] = __builtin_bit_cast(bf16x8, a); p01[sp] = __builtin_bit_cast(bf16x8, c); p11[sp] = __builtin_bit_cast(bf16x8, d);
        }
        asm volatile("s_waitcnt lgkmcnt(0)" ::: "memory");
        f32x16 o[2][2];
#pragma unroll
        for (int vb = 0; vb < 2; ++vb) {
            o[vb][0] = z16; o[vb][1] = z16;
#pragma unroll
            for (int k2 = 0; k2 < 4; ++k2) {
                const s16x4 a0 = vtr(vl + vfo + vb * 4096 + k2 * 1024), a1 = vtr(vl + vfo + vb * 4096 + k2 * 1024 + 512);
                const bf16x8 vt = {a0[0], a0[1], a0[2], a0[3], a1[0], a1[1], a1[2], a1[3]};
                if (k2 < 2) { o[vb][0] = __builtin_amdgcn_mfma_f32_32x32x16_bf16(vt, p00[k2], o[vb][0], 0, 0, 0); o[vb][1] = __builtin_amdgcn_mfma_f32_32x32x16_bf16(vt, p01[k2], o[vb][1], 0, 0, 0); }
                else o[vb][1] = __builtin_amdgcn_mfma_f32_32x32x16_bf16(vt, p11[k2 - 2], o[vb][1], 0, 0, 0);
            }
#pragma unroll
            for (int ks = 0; ks < 2; ++ks) {
                const s16x4 a0 = vtr(sl + sfo + vb * 2048 + (2 * ks + hi) * 512), a1 = vtr(sl + sfo + vb * 2048 + (2 * ks + hi) * 512 + 256);
                const bf16x8 st = {a0[0], a0[1], a0[2], a0[3], a1[0], a1[1], a1[2], a1[3]};
                o[vb][0] = __builtin_amdgcn_mfma_f32_32x32x16_bf16(st, qfr[0][ks], o[vb][0], 0, 0, 0);
                o[vb][1] = __builtin_amdgcn_mfma_f32_32x32x16_bf16(st, qfr[1][ks], o[vb][1], 0, 0, 0);
            }
        }
#pragma unroll
        for (int ib = 0; ib < 2; ++ib) {
            const size_t t = t0 + 32 * ib + r32;
            float ss = 0.f;
#pragma unroll
            for (int r = 0; r < 16; ++r) ss += o[0][ib][r] * o[0][ib][r] + o[1][ib][r] * o[1][ib][r];
            ss = at::xhalf_sum(ss);
            const float rstd = rsqrtf(ss * (1.0f / 64.0f) + EPS);
#pragma unroll
            for (int vb = 0; vb < 2; ++vb)
#pragma unroll
                for (int g = 0; g < 4; ++g) {
                    const int v0 = 32 * vb + 8 * g + 4 * hi;
                    const uint2 rr = *(const uint2*)(Z + t * ZW + ZC_GR + h * 64 + v0); const f32x4 gn = *(const f32x4*)(gon + v0);
                    const float r0 = bf2f(rr.x & 0xffff), r1 = bf2f(rr.x >> 16), r2 = bf2f(rr.y & 0xffff), r3 = bf2f(rr.y >> 16);
                    const float y0 = o[vb][ib][4 * g] * rstd * gn[0] * r0 * sigmoidf_(r0), y1 = o[vb][ib][4 * g + 1] * rstd * gn[1] * r1 * sigmoidf_(r1);
                    const float y2 = o[vb][ib][4 * g + 2] * rstd * gn[2] * r2 * sigmoidf_(r2), y3 = o[vb][ib][4 * g + 3] * rstd * gn[3] * r3 * sigmoidf_(r3);
                    *(uint2*)(YM + t * 1024 + h * 64 + v0) = make_uint2(cvtpk(y0, y1), cvtpk(y2, y3));
                }
        }
        asm volatile("s_waitcnt lgkmcnt(0)" ::: "memory");
    }
}

__device__ __forceinline__ void ph_gla_simple(const Params& P, int layer, unsigned char* lds) {
    if (blockIdx.x >= 4) return;
    const int tz = opaque_tid(); const int wid = tz >> 6, lane = tz & 63;
    float (*sq)[32] = (float (*)[32])(lds + wid * 3072), (*sk)[32] = (float (*)[32])(lds + wid * 3072 + 1024), (*sa)[32] = (float (*)[32])(lds + wid * 3072 + 2048);
    const int bh = blockIdx.x * 8 + wid, b = bh >> 2, h = bh & 3;
    const bf16_t* Z = (const bf16_t*)(P.ws + WS_BIG + BIG_Z); const float* LA = (const float*)(P.ws + WS_BIG + BIG_LA); bf16_t* YM = (bf16_t*)(P.ws + WS_YMIX);
    const float g = P.gla_on[layer * 64 + lane];
    float st[32];
#pragma unroll
    for (int k = 0; k < 32; ++k) st[k] = 0.f;
    for (int c0 = 0; c0 < SEQ; c0 += 8) {
#pragma unroll
        for (int i = 0; i < 4; ++i) {
            const int idx = lane + 64 * i, sp = idx >> 5, k = idx & 31; const size_t t = (size_t)b * SEQ + c0 + sp;
            sq[sp][k] = bf2f(Z[t * ZW + ZC_GQ + h * 32 + k]) * 0.17677669529663687f;
            sk[sp][k] = bf2f(Z[t * ZW + ZC_GK + h * 32 + k]);
            sa[sp][k] = __expf(LA[t * 128 + h * 32 + k]);
        }
        float v[8], r[8];
#pragma unroll
        for (int sp = 0; sp < 8; ++sp) { const size_t t = (size_t)b * SEQ + c0 + sp; v[sp] = bf2f(Z[t * ZW + ZC_GV + h * 64 + lane]); r[sp] = bf2f(Z[t * ZW + ZC_GR + h * 64 + lane]); }
        __syncthreads();
#pragma unroll
        for (int sp = 0; sp < 8; ++sp) {
            float o = 0.f;
#pragma unroll
            for (int k = 0; k < 32; ++k) { st[k] = sa[sp][k] * st[k] + sk[sp][k] * v[sp]; o += sq[sp][k] * st[k]; }
            const float ss = wave_sum(o * o);
            const float on = o * rsqrtf(ss * (1.0f / 64.0f) + EPS) * g;
            const float rr = r[sp];
            YM[((size_t)b * SEQ + c0 + sp) * 1024 + h * 64 + lane] = f2bf(on * rr * sigmoidf_(rr));
        }
        __syncthreads();
    }
}

template <int L> __device__ __forceinline__ void layer_body(const Params& P, const XcdBarrier& bar, unsigned char* lds) {
    constexpr int l = L; char* ws = P.ws; LAS unsigned char* ldsl = (LAS unsigned char*)lds;
    const bf16_t* HB = (const bf16_t*)(ws + WS_HB); const float* RS = (const float*)(ws + WS_RSTD);
    bf16_t* Z = (bf16_t*)(ws + WS_BIG + BIG_Z);
    {
        const char* wsm = ws + WS_WSM + (size_t)l * WSM_STRIDE;
        { EpiBf16_8 e{(bf16_t*)(ws + WS_E), 1024}; ph_gemm_fast<256, 256, true>(ldsl, (const bf16_t*)(ws + WS_PB) + (size_t)l * T * 256, (const bf16_t*)(wsm + WSM_WPLE), 1024, e); }
#ifdef DBL_SHORTK
        { EpiBf16_8 e{(bf16_t*)(ws + WS_E), 1024}; ph_gemm_fast<256, 256, true>(ldsl, (const bf16_t*)(ws + WS_PB) + (size_t)l * T * 256, (const bf16_t*)(wsm + WSM_WPLE), 1024, e); }
#endif
        { EpiZ8 e{Z, RS}; ph_gemm_fast<1024, 1024, true>(ldsl, HB, (const bf16_t*)(wsm + WSM_WIN), ZW, e); }
#ifdef DBL_Z
        { EpiZ8 e{Z, RS}; ph_gemm_fast<1024, 1024, true>(ldsl, HB, (const bf16_t*)(wsm + WSM_WIN), ZW, e); }
#endif
        xcd_barrier(bar);
        ph_prepB(P, l, lds);
#ifdef DBL_PREPB
        __syncthreads(); ph_prepB(P, l, lds);
#endif
        xcd_barrier(bar);
        { EpiBf16_8 e{(bf16_t*)(ws + WS_BIG + BIG_Q), 768}; ph_gemm_fast<256, ZW, true>(ldsl, Z + ZC_CQ, (const bf16_t*)(wsm + WSM_WUQ), 768, e); }
        { EpiBf16_8 e{(bf16_t*)(ws + WS_BIG + BIG_KV), 1024}; ph_gemm_fast<128, ZW, true>(ldsl, Z + ZC_CKV, (const bf16_t*)(wsm + WSM_WUKV), 1024, e); }
#ifdef DBL_SHORTK
        { EpiBf16_8 e{(bf16_t*)(ws + WS_BIG + BIG_Q), 768}; ph_gemm_fast<256, ZW, true>(ldsl, Z + ZC_CQ, (const bf16_t*)(wsm + WSM_WUQ), 768, e); }
        { EpiBf16_8 e{(bf16_t*)(ws + WS_BIG + BIG_KV), 1024}; ph_gemm_fast<128, ZW, true>(ldsl, Z + ZC_CKV, (const bf16_t*)(wsm + WSM_WUKV), 1024, e); }
#endif
        __syncthreads();
        ph_gla_x(P, ldsl);
#ifdef DBL_GLAX
        ph_gla_x<true>(P, ldsl);
#endif
        xcd_barrier(bar);
        ph_prepD(P, l);
#ifdef DBL_PREPD
        ph_prepD<true>(P, l);
#endif
        ph_gla_scan(P);
#ifdef DBL_SCAN
        ph_gla_scan(P);
#endif
        xcd_barrier(bar);
        if ((blockIdx.x >> 3) & 1) { ph_tconv_exp<(L == 0 ? MOE_FP8_L0 : MOE_FP8_L1)>(P, l, ldsl); }
        ph_attn_fast(P, ldsl);
#ifdef DBL_ATTN
        ph_attn_fast(P, ldsl);
#endif
        ph_gla_y(P, l, ldsl);
        if (!((blockIdx.x >> 3) & 1)) { __syncthreads(); ph_tconv_exp<(L == 0 ? MOE_FP8_L0 : MOE_FP8_L1)>(P, l, ldsl); }
#ifdef DBL_GLAY
        ph_gla_y(P, l, ldsl);
#endif
        xcd_barrier(bar);
        { EpiResid8 e{l == 0 ? P.x : nullptr, (bf16_t*)(ws + WS_HB)}; ph_gemm_fast<1024, 1024, true>(ldsl, (const bf16_t*)(ws + WS_YMIX), (const bf16_t*)(wsm + WSM_WOUT), 1024, e); }
        xcd_barrier(bar);
        ph_router<(L == 0 ? MOE_FP8_L0 : MOE_FP8_L1)>(P, l, ldsl);
        xcd_barrier(bar);
        ph_moe_fast<true, (L == 0 ? MOE_FP8_L0 : MOE_FP8_L1)>(P, l, ldsl);
#ifdef DBL_MOE1
        __syncthreads(); ph_moe_fast<true, (L == 0 ? MOE_FP8_L0 : MOE_FP8_L1)>(P, l, ldsl);
#endif
        xcd_barrier(bar);
        ph_moe_fast<false, (L == 0 ? MOE_FP8_L0 : MOE_FP8_L1)>(P, l, ldsl);
#ifdef DBL_MOE2
        __syncthreads(); ph_moe_fast<false, (L == 0 ? MOE_FP8_L0 : MOE_FP8_L1)>(P, l, ldsl);
#endif
        xcd_barrier(bar);
        ph_combine(P);
#ifdef DBL_COMBINE
        ph_combine<true>(P);
#endif
        xcd_barrier(bar);
        { EpiPle8 e{(const bf16_t*)(ws + WS_E), RS + 2 * T, (bf16_t*)(ws + WS_YMIX)}; ph_gemm_fast<1024, 1024, true>(ldsl, HB, (const bf16_t*)(wsm + WSM_WPG), 1024, e); }
#ifdef DBL_PLE
        { EpiPle8 e{(const bf16_t*)(ws + WS_E), RS + 2 * T, (bf16_t*)(ws + WS_YMIX)}; ph_gemm_fast<1024, 1024, true>(ldsl, HB, (const bf16_t*)(wsm + WSM_WPG), 1024, e); }
#endif
        xcd_barrier(bar);
        ph_final(P, l);
#ifdef DBL_FINAL
        ph_final<true>(P, l);
#endif
        xcd_barrier(bar);
    }
}

__global__ void __launch_bounds__(NTHR, 2) mega_fwd(Params P) {
    extern __shared__ __attribute__((aligned(16))) unsigned char lds[];
    char* ws = P.ws;
    if (threadIdx.x == 0) *(uint4*)(lds + LDS_BAR_OFF) = make_uint4(0u, 0u, (unsigned)P.grid, 0u);
    if ((threadIdx.x & 63) == 0) *(volatile LAS int*)((LAS unsigned char*)lds + LDS_WID_OFF + hw_wave_key() * 4) = (int)(threadIdx.x >> 6);
    __syncthreads();
    const XcdBarrier bar = xcd_barrier_post((unsigned*)(ws + WS_CTL), (volatile LAS unsigned*)(lds + LDS_BAR_OFF));
    const bf16_t* HB = (const bf16_t*)(ws + WS_HB); const float* RS = (const float*)(ws + WS_RSTD);
    bf16_t* Z = (bf16_t*)(ws + WS_BIG + BIG_Z);
    for (int l = 0; l < DEPTH; ++l) {
        char* wsm = ws + WS_WSM + (size_t)l * WSM_STRIDE;
        ph_tconv(P.w_in + (size_t)l * 1024 * 1456, nullptr, P.mix_norm + l * 1024, (bf16_t*)(wsm + WSM_WIN), ZW, 1024, 1456, 1, 1, 0, 0, lds);
        ph_tconv(P.w_uq + (size_t)l * 256 * 768, nullptr, P.q_norm + l * 256, (bf16_t*)(wsm + WSM_WUQ), 768, 256, 768, 0, 1, 0, 0, lds);
        ph_tconv(P.w_ukv + (size_t)l * 128 * 1024, nullptr, P.kv_norm + l * 128, (bf16_t*)(wsm + WSM_WUKV), 1024, 128, 1024, 0, 1, 0, 0, lds);
        ph_tconv(P.w_out + (size_t)l * 1024 * 1024, nullptr, nullptr, (bf16_t*)(wsm + WSM_WOUT), 1024, 1024, 1024, 0, 1, 0, 0, lds);
        ph_tconv(P.ple_wg + (size_t)l * 1024 * 1024, nullptr, P.ple_gn + l * 1024, (bf16_t*)(wsm + WSM_WPG), 1024, 1024, 1024, 0, 1, 0, 0, lds);
        ph_tconv(P.ple_wp + (size_t)l * 256 * 1024, nullptr, nullptr, (bf16_t*)(wsm + WSM_WPLE), 1024, 256, 1024, 0, 1, 0, 0, lds);
    }
    ph_conv_bf16(P.p, (bf16_t*)(ws + WS_PB), (long)2 * T * 256 / 8);
    ph_prep_router(P);
    ph_init_h(P);
    ph_rope_table(P);
#ifdef DBL_P0
    __syncthreads();
    for (int l = 0; l < DEPTH; ++l) {
        char* wsm = ws + WS_WSM + (size_t)l * WSM_STRIDE;
        ph_tconv(P.w_in + (size_t)l * 1024 * 1456, nullptr, P.mix_norm + l * 1024, (bf16_t*)(wsm + WSM_WIN), ZW, 1024, 1456, 1, 1, 0, 0, lds);
        ph_tconv(P.w_uq + (size_t)l * 256 * 768, nullptr, P.q_norm + l * 256, (bf16_t*)(wsm + WSM_WUQ), 768, 256, 768, 0, 1, 0, 0, lds);
        ph_tconv(P.w_ukv + (size_t)l * 128 * 1024, nullptr, P.kv_norm + l * 128, (bf16_t*)(wsm + WSM_WUKV), 1024, 128, 1024, 0, 1, 0, 0, lds);
        ph_tconv(P.w_out + (size_t)l * 1024 * 1024, nullptr, nullptr, (bf16_t*)(wsm + WSM_WOUT), 1024, 1024, 1024, 0, 1, 0, 0, lds);
        ph_tconv(P.ple_wg + (size_t)l * 1024 * 1024, nullptr, P.ple_gn + l * 1024, (bf16_t*)(wsm + WSM_WPG), 1024, 1024, 1024, 0, 1, 0, 0, lds);
        ph_tconv(P.ple_wp + (size_t)l * 256 * 1024, nullptr, nullptr, (bf16_t*)(wsm + WSM_WPLE), 1024, 256, 1024, 0, 1, 0, 0, lds);
    }
    ph_conv_bf16(P.p, (bf16_t*)(ws + WS_PB), (long)2 * T * 256 / 8);
    ph_prep_router(P);
    ph_init_h(P);
    ph_rope_table(P);
#endif
    xcd_barrier(bar);
    layer_body<0>(P, bar, lds);
    layer_body<1>(P, bar, lds);
}

extern "C" void kernel_launch(void* const* d_in, const int* in_sizes, int n_in, void* d_out, int out_size, void* d_ws, size_t ws_size, hipStream_t stream) {
    if (n_in != 30 || ws_size < WS_END) { fprintf(stderr, "kernel_launch: need 30 inputs and %zu bytes of workspace (got %d, %zu)\n", (size_t)WS_END, n_in, ws_size); return; }
    static int grid = 0;
    if (!grid) {
        int dev = 0, cus = 0, per_cu = 0;
        if (hipGetDevice(&dev) != hipSuccess || hipDeviceGetAttribute(&cus, hipDeviceAttributeMultiprocessorCount, dev) != hipSuccess) { fprintf(stderr, "kernel_launch: device query failed\n"); return; }
        if (hipFuncSetAttribute((const void*)mega_fwd, hipFuncAttributeMaxDynamicSharedMemorySize, LDS_BYTES) != hipSuccess) { fprintf(stderr, "kernel_launch: hipFuncSetAttribute failed\n"); return; }
        if (hipOccupancyMaxActiveBlocksPerMultiprocessor(&per_cu, (const void*)mega_fwd, NTHR, LDS_BYTES) != hipSuccess || per_cu < 1) { fprintf(stderr, "kernel_launch: occupancy query says %d\n", per_cu); return; }
        grid = cus;
    }
    Params P{};
    P.x = (const float*)d_in[0]; P.p = (const float*)d_in[1]; P.pos = (const int*)d_in[2];
    P.mix_norm = (const float*)d_in[3]; P.w_in = (const float*)d_in[4]; P.gla_wg = (const float*)d_in[5]; P.gla_bg = (const float*)d_in[6]; P.gla_on = (const float*)d_in[7];
    P.q_norm = (const float*)d_in[8]; P.w_uq = (const float*)d_in[9]; P.kv_norm = (const float*)d_in[10]; P.w_ukv = (const float*)d_in[11]; P.qkq = (const float*)d_in[12]; P.qkk = (const float*)d_in[13];
    P.pool_w = (const float*)d_in[14]; P.pool_s = (const float*)d_in[15]; P.w_out = (const float*)d_in[16]; P.ffn_norm = (const float*)d_in[17]; P.router_w = (const float*)d_in[18]; P.router_b = (const float*)d_in[19];
    P.moe_wg = (const float*)d_in[20]; P.moe_bg = (const float*)d_in[21]; P.moe_wu = (const float*)d_in[22]; P.moe_bu = (const float*)d_in[23]; P.moe_wd = (const float*)d_in[24]; P.moe_bd = (const float*)d_in[25];
    P.ple_wp = (const float*)d_in[26]; P.ple_gn = (const float*)d_in[27]; P.ple_wg = (const float*)d_in[28]; P.ple_pn = (const float*)d_in[29];
    P.out = (float*)d_out; P.ws = (char*)d_ws; P.grid = grid; P.pad_ = 0;
    (void)hipMemsetAsync((char*)d_ws + WS_CTL, 0, 65536, stream);
    hipLaunchKernelGGL(mega_fwd, dim3(grid), dim3(NTHR), LDS_BYTES, stream, P);
}
```

```cpp
#include <hip/hip_runtime.h>
#include <cstdio>
#include <cstdint>

typedef unsigned short bf16_t;
typedef short bf16x8 __attribute__((ext_vector_type(8)));
typedef float f32x4 __attribute__((ext_vector_type(4)));

constexpr int T = 32768, DM = 1024, SEQ = 4096, NBATCH = 8, DEPTH = 2;
constexpr int ZW = 1536;
constexpr int ZC_CQ = 0, ZC_GV = 256, ZC_GR = 512, ZC_UP = 768, ZC_GQ = 1024, ZC_GK = 1152, ZC_CKV = 1280, ZC_KR = 1408, ZC_GLOW = 1440;
constexpr int NE = 32, TOPK = 4, DFF = 1024;
constexpr int HROWS = 139264;
constexpr float EPS = 1e-6f;

__host__ __device__ inline int zsrc(int n) {
    if (n < 256) return 784 + n;
    if (n < 512) return 256 + (n - 256);
    if (n < 768) return 528 + (n - 512);
    if (n < 1024) return 1200 + (n - 768);
    if (n < 1152) return n - 1024;
    if (n < 1280) return 128 + (n - 1152);
    if (n < 1408) return 1040 + (n - 1280);
    if (n < 1440) return 1168 + (n - 1408);
    if (n < 1456) return 512 + (n - 1440);
    return -1;
}

constexpr size_t MiB = 1024 * 1024;
constexpr size_t WS_CTL = 0;
constexpr size_t WS_HB = 1 * MiB;
constexpr size_t WS_RSTD = WS_HB + 64 * MiB;
constexpr size_t WS_WSM = WS_RSTD + 1 * MiB;
constexpr size_t WSM_WIN = 0, WSM_WUQ = 3 * MiB, WSM_WUKV = WSM_WUQ + 384 * 1024, WSM_WOUT = WSM_WUKV + 256 * 1024, WSM_WPG = WSM_WOUT + 2 * MiB,
                 WSM_WPLE = WSM_WPG + 2 * MiB, WSM_WR = WSM_WPLE + 512 * 1024, WSM_WPT = WSM_WR + 128 * 1024, WSM_STRIDE = WSM_WR + 128 * 1024 + 128 * 1024;
constexpr size_t WS_PB = WS_WSM + 2 * WSM_STRIDE;
constexpr size_t WS_W1 = WS_PB + 32 * MiB;
constexpr size_t WS_W2 = WS_W1 + 128 * MiB;
constexpr size_t WS_E = WS_W2 + 64 * MiB;
constexpr size_t WS_YMIX = WS_E + 64 * MiB;
constexpr size_t WS_Y = WS_YMIX + 64 * MiB;
constexpr size_t WS_UPD = WS_Y + 256 * MiB;
constexpr size_t WS_DEC = WS_UPD + 16 * MiB;
constexpr size_t WS_SPREV = WS_DEC + 1 * MiB;
constexpr size_t WS_TOPG = WS_SPREV + 8 * MiB;
constexpr size_t WS_LIST = WS_TOPG + 1 * MiB;
constexpr size_t WS_BIG = WS_LIST + 4 * MiB;
constexpr size_t BIG_Z = 0, BIG_Q = 96 * MiB, BIG_KV = BIG_Q + 48 * MiB, BIG_K = BIG_KV + 64 * MiB, BIG_LA = BIG_K + 48 * MiB;
constexpr size_t WS_ROPE = WS_BIG + 272 * MiB;
constexpr size_t WS_LRS = WS_ROPE + 4 * MiB;
constexpr size_t WS_LGT = WS_LRS + 4 * MiB;
constexpr size_t WS_END = WS_LGT + 4 * MiB;
constexpr int CTL_CNT = 4096;

constexpr bool MOE_FP8_L0 = true, MOE_FP8_L1 = true;
__device__ __forceinline__ float bf2f(bf16_t v) { return __uint_as_float(((unsigned)v) << 16); }
__device__ __forceinline__ bf16_t f2bf(float f) { unsigned u = __float_as_uint(f); u += 0x7FFFu + ((u >> 16) & 1u); return (bf16_t)(u >> 16); }
__device__ __forceinline__ unsigned pack2(float lo, float hi) { return (unsigned)f2bf(lo) | ((unsigned)f2bf(hi) << 16); }
template <int CTRL> __device__ __forceinline__ float dppx(float v) { return __int_as_float(__builtin_amdgcn_update_dpp(0, __float_as_int(v), CTRL, 0xf, 0xf, true)); }
__device__ __forceinline__ unsigned pack4_fp8(float x0, float x1, float x2, float x3) { int w = 0; w = __builtin_amdgcn_cvt_pk_fp8_f32(x0, x1, w, false); w = __builtin_amdgcn_cvt_pk_fp8_f32(x2, x3, w, true); return (unsigned)w; }
__device__ __forceinline__ float wave_sum(float v) {
    v += dppx<0xB1>(v); v += dppx<0x4E>(v); v += dppx<0x141>(v); v += dppx<0x140>(v);
    { auto rr = __builtin_amdgcn_permlane16_swap(__float_as_uint(v), __float_as_uint(v), false, false); v = __uint_as_float(rr[0]) + __uint_as_float(rr[1]); }
    { auto rr = __builtin_amdgcn_permlane32_swap(__float_as_uint(v), __float_as_uint(v), false, false); v = __uint_as_float(rr[0]) + __uint_as_float(rr[1]); }
    return v;
}
__device__ __forceinline__ float wave_max(float v) {
    v = fmaxf(v, dppx<0xB1>(v)); v = fmaxf(v, dppx<0x4E>(v)); v = fmaxf(v, dppx<0x141>(v)); v = fmaxf(v, dppx<0x140>(v));
    { auto rr = __builtin_amdgcn_permlane16_swap(__float_as_uint(v), __float_as_uint(v), false, false); v = fmaxf(__uint_as_float(rr[0]), __uint_as_float(rr[1])); }
    { auto rr = __builtin_amdgcn_permlane32_swap(__float_as_uint(v), __float_as_uint(v), false, false); v = fmaxf(__uint_as_float(rr[0]), __uint_as_float(rr[1])); }
    return v;
}
namespace at {
typedef float f32x16 __attribute__((ext_vector_type(16)));
__device__ __forceinline__ float xhalf_max(float v) { auto rr = __builtin_amdgcn_permlane32_swap(__float_as_uint(v), __float_as_uint(v), false, false); return fmaxf(__uint_as_float(rr[0]), __uint_as_float(rr[1])); }
__device__ __forceinline__ float xhalf_sum(float v) { auto rr = __builtin_amdgcn_permlane32_swap(__float_as_uint(v), __float_as_uint(v), false, false); return __uint_as_float(rr[0]) + __uint_as_float(rr[1]); }
}
__device__ __forceinline__ float sigmoidf_(float x) { return __builtin_amdgcn_rcpf(1.0f + __builtin_amdgcn_exp2f(-1.4426950408889634f * x)); }


#define XB_TMO      128
#define XB_XCNT(j)  (256  + 64 * (j))
#define XB_XSUB(j)  (1280 + 64 * (j))
#define XB_XGEN(j)  (2304 + 64 * (j))
#define XB_TOP      3328
#define XB_TOPGEN   3392
#define XCD_BAR_WORDS 3456
#define XB_SPIN_CAP (1u << 18)
#define LAS __attribute__((address_space(3)))

constexpr int LDS_WID_OFF = 147456 - 16 - 256, LDS_GRID_OFF = 147456 - 16 + 8;
__device__ __forceinline__ int grid_size() { extern __shared__ __attribute__((aligned(16))) unsigned char lds_dyn_[]; return __builtin_amdgcn_readfirstlane(*(const volatile LAS int*)((LAS unsigned char*)lds_dyn_ + LDS_GRID_OFF)); }
__device__ __forceinline__ unsigned hw_wave_key() { return (unsigned)__builtin_amdgcn_s_getreg((5 << 11) | 4) & 63u; }
__device__ __forceinline__ int opaque_tid() {
    extern __shared__ __attribute__((aligned(16))) unsigned char lds_dyn_[];
    const int wv = __builtin_amdgcn_readfirstlane(*(const volatile LAS int*)((LAS unsigned char*)lds_dyn_ + LDS_WID_OFF + hw_wave_key() * 4));
    int ln; asm volatile("v_mbcnt_lo_u32_b32 %0, -1, 0\n\tv_mbcnt_hi_u32_b32 %0, -1, %0" : "=v"(ln));
    int t = wv * 64 + ln;
    asm volatile("" : "+v"(t)); return t;
}

__device__ __forceinline__ unsigned xb_ld(unsigned* p)              { return __hip_atomic_load(p, __ATOMIC_RELAXED, __HIP_MEMORY_SCOPE_AGENT); }
__device__ __forceinline__ unsigned xb_add(unsigned* p, unsigned v) { return __hip_atomic_fetch_add(p, v, __ATOMIC_RELAXED, __HIP_MEMORY_SCOPE_AGENT); }
__device__ __forceinline__ unsigned xb_xcc_id() { return (unsigned)__builtin_amdgcn_s_getreg((3 << 11) | 20) & 0xFu; }
#define XB_SPIN(cond, bar) do { unsigned _sp = 0; while (cond) { __builtin_amdgcn_s_sleep(1); \
    if ((++_sp & 255u) == 0u) { if (xb_ld(&(bar)[XB_TMO])) break; if (_sp > XB_SPIN_CAP) { atomicAdd(&(bar)[XB_TMO], 1u); break; } } } } while (0)

struct XcdBarrier {
    unsigned* bar; unsigned x;
    volatile LAS unsigned* st;
};

__device__ __forceinline__ XcdBarrier xcd_barrier_post(unsigned* bar, volatile LAS unsigned* st) {
    XcdBarrier b; b.bar = bar; b.x = xb_xcc_id(); b.st = st;
    if (threadIdx.x == 0) (void)xb_add(&bar[XB_XCNT(b.x)], 1u);
    return b;
}
__device__ __forceinline__ void xcd_barrier_complete(unsigned* bar, unsigned x, unsigned& nloc, unsigned& nx) {
    const unsigned G = (unsigned)grid_size();
    unsigned sum, cnt, mine, sp = 0u;
    for (;;) {
        sum = 0u; cnt = 0u; mine = 0u;
#pragma unroll
        for (unsigned j = 0; j < 16; ++j) { const unsigned c = xb_ld(&bar[XB_XCNT(j)]); sum += c; cnt += (c > 0u) ? 1u : 0u; mine = (j == x) ? c : mine; }
        if (sum == G) break;
        __builtin_amdgcn_s_sleep(1);
        if ((++sp & 255u) == 0u) { if (xb_ld(&bar[XB_TMO])) break; if (sp > XB_SPIN_CAP) { atomicAdd(&bar[XB_TMO], 1u); break; } }
    }
    nloc = mine > 0u ? mine : 1u; nx = cnt > 0u ? cnt : 1u;
}

__device__ __forceinline__ void xcd_barrier1(const XcdBarrier& b) {
    asm volatile("s_waitcnt vmcnt(0)" ::: "memory");
    __syncthreads();
    if (opaque_tid() == 0) {
        unsigned* bar = b.bar;
        __builtin_amdgcn_s_waitcnt(0);
        unsigned nloc = b.st[0], nx = b.st[1];
        if (nloc == 0u) { xcd_barrier_complete(bar, b.x, nloc, nx); b.st[0] = nloc; b.st[1] = nx; }
        const unsigned old = xb_add(&bar[XB_XSUB(b.x)], 1u);
        const unsigned gen = old / nloc;
        if (old + 1u == (gen + 1u) * nloc) {
            __builtin_amdgcn_fence(__ATOMIC_RELEASE, "agent");
            asm volatile("s_waitcnt vmcnt(0)" ::: "memory");
            const unsigned og = xb_add(&bar[XB_TOP], 1u);
            const unsigned tg = og / nx;
            if (og + 1u == (tg + 1u) * nx) xb_add(&bar[XB_TOPGEN], 1u);
            else XB_SPIN(xb_ld(&bar[XB_TOPGEN]) == tg, bar);
            __builtin_amdgcn_fence(__ATOMIC_ACQUIRE, "agent");
            xb_add(&bar[XB_XGEN(b.x)], 1u);
            asm volatile("s_waitcnt vmcnt(0)" ::: "memory");
        } else {
            XB_SPIN(xb_ld(&bar[XB_XGEN(b.x)]) == gen, bar);
            __builtin_amdgcn_fence(__ATOMIC_ACQUIRE, "agent");
            asm volatile("s_waitcnt vmcnt(0)" ::: "memory");
        }
    }
    __syncthreads();
}

struct Params {
    const float *x, *p; const int* pos;
    const float *mix_norm, *w_in, *gla_wg, *gla_bg, *gla_on, *q_norm, *w_uq, *kv_norm, *w_ukv, *qkq, *qkk, *pool_w, *pool_s, *w_out, *ffn_norm, *router_w, *router_b,
        *moe_wg, *moe_bg, *moe_wu, *moe_bu, *moe_wd, *moe_bd, *ple_wp, *ple_gn, *ple_wg, *ple_pn;
    float* out; char* ws; int grid; int pad_;
};


#ifdef DBL_BAR
__device__ __forceinline__ void xcd_barrier(const XcdBarrier& b) { xcd_barrier1(b); xcd_barrier1(b); }
#else
__device__ __forceinline__ void xcd_barrier(const XcdBarrier& b) { xcd_barrier1(b); }
#endif
constexpr int NTHR = 512, NWV = 8;

constexpr int LDS_BYTES = 147456;
constexpr int LDS_BAR_OFF = LDS_BYTES - 16;

__device__ __forceinline__ void ph_tconv(const float* src, const float* src2, const float* gain, bf16_t* dst, int N, int K, int ld_src, int mode, int nexp, long se, long de, unsigned char* lds) {
    const int tz = opaque_tid(); const int tid = tz & 255, half = tz >> 8, tx = tid & 63, ty = tid >> 6;
    float (*tile)[65] = (float (*)[65])(lds + half * 16640);
    const int nx = N / 64, ny = K / 64, nunits = nx * ny * nexp;
    for (int u0 = blockIdx.x * 2; u0 < nunits; u0 += grid_size() * 2) {
        const int u = u0 + half; const int bx = u % nx, by = (u / nx) % ny, e = u / (nx * ny);
        const float* s1 = src + (long)e * se; const float* s2 = src2 ? src2 + (long)e * se : nullptr; bf16_t* d = dst + (long)e * de;
        const int n0 = bx * 64, k0 = by * 64, n = n0 + tx;
        const float* sp = s1; int col;
        if (mode == 0) col = n;
        else if (mode == 1) col = zsrc(n);
        else { const int tl = n >> 8, w = n & 255; if (w < 128) col = tl * 128 + w; else { col = tl * 128 + (w - 128); sp = s2; } }
#pragma unroll
        for (int i = 0; i < 16; ++i) {
            const int k = k0 + ty + 4 * i; float v = 0.f;
            if (col >= 0) v = sp[(long)k * ld_src + col];
            if (gain) v *= gain[k];
            tile[ty + 4 * i][tx] = v;
        }
        __syncthreads();
        const int nl = tid >> 2, ks = (tid & 3) * 16;
        unsigned w0 = pack2(tile[ks + 0][nl], tile[ks + 1][nl]), w1 = pack2(tile[ks + 2][nl], tile[ks + 3][nl]), w2 = pack2(tile[ks + 4][nl], tile[ks + 5][nl]), w3 = pack2(tile[ks + 6][nl], tile[ks + 7][nl]);
        unsigned w4 = pack2(tile[ks + 8][nl], tile[ks + 9][nl]), w5 = pack2(tile[ks + 10][nl], tile[ks + 11][nl]), w6 = pack2(tile[ks + 12][nl], tile[ks + 13][nl]), w7 = pack2(tile[ks + 14][nl], tile[ks + 15][nl]);
        uint4* o = (uint4*)(d + (long)(n0 + nl) * K + k0 + ks);
        o[0] = make_uint4(w0, w1, w2, w3); o[1] = make_uint4(w4, w5, w6, w7);
        __syncthreads();
    }
}


__device__ __forceinline__ void ph_tconv_small(const Params& P, unsigned char* lds) {
    const int tz = opaque_tid(); const int tid = tz & 255, half = tz >> 8, tx = tid & 63, ty = tid >> 6;
    float (*tile)[65] = (float (*)[65])(lds + half * 16640);
    constexpr int U_IN = 24 * 16, U_UQ = 12 * 4, U_KV = 16 * 2, U_OUT = 16 * 16, U_PG = 16 * 16, U_PP = 16 * 4, U_L = U_IN + U_UQ + U_KV + U_OUT + U_PG + U_PP;
    static_assert((2 * U_L) % 2 == 0, "pairs of units");
    for (int u0 = blockIdx.x * 2; u0 < 2 * U_L; u0 += grid_size() * 2) {
        const int u = u0 + half; const int l = u / U_L; int r = u % U_L;
        char* wsm = P.ws + WS_WSM + (size_t)l * WSM_STRIDE;
        const float* src; const float* gain; bf16_t* dst; int N, K, ld, mode;
        if (r < U_IN) { src = P.w_in + (size_t)l * 1024 * 1456; gain = P.mix_norm + l * 1024; dst = (bf16_t*)(wsm + WSM_WIN); N = ZW; K = 1024; ld = 1456; mode = 1; }
        else if ((r -= U_IN) < U_UQ) { src = P.w_uq + (size_t)l * 256 * 768; gain = P.q_norm + l * 256; dst = (bf16_t*)(wsm + WSM_WUQ); N = 768; K = 256; ld = 768; mode = 0; }
        else if ((r -= U_UQ) < U_KV) { src = P.w_ukv + (size_t)l * 128 * 1024; gain = P.kv_norm + l * 128; dst = (bf16_t*)(wsm + WSM_WUKV); N = 1024; K = 128; ld = 1024; mode = 0; }
        else if ((r -= U_KV) < U_OUT) { src = P.w_out + (size_t)l * 1024 * 1024; gain = nullptr; dst = (bf16_t*)(wsm + WSM_WOUT); N = 1024; K = 1024; ld = 1024; mode = 0; }
        else if ((r -= U_OUT) < U_PG) { src = P.ple_wg + (size_t)l * 1024 * 1024; gain = P.ple_gn + l * 1024; dst = (bf16_t*)(wsm + WSM_WPG); N = 1024; K = 1024; ld = 1024; mode = 0; }
        else { r -= U_PG; src = P.ple_wp + (size_t)l * 256 * 1024; gain = nullptr; dst = (bf16_t*)(wsm + WSM_WPLE); N = 1024; K = 256; ld = 1024; mode = 0; }
        const int nx = N / 64; const int bx = r % nx, by = r / nx;
        const int n0 = bx * 64, k0 = by * 64, n = n0 + tx;
        const int col = (mode == 1) ? zsrc(n) : n;
#pragma unroll
        for (int i = 0; i < 16; ++i) {
            const int k = k0 + ty + 4 * i; float v = 0.f;
            if (col >= 0) v = src[(long)k * ld + col];
            if (gain) v *= gain[k];
            tile[ty + 4 * i][tx] = v;
        }
        __syncthreads();
        const int nl = tid >> 2, ks = (tid & 3) * 16;
        unsigned w0 = pack2(tile[ks + 0][nl], tile[ks + 1][nl]), w1 = pack2(tile[ks + 2][nl], tile[ks + 3][nl]), w2 = pack2(tile[ks + 4][nl], tile[ks + 5][nl]), w3 = pack2(tile[ks + 6][nl], tile[ks + 7][nl]);
        unsigned w4 = pack2(tile[ks + 8][nl], tile[ks + 9][nl]), w5 = pack2(tile[ks + 10][nl], tile[ks + 11][nl]), w6 = pack2(tile[ks + 12][nl], tile[ks + 13][nl]), w7 = pack2(tile[ks + 14][nl], tile[ks + 15][nl]);
        uint4* o = (uint4*)(dst + (long)(n0 + nl) * K + k0 + ks);
        o[0] = make_uint4(w0, w1, w2, w3); o[1] = make_uint4(w4, w5, w6, w7);
        __syncthreads();
    }
}

template <bool FP8> __device__ __forceinline__ void ph_tconv_exp(const Params& P, int layer, LAS unsigned char* lds) {
    const int tid = opaque_tid();
    const int kq = tid >> 6, c4 = tid & 63;
    constexpr int PITCH = FP8 ? 68 : 136;
    LAS unsigned char* tile = lds;
    const float* gain = P.ffn_norm + layer * 1024;
    const int nunits = 3 * 32 * 16 * 4;
    for (int u = blockIdx.x; u < nunits; u += grid_size()) {
        const int nt = u & 3, kt = (u >> 2) & 15, e = (u >> 6) & 31, mat = u >> 11;
        const float* src = (mat == 0 ? P.moe_wg : mat == 1 ? P.moe_wu : P.moe_wd) + ((size_t)layer * 32 + e) * 1024 * 1024 + (size_t)(kt * 64) * 1024 + nt * 256 + c4 * 4;
        f32x4 v[2][4];
#pragma unroll
        for (int g = 0; g < 2; ++g)
#pragma unroll
            for (int r = 0; r < 4; ++r) v[g][r] = *(const f32x4*)(src + (size_t)(32 * g + 4 * kq + r) * 1024);
        const float sc = FP8 ? 64.0f : 1.0f;
#pragma unroll
        for (int g = 0; g < 2; ++g)
#pragma unroll
            for (int r = 0; r < 4; ++r) v[g][r] *= (mat < 2 ? gain[kt * 64 + 32 * g + 4 * kq + r] : 1.0f) * sc;
        __syncthreads();
#pragma unroll
        for (int g = 0; g < 2; ++g)
#pragma unroll
            for (int j = 0; j < 4; ++j) {
                if constexpr (FP8) *(LAS unsigned*)(tile + (c4 * 4 + j) * PITCH + 32 * g + 4 * kq) = pack4_fp8(v[g][0][j], v[g][1][j], v[g][2][j], v[g][3][j]);
                else { LAS unsigned* wp_ = (LAS unsigned*)(tile + (c4 * 4 + j) * PITCH + (32 * g + 4 * kq) * 2); wp_[0] = pack2(v[g][0][j], v[g][1][j]); wp_[1] = pack2(v[g][2][j], v[g][3][j]); }
            }
        __syncthreads();
        typedef unsigned u32x4 __attribute__((ext_vector_type(4)));
        unsigned char* dst = (mat < 2) ? (unsigned char*)(P.ws + WS_W1) + (size_t)e * 2048 * (FP8 ? 1024 : 2048) : (unsigned char*)(P.ws + WS_W2) + (size_t)e * 1024 * (FP8 ? 1024 : 2048);
        constexpr int CPR = FP8 ? 4 : 8;
#pragma unroll
        for (int j = 0; j < 256 * CPR / NTHR; ++j) {
            const int id = tid + NTHR * j, nl = id / CPR, ck = id % CPR, n = nt * 256 + nl;
            const int drow = (mat == 2) ? n : ((n >> 7) * 256 + (n & 127) + (mat == 1 ? 128 : 0));
            const LAS unsigned* rp = (const LAS unsigned*)(tile + nl * PITCH + ck * 16);
            const u32x4 o = {rp[0], rp[1], rp[2], rp[3]};
            *(u32x4*)(dst + (size_t)drow * (FP8 ? 1024 : 2048) + (size_t)kt * (FP8 ? 64 : 128) + ck * 16) = o;
        }
    }
    __syncthreads();
}
__device__ __forceinline__ void ph_conv_bf16(const float* src, bf16_t* dst, long n8) {
    const int tz = opaque_tid();
    for (int i = blockIdx.x * NTHR + tz; i < (int)n8; i += grid_size() * NTHR) {
        const float4 a = ((const float4*)src)[2 * i], b = ((const float4*)src)[2 * i + 1];
        ((uint4*)dst)[i] = make_uint4(pack2(a.x, a.y), pack2(a.z, a.w), pack2(b.x, b.y), pack2(b.z, b.w));
    }
}
__device__ __forceinline__ void ph_prep_router(const Params& P) {
    const int tz = opaque_tid();
    for (int i = blockIdx.x * NTHR + tz; i < 2 * 4 * 64 * 64; i += grid_size() * NTHR) {
        const int l = i >> 14, g = (i >> 12) & 3, d = (i >> 6) & 63, c = i & 63;
        ((bf16_t*)(P.ws + WS_WSM + (size_t)l * WSM_STRIDE + WSM_WPT))[(g * 64 + d) * 64 + c] = f2bf(P.pool_w[(size_t)l * 16384 + (g * 64 + c) * 64 + d]);
    }
    for (int i = blockIdx.x * NTHR + tz; i < 2 * 32 * 1024; i += grid_size() * NTHR) {
        const int l = i >> 15, e = (i >> 10) & 31, k = i & 1023;
        bf16_t* Wr = (bf16_t*)(P.ws + WS_WSM + (size_t)l * WSM_STRIDE + WSM_WR);
        const float w = P.router_w[((size_t)l * 1024 + k) * 32 + e] * P.ffn_norm[l * 1024 + k];
        const bf16_t whi = f2bf(w); Wr[e * 1024 + k] = whi; Wr[32 * 1024 + e * 1024 + k] = f2bf(w - bf2f(whi));
    }
}


__device__ __forceinline__ void ph_rope_table(const Params& P) {
    const int tz = opaque_tid();
    float* RT = (float*)(P.ws + WS_ROPE);
    for (int e = blockIdx.x * NTHR + tz; e < T * 16; e += grid_size() * NTHR) {
        const int t = e >> 4, i = e & 15;
        const float inv = exp2f(-(float)(2 * i) * (1.0f / 32.0f) * 13.287712379549449f);
        const float ang = (float)P.pos[t] * inv;
        RT[(size_t)t * 32 + i] = cosf(ang); RT[(size_t)t * 32 + 16 + i] = sinf(ang);
    }
}

__device__ __forceinline__ void ph_init_h(const Params& P) {
    const int tz = opaque_tid(); const int wid = tz >> 6, lane = tz & 63;
    bf16_t* HB = (bf16_t*)(P.ws + WS_HB); float* RS = (float*)(P.ws + WS_RSTD);
    for (int t = blockIdx.x * NWV + wid; t < T; t += grid_size() * NWV) {
        const float* hr = P.x + (size_t)t * 1024;
        float ss = 0.f; float4 v[4];
#pragma unroll
        for (int i = 0; i < 4; ++i) { v[i] = *(const float4*)(hr + i * 256 + lane * 4); ss += v[i].x * v[i].x + v[i].y * v[i].y + v[i].z * v[i].z + v[i].w * v[i].w; }
        ss = wave_sum(ss);
        if (lane == 0) RS[t] = rsqrtf(ss * (1.0f / 1024.0f) + EPS);
#pragma unroll
        for (int i = 0; i < 4; ++i) *(uint2*)(HB + (size_t)t * 1024 + i * 256 + lane * 4) = make_uint2(pack2(v[i].x, v[i].y), pack2(v[i].z, v[i].w));
    }
}

__device__ __forceinline__ void ph_prepB(const Params& P, int layer, unsigned char* lds) {
    float* wg = (float*)lds;
    const int tid = opaque_tid(), wid = tid >> 6, lane = tid & 63;
    for (int i = tid; i < 16 * 128; i += NTHR) wg[i] = P.gla_wg[(size_t)layer * 2048 + i];
    __syncthreads();
    bf16_t* Z = (bf16_t*)(P.ws + WS_BIG + BIG_Z); float* LA = (float*)(P.ws + WS_BIG + BIG_LA); bf16_t* YM = (bf16_t*)(P.ws + WS_YMIX);
    const float* bg = P.gla_bg + layer * 128; const float* psc = P.pool_s + layer * 256;
    const float bg0 = bg[lane], bg1 = bg[lane + 64];
    for (int t0 = (blockIdx.x * NWV + wid) * 2; t0 < T; t0 += grid_size() * NWV * 2) {
        uint2 cq[2]; unsigned ckv[2]; float gl[2];
#pragma unroll
        for (int tt = 0; tt < 2; ++tt) { const bf16_t* zr = Z + (size_t)(t0 + tt) * ZW; cq[tt] = *(const uint2*)(zr + ZC_CQ + lane * 4); ckv[tt] = *(const unsigned*)(zr + ZC_CKV + lane * 2); gl[tt] = (lane < 16) ? bf2f(zr[ZC_GLOW + lane]) : 0.f; }
#pragma unroll
        for (int tt = 0; tt < 2; ++tt) {
            bf16_t* zr = Z + (size_t)(t0 + tt) * ZW;
            {
                const float a = bf2f(cq[tt].x & 0xffff), b = bf2f(cq[tt].x >> 16), c = bf2f(cq[tt].y & 0xffff), d = bf2f(cq[tt].y >> 16);
                const float r = rsqrtf(wave_sum(a * a + b * b + c * c + d * d) * (1.0f / 256.0f) + EPS);
                *(uint2*)(zr + ZC_CQ + lane * 4) = make_uint2(pack2(a * r, b * r), pack2(c * r, d * r));
            }
            {
                const float a = bf2f(ckv[tt] & 0xffff), b = bf2f(ckv[tt] >> 16);
                const float r = rsqrtf(wave_sum(a * a + b * b) * (1.0f / 128.0f) + EPS);
                *(unsigned*)(zr + ZC_CKV + lane * 2) = pack2(a * r, b * r);
            }
            {
                float l0 = bg0, l1 = bg1;
#pragma unroll
                for (int r = 0; r < 16; ++r) { const float g = __uint_as_float(__builtin_amdgcn_readlane(__float_as_uint(gl[tt]), r)); l0 += g * wg[r * 128 + lane]; l1 += g * wg[r * 128 + lane + 64]; }
                const float a0 = fminf(l0, 0.f) - log1pf(__expf(-fabsf(l0))), a1 = fminf(l1, 0.f) - log1pf(__expf(-fabsf(l1)));
                LA[(size_t)(t0 + tt) * 128 + lane] = a0 * (1.0f / 16.0f); LA[(size_t)(t0 + tt) * 128 + lane + 64] = a1 * (1.0f / 16.0f);
            }
        }
    }
    const bf16_t* WpT = (const bf16_t*)(P.ws + WS_WSM + (size_t)layer * WSM_STRIDE + WSM_WPT);
    const int fr = lane & 15, fq = lane >> 4;
    for (int u = blockIdx.x * NWV + wid; u < T / 16; u += grid_size() * NWV) {
        const int t = u * 16 + fr, sq = t & (SEQ - 1);
#pragma unroll
        for (int gi = 0; gi < 4; ++gi) {
            const int w = 2 << gi; const int cnt = (sq + 1 < w) ? sq + 1 : w; const float rc = 1.0f / (float)cnt;
            bf16x8 af[2];
#pragma unroll
            for (int ks = 0; ks < 2; ++ks) {
                const bf16_t* up = Z + (size_t)t * ZW + ZC_UP + gi * 64 + ks * 32 + fq * 8;
                float acc[8], u0[8];
#pragma unroll
                for (int j = 0; j < 16; ++j) if (j < w) {
                    const int jj = (j < cnt) ? j : 0; const float msk = (j < cnt) ? 1.0f : 0.f;
                    const uint4 x = *(const uint4*)(up - (long)jj * ZW);
                    const float xv[8] = {bf2f(x.x & 0xffff), bf2f(x.x >> 16), bf2f(x.y & 0xffff), bf2f(x.y >> 16), bf2f(x.z & 0xffff), bf2f(x.z >> 16), bf2f(x.w & 0xffff), bf2f(x.w >> 16)};
#pragma unroll
                    for (int e = 0; e < 8; ++e) { if (j == 0) { u0[e] = xv[e]; acc[e] = xv[e]; } else acc[e] += msk * xv[e]; }
                }
                typedef unsigned u32x4 __attribute__((ext_vector_type(4)));
                const u32x4 pk = {pack2(acc[0] * rc - u0[0], acc[1] * rc - u0[1]), pack2(acc[2] * rc - u0[2], acc[3] * rc - u0[3]), pack2(acc[4] * rc - u0[4], acc[5] * rc - u0[5]), pack2(acc[6] * rc - u0[6], acc[7] * rc - u0[7])};
                af[ks] = __builtin_bit_cast(bf16x8, pk);
            }
#pragma unroll
            for (int nb = 0; nb < 4; ++nb) {
                f32x4 acc = {0.f, 0.f, 0.f, 0.f};
#pragma unroll
                for (int ks = 0; ks < 2; ++ks) { const bf16x8 bfr = *(const bf16x8*)(WpT + ((size_t)gi * 64 + nb * 16 + fr) * 64 + ks * 32 + fq * 8); acc = __builtin_amdgcn_mfma_f32_16x16x32_bf16(bfr, af[ks], acc, 0, 0, 0); }
                const int d0 = nb * 16 + fq * 4; const f32x4 sc = *(const f32x4*)(psc + gi * 64 + d0);
                *(uint2*)(YM + (size_t)t * 1024 + 768 + gi * 64 + d0) = make_uint2(pack2(acc[0] * sc[0], acc[1] * sc[1]), pack2(acc[2] * sc[2], acc[3] * sc[3]));
            }
        }
    }
}

template <bool DRY = false> __device__ __forceinline__ void ph_prepD(const Params& P, int layer) {
    const int tid = opaque_tid(), wid = tid >> 6, lane = tid & 63, g = lane >> 4, li = lane & 15;
    bf16_t* Z = (bf16_t*)(P.ws + WS_BIG + BIG_Z); bf16_t* Q = (bf16_t*)(P.ws + WS_BIG + BIG_Q); const bf16_t* KV = (const bf16_t*)(P.ws + WS_BIG + BIG_KV); bf16_t* Kd = DRY ? (bf16_t*)(P.ws + WS_Y + 64 * MiB) : (bf16_t*)(P.ws + WS_BIG + BIG_K);
    bf16_t* QW = DRY ? (bf16_t*)(P.ws + WS_Y) : Q;
    const float* RT = (const float*)(P.ws + WS_ROPE);
    const bool act = li < 12, rope = li >= 8 && li < 12, x1part = li < 10;
    const int e0 = act ? 8 * li : 0;
    float gq[8], gk[8];
#pragma unroll
    for (int j = 0; j < 8; ++j) { gq[j] = P.qkq[layer * 96 + e0 + j]; gk[j] = P.qkk[layer * 96 + e0 + j]; }
    const float qscale = 0.10206207261596577f * 1.4426950408889634f;
    for (int t = blockIdx.x * NWV + wid; t < T; t += grid_size() * NWV) {
        typedef unsigned u32x4 __attribute__((ext_vector_type(4)));
        u32x4 qraw[2], kraw[2];
        const int i0 = 8 * (li & 1);
        const f32x4 c0 = *(const f32x4*)(RT + (size_t)t * 32 + i0), c1 = *(const f32x4*)(RT + (size_t)t * 32 + i0 + 4), s0 = *(const f32x4*)(RT + (size_t)t * 32 + 16 + i0), s1 = *(const f32x4*)(RT + (size_t)t * 32 + 16 + i0 + 4);
        const float cs[8] = {c0[0], c0[1], c0[2], c0[3], c1[0], c1[1], c1[2], c1[3]}, sn[8] = {s0[0], s0[1], s0[2], s0[3], s1[0], s1[1], s1[2], s1[3]};
#pragma unroll
        for (int ps = 0; ps < 2; ++ps) {
            const int h = ps * 4 + g;
            qraw[ps] = *(const u32x4*)(Q + (size_t)t * 768 + h * 96 + e0);
            kraw[ps] = (li < 8) ? *(const u32x4*)(KV + (size_t)t * 1024 + h * 128 + e0) : *(const u32x4*)(Z + (size_t)t * ZW + ZC_KR + (rope ? 8 * (li - 8) : 0));
        }
#pragma unroll
        for (int ps = 0; ps < 2; ++ps) {
            const int h = ps * 4 + g;
#pragma unroll
            for (int qk = 0; qk < 2; ++qk) {
                const u32x4 raw = qk == 0 ? qraw[ps] : kraw[ps];
                float x[8];
#pragma unroll
                for (int w = 0; w < 4; ++w) { x[2 * w] = act ? bf2f(raw[w] & 0xffff) : 0.f; x[2 * w + 1] = act ? bf2f(raw[w] >> 16) : 0.f; }
                float ss = 0.f;
#pragma unroll
                for (int j = 0; j < 8; ++j) ss += x[j] * x[j];
                ss += dppx<0xB1>(ss); ss += dppx<0x4E>(ss); ss += dppx<0x141>(ss); ss += dppx<0x140>(ss);
                const float r = rsqrtf(ss * (1.0f / 96.0f) + EPS);
                float y[8];
#pragma unroll
                for (int j = 0; j < 8; ++j) {
                    const float xn = x[j] * r * (qk == 0 ? gq[j] : gk[j]);
                    const float pr = dppx<0x4E>(xn);
                    const float rot = x1part ? (xn * cs[j] - pr * sn[j]) : (xn * cs[j] + pr * sn[j]);
                    y[j] = (rope ? rot : xn) * (qk == 0 ? qscale : 1.0f);
                }
                const u32x4 o = {pack2(y[0], y[1]), pack2(y[2], y[3]), pack2(y[4], y[5]), pack2(y[6], y[7])};
                if (act) { if (qk == 0) *(u32x4*)(QW + (size_t)t * 768 + h * 96 + e0) = o; else *(u32x4*)(Kd + ((size_t)t * 8 + h) * 96 + e0) = o; }
            }
        }
    }
}

template <bool FP8> __device__ __forceinline__ void ph_router(const Params& P, int layer, LAS unsigned char* lds) {
    using at::f32x16;
    const int tid = opaque_tid(); const int wid = __builtin_amdgcn_readfirstlane(tid >> 6), lane = tid & 63, r32 = lane & 31, hi = lane >> 5;
    const bf16_t* HB = (const bf16_t*)(P.ws + WS_HB); float* RS1 = (float*)(P.ws + WS_RSTD) + T;
    const bf16_t* WrH = (const bf16_t*)(P.ws + WS_WSM + (size_t)layer * WSM_STRIDE + WSM_WR); const bf16_t* WrL = WrH + 32 * 1024;
    const float* rb = P.router_b + layer * 32;
    unsigned* cnt = (unsigned*)(P.ws + WS_CTL) + CTL_CNT + layer * 32;
    int* LIST = (int*)(P.ws + WS_LIST);
    constexpr int MAXU = 4;
    LAS unsigned* lcnt = (LAS unsigned*)lds; LAS unsigned* lbase = lcnt + 32;
    LAS unsigned* ent = lbase + 32;
    LAS float* entg = (LAS float*)(ent + NWV * MAXU * 128);
    LAS float* entr = entg + NWV * MAXU * 128;
    if (tid < 32) lcnt[tid] = 0u;
    __syncthreads();
    int nu = 0;
    for (int u = blockIdx.x * 4 + wid; wid < 4 && u < T / 32; u += grid_size() * 4, ++nu) {
        const size_t trow = (size_t)u * 32 + r32;
        f32x16 acc;
#pragma unroll
        for (int r = 0; r < 16; ++r) acc[r] = 0.f;
        float ss = 0.f;
        const bf16_t* hp = HB + trow * 1024 + hi * 8; const bf16_t* wh = WrH + (size_t)r32 * 1024 + hi * 8; const bf16_t* wl_ = WrL + (size_t)r32 * 1024 + hi * 8;
#pragma unroll 8
        for (int ks = 0; ks < 64; ++ks) {
            const bf16x8 hf = *(const bf16x8*)(hp + ks * 16), a0 = *(const bf16x8*)(wh + ks * 16), a1 = *(const bf16x8*)(wl_ + ks * 16);
            acc = __builtin_amdgcn_mfma_f32_32x32x16_bf16(a0, hf, acc, 0, 0, 0);
            acc = __builtin_amdgcn_mfma_f32_32x32x16_bf16(a1, hf, acc, 0, 0, 0);
            float hv[8];
#pragma unroll
            for (int j = 0; j < 8; ++j) { hv[j] = bf2f((bf16_t)hf[j]); ss += hv[j] * hv[j]; }
            if constexpr (FP8) *(uint2*)((unsigned char*)(P.ws + WS_YMIX) + trow * 1024 + ks * 16 + hi * 8) = make_uint2(pack4_fp8(hv[0], hv[1], hv[2], hv[3]), pack4_fp8(hv[4], hv[5], hv[6], hv[7]));
        }
        ss = at::xhalf_sum(ss);
        const float rstd = rsqrtf(ss * (1.0f / 1024.0f) + EPS);
        if (hi == 0) RS1[trow] = rstd;
        float lg[16];
#pragma unroll
        for (int r = 0; r < 16; ++r) lg[r] = acc[r] * rstd + rb[(r & 3) + 8 * (r >> 2) + 4 * hi];
        float cv[8]; int ci[8];
#pragma unroll
        for (int k = 0; k < 4; ++k) {
            float best = -INFINITY; int bi = 0;
#pragma unroll
            for (int r = 0; r < 16; ++r) { const bool ok = lg[r] > best; best = ok ? lg[r] : best; bi = ok ? r : bi; }
#pragma unroll
            for (int r = 0; r < 16; ++r) lg[r] = (r == bi) ? -INFINITY : lg[r];
            cv[k] = best; ci[k] = (bi & 3) + 8 * (bi >> 2) + 4 * hi;
        }
#pragma unroll
        for (int k = 0; k < 4; ++k) {
            { auto rr = __builtin_amdgcn_permlane32_swap(__float_as_uint(cv[k]), __float_as_uint(cv[k]), false, false); cv[4 + k] = __uint_as_float(hi ? rr[0] : rr[1]); }
            { auto rr = __builtin_amdgcn_permlane32_swap((unsigned)ci[k], (unsigned)ci[k], false, false); ci[4 + k] = (int)(hi ? rr[0] : rr[1]); }
        }
        float tv[4]; int ti[4];
#pragma unroll
        for (int k = 0; k < 4; ++k) {
            float best = -INFINITY; int be = 64, bj = 0;
#pragma unroll
            for (int j = 0; j < 8; ++j) { const bool ok = (cv[j] > best) || (cv[j] == best && ci[j] < be); best = ok ? cv[j] : best; be = ok ? ci[j] : be; bj = ok ? j : bj; }
#pragma unroll
            for (int j = 0; j < 8; ++j) cv[j] = (j == bj) ? -INFINITY : cv[j];
            tv[k] = best; ti[k] = be;
        }
        const float e1 = __expf(tv[1] - tv[0]), e2 = __expf(tv[2] - tv[0]), e3 = __expf(tv[3] - tv[0]);
        const float invs = __builtin_amdgcn_rcpf(1.0f + e1 + e2 + e3);
        if (hi == 0 && nu < MAXU) {
            const float gt[4] = {invs, e1 * invs, e2 * invs, e3 * invs};
            const int base = ((wid * MAXU + nu) * 32 + r32) * 4;
#pragma unroll
            for (int k = 0; k < 4; ++k) {
                const unsigned rk = __hip_atomic_fetch_add(&lcnt[ti[k]], 1u, __ATOMIC_RELAXED, __HIP_MEMORY_SCOPE_WORKGROUP);
                ent[base + k] = (unsigned)ti[k] | (rk << 8); entg[base + k] = gt[k];
            }
            entr[(wid * MAXU + nu) * 32 + r32] = rstd;
        }
    }
    __syncthreads();
    if (tid < 32) lbase[tid] = atomicAdd(&cnt[tid], lcnt[tid]);
    __syncthreads();
    {
        int k2 = 0;
        for (int u = blockIdx.x * 4 + wid; wid < 4 && u < T / 32 && k2 < MAXU; u += grid_size() * 4, ++k2) {
#pragma unroll
            for (int h2 = 0; h2 < 2; ++h2) {
                const int i = lane + 64 * h2; const int tl = i >> 2;
                const unsigned code = ent[((wid * MAXU + k2) * 32) * 4 + i]; const int e = (int)(code & 255u); const unsigned pos = lbase[e] + (code >> 8);
                LIST[(size_t)e * T + pos] = (int)(((unsigned)u * 32 + tl) * 4 + (i & 3));
                ((float*)(P.ws + WS_LRS))[(size_t)e * T + pos] = entr[(wid * MAXU + k2) * 32 + tl];
                ((float*)(P.ws + WS_LGT))[(size_t)e * T + pos] = entg[((wid * MAXU + k2) * 32) * 4 + i];
            }
        }
    }
    __syncthreads();
}

template <bool DRY = false> __device__ __forceinline__ void ph_combine(const Params& P) {
    const int tid = opaque_tid(), wid = tid >> 6, lane = tid & 63;
    bf16_t* HB = (bf16_t*)(P.ws + WS_HB); bf16_t* HBW = DRY ? (bf16_t*)(P.ws + WS_BIG + 128 * MiB) : HB; float* RS2 = DRY ? (float*)(P.ws + WS_BIG + 200 * MiB) : (float*)(P.ws + WS_RSTD) + 2 * T; const bf16_t* Y = (const bf16_t*)(P.ws + WS_Y);
    for (int t0 = (blockIdx.x * NWV + wid) * 2; t0 < T; t0 += grid_size() * NWV * 2) {
        uint2 hv[2][4]; uint2 yv[2][4][4];
#pragma unroll
        for (int tt = 0; tt < 2; ++tt)
#pragma unroll
            for (int i = 0; i < 4; ++i) {
                hv[tt][i] = *(const uint2*)(HB + (size_t)(t0 + tt) * 1024 + i * 256 + lane * 4);
#pragma unroll
                for (int k = 0; k < 4; ++k) yv[tt][i][k] = *(const uint2*)(Y + ((size_t)(t0 + tt) * 4 + k) * 1024 + i * 256 + lane * 4);
            }
#pragma unroll
        for (int tt = 0; tt < 2; ++tt) {
            float ss = 0.f;
#pragma unroll
            for (int i = 0; i < 4; ++i) {
                f32x4 v = {bf2f(hv[tt][i].x & 0xffff), bf2f(hv[tt][i].x >> 16), bf2f(hv[tt][i].y & 0xffff), bf2f(hv[tt][i].y >> 16)};
#pragma unroll
                for (int k = 0; k < 4; ++k) { const uint2 y = yv[tt][i][k]; v[0] += bf2f(y.x & 0xffff); v[1] += bf2f(y.x >> 16); v[2] += bf2f(y.y & 0xffff); v[3] += bf2f(y.y >> 16); }
                ss += v[0] * v[0] + v[1] * v[1] + v[2] * v[2] + v[3] * v[3];
                *(uint2*)(HBW + (size_t)(t0 + tt) * 1024 + i * 256 + lane * 4) = make_uint2(pack2(v[0], v[1]), pack2(v[2], v[3]));
            }
            ss = wave_sum(ss);
            if (lane == 0) RS2[t0 + tt] = rsqrtf(ss * (1.0f / 1024.0f) + EPS);
        }
    }
}

template <bool DRY = false> __device__ __forceinline__ void ph_final(const Params& P, int layer) {
    const int tid = opaque_tid(), wid = tid >> 6, lane = tid & 63;
    bf16_t* HB = (bf16_t*)(P.ws + WS_HB); bf16_t* HBW = DRY ? (bf16_t*)(P.ws + WS_BIG + 128 * MiB) : HB; float* RS = DRY ? (float*)(P.ws + WS_BIG + 200 * MiB) : (float*)(P.ws + WS_RSTD); const bf16_t* V = (const bf16_t*)(P.ws + WS_YMIX);
    float* OUTW = DRY ? (float*)(P.ws + WS_BIG) : P.out;
    const float* gp = P.ple_pn + layer * 1024;
    f32x4 g[4];
#pragma unroll
    for (int i = 0; i < 4; ++i) g[i] = *(const f32x4*)(gp + i * 256 + lane * 4);
    for (int t0 = (blockIdx.x * NWV + wid) * 2; t0 < T; t0 += grid_size() * NWV * 2) {
        uint2 hv[2][4]; uint2 yv[2][4];
#pragma unroll
        for (int tt = 0; tt < 2; ++tt)
#pragma unroll
            for (int i = 0; i < 4; ++i) { hv[tt][i] = *(const uint2*)(HB + (size_t)(t0 + tt) * 1024 + i * 256 + lane * 4); yv[tt][i] = *(const uint2*)(V + (size_t)(t0 + tt) * 1024 + i * 256 + lane * 4); }
#pragma unroll
        for (int tt = 0; tt < 2; ++tt) {
            f32x4 vv[4]; float ss = 0.f;
#pragma unroll
            for (int i = 0; i < 4; ++i) { const uint2 y = yv[tt][i]; vv[i] = (f32x4){bf2f(y.x & 0xffff), bf2f(y.x >> 16), bf2f(y.y & 0xffff), bf2f(y.y >> 16)}; ss += vv[i][0] * vv[i][0] + vv[i][1] * vv[i][1] + vv[i][2] * vv[i][2] + vv[i][3] * vv[i][3]; }
            ss = wave_sum(ss);
            const float r = rsqrtf(ss * (1.0f / 1024.0f) + EPS);
            float s2 = 0.f;
#pragma unroll
            for (int i = 0; i < 4; ++i) {
                const f32x4 h = {bf2f(hv[tt][i].x & 0xffff), bf2f(hv[tt][i].x >> 16), bf2f(hv[tt][i].y & 0xffff), bf2f(hv[tt][i].y >> 16)};
                const f32x4 v = h + vv[i] * r * g[i];
                if (layer == DEPTH - 1) *(f32x4*)(OUTW + (size_t)(t0 + tt) * 1024 + i * 256 + lane * 4) = v;
                else { s2 += v[0] * v[0] + v[1] * v[1] + v[2] * v[2] + v[3] * v[3]; *(uint2*)(HBW + (size_t)(t0 + tt) * 1024 + i * 256 + lane * 4) = make_uint2(pack2(v[0], v[1]), pack2(v[2], v[3])); }
            }
            if (layer != DEPTH - 1) { s2 = wave_sum(s2); if (lane == 0) RS[t0 + tt] = rsqrtf(s2 * (1.0f / 1024.0f) + EPS); }
        }
    }
}

struct EpiZ { bf16_t* Z; const float* rstd;
    __device__ __forceinline__ void operator()(int r, int c, f32x4 v) const { const float s = rstd[r]; *(uint2*)(Z + (size_t)r * ZW + c) = make_uint2(pack2(v[0] * s, v[1] * s), pack2(v[2] * s, v[3] * s)); } };
struct EpiBf16 { bf16_t* O; int ldo;
    __device__ __forceinline__ void operator()(int r, int c, f32x4 v) const { *(uint2*)(O + (size_t)r * ldo + c) = make_uint2(pack2(v[0], v[1]), pack2(v[2], v[3])); } };
struct EpiResid { const float* hin; float* out;
    __device__ __forceinline__ void operator()(int r, int c, f32x4 v) const { const f32x4 b = *(const f32x4*)(hin + (size_t)r * 1024 + c); *(f32x4*)(out + (size_t)r * 1024 + c) = b + v; } };
struct EpiMoe1 { const int* list; const float* rstd1; const float* bg; const float* bu; bf16_t* H;
    __device__ __forceinline__ void operator()(int r, int hc, f32x4 g, f32x4 u) const {
        const float s = rstd1[list[r] >> 2]; const f32x4 b0 = *(const f32x4*)(bg + hc), b1 = *(const f32x4*)(bu + hc); float o[4];
#pragma unroll
        for (int j = 0; j < 4; ++j) { const float gg = fminf(g[j] * s + b0[j], 7.0f); const float uu = fminf(fmaxf(u[j] * s + b1[j], -7.0f), 7.0f); o[j] = (uu + 1.0f) * gg * sigmoidf_(1.702f * gg); }
        *(uint2*)(H + (size_t)r * 1024 + hc) = make_uint2(pack2(o[0], o[1]), pack2(o[2], o[3])); } };
struct EpiMoe2 { const int* list; const float* topg; const float* bd; bf16_t* Y;
    __device__ __forceinline__ void operator()(int r, int c, f32x4 v) const { const int ts = list[r]; const float g = topg[ts]; const f32x4 b = *(const f32x4*)(bd + c);
        *(uint2*)(Y + (size_t)ts * 1024 + c) = make_uint2(pack2((v[0] + b[0]) * g, (v[1] + b[1]) * g), pack2((v[2] + b[2]) * g, (v[3] + b[3]) * g)); } };
struct EpiPle { const bf16_t* E; const float* rstd2; bf16_t* V;
    __device__ __forceinline__ void operator()(int r, int c, f32x4 v) const { const float s = rstd2[r]; const uint2 e = *(const uint2*)(E + (size_t)r * 1024 + c);
        const float o0 = bf2f(e.x & 0xffff) * sigmoidf_(v[0] * s), o1 = bf2f(e.x >> 16) * sigmoidf_(v[1] * s), o2 = bf2f(e.y & 0xffff) * sigmoidf_(v[2] * s), o3 = bf2f(e.y >> 16) * sigmoidf_(v[3] * s);
        *(uint2*)(V + (size_t)r * 1024 + c) = make_uint2(pack2(o0, o1), pack2(o2, o3)); } };


typedef unsigned u32x4_t __attribute__((ext_vector_type(4)));
struct EpiZ8 { bf16_t* Z; const float* rstd;
    __device__ __forceinline__ void operator()(int r, int c, f32x4 a, f32x4 b) const { const float s = rstd[r]; *(u32x4_t*)(Z + (size_t)r * ZW + c) = (u32x4_t){pack2(a[0] * s, a[1] * s), pack2(a[2] * s, a[3] * s), pack2(b[0] * s, b[1] * s), pack2(b[2] * s, b[3] * s)}; } };
struct EpiBf16_8 { bf16_t* O; int ldo;
    __device__ __forceinline__ void operator()(int r, int c, f32x4 a, f32x4 b) const { *(u32x4_t*)(O + (size_t)r * ldo + c) = (u32x4_t){pack2(a[0], a[1]), pack2(a[2], a[3]), pack2(b[0], b[1]), pack2(b[2], b[3])}; } };
struct EpiResid8 { const float* xin; bf16_t* HB;
    __device__ __forceinline__ void operator()(int r, int c, f32x4 a, f32x4 b) const {
        f32x4 h0, h1;
        if (xin) { h0 = *(const f32x4*)(xin + (size_t)r * 1024 + c); h1 = *(const f32x4*)(xin + (size_t)r * 1024 + c + 4); }
        else { const u32x4_t e = *(const u32x4_t*)(HB + (size_t)r * 1024 + c); h0 = (f32x4){bf2f(e[0] & 0xffff), bf2f(e[0] >> 16), bf2f(e[1] & 0xffff), bf2f(e[1] >> 16)}; h1 = (f32x4){bf2f(e[2] & 0xffff), bf2f(e[2] >> 16), bf2f(e[3] & 0xffff), bf2f(e[3] >> 16)}; }
        h0 += a; h1 += b;
        *(u32x4_t*)(HB + (size_t)r * 1024 + c) = (u32x4_t){pack2(h0[0], h0[1]), pack2(h0[2], h0[3]), pack2(h1[0], h1[1]), pack2(h1[2], h1[3])}; } };
struct EpiPle8 { const bf16_t* E; const float* rstd2; bf16_t* V;
    __device__ __forceinline__ void operator()(int r, int c, f32x4 a, f32x4 b) const { const float s = rstd2[r]; const u32x4_t e = *(const u32x4_t*)(E + (size_t)r * 1024 + c);
        *(u32x4_t*)(V + (size_t)r * 1024 + c) = (u32x4_t){pack2(bf2f(e[0] & 0xffff) * sigmoidf_(a[0] * s), bf2f(e[0] >> 16) * sigmoidf_(a[1] * s)), pack2(bf2f(e[1] & 0xffff) * sigmoidf_(a[2] * s), bf2f(e[1] >> 16) * sigmoidf_(a[3] * s)),
                                                            pack2(bf2f(e[2] & 0xffff) * sigmoidf_(b[0] * s), bf2f(e[2] >> 16) * sigmoidf_(b[1] * s)), pack2(bf2f(e[3] & 0xffff) * sigmoidf_(b[2] * s), bf2f(e[3] >> 16) * sigmoidf_(b[3] * s))}; } };
__device__ __forceinline__ float swiglu_(float g, float u, float s, float bgv, float buv) { const float gg = fminf(g * s + bgv, 7.0f); const float uu = fminf(fmaxf(u * s + buv, -7.0f), 7.0f); return (uu + 1.0f) * gg * sigmoidf_(1.702f * gg); }

template <class Epi, bool PAIR>
__device__ __forceinline__ void gemm_simple_unit(const bf16_t* A, int lda, const int* rowidx, const bf16_t* Bt, int ldb, int M, int K, int mblk, int nblk, const Epi& epi) {
    const int tid = opaque_tid(), wid = tid >> 6, lane = tid & 63, wr = wid >> 1, wc = wid & 1, fr = lane & 15, fq = lane >> 4;
    const int m0 = mblk * 256 + wr * 64;
    if (m0 >= M) return;
    const bf16_t* ap[4]; const bf16_t* bp[4];
#pragma unroll
    for (int mi = 0; mi < 4; ++mi) { int r = m0 + mi * 16 + fr; if (r >= M) r = M - 1; const long ar = rowidx ? (long)(rowidx[r] >> 2) : (long)r; ap[mi] = A + ar * lda + fq * 8; }
#pragma unroll
    for (int ni = 0; ni < 4; ++ni) {
        int br;
        if (PAIR) { const int hc = nblk * 64 + wc * 32 + (ni & 1) * 16 + fr; br = (hc >> 7) * 256 + (hc & 127) + ((ni >> 1) ? 128 : 0); }
        else br = nblk * 128 + wc * 64 + ni * 16 + fr;
        bp[ni] = Bt + (long)br * ldb + fq * 8;
    }
    f32x4 acc[4][4];
#pragma unroll
    for (int mi = 0; mi < 4; ++mi)
#pragma unroll
        for (int ni = 0; ni < 4; ++ni) acc[mi][ni] = (f32x4){0.f, 0.f, 0.f, 0.f};
    for (int k0 = 0; k0 < K; k0 += 32) {
        bf16x8 a[4], b[4];
#pragma unroll
        for (int i = 0; i < 4; ++i) { a[i] = *(const bf16x8*)(ap[i] + k0); b[i] = *(const bf16x8*)(bp[i] + k0); }
#pragma unroll
        for (int mi = 0; mi < 4; ++mi)
#pragma unroll
            for (int ni = 0; ni < 4; ++ni) acc[mi][ni] = __builtin_amdgcn_mfma_f32_16x16x32_bf16(b[ni], a[mi], acc[mi][ni], 0, 0, 0);
    }
#pragma unroll
    for (int mi = 0; mi < 4; ++mi) {
        const int r = m0 + mi * 16 + fr;
        if (r < M) {
            if constexpr (PAIR) {
#pragma unroll
                for (int ni = 0; ni < 2; ++ni) epi(r, nblk * 64 + wc * 32 + ni * 16 + fq * 4, acc[mi][ni], acc[mi][ni + 2]);
            } else {
#pragma unroll
                for (int ni = 0; ni < 4; ++ni) epi(r, nblk * 128 + wc * 64 + ni * 16 + fq * 4, acc[mi][ni]);
            }
        }
    }
}

namespace fg {
typedef int v4i_t __attribute__((ext_vector_type(4))); typedef int v8i_t __attribute__((ext_vector_type(8)));
constexpr int BM = 256, BK = 64, HALF = 128, HTB = HALF * BK * 2  , STAGE_BYTES = 8 * HTB, NXCD = 8, WGM = 8;
__host__ __device__ __forceinline__ int lds_byte(int r, int c) { const int st = (r >> 4) * 2 + (c >> 5), rr = r & 15, cc = c & 31, ob = rr * 64 + cc * 2; return st * 1024 + (ob ^ (((ob >> 9) & 1) << 5)); }
__host__ __device__ __forceinline__ int perm32(int rho) { const int n = rho >> 4, i = rho & 15; return 8 * (i >> 2) + 4 * n + (i & 3); }
__host__ __device__ __forceinline__ void stage_rc(int b, int& R, int& C) { const int st = b / 1024, sb = b % 1024, swz = sb ^ (((sb >> 9) & 1) << 5); R = (st >> 1) * 16 + swz / 64; C = (st & 1) * 32 + (swz % 64) / 2; }

template <class PB>
__device__ __forceinline__ void gemm_phase(LAS unsigned char* lds, const PB& S) {
    constexpr int K = PB::K, nt = K / BK;
    typedef typename PB::Unit Unit;
    const int tid = opaque_tid(); const int wid = __builtin_amdgcn_readfirstlane(tid >> 6), lane = tid & 63, wr = wid >> 2, wc = wid & 3, fr = lane & 15, fq = lane >> 4;
    unsigned voffB[2];
#pragma unroll
    for (int i = 0; i < 2; ++i) { int R_, C_; stage_rc(tid * 16 + i * 8192, R_, C_); const int Rb_ = PB::PERM ? ((R_ & ~31) + perm32(R_ & 31)) : R_; voffB[i] = (unsigned)(Rb_ * K + C_) * 2u; }
#define FG_AOFFS(dst, unit) do { int tz_ = tid; asm volatile("" : "+v"(tz_)); _Pragma("unroll") for (int i_ = 0; i_ < 2; ++i_) { int R_, C_; stage_rc(tz_ * 16 + i_ * 8192, R_, C_); \
        _Pragma("unroll") for (int h_ = 0; h_ < 2; ++h_) dst[h_][i_] = S.a_off(unit, h_ * HALF + R_) + (unsigned)C_ * 2u; } } while (0)
    constexpr size_t kstep = (size_t)(BK * 2);
    constexpr size_t hstep = (size_t)HALF * K * 2;
    const unsigned ldsw = (unsigned)wid * 1024u;
    const int aoff = lds_byte(wr * 64 + fr, fq * 8), boff = lds_byte(wc * 32 + fr, fq * 8);
#define FG_SA(b, h) (((b) * 2 + (h)) * HTB)
#define FG_SB(b, h) ((4 + (b) * 2 + (h)) * HTB)
#define FG_STAGE_B(bufoff, gbase) do { _Pragma("unroll") for (int _i = 0; _i < 2; ++_i) \
        __builtin_amdgcn_global_load_lds((const unsigned*)((const char*)(gbase) + voffB[_i]), (LAS unsigned*)(lds + (bufoff) + ldsw + _i * 8192), 16, 0, 0); } while (0)
#define FG_STAGE_A(bufoff, o0, o1) do { \
        __builtin_amdgcn_global_load_lds((const unsigned*)(Abase + (o0)), (LAS unsigned*)(lds + (bufoff) + ldsw), 16, 0, 0); \
        __builtin_amdgcn_global_load_lds((const unsigned*)(Abase + (o1)), (LAS unsigned*)(lds + (bufoff) + ldsw + 8192), 16, 0, 0); } while (0)
#define FG_LD8(dst, off) do { const v4i_t lo_ = *(const LAS v4i_t*)(lds + (off)), hi_ = *(const LAS v4i_t*)(lds + (off) + 1024); dst = (v8i_t){lo_[0], lo_[1], lo_[2], lo_[3], hi_[0], hi_[1], hi_[2], hi_[3]}; } while (0)
#define FG_LDA(dst, b, h) do { _Pragma("unroll") for (int m = 0; m < 4; ++m) FG_LD8(dst[m], FG_SA(b, h) + aoff + m * 2048); } while (0)
#define FG_LDB(dst, b, h) do { _Pragma("unroll") for (int n = 0; n < 2; ++n) FG_LD8(dst[n], FG_SB(b, h) + boff + n * 2048); } while (0)
#define FG_HALF(v, k) ((k) == 0 ? __builtin_bit_cast(bf16x8, (v4i_t){(v)[0], (v)[1], (v)[2], (v)[3]}) : __builtin_bit_cast(bf16x8, (v4i_t){(v)[4], (v)[5], (v)[6], (v)[7]}))
#define FG_MMA(ai, bj, At, Bt) do { __builtin_amdgcn_s_setprio(1); \
        if constexpr (PB::FP8) { _Pragma("unroll") for (int m = 0; m < 4; ++m) _Pragma("unroll") for (int n = 0; n < 2; ++n) \
            asm volatile("v_mfma_scale_f32_16x16x128_f8f6f4 %0, %1, %2, %0, %3, %4 op_sel_hi:[0,0,0]" : "+v"(acc[ai][bj][m][n]) : "v"(Bt[n]), "v"(At[m]), "v"(sclW), "v"(sclA)); } \
        else { _Pragma("unroll") for (int m = 0; m < 4; ++m) _Pragma("unroll") for (int n = 0; n < 2; ++n) _Pragma("unroll") for (int k = 0; k < 2; ++k) \
            acc[ai][bj][m][n] = __builtin_amdgcn_mfma_f32_16x16x32_bf16(FG_HALF(Bt[n], k), FG_HALF(At[m], k), acc[ai][bj][m][n], 0, 0, 0); } \
        __builtin_amdgcn_s_setprio(0); } while (0)
#define FG_WAIT_V(n) asm volatile("s_waitcnt vmcnt(" #n ")" ::: "memory")
#define FG_WAIT_L(n) asm volatile("s_waitcnt lgkmcnt(" #n ")" ::: "memory")
#define FG_BAR __builtin_amdgcn_s_barrier()
#define FG_SCHED __builtin_amdgcn_sched_barrier(0)
    Unit cur, nxt; int ui = 0;
    if (!S.next(0, cur)) return;
    f32x4 acc[2][2][4][2];
#pragma unroll
    for (int a = 0; a < 2; ++a)
#pragma unroll
        for (int b = 0; b < 2; ++b)
#pragma unroll
            for (int m = 0; m < 4; ++m)
#pragma unroll
                for (int n = 0; n < 2; ++n) acc[a][b][m][n] = (f32x4){0.f, 0.f, 0.f, 0.f};
    v8i_t At[4], B0[2], B1[2];
    int sclW = 0x79797979, sclA = 0x7f7f7f7f;
    asm volatile("" : "+v"(sclW), "+v"(sclA));
    const char* Abase = S.a_base();
    unsigned vAc[2][2];
    FG_AOFFS(vAc, cur);
    const char* cB = S.b_base(cur);
    FG_STAGE_B(FG_SB(0, 0), cB); FG_STAGE_A(FG_SA(0, 0), vAc[0][0], vAc[0][1]); FG_STAGE_B(FG_SB(0, 1), cB + hstep); FG_STAGE_A(FG_SA(0, 1), vAc[1][0], vAc[1][1]);
    if (wr == 1) FG_BAR;
    FG_WAIT_V(4); FG_BAR;
    FG_STAGE_B(FG_SB(1, 0), cB + kstep); FG_STAGE_A(FG_SA(1, 0), vAc[0][0] + (unsigned)kstep, vAc[0][1] + (unsigned)kstep); FG_STAGE_B(FG_SB(1, 1), cB + hstep + kstep);
    FG_WAIT_V(6); FG_BAR;
    for (;;) {
        const bool has_next = S.next(ui + 1, nxt);
        const char* nB = has_next ? S.b_base(nxt) : cB;
        {
            unsigned vAn[2][2];
            if (has_next) { FG_AOFFS(vAn, nxt); }
            else {
#pragma unroll
                for (int h = 0; h < 2; ++h)
#pragma unroll
                    for (int i = 0; i < 2; ++i) vAn[h][i] = vAc[h][i];
            }
            *(LAS v4i_t*)(lds + STAGE_BYTES + 512 + tid * 16) = (v4i_t){(int)vAn[0][0], (int)vAn[0][1], (int)vAn[1][0], (int)vAn[1][1]};
        }
#pragma unroll 1
        for (int t = 0; t < nt; t += 2) {
            const bool last = (t == nt - 2);
            const unsigned k1 = (unsigned)((t + 1) * (int)kstep), k2 = last ? 0u : (unsigned)((t + 2) * (int)kstep);
            const char* b2 = last ? nB : cB + (size_t)(t + 2) * kstep; const char* b3 = b2 + kstep;
            const unsigned c10_ = vAc[1][0], c11_ = vAc[1][1];
            if (last) { const v4i_t nx_ = *(const LAS v4i_t*)(lds + STAGE_BYTES + 512 + tid * 16); vAc[0][0] = (unsigned)nx_[0]; vAc[0][1] = (unsigned)nx_[1]; vAc[1][0] = (unsigned)nx_[2]; vAc[1][1] = (unsigned)nx_[3]; }
#define FG_A2(h, i) (vAc[h][i] + k2)
            FG_LDB(B0, 0, 0); FG_SCHED; FG_LDA(At, 0, 0); FG_STAGE_A(FG_SA(1, 1), c10_ + k1, c11_ + k1);
            FG_WAIT_L(8); FG_BAR; FG_WAIT_L(0); FG_MMA(0, 0, At, B0); FG_BAR; FG_SCHED;
            FG_LDB(B1, 0, 1); FG_STAGE_B(FG_SB(0, 0), b2);
            FG_BAR; FG_WAIT_L(0); FG_MMA(0, 1, At, B1); FG_BAR;
            FG_LDA(At, 0, 1); FG_STAGE_A(FG_SA(0, 0), FG_A2(0, 0), FG_A2(0, 1));
            FG_BAR; FG_WAIT_L(0); FG_MMA(1, 0, At, B0); FG_BAR; FG_SCHED;
            FG_STAGE_B(FG_SB(0, 1), b2 + hstep);
            FG_WAIT_V(6); FG_BAR; FG_MMA(1, 1, At, B1); FG_BAR;
            FG_LDB(B0, 1, 0); FG_SCHED; FG_LDA(At, 1, 0); FG_STAGE_A(FG_SA(0, 1), FG_A2(1, 0), FG_A2(1, 1));
            FG_WAIT_L(8); FG_BAR; FG_WAIT_L(0); FG_MMA(0, 0, At, B0); FG_BAR; FG_SCHED;
            FG_LDB(B1, 1, 1); FG_STAGE_B(FG_SB(1, 0), b3);
            FG_BAR; FG_WAIT_L(0); FG_MMA(0, 1, At, B1); FG_BAR;
            FG_LDA(At, 1, 1); FG_STAGE_A(FG_SA(1, 0), FG_A2(0, 0) + (unsigned)kstep, FG_A2(0, 1) + (unsigned)kstep);
            FG_BAR; FG_WAIT_L(0); FG_MMA(1, 0, At, B0); FG_BAR; FG_SCHED;
            FG_STAGE_B(FG_SB(1, 1), b3 + hstep);
            FG_WAIT_V(6); FG_BAR; FG_MMA(1, 1, At, B1); FG_BAR;
        }
        if constexpr (PB::FP8) asm volatile("s_nop 15\n\ts_nop 15\n\ts_nop 15" ::: "memory");
        S.epilogue(acc, cur, wr, wc, fr, fq);
        if (!has_next) break;
#pragma unroll
        for (int a = 0; a < 2; ++a)
#pragma unroll
            for (int b = 0; b < 2; ++b)
#pragma unroll
                for (int m = 0; m < 4; ++m)
#pragma unroll
                    for (int n = 0; n < 2; ++n) acc[a][b][m][n] = (f32x4){0.f, 0.f, 0.f, 0.f};
        cur = nxt; cB = nB; ++ui;
    }
    FG_WAIT_V(0);
    if (wr == 0) FG_BAR;
    FG_BAR;
#undef FG_AOFFS
#undef FG_A2
#undef FG_SA
#undef FG_SB
#undef FG_STAGE_A
#undef FG_STAGE_B
#undef FG_LDA
#undef FG_LD8
#undef FG_HALF
#undef FG_LDB
#undef FG_MMA
#undef FG_WAIT_V
#undef FG_WAIT_L
#undef FG_BAR
#undef FG_SCHED
}

template <int K_, int LDA, class Epi, bool PERM_>
struct DenseProb {
    static constexpr int K = K_; static constexpr bool PERM = PERM_, FP8 = false;
    struct Unit { int pm, pn; };
    const bf16_t* A; const bf16_t* Bt; int nM, nN, nwg, G, c; Epi epi;
    __device__ __forceinline__ DenseProb(const bf16_t* A_, const bf16_t* Bt_, int N, const Epi& e) : A(A_), Bt(Bt_), nM(T / BM), nN(N / BM), nwg((T / BM) * (N / BM)), G(grid_size()), c(blockIdx.x), epi(e) {}
    __device__ __forceinline__ bool next(int i, Unit& u) const {
        const long L = (long)i * G + c; if (L >= nwg) return false;
        int wgid = (int)L; { const int q = nwg / NXCD, r = nwg % NXCD, xcd = wgid % NXCD, off = wgid / NXCD; wgid = (xcd < r ? xcd * (q + 1) : r * (q + 1) + (xcd - r) * q) + off; }
        const int nig = WGM * nN, gid = wgid / nig, fm = gid * WGM, gsz = (nM - fm) < WGM ? (nM - fm) : WGM;
        u.pm = fm + ((wgid % nig) % gsz); u.pn = (wgid % nig) / gsz; return true;
    }
    __device__ __forceinline__ const char* a_base() const { return (const char*)A; }
    __device__ __forceinline__ unsigned a_off(const Unit& u, int r) const { return (unsigned)((u.pm * BM + r) * LDA) * 2u; }
    __device__ __forceinline__ const char* b_base(const Unit& u) const { return (const char*)Bt + (size_t)u.pn * BM * K * 2; }
    __device__ __forceinline__ void epilogue(const f32x4 (&acc)[2][2][4][2], const Unit& u, int wr, int wc, int fr, int fq) const {
        const int row0 = u.pm * BM + wr * 64 + fr;
        if constexpr (PERM) {
            const int col0 = u.pn * BM + wc * 32 + 8 * fq;
#pragma unroll
            for (int ai = 0; ai < 2; ++ai)
#pragma unroll
                for (int m = 0; m < 4; ++m)
#pragma unroll
                    for (int bj = 0; bj < 2; ++bj) epi(row0 + ai * HALF + m * 16, col0 + bj * HALF, acc[ai][bj][m][0], acc[ai][bj][m][1]);
        } else {
            const int col0 = u.pn * BM + wc * 32 + 4 * fq;
#pragma unroll
            for (int ai = 0; ai < 2; ++ai)
#pragma unroll
                for (int m = 0; m < 4; ++m)
#pragma unroll
                    for (int bj = 0; bj < 2; ++bj)
#pragma unroll
                        for (int n = 0; n < 2; ++n) epi(row0 + ai * HALF + m * 16, col0 + bj * HALF + n * 16, acc[ai][bj][m][n]);
        }
    }
};
}
template <int K, int LDA, bool PERM, class Epi>
__device__ __forceinline__ void ph_gemm_fast(LAS unsigned char* lds, const bf16_t* A, const bf16_t* Bt, int N, const Epi& epi) {
    const fg::DenseProb<K, LDA, Epi, PERM> pb(A, Bt, N, epi);
    fg::gemm_phase(lds, pb);
}


namespace fg {
struct MoeUnit { int e, mblk, pn, rowoff, M; };
template <bool FIRST, bool FP8_>
struct MoeProb {
    static constexpr int K = FP8_ ? 512 : 1024  , NCOL = FIRST ? 8 : 4; static constexpr bool PERM = true, FP8 = FP8_; static constexpr unsigned RB = FP8_ ? 1024u : 2048u  ;
    typedef MoeUnit Unit;
    const Params& P; int layer; const LAS int* tab;
    int G, c; mutable int e_, acc_, off_;
    __device__ __forceinline__ MoeProb(const Params& P_, int layer_, const LAS int* tab_) : P(P_), layer(layer_), tab(tab_), G(grid_size()), c(blockIdx.x), e_(0), acc_(0), off_(0) {}
    __device__ __forceinline__ bool next(int i, Unit& u) const {
        const int j = i * (G >> 3) + (c >> 3), tile = (j / NCOL) * 8 + (c & 7);
        while (e_ < 32) { const int tl = (tab[e_] + 255) >> 8; if (tile < acc_ + tl) break; acc_ += tl; off_ += tl * 256; ++e_; }
        if (e_ >= 32) return false;
        u.e = e_; u.mblk = tile - acc_; u.pn = j % NCOL; u.rowoff = off_; u.M = tab[e_]; return true;
    }
    __device__ __forceinline__ const char* a_base() const { return FIRST ? (const char*)(P.ws + (FP8_ ? WS_YMIX : WS_HB)) : (const char*)(P.ws + WS_BIG); }
    __device__ __forceinline__ unsigned a_off(const Unit& u, int r) const {
        if (FIRST) { int rr = u.mblk * 256 + r; rr = rr < u.M ? rr : u.M - 1; const int ts = ((const int*)(P.ws + WS_LIST))[(size_t)u.e * T + rr]; return (unsigned)(ts >> 2) * RB; }
        return (unsigned)(u.rowoff + u.mblk * 256 + r) * RB;
    }
    __device__ __forceinline__ const char* b_base(const Unit& u) const {
        return FIRST ? (const char*)(P.ws + WS_W1) + ((size_t)u.e * 2048 + (size_t)u.pn * 256) * RB : (const char*)(P.ws + WS_W2) + ((size_t)u.e * 1024 + (size_t)u.pn * 256) * RB;
    }
    __device__ __forceinline__ void epilogue(const f32x4 (&acc)[2][2][4][2], const Unit& u, int wr, int wc, int fr, int fq) const {
        char* ws = P.ws; const int rl0 = u.mblk * 256 + wr * 64 + fr;
        if (FIRST) {
            const float* lrs = (const float*)(ws + WS_LRS) + (size_t)u.e * T;
            bf16_t* H = (bf16_t*)(ws + WS_BIG) + (size_t)u.rowoff * 1024;
            const int hc0 = u.pn * 128 + wc * 32 + 8 * fq;
            const float* bgp = P.moe_bg + ((size_t)layer * 32 + u.e) * 1024 + hc0; const float* bup = P.moe_bu + ((size_t)layer * 32 + u.e) * 1024 + hc0;
            const f32x4 bg0 = *(const f32x4*)bgp, bg1 = *(const f32x4*)(bgp + 4), bu0 = *(const f32x4*)bup, bu1 = *(const f32x4*)(bup + 4);
            float sc[2][4];
#pragma unroll
            for (int ai = 0; ai < 2; ++ai)
#pragma unroll
                for (int m = 0; m < 4; ++m) { const int r = rl0 + ai * HALF + m * 16; sc[ai][m] = lrs[r < u.M ? r : u.M - 1]; }
#pragma unroll
            for (int ai = 0; ai < 2; ++ai)
#pragma unroll
                for (int m = 0; m < 4; ++m) { const int r = rl0 + ai * HALF + m * 16;
                    if (r < u.M) {
                        const float s_ = sc[ai][m]; const f32x4 g0 = acc[ai][0][m][0], g1 = acc[ai][0][m][1], u0 = acc[ai][1][m][0], u1 = acc[ai][1][m][1];
                        const float h0 = swiglu_(g0[0], u0[0], s_, bg0[0], bu0[0]), h1 = swiglu_(g0[1], u0[1], s_, bg0[1], bu0[1]), h2 = swiglu_(g0[2], u0[2], s_, bg0[2], bu0[2]), h3 = swiglu_(g0[3], u0[3], s_, bg0[3], bu0[3]);
                        const float h4 = swiglu_(g1[0], u1[0], s_, bg1[0], bu1[0]), h5 = swiglu_(g1[1], u1[1], s_, bg1[1], bu1[1]), h6 = swiglu_(g1[2], u1[2], s_, bg1[2], bu1[2]), h7 = swiglu_(g1[3], u1[3], s_, bg1[3], bu1[3]);
                        if constexpr (FP8_) *(uint2*)((unsigned char*)(ws + WS_BIG) + (size_t)(u.rowoff + r) * 1024 + hc0) = make_uint2(pack4_fp8(h0, h1, h2, h3), pack4_fp8(h4, h5, h6, h7));
                        else *(u32x4_t*)(H + (size_t)r * 1024 + hc0) = (u32x4_t){pack2(h0, h1), pack2(h2, h3), pack2(h4, h5), pack2(h6, h7)};
                    } }
        } else {
            const int* list = (const int*)(ws + WS_LIST) + (size_t)u.e * T; const float* lgt = (const float*)(ws + WS_LGT) + (size_t)u.e * T;
            bf16_t* Y = (bf16_t*)(ws + WS_Y);
            const int col0 = u.pn * 256 + wc * 32 + 8 * fq;
            const float* bdp = P.moe_bd + ((size_t)layer * 32 + u.e) * 1024 + col0;
            f32x4 bd[2][2];
#pragma unroll
            for (int bj = 0; bj < 2; ++bj) { bd[bj][0] = *(const f32x4*)(bdp + bj * HALF); bd[bj][1] = *(const f32x4*)(bdp + bj * HALF + 4); }
            int tsv[2][4]; float gv[2][4];
#pragma unroll
            for (int ai = 0; ai < 2; ++ai)
#pragma unroll
                for (int m = 0; m < 4; ++m) { const int r = rl0 + ai * HALF + m * 16; const int rc = r < u.M ? r : u.M - 1; tsv[ai][m] = list[rc]; gv[ai][m] = lgt[rc]; }
#pragma unroll
            for (int ai = 0; ai < 2; ++ai)
#pragma unroll
                for (int m = 0; m < 4; ++m) { const int r = rl0 + ai * HALF + m * 16;
                    if (r < u.M) {
                        const float g = gv[ai][m]; bf16_t* yr = Y + (size_t)tsv[ai][m] * 1024 + col0;
#pragma unroll
                        for (int bj = 0; bj < 2; ++bj) { const f32x4 a = (acc[ai][bj][m][0] + bd[bj][0]) * g, b = (acc[ai][bj][m][1] + bd[bj][1]) * g;
                            *(u32x4_t*)(yr + bj * HALF) = (u32x4_t){pack2(a[0], a[1]), pack2(a[2], a[3]), pack2(b[0], b[1]), pack2(b[2], b[3])}; }
                    } }
        }
    }
};
}
template <bool FIRST, bool FP8>
__device__ __forceinline__ void ph_moe_fast(const Params& P, int layer, LAS unsigned char* lds) {
    LAS int* tab = (LAS int*)(lds + fg::STAGE_BYTES);
    const int tz = opaque_tid();
    if (tz < 32) tab[tz] = (int)((const unsigned*)(P.ws + WS_CTL))[CTL_CNT + layer * 32 + tz];
    __syncthreads();
    const fg::MoeProb<FIRST, FP8> pb(P, layer, tab);
    fg::gemm_phase(lds, pb);
}

template <class Epi>
__device__ __forceinline__ void ph_gemm_dense(const bf16_t* A, int lda, const bf16_t* Bt, int N, int K, const Epi& epi) {
    const int ncol = N / 128, nunits = (T / 256) * ncol;
    for (int u = blockIdx.x; u < nunits; u += grid_size()) gemm_simple_unit<Epi, false>(A, lda, nullptr, Bt, K, T, K, u / ncol, u % ncol, epi);
}
__device__ __forceinline__ bool moe_decode(const unsigned* cnt, int ncol, int u, int& e, int& mblk, int& nblk, int& rowoff) {
    int acc = 0, off = 0;
    for (int i = 0; i < 32; ++i) {
        const int tl = ((int)cnt[i] + 255) >> 8;
        if (u < (acc + tl) * ncol) { e = i; const int local = u - acc * ncol; mblk = local / ncol; nblk = local % ncol; rowoff = off; return true; }
        acc += tl; off += tl * 256;
    }
    return false;
}
__device__ __forceinline__ void ph_moe1(const Params& P, int layer) {
    char* ws = P.ws; const unsigned* cnt = (const unsigned*)(ws + WS_CTL) + CTL_CNT + layer * 32;
    for (int u = blockIdx.x;; u += grid_size()) {
        int e, mblk, nblk, off; if (!moe_decode(cnt, 16, u, e, mblk, nblk, off)) break;
        const int* list = (const int*)(ws + WS_LIST) + (size_t)e * T;
        EpiMoe1 ep{list, (const float*)(ws + WS_RSTD) + T, P.moe_bg + ((size_t)layer * 32 + e) * 1024, P.moe_bu + ((size_t)layer * 32 + e) * 1024, (bf16_t*)(ws + WS_BIG) + (size_t)off * 1024};
        gemm_simple_unit<EpiMoe1, true>((const bf16_t*)(ws + WS_HB), 1024, list, (const bf16_t*)(ws + WS_W1) + (size_t)e * 2048 * 1024, 1024, (int)cnt[e], 1024, mblk, nblk, ep);
    }
}
__device__ __forceinline__ void ph_moe2(const Params& P, int layer) {
    char* ws = P.ws; const unsigned* cnt = (const unsigned*)(ws + WS_CTL) + CTL_CNT + layer * 32;
    for (int u = blockIdx.x;; u += grid_size()) {
        int e, mblk, nblk, off; if (!moe_decode(cnt, 8, u, e, mblk, nblk, off)) break;
        const int* list = (const int*)(ws + WS_LIST) + (size_t)e * T;
        EpiMoe2 ep{list, (const float*)(ws + WS_TOPG), P.moe_bd + ((size_t)layer * 32 + e) * 1024, (bf16_t*)(ws + WS_Y)};
        gemm_simple_unit<EpiMoe2, false>((const bf16_t*)(ws + WS_BIG) + (size_t)off * 1024, 1024, nullptr, (const bf16_t*)(ws + WS_W2) + (size_t)e * 1024 * 1024, 1024, (int)cnt[e], 1024, mblk, nblk, ep);
    }
}

__device__ __forceinline__ void ph_attn_simple(const Params& P, unsigned char* lds) {
    float (*qs)[96] = (float (*)[96])lds; float (*ps)[64] = (float (*)[64])(lds + 8 * 96 * 4);
    const int tid = opaque_tid(), wid = tid >> 6, lane = tid & 63;
    const bf16_t* Q = (const bf16_t*)(P.ws + WS_BIG + BIG_Q); const bf16_t* Kd = (const bf16_t*)(P.ws + WS_BIG + BIG_K); const bf16_t* KV = (const bf16_t*)(P.ws + WS_BIG + BIG_KV);
    bf16_t* YM = (bf16_t*)(P.ws + WS_YMIX);
    for (int u = blockIdx.x; u < T; u += grid_size()) {
        const long gw = (long)u * 8 + wid;
        const int s = (int)(gw & 4095), bh = (int)(gw >> 12), b = bh >> 3, h = bh & 7;
        const long t = (long)b * SEQ + s;
        __syncthreads();
        qs[wid][lane] = bf2f(Q[t * 768 + h * 96 + lane]);
        if (lane < 32) qs[wid][64 + lane] = bf2f(Q[t * 768 + h * 96 + 64 + lane]);
        __syncthreads();
        float m = -INFINITY, l = 0.f, o = 0.f;
        for (int j0 = 0; j0 <= s; j0 += 64) {
            const int j = j0 + lane; const bool valid = j <= s;
            const long kt = (long)b * SEQ + (valid ? j : s);
            const uint4* kr = (const uint4*)(Kd + (kt * 8 + h) * 96);
            float sc = 0.f;
#pragma unroll
            for (int c = 0; c < 12; ++c) {
                const uint4 kk = kr[c];
                sc += qs[wid][c * 8 + 0] * bf2f(kk.x & 0xffff) + qs[wid][c * 8 + 1] * bf2f(kk.x >> 16) + qs[wid][c * 8 + 2] * bf2f(kk.y & 0xffff) + qs[wid][c * 8 + 3] * bf2f(kk.y >> 16)
                    + qs[wid][c * 8 + 4] * bf2f(kk.z & 0xffff) + qs[wid][c * 8 + 5] * bf2f(kk.z >> 16) + qs[wid][c * 8 + 6] * bf2f(kk.w & 0xffff) + qs[wid][c * 8 + 7] * bf2f(kk.w >> 16);
            }
            sc = valid ? sc : -INFINITY;
            const float mn = fmaxf(m, wave_max(sc));
            const float pj = valid ? __expf(sc - mn) : 0.f;
            const float f = __expf(m - mn);
            l = l * f + wave_sum(pj); o *= f; m = mn;
            __syncthreads();
            ps[wid][lane] = pj;
            __syncthreads();
            const bf16_t* vb = KV + ((long)b * SEQ + j0) * 1024 + h * 128 + 64 + lane;
#pragma unroll 8
            for (int jj = 0; jj < 64; ++jj) o += ps[wid][jj] * bf2f(vb[(long)jj * 1024]);
        }
        YM[t * 1024 + 256 + h * 64 + lane] = f2bf(o / l);
    }
}


namespace at {
typedef short s16x4 __attribute__((ext_vector_type(4)));
constexpr int KSLOT = 12288, VSLOT = 8192, NSLOT = 3, LDS_K = 0, LDS_V = NSLOT * KSLOT, LDS_END = LDS_V + NSLOT * VSLOT;
typedef float f32x2_t __attribute__((ext_vector_type(2))); typedef __bf16 bf16x2_t __attribute__((ext_vector_type(2)));
__device__ __forceinline__ unsigned cvtpk(float lo, float hi) { const f32x2_t v = {lo, hi}; const bf16x2_t b = __builtin_convertvector(v, bf16x2_t); return __builtin_bit_cast(unsigned, b); }
__device__ __forceinline__ void glds16(const void* gsrc, unsigned lds_dst) { unsigned keep;
    asm volatile("s_mov_b32 %0, m0\n\ts_mov_b32 m0, %2\n\ts_nop 0\n\tglobal_load_lds_dwordx4 %1, off\n\ts_mov_b32 m0, %0" : "=&s"(keep) : "v"(gsrc), "s"(lds_dst) : "memory"); }
__device__ __forceinline__ s16x4 vtr(const LAS unsigned char* p) { return __builtin_bit_cast(s16x4, __builtin_amdgcn_ds_read_tr16_b64_v4i16((LAS s16x4*)p)); }

__device__ __forceinline__ void attn_unit(int b, int h, int qb, const bf16_t* Q, const bf16_t* Kd, const bf16_t* KV, bf16_t* YM, LAS unsigned char* lds) {
    const int tid = opaque_tid(); const int lane = tid & 63, r32 = lane & 31, hi = lane >> 5; const int wid = __builtin_amdgcn_readfirstlane(tid >> 6);
    const int q0 = qb * 256; const size_t row = (size_t)b * SEQ + q0 + wid * 32 + r32;
    const int NT = 4 * qb + 4;
    const char* ksrcA = (const char*)(Kd + (((size_t)b * SEQ + lane) * 8 + h) * 96) + wid * 16;
    const char* ksrcB = (const char*)(Kd + (((size_t)b * SEQ + lane) * 8 + h) * 96) + (8 + (wid & 3)) * 16;
    const char* vsrc = (const char*)(KV + ((size_t)b * SEQ + 16 * (wid & 3) + (lane >> 2)) * 1024 + h * 128 + 64 + (wid >> 2) * 32 + (lane & 3) * 8);
    const unsigned lds0 = (unsigned)(size_t)lds;
#define AT_DMA(j, slot) do { \
        glds16(ksrcA + (size_t)(j) * (64 * 1536), (unsigned)__builtin_amdgcn_readfirstlane((int)(lds0 + LDS_K + (slot) * KSLOT + wid * 1024))); \
        glds16(ksrcB + (size_t)(j) * (64 * 1536), (unsigned)__builtin_amdgcn_readfirstlane((int)(lds0 + LDS_K + (slot) * KSLOT + (8 + (wid & 3)) * 1024))); \
        glds16(vsrc + (size_t)(j) * (64 * 2048), (unsigned)__builtin_amdgcn_readfirstlane((int)(lds0 + LDS_V + (slot) * VSLOT + wid * 1024))); } while (0)
    AT_DMA(0, 0); AT_DMA(1, 1);
    bf16x8 qf[6];
#pragma unroll
    for (int ks = 0; ks < 6; ++ks) qf[ks] = *(const bf16x8*)(Q + row * 768 + h * 96 + ks * 16 + hi * 8);
    asm volatile("" : "+v"(qf[0]), "+v"(qf[1]), "+v"(qf[2]), "+v"(qf[3]), "+v"(qf[4]), "+v"(qf[5]));
    constexpr float THR = 8.0f;
    float mref = 0.f, l = 0.f;
    f32x16 o0, o1, negm;
#pragma unroll
    for (int r = 0; r < 16; ++r) { o0[r] = 0.f; o1[r] = 0.f; negm[r] = 0.f; }
    const int kfo = hi * 1024 + r32 * 16;
    const int vfo = ((lane >> 4) & 1) * 32 + (lane & 3) * 8 + (4 * hi + ((lane & 15) >> 2)) * 64;
    const int qrel = wid * 32 + r32;
    int slot = 0;
    for (int j = 0; j < NT; ++j) {
        if (j + 1 < NT) asm volatile("s_waitcnt vmcnt(3)\n\ts_barrier" ::: "memory"); else asm volatile("s_waitcnt vmcnt(0)\n\ts_barrier" ::: "memory");
        if (j + 2 < NT) { const int s2 = (slot == 0) ? 2 : slot - 1; AT_DMA(j + 2, s2); }
        const LAS unsigned char* kp = lds + LDS_K + slot * KSLOT + kfo;
        const LAS unsigned char* vp = lds + LDS_V + slot * VSLOT + vfo;
        f32x16 s0, s1;
#pragma unroll
        for (int ks = 0; ks < 6; ++ks) {
            const bf16x8 k0 = *(const LAS bf16x8*)(kp + ks * 2048), k1 = *(const LAS bf16x8*)(kp + ks * 2048 + 512);
            s0 = __builtin_amdgcn_mfma_f32_32x32x16_bf16(k0, qf[ks], ks == 0 ? negm : s0, 0, 0, 0);
            s1 = __builtin_amdgcn_mfma_f32_32x32x16_bf16(k1, qf[ks], ks == 0 ? negm : s1, 0, 0, 0);
        }
        if (j >= NT - 4) {
            const int kb = 64 * (j - (NT - 4)) + 4 * hi;
#pragma unroll
            for (int r = 0; r < 16; ++r) { const int kv = kb + (r & 3) + 8 * (r >> 2); if (kv > qrel) s0[r] = -INFINITY; if (kv + 32 > qrel) s1[r] = -INFINITY; }
        }
        float rm = fmaxf(fmaxf(s0[0], s1[0]), fmaxf(s0[1], s1[1]));
#pragma unroll
        for (int r = 2; r < 16; r += 2) rm = fmaxf(rm, fmaxf(fmaxf(s0[r], s1[r]), fmaxf(s0[r + 1], s1[r + 1])));
        rm = xhalf_max(rm);
        if (__any(rm > THR)) {
            const float dl = fmaxf(rm, 0.f);
            mref += dl;
#pragma unroll
            for (int r = 0; r < 16; ++r) { s0[r] -= dl; s1[r] -= dl; negm[r] = -mref; }
            const float f = __builtin_amdgcn_exp2f(-dl);
            l *= f;
#pragma unroll
            for (int r = 0; r < 16; ++r) { o0[r] *= f; o1[r] *= f; }
        }
        float ps0 = 0.f, ps1 = 0.f;
#pragma unroll
        for (int r = 0; r < 16; ++r) { s0[r] = __builtin_amdgcn_exp2f(s0[r]); s1[r] = __builtin_amdgcn_exp2f(s1[r]); ps0 += s0[r]; ps1 += s1[r]; }
        l += ps0 + ps1;
        bf16x8 pf[4];
        {
            unsigned w[16];
#pragma unroll
            for (int i = 0; i < 8; ++i) { w[i] = cvtpk(s0[2 * i], s0[2 * i + 1]); w[8 + i] = cvtpk(s1[2 * i], s1[2 * i + 1]); }
#pragma unroll
            for (int k = 0; k < 4; ++k) { typedef unsigned u32x4 __attribute__((ext_vector_type(4))); const u32x4 t = {w[4 * k], w[4 * k + 1], w[4 * k + 2], w[4 * k + 3]}; pf[k] = __builtin_bit_cast(bf16x8, t); }
        }
#pragma unroll
        for (int k = 0; k < 4; ++k) {
            const s16x4 a0 = vtr(vp + k * 1024), a1 = vtr(vp + k * 1024 + 512), c0 = vtr(vp + 4096 + k * 1024), c1 = vtr(vp + 4096 + k * 1024 + 512);
            const bf16x8 v0 = {a0[0], a0[1], a0[2], a0[3], a1[0], a1[1], a1[2], a1[3]}, v1 = {c0[0], c0[1], c0[2], c0[3], c1[0], c1[1], c1[2], c1[3]};
            o0 = __builtin_amdgcn_mfma_f32_32x32x16_bf16(v0, pf[k], o0, 0, 0, 0);
            o1 = __builtin_amdgcn_mfma_f32_32x32x16_bf16(v1, pf[k], o1, 0, 0, 0);
        }
        slot = (slot == 2) ? 0 : slot + 1;
    }
    l = xhalf_sum(l);
    const float rl = 1.0f / l;
    bf16_t* op = YM + row * 1024 + 256 + h * 64 + 4 * hi;
#pragma unroll
    for (int g = 0; g < 4; ++g) {
        *(uint2*)(op + 8 * g) = make_uint2(cvtpk(o0[4 * g] * rl, o0[4 * g + 1] * rl), cvtpk(o0[4 * g + 2] * rl, o0[4 * g + 3] * rl));
        *(uint2*)(op + 32 + 8 * g) = make_uint2(cvtpk(o1[4 * g] * rl, o1[4 * g + 1] * rl), cvtpk(o1[4 * g + 2] * rl, o1[4 * g + 3] * rl));
    }
    asm volatile("s_waitcnt lgkmcnt(0)\n\ts_barrier" ::: "memory");
#undef AT_DMA
}
}
__device__ __forceinline__ void ph_attn_fast(const Params& P, LAS unsigned char* lds) {
    const bf16_t* Q = (const bf16_t*)(P.ws + WS_BIG + BIG_Q); const bf16_t* Kd = (const bf16_t*)(P.ws + WS_BIG + BIG_K); const bf16_t* KV = (const bf16_t*)(P.ws + WS_BIG + BIG_KV);
    bf16_t* YM = (bf16_t*)(P.ws + WS_YMIX);
    const int G = grid_size();
    for (int v0 = (blockIdx.x % 8) * (G / 8) + blockIdx.x / 8; v0 < 256; v0 += G) {
        const int bh = v0 >> 2, s = v0 & 3;
#pragma unroll 1
        for (int i = 0; i < 4; ++i) { const int qb = (i == 0) ? s : (i == 1) ? 7 - s : (i == 2) ? 8 + s : 15 - s; at::attn_unit(bh >> 3, bh & 7, qb, Q, Kd, KV, YM, lds); }
    }
}


template <bool DRY = false> __device__ __forceinline__ void ph_gla_x(const Params& P, LAS unsigned char* lds) {
    const int tid = opaque_tid(); const int wid = __builtin_amdgcn_readfirstlane(tid >> 6), lane = tid & 63;
    LAS float* kend = (LAS float*)(lds + wid * 8192);
    const bf16_t* Z = (const bf16_t*)(P.ws + WS_BIG + BIG_Z); float* LA = (float*)(P.ws + WS_BIG + BIG_LA);
    float* UPD = DRY ? (float*)(P.ws + WS_Y + 32 * MiB) : (float*)(P.ws + WS_UPD); float* DEC = DRY ? (float*)(P.ws + WS_Y + 64 * MiB) : (float*)(P.ws + WS_DEC); float* LAW = DRY ? (float*)(P.ws + WS_Y) : LA;
    for (int u = blockIdx.x * NWV + wid; u < 2048; u += grid_size() * NWV) {
        const int bh = u >> 6, n = u & 63, b = bh >> 2, h = bh & 3;
        const size_t t0 = (size_t)b * SEQ + n * 64;
        const int k = lane & 31, half = lane >> 5;
        float c[32]; float run = 0.f;
#pragma unroll
        for (int i = 0; i < 32; ++i) { run += LA[(t0 + 32 * half + i) * 128 + h * 32 + k]; c[i] = run; }
        const float tot0 = __shfl(run, k);
        const float add = half ? tot0 : 0.f;
        const float blast = __shfl(run, 32 + k) + tot0;
#pragma unroll
        for (int i = 0; i < 32; ++i) {
            const float bc = c[i] + add; const size_t t = t0 + 32 * half + i;
            LAW[t * 128 + h * 32 + k] = bc;
            kend[(32 * half + i) * 32 + k] = bf2f(Z[t * ZW + ZC_GK + h * 32 + k]) * __expf(blast - bc);
        }
        if (half == 0) DEC[(size_t)u * 32 + k] = __expf(blast);
        asm volatile("s_waitcnt lgkmcnt(0)" ::: "memory");
        float acc[32];
#pragma unroll
        for (int i = 0; i < 32; ++i) acc[i] = 0.f;
#pragma unroll 4
        for (int j = 0; j < 64; ++j) {
            const float vj = bf2f(Z[(t0 + j) * ZW + ZC_GV + h * 64 + lane]);
#pragma unroll
            for (int kq = 0; kq < 8; ++kq) { const f32x4 ke = *(const LAS f32x4*)(kend + j * 32 + kq * 4); acc[4 * kq] += ke[0] * vj; acc[4 * kq + 1] += ke[1] * vj; acc[4 * kq + 2] += ke[2] * vj; acc[4 * kq + 3] += ke[3] * vj; }
        }
#pragma unroll
        for (int kk = 0; kk < 32; ++kk) UPD[((size_t)u * 32 + kk) * 64 + lane] = acc[kk];
        asm volatile("s_waitcnt lgkmcnt(0)" ::: "memory");
    }
}
__device__ __forceinline__ void ph_gla_scan(const Params& P) {
    const int tz = opaque_tid();
    const float* UPD = (const float*)(P.ws + WS_UPD); const float* DEC = (const float*)(P.ws + WS_DEC); bf16_t* SP = (bf16_t*)(P.ws + WS_SPREV);
    for (int e = blockIdx.x * NTHR + tz; e < 32 * 2048; e += grid_size() * NTHR) {
        const int bh = e >> 11, kv = e & 2047, k = kv >> 6;
        float st = 0.f;
#pragma unroll 8
        for (int n = 0; n < 64; ++n) {
            const size_t u = (size_t)bh * 64 + n;
            SP[u * 2048 + kv] = f2bf(st);
            st = DEC[u * 32 + k] * st + UPD[u * 2048 + kv];
        }
    }
}
__device__ __forceinline__ void ph_gla_y(const Params& P, int layer, LAS unsigned char* lds) {
    using at::f32x16; using at::s16x4; using at::vtr; using at::cvtpk;
    typedef unsigned u32x4 __attribute__((ext_vector_type(4)));
    const int tid = opaque_tid(); const int wid = __builtin_amdgcn_readfirstlane(tid >> 6), lane = tid & 63, r32 = lane & 31, hi = lane >> 5;
    LAS unsigned char* vl = lds + wid * 12288; LAS unsigned char* sl = vl + 8192;
    const bf16_t* Z = (const bf16_t*)(P.ws + WS_BIG + BIG_Z); const float* LA = (const float*)(P.ws + WS_BIG + BIG_LA); const bf16_t* SP = (const bf16_t*)(P.ws + WS_SPREV);
    bf16_t* YM = (bf16_t*)(P.ws + WS_YMIX); const float* gon = P.gla_on + layer * 64;
    const int vfo = ((lane >> 4) & 1) * 32 + (lane & 3) * 8 + (4 * hi + ((lane & 15) >> 2)) * 64;
    const int sfo = ((lane >> 4) & 1) * 32 + (lane & 3) * 8 + ((lane & 15) >> 2) * 64;
    for (int u = blockIdx.x * NWV + wid; u < 2048; u += grid_size() * NWV) {
        const int bh = u >> 6, n = u & 63, b = bh >> 2, h = bh & 3;
        const size_t t0 = (size_t)b * SEQ + n * 64;
#pragma unroll
        for (int p = 0; p < 8; ++p) {
            const int row = 8 * p + (lane >> 3), dv = 8 * (lane & 7);
            const u32x4 x = *(const u32x4*)(Z + (t0 + row) * ZW + ZC_GV + h * 64 + dv);
            *(LAS u32x4*)(vl + (dv >> 5) * 4096 + (row >> 3) * 512 + (row & 7) * 64 + (dv & 31) * 2) = x;
        }
#pragma unroll
        for (int p = 0; p < 4; ++p) {
            const int row = 8 * p + (lane >> 3), dv = 8 * (lane & 7);
            const u32x4 x = *(const u32x4*)(SP + ((size_t)u * 32 + row) * 64 + dv);
            *(LAS u32x4*)(sl + (dv >> 5) * 2048 + (row >> 3) * 512 + (row & 7) * 64 + (dv & 31) * 2) = x;
        }
        bf16x8 qfr[2][2], kfr[2][2];
#pragma unroll
        for (int blk = 0; blk < 2; ++blk)
#pragma unroll
            for (int ks = 0; ks < 2; ++ks) {
                const size_t t = t0 + 32 * blk + r32; const int k0 = 16 * ks + 8 * hi;
                const uint4 qraw = *(const uint4*)(Z + t * ZW + ZC_GQ + h * 32 + k0), kraw = *(const uint4*)(Z + t * ZW + ZC_GK + h * 32 + k0);
                const f32x4 b0 = *(const f32x4*)(LA + t * 128 + h * 32 + k0), b1 = *(const f32x4*)(LA + t * 128 + h * 32 + k0 + 4);
                const unsigned qw[4] = {qraw.x, qraw.y, qraw.z, qraw.w}, kw[4] = {kraw.x, kraw.y, kraw.z, kraw.w};
                const float bcv[8] = {b0[0], b0[1], b0[2], b0[3], b1[0], b1[1], b1[2], b1[3]};
                u32x4 qo, ko;
#pragma unroll
                for (int w = 0; w < 4; ++w) {
                    const float e0 = __expf(bcv[2 * w]), e1 = __expf(bcv[2 * w + 1]);
                    const float q0 = bf2f(qw[w] & 0xffff) * 0.17677669529663687f * e0, q1 = bf2f(qw[w] >> 16) * 0.17677669529663687f * e1;
                    const float k0f = bf2f(kw[w] & 0xffff) * __expf(-bcv[2 * w]), k1f = bf2f(kw[w] >> 16) * __expf(-bcv[2 * w + 1]);
                    qo[w] = cvtpk(q0, q1); ko[w] = cvtpk(k0f, k1f);
                }
                qfr[blk][ks] = __builtin_bit_cast(bf16x8, qo); kfr[blk][ks] = __builtin_bit_cast(bf16x8, ko);
            }
        f32x16 z16;
#pragma unroll
        for (int r = 0; r < 16; ++r) z16[r] = 0.f;
        f32x16 s00 = __builtin_amdgcn_mfma_f32_32x32x16_bf16(kfr[0][0], qfr[0][0], z16, 0, 0, 0); s00 = __builtin_amdgcn_mfma_f32_32x32x16_bf16(kfr[0][1], qfr[0][1], s00, 0, 0, 0);
        f32x16 s01 = __builtin_amdgcn_mfma_f32_32x32x16_bf16(kfr[0][0], qfr[1][0], z16, 0, 0, 0); s01 = __builtin_amdgcn_mfma_f32_32x32x16_bf16(kfr[0][1], qfr[1][1], s01, 0, 0, 0);
        f32x16 s11 = __builtin_amdgcn_mfma_f32_32x32x16_bf16(kfr[1][0], qfr[1][0], z16, 0, 0, 0); s11 = __builtin_amdgcn_mfma_f32_32x32x16_bf16(kfr[1][1], qfr[1][1], s11, 0, 0, 0);
#pragma unroll
        for (int r = 0; r < 16; ++r) { const int jl = (r & 3) + 8 * (r >> 2) + 4 * hi; if (jl > r32) { s00[r] = 0.f; s11[r] = 0.f; } }
        bf16x8 p00[2], p01[2], p11[2];
#pragma unroll
        for (int sp = 0; sp < 2; ++sp) {
            u32x4 a, c, d;
#pragma unroll
            for (int w = 0; w < 4; ++w) { a[w] = cvtpk(s00[8 * sp + 2 * w], s00[8 * sp + 2 * w + 1]); c[w] = cvtpk(s01[8 * sp + 2 * w], s01[8 * sp + 2 * w + 1]); d[w] = cvtpk(s11[8 * sp + 2 * w], s11[8 * sp + 2 * w + 1]); }
            p00[sp] = __builtin_bit_cast(bf16x8, a); p01[sp] = __builtin_bit_cast(bf16x8, c); p11[sp] = __builtin_bit_cast(bf16x8, d);
        }
        asm volatile("s_waitcnt lgkmcnt(0)" ::: "memory");
        f32x16 o[2][2];
#pragma unroll
        for (int vb = 0; vb < 2; ++vb) {
            o[vb][0] = z16; o[vb][1] = z16;
#pragma unroll
            for (int k2 = 0; k2 < 4; ++k2) {
                const s16x4 a0 = vtr(vl + vfo + vb * 4096 + k2 * 1024), a1 = vtr(vl + vfo + vb * 4096 + k2 * 1024 + 512);
                const bf16x8 vt = {a0[0], a0[1], a0[2], a0[3], a1[0], a1[1], a1[2], a1[3]};
                if (k2 < 2) { o[vb][0] = __builtin_amdgcn_mfma_f32_32x32x16_bf16(vt, p00[k2], o[vb][0], 0, 0, 0); o[vb][1] = __builtin_amdgcn_mfma_f32_32x32x16_bf16(vt, p01[k2], o[vb][1], 0, 0, 0); }
                else o[vb][1] = __builtin_amdgcn_mfma_f32_32x32x16_bf16(vt, p11[k2 - 2], o[vb][1], 0, 0, 0);
            }
#pragma unroll
            for (int ks = 0; ks < 2; ++ks) {
                const s16x4 a0 = vtr(sl + sfo + vb * 2048 + (2 * ks + hi) * 512), a1 = vtr(sl + sfo + vb * 2048 + (2 * ks + hi) * 512 + 256);
                const bf16x8 st = {a0[0], a0[1], a0[2], a0[3], a1[0], a1[1], a1[2], a1[3]};
                o[vb][0] = __builtin_amdgcn_mfma_f32_32x32x16_bf16(st, qfr[0][ks], o[vb][0], 0, 0, 0);
                o[vb][1] = __builtin_amdgcn_mfma_f32_32x32x16_bf16(st, qfr[1][ks], o[vb][1], 0, 0, 0);
            }
        }
#pragma unroll
        for (int ib = 0; ib < 2; ++ib) {
            const size_t t = t0 + 32 * ib + r32;
            float ss = 0.f;
#pragma unroll
            for (int r = 0; r < 16; ++r) ss += o[0][ib][r] * o[0][ib][r] + o[1][ib][r] * o[1][ib][r];
            ss = at::xhalf_sum(ss);
            const float rstd = rsqrtf(ss * (1.0f / 64.0f) + EPS);
#pragma unroll
            for (int vb = 0; vb < 2; ++vb)
#pragma unroll
                for (int g = 0; g < 4; ++g) {
                    const int v0 = 32 * vb + 8 * g + 4 * hi;
                    const uint2 rr = *(const uint2*)(Z + t * ZW + ZC_GR + h * 64 + v0); const f32x4 gn = *(const f32x4*)(gon + v0);
                    const float r0 = bf2f(rr.x & 0xffff), r1 = bf2f(rr.x >> 16), r2 = bf2f(rr.y & 0xffff), r3 = bf2f(rr.y >> 16);
                    const float y0 = o[vb][ib][4 * g] * rstd * gn[0] * r0 * sigmoidf_(r0), y1 = o[vb][ib][4 * g + 1] * rstd * gn[1] * r1 * sigmoidf_(r1);
                    const float y2 = o[vb][ib][4 * g + 2] * rstd * gn[2] * r2 * sigmoidf_(r2), y3 = o[vb][ib][4 * g + 3] * rstd * gn[3] * r3 * sigmoidf_(r3);
                    *(uint2*)(YM + t * 1024 + h * 64 + v0) = make_uint2(cvtpk(y0, y1), cvtpk(y2, y3));
                }
        }
        asm volatile("s_waitcnt lgkmcnt(0)" ::: "memory");
    }
}

__device__ __forceinline__ void ph_gla_simple(const Params& P, int layer, unsigned char* lds) {
    if (blockIdx.x >= 4) return;
    const int tz = opaque_tid(); const int wid = tz >> 6, lane = tz & 63;
    float (*sq)[32] = (float (*)[32])(lds + wid * 3072), (*sk)[32] = (float (*)[32])(lds + wid * 3072 + 1024), (*sa)[32] = (float (*)[32])(lds + wid * 3072 + 2048);
    const int bh = blockIdx.x * 8 + wid, b = bh >> 2, h = bh & 3;
    const bf16_t* Z = (const bf16_t*)(P.ws + WS_BIG + BIG_Z); const float* LA = (const float*)(P.ws + WS_BIG + BIG_LA); bf16_t* YM = (bf16_t*)(P.ws + WS_YMIX);
    const float g = P.gla_on[layer * 64 + lane];
    float st[32];
#pragma unroll
    for (int k = 0; k < 32; ++k) st[k] = 0.f;
    for (int c0 = 0; c0 < SEQ; c0 += 8) {
#pragma unroll
        for (int i = 0; i < 4; ++i) {
            const int idx = lane + 64 * i, sp = idx >> 5, k = idx & 31; const size_t t = (size_t)b * SEQ + c0 + sp;
            sq[sp][k] = bf2f(Z[t * ZW + ZC_GQ + h * 32 + k]) * 0.17677669529663687f;
            sk[sp][k] = bf2f(Z[t * ZW + ZC_GK + h * 32 + k]);
            sa[sp][k] = __expf(LA[t * 128 + h * 32 + k]);
        }
        float v[8], r[8];
#pragma unroll
        for (int sp = 0; sp < 8; ++sp) { const size_t t = (size_t)b * SEQ + c0 + sp; v[sp] = bf2f(Z[t * ZW + ZC_GV + h * 64 + lane]); r[sp] = bf2f(Z[t * ZW + ZC_GR + h * 64 + lane]); }
        __syncthreads();
#pragma unroll
        for (int sp = 0; sp < 8; ++sp) {
            float o = 0.f;
#pragma unroll
            for (int k = 0; k < 32; ++k) { st[k] = sa[sp][k] * st[k] + sk[sp][k] * v[sp]; o += sq[sp][k] * st[k]; }
            const float ss = wave_sum(o * o);
            const float on = o * rsqrtf(ss * (1.0f / 64.0f) + EPS) * g;
            const float rr = r[sp];
            YM[((size_t)b * SEQ + c0 + sp) * 1024 + h * 64 + lane] = f2bf(on * rr * sigmoidf_(rr));
        }
        __syncthreads();
    }
}

template <int L> __device__ __forceinline__ void layer_body(const Params& P, const XcdBarrier& bar, unsigned char* lds) {
    constexpr int l = L; char* ws = P.ws; LAS unsigned char* ldsl = (LAS unsigned char*)lds;
    const bf16_t* HB = (const bf16_t*)(ws + WS_HB); const float* RS = (const float*)(ws + WS_RSTD);
    bf16_t* Z = (bf16_t*)(ws + WS_BIG + BIG_Z);
    {
        const char* wsm = ws + WS_WSM + (size_t)l * WSM_STRIDE;
        { EpiBf16_8 e{(bf16_t*)(ws + WS_E), 1024}; ph_gemm_fast<256, 256, true>(ldsl, (const bf16_t*)(ws + WS_PB) + (size_t)l * T * 256, (const bf16_t*)(wsm + WSM_WPLE), 1024, e); }
#ifdef DBL_SHORTK
        { EpiBf16_8 e{(bf16_t*)(ws + WS_E), 1024}; ph_gemm_fast<256, 256, true>(ldsl, (const bf16_t*)(ws + WS_PB) + (size_t)l * T * 256, (const bf16_t*)(wsm + WSM_WPLE), 1024, e); }
#endif
        { EpiZ8 e{Z, RS}; ph_gemm_fast<1024, 1024, true>(ldsl, HB, (const bf16_t*)(wsm + WSM_WIN), ZW, e); }
#ifdef DBL_Z
        { EpiZ8 e{Z, RS}; ph_gemm_fast<1024, 1024, true>(ldsl, HB, (const bf16_t*)(wsm + WSM_WIN), ZW, e); }
#endif
        xcd_barrier(bar);
        ph_prepB(P, l, lds);
#ifdef DBL_PREPB
        __syncthreads(); ph_prepB(P, l, lds);
#endif
        xcd_barrier(bar);
        { EpiBf16_8 e{(bf16_t*)(ws + WS_BIG + BIG_Q), 768}; ph_gemm_fast<256, ZW, true>(ldsl, Z + ZC_CQ, (const bf16_t*)(wsm + WSM_WUQ), 768, e); }
        { EpiBf16_8 e{(bf16_t*)(ws + WS_BIG + BIG_KV), 1024}; ph_gemm_fast<128, ZW, true>(ldsl, Z + ZC_CKV, (const bf16_t*)(wsm + WSM_WUKV), 1024, e); }
#ifdef DBL_SHORTK
        { EpiBf16_8 e{(bf16_t*)(ws + WS_BIG + BIG_Q), 768}; ph_gemm_fast<256, ZW, true>(ldsl, Z + ZC_CQ, (const bf16_t*)(wsm + WSM_WUQ), 768, e); }
        { EpiBf16_8 e{(bf16_t*)(ws + WS_BIG + BIG_KV), 1024}; ph_gemm_fast<128, ZW, true>(ldsl, Z + ZC_CKV, (const bf16_t*)(wsm + WSM_WUKV), 1024, e); }
#endif
        __syncthreads();
        ph_gla_x(P, ldsl);
#ifdef DBL_GLAX
        ph_gla_x<true>(P, ldsl);
#endif
        xcd_barrier(bar);
        ph_prepD(P, l);
#ifdef DBL_PREPD
        ph_prepD<true>(P, l);
#endif
        ph_gla_scan(P);
#ifdef DBL_SCAN
        ph_gla_scan(P);
#endif
        xcd_barrier(bar);
        if ((blockIdx.x >> 3) & 1) { ph_tconv_exp<(L == 0 ? MOE_FP8_L0 : MOE_FP8_L1)>(P, l, ldsl); }
        ph_attn_fast(P, ldsl);
#ifdef DBL_ATTN
        ph_attn_fast(P, ldsl);
#endif
        ph_gla_y(P, l, ldsl);
        if (!((blockIdx.x >> 3) & 1)) { __syncthreads(); ph_tconv_exp<(L == 0 ? MOE_FP8_L0 : MOE_FP8_L1)>(P, l, ldsl); }
#ifdef DBL_GLAY
        ph_gla_y(P, l, ldsl);
#endif
        xcd_barrier(bar);
        { EpiResid8 e{l == 0 ? P.x : nullptr, (bf16_t*)(ws + WS_HB)}; ph_gemm_fast<1024, 1024, true>(ldsl, (const bf16_t*)(ws + WS_YMIX), (const bf16_t*)(wsm + WSM_WOUT), 1024, e); }
        xcd_barrier(bar);
        ph_router<(L == 0 ? MOE_FP8_L0 : MOE_FP8_L1)>(P, l, ldsl);
        xcd_barrier(bar);
        ph_moe_fast<true, (L == 0 ? MOE_FP8_L0 : MOE_FP8_L1)>(P, l, ldsl);
#ifdef DBL_MOE1
        __syncthreads(); ph_moe_fast<true, (L == 0 ? MOE_FP8_L0 : MOE_FP8_L1)>(P, l, ldsl);
#endif
        xcd_barrier(bar);
        ph_moe_fast<false, (L == 0 ? MOE_FP8_L0 : MOE_FP8_L1)>(P, l, ldsl);
#ifdef DBL_MOE2
        __syncthreads(); ph_moe_fast<false, (L == 0 ? MOE_FP8_L0 : MOE_FP8_L1)>(P, l, ldsl);
#endif
        xcd_barrier(bar);
        ph_combine(P);
#ifdef DBL_COMBINE
        ph_combine<true>(P);
#endif
        xcd_barrier(bar);
        { EpiPle8 e{(const bf16_t*)(ws + WS_E), RS + 2 * T, (bf16_t*)(ws + WS_YMIX)}; ph_gemm_fast<1024, 1024, true>(ldsl, HB, (const bf16_t*)(wsm + WSM_WPG), 1024, e); }
#ifdef DBL_PLE
        { EpiPle8 e{(const bf16_t*)(ws + WS_E), RS + 2 * T, (bf16_t*)(ws + WS_YMIX)}; ph_gemm_fast<1024, 1024, true>(ldsl, HB, (const bf16_t*)(wsm + WSM_WPG), 1024, e); }
#endif
        xcd_barrier(bar);
        ph_final(P, l);
#ifdef DBL_FINAL
        ph_final<true>(P, l);
#endif
        xcd_barrier(bar);
    }
}

__global__ void __launch_bounds__(NTHR, 2) mega_fwd(Params P) {
    extern __shared__ __attribute__((aligned(16))) unsigned char lds[];
    char* ws = P.ws;
    if (threadIdx.x == 0) *(uint4*)(lds + LDS_BAR_OFF) = make_uint4(0u, 0u, (unsigned)P.grid, 0u);
    if ((threadIdx.x & 63) == 0) *(volatile LAS int*)((LAS unsigned char*)lds + LDS_WID_OFF + hw_wave_key() * 4) = (int)(threadIdx.x >> 6);
    __syncthreads();
    const XcdBarrier bar = xcd_barrier_post((unsigned*)(ws + WS_CTL), (volatile LAS unsigned*)(lds + LDS_BAR_OFF));
    const bf16_t* HB = (const bf16_t*)(ws + WS_HB); const float* RS = (const float*)(ws + WS_RSTD);
    bf16_t* Z = (bf16_t*)(ws + WS_BIG + BIG_Z);
    ph_tconv_small(P, lds);
    ph_conv_bf16(P.p, (bf16_t*)(ws + WS_PB), (long)2 * T * 256 / 8);
    ph_prep_router(P);
    ph_init_h(P);
    ph_rope_table(P);
#ifdef DBL_P0
    __syncthreads();
    ph_tconv_small(P, lds);
    ph_conv_bf16(P.p, (bf16_t*)(ws + WS_PB), (long)2 * T * 256 / 8);
    ph_prep_router(P);
    ph_init_h(P);
    ph_rope_table(P);
#endif
    xcd_barrier(bar);
    layer_body<0>(P, bar, lds);
    layer_body<1>(P, bar, lds);
}

extern "C" void kernel_launch(void* const* d_in, const int* in_sizes, int n_in, void* d_out, int out_size, void* d_ws, size_t ws_size, hipStream_t stream) {
    if (n_in != 30 || ws_size < WS_END) { fprintf(stderr, "kernel_launch: need 30 inputs and %zu bytes of workspace (got %d, %zu)\n", (size_t)WS_END, n_in, ws_size); return; }
    static int grid = 0;
    if (!grid) {
        int dev = 0, cus = 0, per_cu = 0;
        if (hipGetDevice(&dev) != hipSuccess || hipDeviceGetAttribute(&cus, hipDeviceAttributeMultiprocessorCount, dev) != hipSuccess) { fprintf(stderr, "kernel_launch: device query failed\n"); return; }
        if (hipFuncSetAttribute((const void*)mega_fwd, hipFuncAttributeMaxDynamicSharedMemorySize, LDS_BYTES) != hipSuccess) { fprintf(stderr, "kernel_launch: hipFuncSetAttribute failed\n"); return; }
        if (hipOccupancyMaxActiveBlocksPerMultiprocessor(&per_cu, (const void*)mega_fwd, NTHR, LDS_BYTES) != hipSuccess || per_cu < 1) { fprintf(stderr, "kernel_launch: occupancy query says %d\n", per_cu); return; }
        grid = cus;
    }
    Params P{};
    P.x = (const float*)d_in[0]; P.p = (const float*)d_in[1]; P.pos = (const int*)d_in[2];
    P.mix_norm = (const float*)d_in[3]; P.w_in = (const float*)d_in[4]; P.gla_wg = (const float*)d_in[5]; P.gla_bg = (const float*)d_in[6]; P.gla_on = (const float*)d_in[7];
    P.q_norm = (const float*)d_in[8]; P.w_uq = (const float*)d_in[9]; P.kv_norm = (const float*)d_in[10]; P.w_ukv = (const float*)d_in[11]; P.qkq = (const float*)d_in[12]; P.qkk = (const float*)d_in[13];
    P.pool_w = (const float*)d_in[14]; P.pool_s = (const float*)d_in[15]; P.w_out = (const float*)d_in[16]; P.ffn_norm = (const float*)d_in[17]; P.router_w = (const float*)d_in[18]; P.router_b = (const float*)d_in[19];
    P.moe_wg = (const float*)d_in[20]; P.moe_bg = (const float*)d_in[21]; P.moe_wu = (const float*)d_in[22]; P.moe_bu = (const float*)d_in[23]; P.moe_wd = (const float*)d_in[24]; P.moe_bd = (const float*)d_in[25];
    P.ple_wp = (const float*)d_in[26]; P.ple_gn = (const float*)d_in[27]; P.ple_wg = (const float*)d_in[28]; P.ple_pn = (const float*)d_in[29];
    P.out = (float*)d_out; P.ws = (char*)d_ws; P.grid = grid; P.pad_ = 0;
    (void)hipMemsetAsync((char*)d_ws + WS_CTL, 0, 65536, stream);
    hipLaunchKernelGGL(mega_fwd, dim3(grid), dim3(NTHR), LDS_BYTES, stream, P);
}
```

```cpp
#include <hip/hip_runtime.h>
#include <cstdio>
#include <cstdint>

typedef unsigned short bf16_t;
typedef short bf16x8 __attribute__((ext_vector_type(8)));
typedef float f32x4 __attribute__((ext_vector_type(4)));
typedef unsigned u32x4_t __attribute__((ext_vector_type(4)));

constexpr int T = 32768, DM = 1024, SEQ = 4096, NBATCH = 8, DEPTH = 2;
constexpr int ZW = 1536;
constexpr int ZC_CQ = 0, ZC_GV = 256, ZC_GR = 512, ZC_UP = 768, ZC_GQ = 1024, ZC_GK = 1152, ZC_CKV = 1280, ZC_KR = 1408, ZC_GLOW = 1440;
constexpr int NE = 32, TOPK = 4, DFF = 1024;
constexpr int HROWS = 139264;
constexpr float EPS = 1e-6f;

__host__ __device__ inline int zsrc(int n) {
    if (n < 256) return 784 + n;
    if (n < 512) return 256 + (n - 256);
    if (n < 768) return 528 + (n - 512);
    if (n < 1024) return 1200 + (n - 768);
    if (n < 1152) return n - 1024;
    if (n < 1280) return 128 + (n - 1152);
    if (n < 1408) return 1040 + (n - 1280);
    if (n < 1440) return 1168 + (n - 1408);
    if (n < 1456) return 512 + (n - 1440);
    return -1;
}

constexpr size_t MiB = 1024 * 1024;
constexpr size_t WS_CTL = 0;
constexpr size_t WS_HB = 1 * MiB;
constexpr size_t WS_RSTD = WS_HB + 64 * MiB;
constexpr size_t WS_WSM = WS_RSTD + 1 * MiB;
constexpr size_t WSM_WIN = 0, WSM_WUQ = 3 * MiB, WSM_WUKV = WSM_WUQ + 384 * 1024, WSM_WOUT = WSM_WUKV + 256 * 1024, WSM_WPG = WSM_WOUT + 2 * MiB,
                 WSM_WPLE = WSM_WPG + 2 * MiB, WSM_WR = WSM_WPLE + 512 * 1024, WSM_WPT = WSM_WR + 128 * 1024, WSM_STRIDE = WSM_WR + 128 * 1024 + 128 * 1024;
constexpr size_t WS_PB = WS_WSM + 2 * WSM_STRIDE;
constexpr size_t WS_W1 = WS_PB + 32 * MiB;
constexpr size_t WS_W2 = WS_W1 + 128 * MiB;
constexpr size_t WS_E = WS_W2 + 64 * MiB;
constexpr size_t WS_YMIX = WS_E + 64 * MiB;
constexpr size_t WS_Y = WS_YMIX + 64 * MiB;
constexpr size_t WS_UPD = WS_Y + 256 * MiB;
constexpr size_t WS_DEC = WS_UPD + 16 * MiB;
constexpr size_t WS_SPREV = WS_DEC + 1 * MiB;
constexpr size_t WS_TOPG = WS_SPREV + 8 * MiB;
constexpr size_t WS_LIST = WS_TOPG + 1 * MiB;
constexpr size_t WS_BIG = WS_LIST + 4 * MiB;
constexpr size_t BIG_Z = 0, BIG_Q = 96 * MiB, BIG_KV = BIG_Q + 48 * MiB, BIG_K = BIG_KV + 64 * MiB, BIG_LA = BIG_K + 48 * MiB;
constexpr size_t WS_ROPE = WS_BIG + 272 * MiB;
constexpr size_t WS_LRS = WS_ROPE + 4 * MiB;
constexpr size_t WS_LGT = WS_LRS + 4 * MiB;
constexpr size_t WS_END = WS_LGT + 4 * MiB;
constexpr int CTL_CNT = 4096;

constexpr bool MOE_FP8_L0 = true, MOE_FP8_L1 = true;
__device__ __forceinline__ float bf2f(bf16_t v) { return __uint_as_float(((unsigned)v) << 16); }
__device__ __forceinline__ bf16_t f2bf(float f) { unsigned u = __float_as_uint(f); u += 0x7FFFu + ((u >> 16) & 1u); return (bf16_t)(u >> 16); }
__device__ __forceinline__ unsigned pack2(float lo, float hi) { return (unsigned)f2bf(lo) | ((unsigned)f2bf(hi) << 16); }
template <int CTRL> __device__ __forceinline__ float dppx(float v) { return __int_as_float(__builtin_amdgcn_update_dpp(0, __float_as_int(v), CTRL, 0xf, 0xf, true)); }
__device__ __forceinline__ unsigned pack4_fp8(float x0, float x1, float x2, float x3) { int w = 0; w = __builtin_amdgcn_cvt_pk_fp8_f32(x0, x1, w, false); w = __builtin_amdgcn_cvt_pk_fp8_f32(x2, x3, w, true); return (unsigned)w; }
__device__ __forceinline__ float wave_sum(float v) {
    v += dppx<0xB1>(v); v += dppx<0x4E>(v); v += dppx<0x141>(v); v += dppx<0x140>(v);
    { auto rr = __builtin_amdgcn_permlane16_swap(__float_as_uint(v), __float_as_uint(v), false, false); v = __uint_as_float(rr[0]) + __uint_as_float(rr[1]); }
    { auto rr = __builtin_amdgcn_permlane32_swap(__float_as_uint(v), __float_as_uint(v), false, false); v = __uint_as_float(rr[0]) + __uint_as_float(rr[1]); }
    return v;
}
__device__ __forceinline__ float wave_max(float v) {
    v = fmaxf(v, dppx<0xB1>(v)); v = fmaxf(v, dppx<0x4E>(v)); v = fmaxf(v, dppx<0x141>(v)); v = fmaxf(v, dppx<0x140>(v));
    { auto rr = __builtin_amdgcn_permlane16_swap(__float_as_uint(v), __float_as_uint(v), false, false); v = fmaxf(__uint_as_float(rr[0]), __uint_as_float(rr[1])); }
    { auto rr = __builtin_amdgcn_permlane32_swap(__float_as_uint(v), __float_as_uint(v), false, false); v = fmaxf(__uint_as_float(rr[0]), __uint_as_float(rr[1])); }
    return v;
}
namespace at {
typedef float f32x16 __attribute__((ext_vector_type(16)));
__device__ __forceinline__ float xhalf_max(float v) { auto rr = __builtin_amdgcn_permlane32_swap(__float_as_uint(v), __float_as_uint(v), false, false); return fmaxf(__uint_as_float(rr[0]), __uint_as_float(rr[1])); }
__device__ __forceinline__ float xhalf_sum(float v) { auto rr = __builtin_amdgcn_permlane32_swap(__float_as_uint(v), __float_as_uint(v), false, false); return __uint_as_float(rr[0]) + __uint_as_float(rr[1]); }
}
__device__ __forceinline__ float sigmoidf_(float x) { return __builtin_amdgcn_rcpf(1.0f + __builtin_amdgcn_exp2f(-1.4426950408889634f * x)); }


#define XB_TMO      128
#define XB_XCNT(j)  (256  + 64 * (j))
#define XB_XSUB(j)  (1280 + 64 * (j))
#define XB_XGEN(j)  (2304 + 64 * (j))
#define XB_TOP      3328
#define XB_TOPGEN   3392
#define XCD_BAR_WORDS 3456
#define XB_SPIN_CAP (1u << 18)
#define LAS __attribute__((address_space(3)))

constexpr int LDS_WID_OFF = 147456 - 16 - 256, LDS_GRID_OFF = 147456 - 16 + 8;
__device__ __forceinline__ int grid_size() { extern __shared__ __attribute__((aligned(16))) unsigned char lds_dyn_[]; return __builtin_amdgcn_readfirstlane(*(const volatile LAS int*)((LAS unsigned char*)lds_dyn_ + LDS_GRID_OFF)); }
__device__ __forceinline__ unsigned hw_wave_key() { return (unsigned)__builtin_amdgcn_s_getreg((5 << 11) | 4) & 63u; }
__device__ __forceinline__ int opaque_tid() {
    extern __shared__ __attribute__((aligned(16))) unsigned char lds_dyn_[];
    const int wv = __builtin_amdgcn_readfirstlane(*(const volatile LAS int*)((LAS unsigned char*)lds_dyn_ + LDS_WID_OFF + hw_wave_key() * 4));
    int ln; asm volatile("v_mbcnt_lo_u32_b32 %0, -1, 0\n\tv_mbcnt_hi_u32_b32 %0, -1, %0" : "=v"(ln));
    int t = wv * 64 + ln;
    asm volatile("" : "+v"(t)); return t;
}

__device__ __forceinline__ unsigned xb_ld(unsigned* p)              { return __hip_atomic_load(p, __ATOMIC_RELAXED, __HIP_MEMORY_SCOPE_AGENT); }
__device__ __forceinline__ unsigned xb_add(unsigned* p, unsigned v) { return __hip_atomic_fetch_add(p, v, __ATOMIC_RELAXED, __HIP_MEMORY_SCOPE_AGENT); }
__device__ __forceinline__ unsigned xb_xcc_id() { return (unsigned)__builtin_amdgcn_s_getreg((3 << 11) | 20) & 0xFu; }
#define XB_SPIN(cond, bar) do { unsigned _sp = 0; while (cond) { __builtin_amdgcn_s_sleep(1); \
    if ((++_sp & 255u) == 0u) { if (xb_ld(&(bar)[XB_TMO])) break; if (_sp > XB_SPIN_CAP) { atomicAdd(&(bar)[XB_TMO], 1u); break; } } } } while (0)

struct XcdBarrier {
    unsigned* bar; unsigned x;
    volatile LAS unsigned* st;
};

__device__ __forceinline__ XcdBarrier xcd_barrier_post(unsigned* bar, volatile LAS unsigned* st) {
    XcdBarrier b; b.bar = bar; b.x = xb_xcc_id(); b.st = st;
    if (threadIdx.x == 0) (void)xb_add(&bar[XB_XCNT(b.x)], 1u);
    return b;
}
__device__ __forceinline__ void xcd_barrier_complete(unsigned* bar, unsigned x, unsigned& nloc, unsigned& nx) {
    const unsigned G = (unsigned)grid_size();
    unsigned sum, cnt, mine, sp = 0u;
    for (;;) {
        sum = 0u; cnt = 0u; mine = 0u;
#pragma unroll
        for (unsigned j = 0; j < 16; ++j) { const unsigned c = xb_ld(&bar[XB_XCNT(j)]); sum += c; cnt += (c > 0u) ? 1u : 0u; mine = (j == x) ? c : mine; }
        if (sum == G) break;
        __builtin_amdgcn_s_sleep(1);
        if ((++sp & 255u) == 0u) { if (xb_ld(&bar[XB_TMO])) break; if (sp > XB_SPIN_CAP) { atomicAdd(&bar[XB_TMO], 1u); break; } }
    }
    nloc = mine > 0u ? mine : 1u; nx = cnt > 0u ? cnt : 1u;
}

__device__ __forceinline__ void xcd_barrier1(const XcdBarrier& b) {
    asm volatile("s_waitcnt vmcnt(0)" ::: "memory");
    __syncthreads();
    if (opaque_tid() == 0) {
        unsigned* bar = b.bar;
        __builtin_amdgcn_s_waitcnt(0);
        unsigned nloc = b.st[0], nx = b.st[1];
        if (nloc == 0u) { xcd_barrier_complete(bar, b.x, nloc, nx); b.st[0] = nloc; b.st[1] = nx; }
        const unsigned old = xb_add(&bar[XB_XSUB(b.x)], 1u);
        const unsigned gen = old / nloc;
        if (old + 1u == (gen + 1u) * nloc) {
            __builtin_amdgcn_fence(__ATOMIC_RELEASE, "agent");
            asm volatile("s_waitcnt vmcnt(0)" ::: "memory");
            const unsigned og = xb_add(&bar[XB_TOP], 1u);
            const unsigned tg = og / nx;
            if (og + 1u == (tg + 1u) * nx) xb_add(&bar[XB_TOPGEN], 1u);
            else XB_SPIN(xb_ld(&bar[XB_TOPGEN]) == tg, bar);
            __builtin_amdgcn_fence(__ATOMIC_ACQUIRE, "agent");
            xb_add(&bar[XB_XGEN(b.x)], 1u);
            asm volatile("s_waitcnt vmcnt(0)" ::: "memory");
        } else {
            XB_SPIN(xb_ld(&bar[XB_XGEN(b.x)]) == gen, bar);
            __builtin_amdgcn_fence(__ATOMIC_ACQUIRE, "agent");
            asm volatile("s_waitcnt vmcnt(0)" ::: "memory");
        }
    }
    __syncthreads();
}

struct Params {
    const float *x, *p; const int* pos;
    const float *mix_norm, *w_in, *gla_wg, *gla_bg, *gla_on, *q_norm, *w_uq, *kv_norm, *w_ukv, *qkq, *qkk, *pool_w, *pool_s, *w_out, *ffn_norm, *router_w, *router_b,
        *moe_wg, *moe_bg, *moe_wu, *moe_bu, *moe_wd, *moe_bd, *ple_wp, *ple_gn, *ple_wg, *ple_pn;
    float* out; char* ws; int grid; int pad_;
};


#ifdef DBL_BAR
__device__ __forceinline__ void xcd_barrier(const XcdBarrier& b) { xcd_barrier1(b); xcd_barrier1(b); }
#else
__device__ __forceinline__ void xcd_barrier(const XcdBarrier& b) { xcd_barrier1(b); }
#endif
constexpr int NTHR = 512, NWV = 8;

constexpr int LDS_BYTES = 147456;
constexpr int LDS_BAR_OFF = LDS_BYTES - 16;

__device__ __forceinline__ void ph_tconv(const float* src, const float* src2, const float* gain, bf16_t* dst, int N, int K, int ld_src, int mode, int nexp, long se, long de, unsigned char* lds) {
    const int tz = opaque_tid(); const int tid = tz & 255, half = tz >> 8, tx = tid & 63, ty = tid >> 6;
    float (*tile)[65] = (float (*)[65])(lds + half * 16640);
    const int nx = N / 64, ny = K / 64, nunits = nx * ny * nexp;
    for (int u0 = blockIdx.x * 2; u0 < nunits; u0 += grid_size() * 2) {
        const int u = u0 + half; const int bx = u % nx, by = (u / nx) % ny, e = u / (nx * ny);
        const float* s1 = src + (long)e * se; const float* s2 = src2 ? src2 + (long)e * se : nullptr; bf16_t* d = dst + (long)e * de;
        const int n0 = bx * 64, k0 = by * 64, n = n0 + tx;
        const float* sp = s1; int col;
        if (mode == 0) col = n;
        else if (mode == 1) col = zsrc(n);
        else { const int tl = n >> 8, w = n & 255; if (w < 128) col = tl * 128 + w; else { col = tl * 128 + (w - 128); sp = s2; } }
#pragma unroll
        for (int i = 0; i < 16; ++i) {
            const int k = k0 + ty + 4 * i; float v = 0.f;
            if (col >= 0) v = sp[(long)k * ld_src + col];
            if (gain) v *= gain[k];
            tile[ty + 4 * i][tx] = v;
        }
        __syncthreads();
        const int nl = tid >> 2, ks = (tid & 3) * 16;
        unsigned w0 = pack2(tile[ks + 0][nl], tile[ks + 1][nl]), w1 = pack2(tile[ks + 2][nl], tile[ks + 3][nl]), w2 = pack2(tile[ks + 4][nl], tile[ks + 5][nl]), w3 = pack2(tile[ks + 6][nl], tile[ks + 7][nl]);
        unsigned w4 = pack2(tile[ks + 8][nl], tile[ks + 9][nl]), w5 = pack2(tile[ks + 10][nl], tile[ks + 11][nl]), w6 = pack2(tile[ks + 12][nl], tile[ks + 13][nl]), w7 = pack2(tile[ks + 14][nl], tile[ks + 15][nl]);
        uint4* o = (uint4*)(d + (long)(n0 + nl) * K + k0 + ks);
        o[0] = make_uint4(w0, w1, w2, w3); o[1] = make_uint4(w4, w5, w6, w7);
        __syncthreads();
    }
}


__device__ __forceinline__ void ph_tconv_small(const Params& P, unsigned char* lds) {
    const int tz = opaque_tid(); const int tid = tz & 255, half = tz >> 8, tx = tid & 63, ty = tid >> 6;
    float (*tile)[65] = (float (*)[65])(lds + half * 16640);
    constexpr int U_IN = 24 * 16, U_UQ = 12 * 4, U_KV = 16 * 2, U_OUT = 16 * 16, U_PG = 16 * 16, U_PP = 16 * 4, U_L = U_IN + U_UQ + U_KV + U_OUT + U_PG + U_PP;
    static_assert((2 * U_L) % 2 == 0, "pairs of units");
    for (int u0 = blockIdx.x * 2; u0 < 2 * U_L; u0 += grid_size() * 2) {
        const int u = u0 + half; const int l = u / U_L; int r = u % U_L;
        char* wsm = P.ws + WS_WSM + (size_t)l * WSM_STRIDE;
        const float* src; const float* gain; bf16_t* dst; int N, K, ld, mode;
        if (r < U_IN) { src = P.w_in + (size_t)l * 1024 * 1456; gain = P.mix_norm + l * 1024; dst = (bf16_t*)(wsm + WSM_WIN); N = ZW; K = 1024; ld = 1456; mode = 1; }
        else if ((r -= U_IN) < U_UQ) { src = P.w_uq + (size_t)l * 256 * 768; gain = P.q_norm + l * 256; dst = (bf16_t*)(wsm + WSM_WUQ); N = 768; K = 256; ld = 768; mode = 0; }
        else if ((r -= U_UQ) < U_KV) { src = P.w_ukv + (size_t)l * 128 * 1024; gain = P.kv_norm + l * 128; dst = (bf16_t*)(wsm + WSM_WUKV); N = 1024; K = 128; ld = 1024; mode = 0; }
        else if ((r -= U_KV) < U_OUT) { src = P.w_out + (size_t)l * 1024 * 1024; gain = nullptr; dst = (bf16_t*)(wsm + WSM_WOUT); N = 1024; K = 1024; ld = 1024; mode = 0; }
        else if ((r -= U_OUT) < U_PG) { src = P.ple_wg + (size_t)l * 1024 * 1024; gain = P.ple_gn + l * 1024; dst = (bf16_t*)(wsm + WSM_WPG); N = 1024; K = 1024; ld = 1024; mode = 0; }
        else { r -= U_PG; src = P.ple_wp + (size_t)l * 256 * 1024; gain = nullptr; dst = (bf16_t*)(wsm + WSM_WPLE); N = 1024; K = 256; ld = 1024; mode = 0; }
        const int nx = N / 64; const int bx = r % nx, by = r / nx;
        const int n0 = bx * 64, k0 = by * 64, n = n0 + tx;
        const int col = (mode == 1) ? zsrc(n) : n;
#pragma unroll
        for (int i = 0; i < 16; ++i) {
            const int k = k0 + ty + 4 * i; float v = 0.f;
            if (col >= 0) v = src[(long)k * ld + col];
            if (gain) v *= gain[k];
            tile[ty + 4 * i][tx] = v;
        }
        __syncthreads();
        const int nl = tid >> 2, ks = (tid & 3) * 16;
        unsigned w0 = pack2(tile[ks + 0][nl], tile[ks + 1][nl]), w1 = pack2(tile[ks + 2][nl], tile[ks + 3][nl]), w2 = pack2(tile[ks + 4][nl], tile[ks + 5][nl]), w3 = pack2(tile[ks + 6][nl], tile[ks + 7][nl]);
        unsigned w4 = pack2(tile[ks + 8][nl], tile[ks + 9][nl]), w5 = pack2(tile[ks + 10][nl], tile[ks + 11][nl]), w6 = pack2(tile[ks + 12][nl], tile[ks + 13][nl]), w7 = pack2(tile[ks + 14][nl], tile[ks + 15][nl]);
        uint4* o = (uint4*)(dst + (long)(n0 + nl) * K + k0 + ks);
        o[0] = make_uint4(w0, w1, w2, w3); o[1] = make_uint4(w4, w5, w6, w7);
        __syncthreads();
    }
}

template <bool FP8> __device__ __forceinline__ void ph_tconv_exp(const Params& P, int layer, LAS unsigned char* lds) {
    const int tid = opaque_tid();
    const int kq = tid >> 6, c4 = tid & 63;
    constexpr int PITCH = FP8 ? 68 : 136;
    LAS unsigned char* tile = lds;
    const float* gain = P.ffn_norm + layer * 1024;
    const int nunits = 3 * 32 * 16 * 4;
    for (int u = blockIdx.x; u < nunits; u += grid_size()) {
        const int nt = u & 3, kt = (u >> 2) & 15, e = (u >> 6) & 31, mat = u >> 11;
        const float* src = (mat == 0 ? P.moe_wg : mat == 1 ? P.moe_wu : P.moe_wd) + ((size_t)layer * 32 + e) * 1024 * 1024 + (size_t)(kt * 64) * 1024 + nt * 256 + c4 * 4;
        f32x4 v[2][4];
#pragma unroll
        for (int g = 0; g < 2; ++g)
#pragma unroll
            for (int r = 0; r < 4; ++r) v[g][r] = *(const f32x4*)(src + (size_t)(32 * g + 4 * kq + r) * 1024);
        const float sc = FP8 ? 64.0f : 1.0f;
#pragma unroll
        for (int g = 0; g < 2; ++g)
#pragma unroll
            for (int r = 0; r < 4; ++r) v[g][r] *= (mat < 2 ? gain[kt * 64 + 32 * g + 4 * kq + r] : 1.0f) * sc;
        __syncthreads();
#pragma unroll
        for (int g = 0; g < 2; ++g)
#pragma unroll
            for (int j = 0; j < 4; ++j) {
                if constexpr (FP8) *(LAS unsigned*)(tile + (c4 * 4 + j) * PITCH + 32 * g + 4 * kq) = pack4_fp8(v[g][0][j], v[g][1][j], v[g][2][j], v[g][3][j]);
                else { LAS unsigned* wp_ = (LAS unsigned*)(tile + (c4 * 4 + j) * PITCH + (32 * g + 4 * kq) * 2); wp_[0] = pack2(v[g][0][j], v[g][1][j]); wp_[1] = pack2(v[g][2][j], v[g][3][j]); }
            }
        __syncthreads();
        typedef unsigned u32x4 __attribute__((ext_vector_type(4)));
        unsigned char* dst = (mat < 2) ? (unsigned char*)(P.ws + WS_W1) + (size_t)e * 2048 * (FP8 ? 1024 : 2048) : (unsigned char*)(P.ws + WS_W2) + (size_t)e * 1024 * (FP8 ? 1024 : 2048);
        constexpr int CPR = FP8 ? 4 : 8;
#pragma unroll
        for (int j = 0; j < 256 * CPR / NTHR; ++j) {
            const int id = tid + NTHR * j, nl = id / CPR, ck = id % CPR, n = nt * 256 + nl;
            const int drow = (mat == 2) ? n : ((n >> 7) * 256 + (n & 127) + (mat == 1 ? 128 : 0));
            const LAS unsigned* rp = (const LAS unsigned*)(tile + nl * PITCH + ck * 16);
            const u32x4 o = {rp[0], rp[1], rp[2], rp[3]};
            *(u32x4*)(dst + (size_t)drow * (FP8 ? 1024 : 2048) + (size_t)kt * (FP8 ? 64 : 128) + ck * 16) = o;
        }
    }
    __syncthreads();
}
__device__ __forceinline__ void ph_conv_bf16(const float* src, bf16_t* dst, long n8) {
    const int tz = opaque_tid();
    for (int i = blockIdx.x * NTHR + tz; i < (int)n8; i += grid_size() * NTHR) {
        const float4 a = ((const float4*)src)[2 * i], b = ((const float4*)src)[2 * i + 1];
        ((uint4*)dst)[i] = make_uint4(pack2(a.x, a.y), pack2(a.z, a.w), pack2(b.x, b.y), pack2(b.z, b.w));
    }
}
__device__ __forceinline__ void ph_prep_router(const Params& P) {
    const int tz = opaque_tid();
    for (int i = blockIdx.x * NTHR + tz; i < 2 * 4 * 64 * 64; i += grid_size() * NTHR) {
        const int l = i >> 14, g = (i >> 12) & 3, d = (i >> 6) & 63, c = i & 63;
        ((bf16_t*)(P.ws + WS_WSM + (size_t)l * WSM_STRIDE + WSM_WPT))[(g * 64 + d) * 64 + c] = f2bf(P.pool_w[(size_t)l * 16384 + (g * 64 + c) * 64 + d]);
    }
    for (int i = blockIdx.x * NTHR + tz; i < 2 * 32 * 1024; i += grid_size() * NTHR) {
        const int l = i >> 15, e = (i >> 10) & 31, k = i & 1023;
        bf16_t* Wr = (bf16_t*)(P.ws + WS_WSM + (size_t)l * WSM_STRIDE + WSM_WR);
        const float w = P.router_w[((size_t)l * 1024 + k) * 32 + e] * P.ffn_norm[l * 1024 + k];
        const bf16_t whi = f2bf(w); Wr[e * 1024 + k] = whi; Wr[32 * 1024 + e * 1024 + k] = f2bf(w - bf2f(whi));
    }
}


__device__ __forceinline__ void ph_rope_table(const Params& P) {
    const int tz = opaque_tid();
    float* RT = (float*)(P.ws + WS_ROPE);
    for (int e = blockIdx.x * NTHR + tz; e < T * 16; e += grid_size() * NTHR) {
        const int t = e >> 4, i = e & 15;
        const float inv = exp2f(-(float)(2 * i) * (1.0f / 32.0f) * 13.287712379549449f);
        const float ang = (float)P.pos[t] * inv;
        RT[(size_t)t * 32 + i] = cosf(ang); RT[(size_t)t * 32 + 16 + i] = sinf(ang);
    }
}

__device__ __forceinline__ void ph_init_h(const Params& P) {
    const int tz = opaque_tid(); const int wid = tz >> 6, lane = tz & 63;
    bf16_t* HB = (bf16_t*)(P.ws + WS_HB); float* RS = (float*)(P.ws + WS_RSTD);
    for (int t = blockIdx.x * NWV + wid; t < T; t += grid_size() * NWV) {
        const float* hr = P.x + (size_t)t * 1024;
        float ss = 0.f; float4 v[4];
#pragma unroll
        for (int i = 0; i < 4; ++i) { v[i] = *(const float4*)(hr + i * 256 + lane * 4); ss += v[i].x * v[i].x + v[i].y * v[i].y + v[i].z * v[i].z + v[i].w * v[i].w; }
        ss = wave_sum(ss);
        if (lane == 0) RS[t] = rsqrtf(ss * (1.0f / 1024.0f) + EPS);
#pragma unroll
        for (int i = 0; i < 4; ++i) *(uint2*)(HB + (size_t)t * 1024 + i * 256 + lane * 4) = make_uint2(pack2(v[i].x, v[i].y), pack2(v[i].z, v[i].w));
    }
}

__device__ __forceinline__ void ph_prepB(const Params& P, int layer, unsigned char* lds) {
    float* wg = (float*)lds;
    const int tid = opaque_tid(), wid = tid >> 6, lane = tid & 63;
    for (int i = tid; i < 16 * 128; i += NTHR) wg[i] = P.gla_wg[(size_t)layer * 2048 + i];
    __syncthreads();
    bf16_t* Z = (bf16_t*)(P.ws + WS_BIG + BIG_Z); float* LA = (float*)(P.ws + WS_BIG + BIG_LA); bf16_t* YM = (bf16_t*)(P.ws + WS_YMIX);
    const float* bg = P.gla_bg + layer * 128; const float* psc = P.pool_s + layer * 256;
    const float bg0 = bg[lane], bg1 = bg[lane + 64];
    for (int t0 = (blockIdx.x * NWV + wid) * 2; t0 < T; t0 += grid_size() * NWV * 2) {
        uint2 cq[2]; unsigned ckv[2]; float gl[2];
#pragma unroll
        for (int tt = 0; tt < 2; ++tt) { const bf16_t* zr = Z + (size_t)(t0 + tt) * ZW; cq[tt] = *(const uint2*)(zr + ZC_CQ + lane * 4); ckv[tt] = *(const unsigned*)(zr + ZC_CKV + lane * 2); gl[tt] = (lane < 16) ? bf2f(zr[ZC_GLOW + lane]) : 0.f; }
#pragma unroll
        for (int tt = 0; tt < 2; ++tt) {
            bf16_t* zr = Z + (size_t)(t0 + tt) * ZW;
            {
                const float a = bf2f(cq[tt].x & 0xffff), b = bf2f(cq[tt].x >> 16), c = bf2f(cq[tt].y & 0xffff), d = bf2f(cq[tt].y >> 16);
                const float r = rsqrtf(wave_sum(a * a + b * b + c * c + d * d) * (1.0f / 256.0f) + EPS);
                *(uint2*)(zr + ZC_CQ + lane * 4) = make_uint2(pack2(a * r, b * r), pack2(c * r, d * r));
            }
            {
                const float a = bf2f(ckv[tt] & 0xffff), b = bf2f(ckv[tt] >> 16);
                const float r = rsqrtf(wave_sum(a * a + b * b) * (1.0f / 128.0f) + EPS);
                *(unsigned*)(zr + ZC_CKV + lane * 2) = pack2(a * r, b * r);
            }
            {
                float l0 = bg0, l1 = bg1;
#pragma unroll
                for (int r = 0; r < 16; ++r) { const float g = __uint_as_float(__builtin_amdgcn_readlane(__float_as_uint(gl[tt]), r)); l0 += g * wg[r * 128 + lane]; l1 += g * wg[r * 128 + lane + 64]; }
                const float a0 = fminf(l0, 0.f) - log1pf(__expf(-fabsf(l0))), a1 = fminf(l1, 0.f) - log1pf(__expf(-fabsf(l1)));
                LA[(size_t)(t0 + tt) * 128 + lane] = a0 * (1.0f / 16.0f); LA[(size_t)(t0 + tt) * 128 + lane + 64] = a1 * (1.0f / 16.0f);
            }
        }
    }
    const bf16_t* WpT = (const bf16_t*)(P.ws + WS_WSM + (size_t)layer * WSM_STRIDE + WSM_WPT);
    const int fr = lane & 15, fq = lane >> 4;
    for (int u = blockIdx.x * NWV + wid; u < T / 16; u += grid_size() * NWV) {
        const int t = u * 16 + fr, sq = t & (SEQ - 1);
        uint2 yout[4][4];
#pragma unroll
        for (int gi = 0; gi < 4; ++gi) {
            const int w = 2 << gi; const int cnt = (sq + 1 < w) ? sq + 1 : w; const float rc = 1.0f / (float)cnt;
            bf16x8 af[2];
#pragma unroll
            for (int ks = 0; ks < 2; ++ks) {
                const bf16_t* up = Z + (size_t)t * ZW + ZC_UP + gi * 64 + ks * 32 + fq * 8;
                float acc[8], u0[8];
#pragma unroll
                for (int j = 0; j < 16; ++j) if (j < w) {
                    const int jj = (j < cnt) ? j : 0; const float msk = (j < cnt) ? 1.0f : 0.f;
                    const uint4 x = *(const uint4*)(up - (long)jj * ZW);
                    const float xv[8] = {bf2f(x.x & 0xffff), bf2f(x.x >> 16), bf2f(x.y & 0xffff), bf2f(x.y >> 16), bf2f(x.z & 0xffff), bf2f(x.z >> 16), bf2f(x.w & 0xffff), bf2f(x.w >> 16)};
#pragma unroll
                    for (int e = 0; e < 8; ++e) { if (j == 0) { u0[e] = xv[e]; acc[e] = xv[e]; } else acc[e] += msk * xv[e]; }
                }
                typedef unsigned u32x4 __attribute__((ext_vector_type(4)));
                const u32x4 pk = {pack2(acc[0] * rc - u0[0], acc[1] * rc - u0[1]), pack2(acc[2] * rc - u0[2], acc[3] * rc - u0[3]), pack2(acc[4] * rc - u0[4], acc[5] * rc - u0[5]), pack2(acc[6] * rc - u0[6], acc[7] * rc - u0[7])};
                af[ks] = __builtin_bit_cast(bf16x8, pk);
            }
#pragma unroll
            for (int nb = 0; nb < 4; ++nb) {
                f32x4 acc = {0.f, 0.f, 0.f, 0.f};
#pragma unroll
                for (int ks = 0; ks < 2; ++ks) { const bf16x8 bfr = *(const bf16x8*)(WpT + ((size_t)gi * 64 + nb * 16 + fr) * 64 + ks * 32 + fq * 8); acc = __builtin_amdgcn_mfma_f32_16x16x32_bf16(bfr, af[ks], acc, 0, 0, 0); }
                const int d0 = nb * 16 + fq * 4; const f32x4 sc = *(const f32x4*)(psc + gi * 64 + d0);
                yout[gi][nb] = make_uint2(pack2(acc[0] * sc[0], acc[1] * sc[1]), pack2(acc[2] * sc[2], acc[3] * sc[3]));
            }
        }
#pragma unroll
        for (int gi = 0; gi < 4; ++gi)
#pragma unroll
            for (int nb = 0; nb < 4; ++nb) *(uint2*)(YM + (size_t)t * 1024 + 768 + gi * 64 + nb * 16 + fq * 4) = yout[gi][nb];
    }
}

template <bool DRY = false> __device__ __forceinline__ void ph_prepD(const Params& P, int layer) {
    const int tid = opaque_tid(), wid = tid >> 6, lane = tid & 63, g = lane >> 4, li = lane & 15;
    bf16_t* Z = (bf16_t*)(P.ws + WS_BIG + BIG_Z); bf16_t* Q = (bf16_t*)(P.ws + WS_BIG + BIG_Q); const bf16_t* KV = (const bf16_t*)(P.ws + WS_BIG + BIG_KV); bf16_t* Kd = DRY ? (bf16_t*)(P.ws + WS_Y + 64 * MiB) : (bf16_t*)(P.ws + WS_BIG + BIG_K);
    bf16_t* QW = DRY ? (bf16_t*)(P.ws + WS_Y) : Q;
    const float* RT = (const float*)(P.ws + WS_ROPE);
    const bool act = li < 12, rope = li >= 8 && li < 12, x1part = li < 10;
    const int e0 = act ? 8 * li : 0;
    float gq[8], gk[8];
#pragma unroll
    for (int j = 0; j < 8; ++j) { gq[j] = P.qkq[layer * 96 + e0 + j]; gk[j] = P.qkk[layer * 96 + e0 + j]; }
    const float qscale = 0.10206207261596577f * 1.4426950408889634f;
    for (int t = blockIdx.x * NWV + wid; t < T; t += grid_size() * NWV) {
        typedef unsigned u32x4 __attribute__((ext_vector_type(4)));
        u32x4 qraw[2], kraw[2];
        const int i0 = 8 * (li & 1);
        const f32x4 c0 = *(const f32x4*)(RT + (size_t)t * 32 + i0), c1 = *(const f32x4*)(RT + (size_t)t * 32 + i0 + 4), s0 = *(const f32x4*)(RT + (size_t)t * 32 + 16 + i0), s1 = *(const f32x4*)(RT + (size_t)t * 32 + 16 + i0 + 4);
        const float cs[8] = {c0[0], c0[1], c0[2], c0[3], c1[0], c1[1], c1[2], c1[3]}, sn[8] = {s0[0], s0[1], s0[2], s0[3], s1[0], s1[1], s1[2], s1[3]};
#pragma unroll
        for (int ps = 0; ps < 2; ++ps) {
            const int h = ps * 4 + g;
            qraw[ps] = *(const u32x4*)(Q + (size_t)t * 768 + h * 96 + e0);
            kraw[ps] = (li < 8) ? *(const u32x4*)(KV + (size_t)t * 1024 + h * 128 + e0) : *(const u32x4*)(Z + (size_t)t * ZW + ZC_KR + (rope ? 8 * (li - 8) : 0));
        }
#pragma unroll
        for (int ps = 0; ps < 2; ++ps) {
            const int h = ps * 4 + g;
#pragma unroll
            for (int qk = 0; qk < 2; ++qk) {
                const u32x4 raw = qk == 0 ? qraw[ps] : kraw[ps];
                float x[8];
#pragma unroll
                for (int w = 0; w < 4; ++w) { x[2 * w] = act ? bf2f(raw[w] & 0xffff) : 0.f; x[2 * w + 1] = act ? bf2f(raw[w] >> 16) : 0.f; }
                float ss = 0.f;
#pragma unroll
                for (int j = 0; j < 8; ++j) ss += x[j] * x[j];
                ss += dppx<0xB1>(ss); ss += dppx<0x4E>(ss); ss += dppx<0x141>(ss); ss += dppx<0x140>(ss);
                const float r = rsqrtf(ss * (1.0f / 96.0f) + EPS);
                float y[8];
#pragma unroll
                for (int j = 0; j < 8; ++j) {
                    const float xn = x[j] * r * (qk == 0 ? gq[j] : gk[j]);
                    const float pr = dppx<0x4E>(xn);
                    const float rot = x1part ? (xn * cs[j] - pr * sn[j]) : (xn * cs[j] + pr * sn[j]);
                    y[j] = (rope ? rot : xn) * (qk == 0 ? qscale : 1.0f);
                }
                const u32x4 o = {pack2(y[0], y[1]), pack2(y[2], y[3]), pack2(y[4], y[5]), pack2(y[6], y[7])};
                if (act) { if (qk == 0) *(u32x4*)(QW + (size_t)t * 768 + h * 96 + e0) = o; else *(u32x4*)(Kd + ((size_t)t * 8 + h) * 96 + e0) = o; }
            }
        }
    }
}

template <bool FP8> __device__ __forceinline__ void ph_router(const Params& P, int layer, LAS unsigned char* lds) {
    using at::f32x16;
    const int tid = opaque_tid(); const int wid = __builtin_amdgcn_readfirstlane(tid >> 6), lane = tid & 63, r32 = lane & 31, hi = lane >> 5;
    const bf16_t* HB = (const bf16_t*)(P.ws + WS_HB); float* RS1 = (float*)(P.ws + WS_RSTD) + T;
    const bf16_t* WrH = (const bf16_t*)(P.ws + WS_WSM + (size_t)layer * WSM_STRIDE + WSM_WR); const bf16_t* WrL = WrH + 32 * 1024;
    const float* rb = P.router_b + layer * 32;
    unsigned* cnt = (unsigned*)(P.ws + WS_CTL) + CTL_CNT + layer * 32;
    int* LIST = (int*)(P.ws + WS_LIST);
    constexpr int MAXU = 4;
    LAS unsigned* lcnt = (LAS unsigned*)lds; LAS unsigned* lbase = lcnt + 32;
    LAS unsigned* ent = lbase + 32;
    LAS float* entg = (LAS float*)(ent + NWV * MAXU * 128);
    LAS float* entr = entg + NWV * MAXU * 128;
    if (tid < 32) lcnt[tid] = 0u;
    __syncthreads();
    int nu = 0;
    for (int u = blockIdx.x * 4 + wid; wid < 4 && u < T / 32; u += grid_size() * 4, ++nu) {
        const size_t trow = (size_t)u * 32 + r32;
        f32x16 acc;
#pragma unroll
        for (int r = 0; r < 16; ++r) acc[r] = 0.f;
        float ss = 0.f;
        const bf16_t* hp = HB + trow * 1024 + hi * 8; const bf16_t* wh = WrH + (size_t)r32 * 1024 + hi * 8; const bf16_t* wl_ = WrL + (size_t)r32 * 1024 + hi * 8;
        for (int k8 = 0; k8 < 64; k8 += 8) {
            bf16x8 hf[8], a0[8], a1[8];
#pragma unroll
            for (int q = 0; q < 8; ++q) { hf[q] = *(const bf16x8*)(hp + (k8 + q) * 16); a0[q] = *(const bf16x8*)(wh + (k8 + q) * 16); a1[q] = *(const bf16x8*)(wl_ + (k8 + q) * 16); }
#pragma unroll
            for (int q = 0; q < 8; ++q) {
                acc = __builtin_amdgcn_mfma_f32_32x32x16_bf16(a0[q], hf[q], acc, 0, 0, 0);
                acc = __builtin_amdgcn_mfma_f32_32x32x16_bf16(a1[q], hf[q], acc, 0, 0, 0);
                float hv[8];
#pragma unroll
                for (int j = 0; j < 8; ++j) { hv[j] = bf2f((bf16_t)hf[q][j]); ss += hv[j] * hv[j]; }
                if constexpr (FP8) *(uint2*)((unsigned char*)(P.ws + WS_YMIX) + trow * 1024 + (k8 + q) * 16 + hi * 8) = make_uint2(pack4_fp8(hv[0], hv[1], hv[2], hv[3]), pack4_fp8(hv[4], hv[5], hv[6], hv[7]));
            }
        }
        ss = at::xhalf_sum(ss);
        const float rstd = rsqrtf(ss * (1.0f / 1024.0f) + EPS);
        if (hi == 0) RS1[trow] = rstd;
        float lg[16];
#pragma unroll
        for (int r = 0; r < 16; ++r) lg[r] = acc[r] * rstd + rb[(r & 3) + 8 * (r >> 2) + 4 * hi];
        float cv[8]; int ci[8];
#pragma unroll
        for (int k = 0; k < 4; ++k) {
            float best = -INFINITY; int bi = 0;
#pragma unroll
            for (int r = 0; r < 16; ++r) { const bool ok = lg[r] > best; best = ok ? lg[r] : best; bi = ok ? r : bi; }
#pragma unroll
            for (int r = 0; r < 16; ++r) lg[r] = (r == bi) ? -INFINITY : lg[r];
            cv[k] = best; ci[k] = (bi & 3) + 8 * (bi >> 2) + 4 * hi;
        }
#pragma unroll
        for (int k = 0; k < 4; ++k) {
            { auto rr = __builtin_amdgcn_permlane32_swap(__float_as_uint(cv[k]), __float_as_uint(cv[k]), false, false); cv[4 + k] = __uint_as_float(hi ? rr[0] : rr[1]); }
            { auto rr = __builtin_amdgcn_permlane32_swap((unsigned)ci[k], (unsigned)ci[k], false, false); ci[4 + k] = (int)(hi ? rr[0] : rr[1]); }
        }
        float tv[4]; int ti[4];
#pragma unroll
        for (int k = 0; k < 4; ++k) {
            float best = -INFINITY; int be = 64, bj = 0;
#pragma unroll
            for (int j = 0; j < 8; ++j) { const bool ok = (cv[j] > best) || (cv[j] == best && ci[j] < be); best = ok ? cv[j] : best; be = ok ? ci[j] : be; bj = ok ? j : bj; }
#pragma unroll
            for (int j = 0; j < 8; ++j) cv[j] = (j == bj) ? -INFINITY : cv[j];
            tv[k] = best; ti[k] = be;
        }
        const float e1 = __expf(tv[1] - tv[0]), e2 = __expf(tv[2] - tv[0]), e3 = __expf(tv[3] - tv[0]);
        const float invs = __builtin_amdgcn_rcpf(1.0f + e1 + e2 + e3);
        if (hi == 0 && nu < MAXU) {
            const float gt[4] = {invs, e1 * invs, e2 * invs, e3 * invs};
            const int base = ((wid * MAXU + nu) * 32 + r32) * 4;
#pragma unroll
            for (int k = 0; k < 4; ++k) {
                const unsigned rk = __hip_atomic_fetch_add(&lcnt[ti[k]], 1u, __ATOMIC_RELAXED, __HIP_MEMORY_SCOPE_WORKGROUP);
                ent[base + k] = (unsigned)ti[k] | (rk << 8); entg[base + k] = gt[k];
            }
            entr[(wid * MAXU + nu) * 32 + r32] = rstd;
        }
    }
    __syncthreads();
    if (tid < 32) lbase[tid] = atomicAdd(&cnt[tid], lcnt[tid]);
    __syncthreads();
    {
        int k2 = 0;
        for (int u = blockIdx.x * 4 + wid; wid < 4 && u < T / 32 && k2 < MAXU; u += grid_size() * 4, ++k2) {
#pragma unroll
            for (int h2 = 0; h2 < 2; ++h2) {
                const int i = lane + 64 * h2; const int tl = i >> 2;
                const unsigned code = ent[((wid * MAXU + k2) * 32) * 4 + i]; const int e = (int)(code & 255u); const unsigned pos = lbase[e] + (code >> 8);
                LIST[(size_t)e * T + pos] = (int)(((unsigned)u * 32 + tl) * 4 + (i & 3));
                ((float*)(P.ws + WS_LRS))[(size_t)e * T + pos] = entr[(wid * MAXU + k2) * 32 + tl];
                ((float*)(P.ws + WS_LGT))[(size_t)e * T + pos] = entg[((wid * MAXU + k2) * 32) * 4 + i];
            }
        }
    }
    __syncthreads();
}

__device__ __forceinline__ void unpack8(const u32x4_t w, float (&x)[8]) {
#pragma unroll
    for (int i = 0; i < 4; ++i) { x[2 * i] = bf2f(w[i] & 0xffff); x[2 * i + 1] = bf2f(w[i] >> 16); }
}
template <bool Y8, bool DRY = false> __device__ __forceinline__ void ph_combine(const Params& P) {
    const int tid = opaque_tid(), wid = tid >> 6, lane = tid & 63;
    bf16_t* HB = (bf16_t*)(P.ws + WS_HB); bf16_t* HBW = DRY ? (bf16_t*)(P.ws + WS_BIG + 128 * MiB) : HB; float* RS2 = DRY ? (float*)(P.ws + WS_BIG + 200 * MiB) : (float*)(P.ws + WS_RSTD) + 2 * T;
    const bf16_t* Y = (const bf16_t*)(P.ws + WS_Y); const unsigned char* Yb = (const unsigned char*)(P.ws + WS_Y);
    for (int t0 = (blockIdx.x * NWV + wid) * 2; t0 < T; t0 += grid_size() * NWV * 2) {
        u32x4_t hv[2][2], yv[2][2][4]; uint2 y8[2][2][4];
#pragma unroll
        for (int tt = 0; tt < 2; ++tt)
#pragma unroll
            for (int i = 0; i < 2; ++i) {
                hv[tt][i] = *(const u32x4_t*)(HB + (size_t)(t0 + tt) * 1024 + i * 512 + lane * 8);
#pragma unroll
                for (int k = 0; k < 4; ++k) {
                    if constexpr (Y8) y8[tt][i][k] = *(const uint2*)(Yb + ((size_t)(t0 + tt) * 4 + k) * 1024 + i * 512 + lane * 8);
                    else yv[tt][i][k] = *(const u32x4_t*)(Y + ((size_t)(t0 + tt) * 4 + k) * 1024 + i * 512 + lane * 8);
                }
            }
#pragma unroll
        for (int tt = 0; tt < 2; ++tt) {
            float ss = 0.f;
#pragma unroll
            for (int i = 0; i < 2; ++i) {
                float v[8]; unpack8(hv[tt][i], v);
#pragma unroll
                for (int k = 0; k < 4; ++k) {
                    if constexpr (Y8) {
                        const uint2 w = y8[tt][i][k];
                        const auto p0 = __builtin_amdgcn_cvt_pk_f32_fp8((int)w.x, false), p1 = __builtin_amdgcn_cvt_pk_f32_fp8((int)w.x, true), p2 = __builtin_amdgcn_cvt_pk_f32_fp8((int)w.y, false), p3 = __builtin_amdgcn_cvt_pk_f32_fp8((int)w.y, true);
                        v[0] += p0[0] * 0.0625f; v[1] += p0[1] * 0.0625f; v[2] += p1[0] * 0.0625f; v[3] += p1[1] * 0.0625f; v[4] += p2[0] * 0.0625f; v[5] += p2[1] * 0.0625f; v[6] += p3[0] * 0.0625f; v[7] += p3[1] * 0.0625f;
                    } else { float y[8]; unpack8(yv[tt][i][k], y);
#pragma unroll
                        for (int j = 0; j < 8; ++j) v[j] += y[j]; }
                }
#pragma unroll
                for (int j = 0; j < 8; ++j) ss += v[j] * v[j];
                *(u32x4_t*)(HBW + (size_t)(t0 + tt) * 1024 + i * 512 + lane * 8) = (u32x4_t){pack2(v[0], v[1]), pack2(v[2], v[3]), pack2(v[4], v[5]), pack2(v[6], v[7])};
            }
            ss = wave_sum(ss);
            if (lane == 0) RS2[t0 + tt] = rsqrtf(ss * (1.0f / 1024.0f) + EPS);
        }
    }
}

template <bool DRY = false> __device__ __forceinline__ void ph_final(const Params& P, int layer) {
    const int tid = opaque_tid(), wid = tid >> 6, lane = tid & 63;
    bf16_t* HB = (bf16_t*)(P.ws + WS_HB); bf16_t* HBW = DRY ? (bf16_t*)(P.ws + WS_BIG + 128 * MiB) : HB; float* RS = DRY ? (float*)(P.ws + WS_BIG + 200 * MiB) : (float*)(P.ws + WS_RSTD); const bf16_t* V = (const bf16_t*)(P.ws + WS_YMIX);
    float* OUTW = DRY ? (float*)(P.ws + WS_BIG) : P.out;
    const float* gp = P.ple_pn + layer * 1024;
    float g[2][8];
#pragma unroll
    for (int i = 0; i < 2; ++i) { const f32x4 a = *(const f32x4*)(gp + i * 512 + lane * 8), b = *(const f32x4*)(gp + i * 512 + lane * 8 + 4); g[i][0] = a[0]; g[i][1] = a[1]; g[i][2] = a[2]; g[i][3] = a[3]; g[i][4] = b[0]; g[i][5] = b[1]; g[i][6] = b[2]; g[i][7] = b[3]; }
    for (int t0 = (blockIdx.x * NWV + wid) * 2; t0 < T; t0 += grid_size() * NWV * 2) {
        u32x4_t hv[2][2], yv[2][2];
#pragma unroll
        for (int tt = 0; tt < 2; ++tt)
#pragma unroll
            for (int i = 0; i < 2; ++i) { hv[tt][i] = *(const u32x4_t*)(HB + (size_t)(t0 + tt) * 1024 + i * 512 + lane * 8); yv[tt][i] = *(const u32x4_t*)(V + (size_t)(t0 + tt) * 1024 + i * 512 + lane * 8); }
#pragma unroll
        for (int tt = 0; tt < 2; ++tt) {
            float vv[2][8]; float ss = 0.f;
#pragma unroll
            for (int i = 0; i < 2; ++i) { unpack8(yv[tt][i], vv[i]);
#pragma unroll
                for (int j = 0; j < 8; ++j) ss += vv[i][j] * vv[i][j]; }
            ss = wave_sum(ss);
            const float r = rsqrtf(ss * (1.0f / 1024.0f) + EPS);
            float s2 = 0.f;
#pragma unroll
            for (int i = 0; i < 2; ++i) {
                float h[8]; unpack8(hv[tt][i], h);
#pragma unroll
                for (int j = 0; j < 8; ++j) h[j] += vv[i][j] * r * g[i][j];
                if (layer == DEPTH - 1) { float* op = OUTW + (size_t)(t0 + tt) * 1024 + i * 512 + lane * 8; *(f32x4*)op = (f32x4){h[0], h[1], h[2], h[3]}; *(f32x4*)(op + 4) = (f32x4){h[4], h[5], h[6], h[7]}; }
                else {
#pragma unroll
                    for (int j = 0; j < 8; ++j) s2 += h[j] * h[j];
                    *(u32x4_t*)(HBW + (size_t)(t0 + tt) * 1024 + i * 512 + lane * 8) = (u32x4_t){pack2(h[0], h[1]), pack2(h[2], h[3]), pack2(h[4], h[5]), pack2(h[6], h[7])};
                }
            }
            if (layer != DEPTH - 1) { s2 = wave_sum(s2); if (lane == 0) RS[t0 + tt] = rsqrtf(s2 * (1.0f / 1024.0f) + EPS); }
        }
    }
}

struct EpiZ { bf16_t* Z; const float* rstd;
    __device__ __forceinline__ void operator()(int r, int c, f32x4 v) const { const float s = rstd[r]; *(uint2*)(Z + (size_t)r * ZW + c) = make_uint2(pack2(v[0] * s, v[1] * s), pack2(v[2] * s, v[3] * s)); } };
struct EpiBf16 { bf16_t* O; int ldo;
    __device__ __forceinline__ void operator()(int r, int c, f32x4 v) const { *(uint2*)(O + (size_t)r * ldo + c) = make_uint2(pack2(v[0], v[1]), pack2(v[2], v[3])); } };
struct EpiResid { const float* hin; float* out;
    __device__ __forceinline__ void operator()(int r, int c, f32x4 v) const { const f32x4 b = *(const f32x4*)(hin + (size_t)r * 1024 + c); *(f32x4*)(out + (size_t)r * 1024 + c) = b + v; } };
struct EpiMoe1 { const int* list; const float* rstd1; const float* bg; const float* bu; bf16_t* H;
    __device__ __forceinline__ void operator()(int r, int hc, f32x4 g, f32x4 u) const {
        const float s = rstd1[list[r] >> 2]; const f32x4 b0 = *(const f32x4*)(bg + hc), b1 = *(const f32x4*)(bu + hc); float o[4];
#pragma unroll
        for (int j = 0; j < 4; ++j) { const float gg = fminf(g[j] * s + b0[j], 7.0f); const float uu = fminf(fmaxf(u[j] * s + b1[j], -7.0f), 7.0f); o[j] = (uu + 1.0f) * gg * sigmoidf_(1.702f * gg); }
        *(uint2*)(H + (size_t)r * 1024 + hc) = make_uint2(pack2(o[0], o[1]), pack2(o[2], o[3])); } };
struct EpiMoe2 { const int* list; const float* topg; const float* bd; bf16_t* Y;
    __device__ __forceinline__ void operator()(int r, int c, f32x4 v) const { const int ts = list[r]; const float g = topg[ts]; const f32x4 b = *(const f32x4*)(bd + c);
        *(uint2*)(Y + (size_t)ts * 1024 + c) = make_uint2(pack2((v[0] + b[0]) * g, (v[1] + b[1]) * g), pack2((v[2] + b[2]) * g, (v[3] + b[3]) * g)); } };
struct EpiPle { const bf16_t* E; const float* rstd2; bf16_t* V;
    __device__ __forceinline__ void operator()(int r, int c, f32x4 v) const { const float s = rstd2[r]; const uint2 e = *(const uint2*)(E + (size_t)r * 1024 + c);
        const float o0 = bf2f(e.x & 0xffff) * sigmoidf_(v[0] * s), o1 = bf2f(e.x >> 16) * sigmoidf_(v[1] * s), o2 = bf2f(e.y & 0xffff) * sigmoidf_(v[2] * s), o3 = bf2f(e.y >> 16) * sigmoidf_(v[3] * s);
        *(uint2*)(V + (size_t)r * 1024 + c) = make_uint2(pack2(o0, o1), pack2(o2, o3)); } };


struct EpiZ8 { bf16_t* Z; const float* rstd; typedef float Pre;
    __device__ __forceinline__ Pre pre(int r, int) const { return rstd[r]; }
    __device__ __forceinline__ void post(int r, int c, f32x4 a, f32x4 b, Pre s) const { *(u32x4_t*)(Z + (size_t)r * ZW + c) = (u32x4_t){pack2(a[0] * s, a[1] * s), pack2(a[2] * s, a[3] * s), pack2(b[0] * s, b[1] * s), pack2(b[2] * s, b[3] * s)}; } };
struct EpiBf16_8 { bf16_t* O; int ldo; typedef int Pre;
    __device__ __forceinline__ Pre pre(int, int) const { return 0; }
    __device__ __forceinline__ void post(int r, int c, f32x4 a, f32x4 b, Pre) const { *(u32x4_t*)(O + (size_t)r * ldo + c) = (u32x4_t){pack2(a[0], a[1]), pack2(a[2], a[3]), pack2(b[0], b[1]), pack2(b[2], b[3])}; } };
struct EpiResid8 { const float* xin; bf16_t* HB; struct Pre { f32x4 lo, hi; };
    __device__ __forceinline__ Pre pre(int r, int c) const { Pre p;
        if (xin) { p.lo = *(const f32x4*)(xin + (size_t)r * 1024 + c); p.hi = *(const f32x4*)(xin + (size_t)r * 1024 + c + 4); }
        else { const u32x4_t e = *(const u32x4_t*)(HB + (size_t)r * 1024 + c); p.lo = (f32x4){bf2f(e[0] & 0xffff), bf2f(e[0] >> 16), bf2f(e[1] & 0xffff), bf2f(e[1] >> 16)}; p.hi = (f32x4){bf2f(e[2] & 0xffff), bf2f(e[2] >> 16), bf2f(e[3] & 0xffff), bf2f(e[3] >> 16)}; }
        return p; }
    __device__ __forceinline__ void post(int r, int c, f32x4 a, f32x4 b, const Pre& p) const { const f32x4 h0 = p.lo + a, h1 = p.hi + b;
        *(u32x4_t*)(HB + (size_t)r * 1024 + c) = (u32x4_t){pack2(h0[0], h0[1]), pack2(h0[2], h0[3]), pack2(h1[0], h1[1]), pack2(h1[2], h1[3])}; } };
struct EpiPle8 { const bf16_t* E; const float* rstd2; bf16_t* V; struct Pre { u32x4_t e; float s; };
    __device__ __forceinline__ Pre pre(int r, int c) const { Pre p; p.e = *(const u32x4_t*)(E + (size_t)r * 1024 + c); p.s = rstd2[r]; return p; }
    __device__ __forceinline__ void post(int r, int c, f32x4 a, f32x4 b, const Pre& p) const { const float s = p.s; const u32x4_t e = p.e;
        *(u32x4_t*)(V + (size_t)r * 1024 + c) = (u32x4_t){pack2(bf2f(e[0] & 0xffff) * sigmoidf_(a[0] * s), bf2f(e[0] >> 16) * sigmoidf_(a[1] * s)), pack2(bf2f(e[1] & 0xffff) * sigmoidf_(a[2] * s), bf2f(e[1] >> 16) * sigmoidf_(a[3] * s)),
                                                            pack2(bf2f(e[2] & 0xffff) * sigmoidf_(b[0] * s), bf2f(e[2] >> 16) * sigmoidf_(b[1] * s)), pack2(bf2f(e[3] & 0xffff) * sigmoidf_(b[2] * s), bf2f(e[3] >> 16) * sigmoidf_(b[3] * s))}; } };
__device__ __forceinline__ float swiglu_(float g, float u, float s, float bgv, float buv) { const float gg = fminf(g * s + bgv, 7.0f); const float uu = fminf(fmaxf(u * s + buv, -7.0f), 7.0f); return (uu + 1.0f) * gg * sigmoidf_(1.702f * gg); }

template <class Epi, bool PAIR>
__device__ __forceinline__ void gemm_simple_unit(const bf16_t* A, int lda, const int* rowidx, const bf16_t* Bt, int ldb, int M, int K, int mblk, int nblk, const Epi& epi) {
    const int tid = opaque_tid(), wid = tid >> 6, lane = tid & 63, wr = wid >> 1, wc = wid & 1, fr = lane & 15, fq = lane >> 4;
    const int m0 = mblk * 256 + wr * 64;
    if (m0 >= M) return;
    const bf16_t* ap[4]; const bf16_t* bp[4];
#pragma unroll
    for (int mi = 0; mi < 4; ++mi) { int r = m0 + mi * 16 + fr; if (r >= M) r = M - 1; const long ar = rowidx ? (long)(rowidx[r] >> 2) : (long)r; ap[mi] = A + ar * lda + fq * 8; }
#pragma unroll
    for (int ni = 0; ni < 4; ++ni) {
        int br;
        if (PAIR) { const int hc = nblk * 64 + wc * 32 + (ni & 1) * 16 + fr; br = (hc >> 7) * 256 + (hc & 127) + ((ni >> 1) ? 128 : 0); }
        else br = nblk * 128 + wc * 64 + ni * 16 + fr;
        bp[ni] = Bt + (long)br * ldb + fq * 8;
    }
    f32x4 acc[4][4];
#pragma unroll
    for (int mi = 0; mi < 4; ++mi)
#pragma unroll
        for (int ni = 0; ni < 4; ++ni) acc[mi][ni] = (f32x4){0.f, 0.f, 0.f, 0.f};
    for (int k0 = 0; k0 < K; k0 += 32) {
        bf16x8 a[4], b[4];
#pragma unroll
        for (int i = 0; i < 4; ++i) { a[i] = *(const bf16x8*)(ap[i] + k0); b[i] = *(const bf16x8*)(bp[i] + k0); }
#pragma unroll
        for (int mi = 0; mi < 4; ++mi)
#pragma unroll
            for (int ni = 0; ni < 4; ++ni) acc[mi][ni] = __builtin_amdgcn_mfma_f32_16x16x32_bf16(b[ni], a[mi], acc[mi][ni], 0, 0, 0);
    }
#pragma unroll
    for (int mi = 0; mi < 4; ++mi) {
        const int r = m0 + mi * 16 + fr;
        if (r < M) {
            if constexpr (PAIR) {
#pragma unroll
                for (int ni = 0; ni < 2; ++ni) epi(r, nblk * 64 + wc * 32 + ni * 16 + fq * 4, acc[mi][ni], acc[mi][ni + 2]);
            } else {
#pragma unroll
                for (int ni = 0; ni < 4; ++ni) epi(r, nblk * 128 + wc * 64 + ni * 16 + fq * 4, acc[mi][ni]);
            }
        }
    }
}

namespace fg {
typedef int v4i_t __attribute__((ext_vector_type(4))); typedef int v8i_t __attribute__((ext_vector_type(8)));
constexpr int BM = 256, BK = 64, HALF = 128, HTB = HALF * BK * 2  , STAGE_BYTES = 8 * HTB, NXCD = 8, WGM = 8;
__host__ __device__ __forceinline__ int lds_byte(int r, int c) { const int st = (r >> 4) * 2 + (c >> 5), rr = r & 15, cc = c & 31, ob = rr * 64 + cc * 2; return st * 1024 + (ob ^ (((ob >> 9) & 1) << 5)); }
__host__ __device__ __forceinline__ int perm32(int rho) { const int n = rho >> 4, i = rho & 15; return 8 * (i >> 2) + 4 * n + (i & 3); }
__host__ __device__ __forceinline__ void stage_rc(int b, int& R, int& C) { const int st = b / 1024, sb = b % 1024, swz = sb ^ (((sb >> 9) & 1) << 5); R = (st >> 1) * 16 + swz / 64; C = (st & 1) * 32 + (swz % 64) / 2; }

template <class PB>
__device__ __forceinline__ void gemm_phase(LAS unsigned char* lds, const PB& S) {
    constexpr int K = PB::K, nt = K / BK;
    typedef typename PB::Unit Unit;
    const int tid = opaque_tid(); const int wid = __builtin_amdgcn_readfirstlane(tid >> 6), lane = tid & 63, wr = wid >> 2, wc = wid & 3, fr = lane & 15, fq = lane >> 4;
    unsigned voffB[2];
#pragma unroll
    for (int i = 0; i < 2; ++i) { int R_, C_; stage_rc(tid * 16 + i * 8192, R_, C_); const int Rb_ = PB::PERM ? ((R_ & ~31) + perm32(R_ & 31)) : R_; voffB[i] = (unsigned)(Rb_ * K + C_) * 2u; }
#define FG_AOFFS(dst, unit) do { const int tz_ = opaque_tid(); _Pragma("unroll") for (int i_ = 0; i_ < 2; ++i_) { int R_, C_; stage_rc(tz_ * 16 + i_ * 8192, R_, C_); \
        _Pragma("unroll") for (int h_ = 0; h_ < 2; ++h_) dst[h_][i_] = S.a_off(unit, h_ * HALF + R_) + (unsigned)C_ * 2u; } } while (0)
    constexpr size_t kstep = (size_t)(BK * 2);
    constexpr size_t hstep = (size_t)HALF * K * 2;
    const unsigned ldsw = (unsigned)wid * 1024u;
    const int aoff = lds_byte(wr * 64 + fr, fq * 8), boff = lds_byte(wc * 32 + fr, fq * 8);
#define FG_SA(b, h) (((b) * 2 + (h)) * HTB)
#define FG_SB(b, h) ((4 + (b) * 2 + (h)) * HTB)
#define FG_STAGE_B(bufoff, gbase) do { _Pragma("unroll") for (int _i = 0; _i < 2; ++_i) \
        __builtin_amdgcn_global_load_lds((const unsigned*)((const char*)(gbase) + voffB[_i]), (LAS unsigned*)(lds + (bufoff) + ldsw + _i * 8192), 16, 0, 0); } while (0)
#define FG_STAGE_A(bufoff, o0, o1) do { \
        __builtin_amdgcn_global_load_lds((const unsigned*)(Abase + (o0)), (LAS unsigned*)(lds + (bufoff) + ldsw), 16, 0, 0); \
        __builtin_amdgcn_global_load_lds((const unsigned*)(Abase + (o1)), (LAS unsigned*)(lds + (bufoff) + ldsw + 8192), 16, 0, 0); } while (0)
#define FG_LD8(dst, off) do { const v4i_t lo_ = *(const LAS v4i_t*)(lds + (off)), hi_ = *(const LAS v4i_t*)(lds + (off) + 1024); dst = (v8i_t){lo_[0], lo_[1], lo_[2], lo_[3], hi_[0], hi_[1], hi_[2], hi_[3]}; } while (0)
#define FG_LDA(dst, b, h) do { _Pragma("unroll") for (int m = 0; m < 4; ++m) FG_LD8(dst[m], FG_SA(b, h) + aoff + m * 2048); } while (0)
#define FG_LDB(dst, b, h) do { _Pragma("unroll") for (int n = 0; n < 2; ++n) FG_LD8(dst[n], FG_SB(b, h) + boff + n * 2048); } while (0)
#define FG_HALF(v, k) ((k) == 0 ? __builtin_bit_cast(bf16x8, (v4i_t){(v)[0], (v)[1], (v)[2], (v)[3]}) : __builtin_bit_cast(bf16x8, (v4i_t){(v)[4], (v)[5], (v)[6], (v)[7]}))
#define FG_MMA(ai, bj, At, Bt) do { __builtin_amdgcn_s_setprio(1); \
        if constexpr (PB::FP8) { _Pragma("unroll") for (int m = 0; m < 4; ++m) _Pragma("unroll") for (int n = 0; n < 2; ++n) \
            asm volatile("v_mfma_scale_f32_16x16x128_f8f6f4 %0, %1, %2, %0, %3, %4 op_sel_hi:[0,0,0]" : "+v"(acc[ai][bj][m][n]) : "v"(Bt[n]), "v"(At[m]), "v"(sclW), "v"(sclA)); } \
        else { _Pragma("unroll") for (int m = 0; m < 4; ++m) _Pragma("unroll") for (int n = 0; n < 2; ++n) _Pragma("unroll") for (int k = 0; k < 2; ++k) \
            acc[ai][bj][m][n] = __builtin_amdgcn_mfma_f32_16x16x32_bf16(FG_HALF(Bt[n], k), FG_HALF(At[m], k), acc[ai][bj][m][n], 0, 0, 0); } \
        __builtin_amdgcn_s_setprio(0); } while (0)
#define FG_WAIT_V(n) asm volatile("s_waitcnt vmcnt(" #n ")" ::: "memory")
#define FG_WAIT_L(n) asm volatile("s_waitcnt lgkmcnt(" #n ")" ::: "memory")
#define FG_BAR __builtin_amdgcn_s_barrier()
#define FG_SCHED __builtin_amdgcn_sched_barrier(0)
    Unit cur, nxt; int ui = 0;
    if (!S.next(0, cur)) return;
    f32x4 acc[2][2][4][2];
#pragma unroll
    for (int a = 0; a < 2; ++a)
#pragma unroll
        for (int b = 0; b < 2; ++b)
#pragma unroll
            for (int m = 0; m < 4; ++m)
#pragma unroll
                for (int n = 0; n < 2; ++n) acc[a][b][m][n] = (f32x4){0.f, 0.f, 0.f, 0.f};
    v8i_t At[4], B0[2], B1[2];
    int sclW = 0x79797979, sclA = 0x7f7f7f7f;
    asm volatile("" : "+v"(sclW), "+v"(sclA));
    const char* Abase = S.a_base();
    unsigned vAc[2][2];
    FG_AOFFS(vAc, cur);
    const char* cB = S.b_base(cur);
    FG_STAGE_B(FG_SB(0, 0), cB); FG_STAGE_B(FG_SB(0, 1), cB + hstep); FG_STAGE_A(FG_SA(0, 0), vAc[0][0], vAc[0][1]); FG_STAGE_A(FG_SA(0, 1), vAc[1][0], vAc[1][1]);
    if (wr == 1) FG_BAR;
    FG_WAIT_V(2); FG_BAR;
    FG_STAGE_B(FG_SB(1, 0), cB + kstep); FG_STAGE_A(FG_SA(1, 0), vAc[0][0] + (unsigned)kstep, vAc[0][1] + (unsigned)kstep); FG_STAGE_B(FG_SB(1, 1), cB + hstep + kstep);
    FG_WAIT_V(6); FG_BAR;
    for (;;) {
        const bool has_next = S.next(ui + 1, nxt);
        const char* nB = has_next ? S.b_base(nxt) : cB;
        {
            unsigned vAn[2][2];
            if (has_next) { FG_AOFFS(vAn, nxt); }
            else {
#pragma unroll
                for (int h = 0; h < 2; ++h)
#pragma unroll
                    for (int i = 0; i < 2; ++i) vAn[h][i] = vAc[h][i];
            }
            *(LAS v4i_t*)(lds + STAGE_BYTES + 512 + opaque_tid() * 16) = (v4i_t){(int)vAn[0][0], (int)vAn[0][1], (int)vAn[1][0], (int)vAn[1][1]};
        }
#pragma unroll 1
        for (int t = 0; t < nt; t += 2) {
            const bool last = (t == nt - 2);
            const unsigned k1 = (unsigned)((t + 1) * (int)kstep), k2 = last ? 0u : (unsigned)((t + 2) * (int)kstep);
            const char* b2 = last ? nB : cB + (size_t)(t + 2) * kstep; const char* b3 = b2 + kstep;
            const unsigned c10_ = vAc[1][0], c11_ = vAc[1][1];
            if (last) { const v4i_t nx_ = *(const LAS v4i_t*)(lds + STAGE_BYTES + 512 + opaque_tid() * 16); vAc[0][0] = (unsigned)nx_[0]; vAc[0][1] = (unsigned)nx_[1]; vAc[1][0] = (unsigned)nx_[2]; vAc[1][1] = (unsigned)nx_[3]; }
#define FG_A2(h, i) (vAc[h][i] + k2)
            FG_LDB(B0, 0, 0); FG_LDB(B1, 0, 1); FG_SCHED; FG_LDA(At, 0, 0); FG_STAGE_A(FG_SA(1, 1), c10_ + k1, c11_ + k1);
            FG_WAIT_V(8); FG_WAIT_L(0); FG_BAR; FG_MMA(0, 0, At, B0); FG_MMA(0, 1, At, B1); FG_BAR; FG_SCHED;
            FG_LDA(At, 0, 1); FG_STAGE_B(FG_SB(0, 0), b2); FG_STAGE_B(FG_SB(0, 1), b2 + hstep); FG_STAGE_A(FG_SA(0, 0), FG_A2(0, 0), FG_A2(0, 1));
            FG_WAIT_V(8); FG_WAIT_L(0); FG_BAR; FG_MMA(1, 0, At, B0); FG_MMA(1, 1, At, B1); FG_BAR; FG_SCHED;
            FG_LDB(B0, 1, 0); FG_LDB(B1, 1, 1); FG_SCHED; FG_LDA(At, 1, 0); FG_STAGE_A(FG_SA(0, 1), FG_A2(1, 0), FG_A2(1, 1));
            FG_WAIT_V(8); FG_WAIT_L(0); FG_BAR; FG_MMA(0, 0, At, B0); FG_MMA(0, 1, At, B1); FG_BAR; FG_SCHED;
            FG_LDA(At, 1, 1); FG_STAGE_B(FG_SB(1, 0), b3); FG_STAGE_B(FG_SB(1, 1), b3 + hstep); FG_STAGE_A(FG_SA(1, 0), FG_A2(0, 0) + (unsigned)kstep, FG_A2(0, 1) + (unsigned)kstep);
            FG_WAIT_V(8); FG_WAIT_L(0); FG_BAR; FG_MMA(1, 0, At, B0); FG_MMA(1, 1, At, B1); FG_BAR; FG_SCHED;
        }
        if constexpr (PB::FP8) asm volatile("s_nop 15\n\ts_nop 15\n\ts_nop 15" ::: "memory");
        S.epilogue(acc, cur, wr, wc, fr, fq);
        if (!has_next) break;
#pragma unroll
        for (int a = 0; a < 2; ++a)
#pragma unroll
            for (int b = 0; b < 2; ++b)
#pragma unroll
                for (int m = 0; m < 4; ++m)
#pragma unroll
                    for (int n = 0; n < 2; ++n) acc[a][b][m][n] = (f32x4){0.f, 0.f, 0.f, 0.f};
        cur = nxt; cB = nB; ++ui;
    }
    FG_WAIT_V(0);
    if (wr == 0) FG_BAR;
    FG_BAR;
#undef FG_AOFFS
#undef FG_A2
#undef FG_SA
#undef FG_SB
#undef FG_STAGE_A
#undef FG_STAGE_B
#undef FG_LDA
#undef FG_LD8
#undef FG_HALF
#undef FG_LDB
#undef FG_MMA
#undef FG_WAIT_V
#undef FG_WAIT_L
#undef FG_BAR
#undef FG_SCHED
}

template <int K_, int LDA, class Epi, bool PERM_>
struct DenseProb {
    static constexpr int K = K_; static constexpr bool PERM = PERM_, FP8 = false;
    struct Unit { int pm, pn; };
    const bf16_t* A; const bf16_t* Bt; int nM, nN, nwg, G, c; Epi epi;
    __device__ __forceinline__ DenseProb(const bf16_t* A_, const bf16_t* Bt_, int N, const Epi& e) : A(A_), Bt(Bt_), nM(T / BM), nN(N / BM), nwg((T / BM) * (N / BM)), G(grid_size()), c(blockIdx.x), epi(e) {}
    __device__ __forceinline__ bool next(int i, Unit& u) const {
        const long L = (long)i * G + c; if (L >= nwg) return false;
        int wgid = (int)L; { const int q = nwg / NXCD, r = nwg % NXCD, xcd = wgid % NXCD, off = wgid / NXCD; wgid = (xcd < r ? xcd * (q + 1) : r * (q + 1) + (xcd - r) * q) + off; }
        const int nig = WGM * nN, gid = wgid / nig, fm = gid * WGM, gsz = (nM - fm) < WGM ? (nM - fm) : WGM;
        u.pm = fm + ((wgid % nig) % gsz); u.pn = (wgid % nig) / gsz; return true;
    }
    __device__ __forceinline__ const char* a_base() const { return (const char*)A; }
    __device__ __forceinline__ unsigned a_off(const Unit& u, int r) const { return (unsigned)((u.pm * BM + r) * LDA) * 2u; }
    __device__ __forceinline__ const char* b_base(const Unit& u) const { return (const char*)Bt + (size_t)u.pn * BM * K * 2; }
    __device__ __forceinline__ void epilogue(const f32x4 (&acc)[2][2][4][2], const Unit& u, int wr, int wc, int fr, int fq) const {
        const int row0 = u.pm * BM + wr * 64 + fr;
        if constexpr (PERM) {
            const int col0 = u.pn * BM + wc * 32 + 8 * fq;
#pragma unroll
            for (int ai = 0; ai < 2; ++ai) {
                typename Epi::Pre pre[4][2];
#pragma unroll
                for (int m = 0; m < 4; ++m)
#pragma unroll
                    for (int bj = 0; bj < 2; ++bj) pre[m][bj] = epi.pre(row0 + ai * HALF + m * 16, col0 + bj * HALF);
#pragma unroll
                for (int m = 0; m < 4; ++m)
#pragma unroll
                    for (int bj = 0; bj < 2; ++bj) epi.post(row0 + ai * HALF + m * 16, col0 + bj * HALF, acc[ai][bj][m][0], acc[ai][bj][m][1], pre[m][bj]);
            }
        } else {
            const int col0 = u.pn * BM + wc * 32 + 4 * fq;
#pragma unroll
            for (int ai = 0; ai < 2; ++ai)
#pragma unroll
                for (int m = 0; m < 4; ++m)
#pragma unroll
                    for (int bj = 0; bj < 2; ++bj)
#pragma unroll
                        for (int n = 0; n < 2; ++n) epi(row0 + ai * HALF + m * 16, col0 + bj * HALF + n * 16, acc[ai][bj][m][n]);
        }
    }
};
}
template <int K, int LDA, bool PERM, class Epi>
__device__ __forceinline__ void ph_gemm_fast(LAS unsigned char* lds, const bf16_t* A, const bf16_t* Bt, int N, const Epi& epi) {
    const fg::DenseProb<K, LDA, Epi, PERM> pb(A, Bt, N, epi);
    fg::gemm_phase(lds, pb);
}


namespace fg {
struct MoeUnit { int e, mblk, pn, rowoff, M; };
template <bool FIRST, bool FP8_>
struct MoeProb {
    static constexpr int K = FP8_ ? 512 : 1024  , NCOL = FIRST ? 8 : 4; static constexpr bool PERM = true, FP8 = FP8_; static constexpr unsigned RB = FP8_ ? 1024u : 2048u  ;
    typedef MoeUnit Unit;
    const Params& P; int layer; const LAS int* tab;
    int G, c; mutable int e_, acc_, off_;
    __device__ __forceinline__ MoeProb(const Params& P_, int layer_, const LAS int* tab_) : P(P_), layer(layer_), tab(tab_), G(grid_size()), c(blockIdx.x), e_(0), acc_(0), off_(0) {}
    __device__ __forceinline__ bool next(int i, Unit& u) const {
        const int j = i * (G >> 3) + (c >> 3), tile = (j / NCOL) * 8 + (c & 7);
        while (e_ < 32) { const int tl = (tab[e_] + 255) >> 8; if (tile < acc_ + tl) break; acc_ += tl; off_ += tl * 256; ++e_; }
        if (e_ >= 32) return false;
        u.e = e_; u.mblk = tile - acc_; u.pn = j % NCOL; u.rowoff = off_; u.M = tab[e_]; return true;
    }
    __device__ __forceinline__ const char* a_base() const { return FIRST ? (const char*)(P.ws + (FP8_ ? WS_YMIX : WS_HB)) : (const char*)(P.ws + WS_BIG); }
    __device__ __forceinline__ unsigned a_off(const Unit& u, int r) const {
        if (FIRST) { int rr = u.mblk * 256 + r; rr = rr < u.M ? rr : u.M - 1; const int ts = ((const int*)(P.ws + WS_LIST))[(size_t)u.e * T + rr]; return (unsigned)(ts >> 2) * RB; }
        return (unsigned)(u.rowoff + u.mblk * 256 + r) * RB;
    }
    __device__ __forceinline__ const char* b_base(const Unit& u) const {
        return FIRST ? (const char*)(P.ws + WS_W1) + ((size_t)u.e * 2048 + (size_t)u.pn * 256) * RB : (const char*)(P.ws + WS_W2) + ((size_t)u.e * 1024 + (size_t)u.pn * 256) * RB;
    }
    __device__ __forceinline__ void epilogue(const f32x4 (&acc)[2][2][4][2], const Unit& u, int wr, int wc, int fr, int fq) const {
        char* ws = P.ws; const int rl0 = u.mblk * 256 + wr * 64 + fr;
        if (FIRST) {
            const float* lrs = (const float*)(ws + WS_LRS) + (size_t)u.e * T;
            bf16_t* H = (bf16_t*)(ws + WS_BIG) + (size_t)u.rowoff * 1024;
            const int hc0 = u.pn * 128 + wc * 32 + 8 * fq;
            const float* bgp = P.moe_bg + ((size_t)layer * 32 + u.e) * 1024 + hc0; const float* bup = P.moe_bu + ((size_t)layer * 32 + u.e) * 1024 + hc0;
            const f32x4 bg0 = *(const f32x4*)bgp, bg1 = *(const f32x4*)(bgp + 4), bu0 = *(const f32x4*)bup, bu1 = *(const f32x4*)(bup + 4);
            float sc[2][4];
#pragma unroll
            for (int ai = 0; ai < 2; ++ai)
#pragma unroll
                for (int m = 0; m < 4; ++m) { const int r = rl0 + ai * HALF + m * 16; sc[ai][m] = lrs[r < u.M ? r : u.M - 1]; }
#pragma unroll
            for (int ai = 0; ai < 2; ++ai)
#pragma unroll
                for (int m = 0; m < 4; ++m) { const int r = rl0 + ai * HALF + m * 16;
                    if (r < u.M) {
                        const float s_ = sc[ai][m]; const f32x4 g0 = acc[ai][0][m][0], g1 = acc[ai][0][m][1], u0 = acc[ai][1][m][0], u1 = acc[ai][1][m][1];
                        const float h0 = swiglu_(g0[0], u0[0], s_, bg0[0], bu0[0]), h1 = swiglu_(g0[1], u0[1], s_, bg0[1], bu0[1]), h2 = swiglu_(g0[2], u0[2], s_, bg0[2], bu0[2]), h3 = swiglu_(g0[3], u0[3], s_, bg0[3], bu0[3]);
                        const float h4 = swiglu_(g1[0], u1[0], s_, bg1[0], bu1[0]), h5 = swiglu_(g1[1], u1[1], s_, bg1[1], bu1[1]), h6 = swiglu_(g1[2], u1[2], s_, bg1[2], bu1[2]), h7 = swiglu_(g1[3], u1[3], s_, bg1[3], bu1[3]);
                        if constexpr (FP8_) *(uint2*)((unsigned char*)(ws + WS_BIG) + (size_t)(u.rowoff + r) * 1024 + hc0) = make_uint2(pack4_fp8(h0, h1, h2, h3), pack4_fp8(h4, h5, h6, h7));
                        else *(u32x4_t*)(H + (size_t)r * 1024 + hc0) = (u32x4_t){pack2(h0, h1), pack2(h2, h3), pack2(h4, h5), pack2(h6, h7)};
                    } }
        } else {
            const int* list = (const int*)(ws + WS_LIST) + (size_t)u.e * T; const float* lgt = (const float*)(ws + WS_LGT) + (size_t)u.e * T;
            bf16_t* Y = (bf16_t*)(ws + WS_Y);
            const int col0 = u.pn * 256 + wc * 32 + 8 * fq;
            const float* bdp = P.moe_bd + ((size_t)layer * 32 + u.e) * 1024 + col0;
            f32x4 bd[2][2];
#pragma unroll
            for (int bj = 0; bj < 2; ++bj) { bd[bj][0] = *(const f32x4*)(bdp + bj * HALF); bd[bj][1] = *(const f32x4*)(bdp + bj * HALF + 4); }
            int tsv[2][4]; float gv[2][4];
#pragma unroll
            for (int ai = 0; ai < 2; ++ai)
#pragma unroll
                for (int m = 0; m < 4; ++m) { const int r = rl0 + ai * HALF + m * 16; const int rc = r < u.M ? r : u.M - 1; tsv[ai][m] = list[rc]; gv[ai][m] = lgt[rc]; }
#pragma unroll
            for (int ai = 0; ai < 2; ++ai)
#pragma unroll
                for (int m = 0; m < 4; ++m) { const int r = rl0 + ai * HALF + m * 16;
                    if (r < u.M) {
                        const float g = gv[ai][m]; bf16_t* yr = Y + (size_t)tsv[ai][m] * 1024 + col0;
#pragma unroll
                        for (int bj = 0; bj < 2; ++bj) { const f32x4 a = (acc[ai][bj][m][0] + bd[bj][0]) * g, b = (acc[ai][bj][m][1] + bd[bj][1]) * g;
                            if constexpr (FP8_) *(uint2*)((unsigned char*)(ws + WS_Y) + (size_t)tsv[ai][m] * 1024 + col0 + bj * HALF) = make_uint2(pack4_fp8(a[0] * 16.0f, a[1] * 16.0f, a[2] * 16.0f, a[3] * 16.0f), pack4_fp8(b[0] * 16.0f, b[1] * 16.0f, b[2] * 16.0f, b[3] * 16.0f));
                            else *(u32x4_t*)(yr + bj * HALF) = (u32x4_t){pack2(a[0], a[1]), pack2(a[2], a[3]), pack2(b[0], b[1]), pack2(b[2], b[3])}; }
                    } }
        }
    }
};
}
template <bool FIRST, bool FP8>
__device__ __forceinline__ void ph_moe_fast(const Params& P, int layer, LAS unsigned char* lds) {
    LAS int* tab = (LAS int*)(lds + fg::STAGE_BYTES);
    const int tz = opaque_tid();
    if (tz < 32) tab[tz] = (int)((const unsigned*)(P.ws + WS_CTL))[CTL_CNT + layer * 32 + tz];
    __syncthreads();
    const fg::MoeProb<FIRST, FP8> pb(P, layer, tab);
    fg::gemm_phase(lds, pb);
}

template <class Epi>
__device__ __forceinline__ void ph_gemm_dense(const bf16_t* A, int lda, const bf16_t* Bt, int N, int K, const Epi& epi) {
    const int ncol = N / 128, nunits = (T / 256) * ncol;
    for (int u = blockIdx.x; u < nunits; u += grid_size()) gemm_simple_unit<Epi, false>(A, lda, nullptr, Bt, K, T, K, u / ncol, u % ncol, epi);
}
__device__ __forceinline__ bool moe_decode(const unsigned* cnt, int ncol, int u, int& e, int& mblk, int& nblk, int& rowoff) {
    int acc = 0, off = 0;
    for (int i = 0; i < 32; ++i) {
        const int tl = ((int)cnt[i] + 255) >> 8;
        if (u < (acc + tl) * ncol) { e = i; const int local = u - acc * ncol; mblk = local / ncol; nblk = local % ncol; rowoff = off; return true; }
        acc += tl; off += tl * 256;
    }
    return false;
}
__device__ __forceinline__ void ph_moe1(const Params& P, int layer) {
    char* ws = P.ws; const unsigned* cnt = (const unsigned*)(ws + WS_CTL) + CTL_CNT + layer * 32;
    for (int u = blockIdx.x;; u += grid_size()) {
        int e, mblk, nblk, off; if (!moe_decode(cnt, 16, u, e, mblk, nblk, off)) break;
        const int* list = (const int*)(ws + WS_LIST) + (size_t)e * T;
        EpiMoe1 ep{list, (const float*)(ws + WS_RSTD) + T, P.moe_bg + ((size_t)layer * 32 + e) * 1024, P.moe_bu + ((size_t)layer * 32 + e) * 1024, (bf16_t*)(ws + WS_BIG) + (size_t)off * 1024};
        gemm_simple_unit<EpiMoe1, true>((const bf16_t*)(ws + WS_HB), 1024, list, (const bf16_t*)(ws + WS_W1) + (size_t)e * 2048 * 1024, 1024, (int)cnt[e], 1024, mblk, nblk, ep);
    }
}
__device__ __forceinline__ void ph_moe2(const Params& P, int layer) {
    char* ws = P.ws; const unsigned* cnt = (const unsigned*)(ws + WS_CTL) + CTL_CNT + layer * 32;
    for (int u = blockIdx.x;; u += grid_size()) {
        int e, mblk, nblk, off; if (!moe_decode(cnt, 8, u, e, mblk, nblk, off)) break;
        const int* list = (const int*)(ws + WS_LIST) + (size_t)e * T;
        EpiMoe2 ep{list, (const float*)(ws + WS_TOPG), P.moe_bd + ((size_t)layer * 32 + e) * 1024, (bf16_t*)(ws + WS_Y)};
        gemm_simple_unit<EpiMoe2, false>((const bf16_t*)(ws + WS_BIG) + (size_t)off * 1024, 1024, nullptr, (const bf16_t*)(ws + WS_W2) + (size_t)e * 1024 * 1024, 1024, (int)cnt[e], 1024, mblk, nblk, ep);
    }
}

__device__ __forceinline__ void ph_attn_simple(const Params& P, unsigned char* lds) {
    float (*qs)[96] = (float (*)[96])lds; float (*ps)[64] = (float (*)[64])(lds + 8 * 96 * 4);
    const int tid = opaque_tid(), wid = tid >> 6, lane = tid & 63;
    const bf16_t* Q = (const bf16_t*)(P.ws + WS_BIG + BIG_Q); const bf16_t* Kd = (const bf16_t*)(P.ws + WS_BIG + BIG_K); const bf16_t* KV = (const bf16_t*)(P.ws + WS_BIG + BIG_KV);
    bf16_t* YM = (bf16_t*)(P.ws + WS_YMIX);
    for (int u = blockIdx.x; u < T; u += grid_size()) {
        const long gw = (long)u * 8 + wid;
        const int s = (int)(gw & 4095), bh = (int)(gw >> 12), b = bh >> 3, h = bh & 7;
        const long t = (long)b * SEQ + s;
        __syncthreads();
        qs[wid][lane] = bf2f(Q[t * 768 + h * 96 + lane]);
        if (lane < 32) qs[wid][64 + lane] = bf2f(Q[t * 768 + h * 96 + 64 + lane]);
        __syncthreads();
        float m = -INFINITY, l = 0.f, o = 0.f;
        for (int j0 = 0; j0 <= s; j0 += 64) {
            const int j = j0 + lane; const bool valid = j <= s;
            const long kt = (long)b * SEQ + (valid ? j : s);
            const uint4* kr = (const uint4*)(Kd + (kt * 8 + h) * 96);
            float sc = 0.f;
#pragma unroll
            for (int c = 0; c < 12; ++c) {
                const uint4 kk = kr[c];
                sc += qs[wid][c * 8 + 0] * bf2f(kk.x & 0xffff) + qs[wid][c * 8 + 1] * bf2f(kk.x >> 16) + qs[wid][c * 8 + 2] * bf2f(kk.y & 0xffff) + qs[wid][c * 8 + 3] * bf2f(kk.y >> 16)
                    + qs[wid][c * 8 + 4] * bf2f(kk.z & 0xffff) + qs[wid][c * 8 + 5] * bf2f(kk.z >> 16) + qs[wid][c * 8 + 6] * bf2f(kk.w & 0xffff) + qs[wid][c * 8 + 7] * bf2f(kk.w >> 16);
            }
            sc = valid ? sc : -INFINITY;
            const float mn = fmaxf(m, wave_max(sc));
            const float pj = valid ? __expf(sc - mn) : 0.f;
            const float f = __expf(m - mn);
            l = l * f + wave_sum(pj); o *= f; m = mn;
            __syncthreads();
            ps[wid][lane] = pj;
            __syncthreads();
            const bf16_t* vb = KV + ((long)b * SEQ + j0) * 1024 + h * 128 + 64 + lane;
#pragma unroll 8
            for (int jj = 0; jj < 64; ++jj) o += ps[wid][jj] * bf2f(vb[(long)jj * 1024]);
        }
        YM[t * 1024 + 256 + h * 64 + lane] = f2bf(o / l);
    }
}


namespace at {
typedef short s16x4 __attribute__((ext_vector_type(4)));
constexpr int KSLOT = 12288, VSLOT = 8192, NSLOT = 4, LDS_K = 0, LDS_V = NSLOT * KSLOT, LDS_END = LDS_V + NSLOT * VSLOT;
typedef float f32x2_t __attribute__((ext_vector_type(2))); typedef __bf16 bf16x2_t __attribute__((ext_vector_type(2)));
__device__ __forceinline__ unsigned cvtpk(float lo, float hi) { const f32x2_t v = {lo, hi}; const bf16x2_t b = __builtin_convertvector(v, bf16x2_t); return __builtin_bit_cast(unsigned, b); }
__device__ __forceinline__ void glds16(const void* gsrc, unsigned lds_dst) { unsigned keep;
    asm volatile("s_mov_b32 %0, m0\n\ts_mov_b32 m0, %2\n\ts_nop 0\n\tglobal_load_lds_dwordx4 %1, off\n\ts_mov_b32 m0, %0" : "=&s"(keep) : "v"(gsrc), "s"(lds_dst) : "memory"); }
__device__ __forceinline__ s16x4 vtr(const LAS unsigned char* p) { return __builtin_bit_cast(s16x4, __builtin_amdgcn_ds_read_tr16_b64_v4i16((LAS s16x4*)p)); }

__device__ __forceinline__ void attn_unit(int b, int h, int qb, const bf16_t* Q, const bf16_t* Kd, const bf16_t* KV, bf16_t* YM, LAS unsigned char* lds) {
    const int tid = opaque_tid(); const int lane = tid & 63, r32 = lane & 31, hi = lane >> 5; const int wid = __builtin_amdgcn_readfirstlane(tid >> 6);
    const int q0 = qb * 256; const size_t row = (size_t)b * SEQ + q0 + wid * 32 + r32;
    const int NT = 4 * qb + 4;
    const char* ksrcA = (const char*)(Kd + (((size_t)b * SEQ + lane) * 8 + h) * 96) + wid * 16;
    const char* ksrcB = (const char*)(Kd + (((size_t)b * SEQ + lane) * 8 + h) * 96) + (8 + (wid & 3)) * 16;
    const char* vsrc = (const char*)(KV + ((size_t)b * SEQ + 16 * (wid & 3) + (lane >> 2)) * 1024 + h * 128 + 64 + (wid >> 2) * 32 + (lane & 3) * 8);
    const unsigned lds0 = (unsigned)(size_t)lds;
#define AT_DMA(j, slot) do { \
        glds16(ksrcA + (size_t)(j) * (64 * 1536), (unsigned)__builtin_amdgcn_readfirstlane((int)(lds0 + LDS_K + (slot) * KSLOT + wid * 1024))); \
        glds16(ksrcB + (size_t)(j) * (64 * 1536), (unsigned)__builtin_amdgcn_readfirstlane((int)(lds0 + LDS_K + (slot) * KSLOT + (8 + (wid & 3)) * 1024))); \
        glds16(vsrc + (size_t)(j) * (64 * 2048), (unsigned)__builtin_amdgcn_readfirstlane((int)(lds0 + LDS_V + (slot) * VSLOT + wid * 1024))); } while (0)
    AT_DMA(0, 0); AT_DMA(1, 1); AT_DMA(2, 2);
    bf16x8 qf[6];
#pragma unroll
    for (int ks = 0; ks < 6; ++ks) qf[ks] = *(const bf16x8*)(Q + row * 768 + h * 96 + ks * 16 + hi * 8);
    asm volatile("" : "+v"(qf[0]), "+v"(qf[1]), "+v"(qf[2]), "+v"(qf[3]), "+v"(qf[4]), "+v"(qf[5]));
    constexpr float THR = 8.0f;
    float mref = 0.f, l = 0.f;
    f32x16 o0, o1, negm;
#pragma unroll
    for (int r = 0; r < 16; ++r) { o0[r] = 0.f; o1[r] = 0.f; negm[r] = 0.f; }
    const int kfo = hi * 1024 + r32 * 16;
    const int vfo = ((lane >> 4) & 1) * 32 + (lane & 3) * 8 + (4 * hi + ((lane & 15) >> 2)) * 64;
    const int qrel = wid * 32 + r32;
    int slot = 0;
    for (int j = 0; j < NT; ++j) {
        if (j + 2 < NT) asm volatile("s_waitcnt vmcnt(6)\n\ts_barrier" ::: "memory"); else if (j + 1 < NT) asm volatile("s_waitcnt vmcnt(3)\n\ts_barrier" ::: "memory"); else asm volatile("s_waitcnt vmcnt(0)\n\ts_barrier" ::: "memory");
        if (j + 3 < NT) { AT_DMA(j + 3, (slot + 3) & 3); }
        const LAS unsigned char* kp = lds + LDS_K + slot * KSLOT + kfo;
        const LAS unsigned char* vp = lds + LDS_V + slot * VSLOT + vfo;
        f32x16 s0, s1;
#pragma unroll
        for (int ks = 0; ks < 6; ++ks) {
            const bf16x8 k0 = *(const LAS bf16x8*)(kp + ks * 2048), k1 = *(const LAS bf16x8*)(kp + ks * 2048 + 512);
            s0 = __builtin_amdgcn_mfma_f32_32x32x16_bf16(k0, qf[ks], ks == 0 ? negm : s0, 0, 0, 0);
            s1 = __builtin_amdgcn_mfma_f32_32x32x16_bf16(k1, qf[ks], ks == 0 ? negm : s1, 0, 0, 0);
        }
        if (j >= NT - 4) {
            const int kb = 64 * (j - (NT - 4)) + 4 * hi;
#pragma unroll
            for (int r = 0; r < 16; ++r) { const int kv = kb + (r & 3) + 8 * (r >> 2); if (kv > qrel) s0[r] = -INFINITY; if (kv + 32 > qrel) s1[r] = -INFINITY; }
        }
        float rm = fmaxf(fmaxf(s0[0], s1[0]), fmaxf(s0[1], s1[1]));
#pragma unroll
        for (int r = 2; r < 16; r += 2) rm = fmaxf(rm, fmaxf(fmaxf(s0[r], s1[r]), fmaxf(s0[r + 1], s1[r + 1])));
        rm = xhalf_max(rm);
        if (__any(rm > THR)) {
            const float dl = fmaxf(rm, 0.f);
            mref += dl;
#pragma unroll
            for (int r = 0; r < 16; ++r) { s0[r] -= dl; s1[r] -= dl; negm[r] = -mref; }
            const float f = __builtin_amdgcn_exp2f(-dl);
            l *= f;
#pragma unroll
            for (int r = 0; r < 16; ++r) { o0[r] *= f; o1[r] *= f; }
        }
        float ps0 = 0.f, ps1 = 0.f;
#pragma unroll
        for (int r = 0; r < 16; ++r) { s0[r] = __builtin_amdgcn_exp2f(s0[r]); s1[r] = __builtin_amdgcn_exp2f(s1[r]); ps0 += s0[r]; ps1 += s1[r]; }
        l += ps0 + ps1;
        bf16x8 pf[4];
        {
            unsigned w[16];
#pragma unroll
            for (int i = 0; i < 8; ++i) { w[i] = cvtpk(s0[2 * i], s0[2 * i + 1]); w[8 + i] = cvtpk(s1[2 * i], s1[2 * i + 1]); }
#pragma unroll
            for (int k = 0; k < 4; ++k) { typedef unsigned u32x4 __attribute__((ext_vector_type(4))); const u32x4 t = {w[4 * k], w[4 * k + 1], w[4 * k + 2], w[4 * k + 3]}; pf[k] = __builtin_bit_cast(bf16x8, t); }
        }
#pragma unroll
        for (int k = 0; k < 4; ++k) {
            const s16x4 a0 = vtr(vp + k * 1024), a1 = vtr(vp + k * 1024 + 512), c0 = vtr(vp + 4096 + k * 1024), c1 = vtr(vp + 4096 + k * 1024 + 512);
            const bf16x8 v0 = {a0[0], a0[1], a0[2], a0[3], a1[0], a1[1], a1[2], a1[3]}, v1 = {c0[0], c0[1], c0[2], c0[3], c1[0], c1[1], c1[2], c1[3]};
            o0 = __builtin_amdgcn_mfma_f32_32x32x16_bf16(v0, pf[k], o0, 0, 0, 0);
            o1 = __builtin_amdgcn_mfma_f32_32x32x16_bf16(v1, pf[k], o1, 0, 0, 0);
        }
        slot = (slot + 1) & 3;
    }
    l = xhalf_sum(l);
    const float rl = 1.0f / l;
    bf16_t* op = YM + row * 1024 + 256 + h * 64 + 4 * hi;
#pragma unroll
    for (int g = 0; g < 4; ++g) {
        *(uint2*)(op + 8 * g) = make_uint2(cvtpk(o0[4 * g] * rl, o0[4 * g + 1] * rl), cvtpk(o0[4 * g + 2] * rl, o0[4 * g + 3] * rl));
        *(uint2*)(op + 32 + 8 * g) = make_uint2(cvtpk(o1[4 * g] * rl, o1[4 * g + 1] * rl), cvtpk(o1[4 * g + 2] * rl, o1[4 * g + 3] * rl));
    }
    asm volatile("s_waitcnt lgkmcnt(0)\n\ts_barrier" ::: "memory");
#undef AT_DMA
}
}
__device__ __forceinline__ void ph_attn_fast(const Params& P, LAS unsigned char* lds) {
    const bf16_t* Q = (const bf16_t*)(P.ws + WS_BIG + BIG_Q); const bf16_t* Kd = (const bf16_t*)(P.ws + WS_BIG + BIG_K); const bf16_t* KV = (const bf16_t*)(P.ws + WS_BIG + BIG_KV);
    bf16_t* YM = (bf16_t*)(P.ws + WS_YMIX);
    const int G = grid_size();
    for (int v0 = (blockIdx.x % 8) * (G / 8) + blockIdx.x / 8; v0 < 256; v0 += G) {
        const int bh = v0 >> 2, s = v0 & 3;
#pragma unroll 1
        for (int i = 0; i < 4; ++i) { const int qb = (i == 0) ? s : (i == 1) ? 7 - s : (i == 2) ? 8 + s : 15 - s; at::attn_unit(bh >> 3, bh & 7, qb, Q, Kd, KV, YM, lds); }
    }
}


template <bool DRY = false> __device__ __forceinline__ void ph_gla_x(const Params& P, LAS unsigned char* lds) {
    const int tid = opaque_tid(); const int wid = __builtin_amdgcn_readfirstlane(tid >> 6), lane = tid & 63;
    LAS float* kend = (LAS float*)(lds + wid * 8192);
    const bf16_t* Z = (const bf16_t*)(P.ws + WS_BIG + BIG_Z); float* LA = (float*)(P.ws + WS_BIG + BIG_LA);
    float* UPD = DRY ? (float*)(P.ws + WS_Y + 32 * MiB) : (float*)(P.ws + WS_UPD); float* DEC = DRY ? (float*)(P.ws + WS_Y + 64 * MiB) : (float*)(P.ws + WS_DEC); float* LAW = DRY ? (float*)(P.ws + WS_Y) : LA;
    for (int u = blockIdx.x * NWV + wid; u < 2048; u += grid_size() * NWV) {
        const int bh = u >> 6, n = u & 63, b = bh >> 2, h = bh & 3;
        const size_t t0 = (size_t)b * SEQ + n * 64;
        const int k = lane & 31, half = lane >> 5;
        float c[32]; float run = 0.f;
#pragma unroll
        for (int i = 0; i < 32; ++i) { run += LA[(t0 + 32 * half + i) * 128 + h * 32 + k]; c[i] = run; }
        const float tot0 = __shfl(run, k);
        const float add = half ? tot0 : 0.f;
        const float blast = __shfl(run, 32 + k) + tot0;
        float kk[32];
#pragma unroll
        for (int i = 0; i < 32; ++i) kk[i] = bf2f(Z[(t0 + 32 * half + i) * ZW + ZC_GK + h * 32 + k]);
#pragma unroll
        for (int i = 0; i < 32; ++i) {
            const float bc = c[i] + add; const size_t t = t0 + 32 * half + i;
            LAW[t * 128 + h * 32 + k] = bc;
            kend[(32 * half + i) * 32 + k] = kk[i] * __expf(blast - bc);
        }
        if (half == 0) DEC[(size_t)u * 32 + k] = __expf(blast);
        asm volatile("s_waitcnt lgkmcnt(0)" ::: "memory");
        float acc[32];
#pragma unroll
        for (int i = 0; i < 32; ++i) acc[i] = 0.f;
#pragma unroll 4
        for (int j = 0; j < 64; ++j) {
            const float vj = bf2f(Z[(t0 + j) * ZW + ZC_GV + h * 64 + lane]);
#pragma unroll
            for (int kq = 0; kq < 8; ++kq) { const f32x4 ke = *(const LAS f32x4*)(kend + j * 32 + kq * 4); acc[4 * kq] += ke[0] * vj; acc[4 * kq + 1] += ke[1] * vj; acc[4 * kq + 2] += ke[2] * vj; acc[4 * kq + 3] += ke[3] * vj; }
        }
#pragma unroll
        for (int kk = 0; kk < 32; ++kk) UPD[((size_t)u * 32 + kk) * 64 + lane] = acc[kk];
        asm volatile("s_waitcnt lgkmcnt(0)" ::: "memory");
    }
}
__device__ __forceinline__ void ph_gla_scan(const Params& P) {
    const int tz = opaque_tid();
    const float* UPD = (const float*)(P.ws + WS_UPD); const float* DEC = (const float*)(P.ws + WS_DEC); bf16_t* SP = (bf16_t*)(P.ws + WS_SPREV);
    for (int e = blockIdx.x * NTHR + tz; e < 32 * 2048; e += grid_size() * NTHR) {
        const int bh = e >> 11, kv = e & 2047, k = kv >> 6;
        float st = 0.f;
        for (int n8 = 0; n8 < 64; n8 += 8) {
            float dd[8], uu[8];
#pragma unroll
            for (int q = 0; q < 8; ++q) { const size_t u = (size_t)bh * 64 + n8 + q; dd[q] = DEC[u * 32 + k]; uu[q] = UPD[u * 2048 + kv]; }
#pragma unroll
            for (int q = 0; q < 8; ++q) { const size_t u = (size_t)bh * 64 + n8 + q; SP[u * 2048 + kv] = f2bf(st); st = dd[q] * st + uu[q]; }
        }
    }
}
__device__ __forceinline__ void ph_gla_y(const Params& P, int layer, LAS unsigned char* lds) {
    using at::f32x16; using at::s16x4; using at::vtr; using at::cvtpk;
    typedef unsigned u32x4 __attribute__((ext_vector_type(4)));
    const int tid = opaque_tid(); const int wid = __builtin_amdgcn_readfirstlane(tid >> 6), lane = tid & 63, r32 = lane & 31, hi = lane >> 5;
    LAS unsigned char* vl = lds + wid * 12288; LAS unsigned char* sl = vl + 8192;
    const bf16_t* Z = (const bf16_t*)(P.ws + WS_BIG + BIG_Z); const float* LA = (const float*)(P.ws + WS_BIG + BIG_LA); const bf16_t* SP = (const bf16_t*)(P.ws + WS_SPREV);
    bf16_t* YM = (bf16_t*)(P.ws + WS_YMIX); const float* gon = P.gla_on + layer * 64;
    const int vfo = ((lane >> 4) & 1) * 32 + (lane & 3) * 8 + (4 * hi + ((lane & 15) >> 2)) * 64;
    const int sfo = ((lane >> 4) & 1) * 32 + (lane & 3) * 8 + ((lane & 15) >> 2) * 64;
    for (int u = blockIdx.x * NWV + wid; u < 2048; u += grid_size() * NWV) {
        const int bh = u >> 6, n = u & 63, b = bh >> 2, h = bh & 3;
        const size_t t0 = (size_t)b * SEQ + n * 64;
#pragma unroll
        for (int p = 0; p < 8; ++p) {
            const int row = 8 * p + (lane >> 3), dv = 8 * (lane & 7);
            const u32x4 x = *(const u32x4*)(Z + (t0 + row) * ZW + ZC_GV + h * 64 + dv);
            *(LAS u32x4*)(vl + (dv >> 5) * 4096 + (row >> 3) * 512 + (row & 7) * 64 + (dv & 31) * 2) = x;
        }
#pragma unroll
        for (int p = 0; p < 4; ++p) {
            const int row = 8 * p + (lane >> 3), dv = 8 * (lane & 7);
            const u32x4 x = *(const u32x4*)(SP + ((size_t)u * 32 + row) * 64 + dv);
            *(LAS u32x4*)(sl + (dv >> 5) * 2048 + (row >> 3) * 512 + (row & 7) * 64 + (dv & 31) * 2) = x;
        }
        bf16x8 qfr[2][2], kfr[2][2];
#pragma unroll
        for (int blk = 0; blk < 2; ++blk)
#pragma unroll
            for (int ks = 0; ks < 2; ++ks) {
                const size_t t = t0 + 32 * blk + r32; const int k0 = 16 * ks + 8 * hi;
                const uint4 qraw = *(const uint4*)(Z + t * ZW + ZC_GQ + h * 32 + k0), kraw = *(const uint4*)(Z + t * ZW + ZC_GK + h * 32 + k0);
                const f32x4 b0 = *(const f32x4*)(LA + t * 128 + h * 32 + k0), b1 = *(const f32x4*)(LA + t * 128 + h * 32 + k0 + 4);
                const unsigned qw[4] = {qraw.x, qraw.y, qraw.z, qraw.w}, kw[4] = {kraw.x, kraw.y, kraw.z, kraw.w};
                const float bcv[8] = {b0[0], b0[1], b0[2], b0[3], b1[0], b1[1], b1[2], b1[3]};
                u32x4 qo, ko;
#pragma unroll
                for (int w = 0; w < 4; ++w) {
                    const float e0 = __expf(bcv[2 * w]), e1 = __expf(bcv[2 * w + 1]);
                    const float q0 = bf2f(qw[w] & 0xffff) * 0.17677669529663687f * e0, q1 = bf2f(qw[w] >> 16) * 0.17677669529663687f * e1;
                    const float k0f = bf2f(kw[w] & 0xffff) * __expf(-bcv[2 * w]), k1f = bf2f(kw[w] >> 16) * __expf(-bcv[2 * w + 1]);
                    qo[w] = cvtpk(q0, q1); ko[w] = cvtpk(k0f, k1f);
                }
                qfr[blk][ks] = __builtin_bit_cast(bf16x8, qo); kfr[blk][ks] = __builtin_bit_cast(bf16x8, ko);
            }
        f32x16 z16;
#pragma unroll
        for (int r = 0; r < 16; ++r) z16[r] = 0.f;
        f32x16 s00 = __builtin_amdgcn_mfma_f32_32x32x16_bf16(kfr[0][0], qfr[0][0], z16, 0, 0, 0); s00 = __builtin_amdgcn_mfma_f32_32x32x16_bf16(kfr[0][1], qfr[0][1], s00, 0, 0, 0);
        f32x16 s01 = __builtin_amdgcn_mfma_f32_32x32x16_bf16(kfr[0][0], qfr[1][0], z16, 0, 0, 0); s01 = __builtin_amdgcn_mfma_f32_32x32x16_bf16(kfr[0][1], qfr[1][1], s01, 0, 0, 0);
        f32x16 s11 = __builtin_amdgcn_mfma_f32_32x32x16_bf16(kfr[1][0], qfr[1][0], z16, 0, 0, 0); s11 = __builtin_amdgcn_mfma_f32_32x32x16_bf16(kfr[1][1], qfr[1][1], s11, 0, 0, 0);
#pragma unroll
        for (int r = 0; r < 16; ++r) { const int jl = (r & 3) + 8 * (r >> 2) + 4 * hi; if (jl > r32) { s00[r] = 0.f; s11[r] = 0.f; } }
        bf16x8 p00[2], p01[2], p11[2];
#pragma unroll
        for (int sp = 0; sp < 2; ++sp) {
            u32x4 a, c, d;
#pragma unroll
            for (int w = 0; w < 4; ++w) { a[w] = cvtpk(s00[8 * sp + 2 * w], s00[8 * sp + 2 * w + 1]); c[w] = cvtpk(s01[8 * sp + 2 * w], s01[8 * sp + 2 * w + 1]); d[w] = cvtpk(s11[8 * sp + 2 * w], s11[8 * sp + 2 * w + 1]); }
            p00[sp] = __builtin_bit_cast(bf16x8, a); p01[sp] = __builtin_bit_cast(bf16x8, c); p11[sp] = __builtin_bit_cast(bf16x8, d);
        }
        asm volatile("s_waitcnt lgkmcnt(0)" ::: "memory");
        f32x16 o[2][2];
#pragma unroll
        for (int vb = 0; vb < 2; ++vb) {
            o[vb][0] = z16; o[vb][1] = z16;
#pragma unroll
            for (int k2 = 0; k2 < 4; ++k2) {
                const s16x4 a0 = vtr(vl + vfo + vb * 4096 + k2 * 1024), a1 = vtr(vl + vfo + vb * 4096 + k2 * 1024 + 512);
                const bf16x8 vt = {a0[0], a0[1], a0[2], a0[3], a1[0], a1[1], a1[2], a1[3]};
                if (k2 < 2) { o[vb][0] = __builtin_amdgcn_mfma_f32_32x32x16_bf16(vt, p00[k2], o[vb][0], 0, 0, 0); o[vb][1] = __builtin_amdgcn_mfma_f32_32x32x16_bf16(vt, p01[k2], o[vb][1], 0, 0, 0); }
                else o[vb][1] = __builtin_amdgcn_mfma_f32_32x32x16_bf16(vt, p11[k2 - 2], o[vb][1], 0, 0, 0);
            }
#pragma unroll
            for (int ks = 0; ks < 2; ++ks) {
                const s16x4 a0 = vtr(sl + sfo + vb * 2048 + (2 * ks + hi) * 512), a1 = vtr(sl + sfo + vb * 2048 + (2 * ks + hi) * 512 + 256);
                const bf16x8 st = {a0[0], a0[1], a0[2], a0[3], a1[0], a1[1], a1[2], a1[3]};
                o[vb][0] = __builtin_amdgcn_mfma_f32_32x32x16_bf16(st, qfr[0][ks], o[vb][0], 0, 0, 0);
                o[vb][1] = __builtin_amdgcn_mfma_f32_32x32x16_bf16(st, qfr[1][ks], o[vb][1], 0, 0, 0);
            }
        }
#pragma unroll
        for (int ib = 0; ib < 2; ++ib) {
            const size_t t = t0 + 32 * ib + r32;
            float ss = 0.f;
#pragma unroll
            for (int r = 0; r < 16; ++r) ss += o[0][ib][r] * o[0][ib][r] + o[1][ib][r] * o[1][ib][r];
            ss = at::xhalf_sum(ss);
            const float rstd = rsqrtf(ss * (1.0f / 64.0f) + EPS);
#pragma unroll
            for (int vb = 0; vb < 2; ++vb)
#pragma unroll
                for (int g = 0; g < 4; ++g) {
                    const int v0 = 32 * vb + 8 * g + 4 * hi;
                    const uint2 rr = *(const uint2*)(Z + t * ZW + ZC_GR + h * 64 + v0); const f32x4 gn = *(const f32x4*)(gon + v0);
                    const float r0 = bf2f(rr.x & 0xffff), r1 = bf2f(rr.x >> 16), r2 = bf2f(rr.y & 0xffff), r3 = bf2f(rr.y >> 16);
                    const float y0 = o[vb][ib][4 * g] * rstd * gn[0] * r0 * sigmoidf_(r0), y1 = o[vb][ib][4 * g + 1] * rstd * gn[1] * r1 * sigmoidf_(r1);
                    const float y2 = o[vb][ib][4 * g + 2] * rstd * gn[2] * r2 * sigmoidf_(r2), y3 = o[vb][ib][4 * g + 3] * rstd * gn[3] * r3 * sigmoidf_(r3);
                    *(uint2*)(YM + t * 1024 + h * 64 + v0) = make_uint2(cvtpk(y0, y1), cvtpk(y2, y3));
                }
        }
        asm volatile("s_waitcnt lgkmcnt(0)" ::: "memory");
    }
}

__device__ __forceinline__ void ph_gla_simple(const Params& P, int layer, unsigned char* lds) {
    if (blockIdx.x >= 4) return;
    const int tz = opaque_tid(); const int wid = tz >> 6, lane = tz & 63;
    float (*sq)[32] = (float (*)[32])(lds + wid * 3072), (*sk)[32] = (float (*)[32])(lds + wid * 3072 + 1024), (*sa)[32] = (float (*)[32])(lds + wid * 3072 + 2048);
    const int bh = blockIdx.x * 8 + wid, b = bh >> 2, h = bh & 3;
    const bf16_t* Z = (const bf16_t*)(P.ws + WS_BIG + BIG_Z); const float* LA = (const float*)(P.ws + WS_BIG + BIG_LA); bf16_t* YM = (bf16_t*)(P.ws + WS_YMIX);
    const float g = P.gla_on[layer * 64 + lane];
    float st[32];
#pragma unroll
    for (int k = 0; k < 32; ++k) st[k] = 0.f;
    for (int c0 = 0; c0 < SEQ; c0 += 8) {
#pragma unroll
        for (int i = 0; i < 4; ++i) {
            const int idx = lane + 64 * i, sp = idx >> 5, k = idx & 31; const size_t t = (size_t)b * SEQ + c0 + sp;
            sq[sp][k] = bf2f(Z[t * ZW + ZC_GQ + h * 32 + k]) * 0.17677669529663687f;
            sk[sp][k] = bf2f(Z[t * ZW + ZC_GK + h * 32 + k]);
            sa[sp][k] = __expf(LA[t * 128 + h * 32 + k]);
        }
        float v[8], r[8];
#pragma unroll
        for (int sp = 0; sp < 8; ++sp) { const size_t t = (size_t)b * SEQ + c0 + sp; v[sp] = bf2f(Z[t * ZW + ZC_GV + h * 64 + lane]); r[sp] = bf2f(Z[t * ZW + ZC_GR + h * 64 + lane]); }
        __syncthreads();
#pragma unroll
        for (int sp = 0; sp < 8; ++sp) {
            float o = 0.f;
#pragma unroll
            for (int k = 0; k < 32; ++k) { st[k] = sa[sp][k] * st[k] + sk[sp][k] * v[sp]; o += sq[sp][k] * st[k]; }
            const float ss = wave_sum(o * o);
            const float on = o * rsqrtf(ss * (1.0f / 64.0f) + EPS) * g;
            const float rr = r[sp];
            YM[((size_t)b * SEQ + c0 + sp) * 1024 + h * 64 + lane] = f2bf(on * rr * sigmoidf_(rr));
        }
        __syncthreads();
    }
}

template <int L> __device__ __forceinline__ void layer_body(const Params& P, const XcdBarrier& bar, unsigned char* lds) {
    constexpr int l = L; char* ws = P.ws; LAS unsigned char* ldsl = (LAS unsigned char*)lds;
    const bf16_t* HB = (const bf16_t*)(ws + WS_HB); const float* RS = (const float*)(ws + WS_RSTD);
    bf16_t* Z = (bf16_t*)(ws + WS_BIG + BIG_Z);
    {
        const char* wsm = ws + WS_WSM + (size_t)l * WSM_STRIDE;
        { EpiBf16_8 e{(bf16_t*)(ws + WS_E), 1024}; ph_gemm_fast<256, 256, true>(ldsl, (const bf16_t*)(ws + WS_PB) + (size_t)l * T * 256, (const bf16_t*)(wsm + WSM_WPLE), 1024, e); }
#ifdef DBL_SHORTK
        { EpiBf16_8 e{(bf16_t*)(ws + WS_E), 1024}; ph_gemm_fast<256, 256, true>(ldsl, (const bf16_t*)(ws + WS_PB) + (size_t)l * T * 256, (const bf16_t*)(wsm + WSM_WPLE), 1024, e); }
#endif
        { EpiZ8 e{Z, RS}; ph_gemm_fast<1024, 1024, true>(ldsl, HB, (const bf16_t*)(wsm + WSM_WIN), ZW, e); }
#ifdef DBL_Z
        { EpiZ8 e{Z, RS}; ph_gemm_fast<1024, 1024, true>(ldsl, HB, (const bf16_t*)(wsm + WSM_WIN), ZW, e); }
#endif
        xcd_barrier(bar);
        ph_prepB(P, l, lds);
#ifdef DBL_PREPB
        __syncthreads(); ph_prepB(P, l, lds);
#endif
        xcd_barrier(bar);
        { EpiBf16_8 e{(bf16_t*)(ws + WS_BIG + BIG_Q), 768}; ph_gemm_fast<256, ZW, true>(ldsl, Z + ZC_CQ, (const bf16_t*)(wsm + WSM_WUQ), 768, e); }
        { EpiBf16_8 e{(bf16_t*)(ws + WS_BIG + BIG_KV), 1024}; ph_gemm_fast<128, ZW, true>(ldsl, Z + ZC_CKV, (const bf16_t*)(wsm + WSM_WUKV), 1024, e); }
#ifdef DBL_SHORTK
        { EpiBf16_8 e{(bf16_t*)(ws + WS_BIG + BIG_Q), 768}; ph_gemm_fast<256, ZW, true>(ldsl, Z + ZC_CQ, (const bf16_t*)(wsm + WSM_WUQ), 768, e); }
        { EpiBf16_8 e{(bf16_t*)(ws + WS_BIG + BIG_KV), 1024}; ph_gemm_fast<128, ZW, true>(ldsl, Z + ZC_CKV, (const bf16_t*)(wsm + WSM_WUKV), 1024, e); }
#endif
        __syncthreads();
        ph_gla_x(P, ldsl);
#ifdef DBL_GLAX
        ph_gla_x<true>(P, ldsl);
#endif
        xcd_barrier(bar);
        ph_prepD(P, l);
#ifdef DBL_PREPD
        ph_prepD<true>(P, l);
#endif
        ph_gla_scan(P);
#ifdef DBL_SCAN
        ph_gla_scan(P);
#endif
        xcd_barrier(bar);
        if ((blockIdx.x >> 3) & 1) { ph_tconv_exp<(L == 0 ? MOE_FP8_L0 : MOE_FP8_L1)>(P, l, ldsl); }
        ph_attn_fast(P, ldsl);
#ifdef DBL_ATTN
        ph_attn_fast(P, ldsl);
#endif
        ph_gla_y(P, l, ldsl);
        if (!((blockIdx.x >> 3) & 1)) { __syncthreads(); ph_tconv_exp<(L == 0 ? MOE_FP8_L0 : MOE_FP8_L1)>(P, l, ldsl); }
#ifdef DBL_GLAY
        ph_gla_y(P, l, ldsl);
#endif
        xcd_barrier(bar);
        { EpiResid8 e{l == 0 ? P.x : nullptr, (bf16_t*)(ws + WS_HB)}; ph_gemm_fast<1024, 1024, true>(ldsl, (const bf16_t*)(ws + WS_YMIX), (const bf16_t*)(wsm + WSM_WOUT), 1024, e); }
        xcd_barrier(bar);
        ph_router<(L == 0 ? MOE_FP8_L0 : MOE_FP8_L1)>(P, l, ldsl);
        xcd_barrier(bar);
        ph_moe_fast<true, (L == 0 ? MOE_FP8_L0 : MOE_FP8_L1)>(P, l, ldsl);
#ifdef DBL_MOE1
        __syncthreads(); ph_moe_fast<true, (L == 0 ? MOE_FP8_L0 : MOE_FP8_L1)>(P, l, ldsl);
#endif
        xcd_barrier(bar);
        ph_moe_fast<false, (L == 0 ? MOE_FP8_L0 : MOE_FP8_L1)>(P, l, ldsl);
#ifdef DBL_MOE2
        __syncthreads(); ph_moe_fast<false, (L == 0 ? MOE_FP8_L0 : MOE_FP8_L1)>(P, l, ldsl);
#endif
        xcd_barrier(bar);
        ph_combine<(L == 0 ? MOE_FP8_L0 : MOE_FP8_L1)>(P);
#ifdef DBL_COMBINE
        ph_combine<(L == 0 ? MOE_FP8_L0 : MOE_FP8_L1), true>(P);
#endif
        xcd_barrier(bar);
        { EpiPle8 e{(const bf16_t*)(ws + WS_E), RS + 2 * T, (bf16_t*)(ws + WS_YMIX)}; ph_gemm_fast<1024, 1024, true>(ldsl, HB, (const bf16_t*)(wsm + WSM_WPG), 1024, e); }
#ifdef DBL_PLE
        { EpiPle8 e{(const bf16_t*)(ws + WS_E), RS + 2 * T, (bf16_t*)(ws + WS_YMIX)}; ph_gemm_fast<1024, 1024, true>(ldsl, HB, (const bf16_t*)(wsm + WSM_WPG), 1024, e); }
#endif
        xcd_barrier(bar);
        ph_final(P, l);
#ifdef DBL_FINAL
        ph_final<true>(P, l);
#endif
        xcd_barrier(bar);
    }
}

__global__ void __launch_bounds__(NTHR, 2) mega_fwd(Params P) {
    extern __shared__ __attribute__((aligned(16))) unsigned char lds[];
    char* ws = P.ws;
    if (threadIdx.x == 0) *(uint4*)(lds + LDS_BAR_OFF) = make_uint4(0u, 0u, (unsigned)P.grid, 0u);
    if ((threadIdx.x & 63) == 0) *(volatile LAS int*)((LAS unsigned char*)lds + LDS_WID_OFF + hw_wave_key() * 4) = (int)(threadIdx.x >> 6);
    __syncthreads();
    const XcdBarrier bar = xcd_barrier_post((unsigned*)(ws + WS_CTL), (volatile LAS unsigned*)(lds + LDS_BAR_OFF));
    const bf16_t* HB = (const bf16_t*)(ws + WS_HB); const float* RS = (const float*)(ws + WS_RSTD);
    bf16_t* Z = (bf16_t*)(ws + WS_BIG + BIG_Z);
    ph_tconv_small(P, lds);
    ph_conv_bf16(P.p, (bf16_t*)(ws + WS_PB), (long)2 * T * 256 / 8);
    ph_prep_router(P);
    ph_init_h(P);
    ph_rope_table(P);
#ifdef DBL_P0
    __syncthreads();
    ph_tconv_small(P, lds);
    ph_conv_bf16(P.p, (bf16_t*)(ws + WS_PB), (long)2 * T * 256 / 8);
    ph_prep_router(P);
    ph_init_h(P);
    ph_rope_table(P);
#endif
    xcd_barrier(bar);
    layer_body<0>(P, bar, lds);
    layer_body<1>(P, bar, lds);
}

extern "C" void kernel_launch(void* const* d_in, const int* in_sizes, int n_in, void* d_out, int out_size, void* d_ws, size_t ws_size, hipStream_t stream) {
    if (n_in != 30 || ws_size < WS_END) { fprintf(stderr, "kernel_launch: need 30 inputs and %zu bytes of workspace (got %d, %zu)\n", (size_t)WS_END, n_in, ws_size); return; }
    static int grid = 0;
    if (!grid) {
        int dev = 0, cus = 0, per_cu = 0;
        if (hipGetDevice(&dev) != hipSuccess || hipDeviceGetAttribute(&cus, hipDeviceAttributeMultiprocessorCount, dev) != hipSuccess) { fprintf(stderr, "kernel_launch: device query failed\n"); return; }
        if (hipFuncSetAttribute((const void*)mega_fwd, hipFuncAttributeMaxDynamicSharedMemorySize, LDS_BYTES) != hipSuccess) { fprintf(stderr, "kernel_launch: hipFuncSetAttribute failed\n"); return; }
        if (hipOccupancyMaxActiveBlocksPerMultiprocessor(&per_cu, (const void*)mega_fwd, NTHR, LDS_BYTES) != hipSuccess || per_cu < 1) { fprintf(stderr, "kernel_launch: occupancy query says %d\n", per_cu); return; }
        grid = cus;
    }
    Params P{};
    P.x = (const float*)d_in[0]; P.p = (const float*)d_in[1]; P.pos = (const int*)d_in[2];
    P.mix_norm = (const float*)d_in[3]; P.w_in = (const float*)d_in[4]; P.gla_wg = (const float*)d_in[5]; P.gla_bg = (const float*)d_in[6]; P.gla_on = (const float*)d_in[7];
    P.q_norm = (const float*)d_in[8]; P.w_uq = (const float*)d_in[9]; P.kv_norm = (const float*)d_in[10]; P.w_ukv = (const float*)d_in[11]; P.qkq = (const float*)d_in[12]; P.qkk = (const float*)d_in[13];
    P.pool_w = (const float*)d_in[14]; P.pool_s = (const float*)d_in[15]; P.w_out = (const float*)d_in[16]; P.ffn_norm = (const float*)d_in[17]; P.router_w = (const float*)d_in[18]; P.router_b = (const float*)d_in[19];
    P.moe_wg = (const float*)d_in[20]; P.moe_bg = (const float*)d_in[21]; P.moe_wu = (const float*)d_in[22]; P.moe_bu = (const float*)d_in[23]; P.moe_wd = (const float*)d_in[24]; P.moe_bd = (const float*)d_in[25];
    P.ple_wp = (const float*)d_in[26]; P.ple_gn = (const float*)d_in[27]; P.ple_wg = (const float*)d_in[28]; P.ple_pn = (const float*)d_in[29];
    P.out = (float*)d_out; P.ws = (char*)d_ws; P.grid = grid; P.pad_ = 0;
    (void)hipMemsetAsync((char*)d_ws + WS_CTL, 0, 65536, stream);
    hipLaunchKernelGGL(mega_fwd, dim3(grid), dim3(NTHR), LDS_BYTES, stream, P);
}
```

```cpp
#include <hip/hip_runtime.h>
#include <cstdio>
#include <cstdint>

typedef unsigned short bf16_t;
typedef short bf16x8 __attribute__((ext_vector_type(8)));
typedef float f32x4 __attribute__((ext_vector_type(4)));
typedef unsigned u32x4_t __attribute__((ext_vector_type(4)));

constexpr int T = 32768, DM = 1024, SEQ = 4096, NBATCH = 8, DEPTH = 2;
constexpr int ZW = 1536;
constexpr int ZC_CQ = 0, ZC_GV = 256, ZC_GR = 512, ZC_UP = 768, ZC_GQ = 1024, ZC_GK = 1152, ZC_CKV = 1280, ZC_KR = 1408, ZC_GLOW = 1440;
constexpr int NE = 32, TOPK = 4, DFF = 1024;
constexpr int HROWS = 139264;
constexpr float EPS = 1e-6f;

__host__ __device__ inline int zsrc(int n) {
    if (n < 256) return 784 + n;
    if (n < 512) return 256 + (n - 256);
    if (n < 768) return 528 + (n - 512);
    if (n < 1024) return 1200 + (n - 768);
    if (n < 1152) return n - 1024;
    if (n < 1280) return 128 + (n - 1152);
    if (n < 1408) return 1040 + (n - 1280);
    if (n < 1440) return 1168 + (n - 1408);
    if (n < 1456) return 512 + (n - 1440);
    return -1;
}

constexpr size_t MiB = 1024 * 1024;
constexpr size_t WS_CTL = 0;
constexpr size_t WS_HB = 1 * MiB;
constexpr size_t WS_RSTD = WS_HB + 64 * MiB;
constexpr size_t WS_WSM = WS_RSTD + 1 * MiB;
constexpr size_t WSM_WIN = 0, WSM_WUQ = 3 * MiB, WSM_WUKV = WSM_WUQ + 384 * 1024, WSM_WOUT = WSM_WUKV + 256 * 1024, WSM_WPG = WSM_WOUT + 2 * MiB,
                 WSM_WPLE = WSM_WPG + 2 * MiB, WSM_WR = WSM_WPLE + 512 * 1024, WSM_WPT = WSM_WR + 128 * 1024, WSM_STRIDE = WSM_WR + 128 * 1024 + 128 * 1024;
constexpr size_t WS_PB = WS_WSM + 2 * WSM_STRIDE;
constexpr size_t WS_W1 = WS_PB + 32 * MiB;
constexpr size_t WS_W2 = WS_W1 + 128 * MiB;
constexpr size_t WS_E = WS_W2 + 64 * MiB;
constexpr size_t WS_YMIX = WS_E + 64 * MiB;
constexpr size_t WS_Y = WS_YMIX + 64 * MiB;
constexpr size_t WS_UPD = WS_Y + 256 * MiB;
constexpr size_t WS_DEC = WS_UPD + 16 * MiB;
constexpr size_t WS_SPREV = WS_DEC + 1 * MiB;
constexpr size_t WS_TOPG = WS_SPREV + 8 * MiB;
constexpr size_t WS_LIST = WS_TOPG + 1 * MiB;
constexpr size_t WS_BIG = WS_LIST + 4 * MiB;
constexpr size_t BIG_Z = 0, BIG_Q = 96 * MiB, BIG_KV = BIG_Q + 48 * MiB, BIG_K = BIG_KV + 64 * MiB, BIG_LA = BIG_K + 48 * MiB;
constexpr size_t WS_ROPE = WS_BIG + 272 * MiB;
constexpr size_t WS_LRS = WS_ROPE + 4 * MiB;
constexpr size_t WS_LGT = WS_LRS + 4 * MiB;
constexpr size_t WS_END = WS_LGT + 4 * MiB;
constexpr int CTL_CNT = 4096;

constexpr bool MOE_FP8_L0 = true, MOE_FP8_L1 = true;
__device__ __forceinline__ float bf2f(bf16_t v) { return __uint_as_float(((unsigned)v) << 16); }
__device__ __forceinline__ bf16_t f2bf(float f) { unsigned u = __float_as_uint(f); u += 0x7FFFu + ((u >> 16) & 1u); return (bf16_t)(u >> 16); }
__device__ __forceinline__ unsigned pack2(float lo, float hi) { return (unsigned)f2bf(lo) | ((unsigned)f2bf(hi) << 16); }
template <int CTRL> __device__ __forceinline__ float dppx(float v) { return __int_as_float(__builtin_amdgcn_update_dpp(0, __float_as_int(v), CTRL, 0xf, 0xf, true)); }
__device__ __forceinline__ unsigned pack4_fp8(float x0, float x1, float x2, float x3) { int w = 0; w = __builtin_amdgcn_cvt_pk_fp8_f32(x0, x1, w, false); w = __builtin_amdgcn_cvt_pk_fp8_f32(x2, x3, w, true); return (unsigned)w; }
__device__ __forceinline__ float wave_sum(float v) {
    v += dppx<0xB1>(v); v += dppx<0x4E>(v); v += dppx<0x141>(v); v += dppx<0x140>(v);
    { auto rr = __builtin_amdgcn_permlane16_swap(__float_as_uint(v), __float_as_uint(v), false, false); v = __uint_as_float(rr[0]) + __uint_as_float(rr[1]); }
    { auto rr = __builtin_amdgcn_permlane32_swap(__float_as_uint(v), __float_as_uint(v), false, false); v = __uint_as_float(rr[0]) + __uint_as_float(rr[1]); }
    return v;
}
__device__ __forceinline__ float wave_max(float v) {
    v = fmaxf(v, dppx<0xB1>(v)); v = fmaxf(v, dppx<0x4E>(v)); v = fmaxf(v, dppx<0x141>(v)); v = fmaxf(v, dppx<0x140>(v));
    { auto rr = __builtin_amdgcn_permlane16_swap(__float_as_uint(v), __float_as_uint(v), false, false); v = fmaxf(__uint_as_float(rr[0]), __uint_as_float(rr[1])); }
    { auto rr = __builtin_amdgcn_permlane32_swap(__float_as_uint(v), __float_as_uint(v), false, false); v = fmaxf(__uint_as_float(rr[0]), __uint_as_float(rr[1])); }
    return v;
}
namespace at {
typedef float f32x16 __attribute__((ext_vector_type(16)));
__device__ __forceinline__ float xhalf_max(float v) { auto rr = __builtin_amdgcn_permlane32_swap(__float_as_uint(v), __float_as_uint(v), false, false); return fmaxf(__uint_as_float(rr[0]), __uint_as_float(rr[1])); }
__device__ __forceinline__ float xhalf_sum(float v) { auto rr = __builtin_amdgcn_permlane32_swap(__float_as_uint(v), __float_as_uint(v), false, false); return __uint_as_float(rr[0]) + __uint_as_float(rr[1]); }
}
__device__ __forceinline__ float sigmoidf_(float x) { return __builtin_amdgcn_rcpf(1.0f + __builtin_amdgcn_exp2f(-1.4426950408889634f * x)); }


#define XB_TMO      128
#define XB_XCNT(j)  (256  + 64 * (j))
#define XB_XSUB(j)  (1280 + 64 * (j))
#define XB_XGEN(j)  (2304 + 64 * (j))
#define XB_TOP      3328
#define XB_TOPGEN   3392
#define XCD_BAR_WORDS 3456
#define XB_SPIN_CAP (1u << 18)
#define LAS __attribute__((address_space(3)))

constexpr int LDS_WID_OFF = 147456 - 16 - 256, LDS_GRID_OFF = 147456 - 16 + 8;
__device__ __forceinline__ int grid_size() { extern __shared__ __attribute__((aligned(16))) unsigned char lds_dyn_[]; return __builtin_amdgcn_readfirstlane(*(const volatile LAS int*)((LAS unsigned char*)lds_dyn_ + LDS_GRID_OFF)); }
__device__ __forceinline__ unsigned hw_wave_key() { return (unsigned)__builtin_amdgcn_s_getreg((5 << 11) | 4) & 63u; }
__device__ __forceinline__ int opaque_tid() {
    extern __shared__ __attribute__((aligned(16))) unsigned char lds_dyn_[];
    const int wv = __builtin_amdgcn_readfirstlane(*(const volatile LAS int*)((LAS unsigned char*)lds_dyn_ + LDS_WID_OFF + hw_wave_key() * 4));
    int ln; asm volatile("v_mbcnt_lo_u32_b32 %0, -1, 0\n\tv_mbcnt_hi_u32_b32 %0, -1, %0" : "=v"(ln));
    int t = wv * 64 + ln;
    asm volatile("" : "+v"(t)); return t;
}

__device__ __forceinline__ unsigned xb_ld(unsigned* p)              { return __hip_atomic_load(p, __ATOMIC_RELAXED, __HIP_MEMORY_SCOPE_AGENT); }
__device__ __forceinline__ unsigned xb_add(unsigned* p, unsigned v) { return __hip_atomic_fetch_add(p, v, __ATOMIC_RELAXED, __HIP_MEMORY_SCOPE_AGENT); }
__device__ __forceinline__ unsigned xb_xcc_id() { return (unsigned)__builtin_amdgcn_s_getreg((3 << 11) | 20) & 0xFu; }
#define XB_SPIN(cond, bar) do { unsigned _sp = 0; while (cond) { __builtin_amdgcn_s_sleep(1); \
    if ((++_sp & 255u) == 0u) { if (xb_ld(&(bar)[XB_TMO])) break; if (_sp > XB_SPIN_CAP) { atomicAdd(&(bar)[XB_TMO], 1u); break; } } } } while (0)

struct XcdBarrier {
    unsigned* bar; unsigned x;
    volatile LAS unsigned* st;
};

__device__ __forceinline__ XcdBarrier xcd_barrier_post(unsigned* bar, volatile LAS unsigned* st) {
    XcdBarrier b; b.bar = bar; b.x = xb_xcc_id(); b.st = st;
    if (threadIdx.x == 0) (void)xb_add(&bar[XB_XCNT(b.x)], 1u);
    return b;
}
__device__ __forceinline__ void xcd_barrier_complete(unsigned* bar, unsigned x, unsigned& nloc, unsigned& nx) {
    const unsigned G = (unsigned)grid_size();
    unsigned sum, cnt, mine, sp = 0u;
    for (;;) {
        sum = 0u; cnt = 0u; mine = 0u;
#pragma unroll
        for (unsigned j = 0; j < 16; ++j) { const unsigned c = xb_ld(&bar[XB_XCNT(j)]); sum += c; cnt += (c > 0u) ? 1u : 0u; mine = (j == x) ? c : mine; }
        if (sum == G) break;
        __builtin_amdgcn_s_sleep(1);
        if ((++sp & 255u) == 0u) { if (xb_ld(&bar[XB_TMO])) break; if (sp > XB_SPIN_CAP) { atomicAdd(&bar[XB_TMO], 1u); break; } }
    }
    nloc = mine > 0u ? mine : 1u; nx = cnt > 0u ? cnt : 1u;
}

__device__ __forceinline__ void xcd_barrier(const XcdBarrier& b) {
    asm volatile("s_waitcnt vmcnt(0)" ::: "memory");
    __syncthreads();
    if (opaque_tid() == 0) {
        unsigned* bar = b.bar;
        __builtin_amdgcn_s_waitcnt(0);
        unsigned nloc = b.st[0], nx = b.st[1];
        if (nloc == 0u) { xcd_barrier_complete(bar, b.x, nloc, nx); b.st[0] = nloc; b.st[1] = nx; }
        const unsigned old = xb_add(&bar[XB_XSUB(b.x)], 1u);
        const unsigned gen = old / nloc;
        if (old + 1u == (gen + 1u) * nloc) {
            __builtin_amdgcn_fence(__ATOMIC_RELEASE, "agent");
            asm volatile("s_waitcnt vmcnt(0)" ::: "memory");
            const unsigned og = xb_add(&bar[XB_TOP], 1u);
            const unsigned tg = og / nx;
            if (og + 1u == (tg + 1u) * nx) xb_add(&bar[XB_TOPGEN], 1u);
            else XB_SPIN(xb_ld(&bar[XB_TOPGEN]) == tg, bar);
            __builtin_amdgcn_fence(__ATOMIC_ACQUIRE, "agent");
            xb_add(&bar[XB_XGEN(b.x)], 1u);
            asm volatile("s_waitcnt vmcnt(0)" ::: "memory");
        } else {
            XB_SPIN(xb_ld(&bar[XB_XGEN(b.x)]) == gen, bar);
            __builtin_amdgcn_fence(__ATOMIC_ACQUIRE, "agent");
            asm volatile("s_waitcnt vmcnt(0)" ::: "memory");
        }
    }
    __syncthreads();
}

struct Params {
    const float *x, *p; const int* pos;
    const float *mix_norm, *w_in, *gla_wg, *gla_bg, *gla_on, *q_norm, *w_uq, *kv_norm, *w_ukv, *qkq, *qkk, *pool_w, *pool_s, *w_out, *ffn_norm, *router_w, *router_b,
        *moe_wg, *moe_bg, *moe_wu, *moe_bu, *moe_wd, *moe_bd, *ple_wp, *ple_gn, *ple_wg, *ple_pn;
    float* out; char* ws; int grid; int pad_;
};


constexpr int NTHR = 512, NWV = 8;
constexpr int LDS_BYTES = 147456;
constexpr int LDS_BAR_OFF = LDS_BYTES - 16;


__device__ __forceinline__ void ph_tconv_small(const Params& P, unsigned char* lds) {
    const int tz = opaque_tid(); const int tid = tz & 255, half = tz >> 8, tx = tid & 63, ty = tid >> 6;
    float (*tile)[65] = (float (*)[65])(lds + half * 16640);
    constexpr int U_IN = 24 * 16, U_UQ = 12 * 4, U_KV = 16 * 2, U_OUT = 16 * 16, U_PG = 16 * 16, U_PP = 16 * 4, U_L = U_IN + U_UQ + U_KV + U_OUT + U_PG + U_PP;
    static_assert((2 * U_L) % 2 == 0, "pairs of units");
    for (int u0 = blockIdx.x * 2; u0 < 2 * U_L; u0 += grid_size() * 2) {
        const int u = u0 + half; const int l = u / U_L; int r = u % U_L;
        char* wsm = P.ws + WS_WSM + (size_t)l * WSM_STRIDE;
        const float* src; const float* gain; bf16_t* dst; int N, K, ld, mode;
        if (r < U_IN) { src = P.w_in + (size_t)l * 1024 * 1456; gain = P.mix_norm + l * 1024; dst = (bf16_t*)(wsm + WSM_WIN); N = ZW; K = 1024; ld = 1456; mode = 1; }
        else if ((r -= U_IN) < U_UQ) { src = P.w_uq + (size_t)l * 256 * 768; gain = P.q_norm + l * 256; dst = (bf16_t*)(wsm + WSM_WUQ); N = 768; K = 256; ld = 768; mode = 0; }
        else if ((r -= U_UQ) < U_KV) { src = P.w_ukv + (size_t)l * 128 * 1024; gain = P.kv_norm + l * 128; dst = (bf16_t*)(wsm + WSM_WUKV); N = 1024; K = 128; ld = 1024; mode = 0; }
        else if ((r -= U_KV) < U_OUT) { src = P.w_out + (size_t)l * 1024 * 1024; gain = nullptr; dst = (bf16_t*)(wsm + WSM_WOUT); N = 1024; K = 1024; ld = 1024; mode = 0; }
        else if ((r -= U_OUT) < U_PG) { src = P.ple_wg + (size_t)l * 1024 * 1024; gain = P.ple_gn + l * 1024; dst = (bf16_t*)(wsm + WSM_WPG); N = 1024; K = 1024; ld = 1024; mode = 0; }
        else { r -= U_PG; src = P.ple_wp + (size_t)l * 256 * 1024; gain = nullptr; dst = (bf16_t*)(wsm + WSM_WPLE); N = 1024; K = 256; ld = 1024; mode = 0; }
        const int nx = N / 64; const int bx = r % nx, by = r / nx;
        const int n0 = bx * 64, k0 = by * 64, n = n0 + tx;
        const int col = (mode == 1) ? zsrc(n) : n;
#pragma unroll
        for (int i = 0; i < 16; ++i) {
            const int k = k0 + ty + 4 * i; float v = 0.f;
            if (col >= 0) v = src[(long)k * ld + col];
            if (gain) v *= gain[k];
            tile[ty + 4 * i][tx] = v;
        }
        __syncthreads();
        const int nl = tid >> 2, ks = (tid & 3) * 16;
        unsigned w0 = pack2(tile[ks + 0][nl], tile[ks + 1][nl]), w1 = pack2(tile[ks + 2][nl], tile[ks + 3][nl]), w2 = pack2(tile[ks + 4][nl], tile[ks + 5][nl]), w3 = pack2(tile[ks + 6][nl], tile[ks + 7][nl]);
        unsigned w4 = pack2(tile[ks + 8][nl], tile[ks + 9][nl]), w5 = pack2(tile[ks + 10][nl], tile[ks + 11][nl]), w6 = pack2(tile[ks + 12][nl], tile[ks + 13][nl]), w7 = pack2(tile[ks + 14][nl], tile[ks + 15][nl]);
        uint4* o = (uint4*)(dst + (long)(n0 + nl) * K + k0 + ks);
        o[0] = make_uint4(w0, w1, w2, w3); o[1] = make_uint4(w4, w5, w6, w7);
        __syncthreads();
    }
}

template <bool FP8> __device__ __forceinline__ void ph_tconv_exp(const Params& P, int layer, LAS unsigned char* lds) {
    const int tid = opaque_tid();
    const int kq = tid >> 6, c4 = tid & 63;
    constexpr int PITCH = FP8 ? 68 : 136;
    LAS unsigned char* tile = lds;
    const float* gain = P.ffn_norm + layer * 1024;
    const int nunits = 3 * 32 * 16 * 4;
    for (int u = blockIdx.x; u < nunits; u += grid_size()) {
        const int nt = u & 3, kt = (u >> 2) & 15, e = (u >> 6) & 31, mat = u >> 11;
        const float* src = (mat == 0 ? P.moe_wg : mat == 1 ? P.moe_wu : P.moe_wd) + ((size_t)layer * 32 + e) * 1024 * 1024 + (size_t)(kt * 64) * 1024 + nt * 256 + c4 * 4;
        f32x4 v[2][4];
#pragma unroll
        for (int g = 0; g < 2; ++g)
#pragma unroll
            for (int r = 0; r < 4; ++r) v[g][r] = *(const f32x4*)(src + (size_t)(32 * g + 4 * kq + r) * 1024);
        const float sc = FP8 ? 64.0f : 1.0f;
#pragma unroll
        for (int g = 0; g < 2; ++g)
#pragma unroll
            for (int r = 0; r < 4; ++r) v[g][r] *= (mat < 2 ? gain[kt * 64 + 32 * g + 4 * kq + r] : 1.0f) * sc;
        __syncthreads();
#pragma unroll
        for (int g = 0; g < 2; ++g)
#pragma unroll
            for (int j = 0; j < 4; ++j) {
                if constexpr (FP8) *(LAS unsigned*)(tile + (c4 * 4 + j) * PITCH + 32 * g + 4 * kq) = pack4_fp8(v[g][0][j], v[g][1][j], v[g][2][j], v[g][3][j]);
                else { LAS unsigned* wp_ = (LAS unsigned*)(tile + (c4 * 4 + j) * PITCH + (32 * g + 4 * kq) * 2); wp_[0] = pack2(v[g][0][j], v[g][1][j]); wp_[1] = pack2(v[g][2][j], v[g][3][j]); }
            }
        __syncthreads();
        typedef unsigned u32x4 __attribute__((ext_vector_type(4)));
        unsigned char* dst = (mat < 2) ? (unsigned char*)(P.ws + WS_W1) + (size_t)e * 2048 * (FP8 ? 1024 : 2048) : (unsigned char*)(P.ws + WS_W2) + (size_t)e * 1024 * (FP8 ? 1024 : 2048);
        constexpr int CPR = FP8 ? 4 : 8;
#pragma unroll
        for (int j = 0; j < 256 * CPR / NTHR; ++j) {
            const int id = tid + NTHR * j, nl = id / CPR, ck = id % CPR, n = nt * 256 + nl;
            const int drow = (mat == 2) ? n : ((n >> 7) * 256 + (n & 127) + (mat == 1 ? 128 : 0));
            const LAS unsigned* rp = (const LAS unsigned*)(tile + nl * PITCH + ck * 16);
            const u32x4 o = {rp[0], rp[1], rp[2], rp[3]};
            *(u32x4*)(dst + (size_t)drow * (FP8 ? 1024 : 2048) + (size_t)kt * (FP8 ? 64 : 128) + ck * 16) = o;
        }
    }
    __syncthreads();
}
__device__ __forceinline__ void ph_conv_bf16(const float* src, bf16_t* dst, long n8) {
    const int tz = opaque_tid(); const int G = grid_size() * NTHR;
    for (int i0 = blockIdx.x * NTHR + tz; i0 < (int)n8; i0 += 4 * G) {
        float4 a[4], b[4];
#pragma unroll
        for (int q = 0; q < 4; ++q) { const int i = i0 + q * G; if (i < (int)n8) { a[q] = ((const float4*)src)[2 * (size_t)i]; b[q] = ((const float4*)src)[2 * (size_t)i + 1]; } }
#pragma unroll
        for (int q = 0; q < 4; ++q) { const int i = i0 + q * G; if (i < (int)n8) ((uint4*)dst)[i] = make_uint4(pack2(a[q].x, a[q].y), pack2(a[q].z, a[q].w), pack2(b[q].x, b[q].y), pack2(b[q].z, b[q].w)); }
    }
}
__device__ __forceinline__ void ph_prep_router(const Params& P) {
    const int tz = opaque_tid();
    for (int i = blockIdx.x * NTHR + tz; i < 2 * 4 * 64 * 64; i += grid_size() * NTHR) {
        const int l = i >> 14, g = (i >> 12) & 3, d = (i >> 6) & 63, c = i & 63;
        ((bf16_t*)(P.ws + WS_WSM + (size_t)l * WSM_STRIDE + WSM_WPT))[(g * 64 + d) * 64 + c] = f2bf(P.pool_w[(size_t)l * 16384 + (g * 64 + c) * 64 + d]);
    }
    for (int i = blockIdx.x * NTHR + tz; i < 2 * 32 * 1024; i += grid_size() * NTHR) {
        const int l = i >> 15, e = (i >> 10) & 31, k = i & 1023;
        bf16_t* Wr = (bf16_t*)(P.ws + WS_WSM + (size_t)l * WSM_STRIDE + WSM_WR);
        const float w = P.router_w[((size_t)l * 1024 + k) * 32 + e] * P.ffn_norm[l * 1024 + k];
        const bf16_t whi = f2bf(w); Wr[e * 1024 + k] = whi; Wr[32 * 1024 + e * 1024 + k] = f2bf(w - bf2f(whi));
    }
}


__device__ __forceinline__ void ph_rope_table(const Params& P) {
    const int tz = opaque_tid();
    float* RT = (float*)(P.ws + WS_ROPE);
    for (int e = blockIdx.x * NTHR + tz; e < T * 16; e += grid_size() * NTHR) {
        const int t = e >> 4, i = e & 15;
        const float inv = exp2f(-(float)(2 * i) * (1.0f / 32.0f) * 13.287712379549449f);
        const float ang = (float)P.pos[t] * inv;
        RT[(size_t)t * 32 + i] = cosf(ang); RT[(size_t)t * 32 + 16 + i] = sinf(ang);
    }
}

__device__ __forceinline__ void ph_init_h(const Params& P) {
    const int tz = opaque_tid(); const int wid = tz >> 6, lane = tz & 63;
    bf16_t* HB = (bf16_t*)(P.ws + WS_HB); float* RS = (float*)(P.ws + WS_RSTD);
    for (int t0 = (blockIdx.x * NWV + wid) * 4; t0 < T; t0 += grid_size() * NWV * 4) {
        float4 v[4][4];
#pragma unroll
        for (int tt = 0; tt < 4; ++tt)
#pragma unroll
            for (int i = 0; i < 4; ++i) v[tt][i] = *(const float4*)(P.x + (size_t)(t0 + tt) * 1024 + i * 256 + lane * 4);
#pragma unroll
        for (int tt = 0; tt < 4; ++tt) {
            float ss = 0.f;
#pragma unroll
            for (int i = 0; i < 4; ++i) ss += v[tt][i].x * v[tt][i].x + v[tt][i].y * v[tt][i].y + v[tt][i].z * v[tt][i].z + v[tt][i].w * v[tt][i].w;
            ss = wave_sum(ss);
            if (lane == 0) RS[t0 + tt] = rsqrtf(ss * (1.0f / 1024.0f) + EPS);
#pragma unroll
            for (int i = 0; i < 4; ++i) *(uint2*)(HB + (size_t)(t0 + tt) * 1024 + i * 256 + lane * 4) = make_uint2(pack2(v[tt][i].x, v[tt][i].y), pack2(v[tt][i].z, v[tt][i].w));
        }
    }
}

__device__ __forceinline__ void ph_prepB(const Params& P, int layer, unsigned char* lds) {
    float* wg = (float*)lds;
    const int tid = opaque_tid(), wid = tid >> 6, lane = tid & 63;
    for (int i = tid; i < 16 * 128; i += NTHR) wg[i] = P.gla_wg[(size_t)layer * 2048 + i];
    __syncthreads();
    bf16_t* Z = (bf16_t*)(P.ws + WS_BIG + BIG_Z); float* LA = (float*)(P.ws + WS_BIG + BIG_LA); bf16_t* YM = (bf16_t*)(P.ws + WS_YMIX);
    const float* bg = P.gla_bg + layer * 128; const float* psc = P.pool_s + layer * 256;
    const float bg0 = bg[lane], bg1 = bg[lane + 64];
    for (int t0 = (blockIdx.x * NWV + wid) * 2; t0 < T; t0 += grid_size() * NWV * 2) {
        uint2 cq[2]; unsigned ckv[2]; float gl[2];
#pragma unroll
        for (int tt = 0; tt < 2; ++tt) { const bf16_t* zr = Z + (size_t)(t0 + tt) * ZW; cq[tt] = *(const uint2*)(zr + ZC_CQ + lane * 4); ckv[tt] = *(const unsigned*)(zr + ZC_CKV + lane * 2); gl[tt] = (lane < 16) ? bf2f(zr[ZC_GLOW + lane]) : 0.f; }
#pragma unroll
        for (int tt = 0; tt < 2; ++tt) {
            bf16_t* zr = Z + (size_t)(t0 + tt) * ZW;
            {
                const float a = bf2f(cq[tt].x & 0xffff), b = bf2f(cq[tt].x >> 16), c = bf2f(cq[tt].y & 0xffff), d = bf2f(cq[tt].y >> 16);
                const float r = rsqrtf(wave_sum(a * a + b * b + c * c + d * d) * (1.0f / 256.0f) + EPS);
                *(uint2*)(zr + ZC_CQ + lane * 4) = make_uint2(pack2(a * r, b * r), pack2(c * r, d * r));
            }
            {
                const float a = bf2f(ckv[tt] & 0xffff), b = bf2f(ckv[tt] >> 16);
                const float r = rsqrtf(wave_sum(a * a + b * b) * (1.0f / 128.0f) + EPS);
                *(unsigned*)(zr + ZC_CKV + lane * 2) = pack2(a * r, b * r);
            }
            {
                float l0 = bg0, l1 = bg1;
#pragma unroll
                for (int r = 0; r < 16; ++r) { const float g = __uint_as_float(__builtin_amdgcn_readlane(__float_as_uint(gl[tt]), r)); l0 += g * wg[r * 128 + lane]; l1 += g * wg[r * 128 + lane + 64]; }
                const float a0 = fminf(l0, 0.f) - log1pf(__expf(-fabsf(l0))), a1 = fminf(l1, 0.f) - log1pf(__expf(-fabsf(l1)));
                LA[(size_t)(t0 + tt) * 128 + lane] = a0 * (1.0f / 16.0f); LA[(size_t)(t0 + tt) * 128 + lane + 64] = a1 * (1.0f / 16.0f);
            }
        }
    }
    const bf16_t* WpT = (const bf16_t*)(P.ws + WS_WSM + (size_t)layer * WSM_STRIDE + WSM_WPT);
    const int fr = lane & 15, fq = lane >> 4;
    for (int u = blockIdx.x * NWV + wid; u < T / 16; u += grid_size() * NWV) {
        const int t = u * 16 + fr, sq = t & (SEQ - 1);
        uint2 yout[4][4];
#pragma unroll
        for (int gi = 0; gi < 4; ++gi) {
            const int w = 2 << gi; const int cnt = (sq + 1 < w) ? sq + 1 : w; const float rc = 1.0f / (float)cnt;
            bf16x8 af[2];
#pragma unroll
            for (int ks = 0; ks < 2; ++ks) {
                const bf16_t* up = Z + (size_t)t * ZW + ZC_UP + gi * 64 + ks * 32 + fq * 8;
                float acc[8], u0[8];
#pragma unroll
                for (int j = 0; j < 16; ++j) if (j < w) {
                    const int jj = (j < cnt) ? j : 0; const float msk = (j < cnt) ? 1.0f : 0.f;
                    const uint4 x = *(const uint4*)(up - (long)jj * ZW);
                    const float xv[8] = {bf2f(x.x & 0xffff), bf2f(x.x >> 16), bf2f(x.y & 0xffff), bf2f(x.y >> 16), bf2f(x.z & 0xffff), bf2f(x.z >> 16), bf2f(x.w & 0xffff), bf2f(x.w >> 16)};
#pragma unroll
                    for (int e = 0; e < 8; ++e) { if (j == 0) { u0[e] = xv[e]; acc[e] = xv[e]; } else acc[e] += msk * xv[e]; }
                }
                typedef unsigned u32x4 __attribute__((ext_vector_type(4)));
                const u32x4 pk = {pack2(acc[0] * rc - u0[0], acc[1] * rc - u0[1]), pack2(acc[2] * rc - u0[2], acc[3] * rc - u0[3]), pack2(acc[4] * rc - u0[4], acc[5] * rc - u0[5]), pack2(acc[6] * rc - u0[6], acc[7] * rc - u0[7])};
                af[ks] = __builtin_bit_cast(bf16x8, pk);
            }
#pragma unroll
            for (int nb = 0; nb < 4; ++nb) {
                f32x4 acc = {0.f, 0.f, 0.f, 0.f};
#pragma unroll
                for (int ks = 0; ks < 2; ++ks) { const bf16x8 bfr = *(const bf16x8*)(WpT + ((size_t)gi * 64 + nb * 16 + fr) * 64 + ks * 32 + fq * 8); acc = __builtin_amdgcn_mfma_f32_16x16x32_bf16(bfr, af[ks], acc, 0, 0, 0); }
                const int d0 = nb * 16 + fq * 4; const f32x4 sc = *(const f32x4*)(psc + gi * 64 + d0);
                yout[gi][nb] = make_uint2(pack2(acc[0] * sc[0], acc[1] * sc[1]), pack2(acc[2] * sc[2], acc[3] * sc[3]));
            }
        }
#pragma unroll
        for (int gi = 0; gi < 4; ++gi)
#pragma unroll
            for (int nb = 0; nb < 4; ++nb) *(uint2*)(YM + (size_t)t * 1024 + 768 + gi * 64 + nb * 16 + fq * 4) = yout[gi][nb];
    }
}

template <bool DRY = false> __device__ __forceinline__ void ph_prepD(const Params& P, int layer) {
    const int tid = opaque_tid(), wid = tid >> 6, lane = tid & 63, g = lane >> 4, li = lane & 15;
    bf16_t* Z = (bf16_t*)(P.ws + WS_BIG + BIG_Z); bf16_t* Q = (bf16_t*)(P.ws + WS_BIG + BIG_Q); const bf16_t* KV = (const bf16_t*)(P.ws + WS_BIG + BIG_KV); bf16_t* Kd = DRY ? (bf16_t*)(P.ws + WS_Y + 64 * MiB) : (bf16_t*)(P.ws + WS_BIG + BIG_K);
    bf16_t* QW = DRY ? (bf16_t*)(P.ws + WS_Y) : Q;
    const float* RT = (const float*)(P.ws + WS_ROPE);
    const bool act = li < 12, rope = li >= 8 && li < 12, x1part = li < 10;
    const int e0 = act ? 8 * li : 0;
    float gq[8], gk[8];
#pragma unroll
    for (int j = 0; j < 8; ++j) { gq[j] = P.qkq[layer * 96 + e0 + j]; gk[j] = P.qkk[layer * 96 + e0 + j]; }
    const float qscale = 0.10206207261596577f * 1.4426950408889634f;
    for (int t = blockIdx.x * NWV + wid; t < T; t += grid_size() * NWV) {
        typedef unsigned u32x4 __attribute__((ext_vector_type(4)));
        u32x4 qraw[2], kraw[2];
        const int i0 = 8 * (li & 1);
        const f32x4 c0 = *(const f32x4*)(RT + (size_t)t * 32 + i0), c1 = *(const f32x4*)(RT + (size_t)t * 32 + i0 + 4), s0 = *(const f32x4*)(RT + (size_t)t * 32 + 16 + i0), s1 = *(const f32x4*)(RT + (size_t)t * 32 + 16 + i0 + 4);
        const float cs[8] = {c0[0], c0[1], c0[2], c0[3], c1[0], c1[1], c1[2], c1[3]}, sn[8] = {s0[0], s0[1], s0[2], s0[3], s1[0], s1[1], s1[2], s1[3]};
#pragma unroll
        for (int ps = 0; ps < 2; ++ps) {
            const int h = ps * 4 + g;
            qraw[ps] = *(const u32x4*)(Q + (size_t)t * 768 + h * 96 + e0);
            kraw[ps] = (li < 8) ? *(const u32x4*)(KV + (size_t)t * 1024 + h * 128 + e0) : *(const u32x4*)(Z + (size_t)t * ZW + ZC_KR + (rope ? 8 * (li - 8) : 0));
        }
#pragma unroll
        for (int ps = 0; ps < 2; ++ps) {
            const int h = ps * 4 + g;
#pragma unroll
            for (int qk = 0; qk < 2; ++qk) {
                const u32x4 raw = qk == 0 ? qraw[ps] : kraw[ps];
                float x[8];
#pragma unroll
                for (int w = 0; w < 4; ++w) { x[2 * w] = act ? bf2f(raw[w] & 0xffff) : 0.f; x[2 * w + 1] = act ? bf2f(raw[w] >> 16) : 0.f; }
                float ss = 0.f;
#pragma unroll
                for (int j = 0; j < 8; ++j) ss += x[j] * x[j];
                ss += dppx<0xB1>(ss); ss += dppx<0x4E>(ss); ss += dppx<0x141>(ss); ss += dppx<0x140>(ss);
                const float r = rsqrtf(ss * (1.0f / 96.0f) + EPS);
                float y[8];
#pragma unroll
                for (int j = 0; j < 8; ++j) {
                    const float xn = x[j] * r * (qk == 0 ? gq[j] : gk[j]);
                    const float pr = dppx<0x4E>(xn);
                    const float rot = x1part ? (xn * cs[j] - pr * sn[j]) : (xn * cs[j] + pr * sn[j]);
                    y[j] = (rope ? rot : xn) * (qk == 0 ? qscale : 1.0f);
                }
                const u32x4 o = {pack2(y[0], y[1]), pack2(y[2], y[3]), pack2(y[4], y[5]), pack2(y[6], y[7])};
                if (act) { if (qk == 0) *(u32x4*)(QW + (size_t)t * 768 + h * 96 + e0) = o; else *(u32x4*)(Kd + ((size_t)t * 8 + h) * 96 + e0) = o; }
            }
        }
    }
}

template <bool FP8> __device__ __forceinline__ void ph_router(const Params& P, int layer, LAS unsigned char* lds) {
    using at::f32x16;
    const int tid = opaque_tid(); const int wid = __builtin_amdgcn_readfirstlane(tid >> 6), lane = tid & 63, r32 = lane & 31, hi = lane >> 5;
    const bf16_t* HB = (const bf16_t*)(P.ws + WS_HB); float* RS1 = (float*)(P.ws + WS_RSTD) + T;
    const bf16_t* WrH = (const bf16_t*)(P.ws + WS_WSM + (size_t)layer * WSM_STRIDE + WSM_WR); const bf16_t* WrL = WrH + 32 * 1024;
    const float* rb = P.router_b + layer * 32;
    unsigned* cnt = (unsigned*)(P.ws + WS_CTL) + CTL_CNT + layer * 32;
    int* LIST = (int*)(P.ws + WS_LIST);
    constexpr int MAXU = 4;
    LAS unsigned* lcnt = (LAS unsigned*)lds; LAS unsigned* lbase = lcnt + 32;
    LAS unsigned* ent = lbase + 32;
    LAS float* entg = (LAS float*)(ent + NWV * MAXU * 128);
    LAS float* entr = entg + NWV * MAXU * 128;
    if (tid < 32) lcnt[tid] = 0u;
    __syncthreads();
    int nu = 0;
    for (int u = blockIdx.x * 4 + wid; wid < 4 && u < T / 32; u += grid_size() * 4, ++nu) {
        const size_t trow = (size_t)u * 32 + r32;
        f32x16 acc;
#pragma unroll
        for (int r = 0; r < 16; ++r) acc[r] = 0.f;
        float ss = 0.f;
        const bf16_t* hp = HB + trow * 1024 + hi * 8; const bf16_t* wh = WrH + (size_t)r32 * 1024 + hi * 8; const bf16_t* wl_ = WrL + (size_t)r32 * 1024 + hi * 8;
        for (int k8 = 0; k8 < 64; k8 += 8) {
            bf16x8 hf[8], a0[8], a1[8];
#pragma unroll
            for (int q = 0; q < 8; ++q) { hf[q] = *(const bf16x8*)(hp + (k8 + q) * 16); a0[q] = *(const bf16x8*)(wh + (k8 + q) * 16); a1[q] = *(const bf16x8*)(wl_ + (k8 + q) * 16); }
#pragma unroll
            for (int q = 0; q < 8; ++q) {
                acc = __builtin_amdgcn_mfma_f32_32x32x16_bf16(a0[q], hf[q], acc, 0, 0, 0);
                acc = __builtin_amdgcn_mfma_f32_32x32x16_bf16(a1[q], hf[q], acc, 0, 0, 0);
                float hv[8];
#pragma unroll
                for (int j = 0; j < 8; ++j) { hv[j] = bf2f((bf16_t)hf[q][j]); ss += hv[j] * hv[j]; }
                if constexpr (FP8) *(uint2*)((unsigned char*)(P.ws + WS_YMIX) + trow * 1024 + (k8 + q) * 16 + hi * 8) = make_uint2(pack4_fp8(hv[0], hv[1], hv[2], hv[3]), pack4_fp8(hv[4], hv[5], hv[6], hv[7]));
            }
        }
        ss = at::xhalf_sum(ss);
        const float rstd = rsqrtf(ss * (1.0f / 1024.0f) + EPS);
        if (hi == 0) RS1[trow] = rstd;
        float lg[16];
#pragma unroll
        for (int r = 0; r < 16; ++r) lg[r] = acc[r] * rstd + rb[(r & 3) + 8 * (r >> 2) + 4 * hi];
        float cv[8]; int ci[8];
#pragma unroll
        for (int k = 0; k < 4; ++k) {
            float best = -INFINITY; int bi = 0;
#pragma unroll
            for (int r = 0; r < 16; ++r) { const bool ok = lg[r] > best; best = ok ? lg[r] : best; bi = ok ? r : bi; }
#pragma unroll
            for (int r = 0; r < 16; ++r) lg[r] = (r == bi) ? -INFINITY : lg[r];
            cv[k] = best; ci[k] = (bi & 3) + 8 * (bi >> 2) + 4 * hi;
        }
#pragma unroll
        for (int k = 0; k < 4; ++k) {
            { auto rr = __builtin_amdgcn_permlane32_swap(__float_as_uint(cv[k]), __float_as_uint(cv[k]), false, false); cv[4 + k] = __uint_as_float(hi ? rr[0] : rr[1]); }
            { auto rr = __builtin_amdgcn_permlane32_swap((unsigned)ci[k], (unsigned)ci[k], false, false); ci[4 + k] = (int)(hi ? rr[0] : rr[1]); }
        }
        float tv[4]; int ti[4];
#pragma unroll
        for (int k = 0; k < 4; ++k) {
            float best = -INFINITY; int be = 64, bj = 0;
#pragma unroll
            for (int j = 0; j < 8; ++j) { const bool ok = (cv[j] > best) || (cv[j] == best && ci[j] < be); best = ok ? cv[j] : best; be = ok ? ci[j] : be; bj = ok ? j : bj; }
#pragma unroll
            for (int j = 0; j < 8; ++j) cv[j] = (j == bj) ? -INFINITY : cv[j];
            tv[k] = best; ti[k] = be;
        }
        const float e1 = __expf(tv[1] - tv[0]), e2 = __expf(tv[2] - tv[0]), e3 = __expf(tv[3] - tv[0]);
        const float invs = __builtin_amdgcn_rcpf(1.0f + e1 + e2 + e3);
        if (hi == 0 && nu < MAXU) {
            const float gt[4] = {invs, e1 * invs, e2 * invs, e3 * invs};
            const int base = ((wid * MAXU + nu) * 32 + r32) * 4;
#pragma unroll
            for (int k = 0; k < 4; ++k) {
                const unsigned rk = __hip_atomic_fetch_add(&lcnt[ti[k]], 1u, __ATOMIC_RELAXED, __HIP_MEMORY_SCOPE_WORKGROUP);
                ent[base + k] = (unsigned)ti[k] | (rk << 8); entg[base + k] = gt[k];
            }
            entr[(wid * MAXU + nu) * 32 + r32] = rstd;
        }
    }
    __syncthreads();
    if (tid < 32) lbase[tid] = atomicAdd(&cnt[tid], lcnt[tid]);
    __syncthreads();
    {
        int k2 = 0;
        for (int u = blockIdx.x * 4 + wid; wid < 4 && u < T / 32 && k2 < MAXU; u += grid_size() * 4, ++k2) {
#pragma unroll
            for (int h2 = 0; h2 < 2; ++h2) {
                const int i = lane + 64 * h2; const int tl = i >> 2;
                const unsigned code = ent[((wid * MAXU + k2) * 32) * 4 + i]; const int e = (int)(code & 255u); const unsigned pos = lbase[e] + (code >> 8);
                LIST[(size_t)e * T + pos] = (int)(((unsigned)u * 32 + tl) * 4 + (i & 3));
                ((float*)(P.ws + WS_LRS))[(size_t)e * T + pos] = entr[(wid * MAXU + k2) * 32 + tl];
                ((float*)(P.ws + WS_LGT))[(size_t)e * T + pos] = entg[((wid * MAXU + k2) * 32) * 4 + i];
            }
        }
    }
    __syncthreads();
}

__device__ __forceinline__ void unpack8(const u32x4_t w, float (&x)[8]) {
#pragma unroll
    for (int i = 0; i < 4; ++i) { x[2 * i] = bf2f(w[i] & 0xffff); x[2 * i + 1] = bf2f(w[i] >> 16); }
}
template <bool Y8, bool DRY = false> __device__ __forceinline__ void ph_combine(const Params& P) {
    const int tid = opaque_tid(), wid = tid >> 6, lane = tid & 63;
    bf16_t* HB = (bf16_t*)(P.ws + WS_HB); bf16_t* HBW = DRY ? (bf16_t*)(P.ws + WS_BIG + 128 * MiB) : HB; float* RS2 = DRY ? (float*)(P.ws + WS_BIG + 200 * MiB) : (float*)(P.ws + WS_RSTD) + 2 * T;
    const bf16_t* Y = (const bf16_t*)(P.ws + WS_Y); const unsigned char* Yb = (const unsigned char*)(P.ws + WS_Y);
    for (int t0 = (blockIdx.x * NWV + wid) * 2; t0 < T; t0 += grid_size() * NWV * 2) {
        u32x4_t hv[2][2], yv[2][2][4]; uint2 y8[2][2][4];
#pragma unroll
        for (int tt = 0; tt < 2; ++tt)
#pragma unroll
            for (int i = 0; i < 2; ++i) {
                hv[tt][i] = *(const u32x4_t*)(HB + (size_t)(t0 + tt) * 1024 + i * 512 + lane * 8);
#pragma unroll
                for (int k = 0; k < 4; ++k) {
                    if constexpr (Y8) y8[tt][i][k] = *(const uint2*)(Yb + ((size_t)(t0 + tt) * 4 + k) * 1024 + i * 512 + lane * 8);
                    else yv[tt][i][k] = *(const u32x4_t*)(Y + ((size_t)(t0 + tt) * 4 + k) * 1024 + i * 512 + lane * 8);
                }
            }
#pragma unroll
        for (int tt = 0; tt < 2; ++tt) {
            float ss = 0.f;
#pragma unroll
            for (int i = 0; i < 2; ++i) {
                float v[8]; unpack8(hv[tt][i], v);
#pragma unroll
                for (int k = 0; k < 4; ++k) {
                    if constexpr (Y8) {
                        const uint2 w = y8[tt][i][k];
                        const auto p0 = __builtin_amdgcn_cvt_pk_f32_fp8((int)w.x, false), p1 = __builtin_amdgcn_cvt_pk_f32_fp8((int)w.x, true), p2 = __builtin_amdgcn_cvt_pk_f32_fp8((int)w.y, false), p3 = __builtin_amdgcn_cvt_pk_f32_fp8((int)w.y, true);
                        v[0] += p0[0] * 0.0625f; v[1] += p0[1] * 0.0625f; v[2] += p1[0] * 0.0625f; v[3] += p1[1] * 0.0625f; v[4] += p2[0] * 0.0625f; v[5] += p2[1] * 0.0625f; v[6] += p3[0] * 0.0625f; v[7] += p3[1] * 0.0625f;
                    } else { float y[8]; unpack8(yv[tt][i][k], y);
#pragma unroll
                        for (int j = 0; j < 8; ++j) v[j] += y[j]; }
                }
#pragma unroll
                for (int j = 0; j < 8; ++j) ss += v[j] * v[j];
                *(u32x4_t*)(HBW + (size_t)(t0 + tt) * 1024 + i * 512 + lane * 8) = (u32x4_t){pack2(v[0], v[1]), pack2(v[2], v[3]), pack2(v[4], v[5]), pack2(v[6], v[7])};
            }
            ss = wave_sum(ss);
            if (lane == 0) RS2[t0 + tt] = rsqrtf(ss * (1.0f / 1024.0f) + EPS);
        }
    }
}

template <bool DRY = false> __device__ __forceinline__ void ph_final(const Params& P, int layer) {
    const int tid = opaque_tid(), wid = tid >> 6, lane = tid & 63;
    bf16_t* HB = (bf16_t*)(P.ws + WS_HB); bf16_t* HBW = DRY ? (bf16_t*)(P.ws + WS_BIG + 128 * MiB) : HB; float* RS = DRY ? (float*)(P.ws + WS_BIG + 200 * MiB) : (float*)(P.ws + WS_RSTD); const bf16_t* V = (const bf16_t*)(P.ws + WS_YMIX);
    float* OUTW = DRY ? (float*)(P.ws + WS_BIG) : P.out;
    const float* gp = P.ple_pn + layer * 1024;
    float g[2][8];
#pragma unroll
    for (int i = 0; i < 2; ++i) { const f32x4 a = *(const f32x4*)(gp + i * 512 + lane * 8), b = *(const f32x4*)(gp + i * 512 + lane * 8 + 4); g[i][0] = a[0]; g[i][1] = a[1]; g[i][2] = a[2]; g[i][3] = a[3]; g[i][4] = b[0]; g[i][5] = b[1]; g[i][6] = b[2]; g[i][7] = b[3]; }
    for (int t0 = (blockIdx.x * NWV + wid) * 2; t0 < T; t0 += grid_size() * NWV * 2) {
        u32x4_t hv[2][2], yv[2][2];
#pragma unroll
        for (int tt = 0; tt < 2; ++tt)
#pragma unroll
            for (int i = 0; i < 2; ++i) { hv[tt][i] = *(const u32x4_t*)(HB + (size_t)(t0 + tt) * 1024 + i * 512 + lane * 8); yv[tt][i] = *(const u32x4_t*)(V + (size_t)(t0 + tt) * 1024 + i * 512 + lane * 8); }
#pragma unroll
        for (int tt = 0; tt < 2; ++tt) {
            float vv[2][8]; float ss = 0.f;
#pragma unroll
            for (int i = 0; i < 2; ++i) { unpack8(yv[tt][i], vv[i]);
#pragma unroll
                for (int j = 0; j < 8; ++j) ss += vv[i][j] * vv[i][j]; }
            ss = wave_sum(ss);
            const float r = rsqrtf(ss * (1.0f / 1024.0f) + EPS);
            float s2 = 0.f;
#pragma unroll
            for (int i = 0; i < 2; ++i) {
                float h[8]; unpack8(hv[tt][i], h);
#pragma unroll
                for (int j = 0; j < 8; ++j) h[j] += vv[i][j] * r * g[i][j];
                if (layer == DEPTH - 1) { float* op = OUTW + (size_t)(t0 + tt) * 1024 + i * 512 + lane * 8; *(f32x4*)op = (f32x4){h[0], h[1], h[2], h[3]}; *(f32x4*)(op + 4) = (f32x4){h[4], h[5], h[6], h[7]}; }
                else {
#pragma unroll
                    for (int j = 0; j < 8; ++j) s2 += h[j] * h[j];
                    *(u32x4_t*)(HBW + (size_t)(t0 + tt) * 1024 + i * 512 + lane * 8) = (u32x4_t){pack2(h[0], h[1]), pack2(h[2], h[3]), pack2(h[4], h[5]), pack2(h[6], h[7])};
                }
            }
            if (layer != DEPTH - 1) { s2 = wave_sum(s2); if (lane == 0) RS[t0 + tt] = rsqrtf(s2 * (1.0f / 1024.0f) + EPS); }
        }
    }
}

struct EpiZ8 { bf16_t* Z; const float* rstd; typedef float Pre;
    __device__ __forceinline__ Pre pre(int r, int) const { return rstd[r]; }
    __device__ __forceinline__ void post(int r, int c, f32x4 a, f32x4 b, Pre s) const { *(u32x4_t*)(Z + (size_t)r * ZW + c) = (u32x4_t){pack2(a[0] * s, a[1] * s), pack2(a[2] * s, a[3] * s), pack2(b[0] * s, b[1] * s), pack2(b[2] * s, b[3] * s)}; } };
struct EpiBf16_8 { bf16_t* O; int ldo; typedef int Pre;
    __device__ __forceinline__ Pre pre(int, int) const { return 0; }
    __device__ __forceinline__ void post(int r, int c, f32x4 a, f32x4 b, Pre) const { *(u32x4_t*)(O + (size_t)r * ldo + c) = (u32x4_t){pack2(a[0], a[1]), pack2(a[2], a[3]), pack2(b[0], b[1]), pack2(b[2], b[3])}; } };
struct EpiResid8 { const float* xin; bf16_t* HB; struct Pre { f32x4 lo, hi; };
    __device__ __forceinline__ Pre pre(int r, int c) const { Pre p;
        if (xin) { p.lo = *(const f32x4*)(xin + (size_t)r * 1024 + c); p.hi = *(const f32x4*)(xin + (size_t)r * 1024 + c + 4); }
        else { const u32x4_t e = *(const u32x4_t*)(HB + (size_t)r * 1024 + c); p.lo = (f32x4){bf2f(e[0] & 0xffff), bf2f(e[0] >> 16), bf2f(e[1] & 0xffff), bf2f(e[1] >> 16)}; p.hi = (f32x4){bf2f(e[2] & 0xffff), bf2f(e[2] >> 16), bf2f(e[3] & 0xffff), bf2f(e[3] >> 16)}; }
        return p; }
    __device__ __forceinline__ void post(int r, int c, f32x4 a, f32x4 b, const Pre& p) const { const f32x4 h0 = p.lo + a, h1 = p.hi + b;
        *(u32x4_t*)(HB + (size_t)r * 1024 + c) = (u32x4_t){pack2(h0[0], h0[1]), pack2(h0[2], h0[3]), pack2(h1[0], h1[1]), pack2(h1[2], h1[3])}; } };
struct EpiPle8 { const bf16_t* E; const float* rstd2; bf16_t* V; struct Pre { u32x4_t e; float s; };
    __device__ __forceinline__ Pre pre(int r, int c) const { Pre p; p.e = *(const u32x4_t*)(E + (size_t)r * 1024 + c); p.s = rstd2[r]; return p; }
    __device__ __forceinline__ void post(int r, int c, f32x4 a, f32x4 b, const Pre& p) const { const float s = p.s; const u32x4_t e = p.e;
        *(u32x4_t*)(V + (size_t)r * 1024 + c) = (u32x4_t){pack2(bf2f(e[0] & 0xffff) * sigmoidf_(a[0] * s), bf2f(e[0] >> 16) * sigmoidf_(a[1] * s)), pack2(bf2f(e[1] & 0xffff) * sigmoidf_(a[2] * s), bf2f(e[1] >> 16) * sigmoidf_(a[3] * s)),
                                                            pack2(bf2f(e[2] & 0xffff) * sigmoidf_(b[0] * s), bf2f(e[2] >> 16) * sigmoidf_(b[1] * s)), pack2(bf2f(e[3] & 0xffff) * sigmoidf_(b[2] * s), bf2f(e[3] >> 16) * sigmoidf_(b[3] * s))}; } };
__device__ __forceinline__ float swiglu_(float g, float u, float s, float bgv, float buv) { const float gg = fminf(g * s + bgv, 7.0f); const float uu = fminf(fmaxf(u * s + buv, -7.0f), 7.0f); return (uu + 1.0f) * gg * sigmoidf_(1.702f * gg); }


namespace fg {
typedef int v4i_t __attribute__((ext_vector_type(4))); typedef int v8i_t __attribute__((ext_vector_type(8)));
constexpr int BM = 256, BK = 64, HALF = 128, HTB = HALF * BK * 2  , STAGE_BYTES = 8 * HTB, NXCD = 8, WGM = 8;
__host__ __device__ __forceinline__ int lds_byte(int r, int c) { const int st = (r >> 4) * 2 + (c >> 5), rr = r & 15, cc = c & 31, ob = rr * 64 + cc * 2; return st * 1024 + (ob ^ (((ob >> 9) & 1) << 5)); }
__host__ __device__ __forceinline__ int perm32(int rho) { const int n = rho >> 4, i = rho & 15; return 8 * (i >> 2) + 4 * n + (i & 3); }
__host__ __device__ __forceinline__ void stage_rc(int b, int& R, int& C) { const int st = b / 1024, sb = b % 1024, swz = sb ^ (((sb >> 9) & 1) << 5); R = (st >> 1) * 16 + swz / 64; C = (st & 1) * 32 + (swz % 64) / 2; }

template <class PB>
__device__ __forceinline__ void gemm_phase(LAS unsigned char* lds, const PB& S) {
    constexpr int K = PB::K, nt = K / BK;
    typedef typename PB::Unit Unit;
    const int tid = opaque_tid(); const int wid = __builtin_amdgcn_readfirstlane(tid >> 6), lane = tid & 63, wr = wid >> 2, wc = wid & 3, fr = lane & 15, fq = lane >> 4;
    unsigned voffB[2];
#pragma unroll
    for (int i = 0; i < 2; ++i) { int R_, C_; stage_rc(tid * 16 + i * 8192, R_, C_); const int Rb_ = PB::PERM ? ((R_ & ~31) + perm32(R_ & 31)) : R_; voffB[i] = (unsigned)(Rb_ * K + C_) * 2u; }
#define FG_AOFFS(dst, unit) do { const int tz_ = opaque_tid(); _Pragma("unroll") for (int i_ = 0; i_ < 2; ++i_) { int R_, C_; stage_rc(tz_ * 16 + i_ * 8192, R_, C_); \
        _Pragma("unroll") for (int h_ = 0; h_ < 2; ++h_) dst[h_][i_] = S.a_off(unit, h_ * HALF + R_) + (unsigned)C_ * 2u; } } while (0)
    constexpr size_t kstep = (size_t)(BK * 2);
    constexpr size_t hstep = (size_t)HALF * K * 2;
    const unsigned ldsw = (unsigned)wid * 1024u;
    const int aoff = lds_byte(wr * 64 + fr, fq * 8), boff = lds_byte(wc * 32 + fr, fq * 8);
#define FG_SA(b, h) (((b) * 2 + (h)) * HTB)
#define FG_SB(b, h) ((4 + (b) * 2 + (h)) * HTB)
#define FG_STAGE_B(bufoff, gbase) do { _Pragma("unroll") for (int _i = 0; _i < 2; ++_i) \
        __builtin_amdgcn_global_load_lds((const unsigned*)((const char*)(gbase) + voffB[_i]), (LAS unsigned*)(lds + (bufoff) + ldsw + _i * 8192), 16, 0, 0); } while (0)
#define FG_STAGE_A(bufoff, o0, o1) do { \
        __builtin_amdgcn_global_load_lds((const unsigned*)(Abase + (o0)), (LAS unsigned*)(lds + (bufoff) + ldsw), 16, 0, 0); \
        __builtin_amdgcn_global_load_lds((const unsigned*)(Abase + (o1)), (LAS unsigned*)(lds + (bufoff) + ldsw + 8192), 16, 0, 0); } while (0)
#define FG_LD8(dst, off) do { const v4i_t lo_ = *(const LAS v4i_t*)(lds + (off)), hi_ = *(const LAS v4i_t*)(lds + (off) + 1024); dst = (v8i_t){lo_[0], lo_[1], lo_[2], lo_[3], hi_[0], hi_[1], hi_[2], hi_[3]}; } while (0)
#define FG_LDA(dst, b, h) do { _Pragma("unroll") for (int m = 0; m < 4; ++m) FG_LD8(dst[m], FG_SA(b, h) + aoff + m * 2048); } while (0)
#define FG_LDB(dst, b, h) do { _Pragma("unroll") for (int n = 0; n < 2; ++n) FG_LD8(dst[n], FG_SB(b, h) + boff + n * 2048); } while (0)
#define FG_HALF(v, k) ((k) == 0 ? __builtin_bit_cast(bf16x8, (v4i_t){(v)[0], (v)[1], (v)[2], (v)[3]}) : __builtin_bit_cast(bf16x8, (v4i_t){(v)[4], (v)[5], (v)[6], (v)[7]}))
#define FG_MMA(ai, bj, At, Bt) do { __builtin_amdgcn_s_setprio(1); \
        if constexpr (PB::FP8) { _Pragma("unroll") for (int m = 0; m < 4; ++m) _Pragma("unroll") for (int n = 0; n < 2; ++n) \
            asm volatile("v_mfma_scale_f32_16x16x128_f8f6f4 %0, %1, %2, %0, %3, %4 op_sel_hi:[0,0,0]" : "+v"(acc[ai][bj][m][n]) : "v"(Bt[n]), "v"(At[m]), "v"(sclW), "v"(sclA)); } \
        else { _Pragma("unroll") for (int m = 0; m < 4; ++m) _Pragma("unroll") for (int n = 0; n < 2; ++n) _Pragma("unroll") for (int k = 0; k < 2; ++k) \
            acc[ai][bj][m][n] = __builtin_amdgcn_mfma_f32_16x16x32_bf16(FG_HALF(Bt[n], k), FG_HALF(At[m], k), acc[ai][bj][m][n], 0, 0, 0); } \
        __builtin_amdgcn_s_setprio(0); } while (0)
#define FG_WAIT_V(n) asm volatile("s_waitcnt vmcnt(" #n ")" ::: "memory")
#define FG_WAIT_L(n) asm volatile("s_waitcnt lgkmcnt(" #n ")" ::: "memory")
#define FG_BAR __builtin_amdgcn_s_barrier()
#define FG_SCHED __builtin_amdgcn_sched_barrier(0)
    Unit cur, nxt; int ui = 0;
    if (!S.next(0, cur)) return;
    f32x4 acc[2][2][4][2];
#pragma unroll
    for (int a = 0; a < 2; ++a)
#pragma unroll
        for (int b = 0; b < 2; ++b)
#pragma unroll
            for (int m = 0; m < 4; ++m)
#pragma unroll
                for (int n = 0; n < 2; ++n) acc[a][b][m][n] = (f32x4){0.f, 0.f, 0.f, 0.f};
    v8i_t At[4], B0[2], B1[2];
    int sclW = 0x79797979, sclA = 0x7f7f7f7f;
    asm volatile("" : "+v"(sclW), "+v"(sclA));
    const char* Abase = S.a_base();
    unsigned vAc[2][2];
    FG_AOFFS(vAc, cur);
    const char* cB = S.b_base(cur);
    FG_STAGE_B(FG_SB(0, 0), cB); FG_STAGE_B(FG_SB(0, 1), cB + hstep); FG_STAGE_A(FG_SA(0, 0), vAc[0][0], vAc[0][1]); FG_STAGE_A(FG_SA(0, 1), vAc[1][0], vAc[1][1]);
    if (wr == 1) FG_BAR;
    FG_WAIT_V(2); FG_BAR;
    FG_STAGE_B(FG_SB(1, 0), cB + kstep); FG_STAGE_A(FG_SA(1, 0), vAc[0][0] + (unsigned)kstep, vAc[0][1] + (unsigned)kstep); FG_STAGE_B(FG_SB(1, 1), cB + hstep + kstep);
    FG_WAIT_V(6); FG_BAR;
    for (;;) {
        const bool has_next = S.next(ui + 1, nxt);
        const char* nB = has_next ? S.b_base(nxt) : cB;
        {
            unsigned vAn[2][2];
            if (has_next) { FG_AOFFS(vAn, nxt); }
            else {
#pragma unroll
                for (int h = 0; h < 2; ++h)
#pragma unroll
                    for (int i = 0; i < 2; ++i) vAn[h][i] = vAc[h][i];
            }
            *(LAS v4i_t*)(lds + STAGE_BYTES + 512 + opaque_tid() * 16) = (v4i_t){(int)vAn[0][0], (int)vAn[0][1], (int)vAn[1][0], (int)vAn[1][1]};
        }
#pragma unroll 1
        for (int t = 0; t < nt; t += 2) {
            const bool last = (t == nt - 2);
            const unsigned k1 = (unsigned)((t + 1) * (int)kstep), k2 = last ? 0u : (unsigned)((t + 2) * (int)kstep);
            const char* b2 = last ? nB : cB + (size_t)(t + 2) * kstep; const char* b3 = b2 + kstep;
            const unsigned c10_ = vAc[1][0], c11_ = vAc[1][1];
            if (last) { const v4i_t nx_ = *(const LAS v4i_t*)(lds + STAGE_BYTES + 512 + opaque_tid() * 16); vAc[0][0] = (unsigned)nx_[0]; vAc[0][1] = (unsigned)nx_[1]; vAc[1][0] = (unsigned)nx_[2]; vAc[1][1] = (unsigned)nx_[3]; }
#define FG_A2(h, i) (vAc[h][i] + k2)
            FG_LDB(B0, 0, 0); FG_LDB(B1, 0, 1); FG_SCHED; FG_LDA(At, 0, 0); FG_STAGE_A(FG_SA(1, 1), c10_ + k1, c11_ + k1);
            FG_WAIT_V(8); FG_WAIT_L(0); FG_BAR; FG_MMA(0, 0, At, B0); FG_MMA(0, 1, At, B1); FG_BAR; FG_SCHED;
            FG_LDA(At, 0, 1); FG_STAGE_B(FG_SB(0, 0), b2); FG_STAGE_B(FG_SB(0, 1), b2 + hstep); FG_STAGE_A(FG_SA(0, 0), FG_A2(0, 0), FG_A2(0, 1));
            FG_WAIT_V(8); FG_WAIT_L(0); FG_BAR; FG_MMA(1, 0, At, B0); FG_MMA(1, 1, At, B1); FG_BAR; FG_SCHED;
            FG_LDB(B0, 1, 0); FG_LDB(B1, 1, 1); FG_SCHED; FG_LDA(At, 1, 0); FG_STAGE_A(FG_SA(0, 1), FG_A2(1, 0), FG_A2(1, 1));
            FG_WAIT_V(8); FG_WAIT_L(0); FG_BAR; FG_MMA(0, 0, At, B0); FG_MMA(0, 1, At, B1); FG_BAR; FG_SCHED;
            FG_LDA(At, 1, 1); FG_STAGE_B(FG_SB(1, 0), b3); FG_STAGE_B(FG_SB(1, 1), b3 + hstep); FG_STAGE_A(FG_SA(1, 0), FG_A2(0, 0) + (unsigned)kstep, FG_A2(0, 1) + (unsigned)kstep);
            FG_WAIT_V(8); FG_WAIT_L(0); FG_BAR; FG_MMA(1, 0, At, B0); FG_MMA(1, 1, At, B1); FG_BAR; FG_SCHED;
        }
        if (wr == 0) FG_BAR;
        if constexpr (PB::FP8) asm volatile("s_nop 15\n\ts_nop 15\n\ts_nop 15" ::: "memory");
        { const int t2_ = opaque_tid(); const int w2_ = __builtin_amdgcn_readfirstlane(t2_ >> 6), l2_ = t2_ & 63;
          S.epilogue(acc, cur, w2_ >> 2, w2_ & 3, l2_ & 15, l2_ >> 4); }
        if (!has_next) break;
#pragma unroll
        for (int a = 0; a < 2; ++a)
#pragma unroll
            for (int b = 0; b < 2; ++b)
#pragma unroll
                for (int m = 0; m < 4; ++m)
#pragma unroll
                    for (int n = 0; n < 2; ++n) acc[a][b][m][n] = (f32x4){0.f, 0.f, 0.f, 0.f};
        cur = nxt; cB = nB; ++ui;
        if (wr == 1) FG_BAR;
    }
    FG_WAIT_V(0);
    FG_BAR;
#undef FG_AOFFS
#undef FG_A2
#undef FG_SA
#undef FG_SB
#undef FG_STAGE_A
#undef FG_STAGE_B
#undef FG_LDA
#undef FG_LD8
#undef FG_HALF
#undef FG_LDB
#undef FG_MMA
#undef FG_WAIT_V
#undef FG_WAIT_L
#undef FG_BAR
#undef FG_SCHED
}

template <int K_, int LDA, class Epi, bool PERM_>
struct DenseProb {
    static constexpr int K = K_; static constexpr bool PERM = PERM_, FP8 = false;
    struct Unit { int pm, pn; };
    const bf16_t* A; const bf16_t* Bt; int nM, nN, nwg, G, c; Epi epi;
    __device__ __forceinline__ DenseProb(const bf16_t* A_, const bf16_t* Bt_, int N, const Epi& e) : A(A_), Bt(Bt_), nM(T / BM), nN(N / BM), nwg((T / BM) * (N / BM)), G(grid_size()), c(blockIdx.x), epi(e) {}
    __device__ __forceinline__ bool next(int i, Unit& u) const {
        const long L = (long)i * G + c; if (L >= nwg) return false;
        int wgid = (int)L; { const int q = nwg / NXCD, r = nwg % NXCD, xcd = wgid % NXCD, off = wgid / NXCD; wgid = (xcd < r ? xcd * (q + 1) : r * (q + 1) + (xcd - r) * q) + off; }
        const int nig = WGM * nN, gid = wgid / nig, fm = gid * WGM, gsz = (nM - fm) < WGM ? (nM - fm) : WGM;
        u.pm = fm + ((wgid % nig) % gsz); u.pn = (wgid % nig) / gsz; return true;
    }
    __device__ __forceinline__ const char* a_base() const { return (const char*)A; }
    __device__ __forceinline__ unsigned a_off(const Unit& u, int r) const { return (unsigned)((u.pm * BM + r) * LDA) * 2u; }
    __device__ __forceinline__ const char* b_base(const Unit& u) const { return (const char*)Bt + (size_t)u.pn * BM * K * 2; }
    __device__ __forceinline__ void epilogue(const f32x4 (&acc)[2][2][4][2], const Unit& u, int wr, int wc, int fr, int fq) const {
        const int row0 = u.pm * BM + wr * 64 + fr;
        if constexpr (PERM) {
            const int col0 = u.pn * BM + wc * 32 + 8 * fq;
#pragma unroll
            for (int ai = 0; ai < 2; ++ai) {
                typename Epi::Pre pre[4][2];
#pragma unroll
                for (int m = 0; m < 4; ++m)
#pragma unroll
                    for (int bj = 0; bj < 2; ++bj) pre[m][bj] = epi.pre(row0 + ai * HALF + m * 16, col0 + bj * HALF);
#pragma unroll
                for (int m = 0; m < 4; ++m)
#pragma unroll
                    for (int bj = 0; bj < 2; ++bj) epi.post(row0 + ai * HALF + m * 16, col0 + bj * HALF, acc[ai][bj][m][0], acc[ai][bj][m][1], pre[m][bj]);
            }
        } else {
            const int col0 = u.pn * BM + wc * 32 + 4 * fq;
#pragma unroll
            for (int ai = 0; ai < 2; ++ai)
#pragma unroll
                for (int m = 0; m < 4; ++m)
#pragma unroll
                    for (int bj = 0; bj < 2; ++bj)
#pragma unroll
                        for (int n = 0; n < 2; ++n) epi(row0 + ai * HALF + m * 16, col0 + bj * HALF + n * 16, acc[ai][bj][m][n]);
        }
    }
};
}
template <int K, int LDA, bool PERM, class Epi>
__device__ __forceinline__ void ph_gemm_fast(LAS unsigned char* lds, const bf16_t* A, const bf16_t* Bt, int N, const Epi& epi) {
    const fg::DenseProb<K, LDA, Epi, PERM> pb(A, Bt, N, epi);
    fg::gemm_phase(lds, pb);
}


namespace fg {
struct MoeUnit { int e, mblk, pn, rowoff, M; };
template <bool FIRST, bool FP8_>
struct MoeProb {
    static constexpr int K = FP8_ ? 512 : 1024  , NCOL = FIRST ? 8 : 4; static constexpr bool PERM = true, FP8 = FP8_; static constexpr unsigned RB = FP8_ ? 1024u : 2048u  ;
    typedef MoeUnit Unit;
    const Params& P; int layer; const LAS int* tab;
    int G, c; mutable int e_, acc_, off_;
    __device__ __forceinline__ MoeProb(const Params& P_, int layer_, const LAS int* tab_) : P(P_), layer(layer_), tab(tab_), G(grid_size()), c(blockIdx.x), e_(0), acc_(0), off_(0) {}
    __device__ __forceinline__ bool next(int i, Unit& u) const {
        const int j = i * (G >> 3) + (c >> 3), tile = (j / NCOL) * 8 + (c & 7);
        while (e_ < 32) { const int tl = (tab[e_] + 255) >> 8; if (tile < acc_ + tl) break; acc_ += tl; off_ += tl * 256; ++e_; }
        if (e_ >= 32) return false;
        u.e = e_; u.mblk = tile - acc_; u.pn = j % NCOL; u.rowoff = off_; u.M = tab[e_]; return true;
    }
    __device__ __forceinline__ const char* a_base() const { return FIRST ? (const char*)(P.ws + (FP8_ ? WS_YMIX : WS_HB)) : (const char*)(P.ws + WS_BIG); }
    __device__ __forceinline__ unsigned a_off(const Unit& u, int r) const {
        if (FIRST) { int rr = u.mblk * 256 + r; rr = rr < u.M ? rr : u.M - 1; const int ts = ((const int*)(P.ws + WS_LIST))[(size_t)u.e * T + rr]; return (unsigned)(ts >> 2) * RB; }
        return (unsigned)(u.rowoff + u.mblk * 256 + r) * RB;
    }
    __device__ __forceinline__ const char* b_base(const Unit& u) const {
        return FIRST ? (const char*)(P.ws + WS_W1) + ((size_t)u.e * 2048 + (size_t)u.pn * 256) * RB : (const char*)(P.ws + WS_W2) + ((size_t)u.e * 1024 + (size_t)u.pn * 256) * RB;
    }
    __device__ __forceinline__ void epilogue(const f32x4 (&acc)[2][2][4][2], const Unit& u, int wr, int wc, int fr, int fq) const {
        char* ws = P.ws; const int rl0 = u.mblk * 256 + wr * 64 + fr;
        if (FIRST) {
            const float* lrs = (const float*)(ws + WS_LRS) + (size_t)u.e * T;
            bf16_t* H = (bf16_t*)(ws + WS_BIG) + (size_t)u.rowoff * 1024;
            const int hc0 = u.pn * 128 + wc * 32 + 8 * fq;
            const float* bgp = P.moe_bg + ((size_t)layer * 32 + u.e) * 1024 + hc0; const float* bup = P.moe_bu + ((size_t)layer * 32 + u.e) * 1024 + hc0;
            const f32x4 bg0 = *(const f32x4*)bgp, bg1 = *(const f32x4*)(bgp + 4), bu0 = *(const f32x4*)bup, bu1 = *(const f32x4*)(bup + 4);
            float sc[2][4];
#pragma unroll
            for (int ai = 0; ai < 2; ++ai)
#pragma unroll
                for (int m = 0; m < 4; ++m) { const int r = rl0 + ai * HALF + m * 16; sc[ai][m] = lrs[r < u.M ? r : u.M - 1]; }
#pragma unroll
            for (int ai = 0; ai < 2; ++ai)
#pragma unroll
                for (int m = 0; m < 4; ++m) { const int r = rl0 + ai * HALF + m * 16;
                    if (r < u.M) {
                        const float s_ = sc[ai][m]; const f32x4 g0 = acc[ai][0][m][0], g1 = acc[ai][0][m][1], u0 = acc[ai][1][m][0], u1 = acc[ai][1][m][1];
                        const float h0 = swiglu_(g0[0], u0[0], s_, bg0[0], bu0[0]), h1 = swiglu_(g0[1], u0[1], s_, bg0[1], bu0[1]), h2 = swiglu_(g0[2], u0[2], s_, bg0[2], bu0[2]), h3 = swiglu_(g0[3], u0[3], s_, bg0[3], bu0[3]);
                        const float h4 = swiglu_(g1[0], u1[0], s_, bg1[0], bu1[0]), h5 = swiglu_(g1[1], u1[1], s_, bg1[1], bu1[1]), h6 = swiglu_(g1[2], u1[2], s_, bg1[2], bu1[2]), h7 = swiglu_(g1[3], u1[3], s_, bg1[3], bu1[3]);
                        if constexpr (FP8_) *(uint2*)((unsigned char*)(ws + WS_BIG) + (size_t)(u.rowoff + r) * 1024 + hc0) = make_uint2(pack4_fp8(h0, h1, h2, h3), pack4_fp8(h4, h5, h6, h7));
                        else *(u32x4_t*)(H + (size_t)r * 1024 + hc0) = (u32x4_t){pack2(h0, h1), pack2(h2, h3), pack2(h4, h5), pack2(h6, h7)};
                    } }
        } else {
            const int* list = (const int*)(ws + WS_LIST) + (size_t)u.e * T; const float* lgt = (const float*)(ws + WS_LGT) + (size_t)u.e * T;
            bf16_t* Y = (bf16_t*)(ws + WS_Y);
            const int col0 = u.pn * 256 + wc * 32 + 8 * fq;
            const float* bdp = P.moe_bd + ((size_t)layer * 32 + u.e) * 1024 + col0;
            f32x4 bd[2][2];
#pragma unroll
            for (int bj = 0; bj < 2; ++bj) { bd[bj][0] = *(const f32x4*)(bdp + bj * HALF); bd[bj][1] = *(const f32x4*)(bdp + bj * HALF + 4); }
            int tsv[2][4]; float gv[2][4];
#pragma unroll
            for (int ai = 0; ai < 2; ++ai)
#pragma unroll
                for (int m = 0; m < 4; ++m) { const int r = rl0 + ai * HALF + m * 16; const int rc = r < u.M ? r : u.M - 1; tsv[ai][m] = list[rc]; gv[ai][m] = lgt[rc]; }
#pragma unroll
            for (int ai = 0; ai < 2; ++ai)
#pragma unroll
                for (int m = 0; m < 4; ++m) { const int r = rl0 + ai * HALF + m * 16;
                    if (r < u.M) {
                        const float g = gv[ai][m]; bf16_t* yr = Y + (size_t)tsv[ai][m] * 1024 + col0;
#pragma unroll
                        for (int bj = 0; bj < 2; ++bj) { const f32x4 a = (acc[ai][bj][m][0] + bd[bj][0]) * g, b = (acc[ai][bj][m][1] + bd[bj][1]) * g;
                            if constexpr (FP8_) *(uint2*)((unsigned char*)(ws + WS_Y) + (size_t)tsv[ai][m] * 1024 + col0 + bj * HALF) = make_uint2(pack4_fp8(a[0] * 16.0f, a[1] * 16.0f, a[2] * 16.0f, a[3] * 16.0f), pack4_fp8(b[0] * 16.0f, b[1] * 16.0f, b[2] * 16.0f, b[3] * 16.0f));
                            else *(u32x4_t*)(yr + bj * HALF) = (u32x4_t){pack2(a[0], a[1]), pack2(a[2], a[3]), pack2(b[0], b[1]), pack2(b[2], b[3])}; }
                    } }
        }
    }
};
}
template <bool FIRST, bool FP8>
__device__ __forceinline__ void ph_moe_fast(const Params& P, int layer, LAS unsigned char* lds) {
    LAS int* tab = (LAS int*)(lds + fg::STAGE_BYTES);
    const int tz = opaque_tid();
    if (tz < 32) tab[tz] = (int)((const unsigned*)(P.ws + WS_CTL))[CTL_CNT + layer * 32 + tz];
    __syncthreads();
    const fg::MoeProb<FIRST, FP8> pb(P, layer, tab);
    fg::gemm_phase(lds, pb);
}


namespace at {
typedef short s16x4 __attribute__((ext_vector_type(4)));
constexpr int KSLOT = 12288, VSLOT = 8192, NSLOT = 4, LDS_K = 0, LDS_V = NSLOT * KSLOT, LDS_END = LDS_V + NSLOT * VSLOT;
typedef float f32x2_t __attribute__((ext_vector_type(2))); typedef __bf16 bf16x2_t __attribute__((ext_vector_type(2)));
__device__ __forceinline__ unsigned cvtpk(float lo, float hi) { const f32x2_t v = {lo, hi}; const bf16x2_t b = __builtin_convertvector(v, bf16x2_t); return __builtin_bit_cast(unsigned, b); }
__device__ __forceinline__ void glds16(const void* gsrc, unsigned lds_dst) { unsigned keep;
    asm volatile("s_mov_b32 %0, m0\n\ts_mov_b32 m0, %2\n\ts_nop 0\n\tglobal_load_lds_dwordx4 %1, off\n\ts_mov_b32 m0, %0" : "=&s"(keep) : "v"(gsrc), "s"(lds_dst) : "memory"); }
__device__ __forceinline__ s16x4 vtr(const LAS unsigned char* p) { return __builtin_bit_cast(s16x4, __builtin_amdgcn_ds_read_tr16_b64_v4i16((LAS s16x4*)p)); }

__device__ __forceinline__ void attn_unit(int b, int h, int qb, const bf16_t* Q, const bf16_t* Kd, const bf16_t* KV, bf16_t* YM, LAS unsigned char* lds) {
    const int tid = opaque_tid(); const int lane = tid & 63, r32 = lane & 31, hi = lane >> 5; const int wid = __builtin_amdgcn_readfirstlane(tid >> 6);
    const int q0 = qb * 256; const size_t row = (size_t)b * SEQ + q0 + wid * 32 + r32;
    const int NT = 4 * qb + 4;
    const char* ksrcA = (const char*)(Kd + (((size_t)b * SEQ + lane) * 8 + h) * 96) + wid * 16;
    const char* ksrcB = (const char*)(Kd + (((size_t)b * SEQ + lane) * 8 + h) * 96) + (8 + (wid & 3)) * 16;
    const char* vsrc = (const char*)(KV + ((size_t)b * SEQ + 16 * (wid & 3) + (lane >> 2)) * 1024 + h * 128 + 64 + (wid >> 2) * 32 + (lane & 3) * 8);
    const unsigned lds0 = (unsigned)(size_t)lds;
#define AT_DMA(j, slot) do { \
        glds16(ksrcA + (size_t)(j) * (64 * 1536), (unsigned)__builtin_amdgcn_readfirstlane((int)(lds0 + LDS_K + (slot) * KSLOT + wid * 1024))); \
        glds16(ksrcB + (size_t)(j) * (64 * 1536), (unsigned)__builtin_amdgcn_readfirstlane((int)(lds0 + LDS_K + (slot) * KSLOT + (8 + (wid & 3)) * 1024))); \
        glds16(vsrc + (size_t)(j) * (64 * 2048), (unsigned)__builtin_amdgcn_readfirstlane((int)(lds0 + LDS_V + (slot) * VSLOT + wid * 1024))); } while (0)
    AT_DMA(0, 0); AT_DMA(1, 1); AT_DMA(2, 2);
    bf16x8 qf[6];
#pragma unroll
    for (int ks = 0; ks < 6; ++ks) qf[ks] = *(const bf16x8*)(Q + row * 768 + h * 96 + ks * 16 + hi * 8);
    asm volatile("" : "+v"(qf[0]), "+v"(qf[1]), "+v"(qf[2]), "+v"(qf[3]), "+v"(qf[4]), "+v"(qf[5]));
    constexpr float THR = 8.0f;
    float mref = 0.f, l = 0.f;
    f32x16 o0, o1, negm;
#pragma unroll
    for (int r = 0; r < 16; ++r) { o0[r] = 0.f; o1[r] = 0.f; negm[r] = 0.f; }
    const int kfo = hi * 1024 + r32 * 16;
    const int vfo = ((lane >> 4) & 1) * 32 + (lane & 3) * 8 + (4 * hi + ((lane & 15) >> 2)) * 64;
    const int qrel = wid * 32 + r32;
    int slot = 0;
    for (int j = 0; j < NT; ++j) {
        if (j + 2 < NT) asm volatile("s_waitcnt vmcnt(6)\n\ts_barrier" ::: "memory"); else if (j + 1 < NT) asm volatile("s_waitcnt vmcnt(3)\n\ts_barrier" ::: "memory"); else asm volatile("s_waitcnt vmcnt(0)\n\ts_barrier" ::: "memory");
        if (j + 3 < NT) { AT_DMA(j + 3, (slot + 3) & 3); }
        const LAS unsigned char* kp = lds + LDS_K + slot * KSLOT + kfo;
        const LAS unsigned char* vp = lds + LDS_V + slot * VSLOT + vfo;
        f32x16 s0, s1;
#pragma unroll
        for (int ks = 0; ks < 6; ++ks) {
            const bf16x8 k0 = *(const LAS bf16x8*)(kp + ks * 2048), k1 = *(const LAS bf16x8*)(kp + ks * 2048 + 512);
            s0 = __builtin_amdgcn_mfma_f32_32x32x16_bf16(k0, qf[ks], ks == 0 ? negm : s0, 0, 0, 0);
            s1 = __builtin_amdgcn_mfma_f32_32x32x16_bf16(k1, qf[ks], ks == 0 ? negm : s1, 0, 0, 0);
        }
        if (j >= NT - 4) {
            const int kb = 64 * (j - (NT - 4)) + 4 * hi;
#pragma unroll
            for (int r = 0; r < 16; ++r) { const int kv = kb + (r & 3) + 8 * (r >> 2); if (kv > qrel) s0[r] = -INFINITY; if (kv + 32 > qrel) s1[r] = -INFINITY; }
        }
        float rm = fmaxf(fmaxf(s0[0], s1[0]), fmaxf(s0[1], s1[1]));
#pragma unroll
        for (int r = 2; r < 16; r += 2) rm = fmaxf(rm, fmaxf(fmaxf(s0[r], s1[r]), fmaxf(s0[r + 1], s1[r + 1])));
        rm = xhalf_max(rm);
        if (__any(rm > THR)) {
            const float dl = fmaxf(rm, 0.f);
            mref += dl;
#pragma unroll
            for (int r = 0; r < 16; ++r) { s0[r] -= dl; s1[r] -= dl; negm[r] = -mref; }
            const float f = __builtin_amdgcn_exp2f(-dl);
            l *= f;
#pragma unroll
            for (int r = 0; r < 16; ++r) { o0[r] *= f; o1[r] *= f; }
        }
        float ps0 = 0.f, ps1 = 0.f;
#pragma unroll
        for (int r = 0; r < 16; ++r) { s0[r] = __builtin_amdgcn_exp2f(s0[r]); s1[r] = __builtin_amdgcn_exp2f(s1[r]); ps0 += s0[r]; ps1 += s1[r]; }
        l += ps0 + ps1;
        bf16x8 pf[4];
        {
            unsigned w[16];
#pragma unroll
            for (int i = 0; i < 8; ++i) { w[i] = cvtpk(s0[2 * i], s0[2 * i + 1]); w[8 + i] = cvtpk(s1[2 * i], s1[2 * i + 1]); }
#pragma unroll
            for (int k = 0; k < 4; ++k) { typedef unsigned u32x4 __attribute__((ext_vector_type(4))); const u32x4 t = {w[4 * k], w[4 * k + 1], w[4 * k + 2], w[4 * k + 3]}; pf[k] = __builtin_bit_cast(bf16x8, t); }
        }
#pragma unroll
        for (int k = 0; k < 4; ++k) {
            const s16x4 a0 = vtr(vp + k * 1024), a1 = vtr(vp + k * 1024 + 512), c0 = vtr(vp + 4096 + k * 1024), c1 = vtr(vp + 4096 + k * 1024 + 512);
            const bf16x8 v0 = {a0[0], a0[1], a0[2], a0[3], a1[0], a1[1], a1[2], a1[3]}, v1 = {c0[0], c0[1], c0[2], c0[3], c1[0], c1[1], c1[2], c1[3]};
            o0 = __builtin_amdgcn_mfma_f32_32x32x16_bf16(v0, pf[k], o0, 0, 0, 0);
            o1 = __builtin_amdgcn_mfma_f32_32x32x16_bf16(v1, pf[k], o1, 0, 0, 0);
        }
        slot = (slot + 1) & 3;
    }
    l = xhalf_sum(l);
    const float rl = 1.0f / l;
    bf16_t* op = YM + row * 1024 + 256 + h * 64 + 4 * hi;
#pragma unroll
    for (int g = 0; g < 4; ++g) {
        *(uint2*)(op + 8 * g) = make_uint2(cvtpk(o0[4 * g] * rl, o0[4 * g + 1] * rl), cvtpk(o0[4 * g + 2] * rl, o0[4 * g + 3] * rl));
        *(uint2*)(op + 32 + 8 * g) = make_uint2(cvtpk(o1[4 * g] * rl, o1[4 * g + 1] * rl), cvtpk(o1[4 * g + 2] * rl, o1[4 * g + 3] * rl));
    }
    asm volatile("s_waitcnt lgkmcnt(0)\n\ts_barrier" ::: "memory");
#undef AT_DMA
}
}
__device__ __forceinline__ void ph_attn_fast(const Params& P, LAS unsigned char* lds) {
    const bf16_t* Q = (const bf16_t*)(P.ws + WS_BIG + BIG_Q); const bf16_t* Kd = (const bf16_t*)(P.ws + WS_BIG + BIG_K); const bf16_t* KV = (const bf16_t*)(P.ws + WS_BIG + BIG_KV);
    bf16_t* YM = (bf16_t*)(P.ws + WS_YMIX);
    const int G = grid_size();
    for (int v0 = (blockIdx.x % 8) * (G / 8) + blockIdx.x / 8; v0 < 256; v0 += G) {
        const int bh = v0 >> 2, s = v0 & 3;
#pragma unroll 1
        for (int i = 0; i < 4; ++i) { const int qb = (i == 0) ? s : (i == 1) ? 7 - s : (i == 2) ? 8 + s : 15 - s; at::attn_unit(bh >> 3, bh & 7, qb, Q, Kd, KV, YM, lds); }
    }
}


template <bool DRY = false> __device__ __forceinline__ void ph_gla_x(const Params& P, LAS unsigned char* lds) {
    const int tid = opaque_tid(); const int wid = __builtin_amdgcn_readfirstlane(tid >> 6), lane = tid & 63;
    LAS float* kend = (LAS float*)(lds + wid * 8192);
    const bf16_t* Z = (const bf16_t*)(P.ws + WS_BIG + BIG_Z); float* LA = (float*)(P.ws + WS_BIG + BIG_LA);
    float* UPD = DRY ? (float*)(P.ws + WS_Y + 32 * MiB) : (float*)(P.ws + WS_UPD); float* DEC = DRY ? (float*)(P.ws + WS_Y + 64 * MiB) : (float*)(P.ws + WS_DEC); float* LAW = DRY ? (float*)(P.ws + WS_Y) : LA;
    for (int u = blockIdx.x * NWV + wid; u < 2048; u += grid_size() * NWV) {
        const int bh = u >> 6, n = u & 63, b = bh >> 2, h = bh & 3;
        const size_t t0 = (size_t)b * SEQ + n * 64;
        const int k = lane & 31, half = lane >> 5;
        float c[32]; float run = 0.f;
#pragma unroll
        for (int i = 0; i < 32; ++i) { run += LA[(t0 + 32 * half + i) * 128 + h * 32 + k]; c[i] = run; }
        const float tot0 = __shfl(run, k);
        const float add = half ? tot0 : 0.f;
        const float blast = __shfl(run, 32 + k) + tot0;
        float kk[32];
#pragma unroll
        for (int i = 0; i < 32; ++i) kk[i] = bf2f(Z[(t0 + 32 * half + i) * ZW + ZC_GK + h * 32 + k]);
#pragma unroll
        for (int i = 0; i < 32; ++i) {
            const float bc = c[i] + add; const size_t t = t0 + 32 * half + i;
            LAW[t * 128 + h * 32 + k] = bc;
            kend[(32 * half + i) * 32 + k] = kk[i] * __expf(blast - bc);
        }
        if (half == 0) DEC[(size_t)u * 32 + k] = __expf(blast);
        asm volatile("s_waitcnt lgkmcnt(0)" ::: "memory");
        float acc[32];
#pragma unroll
        for (int i = 0; i < 32; ++i) acc[i] = 0.f;
#pragma unroll 4
        for (int j = 0; j < 64; ++j) {
            const float vj = bf2f(Z[(t0 + j) * ZW + ZC_GV + h * 64 + lane]);
#pragma unroll
            for (int kq = 0; kq < 8; ++kq) { const f32x4 ke = *(const LAS f32x4*)(kend + j * 32 + kq * 4); acc[4 * kq] += ke[0] * vj; acc[4 * kq + 1] += ke[1] * vj; acc[4 * kq + 2] += ke[2] * vj; acc[4 * kq + 3] += ke[3] * vj; }
        }
#pragma unroll
        for (int kk = 0; kk < 32; ++kk) UPD[((size_t)u * 32 + kk) * 64 + lane] = acc[kk];
        asm volatile("s_waitcnt lgkmcnt(0)" ::: "memory");
    }
}
__device__ __forceinline__ void ph_gla_scan(const Params& P) {
    const int tz = opaque_tid();
    const float* UPD = (const float*)(P.ws + WS_UPD); const float* DEC = (const float*)(P.ws + WS_DEC); bf16_t* SP = (bf16_t*)(P.ws + WS_SPREV);
    for (int e = blockIdx.x * NTHR + tz; e < 32 * 2048; e += grid_size() * NTHR) {
        const int bh = e >> 11, kv = e & 2047, k = kv >> 6;
        float st = 0.f;
        for (int n8 = 0; n8 < 64; n8 += 8) {
            float dd[8], uu[8];
#pragma unroll
            for (int q = 0; q < 8; ++q) { const size_t u = (size_t)bh * 64 + n8 + q; dd[q] = DEC[u * 32 + k]; uu[q] = UPD[u * 2048 + kv]; }
#pragma unroll
            for (int q = 0; q < 8; ++q) { const size_t u = (size_t)bh * 64 + n8 + q; SP[u * 2048 + kv] = f2bf(st); st = dd[q] * st + uu[q]; }
        }
    }
}
__device__ __forceinline__ void ph_gla_y(const Params& P, int layer, LAS unsigned char* lds) {
    using at::f32x16; using at::s16x4; using at::vtr; using at::cvtpk;
    typedef unsigned u32x4 __attribute__((ext_vector_type(4)));
    const int tid = opaque_tid(); const int wid = __builtin_amdgcn_readfirstlane(tid >> 6), lane = tid & 63, r32 = lane & 31, hi = lane >> 5;
    LAS unsigned char* vl = lds + wid * 12288; LAS unsigned char* sl = vl + 8192;
    const bf16_t* Z = (const bf16_t*)(P.ws + WS_BIG + BIG_Z); const float* LA = (const float*)(P.ws + WS_BIG + BIG_LA); const bf16_t* SP = (const bf16_t*)(P.ws + WS_SPREV);
    bf16_t* YM = (bf16_t*)(P.ws + WS_YMIX); const float* gon = P.gla_on + layer * 64;
    const int vfo = ((lane >> 4) & 1) * 32 + (lane & 3) * 8 + (4 * hi + ((lane & 15) >> 2)) * 64;
    const int sfo = ((lane >> 4) & 1) * 32 + (lane & 3) * 8 + ((lane & 15) >> 2) * 64;
    for (int u = blockIdx.x * NWV + wid; u < 2048; u += grid_size() * NWV) {
        const int bh = u >> 6, n = u & 63, b = bh >> 2, h = bh & 3;
        const size_t t0 = (size_t)b * SEQ + n * 64;
#pragma unroll
        for (int p = 0; p < 8; ++p) {
            const int row = 8 * p + (lane >> 3), dv = 8 * (lane & 7);
            const u32x4 x = *(const u32x4*)(Z + (t0 + row) * ZW + ZC_GV + h * 64 + dv);
            *(LAS u32x4*)(vl + (dv >> 5) * 4096 + (row >> 3) * 512 + (row & 7) * 64 + (dv & 31) * 2) = x;
        }
#pragma unroll
        for (int p = 0; p < 4; ++p) {
            const int row = 8 * p + (lane >> 3), dv = 8 * (lane & 7);
            const u32x4 x = *(const u32x4*)(SP + ((size_t)u * 32 + row) * 64 + dv);
            *(LAS u32x4*)(sl + (dv >> 5) * 2048 + (row >> 3) * 512 + (row & 7) * 64 + (dv & 31) * 2) = x;
        }
        bf16x8 qfr[2][2], kfr[2][2];
#pragma unroll
        for (int blk = 0; blk < 2; ++blk)
#pragma unroll
            for (int ks = 0; ks < 2; ++ks) {
                const size_t t = t0 + 32 * blk + r32; const int k0 = 16 * ks + 8 * hi;
                const uint4 qraw = *(const uint4*)(Z + t * ZW + ZC_GQ + h * 32 + k0), kraw = *(const uint4*)(Z + t * ZW + ZC_GK + h * 32 + k0);
                const f32x4 b0 = *(const f32x4*)(LA + t * 128 + h * 32 + k0), b1 = *(const f32x4*)(LA + t * 128 + h * 32 + k0 + 4);
                const unsigned qw[4] = {qraw.x, qraw.y, qraw.z, qraw.w}, kw[4] = {kraw.x, kraw.y, kraw.z, kraw.w};
                const float bcv[8] = {b0[0], b0[1], b0[2], b0[3], b1[0], b1[1], b1[2], b1[3]};
                u32x4 qo, ko;
#pragma unroll
                for (int w = 0; w < 4; ++w) {
                    const float e0 = __expf(bcv[2 * w]), e1 = __expf(bcv[2 * w + 1]);
                    const float q0 = bf2f(qw[w] & 0xffff) * 0.17677669529663687f * e0, q1 = bf2f(qw[w] >> 16) * 0.17677669529663687f * e1;
                    const float k0f = bf2f(kw[w] & 0xffff) * __expf(-bcv[2 * w]), k1f = bf2f(kw[w] >> 16) * __expf(-bcv[2 * w + 1]);
                    qo[w] = cvtpk(q0, q1); ko[w] = cvtpk(k0f, k1f);
                }
                qfr[blk][ks] = __builtin_bit_cast(bf16x8, qo); kfr[blk][ks] = __builtin_bit_cast(bf16x8, ko);
            }
        f32x16 z16;
#pragma unroll
        for (int r = 0; r < 16; ++r) z16[r] = 0.f;
        f32x16 s00 = __builtin_amdgcn_mfma_f32_32x32x16_bf16(kfr[0][0], qfr[0][0], z16, 0, 0, 0); s00 = __builtin_amdgcn_mfma_f32_32x32x16_bf16(kfr[0][1], qfr[0][1], s00, 0, 0, 0);
        f32x16 s01 = __builtin_amdgcn_mfma_f32_32x32x16_bf16(kfr[0][0], qfr[1][0], z16, 0, 0, 0); s01 = __builtin_amdgcn_mfma_f32_32x32x16_bf16(kfr[0][1], qfr[1][1], s01, 0, 0, 0);
        f32x16 s11 = __builtin_amdgcn_mfma_f32_32x32x16_bf16(kfr[1][0], qfr[1][0], z16, 0, 0, 0); s11 = __builtin_amdgcn_mfma_f32_32x32x16_bf16(kfr[1][1], qfr[1][1], s11, 0, 0, 0);
#pragma unroll
        for (int r = 0; r < 16; ++r) { const int jl = (r & 3) + 8 * (r >> 2) + 4 * hi; if (jl > r32) { s00[r] = 0.f; s11[r] = 0.f; } }
        bf16x8 p00[2], p01[2], p11[2];
#pragma unroll
        for (int sp = 0; sp < 2; ++sp) {
            u32x4 a, c, d;
#pragma unroll
            for (int w = 0; w < 4; ++w) { a[w] = cvtpk(s00[8 * sp + 2 * w], s00[8 * sp + 2 * w + 1]); c[w] = cvtpk(s01[8 * sp + 2 * w], s01[8 * sp + 2 * w + 1]); d[w] = cvtpk(s11[8 * sp + 2 * w], s11[8 * sp + 2 * w + 1]); }
            p00[sp] = __builtin_bit_cast(bf16x8, a); p01[sp] = __builtin_bit_cast(bf16x8, c); p11[sp] = __builtin_bit_cast(bf16x8, d);
        }
        asm volatile("s_waitcnt lgkmcnt(0)" ::: "memory");
        f32x16 o[2][2];
#pragma unroll
        for (int vb = 0; vb < 2; ++vb) {
            o[vb][0] = z16; o[vb][1] = z16;
#pragma unroll
            for (int k2 = 0; k2 < 4; ++k2) {
                const s16x4 a0 = vtr(vl + vfo + vb * 4096 + k2 * 1024), a1 = vtr(vl + vfo + vb * 4096 + k2 * 1024 + 512);
                const bf16x8 vt = {a0[0], a0[1], a0[2], a0[3], a1[0], a1[1], a1[2], a1[3]};
                if (k2 < 2) { o[vb][0] = __builtin_amdgcn_mfma_f32_32x32x16_bf16(vt, p00[k2], o[vb][0], 0, 0, 0); o[vb][1] = __builtin_amdgcn_mfma_f32_32x32x16_bf16(vt, p01[k2], o[vb][1], 0, 0, 0); }
                else o[vb][1] = __builtin_amdgcn_mfma_f32_32x32x16_bf16(vt, p11[k2 - 2], o[vb][1], 0, 0, 0);
            }
#pragma unroll
            for (int ks = 0; ks < 2; ++ks) {
                const s16x4 a0 = vtr(sl + sfo + vb * 2048 + (2 * ks + hi) * 512), a1 = vtr(sl + sfo + vb * 2048 + (2 * ks + hi) * 512 + 256);
                const bf16x8 st = {a0[0], a0[1], a0[2], a0[3], a1[0], a1[1], a1[2], a1[3]};
                o[vb][0] = __builtin_amdgcn_mfma_f32_32x32x16_bf16(st, qfr[0][ks], o[vb][0], 0, 0, 0);
                o[vb][1] = __builtin_amdgcn_mfma_f32_32x32x16_bf16(st, qfr[1][ks], o[vb][1], 0, 0, 0);
            }
        }
#pragma unroll
        for (int ib = 0; ib < 2; ++ib) {
            const size_t t = t0 + 32 * ib + r32;
            float ss = 0.f;
#pragma unroll
            for (int r = 0; r < 16; ++r) ss += o[0][ib][r] * o[0][ib][r] + o[1][ib][r] * o[1][ib][r];
            ss = at::xhalf_sum(ss);
            const float rstd = rsqrtf(ss * (1.0f / 64.0f) + EPS);
#pragma unroll
            for (int vb = 0; vb < 2; ++vb)
#pragma unroll
                for (int g = 0; g < 4; ++g) {
                    const int v0 = 32 * vb + 8 * g + 4 * hi;
                    const uint2 rr = *(const uint2*)(Z + t * ZW + ZC_GR + h * 64 + v0); const f32x4 gn = *(const f32x4*)(gon + v0);
                    const float r0 = bf2f(rr.x & 0xffff), r1 = bf2f(rr.x >> 16), r2 = bf2f(rr.y & 0xffff), r3 = bf2f(rr.y >> 16);
                    const float y0 = o[vb][ib][4 * g] * rstd * gn[0] * r0 * sigmoidf_(r0), y1 = o[vb][ib][4 * g + 1] * rstd * gn[1] * r1 * sigmoidf_(r1);
                    const float y2 = o[vb][ib][4 * g + 2] * rstd * gn[2] * r2 * sigmoidf_(r2), y3 = o[vb][ib][4 * g + 3] * rstd * gn[3] * r3 * sigmoidf_(r3);
                    *(uint2*)(YM + t * 1024 + h * 64 + v0) = make_uint2(cvtpk(y0, y1), cvtpk(y2, y3));
                }
        }
        asm volatile("s_waitcnt lgkmcnt(0)" ::: "memory");
    }
}


template <int L> __device__ __forceinline__ void layer_body(const Params& P, const XcdBarrier& bar, unsigned char* lds) {
    constexpr int l = L; char* ws = P.ws; LAS unsigned char* ldsl = (LAS unsigned char*)lds;
    const bf16_t* HB = (const bf16_t*)(ws + WS_HB); const float* RS = (const float*)(ws + WS_RSTD);
    bf16_t* Z = (bf16_t*)(ws + WS_BIG + BIG_Z);
    {
        const char* wsm = ws + WS_WSM + (size_t)l * WSM_STRIDE;
        { EpiBf16_8 e{(bf16_t*)(ws + WS_E), 1024}; ph_gemm_fast<256, 256, true>(ldsl, (const bf16_t*)(ws + WS_PB) + (size_t)l * T * 256, (const bf16_t*)(wsm + WSM_WPLE), 1024, e); }
        { EpiZ8 e{Z, RS}; ph_gemm_fast<1024, 1024, true>(ldsl, HB, (const bf16_t*)(wsm + WSM_WIN), ZW, e); }
        xcd_barrier(bar);
        ph_prepB(P, l, lds);
        xcd_barrier(bar);
        { EpiBf16_8 e{(bf16_t*)(ws + WS_BIG + BIG_Q), 768}; ph_gemm_fast<256, ZW, true>(ldsl, Z + ZC_CQ, (const bf16_t*)(wsm + WSM_WUQ), 768, e); }
        { EpiBf16_8 e{(bf16_t*)(ws + WS_BIG + BIG_KV), 1024}; ph_gemm_fast<128, ZW, true>(ldsl, Z + ZC_CKV, (const bf16_t*)(wsm + WSM_WUKV), 1024, e); }
        __syncthreads();
        ph_gla_x(P, ldsl);
        xcd_barrier(bar);
        ph_prepD(P, l);
        ph_gla_scan(P);
        xcd_barrier(bar);
        if ((blockIdx.x >> 3) & 1) { ph_tconv_exp<(L == 0 ? MOE_FP8_L0 : MOE_FP8_L1)>(P, l, ldsl); }
        ph_attn_fast(P, ldsl);
        ph_gla_y(P, l, ldsl);
        if (!((blockIdx.x >> 3) & 1)) { __syncthreads(); ph_tconv_exp<(L == 0 ? MOE_FP8_L0 : MOE_FP8_L1)>(P, l, ldsl); }
        xcd_barrier(bar);
        { EpiResid8 e{l == 0 ? P.x : nullptr, (bf16_t*)(ws + WS_HB)}; ph_gemm_fast<1024, 1024, true>(ldsl, (const bf16_t*)(ws + WS_YMIX), (const bf16_t*)(wsm + WSM_WOUT), 1024, e); }
        xcd_barrier(bar);
        ph_router<(L == 0 ? MOE_FP8_L0 : MOE_FP8_L1)>(P, l, ldsl);
        xcd_barrier(bar);
        ph_moe_fast<true, (L == 0 ? MOE_FP8_L0 : MOE_FP8_L1)>(P, l, ldsl);
        xcd_barrier(bar);
        ph_moe_fast<false, (L == 0 ? MOE_FP8_L0 : MOE_FP8_L1)>(P, l, ldsl);
        xcd_barrier(bar);
        ph_combine<(L == 0 ? MOE_FP8_L0 : MOE_FP8_L1)>(P);
        xcd_barrier(bar);
        { EpiPle8 e{(const bf16_t*)(ws + WS_E), RS + 2 * T, (bf16_t*)(ws + WS_YMIX)}; ph_gemm_fast<1024, 1024, true>(ldsl, HB, (const bf16_t*)(wsm + WSM_WPG), 1024, e); }
        xcd_barrier(bar);
        ph_final(P, l);
        xcd_barrier(bar);
    }
}

__global__ void __launch_bounds__(NTHR, 2) mega_fwd(Params P) {
    extern __shared__ __attribute__((aligned(16))) unsigned char lds[];
    char* ws = P.ws;
    if (threadIdx.x == 0) *(uint4*)(lds + LDS_BAR_OFF) = make_uint4(0u, 0u, (unsigned)P.grid, 0u);
    if ((threadIdx.x & 63) == 0) *(volatile LAS int*)((LAS unsigned char*)lds + LDS_WID_OFF + hw_wave_key() * 4) = (int)(threadIdx.x >> 6);
    __syncthreads();
    const XcdBarrier bar = xcd_barrier_post((unsigned*)(ws + WS_CTL), (volatile LAS unsigned*)(lds + LDS_BAR_OFF));
    const bf16_t* HB = (const bf16_t*)(ws + WS_HB); const float* RS = (const float*)(ws + WS_RSTD);
    bf16_t* Z = (bf16_t*)(ws + WS_BIG + BIG_Z);
    ph_tconv_small(P, lds);
    ph_conv_bf16(P.p, (bf16_t*)(ws + WS_PB), (long)2 * T * 256 / 8);
    ph_prep_router(P);
    ph_init_h(P);
    ph_rope_table(P);
    xcd_barrier(bar);
    layer_body<0>(P, bar, lds);
    layer_body<1>(P, bar, lds);
}

extern "C" void kernel_launch(void* const* d_in, const int* in_sizes, int n_in, void* d_out, int out_size, void* d_ws, size_t ws_size, hipStream_t stream) {
    if (n_in != 30 || ws_size < WS_END) { fprintf(stderr, "kernel_launch: need 30 inputs and %zu bytes of workspace (got %d, %zu)\n", (size_t)WS_END, n_in, ws_size); return; }
    static int grid = 0;
    if (!grid) {
        int dev = 0, cus = 0, per_cu = 0;
        if (hipGetDevice(&dev) != hipSuccess || hipDeviceGetAttribute(&cus, hipDeviceAttributeMultiprocessorCount, dev) != hipSuccess) { fprintf(stderr, "kernel_launch: device query failed\n"); return; }
        if (hipFuncSetAttribute((const void*)mega_fwd, hipFuncAttributeMaxDynamicSharedMemorySize, LDS_BYTES) != hipSuccess) { fprintf(stderr, "kernel_launch: hipFuncSetAttribute failed\n"); return; }
        if (hipOccupancyMaxActiveBlocksPerMultiprocessor(&per_cu, (const void*)mega_fwd, NTHR, LDS_BYTES) != hipSuccess || per_cu < 1) { fprintf(stderr, "kernel_launch: occupancy query says %d\n", per_cu); return; }
        grid = cus;
    }
    Params P{};
    P.x = (const float*)d_in[0]; P.p = (const float*)d_in[1]; P.pos = (const int*)d_in[2];
    P.mix_norm = (const float*)d_in[3]; P.w_in = (const float*)d_in[4]; P.gla_wg = (const float*)d_in[5]; P.gla_bg = (const float*)d_in[6]; P.gla_on = (const float*)d_in[7];
    P.q_norm = (const float*)d_in[8]; P.w_uq = (const float*)d_in[9]; P.kv_norm = (const float*)d_in[10]; P.w_ukv = (const float*)d_in[11]; P.qkq = (const float*)d_in[12]; P.qkk = (const float*)d_in[13];
    P.pool_w = (const float*)d_in[14]; P.pool_s = (const float*)d_in[15]; P.w_out = (const float*)d_in[16]; P.ffn_norm = (const float*)d_in[17]; P.router_w = (const float*)d_in[18]; P.router_b = (const float*)d_in[19];
    P.moe_wg = (const float*)d_in[20]; P.moe_bg = (const float*)d_in[21]; P.moe_wu = (const float*)d_in[22]; P.moe_bu = (const float*)d_in[23]; P.moe_wd = (const float*)d_in[24]; P.moe_bd = (const float*)d_in[25];
    P.ple_wp = (const float*)d_in[26]; P.ple_gn = (const float*)d_in[27]; P.ple_wg = (const float*)d_in[28]; P.ple_pn = (const float*)d_in[29];
    P.out = (float*)d_out; P.ws = (char*)d_ws; P.grid = grid; P.pad_ = 0;
    (void)hipMemsetAsync((char*)d_ws + WS_CTL, 0, 65536, stream);
    hipLaunchKernelGGL(mega_fwd, dim3(grid), dim3(NTHR), LDS_BYTES, stream, P);
}
```

```cpp
#include <hip/hip_runtime.h>
#include <cstdio>
#include <cstdint>

typedef unsigned short bf16_t;
typedef short bf16x8 __attribute__((ext_vector_type(8)));
typedef float f32x4 __attribute__((ext_vector_type(4)));
typedef unsigned u32x4_t __attribute__((ext_vector_type(4)));

constexpr int T = 32768, DM = 1024, SEQ = 4096, NBATCH = 8, DEPTH = 2;
constexpr int ZW = 1536;
constexpr int ZC_CQ = 0, ZC_GV = 256, ZC_GR = 512, ZC_UP = 768, ZC_GQ = 1024, ZC_GK = 1152, ZC_CKV = 1280, ZC_KR = 1408, ZC_GLOW = 1440;
constexpr int NE = 32, TOPK = 4, DFF = 1024;
constexpr int HROWS = 139264;
constexpr float EPS = 1e-6f;

__host__ __device__ inline int zsrc(int n) {
    if (n < 256) return 784 + n;
    if (n < 512) return 256 + (n - 256);
    if (n < 768) return 528 + (n - 512);
    if (n < 1024) return 1200 + (n - 768);
    if (n < 1152) return n - 1024;
    if (n < 1280) return 128 + (n - 1152);
    if (n < 1408) return 1040 + (n - 1280);
    if (n < 1440) return 1168 + (n - 1408);
    if (n < 1456) return 512 + (n - 1440);
    return -1;
}

constexpr size_t MiB = 1024 * 1024;
constexpr size_t WS_CTL = 0;
constexpr size_t WS_HB = 1 * MiB;
constexpr size_t WS_RSTD = WS_HB + 64 * MiB;
constexpr size_t WS_WSM = WS_RSTD + 1 * MiB;
constexpr size_t WSM_WIN = 0, WSM_WUQ = 3 * MiB, WSM_WUKV = WSM_WUQ + 384 * 1024, WSM_WOUT = WSM_WUKV + 256 * 1024, WSM_WPG = WSM_WOUT + 2 * MiB,
                 WSM_WPLE = WSM_WPG + 2 * MiB, WSM_WR = WSM_WPLE + 512 * 1024, WSM_WPT = WSM_WR + 128 * 1024, WSM_STRIDE = WSM_WR + 128 * 1024 + 128 * 1024;
constexpr size_t WS_PB = WS_WSM + 2 * WSM_STRIDE;
constexpr size_t WS_W1 = WS_PB + 32 * MiB;
constexpr size_t WS_W2 = WS_W1 + 128 * MiB;
constexpr size_t WS_E = WS_W2 + 64 * MiB;
constexpr size_t WS_YMIX = WS_E + 64 * MiB;
constexpr size_t WS_Y = WS_YMIX + 64 * MiB;
constexpr size_t WS_UPD = WS_Y + 256 * MiB;
constexpr size_t WS_DEC = WS_UPD + 16 * MiB;
constexpr size_t WS_SPREV = WS_DEC + 1 * MiB;
constexpr size_t WS_TOPG = WS_SPREV + 8 * MiB;
constexpr size_t WS_LIST = WS_TOPG + 1 * MiB;
constexpr size_t WS_BIG = WS_LIST + 4 * MiB;
constexpr size_t BIG_Z = 0, BIG_Q = 96 * MiB, BIG_KV = BIG_Q + 48 * MiB, BIG_K = BIG_KV + 64 * MiB, BIG_LA = BIG_K + 48 * MiB;
constexpr size_t WS_ROPE = WS_BIG + 272 * MiB;
constexpr size_t WS_LRS = WS_ROPE + 4 * MiB;
constexpr size_t WS_LGT = WS_LRS + 4 * MiB;
constexpr size_t WS_END = WS_LGT + 4 * MiB;
constexpr int CTL_CNT = 4096;

constexpr bool MOE_FP8_L0 = true, MOE_FP8_L1 = true;
__device__ __forceinline__ float bf2f(bf16_t v) { return __uint_as_float(((unsigned)v) << 16); }
__device__ __forceinline__ bf16_t f2bf(float f) { unsigned u = __float_as_uint(f); u += 0x7FFFu + ((u >> 16) & 1u); return (bf16_t)(u >> 16); }
typedef float f32x2 __attribute__((ext_vector_type(2))); typedef __bf16 bf16x2h __attribute__((ext_vector_type(2)));
__device__ __forceinline__ unsigned pack2(float lo, float hi) { return (unsigned)f2bf(lo) | ((unsigned)f2bf(hi) << 16); }
__device__ __forceinline__ unsigned pack2h(float lo, float hi) { const f32x2 v = {lo, hi}; return __builtin_bit_cast(unsigned, __builtin_convertvector(v, bf16x2h)); }
__device__ __forceinline__ unsigned pack2v(f32x2 v) { return __builtin_bit_cast(unsigned, __builtin_convertvector(v, bf16x2h)); }
template <int CTRL> __device__ __forceinline__ float dppx(float v) { return __int_as_float(__builtin_amdgcn_update_dpp(0, __float_as_int(v), CTRL, 0xf, 0xf, true)); }
__device__ __forceinline__ unsigned pack4_fp8(float x0, float x1, float x2, float x3) { int w = 0; w = __builtin_amdgcn_cvt_pk_fp8_f32(x0, x1, w, false); w = __builtin_amdgcn_cvt_pk_fp8_f32(x2, x3, w, true); return (unsigned)w; }
__device__ __forceinline__ float wave_sum(float v) {
    v += dppx<0xB1>(v); v += dppx<0x4E>(v); v += dppx<0x141>(v); v += dppx<0x140>(v);
    { auto rr = __builtin_amdgcn_permlane16_swap(__float_as_uint(v), __float_as_uint(v), false, false); v = __uint_as_float(rr[0]) + __uint_as_float(rr[1]); }
    { auto rr = __builtin_amdgcn_permlane32_swap(__float_as_uint(v), __float_as_uint(v), false, false); v = __uint_as_float(rr[0]) + __uint_as_float(rr[1]); }
    return v;
}
__device__ __forceinline__ float wave_max(float v) {
    v = fmaxf(v, dppx<0xB1>(v)); v = fmaxf(v, dppx<0x4E>(v)); v = fmaxf(v, dppx<0x141>(v)); v = fmaxf(v, dppx<0x140>(v));
    { auto rr = __builtin_amdgcn_permlane16_swap(__float_as_uint(v), __float_as_uint(v), false, false); v = fmaxf(__uint_as_float(rr[0]), __uint_as_float(rr[1])); }
    { auto rr = __builtin_amdgcn_permlane32_swap(__float_as_uint(v), __float_as_uint(v), false, false); v = fmaxf(__uint_as_float(rr[0]), __uint_as_float(rr[1])); }
    return v;
}
namespace at {
typedef float f32x16 __attribute__((ext_vector_type(16)));
__device__ __forceinline__ float xhalf_max(float v) { auto rr = __builtin_amdgcn_permlane32_swap(__float_as_uint(v), __float_as_uint(v), false, false); return fmaxf(__uint_as_float(rr[0]), __uint_as_float(rr[1])); }
__device__ __forceinline__ float xhalf_sum(float v) { auto rr = __builtin_amdgcn_permlane32_swap(__float_as_uint(v), __float_as_uint(v), false, false); return __uint_as_float(rr[0]) + __uint_as_float(rr[1]); }
}
__device__ __forceinline__ float sigmoidf_(float x) { return __builtin_amdgcn_rcpf(1.0f + __builtin_amdgcn_exp2f(-1.4426950408889634f * x)); }


#define XB_TMO      128
#define XB_XCNT(j)  (256  + 64 * (j))
#define XB_XSUB(j)  (1280 + 64 * (j))
#define XB_XGEN(j)  (2304 + 64 * (j))
#define XB_TOP      3328
#define XB_TOPGEN   3392
#define XCD_BAR_WORDS 3456
#define XB_SPIN_CAP (1u << 18)
#define LAS __attribute__((address_space(3)))

constexpr int LDS_WID_OFF = 147456 - 16 - 256, LDS_GRID_OFF = 147456 - 16 + 8;
__device__ __forceinline__ int grid_size() { extern __shared__ __attribute__((aligned(16))) unsigned char lds_dyn_[]; return __builtin_amdgcn_readfirstlane(*(const volatile LAS int*)((LAS unsigned char*)lds_dyn_ + LDS_GRID_OFF)); }
__device__ __forceinline__ unsigned hw_wave_key() { return (unsigned)__builtin_amdgcn_s_getreg((5 << 11) | 4) & 63u; }
__device__ __forceinline__ int opaque_tid() {
    extern __shared__ __attribute__((aligned(16))) unsigned char lds_dyn_[];
    const int wv = __builtin_amdgcn_readfirstlane(*(const volatile LAS int*)((LAS unsigned char*)lds_dyn_ + LDS_WID_OFF + hw_wave_key() * 4));
    int ln; asm volatile("v_mbcnt_lo_u32_b32 %0, -1, 0\n\tv_mbcnt_hi_u32_b32 %0, -1, %0" : "=v"(ln));
    int t = wv * 64 + ln;
    asm volatile("" : "+v"(t)); return t;
}

__device__ __forceinline__ unsigned xb_ld(unsigned* p)              { return __hip_atomic_load(p, __ATOMIC_RELAXED, __HIP_MEMORY_SCOPE_AGENT); }
__device__ __forceinline__ unsigned xb_add(unsigned* p, unsigned v) { return __hip_atomic_fetch_add(p, v, __ATOMIC_RELAXED, __HIP_MEMORY_SCOPE_AGENT); }
__device__ __forceinline__ unsigned xb_xcc_id() { return (unsigned)__builtin_amdgcn_s_getreg((3 << 11) | 20) & 0xFu; }
#define XB_SPIN(cond, bar) do { unsigned _sp = 0; while (cond) { __builtin_amdgcn_s_sleep(1); \
    if ((++_sp & 255u) == 0u) { if (xb_ld(&(bar)[XB_TMO])) break; if (_sp > XB_SPIN_CAP) { atomicAdd(&(bar)[XB_TMO], 1u); break; } } } } while (0)

struct XcdBarrier {
    unsigned* bar; unsigned x;
    volatile LAS unsigned* st;
};

__device__ __forceinline__ XcdBarrier xcd_barrier_post(unsigned* bar, volatile LAS unsigned* st) {
    XcdBarrier b; b.bar = bar; b.x = xb_xcc_id(); b.st = st;
    if (threadIdx.x == 0) (void)xb_add(&bar[XB_XCNT(b.x)], 1u);
    return b;
}
__device__ __forceinline__ void xcd_barrier_complete(unsigned* bar, unsigned x, unsigned& nloc, unsigned& nx) {
    const unsigned G = (unsigned)grid_size();
    unsigned sum, cnt, mine, sp = 0u;
    for (;;) {
        sum = 0u; cnt = 0u; mine = 0u;
#pragma unroll
        for (unsigned j = 0; j < 16; ++j) { const unsigned c = xb_ld(&bar[XB_XCNT(j)]); sum += c; cnt += (c > 0u) ? 1u : 0u; mine = (j == x) ? c : mine; }
        if (sum == G) break;
        __builtin_amdgcn_s_sleep(1);
        if ((++sp & 255u) == 0u) { if (xb_ld(&bar[XB_TMO])) break; if (sp > XB_SPIN_CAP) { atomicAdd(&bar[XB_TMO], 1u); break; } }
    }
    nloc = mine > 0u ? mine : 1u; nx = cnt > 0u ? cnt : 1u;
}

__device__ __forceinline__ void xcd_barrier(const XcdBarrier& b) {
    asm volatile("s_waitcnt vmcnt(0)" ::: "memory");
    __syncthreads();
    if (opaque_tid() == 0) {
        unsigned* bar = b.bar;
        __builtin_amdgcn_s_waitcnt(0);
        unsigned nloc = b.st[0], nx = b.st[1];
        if (nloc == 0u) { xcd_barrier_complete(bar, b.x, nloc, nx); b.st[0] = nloc; b.st[1] = nx; }
        const unsigned old = xb_add(&bar[XB_XSUB(b.x)], 1u);
        const unsigned gen = old / nloc;
        if (old + 1u == (gen + 1u) * nloc) {
            __builtin_amdgcn_fence(__ATOMIC_RELEASE, "agent");
            asm volatile("s_waitcnt vmcnt(0)" ::: "memory");
            const unsigned og = xb_add(&bar[XB_TOP], 1u);
            const unsigned tg = og / nx;
            if (og + 1u == (tg + 1u) * nx) xb_add(&bar[XB_TOPGEN], 1u);
            else XB_SPIN(xb_ld(&bar[XB_TOPGEN]) == tg, bar);
            __builtin_amdgcn_fence(__ATOMIC_ACQUIRE, "agent");
            xb_add(&bar[XB_XGEN(b.x)], 1u);
            asm volatile("s_waitcnt vmcnt(0)" ::: "memory");
        } else {
            XB_SPIN(xb_ld(&bar[XB_XGEN(b.x)]) == gen, bar);
            __builtin_amdgcn_fence(__ATOMIC_ACQUIRE, "agent");
            asm volatile("s_waitcnt vmcnt(0)" ::: "memory");
        }
    }
    __syncthreads();
}

struct Params {
    const float *x, *p; const int* pos;
    const float *mix_norm, *w_in, *gla_wg, *gla_bg, *gla_on, *q_norm, *w_uq, *kv_norm, *w_ukv, *qkq, *qkk, *pool_w, *pool_s, *w_out, *ffn_norm, *router_w, *router_b,
        *moe_wg, *moe_bg, *moe_wu, *moe_bu, *moe_wd, *moe_bd, *ple_wp, *ple_gn, *ple_wg, *ple_pn;
    float* out; char* ws; int grid; int pad_;
};


constexpr int NTHR = 512, NWV = 8;
constexpr int LDS_BYTES = 147456;
constexpr int LDS_BAR_OFF = LDS_BYTES - 16;


__device__ __forceinline__ void ph_tconv_small(const Params& P, unsigned char* lds) {
    const int tz = opaque_tid(); const int tid = tz & 255, half = tz >> 8, tx = tid & 63, ty = tid >> 6;
    float (*tile)[65] = (float (*)[65])(lds + half * 16640);
    constexpr int U_IN = 24 * 16, U_UQ = 12 * 4, U_KV = 16 * 2, U_OUT = 16 * 16, U_PG = 16 * 16, U_PP = 16 * 4, U_L = U_IN + U_UQ + U_KV + U_OUT + U_PG + U_PP;
    static_assert((2 * U_L) % 2 == 0, "pairs of units");
    for (int u0 = blockIdx.x * 2; u0 < 2 * U_L; u0 += grid_size() * 2) {
        const int u = u0 + half; const int l = u / U_L; int r = u % U_L;
        char* wsm = P.ws + WS_WSM + (size_t)l * WSM_STRIDE;
        const float* src; const float* gain; bf16_t* dst; int N, K, ld, mode;
        if (r < U_IN) { src = P.w_in + (size_t)l * 1024 * 1456; gain = P.mix_norm + l * 1024; dst = (bf16_t*)(wsm + WSM_WIN); N = ZW; K = 1024; ld = 1456; mode = 1; }
        else if ((r -= U_IN) < U_UQ) { src = P.w_uq + (size_t)l * 256 * 768; gain = P.q_norm + l * 256; dst = (bf16_t*)(wsm + WSM_WUQ); N = 768; K = 256; ld = 768; mode = 0; }
        else if ((r -= U_UQ) < U_KV) { src = P.w_ukv + (size_t)l * 128 * 1024; gain = P.kv_norm + l * 128; dst = (bf16_t*)(wsm + WSM_WUKV); N = 1024; K = 128; ld = 1024; mode = 0; }
        else if ((r -= U_KV) < U_OUT) { src = P.w_out + (size_t)l * 1024 * 1024; gain = nullptr; dst = (bf16_t*)(wsm + WSM_WOUT); N = 1024; K = 1024; ld = 1024; mode = 0; }
        else if ((r -= U_OUT) < U_PG) { src = P.ple_wg + (size_t)l * 1024 * 1024; gain = P.ple_gn + l * 1024; dst = (bf16_t*)(wsm + WSM_WPG); N = 1024; K = 1024; ld = 1024; mode = 0; }
        else { r -= U_PG; src = P.ple_wp + (size_t)l * 256 * 1024; gain = nullptr; dst = (bf16_t*)(wsm + WSM_WPLE); N = 1024; K = 256; ld = 1024; mode = 0; }
        const int nx = N / 64; const int bx = r % nx, by = r / nx;
        const int n0 = bx * 64, k0 = by * 64, n = n0 + tx;
        const int col = (mode == 1) ? zsrc(n) : n;
#pragma unroll
        for (int i = 0; i < 16; ++i) {
            const int k = k0 + ty + 4 * i; float v = 0.f;
            if (col >= 0) v = src[(long)k * ld + col];
            if (gain) v *= gain[k];
            tile[ty + 4 * i][tx] = v;
        }
        __syncthreads();
        const int nl = tid >> 2, ks = (tid & 3) * 16;
        unsigned w0 = pack2(tile[ks + 0][nl], tile[ks + 1][nl]), w1 = pack2(tile[ks + 2][nl], tile[ks + 3][nl]), w2 = pack2(tile[ks + 4][nl], tile[ks + 5][nl]), w3 = pack2(tile[ks + 6][nl], tile[ks + 7][nl]);
        unsigned w4 = pack2(tile[ks + 8][nl], tile[ks + 9][nl]), w5 = pack2(tile[ks + 10][nl], tile[ks + 11][nl]), w6 = pack2(tile[ks + 12][nl], tile[ks + 13][nl]), w7 = pack2(tile[ks + 14][nl], tile[ks + 15][nl]);
        uint4* o = (uint4*)(dst + (long)(n0 + nl) * K + k0 + ks);
        o[0] = make_uint4(w0, w1, w2, w3); o[1] = make_uint4(w4, w5, w6, w7);
        __syncthreads();
    }
}

template <bool FP8> __device__ __forceinline__ void ph_tconv_exp(const Params& P, int layer, LAS unsigned char* lds) {
    const int tid = opaque_tid();
    const int kq = tid >> 6, c4 = tid & 63;
    constexpr int PITCH = FP8 ? 68 : 136;
    LAS unsigned char* tile = lds;
    const float* gain = P.ffn_norm + layer * 1024;
    const int nunits = 3 * 32 * 16 * 4;
    for (int u = blockIdx.x; u < nunits; u += grid_size()) {
        const int nt = u & 3, kt = (u >> 2) & 15, e = (u >> 6) & 31, mat = u >> 11;
        const float* src = (mat == 0 ? P.moe_wg : mat == 1 ? P.moe_wu : P.moe_wd) + ((size_t)layer * 32 + e) * 1024 * 1024 + (size_t)(kt * 64) * 1024 + nt * 256 + c4 * 4;
        f32x4 v[2][4];
#pragma unroll
        for (int g = 0; g < 2; ++g)
#pragma unroll
            for (int r = 0; r < 4; ++r) v[g][r] = *(const f32x4*)(src + (size_t)(32 * g + 4 * kq + r) * 1024);
        const float sc = FP8 ? 64.0f : 1.0f;
#pragma unroll
        for (int g = 0; g < 2; ++g)
#pragma unroll
            for (int r = 0; r < 4; ++r) v[g][r] *= (mat < 2 ? gain[kt * 64 + 32 * g + 4 * kq + r] : 1.0f) * sc;
        __syncthreads();
#pragma unroll
        for (int g = 0; g < 2; ++g)
#pragma unroll
            for (int j = 0; j < 4; ++j) {
                if constexpr (FP8) *(LAS unsigned*)(tile + (c4 * 4 + j) * PITCH + 32 * g + 4 * kq) = pack4_fp8(v[g][0][j], v[g][1][j], v[g][2][j], v[g][3][j]);
                else { LAS unsigned* wp_ = (LAS unsigned*)(tile + (c4 * 4 + j) * PITCH + (32 * g + 4 * kq) * 2); wp_[0] = pack2(v[g][0][j], v[g][1][j]); wp_[1] = pack2(v[g][2][j], v[g][3][j]); }
            }
        __syncthreads();
        typedef unsigned u32x4 __attribute__((ext_vector_type(4)));
        unsigned char* dst = (mat < 2) ? (unsigned char*)(P.ws + WS_W1) + (size_t)e * 2048 * (FP8 ? 1024 : 2048) : (unsigned char*)(P.ws + WS_W2) + (size_t)e * 1024 * (FP8 ? 1024 : 2048);
        constexpr int CPR = FP8 ? 4 : 8;
#pragma unroll
        for (int j = 0; j < 256 * CPR / NTHR; ++j) {
            const int id = tid + NTHR * j, nl = id / CPR, ck = id % CPR, n = nt * 256 + nl;
            const int drow = (mat == 2) ? n : ((n >> 7) * 256 + (n & 127) + (mat == 1 ? 128 : 0));
            const LAS unsigned* rp = (const LAS unsigned*)(tile + nl * PITCH + ck * 16);
            const u32x4 o = {rp[0], rp[1], rp[2], rp[3]};
            *(u32x4*)(dst + (size_t)drow * (FP8 ? 1024 : 2048) + (size_t)kt * (FP8 ? 64 : 128) + ck * 16) = o;
        }
    }
    __syncthreads();
}
__device__ __forceinline__ void ph_conv_bf16(const float* src, bf16_t* dst, long n8) {
    const int tz = opaque_tid(); const int G = grid_size() * NTHR;
    for (int i0 = blockIdx.x * NTHR + tz; i0 < (int)n8; i0 += 4 * G) {
        float4 a[4], b[4];
#pragma unroll
        for (int q = 0; q < 4; ++q) { const int i = i0 + q * G; if (i < (int)n8) { a[q] = ((const float4*)src)[2 * (size_t)i]; b[q] = ((const float4*)src)[2 * (size_t)i + 1]; } }
#pragma unroll
        for (int q = 0; q < 4; ++q) { const int i = i0 + q * G; if (i < (int)n8) ((uint4*)dst)[i] = make_uint4(pack2(a[q].x, a[q].y), pack2(a[q].z, a[q].w), pack2(b[q].x, b[q].y), pack2(b[q].z, b[q].w)); }
    }
}
__device__ __forceinline__ void ph_prep_router(const Params& P) {
    const int tz = opaque_tid();
    for (int i = blockIdx.x * NTHR + tz; i < 2 * 4 * 64 * 64; i += grid_size() * NTHR) {
        const int l = i >> 14, g = (i >> 12) & 3, d = (i >> 6) & 63, c = i & 63;
        ((bf16_t*)(P.ws + WS_WSM + (size_t)l * WSM_STRIDE + WSM_WPT))[(g * 64 + d) * 64 + c] = f2bf(P.pool_w[(size_t)l * 16384 + (g * 64 + c) * 64 + d]);
    }
    for (int i = blockIdx.x * NTHR + tz; i < 2 * 32 * 1024; i += grid_size() * NTHR) {
        const int l = i >> 15, e = (i >> 10) & 31, k = i & 1023;
        bf16_t* Wr = (bf16_t*)(P.ws + WS_WSM + (size_t)l * WSM_STRIDE + WSM_WR);
        const float w = P.router_w[((size_t)l * 1024 + k) * 32 + e] * P.ffn_norm[l * 1024 + k];
        const bf16_t whi = f2bf(w); Wr[e * 1024 + k] = whi; Wr[32 * 1024 + e * 1024 + k] = f2bf(w - bf2f(whi));
    }
}


__device__ __forceinline__ void ph_rope_table(const Params& P) {
    const int tz = opaque_tid();
    float* RT = (float*)(P.ws + WS_ROPE);
    for (int e = blockIdx.x * NTHR + tz; e < T * 16; e += grid_size() * NTHR) {
        const int t = e >> 4, i = e & 15;
        const float inv = exp2f(-(float)(2 * i) * (1.0f / 32.0f) * 13.287712379549449f);
        const float ang = (float)P.pos[t] * inv;
        RT[(size_t)t * 32 + i] = cosf(ang); RT[(size_t)t * 32 + 16 + i] = sinf(ang);
    }
}

__device__ __forceinline__ void ph_init_h(const Params& P) {
    const int tz = opaque_tid(); const int wid = tz >> 6, lane = tz & 63;
    bf16_t* HB = (bf16_t*)(P.ws + WS_HB); float* RS = (float*)(P.ws + WS_RSTD);
    for (int t0 = (blockIdx.x * NWV + wid) * 4; t0 < T; t0 += grid_size() * NWV * 4) {
        float4 v[4][4];
#pragma unroll
        for (int tt = 0; tt < 4; ++tt)
#pragma unroll
            for (int i = 0; i < 4; ++i) v[tt][i] = *(const float4*)(P.x + (size_t)(t0 + tt) * 1024 + i * 256 + lane * 4);
#pragma unroll
        for (int tt = 0; tt < 4; ++tt) {
            float ss = 0.f;
#pragma unroll
            for (int i = 0; i < 4; ++i) ss += v[tt][i].x * v[tt][i].x + v[tt][i].y * v[tt][i].y + v[tt][i].z * v[tt][i].z + v[tt][i].w * v[tt][i].w;
            ss = wave_sum(ss);
            if (lane == 0) RS[t0 + tt] = rsqrtf(ss * (1.0f / 1024.0f) + EPS);
#pragma unroll
            for (int i = 0; i < 4; ++i) *(uint2*)(HB + (size_t)(t0 + tt) * 1024 + i * 256 + lane * 4) = make_uint2(pack2(v[tt][i].x, v[tt][i].y), pack2(v[tt][i].z, v[tt][i].w));
        }
    }
}

__device__ __forceinline__ void ph_prepB(const Params& P, int layer, unsigned char* lds) {
    float* wg = (float*)lds;
    const int tid = opaque_tid(), wid = tid >> 6, lane = tid & 63;
    for (int i = tid; i < 16 * 128; i += NTHR) wg[i] = P.gla_wg[(size_t)layer * 2048 + i];
    __syncthreads();
    bf16_t* Z = (bf16_t*)(P.ws + WS_BIG + BIG_Z); float* LA = (float*)(P.ws + WS_BIG + BIG_LA); bf16_t* YM = (bf16_t*)(P.ws + WS_YMIX);
    const float* bg = P.gla_bg + layer * 128; const float* psc = P.pool_s + layer * 256;
    const float bg0 = bg[lane], bg1 = bg[lane + 64];
    for (int t0 = (blockIdx.x * NWV + wid) * 2; t0 < T; t0 += grid_size() * NWV * 2) {
        uint2 cq[2]; unsigned ckv[2]; float gl[2];
#pragma unroll
        for (int tt = 0; tt < 2; ++tt) { const bf16_t* zr = Z + (size_t)(t0 + tt) * ZW; cq[tt] = *(const uint2*)(zr + ZC_CQ + lane * 4); ckv[tt] = *(const unsigned*)(zr + ZC_CKV + lane * 2); gl[tt] = (lane < 16) ? bf2f(zr[ZC_GLOW + lane]) : 0.f; }
#pragma unroll
        for (int tt = 0; tt < 2; ++tt) {
            bf16_t* zr = Z + (size_t)(t0 + tt) * ZW;
            {
                const float a = bf2f(cq[tt].x & 0xffff), b = bf2f(cq[tt].x >> 16), c = bf2f(cq[tt].y & 0xffff), d = bf2f(cq[tt].y >> 16);
                const float r = rsqrtf(wave_sum(a * a + b * b + c * c + d * d) * (1.0f / 256.0f) + EPS);
                *(uint2*)(zr + ZC_CQ + lane * 4) = make_uint2(pack2(a * r, b * r), pack2(c * r, d * r));
            }
            {
                const float a = bf2f(ckv[tt] & 0xffff), b = bf2f(ckv[tt] >> 16);
                const float r = rsqrtf(wave_sum(a * a + b * b) * (1.0f / 128.0f) + EPS);
                *(unsigned*)(zr + ZC_CKV + lane * 2) = pack2(a * r, b * r);
            }
            {
                float l0 = bg0, l1 = bg1;
#pragma unroll
                for (int r = 0; r < 16; ++r) { const float g = __uint_as_float(__builtin_amdgcn_readlane(__float_as_uint(gl[tt]), r)); l0 += g * wg[r * 128 + lane]; l1 += g * wg[r * 128 + lane + 64]; }
                const float a0 = fminf(l0, 0.f) - log1pf(__expf(-fabsf(l0))), a1 = fminf(l1, 0.f) - log1pf(__expf(-fabsf(l1)));
                LA[(size_t)(t0 + tt) * 128 + lane] = a0 * (1.0f / 16.0f); LA[(size_t)(t0 + tt) * 128 + lane + 64] = a1 * (1.0f / 16.0f);
            }
        }
    }
    const bf16_t* WpT = (const bf16_t*)(P.ws + WS_WSM + (size_t)layer * WSM_STRIDE + WSM_WPT);
    const int fr = lane & 15, fq = lane >> 4;
    for (int u = blockIdx.x * NWV + wid; u < T / 16; u += grid_size() * NWV) {
        const int t = u * 16 + fr, sq = t & (SEQ - 1);
        uint2 yout[4][4];
#pragma unroll
        for (int gi = 0; gi < 4; ++gi) {
            const int w = 2 << gi; const int cnt = (sq + 1 < w) ? sq + 1 : w; const float rc = 1.0f / (float)cnt;
            bf16x8 af[2];
#pragma unroll
            for (int ks = 0; ks < 2; ++ks) {
                const bf16_t* up = Z + (size_t)t * ZW + ZC_UP + gi * 64 + ks * 32 + fq * 8;
                float acc[8], u0[8];
#pragma unroll
                for (int j = 0; j < 16; ++j) if (j < w) {
                    const int jj = (j < cnt) ? j : 0; const float msk = (j < cnt) ? 1.0f : 0.f;
                    const uint4 x = *(const uint4*)(up - (long)jj * ZW);
                    const float xv[8] = {bf2f(x.x & 0xffff), bf2f(x.x >> 16), bf2f(x.y & 0xffff), bf2f(x.y >> 16), bf2f(x.z & 0xffff), bf2f(x.z >> 16), bf2f(x.w & 0xffff), bf2f(x.w >> 16)};
#pragma unroll
                    for (int e = 0; e < 8; ++e) { if (j == 0) { u0[e] = xv[e]; acc[e] = xv[e]; } else acc[e] += msk * xv[e]; }
                }
                typedef unsigned u32x4 __attribute__((ext_vector_type(4)));
                const u32x4 pk = {pack2(acc[0] * rc - u0[0], acc[1] * rc - u0[1]), pack2(acc[2] * rc - u0[2], acc[3] * rc - u0[3]), pack2(acc[4] * rc - u0[4], acc[5] * rc - u0[5]), pack2(acc[6] * rc - u0[6], acc[7] * rc - u0[7])};
                af[ks] = __builtin_bit_cast(bf16x8, pk);
            }
#pragma unroll
            for (int nb = 0; nb < 4; ++nb) {
                f32x4 acc = {0.f, 0.f, 0.f, 0.f};
#pragma unroll
                for (int ks = 0; ks < 2; ++ks) { const bf16x8 bfr = *(const bf16x8*)(WpT + ((size_t)gi * 64 + nb * 16 + fr) * 64 + ks * 32 + fq * 8); acc = __builtin_amdgcn_mfma_f32_16x16x32_bf16(bfr, af[ks], acc, 0, 0, 0); }
                const int d0 = nb * 16 + fq * 4; const f32x4 sc = *(const f32x4*)(psc + gi * 64 + d0);
                yout[gi][nb] = make_uint2(pack2(acc[0] * sc[0], acc[1] * sc[1]), pack2(acc[2] * sc[2], acc[3] * sc[3]));
            }
        }
#pragma unroll
        for (int gi = 0; gi < 4; ++gi)
#pragma unroll
            for (int nb = 0; nb < 4; ++nb) *(uint2*)(YM + (size_t)t * 1024 + 768 + gi * 64 + nb * 16 + fq * 4) = yout[gi][nb];
    }
}

template <bool DRY = false> __device__ __forceinline__ void ph_prepD(const Params& P, int layer) {
    const int tid = opaque_tid(), wid = tid >> 6, lane = tid & 63, g = lane >> 4, li = lane & 15;
    bf16_t* Z = (bf16_t*)(P.ws + WS_BIG + BIG_Z); bf16_t* Q = (bf16_t*)(P.ws + WS_BIG + BIG_Q); const bf16_t* KV = (const bf16_t*)(P.ws + WS_BIG + BIG_KV); bf16_t* Kd = DRY ? (bf16_t*)(P.ws + WS_Y + 64 * MiB) : (bf16_t*)(P.ws + WS_BIG + BIG_K);
    bf16_t* QW = DRY ? (bf16_t*)(P.ws + WS_Y) : Q;
    const float* RT = (const float*)(P.ws + WS_ROPE);
    const bool act = li < 12, rope = li >= 8 && li < 12, x1part = li < 10;
    const int e0 = act ? 8 * li : 0;
    float gq[8], gk[8];
#pragma unroll
    for (int j = 0; j < 8; ++j) { gq[j] = P.qkq[layer * 96 + e0 + j]; gk[j] = P.qkk[layer * 96 + e0 + j]; }
    const float qscale = 0.10206207261596577f * 1.4426950408889634f;
    for (int t = blockIdx.x * NWV + wid; t < T; t += grid_size() * NWV) {
        typedef unsigned u32x4 __attribute__((ext_vector_type(4)));
        u32x4 qraw[2], kraw[2];
        const int i0 = 8 * (li & 1);
        const f32x4 c0 = *(const f32x4*)(RT + (size_t)t * 32 + i0), c1 = *(const f32x4*)(RT + (size_t)t * 32 + i0 + 4), s0 = *(const f32x4*)(RT + (size_t)t * 32 + 16 + i0), s1 = *(const f32x4*)(RT + (size_t)t * 32 + 16 + i0 + 4);
        const float cs[8] = {c0[0], c0[1], c0[2], c0[3], c1[0], c1[1], c1[2], c1[3]}, sn[8] = {s0[0], s0[1], s0[2], s0[3], s1[0], s1[1], s1[2], s1[3]};
#pragma unroll
        for (int ps = 0; ps < 2; ++ps) {
            const int h = ps * 4 + g;
            qraw[ps] = *(const u32x4*)(Q + (size_t)t * 768 + h * 96 + e0);
            kraw[ps] = (li < 8) ? *(const u32x4*)(KV + (size_t)t * 1024 + h * 128 + e0) : *(const u32x4*)(Z + (size_t)t * ZW + ZC_KR + (rope ? 8 * (li - 8) : 0));
        }
#pragma unroll
        for (int ps = 0; ps < 2; ++ps) {
            const int h = ps * 4 + g;
#pragma unroll
            for (int qk = 0; qk < 2; ++qk) {
                const u32x4 raw = qk == 0 ? qraw[ps] : kraw[ps];
                float x[8];
#pragma unroll
                for (int w = 0; w < 4; ++w) { x[2 * w] = act ? bf2f(raw[w] & 0xffff) : 0.f; x[2 * w + 1] = act ? bf2f(raw[w] >> 16) : 0.f; }
                float ss = 0.f;
#pragma unroll
                for (int j = 0; j < 8; ++j) ss += x[j] * x[j];
                ss += dppx<0xB1>(ss); ss += dppx<0x4E>(ss); ss += dppx<0x141>(ss); ss += dppx<0x140>(ss);
                const float r = rsqrtf(ss * (1.0f / 96.0f) + EPS);
                float y[8];
#pragma unroll
                for (int j = 0; j < 8; ++j) {
                    const float xn = x[j] * r * (qk == 0 ? gq[j] : gk[j]);
                    const float pr = dppx<0x4E>(xn);
                    const float rot = x1part ? (xn * cs[j] - pr * sn[j]) : (xn * cs[j] + pr * sn[j]);
                    y[j] = (rope ? rot : xn) * (qk == 0 ? qscale : 1.0f);
                }
                const u32x4 o = {pack2(y[0], y[1]), pack2(y[2], y[3]), pack2(y[4], y[5]), pack2(y[6], y[7])};
                if (act) { if (qk == 0) *(u32x4*)(QW + (size_t)t * 768 + h * 96 + e0) = o; else *(u32x4*)(Kd + ((size_t)t * 8 + h) * 96 + e0) = o; }
            }
        }
    }
}

template <bool FP8> __device__ __forceinline__ void ph_router(const Params& P, int layer, LAS unsigned char* lds) {
    using at::f32x16;
    const int tid = opaque_tid(); const int wid = __builtin_amdgcn_readfirstlane(tid >> 6), lane = tid & 63, r32 = lane & 31, hi = lane >> 5;
    const bf16_t* HB = (const bf16_t*)(P.ws + WS_HB); float* RS1 = (float*)(P.ws + WS_RSTD) + T;
    const bf16_t* WrH = (const bf16_t*)(P.ws + WS_WSM + (size_t)layer * WSM_STRIDE + WSM_WR); const bf16_t* WrL = WrH + 32 * 1024;
    const float* rb = P.router_b + layer * 32;
    unsigned* cnt = (unsigned*)(P.ws + WS_CTL) + CTL_CNT + layer * 32;
    int* LIST = (int*)(P.ws + WS_LIST);
    constexpr int MAXU = 4;
    LAS unsigned* lcnt = (LAS unsigned*)lds; LAS unsigned* lbase = lcnt + 32;
    LAS unsigned* ent = lbase + 32;
    LAS float* entg = (LAS float*)(ent + NWV * MAXU * 128);
    LAS float* entr = entg + NWV * MAXU * 128;
    if (tid < 32) lcnt[tid] = 0u;
    __syncthreads();
    int nu = 0;
    for (int u = blockIdx.x * 4 + wid; wid < 4 && u < T / 32; u += grid_size() * 4, ++nu) {
        const size_t trow = (size_t)u * 32 + r32;
        f32x16 acc;
#pragma unroll
        for (int r = 0; r < 16; ++r) acc[r] = 0.f;
        float ss = 0.f;
        const bf16_t* hp = HB + trow * 1024 + hi * 8; const bf16_t* wh = WrH + (size_t)r32 * 1024 + hi * 8; const bf16_t* wl_ = WrL + (size_t)r32 * 1024 + hi * 8;
        for (int k8 = 0; k8 < 64; k8 += 8) {
            bf16x8 hf[8], a0[8], a1[8];
#pragma unroll
            for (int q = 0; q < 8; ++q) { hf[q] = *(const bf16x8*)(hp + (k8 + q) * 16); a0[q] = *(const bf16x8*)(wh + (k8 + q) * 16); a1[q] = *(const bf16x8*)(wl_ + (k8 + q) * 16); }
#pragma unroll
            for (int q = 0; q < 8; ++q) {
                acc = __builtin_amdgcn_mfma_f32_32x32x16_bf16(a0[q], hf[q], acc, 0, 0, 0);
                acc = __builtin_amdgcn_mfma_f32_32x32x16_bf16(a1[q], hf[q], acc, 0, 0, 0);
                float hv[8];
#pragma unroll
                for (int j = 0; j < 8; ++j) { hv[j] = bf2f((bf16_t)hf[q][j]); ss += hv[j] * hv[j]; }
                if constexpr (FP8) *(uint2*)((unsigned char*)(P.ws + WS_YMIX) + trow * 1024 + (k8 + q) * 16 + hi * 8) = make_uint2(pack4_fp8(hv[0], hv[1], hv[2], hv[3]), pack4_fp8(hv[4], hv[5], hv[6], hv[7]));
            }
        }
        ss = at::xhalf_sum(ss);
        const float rstd = rsqrtf(ss * (1.0f / 1024.0f) + EPS);
        if (hi == 0) RS1[trow] = rstd;
        float lg[16];
#pragma unroll
        for (int r = 0; r < 16; ++r) lg[r] = acc[r] * rstd + rb[(r & 3) + 8 * (r >> 2) + 4 * hi];
        float cv[8]; int ci[8];
#pragma unroll
        for (int k = 0; k < 4; ++k) {
            float best = -INFINITY; int bi = 0;
#pragma unroll
            for (int r = 0; r < 16; ++r) { const bool ok = lg[r] > best; best = ok ? lg[r] : best; bi = ok ? r : bi; }
#pragma unroll
            for (int r = 0; r < 16; ++r) lg[r] = (r == bi) ? -INFINITY : lg[r];
            cv[k] = best; ci[k] = (bi & 3) + 8 * (bi >> 2) + 4 * hi;
        }
#pragma unroll
        for (int k = 0; k < 4; ++k) {
            { auto rr = __builtin_amdgcn_permlane32_swap(__float_as_uint(cv[k]), __float_as_uint(cv[k]), false, false); cv[4 + k] = __uint_as_float(hi ? rr[0] : rr[1]); }
            { auto rr = __builtin_amdgcn_permlane32_swap((unsigned)ci[k], (unsigned)ci[k], false, false); ci[4 + k] = (int)(hi ? rr[0] : rr[1]); }
        }
        float tv[4]; int ti[4];
#pragma unroll
        for (int k = 0; k < 4; ++k) {
            float best = -INFINITY; int be = 64, bj = 0;
#pragma unroll
            for (int j = 0; j < 8; ++j) { const bool ok = (cv[j] > best) || (cv[j] == best && ci[j] < be); best = ok ? cv[j] : best; be = ok ? ci[j] : be; bj = ok ? j : bj; }
#pragma unroll
            for (int j = 0; j < 8; ++j) cv[j] = (j == bj) ? -INFINITY : cv[j];
            tv[k] = best; ti[k] = be;
        }
        const float e1 = __expf(tv[1] - tv[0]), e2 = __expf(tv[2] - tv[0]), e3 = __expf(tv[3] - tv[0]);
        const float invs = __builtin_amdgcn_rcpf(1.0f + e1 + e2 + e3);
        if (hi == 0 && nu < MAXU) {
            const float gt[4] = {invs, e1 * invs, e2 * invs, e3 * invs};
            const int base = ((wid * MAXU + nu) * 32 + r32) * 4;
#pragma unroll
            for (int k = 0; k < 4; ++k) {
                const unsigned rk = __hip_atomic_fetch_add(&lcnt[ti[k]], 1u, __ATOMIC_RELAXED, __HIP_MEMORY_SCOPE_WORKGROUP);
                ent[base + k] = (unsigned)ti[k] | (rk << 8); entg[base + k] = gt[k];
            }
            entr[(wid * MAXU + nu) * 32 + r32] = rstd;
        }
    }
    __syncthreads();
    if (tid < 32) lbase[tid] = atomicAdd(&cnt[tid], lcnt[tid]);
    __syncthreads();
    {
        int k2 = 0;
        for (int u = blockIdx.x * 4 + wid; wid < 4 && u < T / 32 && k2 < MAXU; u += grid_size() * 4, ++k2) {
#pragma unroll
            for (int h2 = 0; h2 < 2; ++h2) {
                const int i = lane + 64 * h2; const int tl = i >> 2;
                const unsigned code = ent[((wid * MAXU + k2) * 32) * 4 + i]; const int e = (int)(code & 255u); const unsigned pos = lbase[e] + (code >> 8);
                LIST[(size_t)e * T + pos] = (int)(((unsigned)u * 32 + tl) * 4 + (i & 3));
                ((float*)(P.ws + WS_LRS))[(size_t)e * T + pos] = entr[(wid * MAXU + k2) * 32 + tl];
                ((float*)(P.ws + WS_LGT))[(size_t)e * T + pos] = entg[((wid * MAXU + k2) * 32) * 4 + i];
            }
        }
    }
    __syncthreads();
}

__device__ __forceinline__ void unpack8(const u32x4_t w, float (&x)[8]) {
#pragma unroll
    for (int i = 0; i < 4; ++i) { x[2 * i] = bf2f(w[i] & 0xffff); x[2 * i + 1] = bf2f(w[i] >> 16); }
}
template <bool Y8, bool DRY = false> __device__ __forceinline__ void ph_combine(const Params& P) {
    const int tid = opaque_tid(), wid = tid >> 6, lane = tid & 63;
    bf16_t* HB = (bf16_t*)(P.ws + WS_HB); bf16_t* HBW = DRY ? (bf16_t*)(P.ws + WS_BIG + 128 * MiB) : HB; float* RS2 = DRY ? (float*)(P.ws + WS_BIG + 200 * MiB) : (float*)(P.ws + WS_RSTD) + 2 * T;
    const bf16_t* Y = (const bf16_t*)(P.ws + WS_Y); const unsigned char* Yb = (const unsigned char*)(P.ws + WS_Y);
    for (int t0 = (blockIdx.x * NWV + wid) * 2; t0 < T; t0 += grid_size() * NWV * 2) {
        u32x4_t hv[2][2], yv[2][2][4]; uint2 y8[2][2][4];
#pragma unroll
        for (int tt = 0; tt < 2; ++tt)
#pragma unroll
            for (int i = 0; i < 2; ++i) {
                hv[tt][i] = *(const u32x4_t*)(HB + (size_t)(t0 + tt) * 1024 + i * 512 + lane * 8);
#pragma unroll
                for (int k = 0; k < 4; ++k) {
                    if constexpr (Y8) y8[tt][i][k] = *(const uint2*)(Yb + ((size_t)(t0 + tt) * 4 + k) * 1024 + i * 512 + lane * 8);
                    else yv[tt][i][k] = *(const u32x4_t*)(Y + ((size_t)(t0 + tt) * 4 + k) * 1024 + i * 512 + lane * 8);
                }
            }
#pragma unroll
        for (int tt = 0; tt < 2; ++tt) {
            float ss = 0.f;
#pragma unroll
            for (int i = 0; i < 2; ++i) {
                float v[8]; unpack8(hv[tt][i], v);
#pragma unroll
                for (int k = 0; k < 4; ++k) {
                    if constexpr (Y8) {
                        const uint2 w = y8[tt][i][k];
                        const auto p0 = __builtin_amdgcn_cvt_pk_f32_fp8((int)w.x, false), p1 = __builtin_amdgcn_cvt_pk_f32_fp8((int)w.x, true), p2 = __builtin_amdgcn_cvt_pk_f32_fp8((int)w.y, false), p3 = __builtin_amdgcn_cvt_pk_f32_fp8((int)w.y, true);
                        v[0] += p0[0] * 0.0625f; v[1] += p0[1] * 0.0625f; v[2] += p1[0] * 0.0625f; v[3] += p1[1] * 0.0625f; v[4] += p2[0] * 0.0625f; v[5] += p2[1] * 0.0625f; v[6] += p3[0] * 0.0625f; v[7] += p3[1] * 0.0625f;
                    } else { float y[8]; unpack8(yv[tt][i][k], y);
#pragma unroll
                        for (int j = 0; j < 8; ++j) v[j] += y[j]; }
                }
#pragma unroll
                for (int j = 0; j < 8; ++j) ss += v[j] * v[j];
                *(u32x4_t*)(HBW + (size_t)(t0 + tt) * 1024 + i * 512 + lane * 8) = (u32x4_t){pack2(v[0], v[1]), pack2(v[2], v[3]), pack2(v[4], v[5]), pack2(v[6], v[7])};
            }
            ss = wave_sum(ss);
            if (lane == 0) RS2[t0 + tt] = rsqrtf(ss * (1.0f / 1024.0f) + EPS);
        }
    }
}

template <bool DRY = false> __device__ __forceinline__ void ph_final(const Params& P, int layer) {
    const int tid = opaque_tid(), wid = tid >> 6, lane = tid & 63;
    bf16_t* HB = (bf16_t*)(P.ws + WS_HB); bf16_t* HBW = DRY ? (bf16_t*)(P.ws + WS_BIG + 128 * MiB) : HB; float* RS = DRY ? (float*)(P.ws + WS_BIG + 200 * MiB) : (float*)(P.ws + WS_RSTD); const bf16_t* V = (const bf16_t*)(P.ws + WS_YMIX);
    float* OUTW = DRY ? (float*)(P.ws + WS_BIG) : P.out;
    const float* gp = P.ple_pn + layer * 1024;
    float g[2][8];
#pragma unroll
    for (int i = 0; i < 2; ++i) { const f32x4 a = *(const f32x4*)(gp + i * 512 + lane * 8), b = *(const f32x4*)(gp + i * 512 + lane * 8 + 4); g[i][0] = a[0]; g[i][1] = a[1]; g[i][2] = a[2]; g[i][3] = a[3]; g[i][4] = b[0]; g[i][5] = b[1]; g[i][6] = b[2]; g[i][7] = b[3]; }
    for (int t0 = (blockIdx.x * NWV + wid) * 2; t0 < T; t0 += grid_size() * NWV * 2) {
        u32x4_t hv[2][2], yv[2][2];
#pragma unroll
        for (int tt = 0; tt < 2; ++tt)
#pragma unroll
            for (int i = 0; i < 2; ++i) { hv[tt][i] = *(const u32x4_t*)(HB + (size_t)(t0 + tt) * 1024 + i * 512 + lane * 8); yv[tt][i] = *(const u32x4_t*)(V + (size_t)(t0 + tt) * 1024 + i * 512 + lane * 8); }
#pragma unroll
        for (int tt = 0; tt < 2; ++tt) {
            float vv[2][8]; float ss = 0.f;
#pragma unroll
            for (int i = 0; i < 2; ++i) { unpack8(yv[tt][i], vv[i]);
#pragma unroll
                for (int j = 0; j < 8; ++j) ss += vv[i][j] * vv[i][j]; }
            ss = wave_sum(ss);
            const float r = rsqrtf(ss * (1.0f / 1024.0f) + EPS);
            float s2 = 0.f;
#pragma unroll
            for (int i = 0; i < 2; ++i) {
                float h[8]; unpack8(hv[tt][i], h);
#pragma unroll
                for (int j = 0; j < 8; ++j) h[j] += vv[i][j] * r * g[i][j];
                if (layer == DEPTH - 1) { float* op = OUTW + (size_t)(t0 + tt) * 1024 + i * 512 + lane * 8; *(f32x4*)op = (f32x4){h[0], h[1], h[2], h[3]}; *(f32x4*)(op + 4) = (f32x4){h[4], h[5], h[6], h[7]}; }
                else {
#pragma unroll
                    for (int j = 0; j < 8; ++j) s2 += h[j] * h[j];
                    *(u32x4_t*)(HBW + (size_t)(t0 + tt) * 1024 + i * 512 + lane * 8) = (u32x4_t){pack2(h[0], h[1]), pack2(h[2], h[3]), pack2(h[4], h[5]), pack2(h[6], h[7])};
                }
            }
            if (layer != DEPTH - 1) { s2 = wave_sum(s2); if (lane == 0) RS[t0 + tt] = rsqrtf(s2 * (1.0f / 1024.0f) + EPS); }
        }
    }
}

struct EpiZ8 { bf16_t* Z; const float* rstd; typedef float Pre;
    __device__ __forceinline__ Pre pre(int r, int) const { return rstd[r]; }
    __device__ __forceinline__ void post(int r, int c, f32x4 a, f32x4 b, Pre s) const { *(u32x4_t*)(Z + (size_t)r * ZW + c) = (u32x4_t){pack2h(a[0] * s, a[1] * s), pack2h(a[2] * s, a[3] * s), pack2h(b[0] * s, b[1] * s), pack2h(b[2] * s, b[3] * s)}; } };
struct EpiBf16_8 { bf16_t* O; int ldo; typedef int Pre;
    __device__ __forceinline__ Pre pre(int, int) const { return 0; }
    __device__ __forceinline__ void post(int r, int c, f32x4 a, f32x4 b, Pre) const { *(u32x4_t*)(O + (size_t)r * ldo + c) = (u32x4_t){pack2(a[0], a[1]), pack2(a[2], a[3]), pack2(b[0], b[1]), pack2(b[2], b[3])}; } };
struct EpiResid8 { const float* xin; bf16_t* HB; struct Pre { f32x4 lo, hi; };
    __device__ __forceinline__ Pre pre(int r, int c) const { Pre p;
        if (xin) { p.lo = *(const f32x4*)(xin + (size_t)r * 1024 + c); p.hi = *(const f32x4*)(xin + (size_t)r * 1024 + c + 4); }
        else { const u32x4_t e = *(const u32x4_t*)(HB + (size_t)r * 1024 + c); p.lo = (f32x4){bf2f(e[0] & 0xffff), bf2f(e[0] >> 16), bf2f(e[1] & 0xffff), bf2f(e[1] >> 16)}; p.hi = (f32x4){bf2f(e[2] & 0xffff), bf2f(e[2] >> 16), bf2f(e[3] & 0xffff), bf2f(e[3] >> 16)}; }
        return p; }
    __device__ __forceinline__ void post(int r, int c, f32x4 a, f32x4 b, const Pre& p) const { const f32x4 h0 = p.lo + a, h1 = p.hi + b;
        *(u32x4_t*)(HB + (size_t)r * 1024 + c) = (u32x4_t){pack2h(h0[0], h0[1]), pack2h(h0[2], h0[3]), pack2h(h1[0], h1[1]), pack2h(h1[2], h1[3])}; } };
struct EpiPle8 { const bf16_t* E; const float* rstd2; bf16_t* V; struct Pre { u32x4_t e; float s; };
    __device__ __forceinline__ Pre pre(int r, int c) const { Pre p; p.e = *(const u32x4_t*)(E + (size_t)r * 1024 + c); p.s = rstd2[r]; return p; }
    static __device__ __forceinline__ unsigned gate2(unsigned ew, f32x2 a, float sn) { const f32x2 x = a * sn; const f32x2 ex = {__builtin_amdgcn_exp2f(x[0]), __builtin_amdgcn_exp2f(x[1])}; const f32x2 d = ex + 1.0f;
        const f32x2 rr = {__builtin_amdgcn_rcpf(d[0]), __builtin_amdgcn_rcpf(d[1])}; const f32x2 ev = {__uint_as_float(ew << 16), __uint_as_float(ew & 0xffff0000u)}; return pack2v(ev * rr); }
    __device__ __forceinline__ void post(int r, int c, f32x4 a, f32x4 b, const Pre& p) const { const float sn = p.s * -1.4426950408889634f; const u32x4_t e = p.e;
        *(u32x4_t*)(V + (size_t)r * 1024 + c) = (u32x4_t){gate2(e[0], __builtin_shufflevector(a, a, 0, 1), sn), gate2(e[1], __builtin_shufflevector(a, a, 2, 3), sn), gate2(e[2], __builtin_shufflevector(b, b, 0, 1), sn), gate2(e[3], __builtin_shufflevector(b, b, 2, 3), sn)}; } };
__device__ __forceinline__ f32x2 swiglu2(f32x2 g, f32x2 u, float s, f32x2 bg, f32x2 bu1) {
    const f32x2 gp = g * s + bg, up = u * s + bu1;
    const f32x2 gg = {fminf(gp[0], 7.0f), fminf(gp[1], 7.0f)};
    const f32x2 uu = {__builtin_amdgcn_fmed3f(up[0], -6.0f, 8.0f), __builtin_amdgcn_fmed3f(up[1], -6.0f, 8.0f)};
    const f32x2 t = uu * gg, xe = gg * (-1.702f * 1.4426950408889634f);
    const f32x2 e = {__builtin_amdgcn_exp2f(xe[0]), __builtin_amdgcn_exp2f(xe[1])};
    const f32x2 d = e + 1.0f;
    const f32x2 r = {__builtin_amdgcn_rcpf(d[0]), __builtin_amdgcn_rcpf(d[1])};
    return t * r;
}


namespace fg {
typedef int v4i_t __attribute__((ext_vector_type(4))); typedef int v8i_t __attribute__((ext_vector_type(8)));
constexpr int BM = 256, BK = 64, HALF = 128, HTB = HALF * BK * 2  , STAGE_BYTES = 8 * HTB, NXCD = 8, WGM = 8;
__host__ __device__ __forceinline__ int lds_byte(int r, int c) { const int st = (r >> 4) * 2 + (c >> 5), rr = r & 15, cc = c & 31, ob = rr * 64 + cc * 2; return st * 1024 + (ob ^ (((ob >> 9) & 1) << 5)); }
__host__ __device__ __forceinline__ int perm32(int rho) { const int n = rho >> 4, i = rho & 15; return 8 * (i >> 2) + 4 * n + (i & 3); }
__host__ __device__ __forceinline__ void stage_rc(int b, int& R, int& C) { const int st = b / 1024, sb = b % 1024, swz = sb ^ (((sb >> 9) & 1) << 5); R = (st >> 1) * 16 + swz / 64; C = (st & 1) * 32 + (swz % 64) / 2; }

template <class PB>
__device__ __forceinline__ void gemm_phase(LAS unsigned char* lds, const PB& S) {
    constexpr int K = PB::K, nt = K / BK;
    typedef typename PB::Unit Unit;
    const int tid = opaque_tid(); const int wid = __builtin_amdgcn_readfirstlane(tid >> 6), lane = tid & 63, wr = wid >> 2, wc = wid & 3, fr = lane & 15, fq = lane >> 4;
    unsigned voffB[2];
#pragma unroll
    for (int i = 0; i < 2; ++i) { int R_, C_; stage_rc(tid * 16 + i * 8192, R_, C_); const int Rb_ = PB::PERM ? ((R_ & ~31) + perm32(R_ & 31)) : R_; voffB[i] = (unsigned)(Rb_ * K + C_) * 2u; }
#define FG_AOFFS(dst, unit) do { const int tz_ = opaque_tid(); _Pragma("unroll") for (int i_ = 0; i_ < 2; ++i_) { int R_, C_; stage_rc(tz_ * 16 + i_ * 8192, R_, C_); \
        _Pragma("unroll") for (int h_ = 0; h_ < 2; ++h_) dst[h_][i_] = S.a_off(unit, h_ * HALF + R_) + (unsigned)C_ * 2u; } } while (0)
    constexpr size_t kstep = (size_t)(BK * 2);
    constexpr size_t hstep = (size_t)HALF * K * 2;
    const unsigned ldsw = (unsigned)wid * 1024u;
    const int aoff = lds_byte(wr * 64 + fr, fq * 8), boff = lds_byte(wc * 32 + fr, fq * 8);
#define FG_SA(b, h) (((b) * 2 + (h)) * HTB)
#define FG_SB(b, h) ((4 + (b) * 2 + (h)) * HTB)
#define FG_STAGE_B(bufoff, gbase) do { _Pragma("unroll") for (int _i = 0; _i < 2; ++_i) \
        __builtin_amdgcn_global_load_lds((const unsigned*)((const char*)(gbase) + voffB[_i]), (LAS unsigned*)(lds + (bufoff) + ldsw + _i * 8192), 16, 0, 0); } while (0)
#define FG_STAGE_A(bufoff, o0, o1) do { \
        __builtin_amdgcn_global_load_lds((const unsigned*)(Abase + (o0)), (LAS unsigned*)(lds + (bufoff) + ldsw), 16, 0, 0); \
        __builtin_amdgcn_global_load_lds((const unsigned*)(Abase + (o1)), (LAS unsigned*)(lds + (bufoff) + ldsw + 8192), 16, 0, 0); } while (0)
#define FG_LD8(dst, off) do { const v4i_t lo_ = *(const LAS v4i_t*)(lds + (off)), hi_ = *(const LAS v4i_t*)(lds + (off) + 1024); dst = (v8i_t){lo_[0], lo_[1], lo_[2], lo_[3], hi_[0], hi_[1], hi_[2], hi_[3]}; } while (0)
#define FG_LDA(dst, b, h) do { _Pragma("unroll") for (int m = 0; m < 4; ++m) FG_LD8(dst[m], FG_SA(b, h) + aoff + m * 2048); } while (0)
#define FG_LDB(dst, b, h) do { _Pragma("unroll") for (int n = 0; n < 2; ++n) FG_LD8(dst[n], FG_SB(b, h) + boff + n * 2048); } while (0)
#define FG_HALF(v, k) ((k) == 0 ? __builtin_bit_cast(bf16x8, (v4i_t){(v)[0], (v)[1], (v)[2], (v)[3]}) : __builtin_bit_cast(bf16x8, (v4i_t){(v)[4], (v)[5], (v)[6], (v)[7]}))
#define FG_MMA(ai, bj, At, Bt) do { __builtin_amdgcn_s_setprio(1); \
        if constexpr (PB::FP8) { _Pragma("unroll") for (int m = 0; m < 4; ++m) _Pragma("unroll") for (int n = 0; n < 2; ++n) \
            asm volatile("v_mfma_scale_f32_16x16x128_f8f6f4 %0, %1, %2, %0, %3, %4 op_sel_hi:[0,0,0]" : "+v"(acc[ai][bj][m][n]) : "v"(Bt[n]), "v"(At[m]), "v"(sclW), "v"(sclA)); } \
        else { _Pragma("unroll") for (int m = 0; m < 4; ++m) _Pragma("unroll") for (int n = 0; n < 2; ++n) _Pragma("unroll") for (int k = 0; k < 2; ++k) \
            acc[ai][bj][m][n] = __builtin_amdgcn_mfma_f32_16x16x32_bf16(FG_HALF(Bt[n], k), FG_HALF(At[m], k), acc[ai][bj][m][n], 0, 0, 0); } \
        __builtin_amdgcn_s_setprio(0); } while (0)
#define FG_WAIT_V(n) asm volatile("s_waitcnt vmcnt(" #n ")" ::: "memory")
#define FG_WAIT_L(n) asm volatile("s_waitcnt lgkmcnt(" #n ")" ::: "memory")
#define FG_BAR __builtin_amdgcn_s_barrier()
#define FG_SCHED __builtin_amdgcn_sched_barrier(0)
    Unit cur, nxt; int ui = 0;
    if (!S.next(0, cur)) return;
    f32x4 acc[2][2][4][2];
#pragma unroll
    for (int a = 0; a < 2; ++a)
#pragma unroll
        for (int b = 0; b < 2; ++b)
#pragma unroll
            for (int m = 0; m < 4; ++m)
#pragma unroll
                for (int n = 0; n < 2; ++n) acc[a][b][m][n] = (f32x4){0.f, 0.f, 0.f, 0.f};
    v8i_t At[4], B0[2], B1[2];
    int sclW = 0x79797979, sclA = 0x7f7f7f7f;
    asm volatile("" : "+v"(sclW), "+v"(sclA));
    const char* Abase = S.a_base();
    unsigned vAc[2][2];
    FG_AOFFS(vAc, cur);
    const char* cB = S.b_base(cur);
    FG_STAGE_B(FG_SB(0, 0), cB); FG_STAGE_B(FG_SB(0, 1), cB + hstep); FG_STAGE_A(FG_SA(0, 0), vAc[0][0], vAc[0][1]); FG_STAGE_A(FG_SA(0, 1), vAc[1][0], vAc[1][1]);
    if (wr == 1) FG_BAR;
    FG_WAIT_V(2); FG_BAR;
    FG_STAGE_B(FG_SB(1, 0), cB + kstep); FG_STAGE_A(FG_SA(1, 0), vAc[0][0] + (unsigned)kstep, vAc[0][1] + (unsigned)kstep); FG_STAGE_B(FG_SB(1, 1), cB + hstep + kstep);
    FG_WAIT_V(6); FG_BAR;
    for (;;) {
        const bool has_next = S.next(ui + 1, nxt);
        const char* nB = has_next ? S.b_base(nxt) : cB;
        {
            unsigned vAn[2][2];
            if (has_next) { FG_AOFFS(vAn, nxt); }
            else {
#pragma unroll
                for (int h = 0; h < 2; ++h)
#pragma unroll
                    for (int i = 0; i < 2; ++i) vAn[h][i] = vAc[h][i];
            }
            *(LAS v4i_t*)(lds + STAGE_BYTES + 512 + opaque_tid() * 16) = (v4i_t){(int)vAn[0][0], (int)vAn[0][1], (int)vAn[1][0], (int)vAn[1][1]};
        }
#pragma unroll 1
        for (int t = 0; t < nt; t += 2) {
            const bool last = (t == nt - 2);
            const unsigned k1 = (unsigned)((t + 1) * (int)kstep), k2 = last ? 0u : (unsigned)((t + 2) * (int)kstep);
            const char* b2 = last ? nB : cB + (size_t)(t + 2) * kstep; const char* b3 = b2 + kstep;
            const unsigned c10_ = vAc[1][0], c11_ = vAc[1][1];
            if (last) { const v4i_t nx_ = *(const LAS v4i_t*)(lds + STAGE_BYTES + 512 + opaque_tid() * 16); vAc[0][0] = (unsigned)nx_[0]; vAc[0][1] = (unsigned)nx_[1]; vAc[1][0] = (unsigned)nx_[2]; vAc[1][1] = (unsigned)nx_[3]; }
#define FG_A2(h, i) (vAc[h][i] + k2)
            FG_LDB(B0, 0, 0); FG_LDB(B1, 0, 1); FG_SCHED; FG_LDA(At, 0, 0); FG_STAGE_A(FG_SA(1, 1), c10_ + k1, c11_ + k1);
            FG_WAIT_V(8); FG_WAIT_L(0); FG_BAR; FG_MMA(0, 0, At, B0); FG_MMA(0, 1, At, B1); FG_BAR; FG_SCHED;
            FG_LDA(At, 0, 1); FG_STAGE_B(FG_SB(0, 0), b2); FG_STAGE_B(FG_SB(0, 1), b2 + hstep); FG_STAGE_A(FG_SA(0, 0), FG_A2(0, 0), FG_A2(0, 1));
            FG_WAIT_V(8); FG_WAIT_L(0); FG_BAR; FG_MMA(1, 0, At, B0); FG_MMA(1, 1, At, B1); FG_BAR; FG_SCHED;
            FG_LDB(B0, 1, 0); FG_LDB(B1, 1, 1); FG_SCHED; FG_LDA(At, 1, 0); FG_STAGE_A(FG_SA(0, 1), FG_A2(1, 0), FG_A2(1, 1));
            FG_WAIT_V(8); FG_WAIT_L(0); FG_BAR; FG_MMA(0, 0, At, B0); FG_MMA(0, 1, At, B1); FG_BAR; FG_SCHED;
            FG_LDA(At, 1, 1); FG_STAGE_B(FG_SB(1, 0), b3); FG_STAGE_B(FG_SB(1, 1), b3 + hstep); FG_STAGE_A(FG_SA(1, 0), FG_A2(0, 0) + (unsigned)kstep, FG_A2(0, 1) + (unsigned)kstep);
            FG_WAIT_V(8); FG_WAIT_L(0); FG_BAR; FG_MMA(1, 0, At, B0); FG_MMA(1, 1, At, B1); FG_BAR; FG_SCHED;
        }
        if (wr == 0) FG_BAR;
        if constexpr (PB::FP8) asm volatile("s_nop 15\n\ts_nop 15\n\ts_nop 15" ::: "memory");
        { const int t2_ = opaque_tid(); const int w2_ = __builtin_amdgcn_readfirstlane(t2_ >> 6), l2_ = t2_ & 63;
          S.epilogue(acc, cur, w2_ >> 2, w2_ & 3, l2_ & 15, l2_ >> 4); }
        if (!has_next) break;
#pragma unroll
        for (int a = 0; a < 2; ++a)
#pragma unroll
            for (int b = 0; b < 2; ++b)
#pragma unroll
                for (int m = 0; m < 4; ++m)
#pragma unroll
                    for (int n = 0; n < 2; ++n) acc[a][b][m][n] = (f32x4){0.f, 0.f, 0.f, 0.f};
        cur = nxt; cB = nB; ++ui;
        if (wr == 1) FG_BAR;
    }
    FG_WAIT_V(0);
    FG_BAR;
#undef FG_AOFFS
#undef FG_A2
#undef FG_SA
#undef FG_SB
#undef FG_STAGE_A
#undef FG_STAGE_B
#undef FG_LDA
#undef FG_LD8
#undef FG_HALF
#undef FG_LDB
#undef FG_MMA
#undef FG_WAIT_V
#undef FG_WAIT_L
#undef FG_BAR
#undef FG_SCHED
}

template <int K_, int LDA, class Epi, bool PERM_>
struct DenseProb {
    static constexpr int K = K_; static constexpr bool PERM = PERM_, FP8 = false;
    struct Unit { int pm, pn; };
    const bf16_t* A; const bf16_t* Bt; int nM, nN, nwg, G, c; Epi epi;
    __device__ __forceinline__ DenseProb(const bf16_t* A_, const bf16_t* Bt_, int N, const Epi& e) : A(A_), Bt(Bt_), nM(T / BM), nN(N / BM), nwg((T / BM) * (N / BM)), G(grid_size()), c(blockIdx.x), epi(e) {}
    __device__ __forceinline__ bool next(int i, Unit& u) const {
        const long L = (long)i * G + c; if (L >= nwg) return false;
        int wgid = (int)L; { const int q = nwg / NXCD, r = nwg % NXCD, xcd = wgid % NXCD, off = wgid / NXCD; wgid = (xcd < r ? xcd * (q + 1) : r * (q + 1) + (xcd - r) * q) + off; }
        const int nig = WGM * nN, gid = wgid / nig, fm = gid * WGM, gsz = (nM - fm) < WGM ? (nM - fm) : WGM;
        u.pm = fm + ((wgid % nig) % gsz); u.pn = (wgid % nig) / gsz; return true;
    }
    __device__ __forceinline__ const char* a_base() const { return (const char*)A; }
    __device__ __forceinline__ unsigned a_off(const Unit& u, int r) const { return (unsigned)((u.pm * BM + r) * LDA) * 2u; }
    __device__ __forceinline__ const char* b_base(const Unit& u) const { return (const char*)Bt + (size_t)u.pn * BM * K * 2; }
    __device__ __forceinline__ void epilogue(const f32x4 (&acc)[2][2][4][2], const Unit& u, int wr, int wc, int fr, int fq) const {
        const int row0 = u.pm * BM + wr * 64 + fr;
        if constexpr (PERM) {
            const int col0 = u.pn * BM + wc * 32 + 8 * fq;
#pragma unroll
            for (int ai = 0; ai < 2; ++ai) {
                typename Epi::Pre pre[4][2];
#pragma unroll
                for (int m = 0; m < 4; ++m)
#pragma unroll
                    for (int bj = 0; bj < 2; ++bj) pre[m][bj] = epi.pre(row0 + ai * HALF + m * 16, col0 + bj * HALF);
#pragma unroll
                for (int m = 0; m < 4; ++m)
#pragma unroll
                    for (int bj = 0; bj < 2; ++bj) epi.post(row0 + ai * HALF + m * 16, col0 + bj * HALF, acc[ai][bj][m][0], acc[ai][bj][m][1], pre[m][bj]);
            }
        } else {
            const int col0 = u.pn * BM + wc * 32 + 4 * fq;
#pragma unroll
            for (int ai = 0; ai < 2; ++ai)
#pragma unroll
                for (int m = 0; m < 4; ++m)
#pragma unroll
                    for (int bj = 0; bj < 2; ++bj)
#pragma unroll
                        for (int n = 0; n < 2; ++n) epi(row0 + ai * HALF + m * 16, col0 + bj * HALF + n * 16, acc[ai][bj][m][n]);
        }
    }
};
}
template <int K, int LDA, bool PERM, class Epi>
__device__ __forceinline__ void ph_gemm_fast(LAS unsigned char* lds, const bf16_t* A, const bf16_t* Bt, int N, const Epi& epi) {
    const fg::DenseProb<K, LDA, Epi, PERM> pb(A, Bt, N, epi);
    fg::gemm_phase(lds, pb);
}


namespace fg {
struct MoeUnit { int e, mblk, pn, rowoff, M; };
template <bool FIRST, bool FP8_>
struct MoeProb {
    static constexpr int K = FP8_ ? 512 : 1024  , NCOL = FIRST ? 8 : 4; static constexpr bool PERM = true, FP8 = FP8_; static constexpr unsigned RB = FP8_ ? 1024u : 2048u  ;
    typedef MoeUnit Unit;
    const Params& P; int layer; const LAS int* tab;
    int G, c; mutable int e_, acc_, off_;
    __device__ __forceinline__ MoeProb(const Params& P_, int layer_, const LAS int* tab_) : P(P_), layer(layer_), tab(tab_), G(grid_size()), c(blockIdx.x), e_(0), acc_(0), off_(0) {}
    __device__ __forceinline__ bool next(int i, Unit& u) const {
        const int j = i * (G >> 3) + (c >> 3), tile = (j / NCOL) * 8 + (c & 7);
        while (e_ < 32) { const int tl = (tab[e_] + 255) >> 8; if (tile < acc_ + tl) break; acc_ += tl; off_ += tl * 256; ++e_; }
        if (e_ >= 32) return false;
        u.e = e_; u.mblk = tile - acc_; u.pn = j % NCOL; u.rowoff = off_; u.M = tab[e_]; return true;
    }
    __device__ __forceinline__ const char* a_base() const { return FIRST ? (const char*)(P.ws + (FP8_ ? WS_YMIX : WS_HB)) : (const char*)(P.ws + WS_BIG); }
    __device__ __forceinline__ unsigned a_off(const Unit& u, int r) const {
        if (FIRST) { int rr = u.mblk * 256 + r; rr = rr < u.M ? rr : u.M - 1; const int ts = ((const int*)(P.ws + WS_LIST))[(size_t)u.e * T + rr]; return (unsigned)(ts >> 2) * RB; }
        return (unsigned)(u.rowoff + u.mblk * 256 + r) * RB;
    }
    __device__ __forceinline__ const char* b_base(const Unit& u) const {
        return FIRST ? (const char*)(P.ws + WS_W1) + ((size_t)u.e * 2048 + (size_t)u.pn * 256) * RB : (const char*)(P.ws + WS_W2) + ((size_t)u.e * 1024 + (size_t)u.pn * 256) * RB;
    }
    __device__ __forceinline__ void epilogue(const f32x4 (&acc)[2][2][4][2], const Unit& u, int wr, int wc, int fr, int fq) const {
        char* ws = P.ws; const int rl0 = u.mblk * 256 + wr * 64 + fr;
        if (FIRST) {
            const float* lrs = (const float*)(ws + WS_LRS) + (size_t)u.e * T;
            bf16_t* H = (bf16_t*)(ws + WS_BIG) + (size_t)u.rowoff * 1024;
            const int hc0 = u.pn * 128 + wc * 32 + 8 * fq;
            const float* bgp = P.moe_bg + ((size_t)layer * 32 + u.e) * 1024 + hc0; const float* bup = P.moe_bu + ((size_t)layer * 32 + u.e) * 1024 + hc0;
            const f32x4 bg0 = *(const f32x4*)bgp, bg1 = *(const f32x4*)(bgp + 4), bu0 = *(const f32x4*)bup + 1.0f, bu1 = *(const f32x4*)(bup + 4) + 1.0f;
            float sc[2][4];
#pragma unroll
            for (int ai = 0; ai < 2; ++ai)
#pragma unroll
                for (int m = 0; m < 4; ++m) { const int r = rl0 + ai * HALF + m * 16; sc[ai][m] = lrs[r < u.M ? r : u.M - 1]; }
#pragma unroll
            for (int ai = 0; ai < 2; ++ai)
#pragma unroll
                for (int m = 0; m < 4; ++m) { const int r = rl0 + ai * HALF + m * 16;
                    if (FP8_ || r < u.M) {
                        const float s_ = sc[ai][m]; const f32x4 g0 = acc[ai][0][m][0], g1 = acc[ai][0][m][1], u0 = acc[ai][1][m][0], u1 = acc[ai][1][m][1];
                        const f32x2 h01 = swiglu2(__builtin_shufflevector(g0, g0, 0, 1), __builtin_shufflevector(u0, u0, 0, 1), s_, __builtin_shufflevector(bg0, bg0, 0, 1), __builtin_shufflevector(bu0, bu0, 0, 1));
                        const f32x2 h23 = swiglu2(__builtin_shufflevector(g0, g0, 2, 3), __builtin_shufflevector(u0, u0, 2, 3), s_, __builtin_shufflevector(bg0, bg0, 2, 3), __builtin_shufflevector(bu0, bu0, 2, 3));
                        const f32x2 h45 = swiglu2(__builtin_shufflevector(g1, g1, 0, 1), __builtin_shufflevector(u1, u1, 0, 1), s_, __builtin_shufflevector(bg1, bg1, 0, 1), __builtin_shufflevector(bu1, bu1, 0, 1));
                        const f32x2 h67 = swiglu2(__builtin_shufflevector(g1, g1, 2, 3), __builtin_shufflevector(u1, u1, 2, 3), s_, __builtin_shufflevector(bg1, bg1, 2, 3), __builtin_shufflevector(bu1, bu1, 2, 3));
                        if constexpr (FP8_) *(uint2*)((unsigned char*)(ws + WS_BIG) + (size_t)(u.rowoff + r) * 1024 + hc0) = make_uint2(pack4_fp8(h01[0], h01[1], h23[0], h23[1]), pack4_fp8(h45[0], h45[1], h67[0], h67[1]));
                        else *(u32x4_t*)(H + (size_t)r * 1024 + hc0) = (u32x4_t){pack2v(h01), pack2v(h23), pack2v(h45), pack2v(h67)};
                    } }
        } else {
            const int* list = (const int*)(ws + WS_LIST) + (size_t)u.e * T; const float* lgt = (const float*)(ws + WS_LGT) + (size_t)u.e * T;
            bf16_t* Y = (bf16_t*)(ws + WS_Y);
            const int col0 = u.pn * 256 + wc * 32 + 8 * fq;
            const float* bdp = P.moe_bd + ((size_t)layer * 32 + u.e) * 1024 + col0;
            f32x4 bd[2][2];
#pragma unroll
            for (int bj = 0; bj < 2; ++bj) { bd[bj][0] = *(const f32x4*)(bdp + bj * HALF); bd[bj][1] = *(const f32x4*)(bdp + bj * HALF + 4); }
            int tsv[2][4]; float gv[2][4];
#pragma unroll
            for (int ai = 0; ai < 2; ++ai)
#pragma unroll
                for (int m = 0; m < 4; ++m) { const int r = rl0 + ai * HALF + m * 16; const int rc = r < u.M ? r : u.M - 1; const int ts_ = list[rc]; tsv[ai][m] = (!FP8_ || r < u.M) ? ts_ : T * 4 + (r & 255); gv[ai][m] = lgt[rc]; }
#pragma unroll
            for (int ai = 0; ai < 2; ++ai)
#pragma unroll
                for (int m = 0; m < 4; ++m) { const int r = rl0 + ai * HALF + m * 16;
                    if (FP8_ || r < u.M) {
                        const float g = FP8_ ? gv[ai][m] * 16.0f : gv[ai][m]; bf16_t* yr = Y + (size_t)tsv[ai][m] * 1024 + col0;
#pragma unroll
                        for (int bj = 0; bj < 2; ++bj) { const f32x4 a = (acc[ai][bj][m][0] + bd[bj][0]) * g, b = (acc[ai][bj][m][1] + bd[bj][1]) * g;
                            if constexpr (FP8_) *(uint2*)((unsigned char*)(ws + WS_Y) + (size_t)tsv[ai][m] * 1024 + col0 + bj * HALF) = make_uint2(pack4_fp8(a[0], a[1], a[2], a[3]), pack4_fp8(b[0], b[1], b[2], b[3]));
                            else *(u32x4_t*)(yr + bj * HALF) = (u32x4_t){pack2(a[0], a[1]), pack2(a[2], a[3]), pack2(b[0], b[1]), pack2(b[2], b[3])}; }
                    } }
        }
    }
};
}
template <bool FIRST, bool FP8>
__device__ __forceinline__ void ph_moe_fast(const Params& P, int layer, LAS unsigned char* lds) {
    LAS int* tab = (LAS int*)(lds + fg::STAGE_BYTES);
    const int tz = opaque_tid();
    if (tz < 32) tab[tz] = (int)((const unsigned*)(P.ws + WS_CTL))[CTL_CNT + layer * 32 + tz];
    __syncthreads();
    const fg::MoeProb<FIRST, FP8> pb(P, layer, tab);
    fg::gemm_phase(lds, pb);
}


namespace at {
typedef short s16x4 __attribute__((ext_vector_type(4)));
constexpr int KSLOT = 12288, VSLOT = 8192, NSLOT = 4, LDS_K = 0, LDS_V = NSLOT * KSLOT, LDS_END = LDS_V + NSLOT * VSLOT;
typedef float f32x2_t __attribute__((ext_vector_type(2))); typedef __bf16 bf16x2_t __attribute__((ext_vector_type(2)));
__device__ __forceinline__ unsigned cvtpk(float lo, float hi) { const f32x2_t v = {lo, hi}; const bf16x2_t b = __builtin_convertvector(v, bf16x2_t); return __builtin_bit_cast(unsigned, b); }
__device__ __forceinline__ void glds16(const void* gsrc, unsigned lds_dst) { unsigned keep;
    asm volatile("s_mov_b32 %0, m0\n\ts_mov_b32 m0, %2\n\ts_nop 0\n\tglobal_load_lds_dwordx4 %1, off\n\ts_mov_b32 m0, %0" : "=&s"(keep) : "v"(gsrc), "s"(lds_dst) : "memory"); }
__device__ __forceinline__ s16x4 vtr(const LAS unsigned char* p) { return __builtin_bit_cast(s16x4, __builtin_amdgcn_ds_read_tr16_b64_v4i16((LAS s16x4*)p)); }

__device__ __forceinline__ void attn_unit(int b, int h, int qb, const bf16_t* Q, const bf16_t* Kd, const bf16_t* KV, bf16_t* YM, LAS unsigned char* lds) {
    const int tid = opaque_tid(); const int lane = tid & 63, r32 = lane & 31, hi = lane >> 5; const int wid = __builtin_amdgcn_readfirstlane(tid >> 6);
    const int q0 = qb * 256; const size_t row = (size_t)b * SEQ + q0 + wid * 32 + r32;
    const int NT = 4 * qb + 4;
    const char* ksrcA = (const char*)(Kd + (((size_t)b * SEQ + lane) * 8 + h) * 96) + wid * 16;
    const char* ksrcB = (const char*)(Kd + (((size_t)b * SEQ + lane) * 8 + h) * 96) + (8 + (wid & 3)) * 16;
    const char* vsrc = (const char*)(KV + ((size_t)b * SEQ + 16 * (wid & 3) + (lane >> 2)) * 1024 + h * 128 + 64 + (wid >> 2) * 32 + (lane & 3) * 8);
    const unsigned lds0 = (unsigned)(size_t)lds;
#define AT_DMA(j, slot) do { \
        glds16(ksrcA + (size_t)(j) * (64 * 1536), (unsigned)__builtin_amdgcn_readfirstlane((int)(lds0 + LDS_K + (slot) * KSLOT + wid * 1024))); \
        glds16(ksrcB + (size_t)(j) * (64 * 1536), (unsigned)__builtin_amdgcn_readfirstlane((int)(lds0 + LDS_K + (slot) * KSLOT + (8 + (wid & 3)) * 1024))); \
        glds16(vsrc + (size_t)(j) * (64 * 2048), (unsigned)__builtin_amdgcn_readfirstlane((int)(lds0 + LDS_V + (slot) * VSLOT + wid * 1024))); } while (0)
    AT_DMA(0, 0); AT_DMA(1, 1); AT_DMA(2, 2);
    bf16x8 qf[6];
#pragma unroll
    for (int ks = 0; ks < 6; ++ks) qf[ks] = *(const bf16x8*)(Q + row * 768 + h * 96 + ks * 16 + hi * 8);
    asm volatile("" : "+v"(qf[0]), "+v"(qf[1]), "+v"(qf[2]), "+v"(qf[3]), "+v"(qf[4]), "+v"(qf[5]));
    constexpr float THR = 8.0f;
    float mref = 0.f, l = 0.f;
    f32x16 o0, o1, negm;
#pragma unroll
    for (int r = 0; r < 16; ++r) { o0[r] = 0.f; o1[r] = 0.f; negm[r] = 0.f; }
    const int kfo = hi * 1024 + r32 * 16;
    const int vfo = ((lane >> 4) & 1) * 32 + (lane & 3) * 8 + (4 * hi + ((lane & 15) >> 2)) * 64;
    const int qrel = wid * 32 + r32;
    int slot = 0;
    for (int j = 0; j < NT; ++j) {
        if (j + 2 < NT) asm volatile("s_waitcnt vmcnt(6)\n\ts_barrier" ::: "memory"); else if (j + 1 < NT) asm volatile("s_waitcnt vmcnt(3)\n\ts_barrier" ::: "memory"); else asm volatile("s_waitcnt vmcnt(0)\n\ts_barrier" ::: "memory");
        if (j + 3 < NT) { AT_DMA(j + 3, (slot + 3) & 3); }
        const LAS unsigned char* kp = lds + LDS_K + slot * KSLOT + kfo;
        const LAS unsigned char* vp = lds + LDS_V + slot * VSLOT + vfo;
        f32x16 s0, s1;
#pragma unroll
        for (int ks = 0; ks < 6; ++ks) {
            const bf16x8 k0 = *(const LAS bf16x8*)(kp + ks * 2048), k1 = *(const LAS bf16x8*)(kp + ks * 2048 + 512);
            s0 = __builtin_amdgcn_mfma_f32_32x32x16_bf16(k0, qf[ks], ks == 0 ? negm : s0, 0, 0, 0);
            s1 = __builtin_amdgcn_mfma_f32_32x32x16_bf16(k1, qf[ks], ks == 0 ? negm : s1, 0, 0, 0);
        }
        if (j >= NT - 4) {
            const int kb = 64 * (j - (NT - 4)) + 4 * hi;
#pragma unroll
            for (int r = 0; r < 16; ++r) { const int kv = kb + (r & 3) + 8 * (r >> 2); if (kv > qrel) s0[r] = -INFINITY; if (kv + 32 > qrel) s1[r] = -INFINITY; }
        }
        float rm = fmaxf(fmaxf(s0[0], s1[0]), fmaxf(s0[1], s1[1]));
#pragma unroll
        for (int r = 2; r < 16; r += 2) rm = fmaxf(rm, fmaxf(fmaxf(s0[r], s1[r]), fmaxf(s0[r + 1], s1[r + 1])));
        rm = xhalf_max(rm);
        if (__any(rm > THR)) {
            const float dl = fmaxf(rm, 0.f);
            mref += dl;
#pragma unroll
            for (int r = 0; r < 16; ++r) { s0[r] -= dl; s1[r] -= dl; negm[r] = -mref; }
            const float f = __builtin_amdgcn_exp2f(-dl);
            l *= f;
#pragma unroll
            for (int r = 0; r < 16; ++r) { o0[r] *= f; o1[r] *= f; }
        }
        float ps0 = 0.f, ps1 = 0.f;
#pragma unroll
        for (int r = 0; r < 16; ++r) { s0[r] = __builtin_amdgcn_exp2f(s0[r]); s1[r] = __builtin_amdgcn_exp2f(s1[r]); ps0 += s0[r]; ps1 += s1[r]; }
        l += ps0 + ps1;
        bf16x8 pf[4];
        {
            unsigned w[16];
#pragma unroll
            for (int i = 0; i < 8; ++i) { w[i] = cvtpk(s0[2 * i], s0[2 * i + 1]); w[8 + i] = cvtpk(s1[2 * i], s1[2 * i + 1]); }
#pragma unroll
            for (int k = 0; k < 4; ++k) { typedef unsigned u32x4 __attribute__((ext_vector_type(4))); const u32x4 t = {w[4 * k], w[4 * k + 1], w[4 * k + 2], w[4 * k + 3]}; pf[k] = __builtin_bit_cast(bf16x8, t); }
        }
#pragma unroll
        for (int k = 0; k < 4; ++k) {
            const s16x4 a0 = vtr(vp + k * 1024), a1 = vtr(vp + k * 1024 + 512), c0 = vtr(vp + 4096 + k * 1024), c1 = vtr(vp + 4096 + k * 1024 + 512);
            const bf16x8 v0 = {a0[0], a0[1], a0[2], a0[3], a1[0], a1[1], a1[2], a1[3]}, v1 = {c0[0], c0[1], c0[2], c0[3], c1[0], c1[1], c1[2], c1[3]};
            o0 = __builtin_amdgcn_mfma_f32_32x32x16_bf16(v0, pf[k], o0, 0, 0, 0);
            o1 = __builtin_amdgcn_mfma_f32_32x32x16_bf16(v1, pf[k], o1, 0, 0, 0);
        }
        slot = (slot + 1) & 3;
    }
    l = xhalf_sum(l);
    const float rl = 1.0f / l;
    bf16_t* op = YM + row * 1024 + 256 + h * 64 + 4 * hi;
#pragma unroll
    for (int g = 0; g < 4; ++g) {
        *(uint2*)(op + 8 * g) = make_uint2(cvtpk(o0[4 * g] * rl, o0[4 * g + 1] * rl), cvtpk(o0[4 * g + 2] * rl, o0[4 * g + 3] * rl));
        *(uint2*)(op + 32 + 8 * g) = make_uint2(cvtpk(o1[4 * g] * rl, o1[4 * g + 1] * rl), cvtpk(o1[4 * g + 2] * rl, o1[4 * g + 3] * rl));
    }
    asm volatile("s_waitcnt lgkmcnt(0)\n\ts_barrier" ::: "memory");
#undef AT_DMA
}
}
__device__ __forceinline__ void ph_attn_fast(const Params& P, LAS unsigned char* lds) {
    const bf16_t* Q = (const bf16_t*)(P.ws + WS_BIG + BIG_Q); const bf16_t* Kd = (const bf16_t*)(P.ws + WS_BIG + BIG_K); const bf16_t* KV = (const bf16_t*)(P.ws + WS_BIG + BIG_KV);
    bf16_t* YM = (bf16_t*)(P.ws + WS_YMIX);
    const int G = grid_size();
    for (int v0 = (blockIdx.x % 8) * (G / 8) + blockIdx.x / 8; v0 < 256; v0 += G) {
        const int bh = v0 >> 2, s = v0 & 3;
#pragma unroll 1
        for (int i = 0; i < 4; ++i) { const int qb = (i == 0) ? s : (i == 1) ? 7 - s : (i == 2) ? 8 + s : 15 - s; at::attn_unit(bh >> 3, bh & 7, qb, Q, Kd, KV, YM, lds); }
    }
}


template <bool DRY = false> __device__ __forceinline__ void ph_gla_x(const Params& P, LAS unsigned char* lds) {
    const int tid = opaque_tid(); const int wid = __builtin_amdgcn_readfirstlane(tid >> 6), lane = tid & 63;
    LAS float* kend = (LAS float*)(lds + wid * 8192);
    const bf16_t* Z = (const bf16_t*)(P.ws + WS_BIG + BIG_Z); float* LA = (float*)(P.ws + WS_BIG + BIG_LA);
    float* UPD = DRY ? (float*)(P.ws + WS_Y + 32 * MiB) : (float*)(P.ws + WS_UPD); float* DEC = DRY ? (float*)(P.ws + WS_Y + 64 * MiB) : (float*)(P.ws + WS_DEC); float* LAW = DRY ? (float*)(P.ws + WS_Y) : LA;
    for (int u = blockIdx.x * NWV + wid; u < 2048; u += grid_size() * NWV) {
        const int bh = u >> 6, n = u & 63, b = bh >> 2, h = bh & 3;
        const size_t t0 = (size_t)b * SEQ + n * 64;
        const int k = lane & 31, half = lane >> 5;
        float c[32]; float run = 0.f;
#pragma unroll
        for (int i = 0; i < 32; ++i) { run += LA[(t0 + 32 * half + i) * 128 + h * 32 + k]; c[i] = run; }
        const float tot0 = __shfl(run, k);
        const float add = half ? tot0 : 0.f;
        const float blast = __shfl(run, 32 + k) + tot0;
        float kk[32];
#pragma unroll
        for (int i = 0; i < 32; ++i) kk[i] = bf2f(Z[(t0 + 32 * half + i) * ZW + ZC_GK + h * 32 + k]);
#pragma unroll
        for (int i = 0; i < 32; ++i) {
            const float bc = c[i] + add; const size_t t = t0 + 32 * half + i;
            LAW[t * 128 + h * 32 + k] = bc;
            kend[(32 * half + i) * 32 + k] = kk[i] * __expf(blast - bc);
        }
        if (half == 0) DEC[(size_t)u * 32 + k] = __expf(blast);
        asm volatile("s_waitcnt lgkmcnt(0)" ::: "memory");
        float acc[32];
#pragma unroll
        for (int i = 0; i < 32; ++i) acc[i] = 0.f;
#pragma unroll 4
        for (int j = 0; j < 64; ++j) {
            const float vj = bf2f(Z[(t0 + j) * ZW + ZC_GV + h * 64 + lane]);
#pragma unroll
            for (int kq = 0; kq < 8; ++kq) { const f32x4 ke = *(const LAS f32x4*)(kend + j * 32 + kq * 4); acc[4 * kq] += ke[0] * vj; acc[4 * kq + 1] += ke[1] * vj; acc[4 * kq + 2] += ke[2] * vj; acc[4 * kq + 3] += ke[3] * vj; }
        }
#pragma unroll
        for (int kk = 0; kk < 32; ++kk) UPD[((size_t)u * 32 + kk) * 64 + lane] = acc[kk];
        asm volatile("s_waitcnt lgkmcnt(0)" ::: "memory");
    }
}
__device__ __forceinline__ void ph_gla_scan(const Params& P) {
    const int tz = opaque_tid();
    const float* UPD = (const float*)(P.ws + WS_UPD); const float* DEC = (const float*)(P.ws + WS_DEC); bf16_t* SP = (bf16_t*)(P.ws + WS_SPREV);
    for (int e = blockIdx.x * NTHR + tz; e < 32 * 2048; e += grid_size() * NTHR) {
        const int bh = e >> 11, kv = e & 2047, k = kv >> 6;
        float st = 0.f;
        for (int n8 = 0; n8 < 64; n8 += 8) {
            float dd[8], uu[8];
#pragma unroll
            for (int q = 0; q < 8; ++q) { const size_t u = (size_t)bh * 64 + n8 + q; dd[q] = DEC[u * 32 + k]; uu[q] = UPD[u * 2048 + kv]; }
#pragma unroll
            for (int q = 0; q < 8; ++q) { const size_t u = (size_t)bh * 64 + n8 + q; SP[u * 2048 + kv] = f2bf(st); st = dd[q] * st + uu[q]; }
        }
    }
}
__device__ __forceinline__ void ph_gla_y(const Params& P, int layer, LAS unsigned char* lds) {
    using at::f32x16; using at::s16x4; using at::vtr; using at::cvtpk;
    typedef unsigned u32x4 __attribute__((ext_vector_type(4)));
    const int tid = opaque_tid(); const int wid = __builtin_amdgcn_readfirstlane(tid >> 6), lane = tid & 63, r32 = lane & 31, hi = lane >> 5;
    LAS unsigned char* vl = lds + wid * 12288; LAS unsigned char* sl = vl + 8192;
    const bf16_t* Z = (const bf16_t*)(P.ws + WS_BIG + BIG_Z); const float* LA = (const float*)(P.ws + WS_BIG + BIG_LA); const bf16_t* SP = (const bf16_t*)(P.ws + WS_SPREV);
    bf16_t* YM = (bf16_t*)(P.ws + WS_YMIX); const float* gon = P.gla_on + layer * 64;
    const int vfo = ((lane >> 4) & 1) * 32 + (lane & 3) * 8 + (4 * hi + ((lane & 15) >> 2)) * 64;
    const int sfo = ((lane >> 4) & 1) * 32 + (lane & 3) * 8 + ((lane & 15) >> 2) * 64;
    for (int u = blockIdx.x * NWV + wid; u < 2048; u += grid_size() * NWV) {
        const int bh = u >> 6, n = u & 63, b = bh >> 2, h = bh & 3;
        const size_t t0 = (size_t)b * SEQ + n * 64;
#pragma unroll
        for (int p = 0; p < 8; ++p) {
            const int row = 8 * p + (lane >> 3), dv = 8 * (lane & 7);
            const u32x4 x = *(const u32x4*)(Z + (t0 + row) * ZW + ZC_GV + h * 64 + dv);
            *(LAS u32x4*)(vl + (dv >> 5) * 4096 + (row >> 3) * 512 + (row & 7) * 64 + (dv & 31) * 2) = x;
        }
#pragma unroll
        for (int p = 0; p < 4; ++p) {
            const int row = 8 * p + (lane >> 3), dv = 8 * (lane & 7);
            const u32x4 x = *(const u32x4*)(SP + ((size_t)u * 32 + row) * 64 + dv);
            *(LAS u32x4*)(sl + (dv >> 5) * 2048 + (row >> 3) * 512 + (row & 7) * 64 + (dv & 31) * 2) = x;
        }
        bf16x8 qfr[2][2], kfr[2][2];
#pragma unroll
        for (int blk = 0; blk < 2; ++blk)
#pragma unroll
            for (int ks = 0; ks < 2; ++ks) {
                const size_t t = t0 + 32 * blk + r32; const int k0 = 16 * ks + 8 * hi;
                const uint4 qraw = *(const uint4*)(Z + t * ZW + ZC_GQ + h * 32 + k0), kraw = *(const uint4*)(Z + t * ZW + ZC_GK + h * 32 + k0);
                const f32x4 b0 = *(const f32x4*)(LA + t * 128 + h * 32 + k0), b1 = *(const f32x4*)(LA + t * 128 + h * 32 + k0 + 4);
                const unsigned qw[4] = {qraw.x, qraw.y, qraw.z, qraw.w}, kw[4] = {kraw.x, kraw.y, kraw.z, kraw.w};
                const float bcv[8] = {b0[0], b0[1], b0[2], b0[3], b1[0], b1[1], b1[2], b1[3]};
                u32x4 qo, ko;
#pragma unroll
                for (int w = 0; w < 4; ++w) {
                    const float e0 = __expf(bcv[2 * w]), e1 = __expf(bcv[2 * w + 1]);
                    const float q0 = bf2f(qw[w] & 0xffff) * 0.17677669529663687f * e0, q1 = bf2f(qw[w] >> 16) * 0.17677669529663687f * e1;
                    const float k0f = bf2f(kw[w] & 0xffff) * __expf(-bcv[2 * w]), k1f = bf2f(kw[w] >> 16) * __expf(-bcv[2 * w + 1]);
                    qo[w] = cvtpk(q0, q1); ko[w] = cvtpk(k0f, k1f);
                }
                qfr[blk][ks] = __builtin_bit_cast(bf16x8, qo); kfr[blk][ks] = __builtin_bit_cast(bf16x8, ko);
            }
        f32x16 z16;
#pragma unroll
        for (int r = 0; r < 16; ++r) z16[r] = 0.f;
        f32x16 s00 = __builtin_amdgcn_mfma_f32_32x32x16_bf16(kfr[0][0], qfr[0][0], z16, 0, 0, 0); s00 = __builtin_amdgcn_mfma_f32_32x32x16_bf16(kfr[0][1], qfr[0][1], s00, 0, 0, 0);
        f32x16 s01 = __builtin_amdgcn_mfma_f32_32x32x16_bf16(kfr[0][0], qfr[1][0], z16, 0, 0, 0); s01 = __builtin_amdgcn_mfma_f32_32x32x16_bf16(kfr[0][1], qfr[1][1], s01, 0, 0, 0);
        f32x16 s11 = __builtin_amdgcn_mfma_f32_32x32x16_bf16(kfr[1][0], qfr[1][0], z16, 0, 0, 0); s11 = __builtin_amdgcn_mfma_f32_32x32x16_bf16(kfr[1][1], qfr[1][1], s11, 0, 0, 0);
#pragma unroll
        for (int r = 0; r < 16; ++r) { const int jl = (r & 3) + 8 * (r >> 2) + 4 * hi; if (jl > r32) { s00[r] = 0.f; s11[r] = 0.f; } }
        bf16x8 p00[2], p01[2], p11[2];
#pragma unroll
        for (int sp = 0; sp < 2; ++sp) {
            u32x4 a, c, d;
#pragma unroll
            for (int w = 0; w < 4; ++w) { a[w] = cvtpk(s00[8 * sp + 2 * w], s00[8 * sp + 2 * w + 1]); c[w] = cvtpk(s01[8 * sp + 2 * w], s01[8 * sp + 2 * w + 1]); d[w] = cvtpk(s11[8 * sp + 2 * w], s11[8 * sp + 2 * w + 1]); }
            p00[sp] = __builtin_bit_cast(bf16x8, a); p01[sp] = __builtin_bit_cast(bf16x8, c); p11[sp] = __builtin_bit_cast(bf16x8, d);
        }
        asm volatile("s_waitcnt lgkmcnt(0)" ::: "memory");
        f32x16 o[2][2];
#pragma unroll
        for (int vb = 0; vb < 2; ++vb) {
            o[vb][0] = z16; o[vb][1] = z16;
#pragma unroll
            for (int k2 = 0; k2 < 4; ++k2) {
                const s16x4 a0 = vtr(vl + vfo + vb * 4096 + k2 * 1024), a1 = vtr(vl + vfo + vb * 4096 + k2 * 1024 + 512);
                const bf16x8 vt = {a0[0], a0[1], a0[2], a0[3], a1[0], a1[1], a1[2], a1[3]};
                if (k2 < 2) { o[vb][0] = __builtin_amdgcn_mfma_f32_32x32x16_bf16(vt, p00[k2], o[vb][0], 0, 0, 0); o[vb][1] = __builtin_amdgcn_mfma_f32_32x32x16_bf16(vt, p01[k2], o[vb][1], 0, 0, 0); }
                else o[vb][1] = __builtin_amdgcn_mfma_f32_32x32x16_bf16(vt, p11[k2 - 2], o[vb][1], 0, 0, 0);
            }
#pragma unroll
            for (int ks = 0; ks < 2; ++ks) {
                const s16x4 a0 = vtr(sl + sfo + vb * 2048 + (2 * ks + hi) * 512), a1 = vtr(sl + sfo + vb * 2048 + (2 * ks + hi) * 512 + 256);
                const bf16x8 st = {a0[0], a0[1], a0[2], a0[3], a1[0], a1[1], a1[2], a1[3]};
                o[vb][0] = __builtin_amdgcn_mfma_f32_32x32x16_bf16(st, qfr[0][ks], o[vb][0], 0, 0, 0);
                o[vb][1] = __builtin_amdgcn_mfma_f32_32x32x16_bf16(st, qfr[1][ks], o[vb][1], 0, 0, 0);
            }
        }
#pragma unroll
        for (int ib = 0; ib < 2; ++ib) {
            const size_t t = t0 + 32 * ib + r32;
            float ss = 0.f;
#pragma unroll
            for (int r = 0; r < 16; ++r) ss += o[0][ib][r] * o[0][ib][r] + o[1][ib][r] * o[1][ib][r];
            ss = at::xhalf_sum(ss);
            const float rstd = rsqrtf(ss * (1.0f / 64.0f) + EPS);
#pragma unroll
            for (int vb = 0; vb < 2; ++vb)
#pragma unroll
                for (int g = 0; g < 4; ++g) {
                    const int v0 = 32 * vb + 8 * g + 4 * hi;
                    const uint2 rr = *(const uint2*)(Z + t * ZW + ZC_GR + h * 64 + v0); const f32x4 gn = *(const f32x4*)(gon + v0);
                    const float r0 = bf2f(rr.x & 0xffff), r1 = bf2f(rr.x >> 16), r2 = bf2f(rr.y & 0xffff), r3 = bf2f(rr.y >> 16);
                    const float y0 = o[vb][ib][4 * g] * rstd * gn[0] * r0 * sigmoidf_(r0), y1 = o[vb][ib][4 * g + 1] * rstd * gn[1] * r1 * sigmoidf_(r1);
                    const float y2 = o[vb][ib][4 * g + 2] * rstd * gn[2] * r2 * sigmoidf_(r2), y3 = o[vb][ib][4 * g + 3] * rstd * gn[3] * r3 * sigmoidf_(r3);
                    *(uint2*)(YM + t * 1024 + h * 64 + v0) = make_uint2(cvtpk(y0, y1), cvtpk(y2, y3));
                }
        }
        asm volatile("s_waitcnt lgkmcnt(0)" ::: "memory");
    }
}


template <int L> __device__ __forceinline__ void layer_body(const Params& P, const XcdBarrier& bar, unsigned char* lds) {
    constexpr int l = L; char* ws = P.ws; LAS unsigned char* ldsl = (LAS unsigned char*)lds;
    const bf16_t* HB = (const bf16_t*)(ws + WS_HB); const float* RS = (const float*)(ws + WS_RSTD);
    bf16_t* Z = (bf16_t*)(ws + WS_BIG + BIG_Z);
    {
        const char* wsm = ws + WS_WSM + (size_t)l * WSM_STRIDE;
        { EpiBf16_8 e{(bf16_t*)(ws + WS_E), 1024}; ph_gemm_fast<256, 256, true>(ldsl, (const bf16_t*)(ws + WS_PB) + (size_t)l * T * 256, (const bf16_t*)(wsm + WSM_WPLE), 1024, e); }
        { EpiZ8 e{Z, RS}; ph_gemm_fast<1024, 1024, true>(ldsl, HB, (const bf16_t*)(wsm + WSM_WIN), ZW, e); }
        xcd_barrier(bar);
        ph_prepB(P, l, lds);
        xcd_barrier(bar);
        { EpiBf16_8 e{(bf16_t*)(ws + WS_BIG + BIG_Q), 768}; ph_gemm_fast<256, ZW, true>(ldsl, Z + ZC_CQ, (const bf16_t*)(wsm + WSM_WUQ), 768, e); }
        { EpiBf16_8 e{(bf16_t*)(ws + WS_BIG + BIG_KV), 1024}; ph_gemm_fast<128, ZW, true>(ldsl, Z + ZC_CKV, (const bf16_t*)(wsm + WSM_WUKV), 1024, e); }
        __syncthreads();
        ph_gla_x(P, ldsl);
        xcd_barrier(bar);
        ph_prepD(P, l);
        ph_gla_scan(P);
        xcd_barrier(bar);
        if ((blockIdx.x >> 3) & 1) { ph_tconv_exp<(L == 0 ? MOE_FP8_L0 : MOE_FP8_L1)>(P, l, ldsl); }
        ph_attn_fast(P, ldsl);
        ph_gla_y(P, l, ldsl);
        if (!((blockIdx.x >> 3) & 1)) { __syncthreads(); ph_tconv_exp<(L == 0 ? MOE_FP8_L0 : MOE_FP8_L1)>(P, l, ldsl); }
        xcd_barrier(bar);
        { EpiResid8 e{l == 0 ? P.x : nullptr, (bf16_t*)(ws + WS_HB)}; ph_gemm_fast<1024, 1024, true>(ldsl, (const bf16_t*)(ws + WS_YMIX), (const bf16_t*)(wsm + WSM_WOUT), 1024, e); }
        xcd_barrier(bar);
        ph_router<(L == 0 ? MOE_FP8_L0 : MOE_FP8_L1)>(P, l, ldsl);
        xcd_barrier(bar);
        ph_moe_fast<true, (L == 0 ? MOE_FP8_L0 : MOE_FP8_L1)>(P, l, ldsl);
        xcd_barrier(bar);
        ph_moe_fast<false, (L == 0 ? MOE_FP8_L0 : MOE_FP8_L1)>(P, l, ldsl);
        xcd_barrier(bar);
        ph_combine<(L == 0 ? MOE_FP8_L0 : MOE_FP8_L1)>(P);
        xcd_barrier(bar);
        { EpiPle8 e{(const bf16_t*)(ws + WS_E), RS + 2 * T, (bf16_t*)(ws + WS_YMIX)}; ph_gemm_fast<1024, 1024, true>(ldsl, HB, (const bf16_t*)(wsm + WSM_WPG), 1024, e); }
        xcd_barrier(bar);
        ph_final(P, l);
        xcd_barrier(bar);
    }
}

__global__ void __launch_bounds__(NTHR, 2) mega_fwd(Params P) {
    extern __shared__ __attribute__((aligned(16))) unsigned char lds[];
    char* ws = P.ws;
    if (threadIdx.x == 0) *(uint4*)(lds + LDS_BAR_OFF) = make_uint4(0u, 0u, (unsigned)P.grid, 0u);
    if ((threadIdx.x & 63) == 0) *(volatile LAS int*)((LAS unsigned char*)lds + LDS_WID_OFF + hw_wave_key() * 4) = (int)(threadIdx.x >> 6);
    __syncthreads();
    const XcdBarrier bar = xcd_barrier_post((unsigned*)(ws + WS_CTL), (volatile LAS unsigned*)(lds + LDS_BAR_OFF));
    const bf16_t* HB = (const bf16_t*)(ws + WS_HB); const float* RS = (const float*)(ws + WS_RSTD);
    bf16_t* Z = (bf16_t*)(ws + WS_BIG + BIG_Z);
    ph_tconv_small(P, lds);
    ph_conv_bf16(P.p, (bf16_t*)(ws + WS_PB), (long)2 * T * 256 / 8);
    ph_prep_router(P);
    ph_init_h(P);
    ph_rope_table(P);
    xcd_barrier(bar);
    layer_body<0>(P, bar, lds);
    layer_body<1>(P, bar, lds);
}

extern "C" void kernel_launch(void* const* d_in, const int* in_sizes, int n_in, void* d_out, int out_size, void* d_ws, size_t ws_size, hipStream_t stream) {
    if (n_in != 30 || ws_size < WS_END) { fprintf(stderr, "kernel_launch: need 30 inputs and %zu bytes of workspace (got %d, %zu)\n", (size_t)WS_END, n_in, ws_size); return; }
    static int grid = 0;
    if (!grid) {
        int dev = 0, cus = 0, per_cu = 0;
        if (hipGetDevice(&dev) != hipSuccess || hipDeviceGetAttribute(&cus, hipDeviceAttributeMultiprocessorCount, dev) != hipSuccess) { fprintf(stderr, "kernel_launch: device query failed\n"); return; }
        if (hipFuncSetAttribute((const void*)mega_fwd, hipFuncAttributeMaxDynamicSharedMemorySize, LDS_BYTES) != hipSuccess) { fprintf(stderr, "kernel_launch: hipFuncSetAttribute failed\n"); return; }
        if (hipOccupancyMaxActiveBlocksPerMultiprocessor(&per_cu, (const void*)mega_fwd, NTHR, LDS_BYTES) != hipSuccess || per_cu < 1) { fprintf(stderr, "kernel_launch: occupancy query says %d\n", per_cu); return; }
        grid = cus;
    }
    Params P{};
    P.x = (const float*)d_in[0]; P.p = (const float*)d_in[1]; P.pos = (const int*)d_in[2];
    P.mix_norm = (const float*)d_in[3]; P.w_in = (const float*)d_in[4]; P.gla_wg = (const float*)d_in[5]; P.gla_bg = (const float*)d_in[6]; P.gla_on = (const float*)d_in[7];
    P.q_norm = (const float*)d_in[8]; P.w_uq = (const float*)d_in[9]; P.kv_norm = (const float*)d_in[10]; P.w_ukv = (const float*)d_in[11]; P.qkq = (const float*)d_in[12]; P.qkk = (const float*)d_in[13];
    P.pool_w = (const float*)d_in[14]; P.pool_s = (const float*)d_in[15]; P.w_out = (const float*)d_in[16]; P.ffn_norm = (const float*)d_in[17]; P.router_w = (const float*)d_in[18]; P.router_b = (const float*)d_in[19];
    P.moe_wg = (const float*)d_in[20]; P.moe_bg = (const float*)d_in[21]; P.moe_wu = (const float*)d_in[22]; P.moe_bu = (const float*)d_in[23]; P.moe_wd = (const float*)d_in[24]; P.moe_bd = (const float*)d_in[25];
    P.ple_wp = (const float*)d_in[26]; P.ple_gn = (const float*)d_in[27]; P.ple_wg = (const float*)d_in[28]; P.ple_pn = (const float*)d_in[29];
    P.out = (float*)d_out; P.ws = (char*)d_ws; P.grid = grid; P.pad_ = 0;
    (void)hipMemsetAsync((char*)d_ws + WS_CTL, 0, 65536, stream);
    hipLaunchKernelGGL(mega_fwd, dim3(grid), dim3(NTHR), LDS_BYTES, stream, P);
}
```

```cpp
#include <hip/hip_runtime.h>
#include <cstdio>
#include <cstdint>

typedef unsigned short bf16_t;
typedef short bf16x8 __attribute__((ext_vector_type(8)));
typedef float f32x4 __attribute__((ext_vector_type(4)));
typedef unsigned u32x4_t __attribute__((ext_vector_type(4)));

constexpr int T = 32768, DM = 1024, SEQ = 4096, NBATCH = 8, DEPTH = 2;
constexpr int ZW = 1536;
constexpr int ZC_CQ = 0, ZC_GV = 256, ZC_GR = 512, ZC_UP = 768, ZC_GQ = 1024, ZC_GK = 1152, ZC_CKV = 1280, ZC_KR = 1408, ZC_GLOW = 1440;
constexpr int NE = 32, TOPK = 4, DFF = 1024;
constexpr int HROWS = 139264;
constexpr float EPS = 1e-6f;

__host__ __device__ inline int zsrc(int n) {
    if (n < 256) return 784 + n;
    if (n < 512) return 256 + (n - 256);
    if (n < 768) return 528 + (n - 512);
    if (n < 1024) return 1200 + (n - 768);
    if (n < 1152) return n - 1024;
    if (n < 1280) return 128 + (n - 1152);
    if (n < 1408) return 1040 + (n - 1280);
    if (n < 1440) return 1168 + (n - 1408);
    if (n < 1456) return 512 + (n - 1440);
    return -1;
}

constexpr size_t MiB = 1024 * 1024;
constexpr size_t WS_CTL = 0;
constexpr size_t WS_HB = 1 * MiB;
constexpr size_t WS_RSTD = WS_HB + 64 * MiB;
constexpr size_t WS_WSM = WS_RSTD + 1 * MiB;
constexpr size_t WSM_WIN = 0, WSM_WUQ = 3 * MiB, WSM_WUKV = WSM_WUQ + 384 * 1024, WSM_WOUT = WSM_WUKV + 256 * 1024, WSM_WPG = WSM_WOUT + 2 * MiB,
                 WSM_WPLE = WSM_WPG + 2 * MiB, WSM_WR = WSM_WPLE + 512 * 1024, WSM_WPT = WSM_WR + 128 * 1024, WSM_STRIDE = WSM_WR + 128 * 1024 + 128 * 1024;
constexpr size_t WS_PB = WS_WSM + 2 * WSM_STRIDE;
constexpr size_t WS_W1 = WS_PB + 32 * MiB;
constexpr size_t WS_W2 = WS_W1 + 128 * MiB;
constexpr size_t WS_E = WS_W2 + 64 * MiB;
constexpr size_t WS_YMIX = WS_E + 64 * MiB;
constexpr size_t WS_Y = WS_YMIX + 64 * MiB;
constexpr size_t WS_UPD = WS_Y + 256 * MiB;
constexpr size_t WS_DEC = WS_UPD + 16 * MiB;
constexpr size_t WS_SPREV = WS_DEC + 1 * MiB;
constexpr size_t WS_TOPG = WS_SPREV + 8 * MiB;
constexpr size_t WS_LIST = WS_TOPG + 1 * MiB;
constexpr size_t WS_BIG = WS_LIST + 4 * MiB;
constexpr size_t BIG_Z = 0, BIG_Q = 96 * MiB, BIG_KV = BIG_Q + 48 * MiB, BIG_K = BIG_KV + 64 * MiB, BIG_LA = BIG_K + 48 * MiB;
constexpr size_t WS_ROPE = WS_BIG + 272 * MiB;
constexpr size_t WS_LRS = WS_ROPE + 4 * MiB;
constexpr size_t WS_LGT = WS_LRS + 4 * MiB;
constexpr size_t WS_END = WS_LGT + 4 * MiB;
constexpr int CTL_CNT = 4096;

constexpr bool MOE_FP8_L0 = true, MOE_FP8_L1 = true;
constexpr bool Z_FP8 = false, PG_FP8 = true;
constexpr size_t WS_H8 = WS_Y;
constexpr size_t WS_H8B = WS_BIG;
__device__ __forceinline__ float bf2f(bf16_t v) { return __uint_as_float(((unsigned)v) << 16); }
__device__ __forceinline__ bf16_t f2bf(float f) { unsigned u = __float_as_uint(f); u += 0x7FFFu + ((u >> 16) & 1u); return (bf16_t)(u >> 16); }
typedef float f32x2 __attribute__((ext_vector_type(2))); typedef __bf16 bf16x2h __attribute__((ext_vector_type(2)));
__device__ __forceinline__ unsigned pack2(float lo, float hi) { return (unsigned)f2bf(lo) | ((unsigned)f2bf(hi) << 16); }
__device__ __forceinline__ unsigned pack2h(float lo, float hi) { const f32x2 v = {lo, hi}; return __builtin_bit_cast(unsigned, __builtin_convertvector(v, bf16x2h)); }
__device__ __forceinline__ unsigned pack2v(f32x2 v) { return __builtin_bit_cast(unsigned, __builtin_convertvector(v, bf16x2h)); }
template <int CTRL> __device__ __forceinline__ float dppx(float v) { return __int_as_float(__builtin_amdgcn_update_dpp(0, __float_as_int(v), CTRL, 0xf, 0xf, true)); }
__device__ __forceinline__ unsigned pack4_fp8(float x0, float x1, float x2, float x3) { int w = 0; w = __builtin_amdgcn_cvt_pk_fp8_f32(x0, x1, w, false); w = __builtin_amdgcn_cvt_pk_fp8_f32(x2, x3, w, true); return (unsigned)w; }
__device__ __forceinline__ float wave_sum(float v) {
    v += dppx<0xB1>(v); v += dppx<0x4E>(v); v += dppx<0x141>(v); v += dppx<0x140>(v);
    { auto rr = __builtin_amdgcn_permlane16_swap(__float_as_uint(v), __float_as_uint(v), false, false); v = __uint_as_float(rr[0]) + __uint_as_float(rr[1]); }
    { auto rr = __builtin_amdgcn_permlane32_swap(__float_as_uint(v), __float_as_uint(v), false, false); v = __uint_as_float(rr[0]) + __uint_as_float(rr[1]); }
    return v;
}
__device__ __forceinline__ float wave_max(float v) {
    v = fmaxf(v, dppx<0xB1>(v)); v = fmaxf(v, dppx<0x4E>(v)); v = fmaxf(v, dppx<0x141>(v)); v = fmaxf(v, dppx<0x140>(v));
    { auto rr = __builtin_amdgcn_permlane16_swap(__float_as_uint(v), __float_as_uint(v), false, false); v = fmaxf(__uint_as_float(rr[0]), __uint_as_float(rr[1])); }
    { auto rr = __builtin_amdgcn_permlane32_swap(__float_as_uint(v), __float_as_uint(v), false, false); v = fmaxf(__uint_as_float(rr[0]), __uint_as_float(rr[1])); }
    return v;
}
namespace at {
typedef float f32x16 __attribute__((ext_vector_type(16)));
__device__ __forceinline__ float xhalf_max(float v) { auto rr = __builtin_amdgcn_permlane32_swap(__float_as_uint(v), __float_as_uint(v), false, false); return fmaxf(__uint_as_float(rr[0]), __uint_as_float(rr[1])); }
__device__ __forceinline__ float xhalf_sum(float v) { auto rr = __builtin_amdgcn_permlane32_swap(__float_as_uint(v), __float_as_uint(v), false, false); return __uint_as_float(rr[0]) + __uint_as_float(rr[1]); }
}
__device__ __forceinline__ float sigmoidf_(float x) { return __builtin_amdgcn_rcpf(1.0f + __builtin_amdgcn_exp2f(-1.4426950408889634f * x)); }


#define XB_TMO      128
#define XB_XCNT(j)  (256  + 64 * (j))
#define XB_XSUB(j)  (1280 + 64 * (j))
#define XB_XGEN(j)  (2304 + 64 * (j))
#define XB_TOP      3328
#define XB_TOPGEN   3392
#define XCD_BAR_WORDS 3456
#define XB_SPIN_CAP (1u << 18)
#define LAS __attribute__((address_space(3)))

constexpr int LDS_WID_OFF = 147456 - 16 - 256, LDS_GRID_OFF = 147456 - 16 + 8;
__device__ __forceinline__ int grid_size() { extern __shared__ __attribute__((aligned(16))) unsigned char lds_dyn_[]; return __builtin_amdgcn_readfirstlane(*(const volatile LAS int*)((LAS unsigned char*)lds_dyn_ + LDS_GRID_OFF)); }
__device__ __forceinline__ unsigned hw_wave_key() { return (unsigned)__builtin_amdgcn_s_getreg((5 << 11) | 4) & 63u; }
__device__ __forceinline__ int opaque_tid() {
    extern __shared__ __attribute__((aligned(16))) unsigned char lds_dyn_[];
    const int wv = __builtin_amdgcn_readfirstlane(*(const volatile LAS int*)((LAS unsigned char*)lds_dyn_ + LDS_WID_OFF + hw_wave_key() * 4));
    int ln; asm volatile("v_mbcnt_lo_u32_b32 %0, -1, 0\n\tv_mbcnt_hi_u32_b32 %0, -1, %0" : "=v"(ln));
    int t = wv * 64 + ln;
    asm volatile("" : "+v"(t)); return t;
}

__device__ __forceinline__ unsigned xb_ld(unsigned* p)              { return __hip_atomic_load(p, __ATOMIC_RELAXED, __HIP_MEMORY_SCOPE_AGENT); }
__device__ __forceinline__ unsigned xb_add(unsigned* p, unsigned v) { return __hip_atomic_fetch_add(p, v, __ATOMIC_RELAXED, __HIP_MEMORY_SCOPE_AGENT); }
__device__ __forceinline__ unsigned xb_xcc_id() { return (unsigned)__builtin_amdgcn_s_getreg((3 << 11) | 20) & 0xFu; }
#define XB_SPIN(cond, bar) do { unsigned _sp = 0; while (cond) { __builtin_amdgcn_s_sleep(1); \
    if ((++_sp & 255u) == 0u) { if (xb_ld(&(bar)[XB_TMO])) break; if (_sp > XB_SPIN_CAP) { atomicAdd(&(bar)[XB_TMO], 1u); break; } } } } while (0)

struct XcdBarrier {
    unsigned* bar; unsigned x;
    volatile LAS unsigned* st;
};

__device__ __forceinline__ XcdBarrier xcd_barrier_post(unsigned* bar, volatile LAS unsigned* st) {
    XcdBarrier b; b.bar = bar; b.x = xb_xcc_id(); b.st = st;
    if (threadIdx.x == 0) (void)xb_add(&bar[XB_XCNT(b.x)], 1u);
    return b;
}
__device__ __forceinline__ void xcd_barrier_complete(unsigned* bar, unsigned x, unsigned& nloc, unsigned& nx) {
    const unsigned G = (unsigned)grid_size();
    unsigned sum, cnt, mine, sp = 0u;
    for (;;) {
        sum = 0u; cnt = 0u; mine = 0u;
#pragma unroll
        for (unsigned j = 0; j < 16; ++j) { const unsigned c = xb_ld(&bar[XB_XCNT(j)]); sum += c; cnt += (c > 0u) ? 1u : 0u; mine = (j == x) ? c : mine; }
        if (sum == G) break;
        __builtin_amdgcn_s_sleep(1);
        if ((++sp & 255u) == 0u) { if (xb_ld(&bar[XB_TMO])) break; if (sp > XB_SPIN_CAP) { atomicAdd(&bar[XB_TMO], 1u); break; } }
    }
    nloc = mine > 0u ? mine : 1u; nx = cnt > 0u ? cnt : 1u;
}

__device__ __forceinline__ void xcd_barrier(const XcdBarrier& b) {
    asm volatile("s_waitcnt vmcnt(0)" ::: "memory");
    __syncthreads();
    if (opaque_tid() == 0) {
        unsigned* bar = b.bar;
        __builtin_amdgcn_s_waitcnt(0);
        unsigned nloc = b.st[0], nx = b.st[1];
        if (nloc == 0u) { xcd_barrier_complete(bar, b.x, nloc, nx); b.st[0] = nloc; b.st[1] = nx; }
        const unsigned old = xb_add(&bar[XB_XSUB(b.x)], 1u);
        const unsigned gen = old / nloc;
        if (old + 1u == (gen + 1u) * nloc) {
            __builtin_amdgcn_fence(__ATOMIC_RELEASE, "agent");
            asm volatile("s_waitcnt vmcnt(0)" ::: "memory");
            const unsigned og = xb_add(&bar[XB_TOP], 1u);
            const unsigned tg = og / nx;
            if (og + 1u == (tg + 1u) * nx) xb_add(&bar[XB_TOPGEN], 1u);
            else XB_SPIN(xb_ld(&bar[XB_TOPGEN]) == tg, bar);
            __builtin_amdgcn_fence(__ATOMIC_ACQUIRE, "agent");
            xb_add(&bar[XB_XGEN(b.x)], 1u);
            asm volatile("s_waitcnt vmcnt(0)" ::: "memory");
        } else {
            XB_SPIN(xb_ld(&bar[XB_XGEN(b.x)]) == gen, bar);
            __builtin_amdgcn_fence(__ATOMIC_ACQUIRE, "agent");
            asm volatile("s_waitcnt vmcnt(0)" ::: "memory");
        }
    }
    __syncthreads();
}

struct Params {
    const float *x, *p; const int* pos;
    const float *mix_norm, *w_in, *gla_wg, *gla_bg, *gla_on, *q_norm, *w_uq, *kv_norm, *w_ukv, *qkq, *qkk, *pool_w, *pool_s, *w_out, *ffn_norm, *router_w, *router_b,
        *moe_wg, *moe_bg, *moe_wu, *moe_bu, *moe_wd, *moe_bd, *ple_wp, *ple_gn, *ple_wg, *ple_pn;
    float* out; char* ws; int grid; int pad_;
};


constexpr int NTHR = 512, NWV = 8;
constexpr int LDS_BYTES = 147456;
constexpr int LDS_BAR_OFF = LDS_BYTES - 16;


__device__ __forceinline__ void ph_tconv_small(const Params& P, unsigned char* lds) {
    const int tz = opaque_tid(); const int tid = tz & 255, half = tz >> 8, tx = tid & 63, ty = tid >> 6;
    float (*tile)[65] = (float (*)[65])(lds + half * 16640);
    constexpr int U_IN = 24 * 16, U_UQ = 12 * 4, U_KV = 16 * 2, U_OUT = 16 * 16, U_PG = 16 * 16, U_PP = 16 * 4, U_L = U_IN + U_UQ + U_KV + U_OUT + U_PG + U_PP;
    static_assert((2 * U_L) % 2 == 0, "pairs of units");
    for (int u0 = blockIdx.x * 2; u0 < 2 * U_L; u0 += grid_size() * 2) {
        const int u = u0 + half; const int l = u / U_L; int r = u % U_L;
        char* wsm = P.ws + WS_WSM + (size_t)l * WSM_STRIDE;
        const float* src; const float* gain; bf16_t* dst; int N, K, ld, mode; bool f8 = false;
        if (r < U_IN) { src = P.w_in + (size_t)l * 1024 * 1456; gain = P.mix_norm + l * 1024; dst = (bf16_t*)(wsm + WSM_WIN); N = ZW; K = 1024; ld = 1456; mode = 1; f8 = Z_FP8; }
        else if ((r -= U_IN) < U_UQ) { src = P.w_uq + (size_t)l * 256 * 768; gain = P.q_norm + l * 256; dst = (bf16_t*)(wsm + WSM_WUQ); N = 768; K = 256; ld = 768; mode = 0; }
        else if ((r -= U_UQ) < U_KV) { src = P.w_ukv + (size_t)l * 128 * 1024; gain = P.kv_norm + l * 128; dst = (bf16_t*)(wsm + WSM_WUKV); N = 1024; K = 128; ld = 1024; mode = 0; }
        else if ((r -= U_KV) < U_OUT) { src = P.w_out + (size_t)l * 1024 * 1024; gain = nullptr; dst = (bf16_t*)(wsm + WSM_WOUT); N = 1024; K = 1024; ld = 1024; mode = 0; }
        else if ((r -= U_OUT) < U_PG) { src = P.ple_wg + (size_t)l * 1024 * 1024; gain = P.ple_gn + l * 1024; dst = (bf16_t*)(wsm + WSM_WPG); N = 1024; K = 1024; ld = 1024; mode = 0; f8 = PG_FP8; }
        else { r -= U_PG; src = P.ple_wp + (size_t)l * 256 * 1024; gain = nullptr; dst = (bf16_t*)(wsm + WSM_WPLE); N = 1024; K = 256; ld = 1024; mode = 0; }
        const int nx = N / 64; const int bx = r % nx, by = r / nx;
        const int n0 = bx * 64, k0 = by * 64, n = n0 + tx;
        const int col = (mode == 1) ? zsrc(n) : n;
        float v[16], gn[16];
        const int colc = col >= 0 ? col : 0;
#pragma unroll
        for (int i = 0; i < 16; ++i) { const int k = k0 + ty + 4 * i; v[i] = src[(long)k * ld + colc]; gn[i] = gain ? gain[k] : 1.0f; }
#pragma unroll
        for (int i = 0; i < 16; ++i) tile[ty + 4 * i][tx] = (col >= 0) ? v[i] * gn[i] : 0.f;
        __syncthreads();
        const int nl = tid >> 2, ks = (tid & 3) * 16;
        unsigned w0 = pack2(tile[ks + 0][nl], tile[ks + 1][nl]), w1 = pack2(tile[ks + 2][nl], tile[ks + 3][nl]), w2 = pack2(tile[ks + 4][nl], tile[ks + 5][nl]), w3 = pack2(tile[ks + 6][nl], tile[ks + 7][nl]);
        unsigned w4 = pack2(tile[ks + 8][nl], tile[ks + 9][nl]), w5 = pack2(tile[ks + 10][nl], tile[ks + 11][nl]), w6 = pack2(tile[ks + 12][nl], tile[ks + 13][nl]), w7 = pack2(tile[ks + 14][nl], tile[ks + 15][nl]);
        if (f8) {
            *(uint4*)((unsigned char*)dst + (long)(n0 + nl) * K + k0 + ks) = make_uint4(pack4_fp8(tile[ks + 0][nl] * 64.f, tile[ks + 1][nl] * 64.f, tile[ks + 2][nl] * 64.f, tile[ks + 3][nl] * 64.f), pack4_fp8(tile[ks + 4][nl] * 64.f, tile[ks + 5][nl] * 64.f, tile[ks + 6][nl] * 64.f, tile[ks + 7][nl] * 64.f),
                                                                                      pack4_fp8(tile[ks + 8][nl] * 64.f, tile[ks + 9][nl] * 64.f, tile[ks + 10][nl] * 64.f, tile[ks + 11][nl] * 64.f), pack4_fp8(tile[ks + 12][nl] * 64.f, tile[ks + 13][nl] * 64.f, tile[ks + 14][nl] * 64.f, tile[ks + 15][nl] * 64.f));
        } else {
        uint4* o = (uint4*)(dst + (long)(n0 + nl) * K + k0 + ks);
        o[0] = make_uint4(w0, w1, w2, w3); o[1] = make_uint4(w4, w5, w6, w7); }
        __syncthreads();
    }
}

template <bool FP8> __device__ __forceinline__ void ph_tconv_exp(const Params& P, int layer, LAS unsigned char* lds) {
    const int tid = opaque_tid();
    const int kq = tid >> 6, c4 = tid & 63;
    constexpr int PITCH = FP8 ? 68 : 136;
    LAS unsigned char* tile = lds;
    const float* gain = P.ffn_norm + layer * 1024;
    const int nunits = 3 * 32 * 16 * 4;
    for (int u = blockIdx.x; u < nunits; u += grid_size()) {
        const int nt = u & 3, kt = (u >> 2) & 15, e = (u >> 6) & 31, mat = u >> 11;
        const float* src = (mat == 0 ? P.moe_wg : mat == 1 ? P.moe_wu : P.moe_wd) + ((size_t)layer * 32 + e) * 1024 * 1024 + (size_t)(kt * 64) * 1024 + nt * 256 + c4 * 4;
        f32x4 v[2][4];
#pragma unroll
        for (int g = 0; g < 2; ++g)
#pragma unroll
            for (int r = 0; r < 4; ++r) v[g][r] = *(const f32x4*)(src + (size_t)(32 * g + 4 * kq + r) * 1024);
        const float sc = FP8 ? 64.0f : 1.0f;
#pragma unroll
        for (int g = 0; g < 2; ++g)
#pragma unroll
            for (int r = 0; r < 4; ++r) v[g][r] *= (mat < 2 ? gain[kt * 64 + 32 * g + 4 * kq + r] : 1.0f) * sc;
        __syncthreads();
#pragma unroll
        for (int g = 0; g < 2; ++g)
#pragma unroll
            for (int j = 0; j < 4; ++j) {
                if constexpr (FP8) *(LAS unsigned*)(tile + (c4 * 4 + j) * PITCH + 32 * g + 4 * kq) = pack4_fp8(v[g][0][j], v[g][1][j], v[g][2][j], v[g][3][j]);
                else { LAS unsigned* wp_ = (LAS unsigned*)(tile + (c4 * 4 + j) * PITCH + (32 * g + 4 * kq) * 2); wp_[0] = pack2(v[g][0][j], v[g][1][j]); wp_[1] = pack2(v[g][2][j], v[g][3][j]); }
            }
        __syncthreads();
        typedef unsigned u32x4 __attribute__((ext_vector_type(4)));
        unsigned char* dst = (mat < 2) ? (unsigned char*)(P.ws + WS_W1) + (size_t)e * 2048 * (FP8 ? 1024 : 2048) : (unsigned char*)(P.ws + WS_W2) + (size_t)e * 1024 * (FP8 ? 1024 : 2048);
        constexpr int CPR = FP8 ? 4 : 8;
#pragma unroll
        for (int j = 0; j < 256 * CPR / NTHR; ++j) {
            const int id = tid + NTHR * j, nl = id / CPR, ck = id % CPR, n = nt * 256 + nl;
            const int drow = (mat == 2) ? n : ((n >> 7) * 256 + (n & 127) + (mat == 1 ? 128 : 0));
            const LAS unsigned* rp = (const LAS unsigned*)(tile + nl * PITCH + ck * 16);
            const u32x4 o = {rp[0], rp[1], rp[2], rp[3]};
            *(u32x4*)(dst + (size_t)drow * (FP8 ? 1024 : 2048) + (size_t)kt * (FP8 ? 64 : 128) + ck * 16) = o;
        }
    }
    __syncthreads();
}
__device__ __forceinline__ void ph_conv_bf16(const float* src, bf16_t* dst, long n8) {
    const int tz = opaque_tid(); const int G = grid_size() * NTHR;
    for (int i0 = blockIdx.x * NTHR + tz; i0 < (int)n8; i0 += 4 * G) {
        float4 a[4], b[4];
#pragma unroll
        for (int q = 0; q < 4; ++q) { const int i = i0 + q * G; if (i < (int)n8) { a[q] = ((const float4*)src)[2 * (size_t)i]; b[q] = ((const float4*)src)[2 * (size_t)i + 1]; } }
#pragma unroll
        for (int q = 0; q < 4; ++q) { const int i = i0 + q * G; if (i < (int)n8) ((uint4*)dst)[i] = make_uint4(pack2(a[q].x, a[q].y), pack2(a[q].z, a[q].w), pack2(b[q].x, b[q].y), pack2(b[q].z, b[q].w)); }
    }
}
__device__ __forceinline__ void ph_prep_router(const Params& P) {
    const int tz = opaque_tid();
    for (int i = blockIdx.x * NTHR + tz; i < 2 * 4 * 64 * 64; i += grid_size() * NTHR) {
        const int l = i >> 14, g = (i >> 12) & 3, d = (i >> 6) & 63, c = i & 63;
        ((bf16_t*)(P.ws + WS_WSM + (size_t)l * WSM_STRIDE + WSM_WPT))[(g * 64 + d) * 64 + c] = f2bf(P.pool_w[(size_t)l * 16384 + (g * 64 + c) * 64 + d]);
    }
    for (int i = blockIdx.x * NTHR + tz; i < 2 * 32 * 1024; i += grid_size() * NTHR) {
        const int l = i >> 15, e = (i >> 10) & 31, k = i & 1023;
        bf16_t* Wr = (bf16_t*)(P.ws + WS_WSM + (size_t)l * WSM_STRIDE + WSM_WR);
        const float w = P.router_w[((size_t)l * 1024 + k) * 32 + e] * P.ffn_norm[l * 1024 + k];
        const bf16_t whi = f2bf(w); Wr[e * 1024 + k] = whi; Wr[32 * 1024 + e * 1024 + k] = f2bf(w - bf2f(whi));
    }
}


__device__ __forceinline__ void ph_rope_table(const Params& P) {
    const int tz = opaque_tid();
    float* RT = (float*)(P.ws + WS_ROPE);
    for (int e = blockIdx.x * NTHR + tz; e < T * 16; e += grid_size() * NTHR) {
        const int t = e >> 4, i = e & 15;
        const float inv = exp2f(-(float)(2 * i) * (1.0f / 32.0f) * 13.287712379549449f);
        const float ang = (float)P.pos[t] * inv;
        RT[(size_t)t * 32 + i] = cosf(ang); RT[(size_t)t * 32 + 16 + i] = sinf(ang);
    }
}

__device__ __forceinline__ void ph_init_h(const Params& P) {
    const int tz = opaque_tid(); const int wid = tz >> 6, lane = tz & 63;
    bf16_t* HB = (bf16_t*)(P.ws + WS_HB); float* RS = (float*)(P.ws + WS_RSTD);
    for (int t0 = (blockIdx.x * NWV + wid) * 4; t0 < T; t0 += grid_size() * NWV * 4) {
        float4 v[4][4];
#pragma unroll
        for (int tt = 0; tt < 4; ++tt)
#pragma unroll
            for (int i = 0; i < 4; ++i) v[tt][i] = *(const float4*)(P.x + (size_t)(t0 + tt) * 1024 + i * 256 + lane * 4);
#pragma unroll
        for (int tt = 0; tt < 4; ++tt) {
            float ss = 0.f;
#pragma unroll
            for (int i = 0; i < 4; ++i) ss += v[tt][i].x * v[tt][i].x + v[tt][i].y * v[tt][i].y + v[tt][i].z * v[tt][i].z + v[tt][i].w * v[tt][i].w;
            ss = wave_sum(ss);
            if (lane == 0) RS[t0 + tt] = rsqrtf(ss * (1.0f / 1024.0f) + EPS);
#pragma unroll
            for (int i = 0; i < 4; ++i) *(uint2*)(HB + (size_t)(t0 + tt) * 1024 + i * 256 + lane * 4) = make_uint2(pack2(v[tt][i].x, v[tt][i].y), pack2(v[tt][i].z, v[tt][i].w));
            if constexpr (Z_FP8) {
#pragma unroll
                for (int i = 0; i < 4; ++i) *(unsigned*)((unsigned char*)(P.ws + WS_H8) + (size_t)(t0 + tt) * 1024 + i * 256 + lane * 4) = pack4_fp8(v[tt][i].x, v[tt][i].y, v[tt][i].z, v[tt][i].w);
            }
        }
    }
}

__device__ __forceinline__ void ph_prepB(const Params& P, int layer, unsigned char* lds) {
    float* wg = (float*)lds;
    const int tid = opaque_tid(), wid = tid >> 6, lane = tid & 63;
    for (int i = tid; i < 16 * 128; i += NTHR) wg[i] = P.gla_wg[(size_t)layer * 2048 + i];
    __syncthreads();
    bf16_t* Z = (bf16_t*)(P.ws + WS_BIG + BIG_Z); float* LA = (float*)(P.ws + WS_BIG + BIG_LA); bf16_t* YM = (bf16_t*)(P.ws + WS_YMIX);
    const float* bg = P.gla_bg + layer * 128; const float* psc = P.pool_s + layer * 256;
    const float bg0 = bg[lane], bg1 = bg[lane + 64];
    for (int t0 = (blockIdx.x * NWV + wid) * 2; t0 < T; t0 += grid_size() * NWV * 2) {
        uint2 cq[2]; unsigned ckv[2]; float gl[2];
#pragma unroll
        for (int tt = 0; tt < 2; ++tt) { const bf16_t* zr = Z + (size_t)(t0 + tt) * ZW; cq[tt] = *(const uint2*)(zr + ZC_CQ + lane * 4); ckv[tt] = *(const unsigned*)(zr + ZC_CKV + lane * 2); gl[tt] = (lane < 16) ? bf2f(zr[ZC_GLOW + lane]) : 0.f; }
#pragma unroll
        for (int tt = 0; tt < 2; ++tt) {
            bf16_t* zr = Z + (size_t)(t0 + tt) * ZW;
            {
                const float a = bf2f(cq[tt].x & 0xffff), b = bf2f(cq[tt].x >> 16), c = bf2f(cq[tt].y & 0xffff), d = bf2f(cq[tt].y >> 16);
                const float r = rsqrtf(wave_sum(a * a + b * b + c * c + d * d) * (1.0f / 256.0f) + EPS);
                *(uint2*)(zr + ZC_CQ + lane * 4) = make_uint2(pack2(a * r, b * r), pack2(c * r, d * r));
            }
            {
                const float a = bf2f(ckv[tt] & 0xffff), b = bf2f(ckv[tt] >> 16);
                const float r = rsqrtf(wave_sum(a * a + b * b) * (1.0f / 128.0f) + EPS);
                *(unsigned*)(zr + ZC_CKV + lane * 2) = pack2(a * r, b * r);
            }
            {
                float l0 = bg0, l1 = bg1;
#pragma unroll
                for (int r = 0; r < 16; ++r) { const float g = __uint_as_float(__builtin_amdgcn_readlane(__float_as_uint(gl[tt]), r)); l0 += g * wg[r * 128 + lane]; l1 += g * wg[r * 128 + lane + 64]; }
                const float a0 = fminf(l0, 0.f) - log1pf(__expf(-fabsf(l0))), a1 = fminf(l1, 0.f) - log1pf(__expf(-fabsf(l1)));
                LA[(size_t)(t0 + tt) * 128 + lane] = a0 * (1.0f / 16.0f); LA[(size_t)(t0 + tt) * 128 + lane + 64] = a1 * (1.0f / 16.0f);
            }
        }
    }
    const bf16_t* WpT = (const bf16_t*)(P.ws + WS_WSM + (size_t)layer * WSM_STRIDE + WSM_WPT);
    const int fr = lane & 15, fq = lane >> 4;
    for (int u = blockIdx.x * NWV + wid; u < T / 16; u += grid_size() * NWV) {
        const int t = u * 16 + fr, sq = t & (SEQ - 1);
        uint2 yout[4][4];
#pragma unroll
        for (int gi = 0; gi < 4; ++gi) {
            const int w = 2 << gi; const int cnt = (sq + 1 < w) ? sq + 1 : w; const float rc = 1.0f / (float)cnt;
            bf16x8 af[2];
#pragma unroll
            for (int ks = 0; ks < 2; ++ks) {
                const bf16_t* up = Z + (size_t)t * ZW + ZC_UP + gi * 64 + ks * 32 + fq * 8;
                float acc[8], u0[8];
#pragma unroll
                for (int j = 0; j < 16; ++j) if (j < w) {
                    const int jj = (j < cnt) ? j : 0; const float msk = (j < cnt) ? 1.0f : 0.f;
                    const uint4 x = *(const uint4*)(up - (long)jj * ZW);
                    const float xv[8] = {bf2f(x.x & 0xffff), bf2f(x.x >> 16), bf2f(x.y & 0xffff), bf2f(x.y >> 16), bf2f(x.z & 0xffff), bf2f(x.z >> 16), bf2f(x.w & 0xffff), bf2f(x.w >> 16)};
#pragma unroll
                    for (int e = 0; e < 8; ++e) { if (j == 0) { u0[e] = xv[e]; acc[e] = xv[e]; } else acc[e] += msk * xv[e]; }
                }
                typedef unsigned u32x4 __attribute__((ext_vector_type(4)));
                const u32x4 pk = {pack2(acc[0] * rc - u0[0], acc[1] * rc - u0[1]), pack2(acc[2] * rc - u0[2], acc[3] * rc - u0[3]), pack2(acc[4] * rc - u0[4], acc[5] * rc - u0[5]), pack2(acc[6] * rc - u0[6], acc[7] * rc - u0[7])};
                af[ks] = __builtin_bit_cast(bf16x8, pk);
            }
#pragma unroll
            for (int nb = 0; nb < 4; ++nb) {
                f32x4 acc = {0.f, 0.f, 0.f, 0.f};
#pragma unroll
                for (int ks = 0; ks < 2; ++ks) { const bf16x8 bfr = *(const bf16x8*)(WpT + ((size_t)gi * 64 + nb * 16 + fr) * 64 + ks * 32 + fq * 8); acc = __builtin_amdgcn_mfma_f32_16x16x32_bf16(bfr, af[ks], acc, 0, 0, 0); }
                const int d0 = nb * 16 + fq * 4; const f32x4 sc = *(const f32x4*)(psc + gi * 64 + d0);
                yout[gi][nb] = make_uint2(pack2(acc[0] * sc[0], acc[1] * sc[1]), pack2(acc[2] * sc[2], acc[3] * sc[3]));
            }
        }
#pragma unroll
        for (int gi = 0; gi < 4; ++gi)
#pragma unroll
            for (int nb = 0; nb < 4; ++nb) *(uint2*)(YM + (size_t)t * 1024 + 768 + gi * 64 + nb * 16 + fq * 4) = yout[gi][nb];
    }
}

template <bool DRY = false> __device__ __forceinline__ void ph_prepD(const Params& P, int layer) {
    const int tid = opaque_tid(), wid = tid >> 6, lane = tid & 63, g = lane >> 4, li = lane & 15;
    bf16_t* Z = (bf16_t*)(P.ws + WS_BIG + BIG_Z); bf16_t* Q = (bf16_t*)(P.ws + WS_BIG + BIG_Q); const bf16_t* KV = (const bf16_t*)(P.ws + WS_BIG + BIG_KV); bf16_t* Kd = DRY ? (bf16_t*)(P.ws + WS_Y + 64 * MiB) : (bf16_t*)(P.ws + WS_BIG + BIG_K);
    bf16_t* QW = DRY ? (bf16_t*)(P.ws + WS_Y) : Q;
    const float* RT = (const float*)(P.ws + WS_ROPE);
    const bool act = li < 12, rope = li >= 8 && li < 12, x1part = li < 10;
    const int e0 = act ? 8 * li : 0;
    float gq[8], gk[8];
#pragma unroll
    for (int j = 0; j < 8; ++j) { gq[j] = P.qkq[layer * 96 + e0 + j]; gk[j] = P.qkk[layer * 96 + e0 + j]; }
    const float qscale = 0.10206207261596577f * 1.4426950408889634f;
    for (int t = blockIdx.x * NWV + wid; t < T; t += grid_size() * NWV) {
        typedef unsigned u32x4 __attribute__((ext_vector_type(4)));
        u32x4 qraw[2], kraw[2];
        const int i0 = 8 * (li & 1);
        const f32x4 c0 = *(const f32x4*)(RT + (size_t)t * 32 + i0), c1 = *(const f32x4*)(RT + (size_t)t * 32 + i0 + 4), s0 = *(const f32x4*)(RT + (size_t)t * 32 + 16 + i0), s1 = *(const f32x4*)(RT + (size_t)t * 32 + 16 + i0 + 4);
        const float cs[8] = {c0[0], c0[1], c0[2], c0[3], c1[0], c1[1], c1[2], c1[3]}, sn[8] = {s0[0], s0[1], s0[2], s0[3], s1[0], s1[1], s1[2], s1[3]};
#pragma unroll
        for (int ps = 0; ps < 2; ++ps) {
            const int h = ps * 4 + g;
            qraw[ps] = *(const u32x4*)(Q + (size_t)t * 768 + h * 96 + e0);
            kraw[ps] = (li < 8) ? *(const u32x4*)(KV + (size_t)t * 1024 + h * 128 + e0) : *(const u32x4*)(Z + (size_t)t * ZW + ZC_KR + (rope ? 8 * (li - 8) : 0));
        }
#pragma unroll
        for (int ps = 0; ps < 2; ++ps) {
            const int h = ps * 4 + g;
#pragma unroll
            for (int qk = 0; qk < 2; ++qk) {
                const u32x4 raw = qk == 0 ? qraw[ps] : kraw[ps];
                float x[8];
#pragma unroll
                for (int w = 0; w < 4; ++w) { x[2 * w] = act ? bf2f(raw[w] & 0xffff) : 0.f; x[2 * w + 1] = act ? bf2f(raw[w] >> 16) : 0.f; }
                float ss = 0.f;
#pragma unroll
                for (int j = 0; j < 8; ++j) ss += x[j] * x[j];
                ss += dppx<0xB1>(ss); ss += dppx<0x4E>(ss); ss += dppx<0x141>(ss); ss += dppx<0x140>(ss);
                const float r = rsqrtf(ss * (1.0f / 96.0f) + EPS);
                float y[8];
#pragma unroll
                for (int j = 0; j < 8; ++j) {
                    const float xn = x[j] * r * (qk == 0 ? gq[j] : gk[j]);
                    const float pr = dppx<0x4E>(xn);
                    const float rot = x1part ? (xn * cs[j] - pr * sn[j]) : (xn * cs[j] + pr * sn[j]);
                    y[j] = (rope ? rot : xn) * (qk == 0 ? qscale : 1.0f);
                }
                const u32x4 o = {pack2(y[0], y[1]), pack2(y[2], y[3]), pack2(y[4], y[5]), pack2(y[6], y[7])};
                if (act) { if (qk == 0) *(u32x4*)(QW + (size_t)t * 768 + h * 96 + e0) = o; else *(u32x4*)(Kd + ((size_t)t * 8 + h) * 96 + e0) = o; }
            }
        }
    }
}

template <bool FP8> __device__ __forceinline__ void ph_router(const Params& P, int layer, LAS unsigned char* lds) {
    using at::f32x16;
    const int tid = opaque_tid(); const int wid = __builtin_amdgcn_readfirstlane(tid >> 6), lane = tid & 63, r32 = lane & 31, hi = lane >> 5;
    const bf16_t* HB = (const bf16_t*)(P.ws + WS_HB); float* RS1 = (float*)(P.ws + WS_RSTD) + T;
    const bf16_t* WrH = (const bf16_t*)(P.ws + WS_WSM + (size_t)layer * WSM_STRIDE + WSM_WR); const bf16_t* WrL = WrH + 32 * 1024;
    const float* rb = P.router_b + layer * 32;
    unsigned* cnt = (unsigned*)(P.ws + WS_CTL) + CTL_CNT + layer * 32;
    int* LIST = (int*)(P.ws + WS_LIST);
    constexpr int MAXU = 4;
    LAS unsigned* lcnt = (LAS unsigned*)lds; LAS unsigned* lbase = lcnt + 32;
    LAS unsigned* ent = lbase + 32;
    LAS float* entg = (LAS float*)(ent + NWV * MAXU * 128);
    LAS float* entr = entg + NWV * MAXU * 128;
    if (tid < 32) lcnt[tid] = 0u;
    __syncthreads();
    int nu = 0;
    for (int u = blockIdx.x * 4 + wid; wid < 4 && u < T / 32; u += grid_size() * 4, ++nu) {
        const size_t trow = (size_t)u * 32 + r32;
        f32x16 acc;
#pragma unroll
        for (int r = 0; r < 16; ++r) acc[r] = 0.f;
        float ss = 0.f;
        const bf16_t* hp = HB + trow * 1024 + hi * 8; const bf16_t* wh = WrH + (size_t)r32 * 1024 + hi * 8; const bf16_t* wl_ = WrL + (size_t)r32 * 1024 + hi * 8;
        for (int k8 = 0; k8 < 64; k8 += 8) {
            bf16x8 hf[8], a0[8], a1[8];
#pragma unroll
            for (int q = 0; q < 8; ++q) { hf[q] = *(const bf16x8*)(hp + (k8 + q) * 16); a0[q] = *(const bf16x8*)(wh + (k8 + q) * 16); a1[q] = *(const bf16x8*)(wl_ + (k8 + q) * 16); }
#pragma unroll
            for (int q = 0; q < 8; ++q) {
                acc = __builtin_amdgcn_mfma_f32_32x32x16_bf16(a0[q], hf[q], acc, 0, 0, 0);
                acc = __builtin_amdgcn_mfma_f32_32x32x16_bf16(a1[q], hf[q], acc, 0, 0, 0);
                float hv[8];
#pragma unroll
                for (int j = 0; j < 8; ++j) { hv[j] = bf2f((bf16_t)hf[q][j]); ss += hv[j] * hv[j]; }
                if constexpr (FP8) *(uint2*)((unsigned char*)(P.ws + WS_YMIX) + trow * 1024 + (k8 + q) * 16 + hi * 8) = make_uint2(pack4_fp8(hv[0], hv[1], hv[2], hv[3]), pack4_fp8(hv[4], hv[5], hv[6], hv[7]));
            }
        }
        ss = at::xhalf_sum(ss);
        const float rstd = rsqrtf(ss * (1.0f / 1024.0f) + EPS);
        if (hi == 0) RS1[trow] = rstd;
        float lg[16];
#pragma unroll
        for (int r = 0; r < 16; ++r) lg[r] = acc[r] * rstd + rb[(r & 3) + 8 * (r >> 2) + 4 * hi];
        float cv[8]; int ci[8];
#pragma unroll
        for (int k = 0; k < 4; ++k) {
            float best = -INFINITY; int bi = 0;
#pragma unroll
            for (int r = 0; r < 16; ++r) { const bool ok = lg[r] > best; best = ok ? lg[r] : best; bi = ok ? r : bi; }
#pragma unroll
            for (int r = 0; r < 16; ++r) lg[r] = (r == bi) ? -INFINITY : lg[r];
            cv[k] = best; ci[k] = (bi & 3) + 8 * (bi >> 2) + 4 * hi;
        }
#pragma unroll
        for (int k = 0; k < 4; ++k) {
            { auto rr = __builtin_amdgcn_permlane32_swap(__float_as_uint(cv[k]), __float_as_uint(cv[k]), false, false); cv[4 + k] = __uint_as_float(hi ? rr[0] : rr[1]); }
            { auto rr = __builtin_amdgcn_permlane32_swap((unsigned)ci[k], (unsigned)ci[k], false, false); ci[4 + k] = (int)(hi ? rr[0] : rr[1]); }
        }
        float tv[4]; int ti[4];
#pragma unroll
        for (int k = 0; k < 4; ++k) {
            float best = -INFINITY; int be = 64, bj = 0;
#pragma unroll
            for (int j = 0; j < 8; ++j) { const bool ok = (cv[j] > best) || (cv[j] == best && ci[j] < be); best = ok ? cv[j] : best; be = ok ? ci[j] : be; bj = ok ? j : bj; }
#pragma unroll
            for (int j = 0; j < 8; ++j) cv[j] = (j == bj) ? -INFINITY : cv[j];
            tv[k] = best; ti[k] = be;
        }
        const float e1 = __expf(tv[1] - tv[0]), e2 = __expf(tv[2] - tv[0]), e3 = __expf(tv[3] - tv[0]);
        const float invs = __builtin_amdgcn_rcpf(1.0f + e1 + e2 + e3);
        if (hi == 0 && nu < MAXU) {
            const float gt[4] = {invs, e1 * invs, e2 * invs, e3 * invs};
            const int base = ((wid * MAXU + nu) * 32 + r32) * 4;
#pragma unroll
            for (int k = 0; k < 4; ++k) {
                const unsigned rk = __hip_atomic_fetch_add(&lcnt[ti[k]], 1u, __ATOMIC_RELAXED, __HIP_MEMORY_SCOPE_WORKGROUP);
                ent[base + k] = (unsigned)ti[k] | (rk << 8); entg[base + k] = gt[k];
            }
            entr[(wid * MAXU + nu) * 32 + r32] = rstd;
        }
    }
    __syncthreads();
    if (tid < 32) lbase[tid] = atomicAdd(&cnt[tid], lcnt[tid]);
    __syncthreads();
    {
        int k2 = 0;
        for (int u = blockIdx.x * 4 + wid; wid < 4 && u < T / 32 && k2 < MAXU; u += grid_size() * 4, ++k2) {
#pragma unroll
            for (int h2 = 0; h2 < 2; ++h2) {
                const int i = lane + 64 * h2; const int tl = i >> 2;
                const unsigned code = ent[((wid * MAXU + k2) * 32) * 4 + i]; const int e = (int)(code & 255u); const unsigned pos = lbase[e] + (code >> 8);
                LIST[(size_t)e * T + pos] = (int)(((unsigned)u * 32 + tl) * 4 + (i & 3));
                ((float*)(P.ws + WS_LRS))[(size_t)e * T + pos] = entr[(wid * MAXU + k2) * 32 + tl];
                ((float*)(P.ws + WS_LGT))[(size_t)e * T + pos] = entg[((wid * MAXU + k2) * 32) * 4 + i];
            }
        }
    }
    __syncthreads();
}

__device__ __forceinline__ void unpack8(const u32x4_t w, float (&x)[8]) {
#pragma unroll
    for (int i = 0; i < 4; ++i) { x[2 * i] = bf2f(w[i] & 0xffff); x[2 * i + 1] = bf2f(w[i] >> 16); }
}
template <bool Y8, bool DRY = false> __device__ __forceinline__ void ph_combine(const Params& P) {
    const int tid = opaque_tid(), wid = tid >> 6, lane = tid & 63;
    bf16_t* HB = (bf16_t*)(P.ws + WS_HB); bf16_t* HBW = DRY ? (bf16_t*)(P.ws + WS_BIG + 128 * MiB) : HB; float* RS2 = DRY ? (float*)(P.ws + WS_BIG + 200 * MiB) : (float*)(P.ws + WS_RSTD) + 2 * T;
    const bf16_t* Y = (const bf16_t*)(P.ws + WS_Y); const unsigned char* Yb = (const unsigned char*)(P.ws + WS_Y);
    for (int t0 = (blockIdx.x * NWV + wid) * 2; t0 < T; t0 += grid_size() * NWV * 2) {
        u32x4_t hv[2][2], yv[2][2][4]; uint2 y8[2][2][4];
#pragma unroll
        for (int tt = 0; tt < 2; ++tt)
#pragma unroll
            for (int i = 0; i < 2; ++i) {
                hv[tt][i] = *(const u32x4_t*)(HB + (size_t)(t0 + tt) * 1024 + i * 512 + lane * 8);
#pragma unroll
                for (int k = 0; k < 4; ++k) {
                    if constexpr (Y8) y8[tt][i][k] = *(const uint2*)(Yb + ((size_t)(t0 + tt) * 4 + k) * 1024 + i * 512 + lane * 8);
                    else yv[tt][i][k] = *(const u32x4_t*)(Y + ((size_t)(t0 + tt) * 4 + k) * 1024 + i * 512 + lane * 8);
                }
            }
#pragma unroll
        for (int tt = 0; tt < 2; ++tt) {
            float ss = 0.f;
#pragma unroll
            for (int i = 0; i < 2; ++i) {
                float v[8]; unpack8(hv[tt][i], v);
#pragma unroll
                for (int k = 0; k < 4; ++k) {
                    if constexpr (Y8) {
                        const uint2 w = y8[tt][i][k];
                        const auto p0 = __builtin_amdgcn_cvt_pk_f32_fp8((int)w.x, false), p1 = __builtin_amdgcn_cvt_pk_f32_fp8((int)w.x, true), p2 = __builtin_amdgcn_cvt_pk_f32_fp8((int)w.y, false), p3 = __builtin_amdgcn_cvt_pk_f32_fp8((int)w.y, true);
                        v[0] += p0[0] * 0.0625f; v[1] += p0[1] * 0.0625f; v[2] += p1[0] * 0.0625f; v[3] += p1[1] * 0.0625f; v[4] += p2[0] * 0.0625f; v[5] += p2[1] * 0.0625f; v[6] += p3[0] * 0.0625f; v[7] += p3[1] * 0.0625f;
                    } else { float y[8]; unpack8(yv[tt][i][k], y);
#pragma unroll
                        for (int j = 0; j < 8; ++j) v[j] += y[j]; }
                }
#pragma unroll
                for (int j = 0; j < 8; ++j) ss += v[j] * v[j];
                *(u32x4_t*)(HBW + (size_t)(t0 + tt) * 1024 + i * 512 + lane * 8) = (u32x4_t){pack2(v[0], v[1]), pack2(v[2], v[3]), pack2(v[4], v[5]), pack2(v[6], v[7])};
                if constexpr (PG_FP8 && !DRY) *(uint2*)((unsigned char*)(P.ws + WS_H8B) + (size_t)(t0 + tt) * 1024 + i * 512 + lane * 8) = make_uint2(pack4_fp8(v[0], v[1], v[2], v[3]), pack4_fp8(v[4], v[5], v[6], v[7]));
            }
            ss = wave_sum(ss);
            if (lane == 0) RS2[t0 + tt] = rsqrtf(ss * (1.0f / 1024.0f) + EPS);
        }
    }
}

template <bool DRY = false> __device__ __forceinline__ void ph_final(const Params& P, int layer) {
    const int tid = opaque_tid(), wid = tid >> 6, lane = tid & 63;
    bf16_t* HB = (bf16_t*)(P.ws + WS_HB); bf16_t* HBW = DRY ? (bf16_t*)(P.ws + WS_BIG + 128 * MiB) : HB; float* RS = DRY ? (float*)(P.ws + WS_BIG + 200 * MiB) : (float*)(P.ws + WS_RSTD); const bf16_t* V = (const bf16_t*)(P.ws + WS_YMIX);
    float* OUTW = DRY ? (float*)(P.ws + WS_BIG) : P.out;
    const float* gp = P.ple_pn + layer * 1024;
    float g[2][8];
#pragma unroll
    for (int i = 0; i < 2; ++i) { const f32x4 a = *(const f32x4*)(gp + i * 512 + lane * 8), b = *(const f32x4*)(gp + i * 512 + lane * 8 + 4); g[i][0] = a[0]; g[i][1] = a[1]; g[i][2] = a[2]; g[i][3] = a[3]; g[i][4] = b[0]; g[i][5] = b[1]; g[i][6] = b[2]; g[i][7] = b[3]; }
    for (int t0 = (blockIdx.x * NWV + wid) * 2; t0 < T; t0 += grid_size() * NWV * 2) {
        u32x4_t hv[2][2], yv[2][2];
#pragma unroll
        for (int tt = 0; tt < 2; ++tt)
#pragma unroll
            for (int i = 0; i < 2; ++i) { hv[tt][i] = *(const u32x4_t*)(HB + (size_t)(t0 + tt) * 1024 + i * 512 + lane * 8); yv[tt][i] = *(const u32x4_t*)(V + (size_t)(t0 + tt) * 1024 + i * 512 + lane * 8); }
#pragma unroll
        for (int tt = 0; tt < 2; ++tt) {
            float vv[2][8]; float ss = 0.f;
#pragma unroll
            for (int i = 0; i < 2; ++i) { unpack8(yv[tt][i], vv[i]);
#pragma unroll
                for (int j = 0; j < 8; ++j) ss += vv[i][j] * vv[i][j]; }
            ss = wave_sum(ss);
            const float r = rsqrtf(ss * (1.0f / 1024.0f) + EPS);
            float s2 = 0.f;
#pragma unroll
            for (int i = 0; i < 2; ++i) {
                float h[8]; unpack8(hv[tt][i], h);
#pragma unroll
                for (int j = 0; j < 8; ++j) h[j] += vv[i][j] * r * g[i][j];
                if (layer == DEPTH - 1) { float* op = OUTW + (size_t)(t0 + tt) * 1024 + i * 512 + lane * 8; *(f32x4*)op = (f32x4){h[0], h[1], h[2], h[3]}; *(f32x4*)(op + 4) = (f32x4){h[4], h[5], h[6], h[7]}; }
                else {
#pragma unroll
                    for (int j = 0; j < 8; ++j) s2 += h[j] * h[j];
                    *(u32x4_t*)(HBW + (size_t)(t0 + tt) * 1024 + i * 512 + lane * 8) = (u32x4_t){pack2(h[0], h[1]), pack2(h[2], h[3]), pack2(h[4], h[5]), pack2(h[6], h[7])};
                    if constexpr (Z_FP8 && !DRY) *(uint2*)((unsigned char*)(P.ws + WS_H8) + (size_t)(t0 + tt) * 1024 + i * 512 + lane * 8) = make_uint2(pack4_fp8(h[0], h[1], h[2], h[3]), pack4_fp8(h[4], h[5], h[6], h[7]));
                }
            }
            if (layer != DEPTH - 1) { s2 = wave_sum(s2); if (lane == 0) RS[t0 + tt] = rsqrtf(s2 * (1.0f / 1024.0f) + EPS); }
        }
    }
}

struct EpiZ8 { bf16_t* Z; const float* rstd; typedef float Pre;
    __device__ __forceinline__ Pre pre(int r, int) const { return rstd[r]; }
    __device__ __forceinline__ void post(int r, int c, f32x4 a, f32x4 b, Pre s) const { *(u32x4_t*)(Z + (size_t)r * ZW + c) = (u32x4_t){pack2h(a[0] * s, a[1] * s), pack2h(a[2] * s, a[3] * s), pack2h(b[0] * s, b[1] * s), pack2h(b[2] * s, b[3] * s)}; } };
struct EpiBf16_8 { bf16_t* O; int ldo; typedef int Pre;
    __device__ __forceinline__ Pre pre(int, int) const { return 0; }
    __device__ __forceinline__ void post(int r, int c, f32x4 a, f32x4 b, Pre) const { *(u32x4_t*)(O + (size_t)r * ldo + c) = (u32x4_t){pack2(a[0], a[1]), pack2(a[2], a[3]), pack2(b[0], b[1]), pack2(b[2], b[3])}; } };
struct EpiResid8 { const float* xin; bf16_t* HB; struct Pre { f32x4 lo, hi; };
    __device__ __forceinline__ Pre pre(int r, int c) const { Pre p;
        if (xin) { p.lo = *(const f32x4*)(xin + (size_t)r * 1024 + c); p.hi = *(const f32x4*)(xin + (size_t)r * 1024 + c + 4); }
        else { const u32x4_t e = *(const u32x4_t*)(HB + (size_t)r * 1024 + c); p.lo = (f32x4){bf2f(e[0] & 0xffff), bf2f(e[0] >> 16), bf2f(e[1] & 0xffff), bf2f(e[1] >> 16)}; p.hi = (f32x4){bf2f(e[2] & 0xffff), bf2f(e[2] >> 16), bf2f(e[3] & 0xffff), bf2f(e[3] >> 16)}; }
        return p; }
    __device__ __forceinline__ void post(int r, int c, f32x4 a, f32x4 b, const Pre& p) const { const f32x4 h0 = p.lo + a, h1 = p.hi + b;
        *(u32x4_t*)(HB + (size_t)r * 1024 + c) = (u32x4_t){pack2h(h0[0], h0[1]), pack2h(h0[2], h0[3]), pack2h(h1[0], h1[1]), pack2h(h1[2], h1[3])}; } };
struct EpiPle8 { const bf16_t* E; const float* rstd2; bf16_t* V; struct Pre { u32x4_t e; float s; };
    __device__ __forceinline__ Pre pre(int r, int c) const { Pre p; p.e = *(const u32x4_t*)(E + (size_t)r * 1024 + c); p.s = rstd2[r]; return p; }
    static __device__ __forceinline__ unsigned gate2(unsigned ew, f32x2 a, float sn) { const f32x2 x = a * sn; const f32x2 ex = {__builtin_amdgcn_exp2f(x[0]), __builtin_amdgcn_exp2f(x[1])}; const f32x2 d = ex + 1.0f;
        const f32x2 rr = {__builtin_amdgcn_rcpf(d[0]), __builtin_amdgcn_rcpf(d[1])}; const f32x2 ev = {__uint_as_float(ew << 16), __uint_as_float(ew & 0xffff0000u)}; return pack2v(ev * rr); }
    __device__ __forceinline__ void post(int r, int c, f32x4 a, f32x4 b, const Pre& p) const { const float sn = p.s * -1.4426950408889634f; const u32x4_t e = p.e;
        *(u32x4_t*)(V + (size_t)r * 1024 + c) = (u32x4_t){gate2(e[0], __builtin_shufflevector(a, a, 0, 1), sn), gate2(e[1], __builtin_shufflevector(a, a, 2, 3), sn), gate2(e[2], __builtin_shufflevector(b, b, 0, 1), sn), gate2(e[3], __builtin_shufflevector(b, b, 2, 3), sn)}; } };
__device__ __forceinline__ f32x2 swiglu2(f32x2 g, f32x2 u, float s, f32x2 bg, f32x2 bu1) {
    const f32x2 gp = g * s + bg, up = u * s + bu1;
    const f32x2 gg = {fminf(gp[0], 7.0f), fminf(gp[1], 7.0f)};
    const f32x2 uu = {__builtin_amdgcn_fmed3f(up[0], -6.0f, 8.0f), __builtin_amdgcn_fmed3f(up[1], -6.0f, 8.0f)};
    const f32x2 t = uu * gg, xe = gg * (-1.702f * 1.4426950408889634f);
    const f32x2 e = {__builtin_amdgcn_exp2f(xe[0]), __builtin_amdgcn_exp2f(xe[1])};
    const f32x2 d = e + 1.0f;
    const f32x2 r = {__builtin_amdgcn_rcpf(d[0]), __builtin_amdgcn_rcpf(d[1])};
    return t * r;
}


namespace fg {
typedef int v4i_t __attribute__((ext_vector_type(4))); typedef int v8i_t __attribute__((ext_vector_type(8)));
constexpr int BM = 256, BK = 64, HALF = 128, HTB = HALF * BK * 2  , STAGE_BYTES = 8 * HTB, NXCD = 8, WGM = 8;
__host__ __device__ __forceinline__ int lds_byte(int r, int c) { const int st = (r >> 4) * 2 + (c >> 5), rr = r & 15, cc = c & 31, ob = rr * 64 + cc * 2; return st * 1024 + (ob ^ (((ob >> 9) & 1) << 5)); }
__host__ __device__ __forceinline__ int perm32(int rho) { const int n = rho >> 4, i = rho & 15; return 8 * (i >> 2) + 4 * n + (i & 3); }
__host__ __device__ __forceinline__ void stage_rc(int b, int& R, int& C) { const int st = b / 1024, sb = b % 1024, swz = sb ^ (((sb >> 9) & 1) << 5); R = (st >> 1) * 16 + swz / 64; C = (st & 1) * 32 + (swz % 64) / 2; }

template <class PB>
__device__ __forceinline__ void gemm_phase(LAS unsigned char* lds, const PB& S) {
    constexpr int K = PB::K, nt = K / BK;
    typedef typename PB::Unit Unit;
    const int tid = opaque_tid(); const int wid = __builtin_amdgcn_readfirstlane(tid >> 6), lane = tid & 63, wr = wid >> 2, wc = wid & 3, fr = lane & 15, fq = lane >> 4;
    unsigned voffB[2];
#pragma unroll
    for (int i = 0; i < 2; ++i) { int R_, C_; stage_rc(tid * 16 + i * 8192, R_, C_); const int Rb_ = PB::PERM ? ((R_ & ~31) + perm32(R_ & 31)) : R_; voffB[i] = (unsigned)(Rb_ * K + C_) * 2u; }
#define FG_AOFFS(dst, unit) do { const int tz_ = opaque_tid(); _Pragma("unroll") for (int i_ = 0; i_ < 2; ++i_) { int R_, C_; stage_rc(tz_ * 16 + i_ * 8192, R_, C_); \
        _Pragma("unroll") for (int h_ = 0; h_ < 2; ++h_) dst[h_][i_] = S.a_off(unit, h_ * HALF + R_) + (unsigned)C_ * 2u; } } while (0)
    constexpr size_t kstep = (size_t)(BK * 2);
    constexpr size_t hstep = (size_t)HALF * K * 2;
    const unsigned ldsw = (unsigned)wid * 1024u;
    const int aoff = lds_byte(wr * 64 + fr, fq * 8), boff = lds_byte(wc * 32 + fr, fq * 8);
#define FG_SA(b, h) (((b) * 2 + (h)) * HTB)
#define FG_SB(b, h) ((4 + (b) * 2 + (h)) * HTB)
#define FG_STAGE_B(bufoff, gbase) do { _Pragma("unroll") for (int _i = 0; _i < 2; ++_i) \
        __builtin_amdgcn_global_load_lds((const unsigned*)((const char*)(gbase) + voffB[_i]), (LAS unsigned*)(lds + (bufoff) + ldsw + _i * 8192), 16, 0, 0); } while (0)
#define FG_STAGE_A(bufoff, o0, o1) do { \
        __builtin_amdgcn_global_load_lds((const unsigned*)(Abase + (o0)), (LAS unsigned*)(lds + (bufoff) + ldsw), 16, 0, 0); \
        __builtin_amdgcn_global_load_lds((const unsigned*)(Abase + (o1)), (LAS unsigned*)(lds + (bufoff) + ldsw + 8192), 16, 0, 0); } while (0)
#define FG_LD8(dst, off) do { const v4i_t lo_ = *(const LAS v4i_t*)(lds + (off)), hi_ = *(const LAS v4i_t*)(lds + (off) + 1024); dst = (v8i_t){lo_[0], lo_[1], lo_[2], lo_[3], hi_[0], hi_[1], hi_[2], hi_[3]}; } while (0)
#define FG_LDA(dst, b, h) do { _Pragma("unroll") for (int m = 0; m < 4; ++m) FG_LD8(dst[m], FG_SA(b, h) + aoff + m * 2048); } while (0)
#define FG_LDB(dst, b, h) do { _Pragma("unroll") for (int n = 0; n < 2; ++n) FG_LD8(dst[n], FG_SB(b, h) + boff + n * 2048); } while (0)
#define FG_HALF(v, k) ((k) == 0 ? __builtin_bit_cast(bf16x8, (v4i_t){(v)[0], (v)[1], (v)[2], (v)[3]}) : __builtin_bit_cast(bf16x8, (v4i_t){(v)[4], (v)[5], (v)[6], (v)[7]}))
#define FG_MMA(ai, bj, At, Bt) do { __builtin_amdgcn_s_setprio(1); \
        if constexpr (PB::FP8) { _Pragma("unroll") for (int m = 0; m < 4; ++m) _Pragma("unroll") for (int n = 0; n < 2; ++n) \
            asm volatile("v_mfma_scale_f32_16x16x128_f8f6f4 %0, %1, %2, %0, %3, %4 op_sel_hi:[0,0,0]" : "+v"(acc[ai][bj][m][n]) : "v"(Bt[n]), "v"(At[m]), "v"(sclW), "v"(sclA)); } \
        else { _Pragma("unroll") for (int m = 0; m < 4; ++m) _Pragma("unroll") for (int n = 0; n < 2; ++n) _Pragma("unroll") for (int k = 0; k < 2; ++k) \
            acc[ai][bj][m][n] = __builtin_amdgcn_mfma_f32_16x16x32_bf16(FG_HALF(Bt[n], k), FG_HALF(At[m], k), acc[ai][bj][m][n], 0, 0, 0); } \
        __builtin_amdgcn_s_setprio(0); } while (0)
#define FG_WAIT_V(n) asm volatile("s_waitcnt vmcnt(" #n ")" ::: "memory")
#define FG_WAIT_L(n) asm volatile("s_waitcnt lgkmcnt(" #n ")" ::: "memory")
#define FG_BAR __builtin_amdgcn_s_barrier()
#define FG_SCHED __builtin_amdgcn_sched_barrier(0)
    Unit cur, nxt; int ui = 0;
    if (!S.next(0, cur)) return;
    f32x4 acc[2][2][4][2];
#pragma unroll
    for (int a = 0; a < 2; ++a)
#pragma unroll
        for (int b = 0; b < 2; ++b)
#pragma unroll
            for (int m = 0; m < 4; ++m)
#pragma unroll
                for (int n = 0; n < 2; ++n) acc[a][b][m][n] = (f32x4){0.f, 0.f, 0.f, 0.f};
    v8i_t At[4], B0[2], B1[2];
    int sclW = 0x79797979, sclA = 0x7f7f7f7f;
    asm volatile("" : "+v"(sclW), "+v"(sclA));
    const char* Abase = S.a_base();
    unsigned vAc[2][2];
    FG_AOFFS(vAc, cur);
    const char* cB = S.b_base(cur);
    FG_STAGE_B(FG_SB(0, 0), cB); FG_STAGE_B(FG_SB(0, 1), cB + hstep); FG_STAGE_A(FG_SA(0, 0), vAc[0][0], vAc[0][1]); FG_STAGE_A(FG_SA(0, 1), vAc[1][0], vAc[1][1]);
    if (wr == 1) FG_BAR;
    FG_WAIT_V(2); FG_BAR;
    FG_STAGE_B(FG_SB(1, 0), cB + kstep); FG_STAGE_A(FG_SA(1, 0), vAc[0][0] + (unsigned)kstep, vAc[0][1] + (unsigned)kstep); FG_STAGE_B(FG_SB(1, 1), cB + hstep + kstep);
    FG_WAIT_V(6); FG_BAR;
    for (;;) {
        const bool has_next = S.next(ui + 1, nxt);
        const char* nB = has_next ? S.b_base(nxt) : cB;
        {
            unsigned vAn[2][2];
            if (has_next) { FG_AOFFS(vAn, nxt); }
            else {
#pragma unroll
                for (int h = 0; h < 2; ++h)
#pragma unroll
                    for (int i = 0; i < 2; ++i) vAn[h][i] = vAc[h][i];
            }
            *(LAS v4i_t*)(lds + STAGE_BYTES + 512 + opaque_tid() * 16) = (v4i_t){(int)vAn[0][0], (int)vAn[0][1], (int)vAn[1][0], (int)vAn[1][1]};
        }
#pragma unroll 1
        for (int t = 0; t < nt; t += 2) {
            const bool last = (t == nt - 2);
            const unsigned k1 = (unsigned)((t + 1) * (int)kstep), k2 = last ? 0u : (unsigned)((t + 2) * (int)kstep);
            const char* b2 = last ? nB : cB + (size_t)(t + 2) * kstep; const char* b3 = b2 + kstep;
            const unsigned c10_ = vAc[1][0], c11_ = vAc[1][1];
            if (last) { const v4i_t nx_ = *(const LAS v4i_t*)(lds + STAGE_BYTES + 512 + opaque_tid() * 16); vAc[0][0] = (unsigned)nx_[0]; vAc[0][1] = (unsigned)nx_[1]; vAc[1][0] = (unsigned)nx_[2]; vAc[1][1] = (unsigned)nx_[3]; }
#define FG_A2(h, i) (vAc[h][i] + k2)
            FG_LDB(B0, 0, 0); FG_LDB(B1, 0, 1); FG_SCHED; FG_LDA(At, 0, 0);
            if constexpr (PB::PREFETCH) { if (t == 2) S.prefetch(cur); }
            FG_STAGE_A(FG_SA(1, 1), c10_ + k1, c11_ + k1);
            FG_WAIT_V(8); FG_WAIT_L(0); FG_BAR; FG_MMA(0, 0, At, B0); FG_MMA(0, 1, At, B1); FG_BAR; FG_SCHED;
            FG_LDA(At, 0, 1); FG_STAGE_B(FG_SB(0, 0), b2); FG_STAGE_B(FG_SB(0, 1), b2 + hstep); FG_STAGE_A(FG_SA(0, 0), FG_A2(0, 0), FG_A2(0, 1));
            FG_WAIT_V(8); FG_WAIT_L(0); FG_BAR; FG_MMA(1, 0, At, B0); FG_MMA(1, 1, At, B1); FG_BAR; FG_SCHED;
            FG_LDB(B0, 1, 0); FG_LDB(B1, 1, 1); FG_SCHED; FG_LDA(At, 1, 0); FG_STAGE_A(FG_SA(0, 1), FG_A2(1, 0), FG_A2(1, 1));
            FG_WAIT_V(8); FG_WAIT_L(0); FG_BAR; FG_MMA(0, 0, At, B0); FG_MMA(0, 1, At, B1); FG_BAR; FG_SCHED;
            FG_LDA(At, 1, 1); FG_STAGE_B(FG_SB(1, 0), b3); FG_STAGE_B(FG_SB(1, 1), b3 + hstep); FG_STAGE_A(FG_SA(1, 0), FG_A2(0, 0) + (unsigned)kstep, FG_A2(0, 1) + (unsigned)kstep);
            FG_WAIT_V(8); FG_WAIT_L(0); FG_BAR; FG_MMA(1, 0, At, B0); FG_MMA(1, 1, At, B1); FG_BAR; FG_SCHED;
        }
        if (wr == 0) FG_BAR;
        if constexpr (PB::FP8) asm volatile("s_nop 15\n\ts_nop 15\n\ts_nop 15" ::: "memory");
        { const int t2_ = opaque_tid(); const int w2_ = __builtin_amdgcn_readfirstlane(t2_ >> 6), l2_ = t2_ & 63;
          S.epilogue(acc, cur, w2_ >> 2, w2_ & 3, l2_ & 15, l2_ >> 4); }
        if (!has_next) break;
#pragma unroll
        for (int a = 0; a < 2; ++a)
#pragma unroll
            for (int b = 0; b < 2; ++b)
#pragma unroll
                for (int m = 0; m < 4; ++m)
#pragma unroll
                    for (int n = 0; n < 2; ++n) acc[a][b][m][n] = (f32x4){0.f, 0.f, 0.f, 0.f};
        cur = nxt; cB = nB; ++ui;
        if (wr == 1) FG_BAR;
    }
    FG_WAIT_V(0);
    FG_BAR;
#undef FG_AOFFS
#undef FG_A2
#undef FG_SA
#undef FG_SB
#undef FG_STAGE_A
#undef FG_STAGE_B
#undef FG_LDA
#undef FG_LD8
#undef FG_HALF
#undef FG_LDB
#undef FG_MMA
#undef FG_WAIT_V
#undef FG_WAIT_L
#undef FG_BAR
#undef FG_SCHED
}

template <int K_, int LDA, class Epi, bool PERM_, bool FP8_ = false>
struct DenseProb {
    static constexpr int K = K_; static constexpr bool PERM = PERM_, FP8 = FP8_, PREFETCH = false;
    struct Unit { int pm, pn; };
    const bf16_t* A; const bf16_t* Bt; int nM, nN, nwg, G, c; Epi epi;
    __device__ __forceinline__ DenseProb(const bf16_t* A_, const bf16_t* Bt_, int N, const Epi& e) : A(A_), Bt(Bt_), nM(T / BM), nN(N / BM), nwg((T / BM) * (N / BM)), G(grid_size()), c(blockIdx.x), epi(e) {}
    __device__ __forceinline__ bool next(int i, Unit& u) const {
        const long L = (long)i * G + c; if (L >= nwg) return false;
        int wgid = (int)L; { const int q = nwg / NXCD, r = nwg % NXCD, xcd = wgid % NXCD, off = wgid / NXCD; wgid = (xcd < r ? xcd * (q + 1) : r * (q + 1) + (xcd - r) * q) + off; }
        const int nig = WGM * nN, gid = wgid / nig, fm = gid * WGM, gsz = (nM - fm) < WGM ? (nM - fm) : WGM;
        u.pm = fm + ((wgid % nig) % gsz); u.pn = (wgid % nig) / gsz; return true;
    }
    __device__ __forceinline__ const char* a_base() const { return (const char*)A; }
    __device__ __forceinline__ unsigned a_off(const Unit& u, int r) const { return (unsigned)((u.pm * BM + r) * LDA) * 2u; }
    __device__ __forceinline__ const char* b_base(const Unit& u) const { return (const char*)Bt + (size_t)u.pn * BM * K * 2; }
    __device__ __forceinline__ void epilogue(const f32x4 (&acc)[2][2][4][2], const Unit& u, int wr, int wc, int fr, int fq) const {
        const int row0 = u.pm * BM + wr * 64 + fr;
        if constexpr (PERM) {
            const int col0 = u.pn * BM + wc * 32 + 8 * fq;
#pragma unroll
            for (int ai = 0; ai < 2; ++ai) {
                typename Epi::Pre pre[4][2];
#pragma unroll
                for (int m = 0; m < 4; ++m)
#pragma unroll
                    for (int bj = 0; bj < 2; ++bj) pre[m][bj] = epi.pre(row0 + ai * HALF + m * 16, col0 + bj * HALF);
#pragma unroll
                for (int m = 0; m < 4; ++m)
#pragma unroll
                    for (int bj = 0; bj < 2; ++bj) epi.post(row0 + ai * HALF + m * 16, col0 + bj * HALF, acc[ai][bj][m][0], acc[ai][bj][m][1], pre[m][bj]);
            }
        } else {
            const int col0 = u.pn * BM + wc * 32 + 4 * fq;
#pragma unroll
            for (int ai = 0; ai < 2; ++ai)
#pragma unroll
                for (int m = 0; m < 4; ++m)
#pragma unroll
                    for (int bj = 0; bj < 2; ++bj)
#pragma unroll
                        for (int n = 0; n < 2; ++n) epi(row0 + ai * HALF + m * 16, col0 + bj * HALF + n * 16, acc[ai][bj][m][n]);
        }
    }
};
}
template <int K, int LDA, bool PERM, class Epi, bool FP8 = false>
__device__ __forceinline__ void ph_gemm_fast(LAS unsigned char* lds, const bf16_t* A, const bf16_t* Bt, int N, const Epi& epi) {
    const fg::DenseProb<K, LDA, Epi, PERM, FP8> pb(A, Bt, N, epi);
    fg::gemm_phase(lds, pb);
}


namespace fg {
struct MoeUnit { int e, mblk, pn, rowoff, M; };
template <bool FIRST, bool FP8_>
struct MoeProb {
    static constexpr int K = FP8_ ? 512 : 1024  , NCOL = FIRST ? 8 : 4; static constexpr bool PERM = true, FP8 = FP8_, PREFETCH = FP8_; static constexpr unsigned RB = FP8_ ? 1024u : 2048u  ;
    static constexpr int PF_OFF = 512 + 8192;
    typedef MoeUnit Unit;
    const Params& P; int layer; const LAS int* tab;
    int G, c; mutable int e_, acc_, off_;
    __device__ __forceinline__ MoeProb(const Params& P_, int layer_, const LAS int* tab_) : P(P_), layer(layer_), tab(tab_), G(grid_size()), c(blockIdx.x), e_(0), acc_(0), off_(0) {}
    __device__ __forceinline__ bool next(int i, Unit& u) const {
        const int j = i * (G >> 3) + (c >> 3), tile = (j / NCOL) * 8 + (c & 7);
        while (e_ < 32) { const int tl = (tab[e_] + 255) >> 8; if (tile < acc_ + tl) break; acc_ += tl; off_ += tl * 256; ++e_; }
        if (e_ >= 32) return false;
        u.e = e_; u.mblk = tile - acc_; u.pn = j % NCOL; u.rowoff = off_; u.M = tab[e_]; return true;
    }
    __device__ __forceinline__ void prefetch(const Unit& u) const {
        const int tz = opaque_tid(); const int w = __builtin_amdgcn_readfirstlane(tz >> 6); char* ws = P.ws;
        LAS unsigned char* pf = (LAS unsigned char*)tab + PF_OFF;
        int r = u.mblk * 256 + (tz & 255); r = r < u.M ? r : u.M - 1;
        if (FIRST) {
            if (w < 4) __builtin_amdgcn_global_load_lds((const unsigned*)((const float*)(ws + WS_LRS) + (size_t)u.e * T + r), (LAS unsigned*)(pf + w * 256), 4, 0, 0);
            else { const int c = tz - 256; const float* src = (c < 128 ? P.moe_bg : P.moe_bu) + ((size_t)layer * 32 + u.e) * 1024 + u.pn * 128 + (c & 127);
                __builtin_amdgcn_global_load_lds((const unsigned*)src, (LAS unsigned*)(pf + 1024 + (w - 4) * 256), 4, 0, 0); }
        } else {
            if (w < 4) { __builtin_amdgcn_global_load_lds((const unsigned*)((const int*)(ws + WS_LIST) + (size_t)u.e * T + r), (LAS unsigned*)(pf + w * 256), 4, 0, 0);
                __builtin_amdgcn_global_load_lds((const unsigned*)(P.moe_bd + ((size_t)layer * 32 + u.e) * 1024 + u.pn * 256 + tz), (LAS unsigned*)(pf + 2048 + w * 256), 4, 0, 0); }
            else __builtin_amdgcn_global_load_lds((const unsigned*)((const float*)(ws + WS_LGT) + (size_t)u.e * T + r), (LAS unsigned*)(pf + 1024 + (w - 4) * 256), 4, 0, 0);
        }
    }
    __device__ __forceinline__ const char* a_base() const { return FIRST ? (const char*)(P.ws + (FP8_ ? WS_YMIX : WS_HB)) : (const char*)(P.ws + WS_BIG); }
    __device__ __forceinline__ unsigned a_off(const Unit& u, int r) const {
        if (FIRST) { int rr = u.mblk * 256 + r; rr = rr < u.M ? rr : u.M - 1; const int ts = ((const int*)(P.ws + WS_LIST))[(size_t)u.e * T + rr]; return (unsigned)(ts >> 2) * RB; }
        return (unsigned)(u.rowoff + u.mblk * 256 + r) * RB;
    }
    __device__ __forceinline__ const char* b_base(const Unit& u) const {
        return FIRST ? (const char*)(P.ws + WS_W1) + ((size_t)u.e * 2048 + (size_t)u.pn * 256) * RB : (const char*)(P.ws + WS_W2) + ((size_t)u.e * 1024 + (size_t)u.pn * 256) * RB;
    }
    __device__ __forceinline__ void epilogue(const f32x4 (&acc)[2][2][4][2], const Unit& u, int wr, int wc, int fr, int fq) const {
        char* ws = P.ws; const int rl0 = u.mblk * 256 + wr * 64 + fr;
        if (FIRST) {
            const float* lrs = (const float*)(ws + WS_LRS) + (size_t)u.e * T;
            bf16_t* H = (bf16_t*)(ws + WS_BIG) + (size_t)u.rowoff * 1024;
            const int hc0 = u.pn * 128 + wc * 32 + 8 * fq;
            const float* bgp = P.moe_bg + ((size_t)layer * 32 + u.e) * 1024 + hc0; const float* bup = P.moe_bu + ((size_t)layer * 32 + u.e) * 1024 + hc0;
            f32x4 bg0, bg1, bu0, bu1; float sc[2][4];
            if constexpr (FP8_) {
                const LAS float* pf = (const LAS float*)((const LAS unsigned char*)tab + PF_OFF);
                bg0 = *(const LAS f32x4*)(pf + 256 + wc * 32 + 8 * fq); bg1 = *(const LAS f32x4*)(pf + 256 + wc * 32 + 8 * fq + 4);
                bu0 = *(const LAS f32x4*)(pf + 384 + wc * 32 + 8 * fq) + 1.0f; bu1 = *(const LAS f32x4*)(pf + 384 + wc * 32 + 8 * fq + 4) + 1.0f;
#pragma unroll
                for (int ai = 0; ai < 2; ++ai)
#pragma unroll
                    for (int m = 0; m < 4; ++m) sc[ai][m] = pf[ai * HALF + wr * 64 + m * 16 + fr];
            } else {
                bg0 = *(const f32x4*)bgp; bg1 = *(const f32x4*)(bgp + 4); bu0 = *(const f32x4*)bup + 1.0f; bu1 = *(const f32x4*)(bup + 4) + 1.0f;
#pragma unroll
                for (int ai = 0; ai < 2; ++ai)
#pragma unroll
                    for (int m = 0; m < 4; ++m) { const int r = rl0 + ai * HALF + m * 16; sc[ai][m] = lrs[r < u.M ? r : u.M - 1]; }
            }
#pragma unroll
            for (int ai = 0; ai < 2; ++ai)
#pragma unroll
                for (int m = 0; m < 4; ++m) { const int r = rl0 + ai * HALF + m * 16;
                    if (FP8_ || r < u.M) {
                        const float s_ = sc[ai][m]; const f32x4 g0 = acc[ai][0][m][0], g1 = acc[ai][0][m][1], u0 = acc[ai][1][m][0], u1 = acc[ai][1][m][1];
                        const f32x2 h01 = swiglu2(__builtin_shufflevector(g0, g0, 0, 1), __builtin_shufflevector(u0, u0, 0, 1), s_, __builtin_shufflevector(bg0, bg0, 0, 1), __builtin_shufflevector(bu0, bu0, 0, 1));
                        const f32x2 h23 = swiglu2(__builtin_shufflevector(g0, g0, 2, 3), __builtin_shufflevector(u0, u0, 2, 3), s_, __builtin_shufflevector(bg0, bg0, 2, 3), __builtin_shufflevector(bu0, bu0, 2, 3));
                        const f32x2 h45 = swiglu2(__builtin_shufflevector(g1, g1, 0, 1), __builtin_shufflevector(u1, u1, 0, 1), s_, __builtin_shufflevector(bg1, bg1, 0, 1), __builtin_shufflevector(bu1, bu1, 0, 1));
                        const f32x2 h67 = swiglu2(__builtin_shufflevector(g1, g1, 2, 3), __builtin_shufflevector(u1, u1, 2, 3), s_, __builtin_shufflevector(bg1, bg1, 2, 3), __builtin_shufflevector(bu1, bu1, 2, 3));
                        if constexpr (FP8_) *(uint2*)((unsigned char*)(ws + WS_BIG) + (size_t)(u.rowoff + r) * 1024 + hc0) = make_uint2(pack4_fp8(h01[0], h01[1], h23[0], h23[1]), pack4_fp8(h45[0], h45[1], h67[0], h67[1]));
                        else *(u32x4_t*)(H + (size_t)r * 1024 + hc0) = (u32x4_t){pack2v(h01), pack2v(h23), pack2v(h45), pack2v(h67)};
                    } }
        } else {
            const int* list = (const int*)(ws + WS_LIST) + (size_t)u.e * T; const float* lgt = (const float*)(ws + WS_LGT) + (size_t)u.e * T;
            bf16_t* Y = (bf16_t*)(ws + WS_Y);
            const int col0 = u.pn * 256 + wc * 32 + 8 * fq;
            const float* bdp = P.moe_bd + ((size_t)layer * 32 + u.e) * 1024 + col0;
            f32x4 bd[2][2];
            int tsv[2][4]; float gv[2][4];
            if constexpr (FP8_) {
                const LAS float* pf = (const LAS float*)((const LAS unsigned char*)tab + PF_OFF);
#pragma unroll
                for (int bj = 0; bj < 2; ++bj) { bd[bj][0] = *(const LAS f32x4*)(pf + 512 + bj * HALF + wc * 32 + 8 * fq); bd[bj][1] = *(const LAS f32x4*)(pf + 512 + bj * HALF + wc * 32 + 8 * fq + 4); }
#pragma unroll
                for (int ai = 0; ai < 2; ++ai)
#pragma unroll
                    for (int m = 0; m < 4; ++m) { const int rt = ai * HALF + wr * 64 + m * 16 + fr, r = u.mblk * 256 + rt; const int ts_ = ((const LAS int*)pf)[rt]; tsv[ai][m] = r < u.M ? ts_ : T * 4 + (r & 255); gv[ai][m] = pf[256 + rt]; }
            } else {
#pragma unroll
            for (int bj = 0; bj < 2; ++bj) { bd[bj][0] = *(const f32x4*)(bdp + bj * HALF); bd[bj][1] = *(const f32x4*)(bdp + bj * HALF + 4); }
#pragma unroll
            for (int ai = 0; ai < 2; ++ai)
#pragma unroll
                for (int m = 0; m < 4; ++m) { const int r = rl0 + ai * HALF + m * 16; const int rc = r < u.M ? r : u.M - 1; const int ts_ = list[rc]; tsv[ai][m] = (!FP8_ || r < u.M) ? ts_ : T * 4 + (r & 255); gv[ai][m] = lgt[rc]; }
            }
#pragma unroll
            for (int ai = 0; ai < 2; ++ai)
#pragma unroll
                for (int m = 0; m < 4; ++m) { const int r = rl0 + ai * HALF + m * 16;
                    if (FP8_ || r < u.M) {
                        const float g = FP8_ ? gv[ai][m] * 16.0f : gv[ai][m]; bf16_t* yr = Y + (size_t)tsv[ai][m] * 1024 + col0;
#pragma unroll
                        for (int bj = 0; bj < 2; ++bj) { const f32x4 a = (acc[ai][bj][m][0] + bd[bj][0]) * g, b = (acc[ai][bj][m][1] + bd[bj][1]) * g;
                            if constexpr (FP8_) *(uint2*)((unsigned char*)(ws + WS_Y) + (size_t)tsv[ai][m] * 1024 + col0 + bj * HALF) = make_uint2(pack4_fp8(a[0], a[1], a[2], a[3]), pack4_fp8(b[0], b[1], b[2], b[3]));
                            else *(u32x4_t*)(yr + bj * HALF) = (u32x4_t){pack2(a[0], a[1]), pack2(a[2], a[3]), pack2(b[0], b[1]), pack2(b[2], b[3])}; }
                    } }
        }
    }
};
}
template <bool FIRST, bool FP8>
__device__ __forceinline__ void ph_moe_fast(const Params& P, int layer, LAS unsigned char* lds) {
    LAS int* tab = (LAS int*)(lds + fg::STAGE_BYTES);
    const int tz = opaque_tid();
    if (tz < 32) tab[tz] = (int)((const unsigned*)(P.ws + WS_CTL))[CTL_CNT + layer * 32 + tz];
    __syncthreads();
    const fg::MoeProb<FIRST, FP8> pb(P, layer, tab);
    fg::gemm_phase(lds, pb);
}


namespace at {
typedef short s16x4 __attribute__((ext_vector_type(4)));
constexpr int KSLOT = 12288, VSLOT = 8192, NSLOT = 4, LDS_K = 0, LDS_V = NSLOT * KSLOT, LDS_END = LDS_V + NSLOT * VSLOT;
typedef float f32x2_t __attribute__((ext_vector_type(2))); typedef __bf16 bf16x2_t __attribute__((ext_vector_type(2)));
__device__ __forceinline__ unsigned cvtpk(float lo, float hi) { const f32x2_t v = {lo, hi}; const bf16x2_t b = __builtin_convertvector(v, bf16x2_t); return __builtin_bit_cast(unsigned, b); }
__device__ __forceinline__ void glds16(const void* gsrc, unsigned lds_dst) { unsigned keep;
    asm volatile("s_mov_b32 %0, m0\n\ts_mov_b32 m0, %2\n\ts_nop 0\n\tglobal_load_lds_dwordx4 %1, off\n\ts_mov_b32 m0, %0" : "=&s"(keep) : "v"(gsrc), "s"(lds_dst) : "memory"); }
__device__ __forceinline__ s16x4 vtr(const LAS unsigned char* p) { return __builtin_bit_cast(s16x4, __builtin_amdgcn_ds_read_tr16_b64_v4i16((LAS s16x4*)p)); }

__device__ __forceinline__ void attn_unit(int b, int h, int qb, const bf16_t* Q, const bf16_t* Kd, const bf16_t* KV, bf16_t* YM, LAS unsigned char* lds) {
    const int tid = opaque_tid(); const int lane = tid & 63, r32 = lane & 31, hi = lane >> 5; const int wid = __builtin_amdgcn_readfirstlane(tid >> 6);
    const int q0 = qb * 256; const size_t row = (size_t)b * SEQ + q0 + wid * 32 + r32;
    const int NT = 4 * qb + 4;
    const char* ksrcA = (const char*)(Kd + (((size_t)b * SEQ + lane) * 8 + h) * 96) + wid * 16;
    const char* ksrcB = (const char*)(Kd + (((size_t)b * SEQ + lane) * 8 + h) * 96) + (8 + (wid & 3)) * 16;
    const char* vsrc = (const char*)(KV + ((size_t)b * SEQ + 16 * (wid & 3) + (lane >> 2)) * 1024 + h * 128 + 64 + (wid >> 2) * 32 + (lane & 3) * 8);
    const unsigned lds0 = (unsigned)(size_t)lds;
#define AT_DMA(j, slot) do { \
        glds16(ksrcA + (size_t)(j) * (64 * 1536), (unsigned)__builtin_amdgcn_readfirstlane((int)(lds0 + LDS_K + (slot) * KSLOT + wid * 1024))); \
        glds16(ksrcB + (size_t)(j) * (64 * 1536), (unsigned)__builtin_amdgcn_readfirstlane((int)(lds0 + LDS_K + (slot) * KSLOT + (8 + (wid & 3)) * 1024))); \
        glds16(vsrc + (size_t)(j) * (64 * 2048), (unsigned)__builtin_amdgcn_readfirstlane((int)(lds0 + LDS_V + (slot) * VSLOT + wid * 1024))); } while (0)
    AT_DMA(0, 0); AT_DMA(1, 1); AT_DMA(2, 2);
    bf16x8 qf[6];
#pragma unroll
    for (int ks = 0; ks < 6; ++ks) qf[ks] = *(const bf16x8*)(Q + row * 768 + h * 96 + ks * 16 + hi * 8);
    asm volatile("" : "+v"(qf[0]), "+v"(qf[1]), "+v"(qf[2]), "+v"(qf[3]), "+v"(qf[4]), "+v"(qf[5]));
    constexpr float THR = 8.0f;
    float mref = 0.f, l = 0.f;
    f32x16 o0, o1, negm;
#pragma unroll
    for (int r = 0; r < 16; ++r) { o0[r] = 0.f; o1[r] = 0.f; negm[r] = 0.f; }
    const int kfo = hi * 1024 + r32 * 16;
    const int vfo = ((lane >> 4) & 1) * 32 + (lane & 3) * 8 + (4 * hi + ((lane & 15) >> 2)) * 64;
    const int qrel = wid * 32 + r32;
    int slot = 0;
    for (int j = 0; j < NT; ++j) {
        if (j + 2 < NT) asm volatile("s_waitcnt vmcnt(6)\n\ts_barrier" ::: "memory"); else if (j + 1 < NT) asm volatile("s_waitcnt vmcnt(3)\n\ts_barrier" ::: "memory"); else asm volatile("s_waitcnt vmcnt(0)\n\ts_barrier" ::: "memory");
        if (j + 3 < NT) { AT_DMA(j + 3, (slot + 3) & 3); }
        const LAS unsigned char* kp = lds + LDS_K + slot * KSLOT + kfo;
        const LAS unsigned char* vp = lds + LDS_V + slot * VSLOT + vfo;
        f32x16 s0, s1;
#pragma unroll
        for (int ks = 0; ks < 6; ++ks) {
            const bf16x8 k0 = *(const LAS bf16x8*)(kp + ks * 2048), k1 = *(const LAS bf16x8*)(kp + ks * 2048 + 512);
            s0 = __builtin_amdgcn_mfma_f32_32x32x16_bf16(k0, qf[ks], ks == 0 ? negm : s0, 0, 0, 0);
            s1 = __builtin_amdgcn_mfma_f32_32x32x16_bf16(k1, qf[ks], ks == 0 ? negm : s1, 0, 0, 0);
        }
        if (j >= NT - 4) {
            const int kb = 64 * (j - (NT - 4)) + 4 * hi;
#pragma unroll
            for (int r = 0; r < 16; ++r) { const int kv = kb + (r & 3) + 8 * (r >> 2); if (kv > qrel) s0[r] = -INFINITY; if (kv + 32 > qrel) s1[r] = -INFINITY; }
        }
        float rm = fmaxf(fmaxf(s0[0], s1[0]), fmaxf(s0[1], s1[1]));
#pragma unroll
        for (int r = 2; r < 16; r += 2) rm = fmaxf(rm, fmaxf(fmaxf(s0[r], s1[r]), fmaxf(s0[r + 1], s1[r + 1])));
        rm = xhalf_max(rm);
        if (__any(rm > THR)) {
            const float dl = fmaxf(rm, 0.f);
            mref += dl;
#pragma unroll
            for (int r = 0; r < 16; ++r) { s0[r] -= dl; s1[r] -= dl; negm[r] = -mref; }
            const float f = __builtin_amdgcn_exp2f(-dl);
            l *= f;
#pragma unroll
            for (int r = 0; r < 16; ++r) { o0[r] *= f; o1[r] *= f; }
        }
        float ps0 = 0.f, ps1 = 0.f;
#pragma unroll
        for (int r = 0; r < 16; ++r) { s0[r] = __builtin_amdgcn_exp2f(s0[r]); s1[r] = __builtin_amdgcn_exp2f(s1[r]); ps0 += s0[r]; ps1 += s1[r]; }
        l += ps0 + ps1;
        bf16x8 pf[4];
        {
            unsigned w[16];
#pragma unroll
            for (int i = 0; i < 8; ++i) { w[i] = cvtpk(s0[2 * i], s0[2 * i + 1]); w[8 + i] = cvtpk(s1[2 * i], s1[2 * i + 1]); }
#pragma unroll
            for (int k = 0; k < 4; ++k) { typedef unsigned u32x4 __attribute__((ext_vector_type(4))); const u32x4 t = {w[4 * k], w[4 * k + 1], w[4 * k + 2], w[4 * k + 3]}; pf[k] = __builtin_bit_cast(bf16x8, t); }
        }
#pragma unroll
        for (int k = 0; k < 4; ++k) {
            const s16x4 a0 = vtr(vp + k * 1024), a1 = vtr(vp + k * 1024 + 512), c0 = vtr(vp + 4096 + k * 1024), c1 = vtr(vp + 4096 + k * 1024 + 512);
            const bf16x8 v0 = {a0[0], a0[1], a0[2], a0[3], a1[0], a1[1], a1[2], a1[3]}, v1 = {c0[0], c0[1], c0[2], c0[3], c1[0], c1[1], c1[2], c1[3]};
            o0 = __builtin_amdgcn_mfma_f32_32x32x16_bf16(v0, pf[k], o0, 0, 0, 0);
            o1 = __builtin_amdgcn_mfma_f32_32x32x16_bf16(v1, pf[k], o1, 0, 0, 0);
        }
        slot = (slot + 1) & 3;
    }
    l = xhalf_sum(l);
    const float rl = 1.0f / l;
    bf16_t* op = YM + row * 1024 + 256 + h * 64 + 4 * hi;
#pragma unroll
    for (int g = 0; g < 4; ++g) {
        *(uint2*)(op + 8 * g) = make_uint2(cvtpk(o0[4 * g] * rl, o0[4 * g + 1] * rl), cvtpk(o0[4 * g + 2] * rl, o0[4 * g + 3] * rl));
        *(uint2*)(op + 32 + 8 * g) = make_uint2(cvtpk(o1[4 * g] * rl, o1[4 * g + 1] * rl), cvtpk(o1[4 * g + 2] * rl, o1[4 * g + 3] * rl));
    }
    asm volatile("s_waitcnt lgkmcnt(0)\n\ts_barrier" ::: "memory");
#undef AT_DMA
}
}
__device__ __forceinline__ void ph_attn_fast(const Params& P, LAS unsigned char* lds) {
    const bf16_t* Q = (const bf16_t*)(P.ws + WS_BIG + BIG_Q); const bf16_t* Kd = (const bf16_t*)(P.ws + WS_BIG + BIG_K); const bf16_t* KV = (const bf16_t*)(P.ws + WS_BIG + BIG_KV);
    bf16_t* YM = (bf16_t*)(P.ws + WS_YMIX);
    const int G = grid_size();
    for (int v0 = (blockIdx.x % 8) * (G / 8) + blockIdx.x / 8; v0 < 256; v0 += G) {
        const int bh = v0 >> 2, s = v0 & 3;
#pragma unroll 1
        for (int i = 0; i < 4; ++i) { const int qb = (i == 0) ? s : (i == 1) ? 7 - s : (i == 2) ? 8 + s : 15 - s; at::attn_unit(bh >> 3, bh & 7, qb, Q, Kd, KV, YM, lds); }
    }
}


template <bool DRY = false> __device__ __forceinline__ void ph_gla_x(const Params& P, LAS unsigned char* lds) {
    const int tid = opaque_tid(); const int wid = __builtin_amdgcn_readfirstlane(tid >> 6), lane = tid & 63;
    LAS float* kend = (LAS float*)(lds + wid * 8192);
    const bf16_t* Z = (const bf16_t*)(P.ws + WS_BIG + BIG_Z); float* LA = (float*)(P.ws + WS_BIG + BIG_LA);
    float* UPD = DRY ? (float*)(P.ws + WS_Y + 32 * MiB) : (float*)(P.ws + WS_UPD); float* DEC = DRY ? (float*)(P.ws + WS_Y + 64 * MiB) : (float*)(P.ws + WS_DEC); float* LAW = DRY ? (float*)(P.ws + WS_Y) : LA;
    for (int u = blockIdx.x * NWV + wid; u < 2048; u += grid_size() * NWV) {
        const int bh = u >> 6, n = u & 63, b = bh >> 2, h = bh & 3;
        const size_t t0 = (size_t)b * SEQ + n * 64;
        const int k = lane & 31, half = lane >> 5;
        float c[32]; float run = 0.f;
#pragma unroll
        for (int i = 0; i < 32; ++i) { run += LA[(t0 + 32 * half + i) * 128 + h * 32 + k]; c[i] = run; }
        const float tot0 = __shfl(run, k);
        const float add = half ? tot0 : 0.f;
        const float blast = __shfl(run, 32 + k) + tot0;
        float kk[32];
#pragma unroll
        for (int i = 0; i < 32; ++i) kk[i] = bf2f(Z[(t0 + 32 * half + i) * ZW + ZC_GK + h * 32 + k]);
#pragma unroll
        for (int i = 0; i < 32; ++i) {
            const float bc = c[i] + add; const size_t t = t0 + 32 * half + i;
            LAW[t * 128 + h * 32 + k] = bc;
            kend[(32 * half + i) * 32 + k] = kk[i] * __expf(blast - bc);
        }
        if (half == 0) DEC[(size_t)u * 32 + k] = __expf(blast);
        asm volatile("s_waitcnt lgkmcnt(0)" ::: "memory");
        float acc[32];
#pragma unroll
        for (int i = 0; i < 32; ++i) acc[i] = 0.f;
#pragma unroll 4
        for (int j = 0; j < 64; ++j) {
            const float vj = bf2f(Z[(t0 + j) * ZW + ZC_GV + h * 64 + lane]);
#pragma unroll
            for (int kq = 0; kq < 8; ++kq) { const f32x4 ke = *(const LAS f32x4*)(kend + j * 32 + kq * 4); acc[4 * kq] += ke[0] * vj; acc[4 * kq + 1] += ke[1] * vj; acc[4 * kq + 2] += ke[2] * vj; acc[4 * kq + 3] += ke[3] * vj; }
        }
#pragma unroll
        for (int kk = 0; kk < 32; ++kk) UPD[((size_t)u * 32 + kk) * 64 + lane] = acc[kk];
        asm volatile("s_waitcnt lgkmcnt(0)" ::: "memory");
    }
}
__device__ __forceinline__ void ph_gla_scan(const Params& P) {
    const int tz = opaque_tid();
    const float* UPD = (const float*)(P.ws + WS_UPD); const float* DEC = (const float*)(P.ws + WS_DEC); bf16_t* SP = (bf16_t*)(P.ws + WS_SPREV);
    for (int e = blockIdx.x * NTHR + tz; e < 32 * 2048; e += grid_size() * NTHR) {
        const int bh = e >> 11, kv = e & 2047, k = kv >> 6;
        float st = 0.f;
        for (int n8 = 0; n8 < 64; n8 += 8) {
            float dd[8], uu[8];
#pragma unroll
            for (int q = 0; q < 8; ++q) { const size_t u = (size_t)bh * 64 + n8 + q; dd[q] = DEC[u * 32 + k]; uu[q] = UPD[u * 2048 + kv]; }
#pragma unroll
            for (int q = 0; q < 8; ++q) { const size_t u = (size_t)bh * 64 + n8 + q; SP[u * 2048 + kv] = f2bf(st); st = dd[q] * st + uu[q]; }
        }
    }
}
__device__ __forceinline__ void ph_gla_y(const Params& P, int layer, LAS unsigned char* lds) {
    using at::f32x16; using at::s16x4; using at::vtr; using at::cvtpk;
    typedef unsigned u32x4 __attribute__((ext_vector_type(4)));
    const int tid = opaque_tid(); const int wid = __builtin_amdgcn_readfirstlane(tid >> 6), lane = tid & 63, r32 = lane & 31, hi = lane >> 5;
    LAS unsigned char* vl = lds + wid * 12288; LAS unsigned char* sl = vl + 8192;
    const bf16_t* Z = (const bf16_t*)(P.ws + WS_BIG + BIG_Z); const float* LA = (const float*)(P.ws + WS_BIG + BIG_LA); const bf16_t* SP = (const bf16_t*)(P.ws + WS_SPREV);
    bf16_t* YM = (bf16_t*)(P.ws + WS_YMIX); const float* gon = P.gla_on + layer * 64;
    const int vfo = ((lane >> 4) & 1) * 32 + (lane & 3) * 8 + (4 * hi + ((lane & 15) >> 2)) * 64;
    const int sfo = ((lane >> 4) & 1) * 32 + (lane & 3) * 8 + ((lane & 15) >> 2) * 64;
    for (int u = blockIdx.x * NWV + wid; u < 2048; u += grid_size() * NWV) {
        const int bh = u >> 6, n = u & 63, b = bh >> 2, h = bh & 3;
        const size_t t0 = (size_t)b * SEQ + n * 64;
#pragma unroll
        for (int p = 0; p < 8; ++p) {
            const int row = 8 * p + (lane >> 3), dv = 8 * (lane & 7);
            const u32x4 x = *(const u32x4*)(Z + (t0 + row) * ZW + ZC_GV + h * 64 + dv);
            *(LAS u32x4*)(vl + (dv >> 5) * 4096 + (row >> 3) * 512 + (row & 7) * 64 + (dv & 31) * 2) = x;
        }
#pragma unroll
        for (int p = 0; p < 4; ++p) {
            const int row = 8 * p + (lane >> 3), dv = 8 * (lane & 7);
            const u32x4 x = *(const u32x4*)(SP + ((size_t)u * 32 + row) * 64 + dv);
            *(LAS u32x4*)(sl + (dv >> 5) * 2048 + (row >> 3) * 512 + (row & 7) * 64 + (dv & 31) * 2) = x;
        }
        bf16x8 qfr[2][2], kfr[2][2];
#pragma unroll
        for (int blk = 0; blk < 2; ++blk)
#pragma unroll
            for (int ks = 0; ks < 2; ++ks) {
                const size_t t = t0 + 32 * blk + r32; const int k0 = 16 * ks + 8 * hi;
                const uint4 qraw = *(const uint4*)(Z + t * ZW + ZC_GQ + h * 32 + k0), kraw = *(const uint4*)(Z + t * ZW + ZC_GK + h * 32 + k0);
                const f32x4 b0 = *(const f32x4*)(LA + t * 128 + h * 32 + k0), b1 = *(const f32x4*)(LA + t * 128 + h * 32 + k0 + 4);
                const unsigned qw[4] = {qraw.x, qraw.y, qraw.z, qraw.w}, kw[4] = {kraw.x, kraw.y, kraw.z, kraw.w};
                const float bcv[8] = {b0[0], b0[1], b0[2], b0[3], b1[0], b1[1], b1[2], b1[3]};
                u32x4 qo, ko;
#pragma unroll
                for (int w = 0; w < 4; ++w) {
                    const float e0 = __expf(bcv[2 * w]), e1 = __expf(bcv[2 * w + 1]);
                    const float q0 = bf2f(qw[w] & 0xffff) * 0.17677669529663687f * e0, q1 = bf2f(qw[w] >> 16) * 0.17677669529663687f * e1;
                    const float k0f = bf2f(kw[w] & 0xffff) * __expf(-bcv[2 * w]), k1f = bf2f(kw[w] >> 16) * __expf(-bcv[2 * w + 1]);
                    qo[w] = cvtpk(q0, q1); ko[w] = cvtpk(k0f, k1f);
                }
                qfr[blk][ks] = __builtin_bit_cast(bf16x8, qo); kfr[blk][ks] = __builtin_bit_cast(bf16x8, ko);
            }
        f32x16 z16;
#pragma unroll
        for (int r = 0; r < 16; ++r) z16[r] = 0.f;
        f32x16 s00 = __builtin_amdgcn_mfma_f32_32x32x16_bf16(kfr[0][0], qfr[0][0], z16, 0, 0, 0); s00 = __builtin_amdgcn_mfma_f32_32x32x16_bf16(kfr[0][1], qfr[0][1], s00, 0, 0, 0);
        f32x16 s01 = __builtin_amdgcn_mfma_f32_32x32x16_bf16(kfr[0][0], qfr[1][0], z16, 0, 0, 0); s01 = __builtin_amdgcn_mfma_f32_32x32x16_bf16(kfr[0][1], qfr[1][1], s01, 0, 0, 0);
        f32x16 s11 = __builtin_amdgcn_mfma_f32_32x32x16_bf16(kfr[1][0], qfr[1][0], z16, 0, 0, 0); s11 = __builtin_amdgcn_mfma_f32_32x32x16_bf16(kfr[1][1], qfr[1][1], s11, 0, 0, 0);
#pragma unroll
        for (int r = 0; r < 16; ++r) { const int jl = (r & 3) + 8 * (r >> 2) + 4 * hi; if (jl > r32) { s00[r] = 0.f; s11[r] = 0.f; } }
        bf16x8 p00[2], p01[2], p11[2];
#pragma unroll
        for (int sp = 0; sp < 2; ++sp) {
            u32x4 a, c, d;
#pragma unroll
            for (int w = 0; w < 4; ++w) { a[w] = cvtpk(s00[8 * sp + 2 * w], s00[8 * sp + 2 * w + 1]); c[w] = cvtpk(s01[8 * sp + 2 * w], s01[8 * sp + 2 * w + 1]); d[w] = cvtpk(s11[8 * sp + 2 * w], s11[8 * sp + 2 * w + 1]); }
            p00[sp] = __builtin_bit_cast(bf16x8, a); p01[sp] = __builtin_bit_cast(bf16x8, c); p11[sp] = __builtin_bit_cast(bf16x8, d);
        }
        asm volatile("s_waitcnt lgkmcnt(0)" ::: "memory");
        f32x16 o[2][2];
#pragma unroll
        for (int vb = 0; vb < 2; ++vb) {
            o[vb][0] = z16; o[vb][1] = z16;
#pragma unroll
            for (int k2 = 0; k2 < 4; ++k2) {
                const s16x4 a0 = vtr(vl + vfo + vb * 4096 + k2 * 1024), a1 = vtr(vl + vfo + vb * 4096 + k2 * 1024 + 512);
                const bf16x8 vt = {a0[0], a0[1], a0[2], a0[3], a1[0], a1[1], a1[2], a1[3]};
                if (k2 < 2) { o[vb][0] = __builtin_amdgcn_mfma_f32_32x32x16_bf16(vt, p00[k2], o[vb][0], 0, 0, 0); o[vb][1] = __builtin_amdgcn_mfma_f32_32x32x16_bf16(vt, p01[k2], o[vb][1], 0, 0, 0); }
                else o[vb][1] = __builtin_amdgcn_mfma_f32_32x32x16_bf16(vt, p11[k2 - 2], o[vb][1], 0, 0, 0);
            }
#pragma unroll
            for (int ks = 0; ks < 2; ++ks) {
                const s16x4 a0 = vtr(sl + sfo + vb * 2048 + (2 * ks + hi) * 512), a1 = vtr(sl + sfo + vb * 2048 + (2 * ks + hi) * 512 + 256);
                const bf16x8 st = {a0[0], a0[1], a0[2], a0[3], a1[0], a1[1], a1[2], a1[3]};
                o[vb][0] = __builtin_amdgcn_mfma_f32_32x32x16_bf16(st, qfr[0][ks], o[vb][0], 0, 0, 0);
                o[vb][1] = __builtin_amdgcn_mfma_f32_32x32x16_bf16(st, qfr[1][ks], o[vb][1], 0, 0, 0);
            }
        }
#pragma unroll
        for (int ib = 0; ib < 2; ++ib) {
            const size_t t = t0 + 32 * ib + r32;
            float ss = 0.f;
#pragma unroll
            for (int r = 0; r < 16; ++r) ss += o[0][ib][r] * o[0][ib][r] + o[1][ib][r] * o[1][ib][r];
            ss = at::xhalf_sum(ss);
            const float rstd = rsqrtf(ss * (1.0f / 64.0f) + EPS);
#pragma unroll
            for (int vb = 0; vb < 2; ++vb)
#pragma unroll
                for (int g = 0; g < 4; ++g) {
                    const int v0 = 32 * vb + 8 * g + 4 * hi;
                    const uint2 rr = *(const uint2*)(Z + t * ZW + ZC_GR + h * 64 + v0); const f32x4 gn = *(const f32x4*)(gon + v0);
                    const float r0 = bf2f(rr.x & 0xffff), r1 = bf2f(rr.x >> 16), r2 = bf2f(rr.y & 0xffff), r3 = bf2f(rr.y >> 16);
                    const float y0 = o[vb][ib][4 * g] * rstd * gn[0] * r0 * sigmoidf_(r0), y1 = o[vb][ib][4 * g + 1] * rstd * gn[1] * r1 * sigmoidf_(r1);
                    const float y2 = o[vb][ib][4 * g + 2] * rstd * gn[2] * r2 * sigmoidf_(r2), y3 = o[vb][ib][4 * g + 3] * rstd * gn[3] * r3 * sigmoidf_(r3);
                    *(uint2*)(YM + t * 1024 + h * 64 + v0) = make_uint2(cvtpk(y0, y1), cvtpk(y2, y3));
                }
        }
        asm volatile("s_waitcnt lgkmcnt(0)" ::: "memory");
    }
}


template <int L> __device__ __forceinline__ void layer_body(const Params& P, const XcdBarrier& bar, unsigned char* lds) {
    constexpr int l = L; char* ws = P.ws; LAS unsigned char* ldsl = (LAS unsigned char*)lds;
    const bf16_t* HB = (const bf16_t*)(ws + WS_HB); const float* RS = (const float*)(ws + WS_RSTD);
    bf16_t* Z = (bf16_t*)(ws + WS_BIG + BIG_Z);
    {
        const char* wsm = ws + WS_WSM + (size_t)l * WSM_STRIDE;
        { EpiBf16_8 e{(bf16_t*)(ws + WS_E), 1024}; ph_gemm_fast<256, 256, true>(ldsl, (const bf16_t*)(ws + WS_PB) + (size_t)l * T * 256, (const bf16_t*)(wsm + WSM_WPLE), 1024, e); }
        { EpiZ8 e{Z, RS}; if constexpr (Z_FP8) ph_gemm_fast<512, 512, true, EpiZ8, true>(ldsl, (const bf16_t*)(ws + WS_H8), (const bf16_t*)(wsm + WSM_WIN), ZW, e);
          else ph_gemm_fast<1024, 1024, true>(ldsl, HB, (const bf16_t*)(wsm + WSM_WIN), ZW, e); }
        xcd_barrier(bar);
        ph_prepB(P, l, lds);
        xcd_barrier(bar);
        { EpiBf16_8 e{(bf16_t*)(ws + WS_BIG + BIG_Q), 768}; ph_gemm_fast<256, ZW, true>(ldsl, Z + ZC_CQ, (const bf16_t*)(wsm + WSM_WUQ), 768, e); }
        { EpiBf16_8 e{(bf16_t*)(ws + WS_BIG + BIG_KV), 1024}; ph_gemm_fast<128, ZW, true>(ldsl, Z + ZC_CKV, (const bf16_t*)(wsm + WSM_WUKV), 1024, e); }
        __syncthreads();
        ph_gla_x(P, ldsl);
        xcd_barrier(bar);
        ph_prepD(P, l);
        ph_gla_scan(P);
        xcd_barrier(bar);
        if ((blockIdx.x >> 3) & 1) { ph_tconv_exp<(L == 0 ? MOE_FP8_L0 : MOE_FP8_L1)>(P, l, ldsl); }
        ph_attn_fast(P, ldsl);
        ph_gla_y(P, l, ldsl);
        if (!((blockIdx.x >> 3) & 1)) { __syncthreads(); ph_tconv_exp<(L == 0 ? MOE_FP8_L0 : MOE_FP8_L1)>(P, l, ldsl); }
        xcd_barrier(bar);
        { EpiResid8 e{l == 0 ? P.x : nullptr, (bf16_t*)(ws + WS_HB)}; ph_gemm_fast<1024, 1024, true>(ldsl, (const bf16_t*)(ws + WS_YMIX), (const bf16_t*)(wsm + WSM_WOUT), 1024, e); }
        xcd_barrier(bar);
        ph_router<(L == 0 ? MOE_FP8_L0 : MOE_FP8_L1)>(P, l, ldsl);
        xcd_barrier(bar);
        ph_moe_fast<true, (L == 0 ? MOE_FP8_L0 : MOE_FP8_L1)>(P, l, ldsl);
        xcd_barrier(bar);
        ph_moe_fast<false, (L == 0 ? MOE_FP8_L0 : MOE_FP8_L1)>(P, l, ldsl);
        xcd_barrier(bar);
        ph_combine<(L == 0 ? MOE_FP8_L0 : MOE_FP8_L1)>(P);
        xcd_barrier(bar);
        { EpiPle8 e{(const bf16_t*)(ws + WS_E), RS + 2 * T, (bf16_t*)(ws + WS_YMIX)}; if constexpr (PG_FP8) ph_gemm_fast<512, 512, true, EpiPle8, true>(ldsl, (const bf16_t*)(ws + WS_H8B), (const bf16_t*)(wsm + WSM_WPG), 1024, e);
          else ph_gemm_fast<1024, 1024, true>(ldsl, HB, (const bf16_t*)(wsm + WSM_WPG), 1024, e); }
        xcd_barrier(bar);
        ph_final(P, l);
        xcd_barrier(bar);
    }
}

__global__ void __launch_bounds__(NTHR, 2) mega_fwd(Params P) {
    extern __shared__ __attribute__((aligned(16))) unsigned char lds[];
    char* ws = P.ws;
    if (threadIdx.x == 0) *(uint4*)(lds + LDS_BAR_OFF) = make_uint4(0u, 0u, (unsigned)P.grid, 0u);
    if ((threadIdx.x & 63) == 0) *(volatile LAS int*)((LAS unsigned char*)lds + LDS_WID_OFF + hw_wave_key() * 4) = (int)(threadIdx.x >> 6);
    __syncthreads();
    const XcdBarrier bar = xcd_barrier_post((unsigned*)(ws + WS_CTL), (volatile LAS unsigned*)(lds + LDS_BAR_OFF));
    const bf16_t* HB = (const bf16_t*)(ws + WS_HB); const float* RS = (const float*)(ws + WS_RSTD);
    bf16_t* Z = (bf16_t*)(ws + WS_BIG + BIG_Z);
    ph_tconv_small(P, lds);
    ph_conv_bf16(P.p, (bf16_t*)(ws + WS_PB), (long)2 * T * 256 / 8);
    ph_prep_router(P);
    ph_init_h(P);
    ph_rope_table(P);
    xcd_barrier(bar);
    layer_body<0>(P, bar, lds);
    layer_body<1>(P, bar, lds);
}

extern "C" void kernel_launch(void* const* d_in, const int* in_sizes, int n_in, void* d_out, int out_size, void* d_ws, size_t ws_size, hipStream_t stream) {
    if (n_in != 30 || ws_size < WS_END) { fprintf(stderr, "kernel_launch: need 30 inputs and %zu bytes of workspace (got %d, %zu)\n", (size_t)WS_END, n_in, ws_size); return; }
    static int grid = 0;
    if (!grid) {
        int dev = 0, cus = 0, per_cu = 0;
        if (hipGetDevice(&dev) != hipSuccess || hipDeviceGetAttribute(&cus, hipDeviceAttributeMultiprocessorCount, dev) != hipSuccess) { fprintf(stderr, "kernel_launch: device query failed\n"); return; }
        if (hipFuncSetAttribute((const void*)mega_fwd, hipFuncAttributeMaxDynamicSharedMemorySize, LDS_BYTES) != hipSuccess) { fprintf(stderr, "kernel_launch: hipFuncSetAttribute failed\n"); return; }
        if (hipOccupancyMaxActiveBlocksPerMultiprocessor(&per_cu, (const void*)mega_fwd, NTHR, LDS_BYTES) != hipSuccess || per_cu < 1) { fprintf(stderr, "kernel_launch: occupancy query says %d\n", per_cu); return; }
        grid = cus;
    }
    Params P{};
    P.x = (const float*)d_in[0]; P.p = (const float*)d_in[1]; P.pos = (const int*)d_in[2];
    P.mix_norm = (const float*)d_in[3]; P.w_in = (const float*)d_in[4]; P.gla_wg = (const float*)d_in[5]; P.gla_bg = (const float*)d_in[6]; P.gla_on = (const float*)d_in[7];
    P.q_norm = (const float*)d_in[8]; P.w_uq = (const float*)d_in[9]; P.kv_norm = (const float*)d_in[10]; P.w_ukv = (const float*)d_in[11]; P.qkq = (const float*)d_in[12]; P.qkk = (const float*)d_in[13];
    P.pool_w = (const float*)d_in[14]; P.pool_s = (const float*)d_in[15]; P.w_out = (const float*)d_in[16]; P.ffn_norm = (const float*)d_in[17]; P.router_w = (const float*)d_in[18]; P.router_b = (const float*)d_in[19];
    P.moe_wg = (const float*)d_in[20]; P.moe_bg = (const float*)d_in[21]; P.moe_wu = (const float*)d_in[22]; P.moe_bu = (const float*)d_in[23]; P.moe_wd = (const float*)d_in[24]; P.moe_bd = (const float*)d_in[25];
    P.ple_wp = (const float*)d_in[26]; P.ple_gn = (const float*)d_in[27]; P.ple_wg = (const float*)d_in[28]; P.ple_pn = (const float*)d_in[29];
    P.out = (float*)d_out; P.ws = (char*)d_ws; P.grid = grid; P.pad_ = 0;
    (void)hipMemsetAsync((char*)d_ws + WS_CTL, 0, 65536, stream);
    hipLaunchKernelGGL(mega_fwd, dim3(grid), dim3(NTHR), LDS_BYTES, stream, P);
}
```

```cpp
#include <hip/hip_runtime.h>
#include <cstdio>
#include <cstdint>

typedef unsigned short bf16_t;
typedef short bf16x8 __attribute__((ext_vector_type(8)));
typedef float f32x4 __attribute__((ext_vector_type(4)));
typedef unsigned u32x4_t __attribute__((ext_vector_type(4)));

constexpr int T = 32768, DM = 1024, SEQ = 4096, NBATCH = 8, DEPTH = 2;
constexpr int ZW = 1536;
constexpr int ZC_CQ = 0, ZC_GV = 256, ZC_GR = 512, ZC_UP = 768, ZC_GQ = 1024, ZC_GK = 1152, ZC_CKV = 1280, ZC_KR = 1408, ZC_GLOW = 1440;
constexpr int NE = 32, TOPK = 4, DFF = 1024;
constexpr int HROWS = 139264;
constexpr float EPS = 1e-6f;

__host__ __device__ inline int zsrc(int n) {
    if (n < 256) return 784 + n;
    if (n < 512) return 256 + (n - 256);
    if (n < 768) return 528 + (n - 512);
    if (n < 1024) return 1200 + (n - 768);
    if (n < 1152) return n - 1024;
    if (n < 1280) return 128 + (n - 1152);
    if (n < 1408) return 1040 + (n - 1280);
    if (n < 1440) return 1168 + (n - 1408);
    if (n < 1456) return 512 + (n - 1440);
    return -1;
}

constexpr size_t MiB = 1024 * 1024;
constexpr size_t WS_CTL = 0;
constexpr size_t WS_HB = 1 * MiB;
constexpr size_t WS_RSTD = WS_HB + 64 * MiB;
constexpr size_t WS_WSM = WS_RSTD + 1 * MiB;
constexpr size_t WSM_WIN = 0, WSM_WUQ = 3 * MiB, WSM_WUKV = WSM_WUQ + 384 * 1024, WSM_WOUT = WSM_WUKV + 256 * 1024, WSM_WPG = WSM_WOUT + 2 * MiB,
                 WSM_WPLE = WSM_WPG + 2 * MiB, WSM_WR = WSM_WPLE + 512 * 1024, WSM_WPT = WSM_WR + 128 * 1024, WSM_STRIDE = WSM_WR + 128 * 1024 + 128 * 1024;
constexpr size_t WS_PB = WS_WSM + 2 * WSM_STRIDE;
constexpr size_t WS_W1 = WS_PB + 32 * MiB;
constexpr size_t WS_W2 = WS_W1 + 128 * MiB;
constexpr size_t WS_E = WS_W2 + 64 * MiB;
constexpr size_t WS_YMIX = WS_E + 64 * MiB;
constexpr size_t WS_Y = WS_YMIX + 64 * MiB;
constexpr size_t WS_UPD = WS_Y + 256 * MiB;
constexpr size_t WS_DEC = WS_UPD + 16 * MiB;
constexpr size_t WS_SPREV = WS_DEC + 1 * MiB;
constexpr size_t WS_TOPG = WS_SPREV + 8 * MiB;
constexpr size_t WS_LIST = WS_TOPG + 1 * MiB;
constexpr size_t WS_BIG = WS_LIST + 4 * MiB;
constexpr size_t BIG_Z = 0, BIG_Q = 96 * MiB, BIG_KV = BIG_Q + 48 * MiB, BIG_K = BIG_KV + 64 * MiB, BIG_LA = BIG_K + 48 * MiB;
constexpr size_t WS_ROPE = WS_BIG + 272 * MiB;
constexpr size_t WS_LRS = WS_ROPE + 4 * MiB;
constexpr size_t WS_LGT = WS_LRS + 4 * MiB;
constexpr size_t WS_END = WS_LGT + 4 * MiB;
constexpr int CTL_CNT = 4096;

constexpr bool MOE_FP8_L0 = true, MOE_FP8_L1 = true;
constexpr bool Z_FP8 = false, PG_FP8 = true;
constexpr size_t WS_H8 = WS_Y;
constexpr size_t WS_H8B = WS_BIG;
__device__ __forceinline__ float bf2f(bf16_t v) { return __uint_as_float(((unsigned)v) << 16); }
__device__ __forceinline__ bf16_t f2bf(float f) { unsigned u = __float_as_uint(f); u += 0x7FFFu + ((u >> 16) & 1u); return (bf16_t)(u >> 16); }
typedef float f32x2 __attribute__((ext_vector_type(2))); typedef __bf16 bf16x2h __attribute__((ext_vector_type(2)));
__device__ __forceinline__ unsigned pack2(float lo, float hi) { return (unsigned)f2bf(lo) | ((unsigned)f2bf(hi) << 16); }
__device__ __forceinline__ unsigned pack2h(float lo, float hi) { const f32x2 v = {lo, hi}; return __builtin_bit_cast(unsigned, __builtin_convertvector(v, bf16x2h)); }
__device__ __forceinline__ unsigned pack2v(f32x2 v) { return __builtin_bit_cast(unsigned, __builtin_convertvector(v, bf16x2h)); }
template <int CTRL> __device__ __forceinline__ float dppx(float v) { return __int_as_float(__builtin_amdgcn_update_dpp(0, __float_as_int(v), CTRL, 0xf, 0xf, true)); }
__device__ __forceinline__ unsigned pack4_fp8(float x0, float x1, float x2, float x3) { int w = 0; w = __builtin_amdgcn_cvt_pk_fp8_f32(x0, x1, w, false); w = __builtin_amdgcn_cvt_pk_fp8_f32(x2, x3, w, true); return (unsigned)w; }
__device__ __forceinline__ float wave_sum(float v) {
    v += dppx<0xB1>(v); v += dppx<0x4E>(v); v += dppx<0x141>(v); v += dppx<0x140>(v);
    { auto rr = __builtin_amdgcn_permlane16_swap(__float_as_uint(v), __float_as_uint(v), false, false); v = __uint_as_float(rr[0]) + __uint_as_float(rr[1]); }
    { auto rr = __builtin_amdgcn_permlane32_swap(__float_as_uint(v), __float_as_uint(v), false, false); v = __uint_as_float(rr[0]) + __uint_as_float(rr[1]); }
    return v;
}
__device__ __forceinline__ float wave_max(float v) {
    v = fmaxf(v, dppx<0xB1>(v)); v = fmaxf(v, dppx<0x4E>(v)); v = fmaxf(v, dppx<0x141>(v)); v = fmaxf(v, dppx<0x140>(v));
    { auto rr = __builtin_amdgcn_permlane16_swap(__float_as_uint(v), __float_as_uint(v), false, false); v = fmaxf(__uint_as_float(rr[0]), __uint_as_float(rr[1])); }
    { auto rr = __builtin_amdgcn_permlane32_swap(__float_as_uint(v), __float_as_uint(v), false, false); v = fmaxf(__uint_as_float(rr[0]), __uint_as_float(rr[1])); }
    return v;
}
namespace at {
typedef float f32x16 __attribute__((ext_vector_type(16)));
__device__ __forceinline__ float xhalf_max(float v) { auto rr = __builtin_amdgcn_permlane32_swap(__float_as_uint(v), __float_as_uint(v), false, false); return fmaxf(__uint_as_float(rr[0]), __uint_as_float(rr[1])); }
__device__ __forceinline__ float xhalf_sum(float v) { auto rr = __builtin_amdgcn_permlane32_swap(__float_as_uint(v), __float_as_uint(v), false, false); return __uint_as_float(rr[0]) + __uint_as_float(rr[1]); }
}
__device__ __forceinline__ float sigmoidf_(float x) { return __builtin_amdgcn_rcpf(1.0f + __builtin_amdgcn_exp2f(-1.4426950408889634f * x)); }


#define XB_TMO      128
#define XB_XCNT(j)  (256  + 64 * (j))
#define XB_XSUB(j)  (1280 + 64 * (j))
#define XB_XGEN(j)  (2304 + 64 * (j))
#define XB_TOP      3328
#define XB_TOPGEN   3392
#define XCD_BAR_WORDS 3456
#define XB_SPIN_CAP (1u << 18)
#define LAS __attribute__((address_space(3)))

constexpr int LDS_WID_OFF = 147456 - 16 - 256, LDS_GRID_OFF = 147456 - 16 + 8;
__device__ __forceinline__ int grid_size() { extern __shared__ __attribute__((aligned(16))) unsigned char lds_dyn_[]; return __builtin_amdgcn_readfirstlane(*(const volatile LAS int*)((LAS unsigned char*)lds_dyn_ + LDS_GRID_OFF)); }
__device__ __forceinline__ unsigned hw_wave_key() { return (unsigned)__builtin_amdgcn_s_getreg((5 << 11) | 4) & 63u; }
__device__ __forceinline__ int opaque_tid() {
    extern __shared__ __attribute__((aligned(16))) unsigned char lds_dyn_[];
    const int wv = __builtin_amdgcn_readfirstlane(*(const volatile LAS int*)((LAS unsigned char*)lds_dyn_ + LDS_WID_OFF + hw_wave_key() * 4));
    int ln; asm volatile("v_mbcnt_lo_u32_b32 %0, -1, 0\n\tv_mbcnt_hi_u32_b32 %0, -1, %0" : "=v"(ln));
    int t = wv * 64 + ln;
    asm volatile("" : "+v"(t)); return t;
}

__device__ __forceinline__ unsigned xb_ld(unsigned* p)              { return __hip_atomic_load(p, __ATOMIC_RELAXED, __HIP_MEMORY_SCOPE_AGENT); }
__device__ __forceinline__ unsigned xb_add(unsigned* p, unsigned v) { return __hip_atomic_fetch_add(p, v, __ATOMIC_RELAXED, __HIP_MEMORY_SCOPE_AGENT); }
__device__ __forceinline__ unsigned xb_xcc_id() { return (unsigned)__builtin_amdgcn_s_getreg((3 << 11) | 20) & 0xFu; }
#define XB_SPIN(cond, bar) do { unsigned _sp = 0; while (cond) { __builtin_amdgcn_s_sleep(1); \
    if ((++_sp & 255u) == 0u) { if (xb_ld(&(bar)[XB_TMO])) break; if (_sp > XB_SPIN_CAP) { atomicAdd(&(bar)[XB_TMO], 1u); break; } } } } while (0)

struct XcdBarrier {
    unsigned* bar; unsigned x;
    volatile LAS unsigned* st;
};

__device__ __forceinline__ XcdBarrier xcd_barrier_post(unsigned* bar, volatile LAS unsigned* st) {
    XcdBarrier b; b.bar = bar; b.x = xb_xcc_id(); b.st = st;
    if (threadIdx.x == 0) (void)xb_add(&bar[XB_XCNT(b.x)], 1u);
    return b;
}
__device__ __forceinline__ void xcd_barrier_complete(unsigned* bar, unsigned x, unsigned& nloc, unsigned& nx) {
    const unsigned G = (unsigned)grid_size();
    unsigned sum, cnt, mine, sp = 0u;
    for (;;) {
        sum = 0u; cnt = 0u; mine = 0u;
#pragma unroll
        for (unsigned j = 0; j < 16; ++j) { const unsigned c = xb_ld(&bar[XB_XCNT(j)]); sum += c; cnt += (c > 0u) ? 1u : 0u; mine = (j == x) ? c : mine; }
        if (sum == G) break;
        __builtin_amdgcn_s_sleep(1);
        if ((++sp & 255u) == 0u) { if (xb_ld(&bar[XB_TMO])) break; if (sp > XB_SPIN_CAP) { atomicAdd(&bar[XB_TMO], 1u); break; } }
    }
    nloc = mine > 0u ? mine : 1u; nx = cnt > 0u ? cnt : 1u;
}

__device__ __forceinline__ void xcd_barrier(const XcdBarrier& b) {
    asm volatile("s_waitcnt vmcnt(0)" ::: "memory");
    __syncthreads();
    if (opaque_tid() == 0) {
        unsigned* bar = b.bar;
        __builtin_amdgcn_s_waitcnt(0);
        unsigned nloc = b.st[0], nx = b.st[1];
        if (nloc == 0u) { xcd_barrier_complete(bar, b.x, nloc, nx); b.st[0] = nloc; b.st[1] = nx; }
        const unsigned old = xb_add(&bar[XB_XSUB(b.x)], 1u);
        const unsigned gen = old / nloc;
        if (old + 1u == (gen + 1u) * nloc) {
            __builtin_amdgcn_fence(__ATOMIC_RELEASE, "agent");
            asm volatile("s_waitcnt vmcnt(0)" ::: "memory");
            const unsigned og = xb_add(&bar[XB_TOP], 1u);
            const unsigned tg = og / nx;
            if (og + 1u == (tg + 1u) * nx) xb_add(&bar[XB_TOPGEN], 1u);
            else XB_SPIN(xb_ld(&bar[XB_TOPGEN]) == tg, bar);
            __builtin_amdgcn_fence(__ATOMIC_ACQUIRE, "agent");
            xb_add(&bar[XB_XGEN(b.x)], 1u);
            asm volatile("s_waitcnt vmcnt(0)" ::: "memory");
        } else {
            XB_SPIN(xb_ld(&bar[XB_XGEN(b.x)]) == gen, bar);
            __builtin_amdgcn_fence(__ATOMIC_ACQUIRE, "agent");
            asm volatile("s_waitcnt vmcnt(0)" ::: "memory");
        }
    }
    __syncthreads();
}

struct Params {
    const float *x, *p; const int* pos;
    const float *mix_norm, *w_in, *gla_wg, *gla_bg, *gla_on, *q_norm, *w_uq, *kv_norm, *w_ukv, *qkq, *qkk, *pool_w, *pool_s, *w_out, *ffn_norm, *router_w, *router_b,
        *moe_wg, *moe_bg, *moe_wu, *moe_bu, *moe_wd, *moe_bd, *ple_wp, *ple_gn, *ple_wg, *ple_pn;
    float* out; char* ws; int grid; int pad_;
};


constexpr int NTHR = 512, NWV = 8;
constexpr int LDS_BYTES = 147456;
constexpr int LDS_BAR_OFF = LDS_BYTES - 16;


struct TcsTile { const float* src; const float* gain; bf16_t* dst; int K, ld, n0, k0; int mode; bool f8; };
__device__ __forceinline__ TcsTile tcs_tile(const Params& P, int u) {
    constexpr int U_IN = 24 * 16, U_UQ = 12 * 4, U_KV = 16 * 2, U_OUT = 16 * 16, U_PG = 16 * 16, U_PP = 16 * 4, U_L = U_IN + U_UQ + U_KV + U_OUT + U_PG + U_PP;
    TcsTile t; const int l = u / U_L; int r = u % U_L; int N;
    char* wsm = P.ws + WS_WSM + (size_t)l * WSM_STRIDE; t.f8 = false; t.mode = 0;
    if (r < U_IN) { t.src = P.w_in + (size_t)l * 1024 * 1456; t.gain = P.mix_norm + l * 1024; t.dst = (bf16_t*)(wsm + WSM_WIN); N = ZW; t.K = 1024; t.ld = 1456; t.mode = 1; t.f8 = Z_FP8; }
    else if ((r -= U_IN) < U_UQ) { t.src = P.w_uq + (size_t)l * 256 * 768; t.gain = P.q_norm + l * 256; t.dst = (bf16_t*)(wsm + WSM_WUQ); N = 768; t.K = 256; t.ld = 768; }
    else if ((r -= U_UQ) < U_KV) { t.src = P.w_ukv + (size_t)l * 128 * 1024; t.gain = P.kv_norm + l * 128; t.dst = (bf16_t*)(wsm + WSM_WUKV); N = 1024; t.K = 128; t.ld = 1024; }
    else if ((r -= U_KV) < U_OUT) { t.src = P.w_out + (size_t)l * 1024 * 1024; t.gain = nullptr; t.dst = (bf16_t*)(wsm + WSM_WOUT); N = 1024; t.K = 1024; t.ld = 1024; }
    else if ((r -= U_OUT) < U_PG) { t.src = P.ple_wg + (size_t)l * 1024 * 1024; t.gain = P.ple_gn + l * 1024; t.dst = (bf16_t*)(wsm + WSM_WPG); N = 1024; t.K = 1024; t.ld = 1024; t.f8 = PG_FP8; }
    else { r -= U_PG; t.src = P.ple_wp + (size_t)l * 256 * 1024; t.gain = nullptr; t.dst = (bf16_t*)(wsm + WSM_WPLE); N = 1024; t.K = 256; t.ld = 1024; }
    const int nx = N / 64; t.n0 = (r % nx) * 64; t.k0 = (r / nx) * 64; return t;
}
__device__ __forceinline__ void ph_tconv_small(const Params& P, unsigned char* lds) {
    const int tz = opaque_tid(); const int tid = tz & 255, half = tz >> 8, tx = tid & 63, ty = tid >> 6;
    float (*tile)[65] = (float (*)[65])(lds + half * 16640);
    constexpr int U_L = 24 * 16 + 12 * 4 + 16 * 2 + 16 * 16 + 16 * 16 + 16 * 4;
    const int G2 = grid_size() * 2;
#define TCS_LOAD(t, v, gn) do { const int col_ = ((t).mode == 1) ? zsrc((t).n0 + tx) : (t).n0 + tx; const int colc_ = col_ >= 0 ? col_ : 0; \
        _Pragma("unroll") for (int i = 0; i < 16; ++i) { const int k = (t).k0 + ty + 4 * i; v[i] = (t).src[(long)k * (t).ld + colc_]; gn[i] = (t).gain ? (t).gain[k] : 1.0f; } \
        if (col_ < 0) { _Pragma("unroll") for (int i = 0; i < 16; ++i) gn[i] = 0.f; } } while (0)
#define TCS_FIN(t, v, gn) do { \
        _Pragma("unroll") for (int i = 0; i < 16; ++i) tile[ty + 4 * i][tx] = v[i] * gn[i]; \
        __syncthreads(); \
        const int nl = tid >> 2, ks = (tid & 3) * 16; \
        if ((t).f8) {                                                               \
            *(uint4*)((unsigned char*)(t).dst + (long)((t).n0 + nl) * (t).K + (t).k0 + ks) = make_uint4(pack4_fp8(tile[ks + 0][nl] * 64.f, tile[ks + 1][nl] * 64.f, tile[ks + 2][nl] * 64.f, tile[ks + 3][nl] * 64.f), pack4_fp8(tile[ks + 4][nl] * 64.f, tile[ks + 5][nl] * 64.f, tile[ks + 6][nl] * 64.f, tile[ks + 7][nl] * 64.f), \
                                                                                      pack4_fp8(tile[ks + 8][nl] * 64.f, tile[ks + 9][nl] * 64.f, tile[ks + 10][nl] * 64.f, tile[ks + 11][nl] * 64.f), pack4_fp8(tile[ks + 12][nl] * 64.f, tile[ks + 13][nl] * 64.f, tile[ks + 14][nl] * 64.f, tile[ks + 15][nl] * 64.f)); \
        } else { \
            uint4* o = (uint4*)((t).dst + (long)((t).n0 + nl) * (t).K + (t).k0 + ks); \
            o[0] = make_uint4(pack2(tile[ks + 0][nl], tile[ks + 1][nl]), pack2(tile[ks + 2][nl], tile[ks + 3][nl]), pack2(tile[ks + 4][nl], tile[ks + 5][nl]), pack2(tile[ks + 6][nl], tile[ks + 7][nl])); \
            o[1] = make_uint4(pack2(tile[ks + 8][nl], tile[ks + 9][nl]), pack2(tile[ks + 10][nl], tile[ks + 11][nl]), pack2(tile[ks + 12][nl], tile[ks + 13][nl]), pack2(tile[ks + 14][nl], tile[ks + 15][nl])); } \
        __syncthreads(); } while (0)
    for (int u0 = blockIdx.x * 2; u0 < 2 * U_L; u0 += 4 * G2) {
        const bool h1 = u0 + G2 < 2 * U_L, h2 = u0 + 2 * G2 < 2 * U_L, h3 = u0 + 3 * G2 < 2 * U_L;
        const TcsTile ta = tcs_tile(P, u0 + half), tb = tcs_tile(P, (h1 ? u0 + G2 : u0) + half), tc = tcs_tile(P, (h2 ? u0 + 2 * G2 : u0) + half), td = tcs_tile(P, (h3 ? u0 + 3 * G2 : u0) + half);
        float va[16], ga[16], vb[16], gb[16], vc[16], gc[16], vd[16], gd[16];
        TCS_LOAD(ta, va, ga);
        if (h1) TCS_LOAD(tb, vb, gb);
        if (h2) TCS_LOAD(tc, vc, gc);
        if (h3) TCS_LOAD(td, vd, gd);
        TCS_FIN(ta, va, ga);
        if (h1) TCS_FIN(tb, vb, gb);
        if (h2) TCS_FIN(tc, vc, gc);
        if (h3) TCS_FIN(td, vd, gd);
    }
#undef TCS_LOAD
#undef TCS_FIN
}

template <bool FP8> __device__ __forceinline__ void ph_tconv_exp(const Params& P, int layer, LAS unsigned char* lds) {
    const int tid = opaque_tid();
    const int kq = tid >> 6, c4 = tid & 63;
    constexpr int PITCH = FP8 ? 68 : 136;
    LAS unsigned char* tile = lds;
    const float* gain = P.ffn_norm + layer * 1024;
    const int nunits = 3 * 32 * 16 * 4;
    for (int u = blockIdx.x; u < nunits; u += grid_size()) {
        const int nt = u & 3, kt = (u >> 2) & 15, e = (u >> 6) & 31, mat = u >> 11;
        const float* src = (mat == 0 ? P.moe_wg : mat == 1 ? P.moe_wu : P.moe_wd) + ((size_t)layer * 32 + e) * 1024 * 1024 + (size_t)(kt * 64) * 1024 + nt * 256 + c4 * 4;
        f32x4 v[2][4];
#pragma unroll
        for (int g = 0; g < 2; ++g)
#pragma unroll
            for (int r = 0; r < 4; ++r) v[g][r] = __builtin_nontemporal_load((const f32x4*)(src + (size_t)(32 * g + 4 * kq + r) * 1024));
        const float sc = FP8 ? 64.0f : 1.0f;
#pragma unroll
        for (int g = 0; g < 2; ++g)
#pragma unroll
            for (int r = 0; r < 4; ++r) v[g][r] *= (mat < 2 ? gain[kt * 64 + 32 * g + 4 * kq + r] : 1.0f) * sc;
        __syncthreads();
#pragma unroll
        for (int g = 0; g < 2; ++g)
#pragma unroll
            for (int j = 0; j < 4; ++j) {
                if constexpr (FP8) *(LAS unsigned*)(tile + (c4 * 4 + j) * PITCH + 32 * g + 4 * kq) = pack4_fp8(v[g][0][j], v[g][1][j], v[g][2][j], v[g][3][j]);
                else { LAS unsigned* wp_ = (LAS unsigned*)(tile + (c4 * 4 + j) * PITCH + (32 * g + 4 * kq) * 2); wp_[0] = pack2(v[g][0][j], v[g][1][j]); wp_[1] = pack2(v[g][2][j], v[g][3][j]); }
            }
        __syncthreads();
        typedef unsigned u32x4 __attribute__((ext_vector_type(4)));
        unsigned char* dst = (mat < 2) ? (unsigned char*)(P.ws + WS_W1) + (size_t)e * 2048 * (FP8 ? 1024 : 2048) : (unsigned char*)(P.ws + WS_W2) + (size_t)e * 1024 * (FP8 ? 1024 : 2048);
        constexpr int CPR = FP8 ? 4 : 8;
#pragma unroll
        for (int j = 0; j < 256 * CPR / NTHR; ++j) {
            const int id = tid + NTHR * j, nl = id / CPR, ck = id % CPR, n = nt * 256 + nl;
            const int drow = (mat == 2) ? n : ((n >> 7) * 256 + (n & 127) + (mat == 1 ? 128 : 0));
            const LAS unsigned* rp = (const LAS unsigned*)(tile + nl * PITCH + ck * 16);
            const u32x4 o = {rp[0], rp[1], rp[2], rp[3]};
            __builtin_nontemporal_store(o, (u32x4*)(dst + (size_t)drow * (FP8 ? 1024 : 2048) + (size_t)kt * (FP8 ? 64 : 128) + ck * 16));
        }
    }
    __syncthreads();
}
__device__ __forceinline__ void ph_conv_bf16(const float* src, bf16_t* dst, long n8) {
    const int tz = opaque_tid(); const int G = grid_size() * NTHR;
    for (int i0 = blockIdx.x * NTHR + tz; i0 < (int)n8; i0 += 4 * G) {
        float4 a[4], b[4];
#pragma unroll
        for (int q = 0; q < 4; ++q) { const int i = i0 + q * G; if (i < (int)n8) { a[q] = ((const float4*)src)[2 * (size_t)i]; b[q] = ((const float4*)src)[2 * (size_t)i + 1]; } }
#pragma unroll
        for (int q = 0; q < 4; ++q) { const int i = i0 + q * G; if (i < (int)n8) ((uint4*)dst)[i] = make_uint4(pack2(a[q].x, a[q].y), pack2(a[q].z, a[q].w), pack2(b[q].x, b[q].y), pack2(b[q].z, b[q].w)); }
    }
}
__device__ __forceinline__ void ph_prep_router(const Params& P) {
    const int tz = opaque_tid();
    for (int i = blockIdx.x * NTHR + tz; i < 2 * 4 * 64 * 64; i += grid_size() * NTHR) {
        const int l = i >> 14, g = (i >> 12) & 3, d = (i >> 6) & 63, c = i & 63;
        ((bf16_t*)(P.ws + WS_WSM + (size_t)l * WSM_STRIDE + WSM_WPT))[(g * 64 + d) * 64 + c] = f2bf(P.pool_w[(size_t)l * 16384 + (g * 64 + c) * 64 + d]);
    }
    for (int i = blockIdx.x * NTHR + tz; i < 2 * 32 * 1024; i += grid_size() * NTHR) {
        const int l = i >> 15, e = (i >> 10) & 31, k = i & 1023;
        bf16_t* Wr = (bf16_t*)(P.ws + WS_WSM + (size_t)l * WSM_STRIDE + WSM_WR);
        const float w = P.router_w[((size_t)l * 1024 + k) * 32 + e] * P.ffn_norm[l * 1024 + k];
        const bf16_t whi = f2bf(w); Wr[e * 1024 + k] = whi; Wr[32 * 1024 + e * 1024 + k] = f2bf(w - bf2f(whi));
    }
}


__device__ __forceinline__ void ph_rope_table(const Params& P) {
    const int tz = opaque_tid();
    float* RT = (float*)(P.ws + WS_ROPE);
    for (int e = blockIdx.x * NTHR + tz; e < T * 16; e += grid_size() * NTHR) {
        const int t = e >> 4, i = e & 15;
        const float inv = exp2f(-(float)(2 * i) * (1.0f / 32.0f) * 13.287712379549449f);
        const float ang = (float)P.pos[t] * inv;
        const float rev = __builtin_amdgcn_fractf(ang * 0.15915494309189535f);
        RT[(size_t)t * 32 + i] = __builtin_amdgcn_cosf(rev); RT[(size_t)t * 32 + 16 + i] = __builtin_amdgcn_sinf(rev);
    }
}

__device__ __forceinline__ void ph_init_h(const Params& P) {
    const int tz = opaque_tid(); const int wid = tz >> 6, lane = tz & 63;
    bf16_t* HB = (bf16_t*)(P.ws + WS_HB); float* RS = (float*)(P.ws + WS_RSTD);
    for (int t0 = (blockIdx.x * NWV + wid) * 4; t0 < T; t0 += grid_size() * NWV * 4) {
        float4 v[4][4];
#pragma unroll
        for (int tt = 0; tt < 4; ++tt)
#pragma unroll
            for (int i = 0; i < 4; ++i) v[tt][i] = *(const float4*)(P.x + (size_t)(t0 + tt) * 1024 + i * 256 + lane * 4);
#pragma unroll
        for (int tt = 0; tt < 4; ++tt) {
            float ss = 0.f;
#pragma unroll
            for (int i = 0; i < 4; ++i) ss += v[tt][i].x * v[tt][i].x + v[tt][i].y * v[tt][i].y + v[tt][i].z * v[tt][i].z + v[tt][i].w * v[tt][i].w;
            ss = wave_sum(ss);
            if (lane == 0) RS[t0 + tt] = rsqrtf(ss * (1.0f / 1024.0f) + EPS);
#pragma unroll
            for (int i = 0; i < 4; ++i) *(uint2*)(HB + (size_t)(t0 + tt) * 1024 + i * 256 + lane * 4) = make_uint2(pack2(v[tt][i].x, v[tt][i].y), pack2(v[tt][i].z, v[tt][i].w));
            if constexpr (Z_FP8) {
#pragma unroll
                for (int i = 0; i < 4; ++i) *(unsigned*)((unsigned char*)(P.ws + WS_H8) + (size_t)(t0 + tt) * 1024 + i * 256 + lane * 4) = pack4_fp8(v[tt][i].x, v[tt][i].y, v[tt][i].z, v[tt][i].w);
            }
        }
    }
}

__device__ __forceinline__ void ph_prepB(const Params& P, int layer, unsigned char* lds) {
    float* wg = (float*)lds;
    const int tid = opaque_tid(), wid = tid >> 6, lane = tid & 63;
    for (int i = tid; i < 16 * 128; i += NTHR) wg[i] = P.gla_wg[(size_t)layer * 2048 + i];
    LAS unsigned char* wpl = (LAS unsigned char*)lds + 8192; LAS float* pscl = (LAS float*)(wpl + 256 * 144);
    { typedef unsigned u32x4 __attribute__((ext_vector_type(4))); const bf16_t* WpTg = (const bf16_t*)(P.ws + WS_WSM + (size_t)layer * WSM_STRIDE + WSM_WPT);
#pragma unroll
      for (int q = 0; q < 4; ++q) { const int id = tid + q * NTHR, row = id >> 3, ch = id & 7; *(LAS u32x4*)(wpl + row * 144 + ch * 16) = *(const u32x4*)(WpTg + (size_t)row * 64 + ch * 8); }
      if (tid < 256) pscl[tid] = P.pool_s[layer * 256 + tid]; }
    __syncthreads();
    bf16_t* Z = (bf16_t*)(P.ws + WS_BIG + BIG_Z); float* LA = (float*)(P.ws + WS_BIG + BIG_LA); bf16_t* YM = (bf16_t*)(P.ws + WS_YMIX);
    const float* bg = P.gla_bg + layer * 128; const float* psc = P.pool_s + layer * 256;
    const float bg0 = bg[lane], bg1 = bg[lane + 64];
    float wr0[16], wr1[16];
#pragma unroll
    for (int r = 0; r < 16; ++r) { wr0[r] = wg[r * 128 + lane]; wr1[r] = wg[r * 128 + lane + 64]; }
    for (int t0 = (blockIdx.x * NWV + wid) * 2; t0 < T; t0 += grid_size() * NWV * 2) {
        uint2 cq[2]; unsigned ckv[2]; float gl[2];
#pragma unroll
        for (int tt = 0; tt < 2; ++tt) { const bf16_t* zr = Z + (size_t)(t0 + tt) * ZW; cq[tt] = *(const uint2*)(zr + ZC_CQ + lane * 4); ckv[tt] = *(const unsigned*)(zr + ZC_CKV + lane * 2); gl[tt] = (lane < 16) ? bf2f(zr[ZC_GLOW + lane]) : 0.f; }
#pragma unroll
        for (int tt = 0; tt < 2; ++tt) {
            bf16_t* zr = Z + (size_t)(t0 + tt) * ZW;
            {
                const float a = bf2f(cq[tt].x & 0xffff), b = bf2f(cq[tt].x >> 16), c = bf2f(cq[tt].y & 0xffff), d = bf2f(cq[tt].y >> 16);
                const float r = rsqrtf(wave_sum(a * a + b * b + c * c + d * d) * (1.0f / 256.0f) + EPS);
                *(uint2*)(zr + ZC_CQ + lane * 4) = make_uint2(pack2(a * r, b * r), pack2(c * r, d * r));
            }
            {
                const float a = bf2f(ckv[tt] & 0xffff), b = bf2f(ckv[tt] >> 16);
                const float r = rsqrtf(wave_sum(a * a + b * b) * (1.0f / 128.0f) + EPS);
                *(unsigned*)(zr + ZC_CKV + lane * 2) = pack2(a * r, b * r);
            }
            {
                float l0 = bg0, l1 = bg1;
#pragma unroll
                for (int r = 0; r < 16; ++r) { const float g = __uint_as_float(__builtin_amdgcn_readlane(__float_as_uint(gl[tt]), r)); l0 += g * wr0[r]; l1 += g * wr1[r]; }
                const float a0 = fminf(l0, 0.f) - 0.6931471805599453f * __builtin_amdgcn_logf(1.0f + __builtin_amdgcn_exp2f(-1.4426950408889634f * fabsf(l0))), a1 = fminf(l1, 0.f) - 0.6931471805599453f * __builtin_amdgcn_logf(1.0f + __builtin_amdgcn_exp2f(-1.4426950408889634f * fabsf(l1)));
                LA[(size_t)(t0 + tt) * 128 + lane] = a0 * (1.0f / 16.0f); LA[(size_t)(t0 + tt) * 128 + lane + 64] = a1 * (1.0f / 16.0f);
            }
        }
    }
    const bf16_t* WpT = (const bf16_t*)(P.ws + WS_WSM + (size_t)layer * WSM_STRIDE + WSM_WPT);
    const int fr = lane & 15, fq = lane >> 4;
    for (int u = blockIdx.x * NWV + wid; u < T / 16; u += grid_size() * NWV) {
        const int t = u * 16 + fr, sq = t & (SEQ - 1);
        const bool halo = ((u * 16) & (SEQ - 1)) != 0;
        uint4 xr[4][2], pr[4][2];
#pragma unroll
        for (int gi = 0; gi < 4; ++gi)
#pragma unroll
            for (int ks = 0; ks < 2; ++ks) { const bf16_t* up = Z + (size_t)t * ZW + ZC_UP + gi * 64 + ks * 32 + fq * 8; xr[gi][ks] = *(const uint4*)up; pr[gi][ks] = *(const uint4*)(up - (halo ? 16 * ZW : 0)); }
        asm volatile("" ::: "memory");
#pragma unroll
        for (int gi = 0; gi < 4; ++gi) {
            __builtin_amdgcn_sched_barrier(0);
            const int w = 2 << gi; const int cnt = (sq + 1 < w) ? sq + 1 : w; const float rc = 1.0f / (float)cnt;
            bf16x8 af[2];
#pragma unroll
            for (int ks = 0; ks < 2; ++ks) {
                const uint4 x = xr[gi][ks], p = pr[gi][ks];
                const float x0[8] = {bf2f(x.x & 0xffff), bf2f(x.x >> 16), bf2f(x.y & 0xffff), bf2f(x.y >> 16), bf2f(x.z & 0xffff), bf2f(x.z >> 16), bf2f(x.w & 0xffff), bf2f(x.w >> 16)};
                const float hm = halo ? 1.0f : 0.f;
                float sx[8], sp[8] = {hm * bf2f(p.x & 0xffff), hm * bf2f(p.x >> 16), hm * bf2f(p.y & 0xffff), hm * bf2f(p.y >> 16), hm * bf2f(p.z & 0xffff), hm * bf2f(p.z >> 16), hm * bf2f(p.w & 0xffff), hm * bf2f(p.w >> 16)};
#pragma unroll
                for (int e = 0; e < 8; ++e) {
                    float a = x0[e], b = sp[e];
                    { a = a + dppx<0x111>(a) + dppx<0x10F>(b); if (w > 2) b = b + dppx<0x111>(b); }
                    if (w > 2) { a = a + dppx<0x112>(a) + dppx<0x10E>(b); if (w > 4) b = b + dppx<0x112>(b); }
                    if (w > 4) { a = a + dppx<0x114>(a) + dppx<0x10C>(b); if (w > 8) b = b + dppx<0x114>(b); }
                    if (w > 8) { a = a + dppx<0x118>(a) + dppx<0x108>(b); }
                    sx[e] = a;
                }
                typedef unsigned u32x4 __attribute__((ext_vector_type(4)));
                const u32x4 pk = {pack2(sx[0] * rc - x0[0], sx[1] * rc - x0[1]), pack2(sx[2] * rc - x0[2], sx[3] * rc - x0[3]), pack2(sx[4] * rc - x0[4], sx[5] * rc - x0[5]), pack2(sx[6] * rc - x0[6], sx[7] * rc - x0[7])};
                af[ks] = __builtin_bit_cast(bf16x8, pk);
            }
            uint2 yout[4];
#pragma unroll
            for (int nb = 0; nb < 4; ++nb) {
                f32x4 acc = {0.f, 0.f, 0.f, 0.f};
#pragma unroll
                for (int ks = 0; ks < 2; ++ks) { const bf16x8 bfr = *(const LAS bf16x8*)(wpl + (gi * 64 + nb * 16 + fr) * 144 + ks * 64 + fq * 16); acc = __builtin_amdgcn_mfma_f32_16x16x32_bf16(bfr, af[ks], acc, 0, 0, 0); }
                const int d0 = nb * 16 + fq * 4; const f32x4 sc = *(const LAS f32x4*)(pscl + gi * 64 + d0);
                yout[nb] = make_uint2(pack2h(acc[0] * sc[0], acc[1] * sc[1]), pack2h(acc[2] * sc[2], acc[3] * sc[3]));
            }
#pragma unroll
            for (int nb = 0; nb < 4; ++nb) *(uint2*)(YM + (size_t)t * 1024 + 768 + gi * 64 + nb * 16 + fq * 4) = yout[nb];
        }
    }
}

template <bool DRY = false> __device__ __forceinline__ void ph_prepD(const Params& P, int layer) {
    const int tid = opaque_tid(), wid = tid >> 6, lane = tid & 63, g = lane >> 4, li = lane & 15;
    bf16_t* Z = (bf16_t*)(P.ws + WS_BIG + BIG_Z); bf16_t* Q = (bf16_t*)(P.ws + WS_BIG + BIG_Q); const bf16_t* KV = (const bf16_t*)(P.ws + WS_BIG + BIG_KV); bf16_t* Kd = DRY ? (bf16_t*)(P.ws + WS_Y + 64 * MiB) : (bf16_t*)(P.ws + WS_BIG + BIG_K);
    bf16_t* QW = DRY ? (bf16_t*)(P.ws + WS_Y) : Q;
    const float* RT = (const float*)(P.ws + WS_ROPE);
    const bool act = li < 12, rope = li >= 8 && li < 12, x1part = li < 10;
    const int e0 = act ? 8 * li : 0;
    float gq[8], gk[8];
#pragma unroll
    for (int j = 0; j < 8; ++j) { gq[j] = P.qkq[layer * 96 + e0 + j]; gk[j] = P.qkk[layer * 96 + e0 + j]; }
    const float qscale = 0.10206207261596577f * 1.4426950408889634f;
    float gqs[8], gqp[8], gkp[8];
#pragma unroll
    for (int j = 0; j < 8; ++j) { gqs[j] = gq[j] * qscale; gqp[j] = dppx<0x4E>(gqs[j]); gkp[j] = dppx<0x4E>(gk[j]); }
    const float sgn = x1part ? -1.0f : 1.0f;
    typedef unsigned u32x4 __attribute__((ext_vector_type(4)));
    const int i0 = 8 * (li & 1); const int tstep = grid_size() * NWV;
#define PD_LOAD(tt, QR, KR, C0, C1, S0, S1) do { \
        C0 = *(const f32x4*)(RT + (size_t)(tt) * 32 + i0); C1 = *(const f32x4*)(RT + (size_t)(tt) * 32 + i0 + 4); S0 = *(const f32x4*)(RT + (size_t)(tt) * 32 + 16 + i0); S1 = *(const f32x4*)(RT + (size_t)(tt) * 32 + 16 + i0 + 4); \
        _Pragma("unroll") for (int ps = 0; ps < 2; ++ps) { const int h = ps * 4 + g; \
            QR[ps] = *(const u32x4*)(Q + (size_t)(tt) * 768 + h * 96 + e0); \
            KR[ps] = (li < 8) ? *(const u32x4*)(KV + (size_t)(tt) * 1024 + h * 128 + e0) : *(const u32x4*)(Z + (size_t)(tt) * ZW + ZC_KR + (rope ? 8 * (li - 8) : 0)); } } while (0)
    u32x4 qraw[2], kraw[2]; f32x4 c0, c1, s0, s1;
    int t = blockIdx.x * NWV + wid;
    if (t < T) PD_LOAD(t, qraw, kraw, c0, c1, s0, s1);
    for (; t < T; t += tstep) {
        u32x4 qn[2], kn[2]; f32x4 c0n, c1n, s0n, s1n;
        const int tn = t + tstep < T ? t + tstep : t;
        PD_LOAD(tn, qn, kn, c0n, c1n, s0n, s1n);
        const float cs[8] = {c0[0], c0[1], c0[2], c0[3], c1[0], c1[1], c1[2], c1[3]}, sn[8] = {s0[0], s0[1], s0[2], s0[3], s1[0], s1[1], s1[2], s1[3]};
        f32x2 Aq[4], Bq[4], Ak[4], Bk[4];
#pragma unroll
        for (int w = 0; w < 4; ++w) {
            const f32x2 ce = {rope ? cs[2 * w] : 1.0f, rope ? cs[2 * w + 1] : 1.0f}, se = {rope ? sgn * sn[2 * w] : 0.f, rope ? sgn * sn[2 * w + 1] : 0.f};
            Aq[w] = (f32x2){gqs[2 * w], gqs[2 * w + 1]} * ce; Bq[w] = (f32x2){gqp[2 * w], gqp[2 * w + 1]} * se;
            Ak[w] = (f32x2){gk[2 * w], gk[2 * w + 1]} * ce;   Bk[w] = (f32x2){gkp[2 * w], gkp[2 * w + 1]} * se;
        }
#pragma unroll
        for (int ps = 0; ps < 2; ++ps) {
            const int h = ps * 4 + g;
#pragma unroll
            for (int qk = 0; qk < 2; ++qk) {
                u32x4 raw = qk == 0 ? qraw[ps] : kraw[ps];
#pragma unroll
                for (int w = 0; w < 4; ++w) raw[w] = act ? raw[w] : 0u;
                f32x2 x[4];
#pragma unroll
                for (int w = 0; w < 4; ++w) x[w] = (f32x2){bf2f(raw[w] & 0xffff), __uint_as_float(raw[w] & 0xffff0000u)};
                f32x2 s2 = x[0] * x[0];
#pragma unroll
                for (int w = 1; w < 4; ++w) s2 += x[w] * x[w];
                float ss = s2[0] + s2[1];
                ss += dppx<0xB1>(ss); ss += dppx<0x4E>(ss); ss += dppx<0x141>(ss); ss += dppx<0x140>(ss);
                const float r = rsqrtf(ss * (1.0f / 96.0f) + EPS);
                u32x4 o;
#pragma unroll
                for (int w = 0; w < 4; ++w) {
                    const f32x2 xp = {dppx<0x4E>(x[w][0]), dppx<0x4E>(x[w][1])};
                    const f32x2 y = (x[w] * (qk == 0 ? Aq[w] : Ak[w]) + xp * (qk == 0 ? Bq[w] : Bk[w])) * r;
                    o[w] = pack2v(y);
                }
                if (act) { if (qk == 0) *(u32x4*)(QW + (size_t)t * 768 + h * 96 + e0) = o; else *(u32x4*)(Kd + ((size_t)t * 8 + h) * 96 + e0) = o; }
            }
        }
#pragma unroll
        for (int ps = 0; ps < 2; ++ps) { qraw[ps] = qn[ps]; kraw[ps] = kn[ps]; }
        c0 = c0n; c1 = c1n; s0 = s0n; s1 = s1n;
    }
#undef PD_LOAD
}

template <bool FP8> __device__ __forceinline__ void ph_router(const Params& P, int layer, LAS unsigned char* lds) {
    using at::f32x16;
    const int tid = opaque_tid(); const int wid = __builtin_amdgcn_readfirstlane(tid >> 6), lane = tid & 63, r32 = lane & 31, hi = lane >> 5;
    const bf16_t* HB = (const bf16_t*)(P.ws + WS_HB); float* RS1 = (float*)(P.ws + WS_RSTD) + T;
    const bf16_t* WrH = (const bf16_t*)(P.ws + WS_WSM + (size_t)layer * WSM_STRIDE + WSM_WR); const bf16_t* WrL = WrH + 32 * 1024;
    const float* rb = P.router_b + layer * 32;
    unsigned* cnt = (unsigned*)(P.ws + WS_CTL) + CTL_CNT + layer * 32;
    int* LIST = (int*)(P.ws + WS_LIST);
    constexpr int MAXU = 4;
    LAS unsigned* lcnt = (LAS unsigned*)lds; LAS unsigned* lbase = lcnt + 32;
    LAS unsigned* ent = lbase + 32;
    LAS float* entg = (LAS float*)(ent + NWV * MAXU * 128);
    LAS float* entr = entg + NWV * MAXU * 128;
    if (tid < 32) lcnt[tid] = 0u;
    __syncthreads();
    LAS float* part = (LAS float*)(entr + NWV * MAXU * 32);
    bf16x8 a0[8], a1[8];
    { const bf16_t* wh = WrH + (size_t)r32 * 1024 + wid * 128 + hi * 8; const bf16_t* wl_ = WrL + (size_t)r32 * 1024 + wid * 128 + hi * 8;
#pragma unroll
      for (int q = 0; q < 8; ++q) { a0[q] = *(const bf16x8*)(wh + q * 16); a1[q] = *(const bf16x8*)(wl_ + q * 16); } }
    int nu = 0;
    for (int g4 = blockIdx.x; g4 < T / 128; g4 += grid_size(), ++nu) {
        f32x16 acc; float ss = 0.f;
#pragma unroll
        for (int r = 0; r < 16; ++r) acc[r] = 0.f;
#pragma unroll 1
        for (int rd = 0; rd < 2; ++rd) {
            bf16x8 hf[2][8];
#pragma unroll
            for (int uu = 0; uu < 2; ++uu) { const bf16_t* hp = HB + ((size_t)(g4 * 4 + rd * 2 + uu) * 32 + r32) * 1024 + wid * 128 + hi * 8;
#pragma unroll
                for (int q = 0; q < 8; ++q) hf[uu][q] = *(const bf16x8*)(hp + q * 16); }
#pragma unroll
            for (int uu = 0; uu < 2; ++uu) {
                const size_t trow_ = (size_t)(g4 * 4 + rd * 2 + uu) * 32 + r32;
                f32x16 pa; float ps = 0.f;
#pragma unroll
                for (int r = 0; r < 16; ++r) pa[r] = 0.f;
#pragma unroll
                for (int q2 = 0; q2 < 8; q2 += 2) {
                    unsigned hw[2][2];
#pragma unroll
                    for (int qi = 0; qi < 2; ++qi) { const int q = q2 + qi;
                        pa = __builtin_amdgcn_mfma_f32_32x32x16_bf16(a0[q], hf[uu][q], pa, 0, 0, 0);
                        pa = __builtin_amdgcn_mfma_f32_32x32x16_bf16(a1[q], hf[uu][q], pa, 0, 0, 0);
                        float hv[8];
#pragma unroll
                        for (int j = 0; j < 8; ++j) { hv[j] = bf2f((bf16_t)hf[uu][q][j]); ps += hv[j] * hv[j]; }
                        hw[qi][0] = pack4_fp8(hv[0], hv[1], hv[2], hv[3]); hw[qi][1] = pack4_fp8(hv[4], hv[5], hv[6], hv[7]); }
                    if constexpr (FP8) {
                        typedef unsigned u32x4w __attribute__((ext_vector_type(4)));
                        const auto s0_ = __builtin_amdgcn_permlane32_swap(hw[0][0], hw[1][0], false, false), s1_ = __builtin_amdgcn_permlane32_swap(hw[0][1], hw[1][1], false, false);
                        *(u32x4w*)((unsigned char*)(P.ws + WS_YMIX) + trow_ * 1024 + wid * 128 + (q2 + hi) * 16) = (u32x4w){s0_[0], s1_[0], s0_[1], s1_[1]};
                    }
                }
                LAS float* pp = part + ((uu * 8 + wid) * 17) * 64 + lane;
#pragma unroll
                for (int r = 0; r < 16; ++r) pp[r * 64] = pa[r];
                pp[16 * 64] = ps;
            }
            __syncthreads();
            if ((wid >> 1) == rd) {
                const LAS float* pp = part + (((wid & 1) * 8) * 17) * 64 + lane;
#pragma unroll
                for (int k = 0; k < 8; ++k) {
#pragma unroll
                    for (int r = 0; r < 16; ++r) acc[r] += pp[(k * 17 + r) * 64];
                    ss += pp[(k * 17 + 16) * 64];
                }
            }
            __syncthreads();
        }
        if (wid >= 4) continue;
        const int u = g4 * 4 + wid; const size_t trow = (size_t)u * 32 + r32;
        ss = at::xhalf_sum(ss);
        const float rstd = rsqrtf(ss * (1.0f / 1024.0f) + EPS);
        if (hi == 0) RS1[trow] = rstd;
        float lg[16];
#pragma unroll
        for (int r = 0; r < 16; ++r) lg[r] = acc[r] * rstd + rb[(r & 3) + 8 * (r >> 2) + 4 * hi];
        float cv[8]; int ci[8];
#pragma unroll
        for (int k = 0; k < 4; ++k) {
            float best = -INFINITY; int bi = 0;
#pragma unroll
            for (int r = 0; r < 16; ++r) { const bool ok = lg[r] > best; best = ok ? lg[r] : best; bi = ok ? r : bi; }
#pragma unroll
            for (int r = 0; r < 16; ++r) lg[r] = (r == bi) ? -INFINITY : lg[r];
            cv[k] = best; ci[k] = (bi & 3) + 8 * (bi >> 2) + 4 * hi;
        }
#pragma unroll
        for (int k = 0; k < 4; ++k) {
            { auto rr = __builtin_amdgcn_permlane32_swap(__float_as_uint(cv[k]), __float_as_uint(cv[k]), false, false); cv[4 + k] = __uint_as_float(hi ? rr[0] : rr[1]); }
            { auto rr = __builtin_amdgcn_permlane32_swap((unsigned)ci[k], (unsigned)ci[k], false, false); ci[4 + k] = (int)(hi ? rr[0] : rr[1]); }
        }
        float tv[4]; int ti[4];
#pragma unroll
        for (int k = 0; k < 4; ++k) {
            float best = -INFINITY; int be = 64, bj = 0;
#pragma unroll
            for (int j = 0; j < 8; ++j) { const bool ok = (cv[j] > best) || (cv[j] == best && ci[j] < be); best = ok ? cv[j] : best; be = ok ? ci[j] : be; bj = ok ? j : bj; }
#pragma unroll
            for (int j = 0; j < 8; ++j) cv[j] = (j == bj) ? -INFINITY : cv[j];
            tv[k] = best; ti[k] = be;
        }
        const float e1 = __expf(tv[1] - tv[0]), e2 = __expf(tv[2] - tv[0]), e3 = __expf(tv[3] - tv[0]);
        const float invs = __builtin_amdgcn_rcpf(1.0f + e1 + e2 + e3);
        if (hi == 0 && nu < MAXU) {
            const float gt[4] = {invs, e1 * invs, e2 * invs, e3 * invs};
            const int base = ((wid * MAXU + nu) * 32 + r32) * 4;
#pragma unroll
            for (int k = 0; k < 4; ++k) {
                const unsigned rk = __hip_atomic_fetch_add(&lcnt[ti[k]], 1u, __ATOMIC_RELAXED, __HIP_MEMORY_SCOPE_WORKGROUP);
                ent[base + k] = (unsigned)ti[k] | (rk << 8); entg[base + k] = gt[k];
            }
            entr[(wid * MAXU + nu) * 32 + r32] = rstd;
        }
    }
    __syncthreads();
    if (tid < 32) lbase[tid] = atomicAdd(&cnt[tid], lcnt[tid]);
    __syncthreads();
    {
        int k2 = 0;
        for (int u = blockIdx.x * 4 + wid; wid < 4 && u < T / 32 && k2 < MAXU; u += grid_size() * 4, ++k2) {
#pragma unroll
            for (int h2 = 0; h2 < 2; ++h2) {
                const int i = lane + 64 * h2; const int tl = i >> 2;
                const unsigned code = ent[((wid * MAXU + k2) * 32) * 4 + i]; const int e = (int)(code & 255u); const unsigned pos = lbase[e] + (code >> 8);
                LIST[(size_t)e * T + pos] = (int)(((unsigned)u * 32 + tl) * 4 + (i & 3));
                ((float*)(P.ws + WS_LRS))[(size_t)e * T + pos] = entr[(wid * MAXU + k2) * 32 + tl];
                ((float*)(P.ws + WS_LGT))[(size_t)e * T + pos] = entg[((wid * MAXU + k2) * 32) * 4 + i];
            }
        }
    }
    __syncthreads();
}

__device__ __forceinline__ void unpack8(const u32x4_t w, float (&x)[8]) {
#pragma unroll
    for (int i = 0; i < 4; ++i) { x[2 * i] = bf2f(w[i] & 0xffff); x[2 * i + 1] = bf2f(w[i] >> 16); }
}
template <bool Y8, bool DRY = false> __device__ __forceinline__ void ph_combine(const Params& P) {
    const int tid = opaque_tid(), wid = tid >> 6, lane = tid & 63;
    bf16_t* HB = (bf16_t*)(P.ws + WS_HB); bf16_t* HBW = DRY ? (bf16_t*)(P.ws + WS_BIG + 128 * MiB) : HB; float* RS2 = DRY ? (float*)(P.ws + WS_BIG + 200 * MiB) : (float*)(P.ws + WS_RSTD) + 2 * T;
    const bf16_t* Y = (const bf16_t*)(P.ws + WS_Y); const unsigned char* Yb = (const unsigned char*)(P.ws + WS_Y);
    for (int t0 = (blockIdx.x * NWV + wid) * 2; t0 < T; t0 += grid_size() * NWV * 2) {
        u32x4_t hv[2][2], yv[2][2][4]; uint2 y8[2][2][4];
#pragma unroll
        for (int tt = 0; tt < 2; ++tt)
#pragma unroll
            for (int i = 0; i < 2; ++i) {
                hv[tt][i] = *(const u32x4_t*)(HB + (size_t)(t0 + tt) * 1024 + i * 512 + lane * 8);
#pragma unroll
                for (int k = 0; k < 4; ++k) {
                    if constexpr (Y8) y8[tt][i][k] = *(const uint2*)(Yb + ((size_t)(t0 + tt) * 4 + k) * 1024 + i * 512 + lane * 8);
                    else yv[tt][i][k] = *(const u32x4_t*)(Y + ((size_t)(t0 + tt) * 4 + k) * 1024 + i * 512 + lane * 8);
                }
            }
#pragma unroll
        for (int tt = 0; tt < 2; ++tt) {
            float ss = 0.f;
#pragma unroll
            for (int i = 0; i < 2; ++i) {
                float v[8]; unpack8(hv[tt][i], v);
#pragma unroll
                for (int k = 0; k < 4; ++k) {
                    if constexpr (Y8) {
                        const uint2 w = y8[tt][i][k];
                        const auto p0 = __builtin_amdgcn_cvt_pk_f32_fp8((int)w.x, false), p1 = __builtin_amdgcn_cvt_pk_f32_fp8((int)w.x, true), p2 = __builtin_amdgcn_cvt_pk_f32_fp8((int)w.y, false), p3 = __builtin_amdgcn_cvt_pk_f32_fp8((int)w.y, true);
                        v[0] += p0[0] * 0.0625f; v[1] += p0[1] * 0.0625f; v[2] += p1[0] * 0.0625f; v[3] += p1[1] * 0.0625f; v[4] += p2[0] * 0.0625f; v[5] += p2[1] * 0.0625f; v[6] += p3[0] * 0.0625f; v[7] += p3[1] * 0.0625f;
                    } else { float y[8]; unpack8(yv[tt][i][k], y);
#pragma unroll
                        for (int j = 0; j < 8; ++j) v[j] += y[j]; }
                }
#pragma unroll
                for (int j = 0; j < 8; ++j) ss += v[j] * v[j];
                *(u32x4_t*)(HBW + (size_t)(t0 + tt) * 1024 + i * 512 + lane * 8) = (u32x4_t){pack2(v[0], v[1]), pack2(v[2], v[3]), pack2(v[4], v[5]), pack2(v[6], v[7])};
                if constexpr (PG_FP8 && !DRY) *(uint2*)((unsigned char*)(P.ws + WS_H8B) + (size_t)(t0 + tt) * 1024 + i * 512 + lane * 8) = make_uint2(pack4_fp8(v[0], v[1], v[2], v[3]), pack4_fp8(v[4], v[5], v[6], v[7]));
            }
            ss = wave_sum(ss);
            if (lane == 0) RS2[t0 + tt] = rsqrtf(ss * (1.0f / 1024.0f) + EPS);
        }
    }
}

template <bool DRY = false> __device__ __forceinline__ void ph_final(const Params& P, int layer) {
    const int tid = opaque_tid(), wid = tid >> 6, lane = tid & 63;
    bf16_t* HB = (bf16_t*)(P.ws + WS_HB); bf16_t* HBW = DRY ? (bf16_t*)(P.ws + WS_BIG + 128 * MiB) : HB; float* RS = DRY ? (float*)(P.ws + WS_BIG + 200 * MiB) : (float*)(P.ws + WS_RSTD); const bf16_t* V = (const bf16_t*)(P.ws + WS_YMIX);
    float* OUTW = DRY ? (float*)(P.ws + WS_BIG) : P.out;
    const float* gp = P.ple_pn + layer * 1024;
    float g[2][8];
#pragma unroll
    for (int i = 0; i < 2; ++i) { const f32x4 a = *(const f32x4*)(gp + i * 512 + lane * 8), b = *(const f32x4*)(gp + i * 512 + lane * 8 + 4); g[i][0] = a[0]; g[i][1] = a[1]; g[i][2] = a[2]; g[i][3] = a[3]; g[i][4] = b[0]; g[i][5] = b[1]; g[i][6] = b[2]; g[i][7] = b[3]; }
    for (int t0 = (blockIdx.x * NWV + wid) * 2; t0 < T; t0 += grid_size() * NWV * 2) {
        u32x4_t hv[2][2], yv[2][2];
#pragma unroll
        for (int tt = 0; tt < 2; ++tt)
#pragma unroll
            for (int i = 0; i < 2; ++i) { hv[tt][i] = *(const u32x4_t*)(HB + (size_t)(t0 + tt) * 1024 + i * 512 + lane * 8); yv[tt][i] = *(const u32x4_t*)(V + (size_t)(t0 + tt) * 1024 + i * 512 + lane * 8); }
#pragma unroll
        for (int tt = 0; tt < 2; ++tt) {
            float vv[2][8]; float ss = 0.f;
#pragma unroll
            for (int i = 0; i < 2; ++i) { unpack8(yv[tt][i], vv[i]);
#pragma unroll
                for (int j = 0; j < 8; ++j) ss += vv[i][j] * vv[i][j]; }
            ss = wave_sum(ss);
            const float r = rsqrtf(ss * (1.0f / 1024.0f) + EPS);
            float s2 = 0.f;
#pragma unroll
            for (int i = 0; i < 2; ++i) {
                float h[8]; unpack8(hv[tt][i], h);
#pragma unroll
                for (int j = 0; j < 8; ++j) h[j] += vv[i][j] * r * g[i][j];
                if (layer == DEPTH - 1) { float* op = OUTW + (size_t)(t0 + tt) * 1024 + i * 512 + lane * 8; *(f32x4*)op = (f32x4){h[0], h[1], h[2], h[3]}; *(f32x4*)(op + 4) = (f32x4){h[4], h[5], h[6], h[7]}; }
                else {
#pragma unroll
                    for (int j = 0; j < 8; ++j) s2 += h[j] * h[j];
                    *(u32x4_t*)(HBW + (size_t)(t0 + tt) * 1024 + i * 512 + lane * 8) = (u32x4_t){pack2(h[0], h[1]), pack2(h[2], h[3]), pack2(h[4], h[5]), pack2(h[6], h[7])};
                    if constexpr (Z_FP8 && !DRY) *(uint2*)((unsigned char*)(P.ws + WS_H8) + (size_t)(t0 + tt) * 1024 + i * 512 + lane * 8) = make_uint2(pack4_fp8(h[0], h[1], h[2], h[3]), pack4_fp8(h[4], h[5], h[6], h[7]));
                }
            }
            if (layer != DEPTH - 1) { s2 = wave_sum(s2); if (lane == 0) RS[t0 + tt] = rsqrtf(s2 * (1.0f / 1024.0f) + EPS); }
        }
    }
}

struct EpiZ8 { bf16_t* Z; const float* rstd; typedef float Pre; static constexpr bool HOIST_ALL = true;
    __device__ __forceinline__ Pre pre(int r, int) const { return rstd[r]; }
    __device__ __forceinline__ void post(int r, int c, f32x4 a, f32x4 b, Pre s) const { __builtin_nontemporal_store((u32x4_t){pack2h(a[0] * s, a[1] * s), pack2h(a[2] * s, a[3] * s), pack2h(b[0] * s, b[1] * s), pack2h(b[2] * s, b[3] * s)}, (u32x4_t*)(Z + (size_t)r * ZW + c)); } };
struct EpiBf16_8 { bf16_t* O; int ldo; typedef int Pre; static constexpr bool HOIST_ALL = false;
    __device__ __forceinline__ Pre pre(int, int) const { return 0; }
    __device__ __forceinline__ void post(int r, int c, f32x4 a, f32x4 b, Pre) const { __builtin_nontemporal_store((u32x4_t){pack2h(a[0], a[1]), pack2h(a[2], a[3]), pack2h(b[0], b[1]), pack2h(b[2], b[3])}, (u32x4_t*)(O + (size_t)r * ldo + c)); } };
template <bool XIN> struct EpiResid8;
template <> struct EpiResid8<true> { const float* xin; bf16_t* HB; struct Pre { f32x4 lo, hi; }; static constexpr bool HOIST_ALL = false;
    __device__ __forceinline__ Pre pre(int r, int c) const { Pre p; p.lo = *(const f32x4*)(xin + (size_t)r * 1024 + c); p.hi = *(const f32x4*)(xin + (size_t)r * 1024 + c + 4); return p; }
    __device__ __forceinline__ void post(int r, int c, f32x4 a, f32x4 b, const Pre& p) const { const f32x4 h0 = p.lo + a, h1 = p.hi + b;
        *(u32x4_t*)(HB + (size_t)r * 1024 + c) = (u32x4_t){pack2h(h0[0], h0[1]), pack2h(h0[2], h0[3]), pack2h(h1[0], h1[1]), pack2h(h1[2], h1[3])}; } };
template <> struct EpiResid8<false> { const float* xin; bf16_t* HB; typedef u32x4_t Pre; static constexpr bool HOIST_ALL = false;
    __device__ __forceinline__ Pre pre(int r, int c) const { return *(const u32x4_t*)(HB + (size_t)r * 1024 + c); }
    __device__ __forceinline__ void post(int r, int c, f32x4 a, f32x4 b, const Pre& e) const {
        const f32x4 h0 = (f32x4){bf2f(e[0] & 0xffff), bf2f(e[0] >> 16), bf2f(e[1] & 0xffff), bf2f(e[1] >> 16)} + a, h1 = (f32x4){bf2f(e[2] & 0xffff), bf2f(e[2] >> 16), bf2f(e[3] & 0xffff), bf2f(e[3] >> 16)} + b;
        *(u32x4_t*)(HB + (size_t)r * 1024 + c) = (u32x4_t){pack2h(h0[0], h0[1]), pack2h(h0[2], h0[3]), pack2h(h1[0], h1[1]), pack2h(h1[2], h1[3])}; } };
struct EpiPle8 { const bf16_t* E; const float* rstd2; bf16_t* V; struct Pre { u32x4_t e; float s; }; static constexpr bool HOIST_ALL = false;
    __device__ __forceinline__ Pre pre(int r, int c) const { Pre p; p.e = *(const u32x4_t*)(E + (size_t)r * 1024 + c); p.s = rstd2[r]; return p; }
    static __device__ __forceinline__ unsigned gate2(unsigned ew, f32x2 a, float sn) { const f32x2 x = a * sn; const f32x2 ex = {__builtin_amdgcn_exp2f(x[0]), __builtin_amdgcn_exp2f(x[1])}; const f32x2 d = ex + 1.0f;
        const f32x2 rr = {__builtin_amdgcn_rcpf(d[0]), __builtin_amdgcn_rcpf(d[1])}; const f32x2 ev = {__uint_as_float(ew << 16), __uint_as_float(ew & 0xffff0000u)}; return pack2v(ev * rr); }
    __device__ __forceinline__ void post(int r, int c, f32x4 a, f32x4 b, const Pre& p) const { const float sn = p.s * -1.4426950408889634f; const u32x4_t e = p.e;
        __builtin_nontemporal_store((u32x4_t){gate2(e[0], __builtin_shufflevector(a, a, 0, 1), sn), gate2(e[1], __builtin_shufflevector(a, a, 2, 3), sn), gate2(e[2], __builtin_shufflevector(b, b, 0, 1), sn), gate2(e[3], __builtin_shufflevector(b, b, 2, 3), sn)}, (u32x4_t*)(V + (size_t)r * 1024 + c)); } };
__device__ __forceinline__ f32x2 swiglu2(f32x2 g, f32x2 u, float s, f32x2 bg, f32x2 bu1) {
    const f32x2 gp = g * s + bg, up = u * s + bu1;
    const f32x2 gg = {fminf(gp[0], 7.0f), fminf(gp[1], 7.0f)};
    const f32x2 uu = {__builtin_amdgcn_fmed3f(up[0], -6.0f, 8.0f), __builtin_amdgcn_fmed3f(up[1], -6.0f, 8.0f)};
    const f32x2 t = uu * gg, xe = gg * (-1.702f * 1.4426950408889634f);
    const f32x2 e = {__builtin_amdgcn_exp2f(xe[0]), __builtin_amdgcn_exp2f(xe[1])};
    const f32x2 d = e + 1.0f;
    const f32x2 r = {__builtin_amdgcn_rcpf(d[0]), __builtin_amdgcn_rcpf(d[1])};
    return t * r;
}


namespace fg {
typedef int v4i_t __attribute__((ext_vector_type(4))); typedef int v8i_t __attribute__((ext_vector_type(8)));
constexpr int BM = 256, BK = 64, HALF = 128, HTB = HALF * BK * 2  , STAGE_BYTES = 8 * HTB, NXCD = 8, WGM = 8;
__host__ __device__ __forceinline__ int lds_byte(int r, int c) { const int st = (r >> 4) * 2 + (c >> 5), rr = r & 15, cc = c & 31, ob = rr * 64 + cc * 2; return st * 1024 + (ob ^ (((ob >> 9) & 1) << 5)); }
__host__ __device__ __forceinline__ int perm32(int rho) { const int n = rho >> 4, i = rho & 15; return 8 * (i >> 2) + 4 * n + (i & 3); }
__host__ __device__ __forceinline__ void stage_rc(int b, int& R, int& C) { const int st = b / 1024, sb = b % 1024, swz = sb ^ (((sb >> 9) & 1) << 5); R = (st >> 1) * 16 + swz / 64; C = (st & 1) * 32 + (swz % 64) / 2; }

template <int IMM> __device__ __forceinline__ void glds16i(const char* sbase, unsigned voff, unsigned base) { unsigned keep;
    asm volatile("s_mov_b32 %0, m0\n\ts_add_u32 m0, %3, %4\n\ts_nop 0\n\tglobal_load_lds_dwordx4 %1, %2\n\ts_mov_b32 m0, %0" : "=&s"(keep) : "v"(voff), "s"(sbase), "s"(base), "n"(IMM) : "memory", "scc"); }
template <class PB>
__device__ __forceinline__ void gemm_phase(LAS unsigned char* lds, const PB& S) {
    constexpr int K = PB::K, nt = K / BK;
    typedef typename PB::Unit Unit;
    const int tid = opaque_tid(); const int wid = __builtin_amdgcn_readfirstlane(tid >> 6), lane = tid & 63, wr = wid >> 2, wc = wid & 3, fr = lane & 15, fq = lane >> 4;
    unsigned voffB[2];
#pragma unroll
    for (int i = 0; i < 2; ++i) { int R_, C_; stage_rc(tid * 16 + i * 8192, R_, C_);
        const int Rb_ = PB::PERM2 ? (64 * ((R_ >> 5) & 3) + 16 * ((R_ >> 2) & 3) + 8 * (R_ >> 7) + 4 * ((R_ >> 4) & 1) + (R_ & 3)) : PB::PERM3 ? (64 * ((R_ >> 5) & 3) + 8 * ((R_ >> 2) & 3) + 4 * ((R_ >> 4) & 1) + (R_ & 3))
                      : PB::PERM ? ((R_ & ~31) + perm32(R_ & 31)) : R_; voffB[i] = (unsigned)(Rb_ * K + C_) * 2u; }
#define FG_AOFFS(dst, unit) do { const int tz_ = opaque_tid(); _Pragma("unroll") for (int i_ = 0; i_ < 2; ++i_) { int R_, C_; stage_rc(tz_ * 16 + i_ * 8192, R_, C_); \
        _Pragma("unroll") for (int h_ = 0; h_ < 2; ++h_) dst[h_][i_] = S.a_off(unit, h_ * HALF + R_) + (unsigned)C_ * 2u; } } while (0)
    constexpr size_t kstep = (size_t)(BK * 2);
    constexpr size_t hstep = PB::PERM2 ? (size_t)8 * K * 2 : PB::PERM3 ? (size_t)32 * K * 2 : (size_t)HALF * K * 2;
    const unsigned ldsw = (unsigned)wid * 1024u;
    const int aoff = lds_byte(wr * 64 + fr, fq * 8), boff = lds_byte(wc * 32 + fr, fq * 8);
#define FG_SA(b, h) (((b) * 2 + (h)) * HTB)
#define FG_SB(b, h) ((4 + (b) * 2 + (h)) * HTB)
    const unsigned ldsb = (unsigned)__builtin_amdgcn_readfirstlane((int)((unsigned)(size_t)lds + ldsw));
#define FG_STAGE_B(bufoff, gbase) do { glds16i<(bufoff)>((const char*)(gbase), voffB[0], ldsb); glds16i<(bufoff) + 8192>((const char*)(gbase), voffB[1], ldsb); } while (0)
#define FG_STAGE_A(bufoff, o0, o1) do { glds16i<(bufoff)>(Abase, (o0), ldsb); glds16i<(bufoff) + 8192>(Abase, (o1), ldsb); } while (0)
#define FG_LD8(dst, off) do { const v4i_t lo_ = *(const LAS v4i_t*)(lds + (off)), hi_ = *(const LAS v4i_t*)(lds + (off) + 1024); dst = (v8i_t){lo_[0], lo_[1], lo_[2], lo_[3], hi_[0], hi_[1], hi_[2], hi_[3]}; } while (0)
#define FG_LDA(dst, b, h) do { _Pragma("unroll") for (int m = 0; m < 4; ++m) FG_LD8(dst[m], FG_SA(b, h) + aoff + m * 2048); } while (0)
#define FG_LDB(dst, b, h) do { _Pragma("unroll") for (int n = 0; n < 2; ++n) FG_LD8(dst[n], FG_SB(b, h) + boff + n * 2048); } while (0)
#define FG_HALF(v, k) ((k) == 0 ? __builtin_bit_cast(bf16x8, (v4i_t){(v)[0], (v)[1], (v)[2], (v)[3]}) : __builtin_bit_cast(bf16x8, (v4i_t){(v)[4], (v)[5], (v)[6], (v)[7]}))
#define FG_MMA(ai, bj, At, Bt) do { __builtin_amdgcn_s_setprio(1); \
        if constexpr (PB::FP8) { _Pragma("unroll") for (int m = 0; m < 4; ++m) _Pragma("unroll") for (int n = 0; n < 2; ++n) \
            asm volatile("v_mfma_scale_f32_16x16x128_f8f6f4 %0, %1, %2, %0, %3, %4 op_sel_hi:[0,0,0]" : "+v"(acc[ai][bj][m][n]) : "v"(Bt[n]), "v"(At[m]), "v"(sclW), "v"(sclA)); } \
        else { _Pragma("unroll") for (int m = 0; m < 4; ++m) _Pragma("unroll") for (int n = 0; n < 2; ++n) _Pragma("unroll") for (int k = 0; k < 2; ++k) \
            acc[ai][bj][m][n] = __builtin_amdgcn_mfma_f32_16x16x32_bf16(FG_HALF(Bt[n], k), FG_HALF(At[m], k), acc[ai][bj][m][n], 0, 0, 0); } \
        __builtin_amdgcn_s_setprio(0); } while (0)
#define FG_WAIT_V(n) asm volatile("s_waitcnt vmcnt(" #n ")" ::: "memory")
#define FG_WAIT_L(n) asm volatile("s_waitcnt lgkmcnt(" #n ")" ::: "memory")
#define FG_BAR __builtin_amdgcn_s_barrier()
#define FG_SCHED __builtin_amdgcn_sched_barrier(0)
    Unit cur, nxt; int ui = 0;
    if (!S.next(0, cur)) return;
    f32x4 acc[2][2][4][2];
#pragma unroll
    for (int a = 0; a < 2; ++a)
#pragma unroll
        for (int b = 0; b < 2; ++b)
#pragma unroll
            for (int m = 0; m < 4; ++m)
#pragma unroll
                for (int n = 0; n < 2; ++n) acc[a][b][m][n] = (f32x4){0.f, 0.f, 0.f, 0.f};
    v8i_t At[4], B0[2], B1[2];
    int sclW = 0x79797979, sclA = 0x7f7f7f7f;
    asm volatile("" : "+v"(sclW), "+v"(sclA));
    const char* Abase = S.a_base();
    unsigned vAc[2][2];
    FG_AOFFS(vAc, cur);
    const char* cB = S.b_base(cur);
    FG_STAGE_B(FG_SB(0, 0), cB); FG_STAGE_B(FG_SB(0, 1), cB + hstep); FG_STAGE_A(FG_SA(0, 0), vAc[0][0], vAc[0][1]); FG_STAGE_A(FG_SA(0, 1), vAc[1][0], vAc[1][1]);
    if (wr == 1) FG_BAR;
    FG_WAIT_V(2); FG_BAR;
    FG_STAGE_B(FG_SB(1, 0), cB + kstep); FG_STAGE_A(FG_SA(1, 0), vAc[0][0] + (unsigned)kstep, vAc[0][1] + (unsigned)kstep); FG_STAGE_B(FG_SB(1, 1), cB + hstep + kstep);
    FG_WAIT_V(6); FG_BAR;
    for (;;) {
        const bool has_next = S.next(ui + 1, nxt);
        const char* nB = has_next ? S.b_base(nxt) : cB;
        if constexpr (PB::GATHER) {
            const Unit tg = has_next ? nxt : cur;
            const int tz_ = opaque_tid(); const unsigned w_ = (unsigned)__builtin_amdgcn_readfirstlane(tz_ >> 6);
#pragma unroll
            for (int i_ = 0; i_ < 2; ++i_) { int R_, C_; stage_rc(tz_ * 16 + i_ * 8192, R_, C_);
#pragma unroll
                for (int h_ = 0; h_ < 2; ++h_) __builtin_amdgcn_global_load_lds(S.a_list_ptr(tg, h_ * HALF + R_), (LAS unsigned*)(lds + STAGE_BYTES + 512 + (h_ * 2 + i_) * 2048 + w_ * 256u), 4, 0, 0); }
        } else {
            unsigned vAn[2][2];
            if (has_next) { FG_AOFFS(vAn, nxt); }
            else {
#pragma unroll
                for (int h = 0; h < 2; ++h)
#pragma unroll
                    for (int i = 0; i < 2; ++i) vAn[h][i] = vAc[h][i];
            }
            *(LAS v4i_t*)(lds + STAGE_BYTES + 512 + opaque_tid() * 16) = (v4i_t){(int)vAn[0][0], (int)vAn[0][1], (int)vAn[1][0], (int)vAn[1][1]};
        }
#pragma unroll 1
        for (int t = 0; t < nt; t += 2) {
            const bool last = (t == nt - 2);
            const unsigned k1 = (unsigned)((t + 1) * (int)kstep), k2 = last ? 0u : (unsigned)((t + 2) * (int)kstep);
            const char* b2 = last ? nB : cB + (size_t)(t + 2) * kstep; const char* b3 = b2 + kstep;
            const unsigned c10_ = vAc[1][0], c11_ = vAc[1][1];
            if (last) {
                if constexpr (PB::GATHER) { const int tz_ = opaque_tid();
#pragma unroll
                    for (int i_ = 0; i_ < 2; ++i_) { int R_, C_; stage_rc(tz_ * 16 + i_ * 8192, R_, C_);
#pragma unroll
                        for (int h_ = 0; h_ < 2; ++h_) vAc[h_][i_] = S.a_from_list(*(const LAS int*)(lds + STAGE_BYTES + 512 + (h_ * 2 + i_) * 2048 + tz_ * 4)) + (unsigned)C_ * 2u; }
                } else { const v4i_t nx_ = *(const LAS v4i_t*)(lds + STAGE_BYTES + 512 + opaque_tid() * 16); vAc[0][0] = (unsigned)nx_[0]; vAc[0][1] = (unsigned)nx_[1]; vAc[1][0] = (unsigned)nx_[2]; vAc[1][1] = (unsigned)nx_[3]; } }
#define FG_A2(h, i) (vAc[h][i] + k2)
            FG_LDB(B0, 0, 0); FG_LDB(B1, 0, 1); FG_SCHED; FG_LDA(At, 0, 0);
            if constexpr (PB::PREFETCH) { if (t == 2) S.prefetch(cur); }
            FG_STAGE_A(FG_SA(1, 1), c10_ + k1, c11_ + k1);
            const bool fresh = PB::SKIPW && ui > 0 && t == 0;
            if (!fresh) FG_WAIT_V(8);
            FG_WAIT_L(0); FG_BAR; FG_MMA(0, 0, At, B0); FG_MMA(0, 1, At, B1); FG_BAR; FG_SCHED;
            FG_LDA(At, 0, 1); FG_STAGE_B(FG_SB(0, 0), b2); FG_STAGE_B(FG_SB(0, 1), b2 + hstep); FG_STAGE_A(FG_SA(0, 0), FG_A2(0, 0), FG_A2(0, 1));
            if (!fresh) FG_WAIT_V(8);
            FG_WAIT_L(0); FG_BAR; FG_MMA(1, 0, At, B0); FG_MMA(1, 1, At, B1); FG_BAR; FG_SCHED;
            FG_LDB(B0, 1, 0); FG_LDB(B1, 1, 1); FG_SCHED; FG_LDA(At, 1, 0); FG_STAGE_A(FG_SA(0, 1), FG_A2(1, 0), FG_A2(1, 1));
            FG_WAIT_V(8); FG_WAIT_L(0); FG_BAR; FG_MMA(0, 0, At, B0); FG_MMA(0, 1, At, B1); FG_BAR; FG_SCHED;
            FG_LDA(At, 1, 1); FG_STAGE_B(FG_SB(1, 0), b3); FG_STAGE_B(FG_SB(1, 1), b3 + hstep); FG_STAGE_A(FG_SA(1, 0), FG_A2(0, 0) + (unsigned)kstep, FG_A2(0, 1) + (unsigned)kstep);
            FG_WAIT_V(8); FG_WAIT_L(0); FG_BAR; FG_MMA(1, 0, At, B0); FG_MMA(1, 1, At, B1); FG_BAR; FG_SCHED;
        }
        if (wr == 0) FG_BAR;
        if constexpr (PB::FP8) asm volatile("s_nop 15\n\ts_nop 15\n\ts_nop 15" ::: "memory");
        if constexpr (PB::SKIPW) FG_WAIT_V(0);
        { const int t2_ = opaque_tid(); const int w2_ = __builtin_amdgcn_readfirstlane(t2_ >> 6), l2_ = t2_ & 63;
          S.epilogue(acc, cur, w2_ >> 2, w2_ & 3, l2_ & 15, l2_ >> 4); }
        if (!has_next) break;
#pragma unroll
        for (int a = 0; a < 2; ++a)
#pragma unroll
            for (int b = 0; b < 2; ++b)
#pragma unroll
                for (int m = 0; m < 4; ++m)
#pragma unroll
                    for (int n = 0; n < 2; ++n) acc[a][b][m][n] = (f32x4){0.f, 0.f, 0.f, 0.f};
        cur = nxt; cB = nB; ++ui;
        if (wr == 1) FG_BAR;
    }
    FG_WAIT_V(0);
    FG_BAR;
#undef FG_AOFFS
#undef FG_A2
#undef FG_SA
#undef FG_SB
#undef FG_STAGE_A
#undef FG_STAGE_B
#undef FG_LDA
#undef FG_LD8
#undef FG_HALF
#undef FG_LDB
#undef FG_MMA
#undef FG_WAIT_V
#undef FG_WAIT_L
#undef FG_BAR
#undef FG_SCHED
}

template <int K_, int LDA, class Epi, bool PERM_, bool FP8_ = false>
struct DenseProb {
    static constexpr int K = K_; static constexpr bool PERM = PERM_, PERM2 = false, PERM3 = PERM_, FP8 = FP8_, PREFETCH = false, GATHER = false, SKIPW = (K_ >= 512);
    struct Unit { int pm, pn; };
    const bf16_t* A; const bf16_t* Bt; int nM, nN, nwg, G, c; Epi epi;
    __device__ __forceinline__ DenseProb(const bf16_t* A_, const bf16_t* Bt_, int N, const Epi& e) : A(A_), Bt(Bt_), nM(T / BM), nN(N / BM), nwg((T / BM) * (N / BM)), G(grid_size()), c(blockIdx.x), epi(e) {}
    __device__ __forceinline__ bool next(int i, Unit& u) const {
        const long L = (long)i * G + c; if (L >= nwg) return false;
        int wgid = (int)L; { const int q = nwg / NXCD, r = nwg % NXCD, xcd = wgid % NXCD, off = wgid / NXCD; wgid = (xcd < r ? xcd * (q + 1) : r * (q + 1) + (xcd - r) * q) + off; }
        const int nig = WGM * nN, gid = wgid / nig, fm = gid * WGM, gsz = (nM - fm) < WGM ? (nM - fm) : WGM;
        u.pm = fm + ((wgid % nig) % gsz); u.pn = (wgid % nig) / gsz; return true;
    }
    __device__ __forceinline__ const char* a_base() const { return (const char*)A; }
    __device__ __forceinline__ unsigned a_off(const Unit& u, int r) const { return (unsigned)((u.pm * BM + r) * LDA) * 2u; }
    __device__ __forceinline__ const char* b_base(const Unit& u) const { return (const char*)Bt + (size_t)u.pn * BM * K * 2; }
    __device__ __forceinline__ void epilogue(const f32x4 (&acc)[2][2][4][2], const Unit& u, int wr, int wc, int fr, int fq) const {
        const int row0 = u.pm * BM + wr * 64 + fr;
        if constexpr (PERM) {
            const int col0 = u.pn * BM + wc * 64 + 8 * fq;
            if constexpr (Epi::HOIST_ALL) {
                typename Epi::Pre pre[2][4][2];
#pragma unroll
                for (int ai = 0; ai < 2; ++ai)
#pragma unroll
                    for (int m = 0; m < 4; ++m)
#pragma unroll
                        for (int bj = 0; bj < 2; ++bj) pre[ai][m][bj] = epi.pre(row0 + ai * HALF + m * 16, col0 + bj * 32);
#pragma unroll
                for (int ai = 0; ai < 2; ++ai)
#pragma unroll
                    for (int m = 0; m < 4; ++m)
#pragma unroll
                        for (int bj = 0; bj < 2; ++bj) epi.post(row0 + ai * HALF + m * 16, col0 + bj * 32, acc[ai][bj][m][0], acc[ai][bj][m][1], pre[ai][m][bj]);
            } else
#pragma unroll
            for (int ai = 0; ai < 2; ++ai) {
                typename Epi::Pre pre[4][2];
#pragma unroll
                for (int m = 0; m < 4; ++m)
#pragma unroll
                    for (int bj = 0; bj < 2; ++bj) pre[m][bj] = epi.pre(row0 + ai * HALF + m * 16, col0 + bj * 32);
#pragma unroll
                for (int m = 0; m < 4; ++m)
#pragma unroll
                    for (int bj = 0; bj < 2; ++bj) epi.post(row0 + ai * HALF + m * 16, col0 + bj * 32, acc[ai][bj][m][0], acc[ai][bj][m][1], pre[m][bj]);
            }
        } else {
            const int col0 = u.pn * BM + wc * 32 + 4 * fq;
#pragma unroll
            for (int ai = 0; ai < 2; ++ai)
#pragma unroll
                for (int m = 0; m < 4; ++m)
#pragma unroll
                    for (int bj = 0; bj < 2; ++bj)
#pragma unroll
                        for (int n = 0; n < 2; ++n) epi(row0 + ai * HALF + m * 16, col0 + bj * HALF + n * 16, acc[ai][bj][m][n]);
        }
    }
};
}
template <int K, int LDA, bool PERM, class Epi, bool FP8 = false>
__device__ __forceinline__ void ph_gemm_fast(LAS unsigned char* lds, const bf16_t* A, const bf16_t* Bt, int N, const Epi& epi) {
    const fg::DenseProb<K, LDA, Epi, PERM, FP8> pb(A, Bt, N, epi);
    fg::gemm_phase(lds, pb);
}


namespace fg {
struct MoeUnit { int e, mblk, pn, rowoff, M; };
template <bool FIRST, bool FP8_>
struct MoeProb {
    static constexpr int K = FP8_ ? 512 : 1024  , NCOL = FIRST ? 8 : 4; static constexpr bool PERM = true, PERM2 = !FIRST && FP8_, PERM3 = false, FP8 = FP8_, PREFETCH = FP8_, GATHER = FIRST, SKIPW = true; static constexpr unsigned RB = FP8_ ? 1024u : 2048u  ;
    static constexpr int PF_OFF = 512 + 8192;
    typedef MoeUnit Unit;
    const Params& P; int layer; const LAS int* tab;
    int G, c; mutable int e_, acc_, off_;
    __device__ __forceinline__ MoeProb(const Params& P_, int layer_, const LAS int* tab_) : P(P_), layer(layer_), tab(tab_), G(grid_size()), c(blockIdx.x), e_(0), acc_(0), off_(0) {}
    __device__ __forceinline__ bool next(int i, Unit& u) const {
        const int j = i * (G >> 3) + (c >> 3), tile = (j / NCOL) * 8 + (c & 7);
        while (e_ < 32) { const int tl = (tab[e_] + 255) >> 8; if (tile < acc_ + tl) break; acc_ += tl; off_ += tl * 256; ++e_; }
        if (e_ >= 32) return false;
        u.e = e_; u.mblk = tile - acc_; u.pn = j % NCOL; u.rowoff = off_; u.M = tab[e_]; return true;
    }
    __device__ __forceinline__ void prefetch(const Unit& u) const {
        const int tz = opaque_tid(); const int w = __builtin_amdgcn_readfirstlane(tz >> 6); char* ws = P.ws;
        LAS unsigned char* pf = (LAS unsigned char*)tab + PF_OFF;
        int r = u.mblk * 256 + (tz & 255); r = r < u.M ? r : u.M - 1;
        if (FIRST) {
            if (w < 4) __builtin_amdgcn_global_load_lds((const unsigned*)((const float*)(ws + WS_LRS) + (size_t)u.e * T + r), (LAS unsigned*)(pf + w * 256), 4, 0, 0);
            else { const int c = tz - 256; const float* bsel = (w < 6) ? P.moe_bg : P.moe_bu;
                const float* src = bsel + ((size_t)layer * 32 + u.e) * 1024 + u.pn * 128 + (c & 127);
                __builtin_amdgcn_global_load_lds((const unsigned*)src, (LAS unsigned*)(pf + 1024 + (w - 4) * 256), 4, 0, 0); }
        } else {
            if (w < 4) { __builtin_amdgcn_global_load_lds((const unsigned*)((const int*)(ws + WS_LIST) + (size_t)u.e * T + r), (LAS unsigned*)(pf + w * 256), 4, 0, 0);
                __builtin_amdgcn_global_load_lds((const unsigned*)(P.moe_bd + ((size_t)layer * 32 + u.e) * 1024 + u.pn * 256 + tz), (LAS unsigned*)(pf + 2048 + w * 256), 4, 0, 0); }
            else __builtin_amdgcn_global_load_lds((const unsigned*)((const float*)(ws + WS_LGT) + (size_t)u.e * T + r), (LAS unsigned*)(pf + 1024 + (w - 4) * 256), 4, 0, 0);
        }
    }
    __device__ __forceinline__ const char* a_base() const { return FIRST ? (const char*)(P.ws + (FP8_ ? WS_YMIX : WS_HB)) : (const char*)(P.ws + WS_BIG); }
    __device__ __forceinline__ unsigned a_off(const Unit& u, int r) const {
        if (FIRST) { int rr = u.mblk * 256 + r; rr = rr < u.M ? rr : u.M - 1; const int ts = ((const int*)(P.ws + WS_LIST))[(size_t)u.e * T + rr]; return (unsigned)(ts >> 2) * RB; }
        return (unsigned)(u.rowoff + u.mblk * 256 + r) * RB;
    }
    __device__ __forceinline__ const unsigned* a_list_ptr(const Unit& u, int r) const { int rr = u.mblk * 256 + r; rr = rr < u.M ? rr : u.M - 1; return (const unsigned*)((const int*)(P.ws + WS_LIST) + (size_t)u.e * T + rr); }
    __device__ __forceinline__ unsigned a_from_list(int ts) const { return (unsigned)(ts >> 2) * RB; }
    __device__ __forceinline__ const char* b_base(const Unit& u) const {
        return FIRST ? (const char*)(P.ws + WS_W1) + ((size_t)u.e * 2048 + (size_t)u.pn * 256) * RB : (const char*)(P.ws + WS_W2) + ((size_t)u.e * 1024 + (size_t)u.pn * 256) * RB;
    }
    __device__ __forceinline__ void epilogue(const f32x4 (&acc)[2][2][4][2], const Unit& u, int wr, int wc, int fr, int fq) const {
        char* ws = P.ws; const int rl0 = u.mblk * 256 + wr * 64 + fr;
        if (FIRST) {
            const float* lrs = (const float*)(ws + WS_LRS) + (size_t)u.e * T;
            bf16_t* H = (bf16_t*)(ws + WS_BIG) + (size_t)u.rowoff * 1024;
            const int hc0 = u.pn * 128 + wc * 32 + 8 * fq;
            const float* bgp = P.moe_bg + ((size_t)layer * 32 + u.e) * 1024 + hc0; const float* bup = P.moe_bu + ((size_t)layer * 32 + u.e) * 1024 + hc0;
            f32x4 bg0, bg1, bu0, bu1; float sc[2][4];
            if constexpr (FP8_) {
                const LAS float* pf = (const LAS float*)((const LAS unsigned char*)tab + PF_OFF);
                bg0 = *(const LAS f32x4*)(pf + 256 + wc * 32 + 8 * fq); bg1 = *(const LAS f32x4*)(pf + 256 + wc * 32 + 8 * fq + 4);
                bu0 = *(const LAS f32x4*)(pf + 384 + wc * 32 + 8 * fq) + 1.0f; bu1 = *(const LAS f32x4*)(pf + 384 + wc * 32 + 8 * fq + 4) + 1.0f;
#pragma unroll
                for (int ai = 0; ai < 2; ++ai)
#pragma unroll
                    for (int m = 0; m < 4; ++m) sc[ai][m] = pf[ai * HALF + wr * 64 + m * 16 + fr];
            } else {
                bg0 = *(const f32x4*)bgp; bg1 = *(const f32x4*)(bgp + 4); bu0 = *(const f32x4*)bup + 1.0f; bu1 = *(const f32x4*)(bup + 4) + 1.0f;
#pragma unroll
                for (int ai = 0; ai < 2; ++ai)
#pragma unroll
                    for (int m = 0; m < 4; ++m) { const int r = rl0 + ai * HALF + m * 16; sc[ai][m] = lrs[r < u.M ? r : u.M - 1]; }
            }
#pragma unroll
            for (int ai = 0; ai < 2; ++ai)
#pragma unroll
                for (int m = 0; m < 4; ++m) { const int r = rl0 + ai * HALF + m * 16;
                    if (FP8_ || r < u.M) {
                        const float s_ = sc[ai][m]; const f32x4 g0 = acc[ai][0][m][0], g1 = acc[ai][0][m][1], u0 = acc[ai][1][m][0], u1 = acc[ai][1][m][1];
                        const f32x2 h01 = swiglu2(__builtin_shufflevector(g0, g0, 0, 1), __builtin_shufflevector(u0, u0, 0, 1), s_, __builtin_shufflevector(bg0, bg0, 0, 1), __builtin_shufflevector(bu0, bu0, 0, 1));
                        const f32x2 h23 = swiglu2(__builtin_shufflevector(g0, g0, 2, 3), __builtin_shufflevector(u0, u0, 2, 3), s_, __builtin_shufflevector(bg0, bg0, 2, 3), __builtin_shufflevector(bu0, bu0, 2, 3));
                        const f32x2 h45 = swiglu2(__builtin_shufflevector(g1, g1, 0, 1), __builtin_shufflevector(u1, u1, 0, 1), s_, __builtin_shufflevector(bg1, bg1, 0, 1), __builtin_shufflevector(bu1, bu1, 0, 1));
                        const f32x2 h67 = swiglu2(__builtin_shufflevector(g1, g1, 2, 3), __builtin_shufflevector(u1, u1, 2, 3), s_, __builtin_shufflevector(bg1, bg1, 2, 3), __builtin_shufflevector(bu1, bu1, 2, 3));
                        if constexpr (FP8_) { typedef unsigned u32x2w __attribute__((ext_vector_type(2))); __builtin_nontemporal_store((u32x2w){pack4_fp8(h01[0], h01[1], h23[0], h23[1]), pack4_fp8(h45[0], h45[1], h67[0], h67[1])}, (u32x2w*)((unsigned char*)(ws + WS_BIG) + (size_t)(u.rowoff + r) * 1024 + hc0)); }
                        else *(u32x4_t*)(H + (size_t)r * 1024 + hc0) = (u32x4_t){pack2v(h01), pack2v(h23), pack2v(h45), pack2v(h67)};
                    } }
        } else {
            const int* list = (const int*)(ws + WS_LIST) + (size_t)u.e * T; const float* lgt = (const float*)(ws + WS_LGT) + (size_t)u.e * T;
            bf16_t* Y = (bf16_t*)(ws + WS_Y);
            const int col0 = u.pn * 256 + wc * 32 + 8 * fq;
            const float* bdp = P.moe_bd + ((size_t)layer * 32 + u.e) * 1024 + col0;
            f32x4 bd[2][2];
            int tsv[2][4]; float gv[2][4];
            if constexpr (FP8_) {
                const LAS float* pf = (const LAS float*)((const LAS unsigned char*)tab + PF_OFF);
#pragma unroll
                for (int bj = 0; bj < 2; ++bj) { bd[bj][0] = *(const LAS f32x4*)(pf + 512 + wc * 64 + 16 * fq + 8 * bj); bd[bj][1] = *(const LAS f32x4*)(pf + 512 + wc * 64 + 16 * fq + 8 * bj + 4); }
#pragma unroll
                for (int ai = 0; ai < 2; ++ai)
#pragma unroll
                    for (int m = 0; m < 4; ++m) { const int rt = ai * HALF + wr * 64 + m * 16 + fr, r = u.mblk * 256 + rt; const int ts_ = ((const LAS int*)pf)[rt]; tsv[ai][m] = r < u.M ? ts_ : T * 4 + (r & 255); gv[ai][m] = pf[256 + rt]; }
            } else {
#pragma unroll
            for (int bj = 0; bj < 2; ++bj) { bd[bj][0] = *(const f32x4*)(bdp + bj * HALF); bd[bj][1] = *(const f32x4*)(bdp + bj * HALF + 4); }
#pragma unroll
            for (int ai = 0; ai < 2; ++ai)
#pragma unroll
                for (int m = 0; m < 4; ++m) { const int r = rl0 + ai * HALF + m * 16; const int rc = r < u.M ? r : u.M - 1; const int ts_ = list[rc]; tsv[ai][m] = (!FP8_ || r < u.M) ? ts_ : T * 4 + (r & 255); gv[ai][m] = lgt[rc]; }
            }
#pragma unroll
            for (int ai = 0; ai < 2; ++ai)
#pragma unroll
                for (int m = 0; m < 4; ++m) { const int r = rl0 + ai * HALF + m * 16;
                    if (FP8_ || r < u.M) {
                        const float g = FP8_ ? gv[ai][m] * 16.0f : gv[ai][m]; bf16_t* yr = Y + (size_t)tsv[ai][m] * 1024 + col0;
                        if constexpr (FP8_) {
                            const f32x4 a0_ = (acc[ai][0][m][0] + bd[0][0]) * g, b0_ = (acc[ai][0][m][1] + bd[0][1]) * g, a1_ = (acc[ai][1][m][0] + bd[1][0]) * g, b1_ = (acc[ai][1][m][1] + bd[1][1]) * g;
                            __builtin_nontemporal_store((u32x4_t){pack4_fp8(a0_[0], a0_[1], a0_[2], a0_[3]), pack4_fp8(b0_[0], b0_[1], b0_[2], b0_[3]), pack4_fp8(a1_[0], a1_[1], a1_[2], a1_[3]), pack4_fp8(b1_[0], b1_[1], b1_[2], b1_[3])}, (u32x4_t*)((unsigned char*)(ws + WS_Y) + (size_t)tsv[ai][m] * 1024 + u.pn * 256 + wc * 64 + 16 * fq));
                        } else {
#pragma unroll
                        for (int bj = 0; bj < 2; ++bj) { const f32x4 a = (acc[ai][bj][m][0] + bd[bj][0]) * g, b = (acc[ai][bj][m][1] + bd[bj][1]) * g;
                            *(u32x4_t*)(yr + bj * HALF) = (u32x4_t){pack2(a[0], a[1]), pack2(a[2], a[3]), pack2(b[0], b[1]), pack2(b[2], b[3])}; } }
                    } }
        }
    }
};
}
template <bool FIRST, bool FP8>
__device__ __forceinline__ void ph_moe_fast(const Params& P, int layer, LAS unsigned char* lds) {
    LAS int* tab = (LAS int*)(lds + fg::STAGE_BYTES);
    const int tz = opaque_tid();
    if (tz < 32) tab[tz] = (int)((const unsigned*)(P.ws + WS_CTL))[CTL_CNT + layer * 32 + tz];
    __syncthreads();
    const fg::MoeProb<FIRST, FP8> pb(P, layer, tab);
    fg::gemm_phase(lds, pb);
}


namespace at {
typedef short s16x4 __attribute__((ext_vector_type(4)));
constexpr int KSLOT = 12288, VSLOT = 8192, NSLOT = 4, LDS_K = 0, LDS_V = NSLOT * KSLOT, LDS_END = LDS_V + NSLOT * VSLOT;
typedef float f32x2_t __attribute__((ext_vector_type(2))); typedef __bf16 bf16x2_t __attribute__((ext_vector_type(2)));
__device__ __forceinline__ unsigned cvtpk(float lo, float hi) { const f32x2_t v = {lo, hi}; const bf16x2_t b = __builtin_convertvector(v, bf16x2_t); return __builtin_bit_cast(unsigned, b); }
__device__ __forceinline__ void glds16(const void* gsrc, unsigned lds_dst) { unsigned keep;
    asm volatile("s_mov_b32 %0, m0\n\ts_mov_b32 m0, %2\n\ts_nop 0\n\tglobal_load_lds_dwordx4 %1, off\n\ts_mov_b32 m0, %0" : "=&s"(keep) : "v"(gsrc), "s"(lds_dst) : "memory"); }
__device__ __forceinline__ s16x4 vtr(const LAS unsigned char* p) { return __builtin_bit_cast(s16x4, __builtin_amdgcn_ds_read_tr16_b64_v4i16((LAS s16x4*)p)); }

__device__ __forceinline__ void attn_unit(int b, int h, int qb, const bf16_t* Q, const bf16_t* Kd, const bf16_t* KV, bf16_t* YM, LAS unsigned char* lds) {
    const int tid = opaque_tid(); const int lane = tid & 63, r32 = lane & 31, hi = lane >> 5; const int wid = __builtin_amdgcn_readfirstlane(tid >> 6);
    const int q0 = qb * 256; const size_t row = (size_t)b * SEQ + q0 + wid * 32 + r32;
    const int NT = 4 * qb + 4;
    const char* ksrcA = (const char*)(Kd + (((size_t)b * SEQ + lane) * 8 + h) * 96) + wid * 16;
    const char* ksrcB = (const char*)(Kd + (((size_t)b * SEQ + lane) * 8 + h) * 96) + (8 + (wid & 3)) * 16;
    const char* vsrc = (const char*)(KV + ((size_t)b * SEQ + 16 * (wid & 3) + (lane >> 2)) * 1024 + h * 128 + 64 + (wid >> 2) * 32 + (lane & 3) * 8);
    const unsigned lds0 = (unsigned)(size_t)lds;
#define AT_DMA(j, slot) do { \
        glds16(ksrcA + (size_t)(j) * (64 * 1536), (unsigned)__builtin_amdgcn_readfirstlane((int)(lds0 + LDS_K + (slot) * KSLOT + wid * 1024))); \
        glds16(ksrcB + (size_t)(j) * (64 * 1536), (unsigned)__builtin_amdgcn_readfirstlane((int)(lds0 + LDS_K + (slot) * KSLOT + (8 + (wid & 3)) * 1024))); \
        glds16(vsrc + (size_t)(j) * (64 * 2048), (unsigned)__builtin_amdgcn_readfirstlane((int)(lds0 + LDS_V + (slot) * VSLOT + wid * 1024))); } while (0)
    AT_DMA(0, 0); AT_DMA(1, 1); AT_DMA(2, 2);
    bf16x8 qf[6];
#pragma unroll
    for (int ks = 0; ks < 6; ++ks) qf[ks] = *(const bf16x8*)(Q + row * 768 + h * 96 + ks * 16 + hi * 8);
    asm volatile("" : "+v"(qf[0]), "+v"(qf[1]), "+v"(qf[2]), "+v"(qf[3]), "+v"(qf[4]), "+v"(qf[5]));
    constexpr float THR = 8.0f;
    float mref = 0.f, l = 0.f;
    f32x16 o0, o1, negm;
#pragma unroll
    for (int r = 0; r < 16; ++r) { o0[r] = 0.f; o1[r] = 0.f; negm[r] = 0.f; }
    const int kfo = hi * 1024 + r32 * 16;
    const int vfo = ((lane >> 4) & 1) * 32 + (lane & 3) * 8 + (4 * hi + ((lane & 15) >> 2)) * 64;
    const int qrel = wid * 32 + r32;
    int slot = 0;
    for (int j = 0; j < NT; ++j) {
        if (j + 2 < NT) asm volatile("s_waitcnt vmcnt(6)\n\ts_barrier" ::: "memory"); else if (j + 1 < NT) asm volatile("s_waitcnt vmcnt(3)\n\ts_barrier" ::: "memory"); else asm volatile("s_waitcnt vmcnt(0)\n\ts_barrier" ::: "memory");
        if (j + 3 < NT) { AT_DMA(j + 3, (slot + 3) & 3); }
        const LAS unsigned char* kp = lds + LDS_K + slot * KSLOT + kfo;
        const LAS unsigned char* vp = lds + LDS_V + slot * VSLOT + vfo;
        f32x16 s0, s1;
#pragma unroll
        for (int ks = 0; ks < 6; ++ks) {
            const bf16x8 k0 = *(const LAS bf16x8*)(kp + ks * 2048), k1 = *(const LAS bf16x8*)(kp + ks * 2048 + 512);
            s0 = __builtin_amdgcn_mfma_f32_32x32x16_bf16(k0, qf[ks], ks == 0 ? negm : s0, 0, 0, 0);
            s1 = __builtin_amdgcn_mfma_f32_32x32x16_bf16(k1, qf[ks], ks == 0 ? negm : s1, 0, 0, 0);
        }
        if (j >= NT - 4) {
            const int kb = 64 * (j - (NT - 4)) + 4 * hi;
#pragma unroll
            for (int r = 0; r < 16; ++r) { const int kv = kb + (r & 3) + 8 * (r >> 2); if (kv > qrel) s0[r] = -INFINITY; if (kv + 32 > qrel) s1[r] = -INFINITY; }
        }
        float rm = fmaxf(fmaxf(s0[0], s1[0]), fmaxf(s0[1], s1[1]));
#pragma unroll
        for (int r = 2; r < 16; r += 2) rm = fmaxf(rm, fmaxf(fmaxf(s0[r], s1[r]), fmaxf(s0[r + 1], s1[r + 1])));
        rm = xhalf_max(rm);
        if (__any(rm > THR)) {
            const float dl = fmaxf(rm, 0.f);
            mref += dl;
#pragma unroll
            for (int r = 0; r < 16; ++r) { s0[r] -= dl; s1[r] -= dl; negm[r] = -mref; }
            const float f = __builtin_amdgcn_exp2f(-dl);
            l *= f;
#pragma unroll
            for (int r = 0; r < 16; ++r) { o0[r] *= f; o1[r] *= f; }
        }
        float ps0 = 0.f, ps1 = 0.f;
#pragma unroll
        for (int r = 0; r < 16; ++r) { s0[r] = __builtin_amdgcn_exp2f(s0[r]); s1[r] = __builtin_amdgcn_exp2f(s1[r]); ps0 += s0[r]; ps1 += s1[r]; }
        l += ps0 + ps1;
        bf16x8 pf[4];
        {
            unsigned w[16];
#pragma unroll
            for (int i = 0; i < 8; ++i) { w[i] = cvtpk(s0[2 * i], s0[2 * i + 1]); w[8 + i] = cvtpk(s1[2 * i], s1[2 * i + 1]); }
#pragma unroll
            for (int k = 0; k < 4; ++k) { typedef unsigned u32x4 __attribute__((ext_vector_type(4))); const u32x4 t = {w[4 * k], w[4 * k + 1], w[4 * k + 2], w[4 * k + 3]}; pf[k] = __builtin_bit_cast(bf16x8, t); }
        }
#pragma unroll
        for (int k = 0; k < 4; ++k) {
            const s16x4 a0 = vtr(vp + k * 1024), a1 = vtr(vp + k * 1024 + 512), c0 = vtr(vp + 4096 + k * 1024), c1 = vtr(vp + 4096 + k * 1024 + 512);
            const bf16x8 v0 = {a0[0], a0[1], a0[2], a0[3], a1[0], a1[1], a1[2], a1[3]}, v1 = {c0[0], c0[1], c0[2], c0[3], c1[0], c1[1], c1[2], c1[3]};
            o0 = __builtin_amdgcn_mfma_f32_32x32x16_bf16(v0, pf[k], o0, 0, 0, 0);
            o1 = __builtin_amdgcn_mfma_f32_32x32x16_bf16(v1, pf[k], o1, 0, 0, 0);
        }
        slot = (slot + 1) & 3;
    }
    l = xhalf_sum(l);
    const float rl = 1.0f / l;
    bf16_t* op = YM + row * 1024 + 256 + h * 64 + 8 * hi;
    typedef unsigned u32x4w __attribute__((ext_vector_type(4)));
#pragma unroll
    for (int gp = 0; gp < 4; gp += 2) {
        { const auto s0_ = __builtin_amdgcn_permlane32_swap(cvtpk(o0[4 * gp] * rl, o0[4 * gp + 1] * rl), cvtpk(o0[4 * gp + 4] * rl, o0[4 * gp + 5] * rl), false, false);
          const auto s1_ = __builtin_amdgcn_permlane32_swap(cvtpk(o0[4 * gp + 2] * rl, o0[4 * gp + 3] * rl), cvtpk(o0[4 * gp + 6] * rl, o0[4 * gp + 7] * rl), false, false);
          *(u32x4w*)(op + 8 * gp) = (u32x4w){s0_[0], s1_[0], s0_[1], s1_[1]}; }
        { const auto s0_ = __builtin_amdgcn_permlane32_swap(cvtpk(o1[4 * gp] * rl, o1[4 * gp + 1] * rl), cvtpk(o1[4 * gp + 4] * rl, o1[4 * gp + 5] * rl), false, false);
          const auto s1_ = __builtin_amdgcn_permlane32_swap(cvtpk(o1[4 * gp + 2] * rl, o1[4 * gp + 3] * rl), cvtpk(o1[4 * gp + 6] * rl, o1[4 * gp + 7] * rl), false, false);
          *(u32x4w*)(op + 32 + 8 * gp) = (u32x4w){s0_[0], s1_[0], s0_[1], s1_[1]}; }
    }
    asm volatile("s_waitcnt lgkmcnt(0)\n\ts_barrier" ::: "memory");
#undef AT_DMA
}
}
__device__ __forceinline__ void ph_attn_fast(const Params& P, LAS unsigned char* lds) {
    const bf16_t* Q = (const bf16_t*)(P.ws + WS_BIG + BIG_Q); const bf16_t* Kd = (const bf16_t*)(P.ws + WS_BIG + BIG_K); const bf16_t* KV = (const bf16_t*)(P.ws + WS_BIG + BIG_KV);
    bf16_t* YM = (bf16_t*)(P.ws + WS_YMIX);
    const int G = grid_size();
    for (int v0 = (blockIdx.x % 8) * (G / 8) + blockIdx.x / 8; v0 < 256; v0 += G) {
        const int bh = v0 >> 2, s = v0 & 3;
#pragma unroll 1
        for (int i = 0; i < 4; ++i) { const int qb = (i == 0) ? s : (i == 1) ? 7 - s : (i == 2) ? 8 + s : 15 - s; at::attn_unit(bh >> 3, bh & 7, qb, Q, Kd, KV, YM, lds); }
    }
}


template <bool DRY = false> __device__ __forceinline__ void ph_gla_x(const Params& P, LAS unsigned char* lds) {
    const int tid = opaque_tid(); const int wid = __builtin_amdgcn_readfirstlane(tid >> 6), lane = tid & 63;
    LAS float* kend = (LAS float*)(lds + wid * 8192);
    const bf16_t* Z = (const bf16_t*)(P.ws + WS_BIG + BIG_Z); float* LA = (float*)(P.ws + WS_BIG + BIG_LA);
    float* UPD = DRY ? (float*)(P.ws + WS_Y + 32 * MiB) : (float*)(P.ws + WS_UPD); float* DEC = DRY ? (float*)(P.ws + WS_Y + 64 * MiB) : (float*)(P.ws + WS_DEC); float* LAW = DRY ? (float*)(P.ws + WS_Y) : LA;
    for (int u = blockIdx.x * NWV + wid; u < 2048; u += grid_size() * NWV) {
        const int bh = u >> 6, n = u & 63, b = bh >> 2, h = bh & 3;
        const size_t t0 = (size_t)b * SEQ + n * 64;
        const int k = lane & 31, half = lane >> 5;
        float c[32]; float run = 0.f;
#pragma unroll
        for (int i = 0; i < 32; ++i) { run += LA[(t0 + 32 * half + i) * 128 + h * 32 + k]; c[i] = run; }
        const float tot0 = __shfl(run, k);
        const float add = half ? tot0 : 0.f;
        const float blast = __shfl(run, 32 + k) + tot0;
        float kk[32];
#pragma unroll
        for (int i = 0; i < 32; ++i) kk[i] = bf2f(Z[(t0 + 32 * half + i) * ZW + ZC_GK + h * 32 + k]);
        typedef unsigned u32x4 __attribute__((ext_vector_type(4)));
        LAS unsigned char* vl = (LAS unsigned char*)kend;
        u32x4 vx[8];
#pragma unroll
        for (int p = 0; p < 8; ++p) { const int row = 8 * p + (lane >> 3), dv = 8 * (lane & 7); vx[p] = *(const u32x4*)(Z + (t0 + row) * ZW + ZC_GV + h * 64 + dv); }
#pragma unroll
        for (int p = 0; p < 8; ++p) { const int row = 8 * p + (lane >> 3), dv = 8 * (lane & 7); *(LAS u32x4*)(vl + (dv >> 5) * 4096 + (row >> 3) * 512 + (row & 7) * 64 + (dv & 31) * 2) = vx[p]; }
        bf16x8 af[4];
        {
            unsigned aw[16];
#pragma unroll
            for (int i = 0; i < 32; i += 2) {
                const float bc0 = c[i] + add, bc1 = c[i + 1] + add; const size_t t = t0 + 32 * half + i;
                LAW[t * 128 + h * 32 + k] = bc0; LAW[(t + 1) * 128 + h * 32 + k] = bc1;
                aw[i >> 1] = at::cvtpk(kk[i] * __expf(blast - bc0), kk[i + 1] * __expf(blast - bc1));
            }
#pragma unroll
            for (int s4 = 0; s4 < 4; ++s4) { const u32x4 w_ = {aw[4 * s4], aw[4 * s4 + 1], aw[4 * s4 + 2], aw[4 * s4 + 3]}; af[s4] = __builtin_bit_cast(bf16x8, w_); }
        }
        if (half == 0) DEC[(size_t)u * 32 + k] = __expf(blast);
        asm volatile("s_waitcnt lgkmcnt(0)" ::: "memory");
        const int sfo = ((lane >> 4) & 1) * 32 + (lane & 3) * 8 + ((lane & 15) >> 2) * 64;
        at::f32x16 upd[2];
#pragma unroll
        for (int vb = 0; vb < 2; ++vb) {
#pragma unroll
            for (int r = 0; r < 16; ++r) upd[vb][r] = 0.f;
#pragma unroll
            for (int s4 = 0; s4 < 4; ++s4) {
                const at::s16x4 a0 = at::vtr(vl + sfo + vb * 4096 + (4 * half + s4) * 512), a1 = at::vtr(vl + sfo + vb * 4096 + (4 * half + s4) * 512 + 256);
                const bf16x8 vt = {a0[0], a0[1], a0[2], a0[3], a1[0], a1[1], a1[2], a1[3]};
                upd[vb] = __builtin_amdgcn_mfma_f32_32x32x16_bf16(af[s4], vt, upd[vb], 0, 0, 0);
            }
        }
#pragma unroll
        for (int vb = 0; vb < 2; ++vb)
#pragma unroll
            for (int r = 0; r < 16; ++r) UPD[((size_t)u * 32 + (r & 3) + 8 * (r >> 2) + 4 * half) * 64 + 32 * vb + (lane & 31)] = upd[vb][r];
        asm volatile("s_waitcnt lgkmcnt(0)" ::: "memory");
    }
}
__device__ __forceinline__ void ph_gla_scan(const Params& P) {
    const int tz = opaque_tid();
    const float* UPD = (const float*)(P.ws + WS_UPD); const float* DEC = (const float*)(P.ws + WS_DEC); bf16_t* SP = (bf16_t*)(P.ws + WS_SPREV);
    for (int e = blockIdx.x * NTHR + tz; e < 32 * 2048; e += grid_size() * NTHR) {
        const int bh = e >> 11, kv = e & 2047, k = kv >> 6;
        float st = 0.f;
        float dd[64], uu[64];
#pragma unroll
        for (int q = 0; q < 64; ++q) { const size_t u = (size_t)bh * 64 + q; dd[q] = DEC[u * 32 + k]; uu[q] = UPD[u * 2048 + kv]; }
#pragma unroll
        for (int q = 0; q < 64; ++q) { const size_t u = (size_t)bh * 64 + q; SP[u * 2048 + kv] = f2bf(st); st = dd[q] * st + uu[q]; }
    }
}
__device__ __forceinline__ void ph_gla_y(const Params& P, int layer, LAS unsigned char* lds) {
    using at::f32x16; using at::s16x4; using at::vtr; using at::cvtpk;
    typedef unsigned u32x4 __attribute__((ext_vector_type(4)));
    const int tid = opaque_tid(); const int wid = __builtin_amdgcn_readfirstlane(tid >> 6), lane = tid & 63, r32 = lane & 31, hi = lane >> 5;
    LAS unsigned char* vl = lds + wid * 12288; LAS unsigned char* sl = vl + 8192;
    const bf16_t* Z = (const bf16_t*)(P.ws + WS_BIG + BIG_Z); const float* LA = (const float*)(P.ws + WS_BIG + BIG_LA); const bf16_t* SP = (const bf16_t*)(P.ws + WS_SPREV);
    bf16_t* YM = (bf16_t*)(P.ws + WS_YMIX); const float* gon = P.gla_on + layer * 64;
    const int vfo = ((lane >> 4) & 1) * 32 + (lane & 3) * 8 + (4 * hi + ((lane & 15) >> 2)) * 64;
    const int sfo = ((lane >> 4) & 1) * 32 + (lane & 3) * 8 + ((lane & 15) >> 2) * 64;
    for (int u = blockIdx.x * NWV + wid; u < 2048; u += grid_size() * NWV) {
        const int bh = u >> 6, n = u & 63, b = bh >> 2, h = bh & 3;
        const size_t t0 = (size_t)b * SEQ + n * 64;
#pragma unroll
        for (int p = 0; p < 8; ++p) {
            const int row = 8 * p + (lane >> 3), dv = 8 * (lane & 7);
            const u32x4 x = *(const u32x4*)(Z + (t0 + row) * ZW + ZC_GV + h * 64 + dv);
            *(LAS u32x4*)(vl + (dv >> 5) * 4096 + (row >> 3) * 512 + (row & 7) * 64 + (dv & 31) * 2) = x;
        }
#pragma unroll
        for (int p = 0; p < 4; ++p) {
            const int row = 8 * p + (lane >> 3), dv = 8 * (lane & 7);
            const u32x4 x = *(const u32x4*)(SP + ((size_t)u * 32 + row) * 64 + dv);
            *(LAS u32x4*)(sl + (dv >> 5) * 2048 + (row >> 3) * 512 + (row & 7) * 64 + (dv & 31) * 2) = x;
        }
        bf16x8 qfr[2][2], kfr[2][2];
#pragma unroll
        for (int blk = 0; blk < 2; ++blk)
#pragma unroll
            for (int ks = 0; ks < 2; ++ks) {
                const size_t t = t0 + 32 * blk + r32; const int k0 = 16 * ks + 8 * hi;
                const uint4 qraw = *(const uint4*)(Z + t * ZW + ZC_GQ + h * 32 + k0), kraw = *(const uint4*)(Z + t * ZW + ZC_GK + h * 32 + k0);
                const f32x4 b0 = *(const f32x4*)(LA + t * 128 + h * 32 + k0), b1 = *(const f32x4*)(LA + t * 128 + h * 32 + k0 + 4);
                const unsigned qw[4] = {qraw.x, qraw.y, qraw.z, qraw.w}, kw[4] = {kraw.x, kraw.y, kraw.z, kraw.w};
                const float bcv[8] = {b0[0], b0[1], b0[2], b0[3], b1[0], b1[1], b1[2], b1[3]};
                u32x4 qo, ko;
#pragma unroll
                for (int w = 0; w < 4; ++w) {
                    const float e0 = __expf(bcv[2 * w]), e1 = __expf(bcv[2 * w + 1]);
                    const float q0 = bf2f(qw[w] & 0xffff) * 0.17677669529663687f * e0, q1 = bf2f(qw[w] >> 16) * 0.17677669529663687f * e1;
                    const float k0f = bf2f(kw[w] & 0xffff) * __expf(-bcv[2 * w]), k1f = bf2f(kw[w] >> 16) * __expf(-bcv[2 * w + 1]);
                    qo[w] = cvtpk(q0, q1); ko[w] = cvtpk(k0f, k1f);
                }
                qfr[blk][ks] = __builtin_bit_cast(bf16x8, qo); kfr[blk][ks] = __builtin_bit_cast(bf16x8, ko);
            }
        uint2 rrv[2][2][4];
#pragma unroll
        for (int ib = 0; ib < 2; ++ib)
#pragma unroll
            for (int vb = 0; vb < 2; ++vb)
#pragma unroll
                for (int g = 0; g < 4; ++g) rrv[ib][vb][g] = *(const uint2*)(Z + (t0 + 32 * ib + r32) * ZW + ZC_GR + h * 64 + 32 * vb + 8 * g + 4 * hi);
        f32x4 gnv[2][4];
#pragma unroll
        for (int vb = 0; vb < 2; ++vb)
#pragma unroll
            for (int g = 0; g < 4; ++g) gnv[vb][g] = *(const f32x4*)(gon + 32 * vb + 8 * g + 4 * hi);
        f32x16 z16;
#pragma unroll
        for (int r = 0; r < 16; ++r) z16[r] = 0.f;
        f32x16 s00 = __builtin_amdgcn_mfma_f32_32x32x16_bf16(kfr[0][0], qfr[0][0], z16, 0, 0, 0); s00 = __builtin_amdgcn_mfma_f32_32x32x16_bf16(kfr[0][1], qfr[0][1], s00, 0, 0, 0);
        f32x16 s01 = __builtin_amdgcn_mfma_f32_32x32x16_bf16(kfr[0][0], qfr[1][0], z16, 0, 0, 0); s01 = __builtin_amdgcn_mfma_f32_32x32x16_bf16(kfr[0][1], qfr[1][1], s01, 0, 0, 0);
        f32x16 s11 = __builtin_amdgcn_mfma_f32_32x32x16_bf16(kfr[1][0], qfr[1][0], z16, 0, 0, 0); s11 = __builtin_amdgcn_mfma_f32_32x32x16_bf16(kfr[1][1], qfr[1][1], s11, 0, 0, 0);
#pragma unroll
        for (int r = 0; r < 16; ++r) { const int jl = (r & 3) + 8 * (r >> 2) + 4 * hi; if (jl > r32) { s00[r] = 0.f; s11[r] = 0.f; } }
        bf16x8 p00[2], p01[2], p11[2];
#pragma unroll
        for (int sp = 0; sp < 2; ++sp) {
            u32x4 a, c, d;
#pragma unroll
            for (int w = 0; w < 4; ++w) { a[w] = cvtpk(s00[8 * sp + 2 * w], s00[8 * sp + 2 * w + 1]); c[w] = cvtpk(s01[8 * sp + 2 * w], s01[8 * sp + 2 * w + 1]); d[w] = cvtpk(s11[8 * sp + 2 * w], s11[8 * sp + 2 * w + 1]); }
            p00[sp] = __builtin_bit_cast(bf16x8, a); p01[sp] = __builtin_bit_cast(bf16x8, c); p11[sp] = __builtin_bit_cast(bf16x8, d);
        }
        asm volatile("s_waitcnt lgkmcnt(0)" ::: "memory");
        f32x16 o[2][2];
#pragma unroll
        for (int vb = 0; vb < 2; ++vb) {
            o[vb][0] = z16; o[vb][1] = z16;
#pragma unroll
            for (int k2 = 0; k2 < 4; ++k2) {
                const s16x4 a0 = vtr(vl + vfo + vb * 4096 + k2 * 1024), a1 = vtr(vl + vfo + vb * 4096 + k2 * 1024 + 512);
                const bf16x8 vt = {a0[0], a0[1], a0[2], a0[3], a1[0], a1[1], a1[2], a1[3]};
                if (k2 < 2) { o[vb][0] = __builtin_amdgcn_mfma_f32_32x32x16_bf16(vt, p00[k2], o[vb][0], 0, 0, 0); o[vb][1] = __builtin_amdgcn_mfma_f32_32x32x16_bf16(vt, p01[k2], o[vb][1], 0, 0, 0); }
                else o[vb][1] = __builtin_amdgcn_mfma_f32_32x32x16_bf16(vt, p11[k2 - 2], o[vb][1], 0, 0, 0);
            }
#pragma unroll
            for (int ks = 0; ks < 2; ++ks) {
                const s16x4 a0 = vtr(sl + sfo + vb * 2048 + (2 * ks + hi) * 512), a1 = vtr(sl + sfo + vb * 2048 + (2 * ks + hi) * 512 + 256);
                const bf16x8 st = {a0[0], a0[1], a0[2], a0[3], a1[0], a1[1], a1[2], a1[3]};
                o[vb][0] = __builtin_amdgcn_mfma_f32_32x32x16_bf16(st, qfr[0][ks], o[vb][0], 0, 0, 0);
                o[vb][1] = __builtin_amdgcn_mfma_f32_32x32x16_bf16(st, qfr[1][ks], o[vb][1], 0, 0, 0);
            }
        }
#pragma unroll
        for (int ib = 0; ib < 2; ++ib) {
            const size_t t = t0 + 32 * ib + r32;
            float ss = 0.f;
#pragma unroll
            for (int r = 0; r < 16; ++r) ss += o[0][ib][r] * o[0][ib][r] + o[1][ib][r] * o[1][ib][r];
            ss = at::xhalf_sum(ss);
            const float rstd = rsqrtf(ss * (1.0f / 64.0f) + EPS);
#pragma unroll
            for (int vb = 0; vb < 2; ++vb)
#pragma unroll
                for (int gp = 0; gp < 4; gp += 2) {
                    unsigned yw[2][2];
#pragma unroll
                    for (int gi_ = 0; gi_ < 2; ++gi_) { const int g = gp + gi_;
                        const uint2 rr = rrv[ib][vb][g]; const f32x4 gn = gnv[vb][g];
                        const float r0 = bf2f(rr.x & 0xffff), r1 = bf2f(rr.x >> 16), r2 = bf2f(rr.y & 0xffff), r3 = bf2f(rr.y >> 16);
                        const float y0 = o[vb][ib][4 * g] * rstd * gn[0] * r0 * sigmoidf_(r0), y1 = o[vb][ib][4 * g + 1] * rstd * gn[1] * r1 * sigmoidf_(r1);
                        const float y2 = o[vb][ib][4 * g + 2] * rstd * gn[2] * r2 * sigmoidf_(r2), y3 = o[vb][ib][4 * g + 3] * rstd * gn[3] * r3 * sigmoidf_(r3);
                        yw[gi_][0] = cvtpk(y0, y1); yw[gi_][1] = cvtpk(y2, y3); }
                    const auto s0_ = __builtin_amdgcn_permlane32_swap(yw[0][0], yw[1][0], false, false), s1_ = __builtin_amdgcn_permlane32_swap(yw[0][1], yw[1][1], false, false);
                    *(u32x4*)(YM + t * 1024 + h * 64 + 32 * vb + 8 * gp + 8 * hi) = (u32x4){s0_[0], s1_[0], s0_[1], s1_[1]};
                    __builtin_amdgcn_sched_barrier(0);
                }
        }
        asm volatile("s_waitcnt lgkmcnt(0)" ::: "memory");
    }
}


template <int L> __device__ __forceinline__ void layer_body(const Params& P, const XcdBarrier& bar, unsigned char* lds) {
    constexpr int l = L; char* ws = P.ws; LAS unsigned char* ldsl = (LAS unsigned char*)lds;
    const bf16_t* HB = (const bf16_t*)(ws + WS_HB); const float* RS = (const float*)(ws + WS_RSTD);
    bf16_t* Z = (bf16_t*)(ws + WS_BIG + BIG_Z);
    {
        const char* wsm = ws + WS_WSM + (size_t)l * WSM_STRIDE;
        { EpiBf16_8 e{(bf16_t*)(ws + WS_E), 1024}; ph_gemm_fast<256, 256, true>(ldsl, (const bf16_t*)(ws + WS_PB) + (size_t)l * T * 256, (const bf16_t*)(wsm + WSM_WPLE), 1024, e); }
        { EpiZ8 e{Z, RS}; if constexpr (Z_FP8) ph_gemm_fast<512, 512, true, EpiZ8, true>(ldsl, (const bf16_t*)(ws + WS_H8), (const bf16_t*)(wsm + WSM_WIN), ZW, e);
          else ph_gemm_fast<1024, 1024, true>(ldsl, HB, (const bf16_t*)(wsm + WSM_WIN), ZW, e); }
        xcd_barrier(bar);
        ph_prepB(P, l, lds);
        xcd_barrier(bar);
        { EpiBf16_8 e{(bf16_t*)(ws + WS_BIG + BIG_Q), 768}; ph_gemm_fast<256, ZW, true>(ldsl, Z + ZC_CQ, (const bf16_t*)(wsm + WSM_WUQ), 768, e); }
        { EpiBf16_8 e{(bf16_t*)(ws + WS_BIG + BIG_KV), 1024}; ph_gemm_fast<128, ZW, true>(ldsl, Z + ZC_CKV, (const bf16_t*)(wsm + WSM_WUKV), 1024, e); }
        __syncthreads();
        ph_gla_x(P, ldsl);
        xcd_barrier(bar);
        ph_prepD(P, l);
        ph_gla_scan(P);
        xcd_barrier(bar);
        if ((blockIdx.x >> 3) & 1) { ph_tconv_exp<(L == 0 ? MOE_FP8_L0 : MOE_FP8_L1)>(P, l, ldsl); }
        ph_attn_fast(P, ldsl);
        ph_gla_y(P, l, ldsl);
        if (!((blockIdx.x >> 3) & 1)) { __syncthreads(); ph_tconv_exp<(L == 0 ? MOE_FP8_L0 : MOE_FP8_L1)>(P, l, ldsl); }
        xcd_barrier(bar);
        { EpiResid8<L == 0> e{P.x, (bf16_t*)(ws + WS_HB)}; ph_gemm_fast<1024, 1024, true>(ldsl, (const bf16_t*)(ws + WS_YMIX), (const bf16_t*)(wsm + WSM_WOUT), 1024, e); }
        xcd_barrier(bar);
        ph_router<(L == 0 ? MOE_FP8_L0 : MOE_FP8_L1)>(P, l, ldsl);
        xcd_barrier(bar);
        ph_moe_fast<true, (L == 0 ? MOE_FP8_L0 : MOE_FP8_L1)>(P, l, ldsl);
        xcd_barrier(bar);
        ph_moe_fast<false, (L == 0 ? MOE_FP8_L0 : MOE_FP8_L1)>(P, l, ldsl);
        xcd_barrier(bar);
        ph_combine<(L == 0 ? MOE_FP8_L0 : MOE_FP8_L1)>(P);
        xcd_barrier(bar);
        { EpiPle8 e{(const bf16_t*)(ws + WS_E), RS + 2 * T, (bf16_t*)(ws + WS_YMIX)}; if constexpr (PG_FP8) ph_gemm_fast<512, 512, true, EpiPle8, true>(ldsl, (const bf16_t*)(ws + WS_H8B), (const bf16_t*)(wsm + WSM_WPG), 1024, e);
          else ph_gemm_fast<1024, 1024, true>(ldsl, HB, (const bf16_t*)(wsm + WSM_WPG), 1024, e); }
        xcd_barrier(bar);
        ph_final(P, l);
        if constexpr (L != DEPTH - 1) xcd_barrier(bar);
    }
}

__global__ void __launch_bounds__(NTHR, 2) mega_fwd(Params P) {
    extern __shared__ __attribute__((aligned(16))) unsigned char lds[];
    char* ws = P.ws;
    if (threadIdx.x == 0) *(uint4*)(lds + LDS_BAR_OFF) = make_uint4(0u, 0u, (unsigned)P.grid, 0u);
    if ((threadIdx.x & 63) == 0) *(volatile LAS int*)((LAS unsigned char*)lds + LDS_WID_OFF + hw_wave_key() * 4) = (int)(threadIdx.x >> 6);
    __syncthreads();
    const XcdBarrier bar = xcd_barrier_post((unsigned*)(ws + WS_CTL), (volatile LAS unsigned*)(lds + LDS_BAR_OFF));
    const bf16_t* HB = (const bf16_t*)(ws + WS_HB); const float* RS = (const float*)(ws + WS_RSTD);
    bf16_t* Z = (bf16_t*)(ws + WS_BIG + BIG_Z);
    ph_tconv_small(P, lds);
    ph_conv_bf16(P.p, (bf16_t*)(ws + WS_PB), (long)2 * T * 256 / 8);
    ph_prep_router(P);
    ph_init_h(P);
    ph_rope_table(P);
    xcd_barrier(bar);
    layer_body<0>(P, bar, lds);
    layer_body<1>(P, bar, lds);
}

extern "C" void kernel_launch(void* const* d_in, const int* in_sizes, int n_in, void* d_out, int out_size, void* d_ws, size_t ws_size, hipStream_t stream) {
    if (n_in != 30 || ws_size < WS_END) { fprintf(stderr, "kernel_launch: need 30 inputs and %zu bytes of workspace (got %d, %zu)\n", (size_t)WS_END, n_in, ws_size); return; }
    static int grid = 0;
    if (!grid) {
        int dev = 0, cus = 0, per_cu = 0;
        if (hipGetDevice(&dev) != hipSuccess || hipDeviceGetAttribute(&cus, hipDeviceAttributeMultiprocessorCount, dev) != hipSuccess) { fprintf(stderr, "kernel_launch: device query failed\n"); return; }
        if (hipFuncSetAttribute((const void*)mega_fwd, hipFuncAttributeMaxDynamicSharedMemorySize, LDS_BYTES) != hipSuccess) { fprintf(stderr, "kernel_launch: hipFuncSetAttribute failed\n"); return; }
        if (hipOccupancyMaxActiveBlocksPerMultiprocessor(&per_cu, (const void*)mega_fwd, NTHR, LDS_BYTES) != hipSuccess || per_cu < 1) { fprintf(stderr, "kernel_launch: occupancy query says %d\n", per_cu); return; }
        grid = cus;
    }
    Params P{};
    P.x = (const float*)d_in[0]; P.p = (const float*)d_in[1]; P.pos = (const int*)d_in[2];
    P.mix_norm = (const float*)d_in[3]; P.w_in = (const float*)d_in[4]; P.gla_wg = (const float*)d_in[5]; P.gla_bg = (const float*)d_in[6]; P.gla_on = (const float*)d_in[7];
    P.q_norm = (const float*)d_in[8]; P.w_uq = (const float*)d_in[9]; P.kv_norm = (const float*)d_in[10]; P.w_ukv = (const float*)d_in[11]; P.qkq = (const float*)d_in[12]; P.qkk = (const float*)d_in[13];
    P.pool_w = (const float*)d_in[14]; P.pool_s = (const float*)d_in[15]; P.w_out = (const float*)d_in[16]; P.ffn_norm = (const float*)d_in[17]; P.router_w = (const float*)d_in[18]; P.router_b = (const float*)d_in[19];
    P.moe_wg = (const float*)d_in[20]; P.moe_bg = (const float*)d_in[21]; P.moe_wu = (const float*)d_in[22]; P.moe_bu = (const float*)d_in[23]; P.moe_wd = (const float*)d_in[24]; P.moe_bd = (const float*)d_in[25];
    P.ple_wp = (const float*)d_in[26]; P.ple_gn = (const float*)d_in[27]; P.ple_wg = (const float*)d_in[28]; P.ple_pn = (const float*)d_in[29];
    P.out = (float*)d_out; P.ws = (char*)d_ws; P.grid = grid; P.pad_ = 0;
    (void)hipMemsetAsync((char*)d_ws + WS_CTL, 0, 65536, stream);
    hipLaunchKernelGGL(mega_fwd, dim3(grid), dim3(NTHR), LDS_BYTES, stream, P);
}
```
